# Optimizing an MI355X kernel written in HIP

```python
import jax, jax.numpy as jnp
from jax import lax
import numpy as np

D_MODEL = 1024
BATCH = 4
SEQ = 8192
DEPTH = 4

N_META = 16
N_A = DEPTH // 2
N_B = DEPTH - N_A
N_DENSE = (DEPTH + 1) // 2
N_MOE = DEPTH // 2

M_HEADS = 8
M_QK = 64
M_V = D_MODEL // M_HEADS
M_CHUNK = 64
M_IN = 2 * M_HEADS * M_QK + M_HEADS * M_V + D_MODEL + 2 * M_HEADS

A_HEADS = 16
A_KV = 4
A_HD = 64
A_GROUP = A_HEADS // A_KV
WINDOW = 128
ROPE_THETA = 500000.0
ROPE_DIM = A_HD // 4

D_FF = 2816
N_EXP = 8
TOP_K = 2
D_FF_EXP = 3584
MOE_BLOCK = 256

ALPHA = (2.0 * DEPTH) ** 0.25
BETA = (8.0 * DEPTH) ** -0.25
LN_EPS = 1e-5
NEG = -1e30

kernel_name = "hybrid_mlstm_swa_yoco_moe"


def layer_norm(x, g, b):
    xf = x.astype(jnp.float32)
    mu = xf.mean(-1, keepdims=True)
    var = jnp.square(xf - mu).mean(-1, keepdims=True)
    return ((xf - mu) * lax.rsqrt(var + LN_EPS) * g.astype(jnp.float32) + b.astype(jnp.float32)).astype(x.dtype)


def rope_tables(length):
    half = ROPE_DIM // 2
    inv_freq = ROPE_THETA ** (-jnp.arange(half, dtype=jnp.float32) * 2.0 / ROPE_DIM)
    ang = jnp.arange(length, dtype=jnp.float32)[:, None] * inv_freq[None, :]
    return jnp.cos(ang), jnp.sin(ang)


def partial_rope(x, cos, sin):
    half = ROPE_DIM // 2
    xr = x[..., :ROPE_DIM].astype(jnp.float32)
    x1, x2 = xr[..., :half], xr[..., half:]
    c, s = cos[None, :, None, :], sin[None, :, None, :]
    rot = jnp.concatenate([x1 * c - x2 * s, x2 * c + x1 * s], -1).astype(x.dtype)
    return jnp.concatenate([rot, x[..., ROPE_DIM:]], -1)


def mlstm_chunkwise(q, k, v, i_pre, f_pre):
    bsz, length, n_h, dk = q.shape
    dv = v.shape[-1]
    f32 = jnp.float32
    pad = (-length) % M_CHUNK
    q = jnp.pad(q.astype(f32) * dk ** -0.5, ((0, 0), (pad, 0), (0, 0), (0, 0)))
    k = jnp.pad(k.astype(f32), ((0, 0), (pad, 0), (0, 0), (0, 0)))
    v = jnp.pad(v.astype(f32), ((0, 0), (pad, 0), (0, 0), (0, 0)))
    li = jnp.pad(i_pre.astype(f32), ((0, 0), (pad, 0), (0, 0)), constant_values=NEG)
    lf = jnp.pad(jax.nn.log_sigmoid(f_pre.astype(f32)), ((0, 0), (pad, 0), (0, 0)))
    n_c = (length + pad) // M_CHUNK

    def chunks(t):
        return t.reshape(bsz, n_c, M_CHUNK, n_h, -1).transpose(0, 3, 1, 2, 4)

    qc, kc, vc = chunks(q), chunks(k), chunks(v)
    lic = li.reshape(bsz, n_c, M_CHUNK, n_h).transpose(0, 3, 1, 2)
    lfc = lf.reshape(bsz, n_c, M_CHUNK, n_h).transpose(0, 3, 1, 2)
    b = jnp.cumsum(lfc, axis=-1)
    b_last = b[..., -1]

    a = b_last[..., None] - b + lic
    a_max = a.max(-1)
    w = jnp.exp(a - a_max[..., None])
    c_loc = jnp.einsum('bhnc,bhnck,bhncv->bhnkv', w, kc, vc)
    n_loc = jnp.einsum('bhnc,bhnck->bhnk', w, kc)

    def step(carry, inp):
        c_st, n_st, m_st = carry
        cl, nl, ml, g = inp
        m_new = jnp.maximum(g + m_st, ml)
        s_old = jnp.exp(g + m_st - m_new)
        s_new = jnp.exp(ml - m_new)
        c_new = s_old[..., None, None] * c_st + s_new[..., None, None] * cl
        n_new = s_old[..., None] * n_st + s_new[..., None] * nl
        return (c_new, n_new, m_new), (c_st, n_st, m_st)

    init = (jnp.zeros((bsz, n_h, dk, dv), f32), jnp.zeros((bsz, n_h, dk), f32), jnp.zeros((bsz, n_h), f32))
    xs = (jnp.moveaxis(c_loc, 2, 0), jnp.moveaxis(n_loc, 2, 0), jnp.moveaxis(a_max, 2, 0), jnp.moveaxis(b_last, 2, 0))
    _, (c0, n0, m0) = lax.scan(step, init, xs)
    c0, n0, m0 = jnp.moveaxis(c0, 0, 2), jnp.moveaxis(n0, 0, 2), jnp.moveaxis(m0, 0, 2)

    idx = jnp.arange(M_CHUNK)
    causal = idx[:, None] >= idx[None, :]
    dmat = jnp.where(causal, b[..., :, None] - b[..., None, :] + lic[..., None, :], NEG)
    inter = b + m0[..., None]
    m_t = jnp.maximum(dmat.max(-1), inter)
    s = jnp.einsum('bhnik,bhnjk->bhnij', qc, kc) * jnp.exp(dmat - m_t[..., None])
    s_inter = jnp.exp(inter - m_t)
    num = jnp.einsum('bhnij,bhnjv->bhniv', s, vc) + s_inter[..., None] * jnp.einsum('bhnik,bhnkv->bhniv', qc, c0)
    den = s.sum(-1) + s_inter * jnp.einsum('bhnik,bhnk->bhni', qc, n0)
    h = num / jnp.maximum(jnp.abs(den), jnp.exp(-m_t))[..., None]
    h = h.transpose(0, 2, 3, 1, 4).reshape(bsz, n_c * M_CHUNK, n_h, dv)
    return h[:, pad:]


def mlstm_mixer(x, w_in, b_gate, ln_h, w_out):
    bsz, length, _ = x.shape
    proj = x @ w_in
    o1 = M_HEADS * M_QK
    o2 = 2 * o1
    o3 = o2 + M_HEADS * M_V
    o4 = o3 + D_MODEL
    q = proj[..., :o1].reshape(bsz, length, M_HEADS, M_QK)
    k = proj[..., o1:o2].reshape(bsz, length, M_HEADS, M_QK)
    v = proj[..., o2:o3].reshape(bsz, length, M_HEADS, M_V)
    og = proj[..., o3:o4]
    gates = proj[..., o4:] + b_gate
    hm = mlstm_chunkwise(q, k, v, gates[..., :M_HEADS], gates[..., M_HEADS:])
    mu = hm.mean(-1, keepdims=True)
    var = jnp.square(hm - mu).mean(-1, keepdims=True)
    hn = (hm - mu) * lax.rsqrt(var + LN_EPS) * ln_h.astype(jnp.float32).reshape(M_HEADS, M_V)
    out = (hn.reshape(bsz, length, M_HEADS * M_V) * jax.nn.sigmoid(og.astype(jnp.float32))).astype(x.dtype)
    return out @ w_out


def shared_kv(h, w_kv, cos, sin):
    bsz, length, _ = h.shape
    kv = h @ w_kv
    k = kv[..., :A_KV * A_HD].reshape(bsz, length, A_KV, A_HD)
    v = kv[..., A_KV * A_HD:].reshape(bsz, length, A_KV, A_HD)
    return partial_rope(k, cos, sin), v


def swa_mixer(x, k, v, w_q, sinks, w_o, cos, sin):
    bsz, length, _ = x.shape
    n_real = length - N_META
    n_blk = n_real // WINDOW
    f32 = jnp.float32
    scale = A_HD ** -0.5
    q = partial_rope((x @ w_q).reshape(bsz, length, A_HEADS, A_HD), cos, sin)
    q = q.reshape(bsz, length, A_KV, A_GROUP, A_HD)
    sink = sinks.astype(f32).reshape(A_KV, A_GROUP)[:, :, None]
    qm, qr = q[:, :N_META], q[:, N_META:]
    km, kr = k[:, :N_META], k[:, N_META:]
    vm, vr = v[:, :N_META].astype(f32), v[:, N_META:]

    s_mm = jnp.einsum('bqhgd,bkhd->bhgqk', qm, km).astype(f32) * scale
    s_mm = jnp.where(jnp.tril(jnp.ones((N_META, N_META), bool)), s_mm, NEG)
    m_mm = jnp.maximum(s_mm.max(-1), sink)
    p_mm = jnp.exp(s_mm - m_mm[..., None])
    den_mm = p_mm.sum(-1) + jnp.exp(sink - m_mm)
    o_m = jnp.einsum('bhgqk,bkhd->bqhgd', p_mm / den_mm[..., None], vm)

    qb = qr.reshape(bsz, n_blk, WINDOW, A_KV, A_GROUP, A_HD)
    kb = kr.reshape(bsz, n_blk, WINDOW, A_KV, A_HD)
    vb = vr.reshape(bsz, n_blk, WINDOW, A_KV, A_HD)

    def with_prev(t):
        prev = jnp.pad(t, ((0, 0), (1, 0), (0, 0), (0, 0), (0, 0)))[:, :-1]
        return jnp.concatenate([prev, t], axis=2)

    k_band, v_band = with_prev(kb), with_prev(vb).astype(f32)
    s_band = jnp.einsum('bnqhgd,bnkhd->bnhgqk', qb, k_band).astype(f32) * scale
    s_meta = jnp.einsum('bnqhgd,bkhd->bnhgqk', qb, km).astype(f32) * scale
    qi = jnp.arange(WINDOW)[:, None]
    kj = jnp.arange(2 * WINDOW)[None, :]
    rel = qi + WINDOW - kj
    in_band = (rel >= 0) & (rel < WINDOW)
    blk_ok = (jnp.arange(n_blk)[:, None, None] > 0) | (kj >= WINDOW)[None]
    mask = in_band[None] & blk_ok
    s_band = jnp.where(mask[None, :, None, None], s_band, NEG)
    m = jnp.maximum(jnp.maximum(s_band.max(-1), s_meta.max(-1)), sink)
    p_band = jnp.exp(s_band - m[..., None])
    p_meta = jnp.exp(s_meta - m[..., None])
    inv_den = 1.0 / (p_band.sum(-1) + p_meta.sum(-1) + jnp.exp(sink - m))
    o_r = (jnp.einsum('bnhgqk,bnkhd->bnhgqd', p_band, v_band)
           + jnp.einsum('bnhgqk,bkhd->bnhgqd', p_meta, vm)) * inv_den[..., None]
    o_r = o_r.transpose(0, 1, 4, 2, 3, 5).reshape(bsz, n_real, A_HEADS * A_HD)
    o = jnp.concatenate([o_m.reshape(bsz, N_META, A_HEADS * A_HD), o_r], axis=1).astype(x.dtype)
    return o @ w_o


def swiglu(x, w_gu, w_down):
    gu = x @ w_gu
    return (jax.nn.silu(gu[..., :D_FF]) * gu[..., D_FF:]) @ w_down


def moe_swiglu(x, w_router, b_router, w_gu, w_down):
    bsz, length, d = x.shape
    n_tok = bsz * length
    f32 = jnp.float32
    xt = x.reshape(n_tok, d)
    logits = (xt @ w_router).astype(f32) + b_router.astype(f32)
    top_val, top_idx = lax.top_k(logits, TOP_K)
    gate = jax.nn.softmax(top_val, axis=-1)
    n_assign = n_tok * TOP_K
    flat_e = top_idx.reshape(-1)
    flat_tok = jnp.repeat(jnp.arange(n_tok, dtype=jnp.int32), TOP_K)
    flat_gate = gate.reshape(-1)
    order = jnp.argsort(flat_e)
    e_sorted = flat_e[order]
    counts = jnp.bincount(flat_e, length=N_EXP)
    padded = (counts + MOE_BLOCK - 1) // MOE_BLOCK * MOE_BLOCK
    start = jnp.cumsum(counts) - counts
    pad_end = jnp.cumsum(padded)
    pad_start = pad_end - padded
    dest = pad_start[e_sorted] + jnp.arange(n_assign) - start[e_sorted]
    n_rows = -(-n_assign // MOE_BLOCK) * MOE_BLOCK + N_EXP * MOE_BLOCK
    n_blocks = n_rows // MOE_BLOCK
    row_tok = jnp.zeros((n_rows,), jnp.int32).at[dest].set(flat_tok[order])
    row_gate = jnp.zeros((n_rows,), f32).at[dest].set(flat_gate[order])
    blk_exp = jnp.minimum(jnp.searchsorted(pad_end, jnp.arange(n_blocks) * MOE_BLOCK, side='right'), N_EXP - 1)
    xs = xt[row_tok].reshape(n_blocks, MOE_BLOCK, d)

    def expert_block(args):
        xb, e = args
        gu = xb @ w_gu[e]
        return (jax.nn.silu(gu[:, :D_FF_EXP]) * gu[:, D_FF_EXP:]) @ w_down[e]

    ys = lax.map(expert_block, (xs, blk_exp)).reshape(n_rows, d)
    out = jax.ops.segment_sum(ys * row_gate[:, None].astype(ys.dtype), row_tok, num_segments=n_tok)
    return out.reshape(bsz, length, d).astype(x.dtype)


def setup_inputs(seed: int = 0) -> dict:
    key = jax.random.key(seed)
    ks = jax.random.split(key, 24)
    f32 = jnp.float32

    def nrm(k, shape):
        return jax.random.normal(k, shape, f32)

    def dense(k, shape, fan_in, gain=1.0):
        return nrm(k, shape) * (gain * fan_in ** -0.5)

    return {
        "x": nrm(ks[0], (BATCH, SEQ, D_MODEL)),
        "meta": nrm(ks[1], (N_META, D_MODEL)),
        "w_in_a": dense(ks[2], (N_A, D_MODEL, M_IN), D_MODEL),
        "b_gate_a": jnp.concatenate([0.1 * nrm(ks[3], (N_A, M_HEADS)),
                                      3.0 + 0.5 * nrm(ks[4], (N_A, M_HEADS))], axis=-1),
        "ln_h_a": 1.0 + 0.02 * nrm(ks[5], (N_A, M_HEADS * M_V)),
        "w_out_a": dense(ks[6], (N_A, M_HEADS * M_V, D_MODEL), M_HEADS * M_V, BETA),
        "w_kv": dense(ks[7], (D_MODEL, 2 * A_KV * A_HD), D_MODEL),
        "w_q_b": dense(ks[8], (N_B, D_MODEL, A_HEADS * A_HD), D_MODEL),
        "sinks_b": 0.5 * nrm(ks[9], (N_B, A_HEADS)),
        "w_o_b": dense(ks[10], (N_B, A_HEADS * A_HD, D_MODEL), A_HEADS * A_HD, BETA),
        "w_gu_d": dense(ks[11], (N_DENSE, D_MODEL, 2 * D_FF), D_MODEL),
        "w_down_d": dense(ks[12], (N_DENSE, D_FF, D_MODEL), D_FF, BETA),
        "w_router": dense(ks[13], (N_MOE, D_MODEL, N_EXP), D_MODEL),
        "b_router": 0.01 * nrm(ks[14], (N_MOE, N_EXP)),
        "w_gu_e": dense(ks[15], (N_MOE, N_EXP, D_MODEL, 2 * D_FF_EXP), D_MODEL),
        "w_down_e": dense(ks[16], (N_MOE, N_EXP, D_FF_EXP, D_MODEL), D_FF_EXP, BETA),
        "ln_g": 1.0 + 0.02 * nrm(ks[17], (DEPTH, 2, D_MODEL)),
        "ln_b": 0.02 * nrm(ks[18], (DEPTH, 2, D_MODEL)),
    }


def reference(x, meta, w_in_a, b_gate_a, ln_h_a, w_out_a, w_kv, w_q_b, sinks_b, w_o_b,
              w_gu_d, w_down_d, w_router, b_router, w_gu_e, w_down_e, ln_g, ln_b):
    bsz = x.shape[0]
    h = jnp.concatenate([jnp.broadcast_to(meta.astype(x.dtype)[None], (bsz, N_META, D_MODEL)), x], axis=1)
    length = h.shape[1]
    cos, sin = rope_tables(length)
    k_sh, v_sh = None, None
    for layer in range(DEPTH):
        if layer < N_A:
            mix = mlstm_mixer(h, w_in_a[layer], b_gate_a[layer], ln_h_a[layer], w_out_a[layer])
        else:
            if layer == N_A:
                k_sh, v_sh = shared_kv(h, w_kv, cos, sin)
            j = layer - N_A
            mix = swa_mixer(h, k_sh, v_sh, w_q_b[j], sinks_b[j], w_o_b[j], cos, sin)
        h = layer_norm(ALPHA * h + mix, ln_g[layer, 0], ln_b[layer, 0])
        if layer % 2 == 0:
            ffn = swiglu(h, w_gu_d[layer // 2], w_down_d[layer // 2])
        else:
            e = layer // 2
            ffn = moe_swiglu(h, w_router[e], b_router[e], w_gu_e[e], w_down_e[e])
        h = layer_norm(ALPHA * h + ffn, ln_g[layer, 1], ln_b[layer, 1])
    return h[:, N_META:]
```

```cpp
#include <hip/hip_runtime.h>
#include <cstdio>
#include <cstdint>

#define LAS __attribute__((address_space(3)))
#define GAS __attribute__((address_space(1)))
typedef unsigned short bf16_t;
typedef short bf16x8 __attribute__((ext_vector_type(8)));
typedef float f32x4 __attribute__((ext_vector_type(4)));
typedef float f32x2 __attribute__((ext_vector_type(2)));
typedef unsigned u32x4 __attribute__((ext_vector_type(4)));
typedef unsigned u32x2 __attribute__((ext_vector_type(2)));

constexpr int D = 1024, NBATCH = 4, SEQ = 8192, NMETA = 16;
constexpr int MREAL = NBATCH * SEQ;
constexpr int MV = MREAL + NMETA;
constexpr int MP = 129 * 256;
constexpr int M_HEADS = 8, M_QK = 64, M_V = 128;
constexpr int M_IN = 3088, M_INP = 3328;
constexpr int PROJ_LD = 3072;
constexpr int A_HEADS = 16, A_KV = 4, A_HD = 64, WINDOW = 128;
constexpr int D_FF = 2816, N_EXP = 8, D_FF_EXP = 3584;
constexpr float ALPHA = 1.681792830507429f;
constexpr float LN_EPS = 1e-5f;
constexpr int RP = 265 * 256;
constexpr int NSEG = 8, SEG_CHUNKS = 16;
constexpr int ST_FLOATS = 8 * 5 * 64 * 4;

constexpr size_t MiB = 1u << 20;
constexpr size_t al(size_t x) { return (x + 4095) & ~(size_t)4095; }
constexpr size_t WS_CTL = 0, CTL_BYTES = 1 * MiB;
constexpr size_t WS_WIN = WS_CTL + CTL_BYTES;
constexpr size_t WS_WOUT = WS_WIN + al((size_t)2 * M_INP * D * 2);
constexpr size_t WS_WQKV = WS_WOUT + al((size_t)2 * D * D * 2);
constexpr size_t WS_WQ3 = WS_WQKV + al((size_t)1536 * D * 2);
constexpr size_t WS_WO = WS_WQ3 + al((size_t)D * D * 2);
constexpr size_t WS_WGU = WS_WO + al((size_t)2 * D * D * 2);
constexpr size_t WS_WDN = WS_WGU + al((size_t)2 * 2 * D_FF * D * 2);
constexpr size_t WS_WGUE = WS_WDN + al((size_t)2 * D * D_FF * 2);
constexpr size_t WS_WDNE = WS_WGUE + al((size_t)16 * 2 * D_FF_EXP * D * 2);
constexpr size_t WS_H = WS_WDNE + al((size_t)16 * D * D_FF_EXP * 2);
constexpr size_t WS_HB = WS_H + al((size_t)MP * D * 4);
constexpr size_t WS_PROJ = WS_HB + al((size_t)MP * D * 2);
constexpr size_t WS_HG = WS_PROJ + (size_t)MP * PROJ_LD * 2;
constexpr size_t WS_CONTRIB = WS_PROJ;
constexpr size_t WS_KB = WS_HG + al((size_t)MP * D * 2);
constexpr size_t WS_VB = WS_KB + al((size_t)MP * 256 * 2);
constexpr size_t WS_GATES = WS_VB + al((size_t)MP * 256 * 2);
constexpr size_t WS_ACT = WS_GATES + al((size_t)MP * 16 * 4);
constexpr size_t WS_STATE = WS_ACT + al((size_t)RP * D_FF_EXP * 2);
constexpr size_t WS_STSC = WS_STATE + al((size_t)32 * 7 * ST_FLOATS * 4);
constexpr size_t WS_ROPE = WS_STSC + al((size_t)32 * 7 * 4 * 4);
constexpr size_t WS_TOPE = WS_ROPE + al((size_t)8208 * 16 * 4);
constexpr size_t WS_TOPG = WS_TOPE + al((size_t)MP * 4);
constexpr size_t WS_ROWTOK = WS_TOPG + al((size_t)MP * 8);
constexpr size_t WS_ROWDST = WS_ROWTOK + al((size_t)RP * 4);
constexpr size_t WS_ROWGATE = WS_ROWDST + al((size_t)RP * 4);
constexpr size_t WS_SMALL = WS_ROWGATE + al((size_t)RP * 4);
constexpr int SM_BGATE = 0, SM_SINKS = 32, SM_BROUTER = 64, SM_LNH = 128, SM_LNG = SM_LNH + 2 * D, SM_LNB = SM_LNG + 8 * D, SM_WROUTER = SM_LNB + 8 * D, SM_END = SM_WROUTER + 2 * D * N_EXP;
constexpr size_t WS_END = WS_SMALL + al((size_t)SM_END * 4);
static_assert((size_t)MP * 2 * D * 4 <= (WS_KB - WS_PROJ), "contrib overlay fits PROJ+HG");

constexpr int CW_CNT = 1024;
constexpr int CW_CUR = 1024 + 256;
constexpr int CW_BAR = 16384;

constexpr int LDS_BYTES = 163840 - 512;
constexpr int RING_BYTES = 131072;
constexpr int MISC_OFF = LDS_BYTES - 256;

__device__ __forceinline__ unsigned f2bf(float f) { unsigned u = __builtin_bit_cast(unsigned, f); return (u + 0x7fffu + ((u >> 16) & 1u)) >> 16; }
__device__ __forceinline__ unsigned pk2(float lo, float hi) { return f2bf(lo) | (f2bf(hi) << 16); }
__device__ __forceinline__ unsigned cvt_pk_bf16(float lo, float hi) { unsigned r; asm volatile("v_cvt_pk_bf16_f32 %0, %1, %2" : "=v"(r) : "v"(lo), "v"(hi)); return r; }
__device__ __forceinline__ float bf2f(unsigned short b) { return __builtin_bit_cast(float, ((unsigned)b) << 16); }
__device__ __forceinline__ float wave_sum(float v) {
#pragma unroll
    for (int o = 1; o < 64; o <<= 1) v += __shfl_xor(v, o);
    return v;
}
__device__ __forceinline__ float fast_exp(float x) { return __builtin_amdgcn_exp2f(x * 1.4426950408889634f); }
#define LDS_WAIT() asm volatile("s_waitcnt lgkmcnt(0)" ::: "memory")
#define VM_WAIT() asm volatile("s_waitcnt vmcnt(0)" ::: "memory")

#define XB_TMO      128
#define XB_XCNT(j)  (256  + 64 * (j))
#define XB_XSUB(j)  (1280 + 64 * (j))
#define XB_XGEN(j)  (2304 + 64 * (j))
#define XB_TOP      3328
#define XB_TOPGEN   3392
#define XCD_BAR_WORDS 3456
#define XB_SPIN_CAP (1u << 18)
__device__ __forceinline__ unsigned xb_ld(unsigned* p)              { return __hip_atomic_load(p, __ATOMIC_RELAXED, __HIP_MEMORY_SCOPE_AGENT); }
__device__ __forceinline__ unsigned xb_add(unsigned* p, unsigned v) { return __hip_atomic_fetch_add(p, v, __ATOMIC_RELAXED, __HIP_MEMORY_SCOPE_AGENT); }
__device__ __forceinline__ unsigned xb_xcc_id() { return (unsigned)__builtin_amdgcn_s_getreg((3 << 11) | 20) & 0xFu; }
#define XB_SPIN(cond, bar) do { unsigned _sp = 0; while (cond) { __builtin_amdgcn_s_sleep(1); \
    if ((++_sp & 255u) == 0u) { if (xb_ld(&(bar)[XB_TMO])) break; if (_sp > XB_SPIN_CAP) { atomicAdd(&(bar)[XB_TMO], 1u); break; } } } } while (0)
struct XcdBarrier { unsigned* bar; unsigned x; volatile LAS unsigned* st; };
__device__ __forceinline__ XcdBarrier xcd_barrier_post(unsigned* bar, volatile LAS unsigned* st) {
    XcdBarrier b; b.bar = bar; b.x = xb_xcc_id(); b.st = st;
    if (threadIdx.x == 0) (void)xb_add(&bar[XB_XCNT(b.x)], 1u);
    return b;
}
__device__ __forceinline__ void xcd_barrier_complete(unsigned* bar, unsigned x, unsigned& nloc, unsigned& nx) {
    const unsigned G = gridDim.x * gridDim.y * gridDim.z;
    unsigned sum, cnt, mine, sp = 0u;
    for (;;) {
        sum = 0u; cnt = 0u; mine = 0u;
#pragma unroll
        for (unsigned j = 0; j < 16; ++j) { const unsigned c = xb_ld(&bar[XB_XCNT(j)]); sum += c; cnt += (c > 0u) ? 1u : 0u; mine = (j == x) ? c : mine; }
        if (sum == G) break;
        __builtin_amdgcn_s_sleep(1);
        if ((++sp & 255u) == 0u) { if (xb_ld(&bar[XB_TMO])) break; if (sp > XB_SPIN_CAP) { atomicAdd(&bar[XB_TMO], 1u); break; } }
    }
    nloc = mine > 0u ? mine : 1u; nx = cnt > 0u ? cnt : 1u;
}
__device__ __forceinline__ void xcd_barrier(const XcdBarrier& b) {
    asm volatile("s_waitcnt vmcnt(0)" ::: "memory");
    __syncthreads();
    if (threadIdx.x == 0) {
        unsigned* bar = b.bar;
        __builtin_amdgcn_s_waitcnt(0);
        unsigned nloc = b.st[0], nx = b.st[1];
        if (nloc == 0u) { xcd_barrier_complete(bar, b.x, nloc, nx); b.st[0] = nloc; b.st[1] = nx; }
        const unsigned old = xb_add(&bar[XB_XSUB(b.x)], 1u);
        const unsigned gen = old / nloc;
        if (old + 1u == (gen + 1u) * nloc) {
            __builtin_amdgcn_fence(__ATOMIC_RELEASE, "agent");
            asm volatile("s_waitcnt vmcnt(0)" ::: "memory");
            const unsigned og = xb_add(&bar[XB_TOP], 1u);
            const unsigned tg = og / nx;
            if (og + 1u == (tg + 1u) * nx) xb_add(&bar[XB_TOPGEN], 1u);
            else XB_SPIN(xb_ld(&bar[XB_TOPGEN]) == tg, bar);
            __builtin_amdgcn_fence(__ATOMIC_ACQUIRE, "agent");
            xb_add(&bar[XB_XGEN(b.x)], 1u);
            asm volatile("s_waitcnt vmcnt(0)" ::: "memory");
        } else {
            XB_SPIN(xb_ld(&bar[XB_XGEN(b.x)]) == gen, bar);
            __builtin_amdgcn_fence(__ATOMIC_ACQUIRE, "agent");
            asm volatile("s_waitcnt vmcnt(0)" ::: "memory");
        }
    }
    __syncthreads();
}

namespace pg8 {
constexpr int BM = 256, BK = 64, HALF = 128, HTB = HALF * BK * 2, STAGE_BYTES = 8 * HTB, NXCD = 8, WGM = 8;
__host__ __device__ __forceinline__ int lds_byte(int r, int c) { const int st = (r >> 4) * 2 + (c >> 5), rr = r & 15, cc = c & 31, ob = rr * 64 + cc * 2; return st * 1024 + (ob ^ (((ob >> 9) & 1) << 5)); }
__host__ __device__ __forceinline__ void stage_rc(int b, int& R, int& C) { const int st = b / 1024, sb = b % 1024, swz = sb ^ (((sb >> 9) & 1) << 5); R = (st >> 1) * 16 + swz / 64; C = (st & 1) * 32 + (swz % 64) / 2; }
__host__ __device__ __forceinline__ int perm32(int rho) { const int n = rho >> 4, i = rho & 15; return 8 * (i >> 2) + 4 * n + (i & 3); }

struct Unit { int pm, pn, brow; };

struct DenseOrder {
    int nM, nN, nwg, G, c;
    __device__ void init(int nM_, int nN_, int G_, int c_) { nM = nM_; nN = nN_; nwg = nM * nN; G = G_; c = c_; }
    __device__ __forceinline__ bool next(int i, Unit& u) const {
        const long L = (long)i * G + c; if (L >= nwg) return false;
        int wgid = (int)L; { const int q = nwg / NXCD, r = nwg % NXCD, xcd = wgid % NXCD, off = wgid / NXCD; wgid = (xcd < r ? xcd * (q + 1) : r * (q + 1) + (xcd - r) * q) + off; }
        const int nig = WGM * nN, gid = wgid / nig, fm = gid * WGM, gsz = (nM - fm) < WGM ? (nM - fm) : WGM;
        u.pm = fm + ((wgid % nig) % gsz); u.pn = (wgid % nig) / gsz; u.brow = u.pn * BM; return true;
    }
    __device__ __forceinline__ int a_row(const Unit& u, int r) const { return u.pm * BM + r; }
};
struct GroupedOrder {
    DenseOrder o; int pstart[9]; int nexp_rows;
    const int* rowtok;
    __device__ __forceinline__ bool next(int i, Unit& u) const {
        if (!o.next(i, u)) return false;
        int e = 0;
#pragma unroll
        for (int k = 1; k < 8; ++k) e += (u.pm >= pstart[k]) ? 1 : 0;
        u.brow = e * nexp_rows + u.pn * BM; return true;
    }
    __device__ __forceinline__ int a_row(const Unit& u, int r) const {
        const int pos = u.pm * BM + r; if (!rowtok) return pos;
        const int t = rowtok[pos]; return t < 0 ? 0 : t;
    }
};

template <class Epi, class Sched>
__device__ __forceinline__ void gemm_phase(LAS unsigned char* lds, const bf16_t* Abase, const bf16_t* Btbase, const int K, const Sched& S, const Epi& E) {
    int tid = threadIdx.x; asm volatile("; opaque tid" : "+v"(tid));
    const int wid = __builtin_amdgcn_readfirstlane(tid >> 6), lane = tid & 63, wr = wid >> 2, wc = wid & 3, fr = lane & 15, fq = lane >> 4;
    const int nt = K / BK;
    unsigned voffB[2];
#pragma unroll
    for (int i = 0; i < 2; ++i) { int R, C; stage_rc(tid * 16 + i * 8192, R, C); const int Rb = Epi::PERM ? ((R & ~31) + perm32(R & 31)) : R; voffB[i] = (unsigned)(Rb * K + C) * 2u; }
    const size_t kstep = (size_t)(BK * 2);
    const size_t hstep = (size_t)HALF * K * 2;
    const unsigned ldsw = (unsigned)wid * 1024u;
    const int aoff = lds_byte(wr * 64 + fr, fq * 8), boff = lds_byte(wc * 32 + fr, fq * 8);
#define PG8_SA(b, h) (((b) * 2 + (h)) * HTB)
#define PG8_SB(b, h) ((4 + (b) * 2 + (h)) * HTB)
#define PG8_STAGE(bufoff, gbase, voff) do { _Pragma("unroll") for (int _i = 0; _i < 2; ++_i) \
        __builtin_amdgcn_global_load_lds((const unsigned*)((const char*)(gbase) + (voff)[_i]), (LAS unsigned*)(lds + (bufoff) + ldsw + _i * 8192), 16, 0, 0); } while (0)
#define PG8_LDA(dst, b, h) do { _Pragma("unroll") for (int m = 0; m < 4; ++m) _Pragma("unroll") for (int k = 0; k < 2; ++k) dst[m][k] = *(const LAS bf16x8*)(lds + PG8_SA(b, h) + aoff + m * 2048 + k * 1024); } while (0)
#define PG8_LDB(dst, b, h) do { _Pragma("unroll") for (int n = 0; n < 2; ++n) _Pragma("unroll") for (int k = 0; k < 2; ++k) dst[n][k] = *(const LAS bf16x8*)(lds + PG8_SB(b, h) + boff + n * 2048 + k * 1024); } while (0)
#define PG8_MMA(ai, bj, At, Bt) do { __builtin_amdgcn_s_setprio(1); _Pragma("unroll") for (int m = 0; m < 4; ++m) _Pragma("unroll") for (int n = 0; n < 2; ++n) _Pragma("unroll") for (int k = 0; k < 2; ++k) \
        acc[ai][bj][m][n] = __builtin_amdgcn_mfma_f32_16x16x32_bf16(Bt[n][k], At[m][k], acc[ai][bj][m][n], 0, 0, 0); __builtin_amdgcn_s_setprio(0); } while (0)
#define PG8_WAIT_V(n) asm volatile("s_waitcnt vmcnt(" #n ")" ::: "memory")
#define PG8_WAIT_L(n) asm volatile("s_waitcnt lgkmcnt(" #n ")" ::: "memory")
#define PG8_BAR __builtin_amdgcn_s_barrier()
#define PG8_SCHED __builtin_amdgcn_sched_barrier(0)
#define PG8_AOFF(dst, u) do { _Pragma("unroll") for (int _i = 0; _i < 2; ++_i) { int _R, _C; stage_rc(tid * 16 + _i * 8192, _R, _C); _Pragma("unroll") for (int _h = 0; _h < 2; ++_h) \
        dst[_h][_i] = (unsigned)(((size_t)S.a_row(u, _h * HALF + _R) * K + _C) * 2u); } } while (0)
    Unit cur, nxt; int ui = 0;
    if (!S.next(0, cur)) return;
    f32x4 acc[2][2][4][2];
#pragma unroll
    for (int a = 0; a < 2; ++a)
#pragma unroll
        for (int b = 0; b < 2; ++b)
#pragma unroll
            for (int m = 0; m < 4; ++m)
#pragma unroll
                for (int n = 0; n < 2; ++n) acc[a][b][m][n] = (f32x4){0.f, 0.f, 0.f, 0.f};
    bf16x8 At[4][2], B0[2][2], B1[2][2];
    unsigned cao[2][2];
    PG8_AOFF(cao, cur);
    const char* cA = (const char*)Abase; const char* cB = (const char*)Btbase + (size_t)cur.brow * K * 2;
    PG8_STAGE(PG8_SB(0, 0), cB, voffB); PG8_STAGE(PG8_SB(0, 1), cB + hstep, voffB); PG8_STAGE(PG8_SA(0, 0), cA, cao[0]); PG8_STAGE(PG8_SA(0, 1), cA, cao[1]);
    if (wr == 1) PG8_BAR;
    PG8_WAIT_V(2); PG8_BAR;
    PG8_STAGE(PG8_SB(1, 0), cB + kstep, voffB); PG8_STAGE(PG8_SA(1, 0), cA + kstep, cao[0]); PG8_STAGE(PG8_SB(1, 1), cB + hstep + kstep, voffB);
    PG8_WAIT_V(6); PG8_BAR;
    for (;;) {
        const bool has_next = S.next(ui + 1, nxt);
        const char* nB = has_next ? (const char*)Btbase + (size_t)nxt.brow * K * 2 : cB;
        for (int t = 0; t < nt; t += 2) {
            const bool last = (t == nt - 2);
            const char* a1 = cA + (size_t)(t + 1) * kstep;
            const char* a2 = last ? cA : cA + (size_t)(t + 2) * kstep; const char* b2 = last ? nB : cB + (size_t)(t + 2) * kstep;
            const char* a3 = a2 + kstep; const char* b3 = b2 + kstep;
            PG8_LDB(B0, 0, 0); PG8_LDB(B1, 0, 1); PG8_SCHED; PG8_LDA(At, 0, 0); PG8_STAGE(PG8_SA(1, 1), a1, cao[1]);
            if (last && has_next) { PG8_AOFF(cao, nxt); }
            PG8_WAIT_V(8); PG8_WAIT_L(0); PG8_BAR; PG8_MMA(0, 0, At, B0); PG8_MMA(0, 1, At, B1); PG8_BAR; PG8_SCHED;
            PG8_LDA(At, 0, 1); PG8_STAGE(PG8_SB(0, 0), b2, voffB); PG8_STAGE(PG8_SB(0, 1), b2 + hstep, voffB); PG8_STAGE(PG8_SA(0, 0), a2, cao[0]);
            PG8_WAIT_V(8); PG8_WAIT_L(0); PG8_BAR; PG8_MMA(1, 0, At, B0); PG8_MMA(1, 1, At, B1); PG8_BAR; PG8_SCHED;
            PG8_LDB(B0, 1, 0); PG8_LDB(B1, 1, 1); PG8_SCHED; PG8_LDA(At, 1, 0); PG8_STAGE(PG8_SA(0, 1), a2, cao[1]);
            PG8_WAIT_V(8); PG8_WAIT_L(0); PG8_BAR; PG8_MMA(0, 0, At, B0); PG8_MMA(0, 1, At, B1); PG8_BAR; PG8_SCHED;
            PG8_LDA(At, 1, 1); PG8_STAGE(PG8_SB(1, 0), b3, voffB); PG8_STAGE(PG8_SB(1, 1), b3 + hstep, voffB); PG8_STAGE(PG8_SA(1, 0), a3, cao[0]);
            PG8_WAIT_V(8); PG8_WAIT_L(0); PG8_BAR; PG8_MMA(1, 0, At, B0); PG8_MMA(1, 1, At, B1); PG8_BAR; PG8_SCHED;
        }
        if (wr == 0) PG8_BAR;
        E(acc, cur, wr, wc, fr, fq);
        if (!has_next) break;
#pragma unroll
        for (int a = 0; a < 2; ++a)
#pragma unroll
            for (int b = 0; b < 2; ++b)
#pragma unroll
                for (int m = 0; m < 4; ++m)
#pragma unroll
                    for (int n = 0; n < 2; ++n) acc[a][b][m][n] = (f32x4){0.f, 0.f, 0.f, 0.f};
        cur = nxt; cB = nB; ++ui;
        if (wr == 1) PG8_BAR;
    }
    PG8_WAIT_V(0);
    PG8_BAR;
#undef PG8_SA
#undef PG8_SB
#undef PG8_STAGE
#undef PG8_LDA
#undef PG8_LDB
#undef PG8_MMA
#undef PG8_WAIT_V
#undef PG8_WAIT_L
#undef PG8_BAR
#undef PG8_SCHED
#undef PG8_AOFF
}
}

typedef f32x4 AccT[2][2][4][2];

struct EpiProj {
    static constexpr bool PERM = true;
    bf16_t* proj; float* gates; const float* bgate;
    __device__ __forceinline__ void operator()(const AccT& acc, const pg8::Unit& u, int wr, int wc, int fr, int fq) const {
        const int row0 = u.pm * 256 + wr * 64 + fr;
        if (u.pn < 12) {
            const int col0 = u.pn * 256 + wc * 32 + 8 * fq;
#pragma unroll
            for (int ai = 0; ai < 2; ++ai)
#pragma unroll
                for (int m = 0; m < 4; ++m) { bf16_t* rowp = proj + (size_t)(row0 + ai * 128 + m * 16) * PROJ_LD + col0;
#pragma unroll
                    for (int bj = 0; bj < 2; ++bj) { const f32x4 v0 = acc[ai][bj][m][0], v1 = acc[ai][bj][m][1];
                        u32x4 w; w.x = cvt_pk_bf16(v0[0], v0[1]); w.y = cvt_pk_bf16(v0[2], v0[3]); w.z = cvt_pk_bf16(v1[0], v1[1]); w.w = cvt_pk_bf16(v1[2], v1[3]);
                        *(u32x4*)(rowp + bj * 128) = w; } }
        } else if (wc == 0 && fq < 2) {
#pragma unroll
            for (int n = 0; n < 2; ++n) { const f32x4 bv = *(const f32x4*)(bgate + 8 * fq + 4 * n);
#pragma unroll
                for (int ai = 0; ai < 2; ++ai)
#pragma unroll
                    for (int m = 0; m < 4; ++m) *(f32x4*)(gates + (size_t)(row0 + ai * 128 + m * 16) * 16 + 8 * fq + 4 * n) = acc[ai][0][m][n] + bv; }
        }
    }
};
struct EpiRes {
    static constexpr bool PERM = false;
    float* H;
    __device__ __forceinline__ void operator()(const AccT& acc, const pg8::Unit& u, int wr, int wc, int fr, int fq) const {
        const int row0 = u.pm * 256 + wr * 64 + fr, col0 = u.pn * 256 + wc * 32 + 4 * fq;
#pragma unroll
        for (int ai = 0; ai < 2; ++ai)
#pragma unroll
            for (int m = 0; m < 4; ++m) { float* rowp = H + (size_t)(row0 + ai * 128 + m * 16) * D + col0;
#pragma unroll
                for (int bj = 0; bj < 2; ++bj)
#pragma unroll
                    for (int n = 0; n < 2; ++n) { float* p = rowp + bj * 128 + n * 16; const f32x4 h = *(const f32x4*)p; *(f32x4*)p = h * ALPHA + acc[ai][bj][m][n]; } }
    }
};
struct EpiSwiglu {
    static constexpr bool PERM = true;
    bf16_t* act; int ld;
    __device__ __forceinline__ static float silu_mul(float g, float u) { return g * u * __builtin_amdgcn_rcpf(1.0f + __builtin_amdgcn_exp2f(-g * 1.4426950408889634f)); }
    __device__ __forceinline__ void operator()(const AccT& acc, const pg8::Unit& u, int wr, int wc, int fr, int fq) const {
        const int row0 = u.pm * 256 + wr * 64 + fr, col0 = u.pn * 128 + wc * 32 + 8 * fq;
#pragma unroll
        for (int ai = 0; ai < 2; ++ai)
#pragma unroll
            for (int m = 0; m < 4; ++m) { const f32x4 g0 = acc[ai][0][m][0], g1 = acc[ai][0][m][1], u0 = acc[ai][1][m][0], u1 = acc[ai][1][m][1];
                u32x4 w; w.x = cvt_pk_bf16(silu_mul(g0[0], u0[0]), silu_mul(g0[1], u0[1])); w.y = cvt_pk_bf16(silu_mul(g0[2], u0[2]), silu_mul(g0[3], u0[3]));
                w.z = cvt_pk_bf16(silu_mul(g1[0], u1[0]), silu_mul(g1[1], u1[1])); w.w = cvt_pk_bf16(silu_mul(g1[2], u1[2]), silu_mul(g1[3], u1[3]));
                *(u32x4*)(act + (size_t)(row0 + ai * 128 + m * 16) * ld + col0) = w; }
    }
};
struct EpiScatter {
    static constexpr bool PERM = false;
    float* contrib; const int* rowdst; const float* rowgate;
    __device__ __forceinline__ void operator()(const AccT& acc, const pg8::Unit& u, int wr, int wc, int fr, int fq) const {
        const int row0 = u.pm * 256 + wr * 64 + fr, col0 = u.pn * 256 + wc * 32 + 4 * fq;
#pragma unroll
        for (int ai = 0; ai < 2; ++ai)
#pragma unroll
            for (int m = 0; m < 4; ++m) { const int pos = row0 + ai * 128 + m * 16; const int d = rowdst[pos];
                if (d >= 0) { const float g = rowgate[pos]; float* rowp = contrib + (size_t)d * D + col0;
#pragma unroll
                    for (int bj = 0; bj < 2; ++bj)
#pragma unroll
                        for (int n = 0; n < 2; ++n) *(f32x4*)(rowp + bj * 128 + n * 16) = acc[ai][bj][m][n] * g; } }
    }
};
struct EpiQKV {
    static constexpr bool PERM = true;
    bf16_t *Q, *KB, *VB; const float* rope;
    __device__ __forceinline__ void operator()(const AccT& acc, const pg8::Unit& u, int wr, int wc, int fr, int fq) const {
        const int row0 = u.pm * 256 + wr * 64 + fr, cl = wc * 32 + 8 * fq;
        bf16_t* base; int ld;
        if (u.pn < 4) { base = Q + u.pn * 256 + cl; ld = D; } else if (u.pn == 4) { base = KB + cl; ld = 256; } else { base = VB + cl; ld = 256; }
        const bool dorope = (u.pn <= 4) && ((wc & 1) == 0);
#pragma unroll
        for (int ai = 0; ai < 2; ++ai)
#pragma unroll
            for (int m = 0; m < 4; ++m) { const int row = row0 + ai * 128 + m * 16;
                f32x4 v[2][2];
#pragma unroll
                for (int bj = 0; bj < 2; ++bj)
#pragma unroll
                    for (int n = 0; n < 2; ++n) v[bj][n] = acc[ai][bj][m][n];
                if (dorope) {
                    int pos = row < MREAL ? (row & (SEQ - 1)) + NMETA : row - MREAL; pos = pos > SEQ + NMETA - 1 ? SEQ + NMETA - 1 : pos;
                    const float* rp = rope + (size_t)pos * 16;
                    const f32x4 c0 = *(const f32x4*)rp, c1 = *(const f32x4*)(rp + 4), s0 = *(const f32x4*)(rp + 8), s1 = *(const f32x4*)(rp + 12);
#pragma unroll
                    for (int bj = 0; bj < 2; ++bj)
#pragma unroll
                        for (int n = 0; n < 2; ++n) { const f32x4 c = n ? c1 : c0, s = n ? s1 : s0; f32x4 o;
#pragma unroll
                            for (int j = 0; j < 4; ++j) { const float x = v[bj][n][j]; const float y = __shfl_xor(x, 16);
                                o[j] = fq == 0 ? x * c[j] - y * s[j] : (fq == 1 ? x * c[j] + y * s[j] : x); }
                            v[bj][n] = o; }
                }
#pragma unroll
                for (int bj = 0; bj < 2; ++bj) { const f32x4 v0 = v[bj][0], v1 = v[bj][1];
                    u32x4 w; w.x = cvt_pk_bf16(v0[0], v0[1]); w.y = cvt_pk_bf16(v0[2], v0[3]); w.z = cvt_pk_bf16(v1[0], v1[1]); w.w = cvt_pk_bf16(v1[2], v1[3]);
                    *(u32x4*)(base + (size_t)row * ld + bj * 128) = w; } }
    }
};

struct Params { const float* in[18]; float* out; unsigned char* ws; int ph_lo, ph_hi, li, pad; };
enum { I_X = 0, I_META, I_WIN, I_BGATE, I_LNH, I_WOUT, I_WKV, I_WQ, I_SINKS, I_WO, I_WGUD, I_WDND, I_WROUTER, I_BROUTER, I_WGUE, I_WDNE, I_LNG, I_LNB };
constexpr int NWAVES = 8, NTHREADS = 512;

__device__ __forceinline__ void tr_item(const float* W, int Nsrc, int K, bf16_t* WT, int k0, int n0, int drow0, float scale, int nvalid, LAS float* scr, int lane) {
#pragma unroll 8
    for (int i = 0; i < 32; ++i) { const int kk = 2 * i + (lane >> 5), n = lane & 31; scr[kk * 33 + n] = (n < nvalid) ? W[(size_t)(k0 + kk) * Nsrc + n0 + n] * scale : 0.f; }
    LDS_WAIT(); asm volatile("" ::: "memory");
    const int c = lane & 7;
#pragma unroll
    for (int j = 0; j < 4; ++j) { const int n = (lane >> 3) + 8 * j; const LAS float* s = scr + (8 * c) * 33 + n;
        u32x4 o; o.x = pk2(s[0 * 33], s[1 * 33]); o.y = pk2(s[2 * 33], s[3 * 33]); o.z = pk2(s[4 * 33], s[5 * 33]); o.w = pk2(s[6 * 33], s[7 * 33]);
        if (n < nvalid) *(u32x4*)(WT + (size_t)(drow0 + n) * K + k0 + 8 * c) = o; }
    LDS_WAIT(); asm volatile("" ::: "memory");
}
__device__ __forceinline__ int pair_row(int n, int FF) { const int up = n >= FF ? 1 : 0, j = n - up * FF; return 256 * (j >> 7) + 128 * up + (j & 127); }

__device__ __forceinline__ void p0_prologue(const Params& P, LAS unsigned char* lds, int gw, int NGW, int wave, int lane) {
    unsigned char* ws = P.ws;
    LAS float* scr = (LAS float*)(lds + wave * 16384);
    constexpr int IT0 = 16 * 97, IT1 = 16 * 32, IT2 = 16 * 16, IT5 = 16 * 176, IT6 = 44 * 32, IT7 = 16 * 224, IT8 = 56 * 32;
    constexpr int C0 = 2 * IT0, C1 = C0 + 2 * IT1, C2 = C1 + IT2, C3 = C2 + 2 * IT1, C4 = C3 + 2 * IT1, C5 = C4 + 2 * IT5, C6 = C5 + 2 * IT6, C7 = C6 + 16 * IT7, C8 = C7 + 16 * IT8;
    for (int it = gw; it < C8; it += NGW) {
        if (it < C0) { const int mi = it / IT0, r = it % IT0, kb = r / 97, nb = r % 97; const int n0 = nb * 32;
            tr_item(P.in[I_WIN] + (size_t)mi * D * M_IN, M_IN, D, (bf16_t*)(ws + WS_WIN) + (size_t)mi * M_INP * D, kb * 64, n0, n0, n0 < 512 ? 0.125f : 1.f, nb == 96 ? 16 : 32, scr, lane);
        } else if (it < C1) { const int q = it - C0, mi = q / IT1, r = q % IT1, kb = r / 32, nb = r % 32;
            tr_item(P.in[I_WOUT] + (size_t)mi * D * D, D, D, (bf16_t*)(ws + WS_WOUT) + (size_t)mi * D * D, kb * 64, nb * 32, nb * 32, 1.f, 32, scr, lane);
        } else if (it < C2) { const int r = it - C1, kb = r / 16, nb = r % 16;
            tr_item(P.in[I_WKV], 512, D, (bf16_t*)(ws + WS_WQKV), kb * 64, nb * 32, 1024 + nb * 32, 1.f, 32, scr, lane);
        } else if (it < C3) { const int q = it - C2, mi = q / IT1, r = q % IT1, kb = r / 32, nb = r % 32;
            tr_item(P.in[I_WQ] + (size_t)mi * D * D, D, D, (bf16_t*)(ws + (mi ? WS_WQ3 : WS_WQKV)), kb * 64, nb * 32, nb * 32, 0.125f, 32, scr, lane);
        } else if (it < C4) { const int q = it - C3, mi = q / IT1, r = q % IT1, kb = r / 32, nb = r % 32;
            tr_item(P.in[I_WO] + (size_t)mi * D * D, D, D, (bf16_t*)(ws + WS_WO) + (size_t)mi * D * D, kb * 64, nb * 32, nb * 32, 1.f, 32, scr, lane);
        } else if (it < C5) { const int q = it - C4, mi = q / IT5, r = q % IT5, kb = r / 176, nb = r % 176;
            tr_item(P.in[I_WGUD] + (size_t)mi * D * 2 * D_FF, 2 * D_FF, D, (bf16_t*)(ws + WS_WGU) + (size_t)mi * 2 * D_FF * D, kb * 64, nb * 32, pair_row(nb * 32, D_FF), 1.f, 32, scr, lane);
        } else if (it < C6) { const int q = it - C5, mi = q / IT6, r = q % IT6, kb = r / 32, nb = r % 32;
            tr_item(P.in[I_WDND] + (size_t)mi * D_FF * D, D, D_FF, (bf16_t*)(ws + WS_WDN) + (size_t)mi * D * D_FF, kb * 64, nb * 32, nb * 32, 1.f, 32, scr, lane);
        } else if (it < C7) { const int q = it - C6, mi = q / IT7, r = q % IT7, kb = r / 224, nb = r % 224;
            tr_item(P.in[I_WGUE] + (size_t)mi * D * 2 * D_FF_EXP, 2 * D_FF_EXP, D, (bf16_t*)(ws + WS_WGUE) + (size_t)mi * 2 * D_FF_EXP * D, kb * 64, nb * 32, pair_row(nb * 32, D_FF_EXP), 1.f, 32, scr, lane);
        } else { const int q = it - C7, mi = q / IT8, r = q % IT8, kb = r / 32, nb = r % 32;
            tr_item(P.in[I_WDNE] + (size_t)mi * D_FF_EXP * D, D, D_FF_EXP, (bf16_t*)(ws + WS_WDNE) + (size_t)mi * D * D_FF_EXP, kb * 64, nb * 32, nb * 32, 1.f, 32, scr, lane);
        }
    }
    { float* sm = (float*)(ws + WS_SMALL); const int gt = gw * 64 + lane, NT = NGW * 64;
      for (int i = gt; i < SM_END; i += NT) { float v = 0.f;
          if (i < SM_SINKS) v = P.in[I_BGATE][i]; else if (i < SM_BROUTER) v = P.in[I_SINKS][i - SM_SINKS]; else if (i < SM_BROUTER + 16) v = P.in[I_BROUTER][i - SM_BROUTER];
          else if (i < SM_LNH) v = 0.f; else if (i < SM_LNG) v = P.in[I_LNH][i - SM_LNH]; else if (i < SM_LNB) v = P.in[I_LNG][i - SM_LNG]; else if (i < SM_WROUTER) v = P.in[I_LNB][i - SM_LNB]; else v = P.in[I_WROUTER][i - SM_WROUTER];
          sm[i] = v; } }
    { float* H = (float*)(ws + WS_H); bf16_t* HB = (bf16_t*)(ws + WS_HB);
      const size_t gt = (size_t)gw * 64 + lane, NT = (size_t)NGW * 64;
      for (size_t i = gt; i < (size_t)MV * (D / 4); i += NT) { const size_t row = i >> 8; const int c4 = (int)(i & 255);
          const f32x4 v = row < MREAL ? ((const f32x4*)P.in[I_X])[i] : ((const f32x4*)P.in[I_META])[(row - MREAL) * 256 + c4];
          ((f32x4*)H)[i] = v; u32x2 w; w.x = pk2(v[0], v[1]); w.y = pk2(v[2], v[3]); ((u32x2*)HB)[i] = w; }
      float* rope = (float*)(ws + WS_ROPE);
      for (size_t i = gt; i < (size_t)(SEQ + NMETA) * 8; i += NT) { const int pos = (int)(i >> 3), fi = (int)(i & 7);
          const double invf = fi == 0 ? 1.0 : fi == 1 ? 0.19392274474868576 : fi == 2 ? 0.03760603093086393 : fi == 3 ? 0.007292664737217109 : fi == 4 ? 0.001414213562373095
                            : fi == 5 ? 0.0002742481756762073 : fi == 6 ? 5.318295896944988e-05 : 1.031338537721246e-05;
          const float angf = (float)pos * (float)invf;
          double a = (double)angf; a -= 6.283185307179586476925 * __builtin_rint(a * 0.15915494309189533577); const double hx = 0.5 * a, h2 = hx * hx;
          double sp = 1.0, cp = 1.0;
#pragma unroll
          for (int k = 12; k >= 1; --k) { sp = 1.0 - sp * h2 / (double)((2 * k) * (2 * k + 1)); cp = 1.0 - cp * h2 / (double)((2 * k - 1) * (2 * k)); }
          const double sh = hx * sp, ch = cp;
          rope[(size_t)pos * 16 + fi] = (float)(1.0 - 2.0 * sh * sh); rope[(size_t)pos * 16 + 8 + fi] = (float)(2.0 * sh * ch); }
    }
}

__device__ __forceinline__ void ln_phase(unsigned char* ws, float* outp, LAS unsigned char* lds, int gw, int NGW, int lane, int tid,
                                         int lnidx, bool moe_src, bool router, int moe_idx, bool final) {
    const float* sm = (const float*)(ws + WS_SMALL);
    float* H = (float*)(ws + WS_H); bf16_t* HB = (bf16_t*)(ws + WS_HB); const float* contrib = (const float*)(ws + WS_CONTRIB);
    const float* lg = sm + SM_LNG + (size_t)lnidx * D; const float* lb = sm + SM_LNB + (size_t)lnidx * D;
    f32x4 gv[4], bv[4];
#pragma unroll
    for (int j = 0; j < 4; ++j) { gv[j] = *(const f32x4*)(lg + 256 * j + 4 * lane); bv[j] = *(const f32x4*)(lb + 256 * j + 4 * lane); }
    LAS float* wr = (LAS float*)lds;
    volatile LAS unsigned* misc = (volatile LAS unsigned*)(lds + MISC_OFF);
    if (router) {
        const float* src = sm + SM_WROUTER + (size_t)moe_idx * D * N_EXP;
        for (int i = tid; i < D * N_EXP / 4; i += NTHREADS) ((LAS f32x4*)wr)[i] = ((const f32x4*)src)[i];
        if (tid < 8) misc[16 + tid] = 0u;
        __syncthreads();
    }
    int* tope = (int*)(ws + WS_TOPE); float* topg = (float*)(ws + WS_TOPG);
    const float* br = sm + SM_BROUTER + moe_idx * N_EXP;
    for (int row = gw; row < MV; row += NGW) {
        f32x4 v[4];
        const f32x4* hr = (const f32x4*)(H + (size_t)row * D) + lane;
#pragma unroll
        for (int j = 0; j < 4; ++j) v[j] = hr[64 * j];
        if (moe_src) { const f32x4* c0 = (const f32x4*)(contrib + (size_t)(2 * row) * D) + lane; const f32x4* c1 = c0 + 256;
#pragma unroll
            for (int j = 0; j < 4; ++j) v[j] = v[j] * ALPHA + c0[64 * j] + c1[64 * j]; }
        float s = 0.f;
#pragma unroll
        for (int j = 0; j < 4; ++j) s += (v[j][0] + v[j][1]) + (v[j][2] + v[j][3]);
        const float mean = wave_sum(s) * (1.f / D); float s2 = 0.f;
#pragma unroll
        for (int j = 0; j < 4; ++j) { v[j] = v[j] - mean; s2 += (v[j][0] * v[j][0] + v[j][1] * v[j][1]) + (v[j][2] * v[j][2] + v[j][3] * v[j][3]); }
        const float rstd = 1.f / sqrtf(wave_sum(s2) * (1.f / D) + LN_EPS);
#pragma unroll
        for (int j = 0; j < 4; ++j) v[j] = v[j] * rstd * gv[j] + bv[j];
        if (final) { if (row < MREAL) { f32x4* o = (f32x4*)(outp + (size_t)row * D) + lane;
#pragma unroll
                for (int j = 0; j < 4; ++j) o[64 * j] = v[j]; } }
        else { f32x4* o = (f32x4*)(H + (size_t)row * D) + lane; u32x2* ob = (u32x2*)(HB + (size_t)row * D) + lane;
#pragma unroll
            for (int j = 0; j < 4; ++j) { o[64 * j] = v[j]; u32x2 w; w.x = pk2(v[j][0], v[j][1]); w.y = pk2(v[j][2], v[j][3]); ob[64 * j] = w; } }
        if (router) {
            float lg8[8];
#pragma unroll
            for (int e = 0; e < 8; ++e) lg8[e] = 0.f;
#pragma unroll
            for (int j = 0; j < 4; ++j)
#pragma unroll
                for (int c = 0; c < 4; ++c) { const LAS f32x4* w4 = (const LAS f32x4*)(wr + (size_t)(256 * j + 4 * lane + c) * 8); const f32x4 wa = w4[0], wb = w4[1]; const float x = v[j][c];
                    lg8[0] += x * wa[0]; lg8[1] += x * wa[1]; lg8[2] += x * wa[2]; lg8[3] += x * wa[3]; lg8[4] += x * wb[0]; lg8[5] += x * wb[1]; lg8[6] += x * wb[2]; lg8[7] += x * wb[3]; }
#pragma unroll
            for (int e = 0; e < 8; ++e) lg8[e] = wave_sum(lg8[e]) + br[e];
            int e1 = 0; float v1 = lg8[0];
#pragma unroll
            for (int e = 1; e < 8; ++e) if (lg8[e] > v1) { v1 = lg8[e]; e1 = e; }
            int e2 = -1; float v2 = -3.0e38f;
#pragma unroll
            for (int e = 0; e < 8; ++e) if (e != e1 && lg8[e] > v2) { v2 = lg8[e]; e2 = e; }
            const float ex = expf(v2 - v1), g1 = 1.f / (1.f + ex), g2 = ex / (1.f + ex);
            if (lane == 0) { tope[row] = e1 | (e2 << 8); topg[2 * row] = g1; topg[2 * row + 1] = g2;
                __hip_atomic_fetch_add((LAS unsigned*)&misc[16 + e1], 1u, __ATOMIC_RELAXED, __HIP_MEMORY_SCOPE_WORKGROUP);
                __hip_atomic_fetch_add((LAS unsigned*)&misc[16 + e2], 1u, __ATOMIC_RELAXED, __HIP_MEMORY_SCOPE_WORKGROUP); }
        }
    }
    if (router) { __syncthreads();
        if (tid < 8) __hip_atomic_fetch_add((unsigned*)(ws + WS_CTL) + CW_CNT + moe_idx * 64 + tid, misc[16 + tid], __ATOMIC_RELAXED, __HIP_MEMORY_SCOPE_AGENT);
        __syncthreads(); }
}

__device__ __forceinline__ void moe_starts(const unsigned char* ws, int moe_idx, int (&cnt)[8], int (&pstart)[9]) {
    const unsigned* c = (const unsigned*)(ws + WS_CTL) + CW_CNT + moe_idx * 64; int p = 0;
#pragma unroll
    for (int e = 0; e < 8; ++e) { cnt[e] = __builtin_amdgcn_readfirstlane((int)__hip_atomic_load(c + e, __ATOMIC_RELAXED, __HIP_MEMORY_SCOPE_AGENT)); pstart[e] = p; p += (cnt[e] + 255) >> 8; }
    pstart[8] = p;
}
__device__ __forceinline__ void assign_phase(unsigned char* ws, int gw, int NGW, int lane, int tid, int moe_idx) {
    int cnt[8], pstart[9]; moe_starts(ws, moe_idx, cnt, pstart);
    const int* tope = (const int*)(ws + WS_TOPE); const float* topg = (const float*)(ws + WS_TOPG);
    int* rowtok = (int*)(ws + WS_ROWTOK); int* rowdst = (int*)(ws + WS_ROWDST); float* rowgate = (float*)(ws + WS_ROWGATE);
    unsigned* cur = (unsigned*)(ws + WS_CTL) + CW_CUR + moe_idx * 64;
    for (int base = gw * 64; base < MV; base += NGW * 64) {
        const int row = base + lane; const bool valid = row < MV;
        const int te = valid ? tope[row] : 0xffff;
#pragma unroll
        for (int slot = 0; slot < 2; ++slot) {
            const int e = valid ? ((te >> (8 * slot)) & 255) : 255; int pos = -1;
#pragma unroll
            for (int ee = 0; ee < 8; ++ee) {
                const unsigned long long mask = __ballot(e == ee);
                if (mask) { const int n = __popcll(mask), leader = __ffsll((long long)mask) - 1; unsigned b0 = 0;
                    if (lane == leader) b0 = __hip_atomic_fetch_add(cur + ee, (unsigned)n, __ATOMIC_RELAXED, __HIP_MEMORY_SCOPE_AGENT);
                    b0 = __shfl(b0, leader);
                    if (e == ee) pos = pstart[ee] * 256 + (int)b0 + __popcll(mask & ((1ull << lane) - 1ull)); }
            }
            if (valid) { rowtok[pos] = row; rowdst[pos] = 2 * row + slot; rowgate[pos] = topg[2 * row + slot]; }
        }
    }
    if (blockIdx.x < 8) { const int e = blockIdx.x; int ps = 0, pe = 0, ce = 0;
#pragma unroll
        for (int ee = 0; ee < 8; ++ee) if (ee == e) { ps = pstart[ee]; pe = pstart[ee + 1]; ce = cnt[ee]; }
        for (int pos = ps * 256 + ce + tid; pos < pe * 256; pos += NTHREADS) { rowtok[pos] = -1; rowdst[pos] = -1; rowgate[pos] = 0.f; } }
}

constexpr int ML_RS = 72;
constexpr int ML_QS = 0, ML_KS = 9216, ML_KT = 18432, ML_PS = 27648, ML_VT = 36864, ML_CT = 57600, ML_HS = 78336, ML_SC = 112128;
constexpr int ML_HSS = 132;
__device__ __forceinline__ bf16x8 ml_frag(LAS unsigned char* lds, int base, int row, int kcol) { return *(const LAS bf16x8*)(lds + base + (row * ML_RS + kcol) * 2); }

template <int MODE>
__device__ __forceinline__ void mlstm_phase(unsigned char* ws, LAS unsigned char* lds, int layer, int tid, int wave, int lane) {
    const int item = blockIdx.x; const int bh = item >> 3, seg = item & 7, b = bh >> 3, h = bh & 7;
    if (MODE == 1 && seg == 7) return;
    const bf16_t* proj = (const bf16_t*)(ws + WS_PROJ); const float* gates = (const float*)(ws + WS_GATES);
    bf16_t* HG = (bf16_t*)(ws + WS_HG);
    float* STATE = (float*)(ws + WS_STATE); float* STSC = (float*)(ws + WS_STSC);
    LAS float* sc = (LAS float*)(lds + ML_SC);
    const int fr = lane & 15, quad = lane >> 4;
    f32x4 st[5]; float zero = 0.f; asm volatile("; opaque zero" : "+v"(zero));
#pragma unroll
    for (int i = 0; i < 5; ++i) st[i] = (f32x4){zero, zero, zero, zero};
    float m0 = (MODE == 1) ? -1.0e30f : 0.f, gsum = 0.f;
    for (int i = tid; i < 16 * ML_RS; i += NTHREADS) ((LAS bf16_t*)(lds + ML_VT))[128 * ML_RS + i] = (i < ML_RS) ? (bf16_t)0x3F80 : (bf16_t)0;
    if (MODE == 2 && seg > 0) {
        m0 = -1.0e30f;
        for (int s2 = 0; s2 < seg; ++s2) {
            const float ms = STSC[(bh * 7 + s2) * 4 + 0], Gs = STSC[(bh * 7 + s2) * 4 + 1];
            const float mn = fmaxf(Gs + m0, ms), fo = fast_exp(Gs + m0 - mn), fn = fast_exp(ms - mn);
            const f32x4* sp = (const f32x4*)(STATE + (size_t)(bh * 7 + s2) * ST_FLOATS) + (wave * 5) * 64 + lane;
#pragma unroll
            for (int i = 0; i < 5; ++i) st[i] = st[i] * fo + sp[i * 64] * fn;
            m0 = mn;
        }
    }
#pragma unroll
    for (int i = 0; i < 5; ++i) { const int dv = (i < 4) ? 16 * wave + fr : 128 + fr, dk = (i < 4) ? 16 * i + 4 * quad : 16 * wave + 4 * quad;
        if (i < 4 || wave < 4) { u32x2 w; w.x = pk2(st[i][0], st[i][1]); w.y = pk2(st[i][2], st[i][3]); *(LAS u32x2*)(lds + ML_CT + (dv * ML_RS + dk) * 2) = w; } }
    float lnh[16];
    if (MODE == 2) {
#pragma unroll
        for (int e = 0; e < 16; ++e) lnh[e] = ((const float*)(ws + WS_SMALL))[SM_LNH + layer * D + h * M_V + 16 * (tid & 7) + e]; }
    const int nch = SEG_CHUNKS + (seg == 0 ? 1 : 0);
    u32x4 rq, rk, rv0, rv1; float rli = 0.f, rlf = 0.f;
    auto chunk_rows = [&](int ci, int& rbase, int& nv) { if (seg == 0 && ci == 0) { rbase = MREAL; nv = NMETA; } else { const int c = seg * SEG_CHUNKS + ci - (seg == 0 ? 1 : 0); rbase = b * SEQ + c * 64; nv = 64; } };
    auto load_chunk = [&](int ci) {
        int rbase, nv; chunk_rows(ci, rbase, nv);
        { const int j = tid >> 3, c8 = (tid & 7) * 8; const bool ok = j < nv; const bf16_t* rp = proj + (size_t)(rbase + j) * PROJ_LD + h * 64 + c8;
          rq = (MODE == 2 && ok) ? *(const u32x4*)rp : (u32x4){0u, 0u, 0u, 0u}; rk = ok ? *(const u32x4*)(rp + 512) : (u32x4){0u, 0u, 0u, 0u}; }
        { const int j0 = tid >> 4, c8 = (tid & 15) * 8; const bf16_t* rp = proj + (size_t)(rbase + j0) * PROJ_LD + 1024 + h * 128 + c8;
          rv0 = (j0 < nv) ? *(const u32x4*)rp : (u32x4){0u, 0u, 0u, 0u}; rv1 = (j0 + 32 < nv) ? *(const u32x4*)(rp + (size_t)32 * PROJ_LD) : (u32x4){0u, 0u, 0u, 0u}; }
        if (tid < 64) { const bool ok = tid < nv; rli = ok ? gates[(size_t)(rbase + tid) * 16 + h] : -1.0e30f; rlf = ok ? gates[(size_t)(rbase + tid) * 16 + 8 + h] : 1.0e30f; }
    };
    load_chunk(0);
    __syncthreads();
    for (int ci = 0; ci < nch; ++ci) {
        int rbase, nv; chunk_rows(ci, rbase, nv);
        { const int j = tid >> 3, c8 = (tid & 7) * 8;
          if (MODE == 2) *(LAS u32x4*)(lds + ML_QS + (j * ML_RS + c8) * 2) = rq;
          *(LAS u32x4*)(lds + ML_KS + (j * ML_RS + c8) * 2) = rk; }
        { const int j0 = tid >> 4, c8 = (tid & 15) * 8; LAS bf16_t* vt = (LAS bf16_t*)(lds + ML_VT);
          const unsigned a[4] = {rv0.x, rv0.y, rv0.z, rv0.w}, c[4] = {rv1.x, rv1.y, rv1.z, rv1.w};
#pragma unroll
          for (int e = 0; e < 4; ++e) { vt[(c8 + 2 * e) * ML_RS + j0] = (bf16_t)(a[e] & 0xffffu); vt[(c8 + 2 * e + 1) * ML_RS + j0] = (bf16_t)(a[e] >> 16);
              vt[(c8 + 2 * e) * ML_RS + j0 + 32] = (bf16_t)(c[e] & 0xffffu); vt[(c8 + 2 * e + 1) * ML_RS + j0 + 32] = (bf16_t)(c[e] >> 16); } }
        if (wave == 0) {
            const float li = rli, f = rlf;
            const float lf = (f > 1.0e29f) ? 0.f : (fminf(f, 0.f) - logf(1.f + expf(-fabsf(f))));
            float bc = lf;
#pragma unroll
            for (int o = 1; o < 64; o <<= 1) { const float t = __shfl_up(bc, o); if (lane >= o) bc += t; }
            const float u = li - bc; float pm = u;
#pragma unroll
            for (int o = 1; o < 64; o <<= 1) { const float t = __shfl_up(pm, o); if (lane >= o) pm = fmaxf(pm, t); }
            const float blast = __shfl(bc, 63), umax = __shfl(pm, 63);
            const float MM = fmaxf(pm, m0), amax = blast + umax, mn = fmaxf(blast + m0, amax);
            const float sold = fast_exp(blast + m0 - mn), snew = fast_exp(amax - mn);
            sc[lane] = u; sc[64 + lane] = MM; sc[128 + lane] = fast_exp(m0 - MM); sc[192 + lane] = fast_exp(-(bc + MM)); sc[256 + lane] = snew * fast_exp(u - umax);
            if (lane == 0) { sc[384] = sold; sc[385] = mn; sc[386] = blast; }
        }
        __syncthreads();
        if (ci + 1 < nch) load_chunk(ci + 1);
        m0 = sc[385]; gsum += sc[386];
        const float sold = sc[384];
        { const int j = tid >> 3, c8 = (tid & 7) * 8; const u32x4 kv = *(const LAS u32x4*)(lds + ML_KS + (j * ML_RS + c8) * 2); const float wj = sc[256 + j];
          const unsigned a[4] = {kv.x, kv.y, kv.z, kv.w}; LAS bf16_t* kt = (LAS bf16_t*)(lds + ML_KT);
#pragma unroll
          for (int e = 0; e < 4; ++e) { kt[(c8 + 2 * e) * ML_RS + j] = (bf16_t)f2bf(bf2f((unsigned short)(a[e] & 0xffffu)) * wj); kt[(c8 + 2 * e + 1) * ML_RS + j] = (bf16_t)f2bf(bf2f((unsigned short)(a[e] >> 16)) * wj); } }
        if (MODE == 2) {
            const int mt = wave >> 1;
#pragma unroll
            for (int q = 0; q < 2; ++q) { const int nt = 2 * (wave & 1) + q; f32x4 s = (f32x4){0.f, 0.f, 0.f, 0.f};
                if (nt <= mt) {
#pragma unroll
                    for (int ks = 0; ks < 2; ++ks) s = __builtin_amdgcn_mfma_f32_16x16x32_bf16(ml_frag(lds, ML_QS, 16 * mt + fr, 32 * ks + 8 * quad), ml_frag(lds, ML_KS, 16 * nt + fr, 32 * ks + 8 * quad), s, 0, 0, 0); }
                const int j = 16 * nt + fr; const float uj = sc[j];
#pragma unroll
                for (int r = 0; r < 4; ++r) { const int i = 16 * mt + 4 * quad + r; const float p = (j <= i) ? s[r] * fast_exp(uj - sc[64 + i]) : 0.f;
                    ((LAS bf16_t*)(lds + ML_PS))[i * ML_RS + j] = (bf16_t)f2bf(p); } }
        }
        __syncthreads();
        f32x4 o1[4], o2[4];
        if (MODE == 2) {
            bf16x8 vb[2], cb[2];
#pragma unroll
            for (int ks = 0; ks < 2; ++ks) { vb[ks] = ml_frag(lds, ML_VT, 16 * wave + fr, 32 * ks + 8 * quad); cb[ks] = ml_frag(lds, ML_CT, 16 * wave + fr, 32 * ks + 8 * quad); }
#pragma unroll
            for (int mt = 0; mt < 4; ++mt) { o1[mt] = (f32x4){0.f, 0.f, 0.f, 0.f}; o2[mt] = (f32x4){0.f, 0.f, 0.f, 0.f};
#pragma unroll
                for (int ks = 0; ks < 2; ++ks) { o1[mt] = __builtin_amdgcn_mfma_f32_16x16x32_bf16(ml_frag(lds, ML_PS, 16 * mt + fr, 32 * ks + 8 * quad), vb[ks], o1[mt], 0, 0, 0);
                    o2[mt] = __builtin_amdgcn_mfma_f32_16x16x32_bf16(ml_frag(lds, ML_QS, 16 * mt + fr, 32 * ks + 8 * quad), cb[ks], o2[mt], 0, 0, 0); } }
            if (wave < 4) { f32x4 d1 = (f32x4){0.f, 0.f, 0.f, 0.f}, d2 = (f32x4){0.f, 0.f, 0.f, 0.f};
#pragma unroll
                for (int ks = 0; ks < 2; ++ks) { d1 = __builtin_amdgcn_mfma_f32_16x16x32_bf16(ml_frag(lds, ML_PS, 16 * wave + fr, 32 * ks + 8 * quad), ml_frag(lds, ML_VT, 128 + fr, 32 * ks + 8 * quad), d1, 0, 0, 0);
                    d2 = __builtin_amdgcn_mfma_f32_16x16x32_bf16(ml_frag(lds, ML_QS, 16 * wave + fr, 32 * ks + 8 * quad), ml_frag(lds, ML_CT, 128 + fr, 32 * ks + 8 * quad), d2, 0, 0, 0); }
                if (fr == 0) {
#pragma unroll
                    for (int r = 0; r < 4; ++r) { const int i = 16 * wave + 4 * quad + r; sc[320 + i] = d1[r] + sc[128 + i] * d2[r]; } } }
            __syncthreads();
        }
        if (MODE == 2) {
#pragma unroll
            for (int mt = 0; mt < 4; ++mt)
#pragma unroll
                for (int r = 0; r < 4; ++r) { const int i = 16 * mt + 4 * quad + r; const float num = o1[mt][r] + sc[128 + i] * o2[mt][r];
                    ((LAS float*)(lds + ML_HS))[i * ML_HSS + 16 * wave + fr] = num / fmaxf(fabsf(sc[320 + i]), sc[192 + i]); }
        }
        { bf16x8 vb[2];
#pragma unroll
          for (int ks = 0; ks < 2; ++ks) vb[ks] = ml_frag(lds, ML_VT, 16 * wave + fr, 32 * ks + 8 * quad);
#pragma unroll
          for (int mt = 0; mt < 4; ++mt) { st[mt] = st[mt] * sold;
#pragma unroll
              for (int ks = 0; ks < 2; ++ks) st[mt] = __builtin_amdgcn_mfma_f32_16x16x32_bf16(ml_frag(lds, ML_KT, 16 * mt + fr, 32 * ks + 8 * quad), vb[ks], st[mt], 0, 0, 0); }
          if (wave < 4) { st[4] = st[4] * sold;
#pragma unroll
              for (int ks = 0; ks < 2; ++ks) st[4] = __builtin_amdgcn_mfma_f32_16x16x32_bf16(ml_frag(lds, ML_KT, 16 * wave + fr, 32 * ks + 8 * quad), ml_frag(lds, ML_VT, 128 + fr, 32 * ks + 8 * quad), st[4], 0, 0, 0); }
          if (MODE == 2) {
#pragma unroll
              for (int i = 0; i < 5; ++i) { const int dv = (i < 4) ? 16 * wave + fr : 128 + fr, dk = (i < 4) ? 16 * i + 4 * quad : 16 * wave + 4 * quad;
                  if (i < 4 || wave < 4) { u32x2 w; w.x = pk2(st[i][0], st[i][1]); w.y = pk2(st[i][2], st[i][3]); *(LAS u32x2*)(lds + ML_CT + (dv * ML_RS + dk) * 2) = w; } } }
        }
        __syncthreads();
        if (MODE == 2) {
            const int i = tid >> 3, sg = tid & 7; const LAS float* hp = (const LAS float*)(lds + ML_HS) + i * ML_HSS + 16 * sg;
            float x[16]; float s = 0.f;
#pragma unroll
            for (int e = 0; e < 16; ++e) { x[e] = hp[e]; s += x[e]; }
            s += __shfl_xor(s, 1); s += __shfl_xor(s, 2); s += __shfl_xor(s, 4);
            const float mean = s * (1.f / M_V); float q = 0.f;
#pragma unroll
            for (int e = 0; e < 16; ++e) { x[e] -= mean; q += x[e] * x[e]; }
            q += __shfl_xor(q, 1); q += __shfl_xor(q, 2); q += __shfl_xor(q, 4);
            const float rstd = 1.f / sqrtf(q * (1.f / M_V) + LN_EPS);
            if (i < nv && (nv == 64 || b == 0)) {
                const size_t row = (size_t)(rbase + i);
                const u32x4* ogp = (const u32x4*)(proj + row * PROJ_LD + 2048 + h * M_V + 16 * sg); const u32x4 g0 = ogp[0], g1 = ogp[1];
                const unsigned gw8[8] = {g0.x, g0.y, g0.z, g0.w, g1.x, g1.y, g1.z, g1.w}; unsigned ow[8];
#pragma unroll
                for (int e = 0; e < 8; ++e) { const float oga = bf2f((unsigned short)(gw8[e] & 0xffffu)), ogb = bf2f((unsigned short)(gw8[e] >> 16));
                    const float ya = x[2 * e] * rstd * lnh[2 * e] / (1.f + fast_exp(-oga)), yb = x[2 * e + 1] * rstd * lnh[2 * e + 1] / (1.f + fast_exp(-ogb));
                    ow[e] = pk2(ya, yb); }
                u32x4* op = (u32x4*)(HG + row * D + h * M_V + 16 * sg);
                op[0] = (u32x4){ow[0], ow[1], ow[2], ow[3]}; op[1] = (u32x4){ow[4], ow[5], ow[6], ow[7]};
            }
        }
    }
    if (MODE == 1) {
        f32x4* sp = (f32x4*)(STATE + (size_t)(bh * 7 + seg) * ST_FLOATS) + (wave * 5) * 64 + lane;
#pragma unroll
        for (int i = 0; i < 5; ++i) sp[i * 64] = (i < 4 || wave < 4) ? st[i] : (f32x4){0.f, 0.f, 0.f, 0.f};
        if (tid == 0) { STSC[(bh * 7 + seg) * 4 + 0] = m0; STSC[(bh * 7 + seg) * 4 + 1] = gsum; }
    }
}

constexpr int AT_KRS = 72, AT_VRS = 296, AT_NK = 272;
constexpr int AT_KS = 0, AT_VT = AT_NK * AT_KRS * 2, AT_PS = AT_VT + 64 * AT_VRS * 2, AT_PSW = 16 * AT_VRS * 2;
static_assert(AT_PS + 8 * AT_PSW <= MISC_OFF, "attention LDS");
__device__ __forceinline__ void attn_phase(unsigned char* ws, LAS unsigned char* lds, int j_layer, int tid, int wave, int lane) {
    const bf16_t* Q = (const bf16_t*)(ws + WS_PROJ); const bf16_t* KB = (const bf16_t*)(ws + WS_KB); const bf16_t* VB = (const bf16_t*)(ws + WS_VB);
    bf16_t* HG = (bf16_t*)(ws + WS_HG);
    const float* sinks = (const float*)(ws + WS_SMALL) + SM_SINKS + j_layer * A_HEADS;
    const int fr = lane & 15, quad = lane >> 4;
    LAS bf16_t* ks = (LAS bf16_t*)(lds + AT_KS); LAS bf16_t* vt = (LAS bf16_t*)(lds + AT_VT); LAS bf16_t* ps = (LAS bf16_t*)(lds + AT_PS + wave * AT_PSW);
    for (int i = tid; i < 64 * 24; i += NTHREADS) vt[(i / 24) * AT_VRS + AT_NK + (i % 24)] = 0;
    for (int i = lane; i < 16 * 24; i += 64) ps[(i / 24) * AT_VRS + AT_NK + (i % 24)] = 0;
    for (int it = blockIdx.x; it < NBATCH * A_KV * (SEQ / WINDOW); it += gridDim.x) {
        const int b = it >> 8, g = (it >> 6) & 3, blk = it & 63;
        __syncthreads();
        for (int p = tid; p < AT_NK * 8; p += NTHREADS) { const int kk = p >> 3, c8 = (p & 7) * 8;
            int row; if (kk < 16) row = MREAL + kk; else { const int tk = (blk - 1) * WINDOW + (kk - 16); row = tk < 0 ? -1 : b * SEQ + tk; }
            u32x4 kv = (u32x4){0u, 0u, 0u, 0u}, vv = (u32x4){0u, 0u, 0u, 0u};
            if (row >= 0) { kv = *(const u32x4*)(KB + (size_t)row * 256 + g * 64 + c8); vv = *(const u32x4*)(VB + (size_t)row * 256 + g * 64 + c8); }
            *(LAS u32x4*)(ks + kk * AT_KRS + c8) = kv;
            const unsigned a[4] = {vv.x, vv.y, vv.z, vv.w};
#pragma unroll
            for (int e = 0; e < 4; ++e) { vt[(c8 + 2 * e) * AT_VRS + kk] = (bf16_t)(a[e] & 0xffffu); vt[(c8 + 2 * e + 1) * AT_VRS + kk] = (bf16_t)(a[e] >> 16); } }
        __syncthreads();
        const int qh = g * 4 + (wave >> 1); const float sink = sinks[qh];
        for (int mt = 0; mt < 4; ++mt) {
            const int qi0 = 64 * (wave & 1) + 16 * mt; const size_t rowq = (size_t)b * SEQ + blk * WINDOW + qi0;
            bf16x8 qf[2];
#pragma unroll
            for (int k2 = 0; k2 < 2; ++k2) qf[k2] = *(const bf16x8*)(Q + (rowq + fr) * D + qh * 64 + 32 * k2 + 8 * quad);
            f32x4 s[17];
#pragma unroll
            for (int nt = 0; nt < 17; ++nt) { s[nt] = (f32x4){0.f, 0.f, 0.f, 0.f};
#pragma unroll
                for (int k2 = 0; k2 < 2; ++k2) s[nt] = __builtin_amdgcn_mfma_f32_16x16x32_bf16(qf[k2], *(const LAS bf16x8*)(ks + (16 * nt + fr) * AT_KRS + 32 * k2 + 8 * quad), s[nt], 0, 0, 0); }
            float mx[4], sum[4], inv[4];
#pragma unroll
            for (int r = 0; r < 4; ++r) { const int qi = qi0 + 4 * quad + r; float m = -1.0e30f;
#pragma unroll
                for (int nt = 0; nt < 17; ++nt) { bool vis = true;
                    if (nt > 0) { const int j = 16 * nt + fr - 16, rel = qi + WINDOW - j; vis = (rel >= 0) && (rel < WINDOW) && (blk > 0 || j >= WINDOW); }
                    s[nt][r] = vis ? s[nt][r] : -1.0e30f; m = fmaxf(m, s[nt][r]); }
                m = fmaxf(m, __shfl_xor(m, 1)); m = fmaxf(m, __shfl_xor(m, 2)); m = fmaxf(m, __shfl_xor(m, 4)); m = fmaxf(m, __shfl_xor(m, 8));
                m = fmaxf(m, sink); mx[r] = m; float sm = 0.f;
#pragma unroll
                for (int nt = 0; nt < 17; ++nt) { const float p = fast_exp(s[nt][r] - m); s[nt][r] = p; sm += p; }
                sm += __shfl_xor(sm, 1); sm += __shfl_xor(sm, 2); sm += __shfl_xor(sm, 4); sm += __shfl_xor(sm, 8);
                sum[r] = sm; inv[r] = 1.f / (sm + fast_exp(sink - m)); }
#pragma unroll
            for (int nt = 0; nt < 17; ++nt)
#pragma unroll
                for (int r = 0; r < 4; ++r) ps[(4 * quad + r) * AT_VRS + 16 * nt + fr] = (bf16_t)f2bf(s[nt][r]);
            f32x4 o[4];
#pragma unroll
            for (int nd = 0; nd < 4; ++nd) o[nd] = (f32x4){0.f, 0.f, 0.f, 0.f};
#pragma unroll
            for (int k2 = 0; k2 < 9; ++k2) { const bf16x8 pf = *(const LAS bf16x8*)(ps + fr * AT_VRS + 32 * k2 + 8 * quad);
#pragma unroll
                for (int nd = 0; nd < 4; ++nd) o[nd] = __builtin_amdgcn_mfma_f32_16x16x32_bf16(pf, *(const LAS bf16x8*)(vt + (16 * nd + fr) * AT_VRS + 32 * k2 + 8 * quad), o[nd], 0, 0, 0); }
#pragma unroll
            for (int nd = 0; nd < 4; ++nd)
#pragma unroll
                for (int r = 0; r < 4; ++r) HG[(rowq + 4 * quad + r) * D + qh * 64 + 16 * nd + fr] = (bf16_t)f2bf(o[nd][r] * inv[r]);
        }
    }
    if (blockIdx.x == gridDim.x - 1 && tid < 256) {
        const int qm = tid >> 4, head = tid & 15, g = head >> 2; const float sink = sinks[head];
        const bf16_t* qp = Q + (size_t)(MREAL + qm) * D + head * 64;
        float sv[16]; float m = sink;
#pragma unroll
        for (int kk = 0; kk < 16; ++kk) { float d = 0.f; const bf16_t* kp = KB + (size_t)(MREAL + kk) * 256 + g * 64;
            for (int c = 0; c < 64; ++c) d += bf2f(qp[c]) * bf2f(kp[c]);
            sv[kk] = (kk <= qm) ? d : -1.0e30f; m = fmaxf(m, sv[kk]); }
        float den = fast_exp(sink - m);
#pragma unroll
        for (int kk = 0; kk < 16; ++kk) { sv[kk] = (kk <= qm) ? fast_exp(sv[kk] - m) : 0.f; den += sv[kk]; }
        const float invd = 1.f / den;
        for (int c = 0; c < 64; ++c) { float a = 0.f;
#pragma unroll
            for (int kk = 0; kk < 16; ++kk) a += sv[kk] * bf2f(VB[(size_t)(MREAL + kk) * 256 + g * 64 + c]);
            HG[(size_t)(MREAL + qm) * D + head * 64 + c] = (bf16_t)f2bf(a * invd); }
    }
}

#ifndef SITES
#define SITES 0xFFFF
#endif
#define SITE(n) ((SITES >> (n)) & 1)
#ifndef MK_PER_PHASE
#define MK_PER_PHASE 1
#endif
constexpr int PH_PER_LAYER = 12, N_PHASES = 1 + 4 * PH_PER_LAYER;

__global__ void __launch_bounds__(NTHREADS, 2) fwd(Params P) {
    extern __shared__ __attribute__((aligned(16))) unsigned char lds_raw[];
    LAS unsigned char* const lds0 = (LAS unsigned char*)lds_raw;
    const int G = gridDim.x;
    const int vcu = (G % 8 == 0) ? ((int)blockIdx.x % 8) * (G / 8) + (int)blockIdx.x / 8 : (int)blockIdx.x;
    const int NGW = G * NWAVES;
    unsigned char* const wsbase = P.ws;
    volatile LAS unsigned* misc = (volatile LAS unsigned*)(lds0 + MISC_OFF);
    if (threadIdx.x < 64) misc[threadIdx.x] = 0u;
    __syncthreads();
    XcdBarrier bar = xcd_barrier_post((unsigned*)(wsbase + WS_CTL) + CW_BAR + P.li * 4096, misc + 8);
    const int lo = P.ph_lo, hi = P.ph_hi;
#define RUN(idx) ((idx) >= lo && (idx) < hi)
#define SEAM(idx) do { if ((idx) + 1 < hi) xcd_barrier(bar); } while (0)
#define IDS() int tid = threadIdx.x; asm volatile("; opaque tid" : "+v"(tid)); unsigned char* ws = wsbase; asm volatile("; opaque ws" : "+s"(ws)); \
              LAS unsigned char* lds = lds0; asm volatile("; opaque lds" : "+s"(lds)); \
              const int lane = tid & 63, wave = __builtin_amdgcn_readfirstlane(tid >> 6); const int gw = vcu * NWAVES + wave; (void)lane; (void)gw; (void)ws

    if (SITE(0) && RUN(0)) { IDS(); p0_prologue(P, lds, gw, NGW, wave, lane); SEAM(0); }

    for (int l = 0; l < 4; ++l) {
        const int pb = 1 + l * PH_PER_LAYER;
        const bool moe = (l & 1) != 0; const int fi = l >> 1;
        if (l < 2) {
            if (SITE(1) && RUN(pb + 0)) {
                IDS();
                pg8::DenseOrder S; S.init(MP / 256, M_INP / 256, G, (int)blockIdx.x);
                EpiProj E{(bf16_t*)(ws + WS_PROJ), (float*)(ws + WS_GATES), (const float*)(ws + WS_SMALL) + SM_BGATE + l * 16};
                pg8::gemm_phase(lds, (const bf16_t*)(ws + WS_HB), (const bf16_t*)(ws + WS_WIN) + (size_t)l * M_INP * D, D, S, E);
                SEAM(pb + 0); }
            if (SITE(2) && RUN(pb + 1)) { IDS(); mlstm_phase<1>(ws, lds, l, tid, wave, lane); SEAM(pb + 1); }
            if (SITE(3) && RUN(pb + 2)) { IDS(); mlstm_phase<2>(ws, lds, l, tid, wave, lane); SEAM(pb + 2); }
        } else {
            if (SITE(4) && RUN(pb + 0)) {
                IDS();
                pg8::DenseOrder S; S.init(MP / 256, l == 2 ? 6 : 4, G, (int)blockIdx.x);
                EpiQKV E{(bf16_t*)(ws + WS_PROJ), (bf16_t*)(ws + WS_KB), (bf16_t*)(ws + WS_VB), (const float*)(ws + WS_ROPE)};
                pg8::gemm_phase(lds, (const bf16_t*)(ws + WS_HB), (const bf16_t*)(ws + (l == 2 ? WS_WQKV : WS_WQ3)), D, S, E);
                SEAM(pb + 0); }
            if (SITE(5) && RUN(pb + 1)) { IDS(); attn_phase(ws, lds, l - 2, tid, wave, lane); SEAM(pb + 1); }
        }
        if (SITE(6) && RUN(pb + 3)) {
            IDS();
            pg8::DenseOrder S; S.init(MP / 256, 4, G, (int)blockIdx.x);
            EpiRes E{(float*)(ws + WS_H)};
            pg8::gemm_phase(lds, (const bf16_t*)(ws + WS_HG), (const bf16_t*)(ws + (l < 2 ? WS_WOUT : WS_WO)) + (size_t)(l & 1) * D * D, D, S, E);
            SEAM(pb + 3); }
        if (SITE(7) && RUN(pb + 4)) { IDS(); ln_phase(ws, nullptr, lds, gw, NGW, lane, tid, l * 2 + 0, false, moe, fi, false); SEAM(pb + 4); }
        if (!moe) {
            if (SITE(8) && RUN(pb + 5)) {
                IDS();
                pg8::DenseOrder S; S.init(MP / 256, 2 * D_FF / 256, G, (int)blockIdx.x);
                EpiSwiglu E{(bf16_t*)(ws + WS_ACT), D_FF};
                pg8::gemm_phase(lds, (const bf16_t*)(ws + WS_HB), (const bf16_t*)(ws + WS_WGU) + (size_t)fi * 2 * D_FF * D, D, S, E);
                SEAM(pb + 5); }
            if (SITE(9) && RUN(pb + 6)) {
                IDS();
                pg8::DenseOrder S; S.init(MP / 256, 4, G, (int)blockIdx.x);
                EpiRes E{(float*)(ws + WS_H)};
                pg8::gemm_phase(lds, (const bf16_t*)(ws + WS_ACT), (const bf16_t*)(ws + WS_WDN) + (size_t)fi * D * D_FF, D_FF, S, E);
                SEAM(pb + 6); }
        } else {
            if (SITE(10) && RUN(pb + 5)) { IDS(); assign_phase(ws, gw, NGW, lane, tid, fi); SEAM(pb + 5); }
            if (SITE(11) && RUN(pb + 6)) {
                IDS();
                int cnt[8]; pg8::GroupedOrder S; moe_starts(ws, fi, cnt, S.pstart);
                S.o.init(S.pstart[8], 2 * D_FF_EXP / 256, G, (int)blockIdx.x); S.nexp_rows = 2 * D_FF_EXP; S.rowtok = (const int*)(ws + WS_ROWTOK);
                EpiSwiglu E{(bf16_t*)(ws + WS_ACT), D_FF_EXP};
                pg8::gemm_phase(lds, (const bf16_t*)(ws + WS_HB), (const bf16_t*)(ws + WS_WGUE) + (size_t)fi * 8 * 2 * D_FF_EXP * D, D, S, E);
                SEAM(pb + 6); }
            if (SITE(12) && RUN(pb + 7)) {
                IDS();
                int cnt[8]; pg8::GroupedOrder S; moe_starts(ws, fi, cnt, S.pstart);
                S.o.init(S.pstart[8], 4, G, (int)blockIdx.x); S.nexp_rows = D; S.rowtok = nullptr;
                EpiScatter E{(float*)(ws + WS_CONTRIB), (const int*)(ws + WS_ROWDST), (const float*)(ws + WS_ROWGATE)};
                pg8::gemm_phase(lds, (const bf16_t*)(ws + WS_ACT), (const bf16_t*)(ws + WS_WDNE) + (size_t)fi * 8 * D * D_FF_EXP, D_FF_EXP, S, E);
                SEAM(pb + 7); }
        }
        if (SITE(13) && RUN(pb + 10)) { IDS(); ln_phase(ws, P.out, lds, gw, NGW, lane, tid, l * 2 + 1, moe, false, 0, l == 3); SEAM(pb + 10); }
    }
#undef RUN
#undef SEAM
#undef IDS
}

extern "C" void kernel_launch(void* const* d_in, const int* in_sizes, int n_in, void* d_out, int out_size, void* d_ws, size_t ws_size, hipStream_t stream) {
    static int grid = 0;
    if (grid == 0) {
        if (n_in != 18 || out_size != MREAL * D || ws_size < WS_END) { fprintf(stderr, "kernel_launch: unexpected shapes (n_in %d, out %d, ws %zu < %zu)\n", n_in, out_size, ws_size, (size_t)WS_END); grid = -1; return; }
        int dev = 0, cus = 0, per_cu = 0;
        if (hipGetDevice(&dev) != hipSuccess || hipDeviceGetAttribute(&cus, hipDeviceAttributeMultiprocessorCount, dev) != hipSuccess) { grid = -1; return; }
        if (hipFuncSetAttribute((const void*)fwd, hipFuncAttributeMaxDynamicSharedMemorySize, LDS_BYTES) != hipSuccess) { fprintf(stderr, "kernel_launch: hipFuncSetAttribute failed\n"); grid = -1; return; }
        if (hipOccupancyMaxActiveBlocksPerMultiprocessor(&per_cu, (const void*)fwd, NTHREADS, LDS_BYTES) != hipSuccess || per_cu < 1) fprintf(stderr, "kernel_launch: occupancy query reports %d\n", per_cu);
        (void)hipGetLastError();
        grid = cus > 256 ? 256 : cus;
    }
    if (grid < 0) return;
    (void)in_sizes;
    if (hipMemsetAsync((char*)d_ws + WS_CTL, 0, CTL_BYTES, stream) != hipSuccess) return;
    Params p{};
    for (int i = 0; i < 18; ++i) p.in[i] = (const float*)d_in[i];
    p.out = (float*)d_out; p.ws = (unsigned char*)d_ws;
#if MK_PER_PHASE
    int li = 0;
    for (int ph = 0; ph < N_PHASES; ++ph) {
        const int k = (ph - 1) % PH_PER_LAYER, l = (ph - 1) / PH_PER_LAYER;
        if (ph > 0) { const bool moe = l & 1; if (k == 2 && l >= 2) continue; if (k == 8 || k == 9 || k == 11) continue; if (k == 7 && !moe) continue; }
        p.ph_lo = ph; p.ph_hi = ph + 1; p.li = li++; p.pad = 0;
        hipLaunchKernelGGL(fwd, dim3(grid), dim3(NTHREADS), LDS_BYTES, stream, p);
    }
#else
    p.ph_lo = 0; p.ph_hi = N_PHASES; p.li = 0; p.pad = 0;
    hipLaunchKernelGGL(fwd, dim3(grid), dim3(NTHREADS), LDS_BYTES, stream, p);
#endif
}
```

```cpp
#include <hip/hip_runtime.h>
#include <cstdio>
#include <cstdint>

#define LAS __attribute__((address_space(3)))
#define GAS __attribute__((address_space(1)))
typedef unsigned short bf16_t;
typedef short bf16x8 __attribute__((ext_vector_type(8)));
typedef float f32x4 __attribute__((ext_vector_type(4)));
typedef float f32x2 __attribute__((ext_vector_type(2)));
typedef unsigned u32x4 __attribute__((ext_vector_type(4)));
typedef unsigned u32x2 __attribute__((ext_vector_type(2)));

constexpr int D = 1024, NBATCH = 4, SEQ = 8192, NMETA = 16;
constexpr int MREAL = NBATCH * SEQ;
constexpr int MV = MREAL + NMETA;
constexpr int MP = 129 * 256;
constexpr int M_HEADS = 8, M_QK = 64, M_V = 128;
constexpr int M_IN = 3088, M_INP = 3328;
constexpr int PROJ_LD = 3072;
constexpr int A_HEADS = 16, A_KV = 4, A_HD = 64, WINDOW = 128;
constexpr int D_FF = 2816, N_EXP = 8, D_FF_EXP = 3584;
constexpr float ALPHA = 1.681792830507429f;
constexpr float LN_EPS = 1e-5f;
constexpr int RP = 265 * 256;
constexpr int NSEG = 8, SEG_CHUNKS = 16;
constexpr int ST_FLOATS = 8 * 5 * 64 * 4;

constexpr size_t MiB = 1u << 20;
constexpr size_t al(size_t x) { return (x + 4095) & ~(size_t)4095; }
constexpr size_t WS_CTL = 0, CTL_BYTES = 1 * MiB;
constexpr size_t WS_WIN = WS_CTL + CTL_BYTES;
constexpr size_t WS_WOUT = WS_WIN + al((size_t)2 * M_INP * D * 2);
constexpr size_t WS_WQKV = WS_WOUT + al((size_t)2 * D * D * 2);
constexpr size_t WS_WQ3 = WS_WQKV + al((size_t)1536 * D * 2);
constexpr size_t WS_WO = WS_WQ3 + al((size_t)D * D * 2);
constexpr size_t WS_WGU = WS_WO + al((size_t)2 * D * D * 2);
constexpr size_t WS_WDN = WS_WGU + al((size_t)2 * 2 * D_FF * D * 2);
constexpr size_t WS_WGUE = WS_WDN + al((size_t)2 * D * D_FF * 2);
constexpr size_t WS_WDNE = WS_WGUE + al((size_t)16 * 2 * D_FF_EXP * D * 2);
constexpr size_t WS_H = WS_WDNE + al((size_t)16 * D * D_FF_EXP * 2);
constexpr size_t WS_HB = WS_H + al((size_t)MP * D * 4);
constexpr size_t WS_PROJ = WS_HB + al((size_t)MP * D * 2);
constexpr size_t WS_HG = WS_PROJ + (size_t)MP * PROJ_LD * 2;
constexpr size_t WS_CONTRIB = WS_PROJ;
constexpr size_t WS_KB = WS_HG + al((size_t)MP * D * 2);
constexpr size_t WS_VB = WS_KB + al((size_t)MP * 256 * 2);
constexpr size_t WS_GATES = WS_VB + al((size_t)MP * 256 * 2);
constexpr size_t WS_ACT = WS_GATES + al((size_t)MP * 16 * 4);
constexpr size_t WS_STATE = WS_ACT + al((size_t)RP * D_FF_EXP * 2);
constexpr size_t WS_STSC = WS_STATE + al((size_t)32 * 7 * ST_FLOATS * 4);
constexpr size_t WS_ROPE = WS_STSC + al((size_t)32 * 7 * 4 * 4);
constexpr size_t WS_TOPE = WS_ROPE + al((size_t)8208 * 16 * 4);
constexpr size_t WS_TOPG = WS_TOPE + al((size_t)MP * 4);
constexpr size_t WS_ROWTOK = WS_TOPG + al((size_t)MP * 8);
constexpr size_t WS_ROWDST = WS_ROWTOK + al((size_t)RP * 4);
constexpr size_t WS_ROWGATE = WS_ROWDST + al((size_t)RP * 4);
constexpr size_t WS_SMALL = WS_ROWGATE + al((size_t)RP * 4);
constexpr int SM_BGATE = 0, SM_SINKS = 32, SM_BROUTER = 64, SM_LNH = 128, SM_LNG = SM_LNH + 2 * D, SM_LNB = SM_LNG + 8 * D, SM_WROUTER = SM_LNB + 8 * D, SM_END = SM_WROUTER + 2 * D * N_EXP;
constexpr size_t WS_END = WS_SMALL + al((size_t)SM_END * 4);
static_assert((size_t)MP * 2 * D * 4 <= (WS_KB - WS_PROJ), "contrib overlay fits PROJ+HG");

constexpr int CW_CNT = 1024;
constexpr int CW_CUR = 1024 + 256;
constexpr int CW_BAR = 16384;

constexpr int LDS_BYTES = 163840 - 512;
constexpr int RING_BYTES = 131072;
constexpr int MISC_OFF = LDS_BYTES - 256;

__device__ __forceinline__ unsigned f2bf(float f) { unsigned u = __builtin_bit_cast(unsigned, f); return (u + 0x7fffu + ((u >> 16) & 1u)) >> 16; }
__device__ __forceinline__ unsigned pk2(float lo, float hi) { return f2bf(lo) | (f2bf(hi) << 16); }
__device__ __forceinline__ unsigned cvt_pk_bf16(float lo, float hi) { unsigned r; asm volatile("v_cvt_pk_bf16_f32 %0, %1, %2" : "=v"(r) : "v"(lo), "v"(hi)); return r; }
__device__ __forceinline__ float bf2f(unsigned short b) { return __builtin_bit_cast(float, ((unsigned)b) << 16); }
__device__ __forceinline__ float wave_sum(float v) {
#pragma unroll
    for (int o = 1; o < 64; o <<= 1) v += __shfl_xor(v, o);
    return v;
}
__device__ __forceinline__ float fast_exp(float x) { return __builtin_amdgcn_exp2f(x * 1.4426950408889634f); }
#define LDS_WAIT() asm volatile("s_waitcnt lgkmcnt(0)" ::: "memory")
#define VM_WAIT() asm volatile("s_waitcnt vmcnt(0)" ::: "memory")

#define XB_TMO      128
#define XB_XCNT(j)  (256  + 64 * (j))
#define XB_XSUB(j)  (1280 + 64 * (j))
#define XB_XGEN(j)  (2304 + 64 * (j))
#define XB_TOP      3328
#define XB_TOPGEN   3392
#define XCD_BAR_WORDS 3456
#define XB_SPIN_CAP (1u << 18)
__device__ __forceinline__ unsigned xb_ld(unsigned* p)              { return __hip_atomic_load(p, __ATOMIC_RELAXED, __HIP_MEMORY_SCOPE_AGENT); }
__device__ __forceinline__ unsigned xb_add(unsigned* p, unsigned v) { return __hip_atomic_fetch_add(p, v, __ATOMIC_RELAXED, __HIP_MEMORY_SCOPE_AGENT); }
__device__ __forceinline__ unsigned xb_xcc_id() { return (unsigned)__builtin_amdgcn_s_getreg((3 << 11) | 20) & 0xFu; }
#define XB_SPIN(cond, bar) do { unsigned _sp = 0; while (cond) { __builtin_amdgcn_s_sleep(1); \
    if ((++_sp & 255u) == 0u) { if (xb_ld(&(bar)[XB_TMO])) break; if (_sp > XB_SPIN_CAP) { atomicAdd(&(bar)[XB_TMO], 1u); break; } } } } while (0)
struct XcdBarrier { unsigned* bar; unsigned x; volatile LAS unsigned* st; };
__device__ __forceinline__ XcdBarrier xcd_barrier_post(unsigned* bar, volatile LAS unsigned* st) {
    XcdBarrier b; b.bar = bar; b.x = xb_xcc_id(); b.st = st;
    if (threadIdx.x == 0) (void)xb_add(&bar[XB_XCNT(b.x)], 1u);
    return b;
}
__device__ __forceinline__ void xcd_barrier_complete(unsigned* bar, unsigned x, unsigned& nloc, unsigned& nx) {
    const unsigned G = gridDim.x * gridDim.y * gridDim.z;
    unsigned sum, cnt, mine, sp = 0u;
    for (;;) {
        sum = 0u; cnt = 0u; mine = 0u;
#pragma unroll
        for (unsigned j = 0; j < 16; ++j) { const unsigned c = xb_ld(&bar[XB_XCNT(j)]); sum += c; cnt += (c > 0u) ? 1u : 0u; mine = (j == x) ? c : mine; }
        if (sum == G) break;
        __builtin_amdgcn_s_sleep(1);
        if ((++sp & 255u) == 0u) { if (xb_ld(&bar[XB_TMO])) break; if (sp > XB_SPIN_CAP) { atomicAdd(&bar[XB_TMO], 1u); break; } }
    }
    nloc = mine > 0u ? mine : 1u; nx = cnt > 0u ? cnt : 1u;
}
__device__ __forceinline__ void xcd_barrier(const XcdBarrier& b) {
    asm volatile("s_waitcnt vmcnt(0)" ::: "memory");
    __syncthreads();
    if (threadIdx.x == 0) {
        unsigned* bar = b.bar;
        __builtin_amdgcn_s_waitcnt(0);
        unsigned nloc = b.st[0], nx = b.st[1];
        if (nloc == 0u) { xcd_barrier_complete(bar, b.x, nloc, nx); b.st[0] = nloc; b.st[1] = nx; }
        const unsigned old = xb_add(&bar[XB_XSUB(b.x)], 1u);
        const unsigned gen = old / nloc;
        if (old + 1u == (gen + 1u) * nloc) {
            __builtin_amdgcn_fence(__ATOMIC_RELEASE, "agent");
            asm volatile("s_waitcnt vmcnt(0)" ::: "memory");
            const unsigned og = xb_add(&bar[XB_TOP], 1u);
            const unsigned tg = og / nx;
            if (og + 1u == (tg + 1u) * nx) xb_add(&bar[XB_TOPGEN], 1u);
            else XB_SPIN(xb_ld(&bar[XB_TOPGEN]) == tg, bar);
            __builtin_amdgcn_fence(__ATOMIC_ACQUIRE, "agent");
            xb_add(&bar[XB_XGEN(b.x)], 1u);
            asm volatile("s_waitcnt vmcnt(0)" ::: "memory");
        } else {
            XB_SPIN(xb_ld(&bar[XB_XGEN(b.x)]) == gen, bar);
            __builtin_amdgcn_fence(__ATOMIC_ACQUIRE, "agent");
            asm volatile("s_waitcnt vmcnt(0)" ::: "memory");
        }
    }
    __syncthreads();
}

namespace pg8 {
constexpr int BM = 256, BK = 64, HALF = 128, HTB = HALF * BK * 2, STAGE_BYTES = 8 * HTB, NXCD = 8, WGM = 8;
__host__ __device__ __forceinline__ int lds_byte(int r, int c) { const int st = (r >> 4) * 2 + (c >> 5), rr = r & 15, cc = c & 31, ob = rr * 64 + cc * 2; return st * 1024 + (ob ^ (((ob >> 9) & 1) << 5)); }
__host__ __device__ __forceinline__ void stage_rc(int b, int& R, int& C) { const int st = b / 1024, sb = b % 1024, swz = sb ^ (((sb >> 9) & 1) << 5); R = (st >> 1) * 16 + swz / 64; C = (st & 1) * 32 + (swz % 64) / 2; }
__host__ __device__ __forceinline__ int perm32(int rho) { const int n = rho >> 4, i = rho & 15; return 8 * (i >> 2) + 4 * n + (i & 3); }

struct Unit { int pm, pn, brow; };

struct DenseOrder {
    int nM, nN, nwg, G, c;
    __device__ void init(int nM_, int nN_, int G_, int c_) { nM = nM_; nN = nN_; nwg = nM * nN; G = G_; c = c_; }
    __device__ __forceinline__ bool next(int i, Unit& u) const {
        const long L = (long)i * G + c; if (L >= nwg) return false;
        int wgid = (int)L; { const int q = nwg / NXCD, r = nwg % NXCD, xcd = wgid % NXCD, off = wgid / NXCD; wgid = (xcd < r ? xcd * (q + 1) : r * (q + 1) + (xcd - r) * q) + off; }
        const int nig = WGM * nN, gid = wgid / nig, fm = gid * WGM, gsz = (nM - fm) < WGM ? (nM - fm) : WGM;
        u.pm = fm + ((wgid % nig) % gsz); u.pn = (wgid % nig) / gsz; u.brow = u.pn * BM; return true;
    }
    __device__ __forceinline__ int a_row(const Unit& u, int r) const { return u.pm * BM + r; }
};
struct GroupedOrder {
    DenseOrder o; int pstart[9]; int nexp_rows;
    const int* rowtok;
    __device__ __forceinline__ bool next(int i, Unit& u) const {
        if (!o.next(i, u)) return false;
        int e = 0;
#pragma unroll
        for (int k = 1; k < 8; ++k) e += (u.pm >= pstart[k]) ? 1 : 0;
        u.brow = e * nexp_rows + u.pn * BM; return true;
    }
    __device__ __forceinline__ int a_row(const Unit& u, int r) const {
        const int pos = u.pm * BM + r; if (!rowtok) return pos;
        const int t = rowtok[pos]; return t < 0 ? 0 : t;
    }
};

template <class Epi, class Sched>
__device__ __forceinline__ void gemm_phase(LAS unsigned char* lds, const bf16_t* Abase, const bf16_t* Btbase, const int K, const Sched& S, const Epi& E) {
    int tid = threadIdx.x; asm volatile("; opaque tid" : "+v"(tid));
    const int wid = __builtin_amdgcn_readfirstlane(tid >> 6), lane = tid & 63, wr = wid >> 2, wc = wid & 3, fr = lane & 15, fq = lane >> 4;
    const int nt = K / BK;
    unsigned voffB[2];
#pragma unroll
    for (int i = 0; i < 2; ++i) { int R, C; stage_rc(tid * 16 + i * 8192, R, C); const int Rb = Epi::PERM ? ((R & ~31) + perm32(R & 31)) : R; voffB[i] = (unsigned)(Rb * K + C) * 2u; }
    const size_t kstep = (size_t)(BK * 2);
    const size_t hstep = (size_t)HALF * K * 2;
    const unsigned ldsw = (unsigned)wid * 1024u;
    const int aoff = lds_byte(wr * 64 + fr, fq * 8), boff = lds_byte(wc * 32 + fr, fq * 8);
#define PG8_SA(b, h) (((b) * 2 + (h)) * HTB)
#define PG8_SB(b, h) ((4 + (b) * 2 + (h)) * HTB)
#define PG8_STAGE(bufoff, gbase, voff) do { _Pragma("unroll") for (int _i = 0; _i < 2; ++_i) \
        __builtin_amdgcn_global_load_lds((const unsigned*)((const char*)(gbase) + (voff)[_i]), (LAS unsigned*)(lds + (bufoff) + ldsw + _i * 8192), 16, 0, 0); } while (0)
#define PG8_LDA(dst, b, h) do { _Pragma("unroll") for (int m = 0; m < 4; ++m) _Pragma("unroll") for (int k = 0; k < 2; ++k) dst[m][k] = *(const LAS bf16x8*)(lds + PG8_SA(b, h) + aoff + m * 2048 + k * 1024); } while (0)
#define PG8_LDB(dst, b, h) do { _Pragma("unroll") for (int n = 0; n < 2; ++n) _Pragma("unroll") for (int k = 0; k < 2; ++k) dst[n][k] = *(const LAS bf16x8*)(lds + PG8_SB(b, h) + boff + n * 2048 + k * 1024); } while (0)
#define PG8_MMA(ai, bj, At, Bt) do { __builtin_amdgcn_s_setprio(1); _Pragma("unroll") for (int m = 0; m < 4; ++m) _Pragma("unroll") for (int n = 0; n < 2; ++n) _Pragma("unroll") for (int k = 0; k < 2; ++k) \
        acc[ai][bj][m][n] = __builtin_amdgcn_mfma_f32_16x16x32_bf16(Bt[n][k], At[m][k], acc[ai][bj][m][n], 0, 0, 0); __builtin_amdgcn_s_setprio(0); } while (0)
#define PG8_WAIT_V(n) asm volatile("s_waitcnt vmcnt(" #n ")" ::: "memory")
#define PG8_WAIT_L(n) asm volatile("s_waitcnt lgkmcnt(" #n ")" ::: "memory")
#define PG8_BAR __builtin_amdgcn_s_barrier()
#define PG8_SCHED __builtin_amdgcn_sched_barrier(0)
#define PG8_AOFF(dst, u) do { _Pragma("unroll") for (int _i = 0; _i < 2; ++_i) { int _R, _C; stage_rc(tid * 16 + _i * 8192, _R, _C); _Pragma("unroll") for (int _h = 0; _h < 2; ++_h) \
        dst[_h][_i] = (unsigned)(((size_t)S.a_row(u, _h * HALF + _R) * K + _C) * 2u); } } while (0)
    Unit cur, nxt; int ui = 0;
    if (!S.next(0, cur)) return;
    f32x4 acc[2][2][4][2];
#pragma unroll
    for (int a = 0; a < 2; ++a)
#pragma unroll
        for (int b = 0; b < 2; ++b)
#pragma unroll
            for (int m = 0; m < 4; ++m)
#pragma unroll
                for (int n = 0; n < 2; ++n) acc[a][b][m][n] = (f32x4){0.f, 0.f, 0.f, 0.f};
    bf16x8 At[4][2], B0[2][2], B1[2][2];
    unsigned cao[2][2];
    PG8_AOFF(cao, cur);
    const char* cA = (const char*)Abase; const char* cB = (const char*)Btbase + (size_t)cur.brow * K * 2;
    PG8_STAGE(PG8_SB(0, 0), cB, voffB); PG8_STAGE(PG8_SB(0, 1), cB + hstep, voffB); PG8_STAGE(PG8_SA(0, 0), cA, cao[0]); PG8_STAGE(PG8_SA(0, 1), cA, cao[1]);
    if (wr == 1) PG8_BAR;
    PG8_WAIT_V(2); PG8_BAR;
    PG8_STAGE(PG8_SB(1, 0), cB + kstep, voffB); PG8_STAGE(PG8_SA(1, 0), cA + kstep, cao[0]); PG8_STAGE(PG8_SB(1, 1), cB + hstep + kstep, voffB);
    PG8_WAIT_V(6); PG8_BAR;
    for (;;) {
        const bool has_next = S.next(ui + 1, nxt);
        const char* nB = has_next ? (const char*)Btbase + (size_t)nxt.brow * K * 2 : cB;
        for (int t = 0; t < nt; t += 2) {
            const bool last = (t == nt - 2);
            const char* a1 = cA + (size_t)(t + 1) * kstep;
            const char* a2 = last ? cA : cA + (size_t)(t + 2) * kstep; const char* b2 = last ? nB : cB + (size_t)(t + 2) * kstep;
            const char* a3 = a2 + kstep; const char* b3 = b2 + kstep;
            PG8_LDB(B0, 0, 0); PG8_LDB(B1, 0, 1); PG8_SCHED; PG8_LDA(At, 0, 0); PG8_STAGE(PG8_SA(1, 1), a1, cao[1]);
            if (last && has_next) { PG8_AOFF(cao, nxt); }
            PG8_WAIT_V(8); PG8_WAIT_L(0); PG8_BAR; PG8_MMA(0, 0, At, B0); PG8_MMA(0, 1, At, B1); PG8_BAR; PG8_SCHED;
            PG8_LDA(At, 0, 1); PG8_STAGE(PG8_SB(0, 0), b2, voffB); PG8_STAGE(PG8_SB(0, 1), b2 + hstep, voffB); PG8_STAGE(PG8_SA(0, 0), a2, cao[0]);
            PG8_WAIT_V(8); PG8_WAIT_L(0); PG8_BAR; PG8_MMA(1, 0, At, B0); PG8_MMA(1, 1, At, B1); PG8_BAR; PG8_SCHED;
            PG8_LDB(B0, 1, 0); PG8_LDB(B1, 1, 1); PG8_SCHED; PG8_LDA(At, 1, 0); PG8_STAGE(PG8_SA(0, 1), a2, cao[1]);
            PG8_WAIT_V(8); PG8_WAIT_L(0); PG8_BAR; PG8_MMA(0, 0, At, B0); PG8_MMA(0, 1, At, B1); PG8_BAR; PG8_SCHED;
            PG8_LDA(At, 1, 1); PG8_STAGE(PG8_SB(1, 0), b3, voffB); PG8_STAGE(PG8_SB(1, 1), b3 + hstep, voffB); PG8_STAGE(PG8_SA(1, 0), a3, cao[0]);
            PG8_WAIT_V(8); PG8_WAIT_L(0); PG8_BAR; PG8_MMA(1, 0, At, B0); PG8_MMA(1, 1, At, B1); PG8_BAR; PG8_SCHED;
        }
        if (wr == 0) PG8_BAR;
        E(acc, cur, wr, wc, fr, fq);
        if (!has_next) break;
#pragma unroll
        for (int a = 0; a < 2; ++a)
#pragma unroll
            for (int b = 0; b < 2; ++b)
#pragma unroll
                for (int m = 0; m < 4; ++m)
#pragma unroll
                    for (int n = 0; n < 2; ++n) acc[a][b][m][n] = (f32x4){0.f, 0.f, 0.f, 0.f};
        cur = nxt; cB = nB; ++ui;
        if (wr == 1) PG8_BAR;
    }
    PG8_WAIT_V(0);
    PG8_BAR;
#undef PG8_SA
#undef PG8_SB
#undef PG8_STAGE
#undef PG8_LDA
#undef PG8_LDB
#undef PG8_MMA
#undef PG8_WAIT_V
#undef PG8_WAIT_L
#undef PG8_BAR
#undef PG8_SCHED
#undef PG8_AOFF
}
}

typedef f32x4 AccT[2][2][4][2];

struct EpiProj {
    static constexpr bool PERM = true;
    bf16_t* proj; float* gates; const float* bgate;
    __device__ __forceinline__ void operator()(const AccT& acc, const pg8::Unit& u, int wr, int wc, int fr, int fq) const {
        const int row0 = u.pm * 256 + wr * 64 + fr;
        if (u.pn < 12) {
            const int col0 = u.pn * 256 + wc * 32 + 8 * fq;
#pragma unroll
            for (int ai = 0; ai < 2; ++ai)
#pragma unroll
                for (int m = 0; m < 4; ++m) { bf16_t* rowp = proj + (size_t)(row0 + ai * 128 + m * 16) * PROJ_LD + col0;
#pragma unroll
                    for (int bj = 0; bj < 2; ++bj) { const f32x4 v0 = acc[ai][bj][m][0], v1 = acc[ai][bj][m][1];
                        u32x4 w; w.x = cvt_pk_bf16(v0[0], v0[1]); w.y = cvt_pk_bf16(v0[2], v0[3]); w.z = cvt_pk_bf16(v1[0], v1[1]); w.w = cvt_pk_bf16(v1[2], v1[3]);
                        *(u32x4*)(rowp + bj * 128) = w; } }
        } else if (wc == 0 && fq < 2) {
#pragma unroll
            for (int n = 0; n < 2; ++n) { const f32x4 bv = *(const f32x4*)(bgate + 8 * fq + 4 * n);
#pragma unroll
                for (int ai = 0; ai < 2; ++ai)
#pragma unroll
                    for (int m = 0; m < 4; ++m) *(f32x4*)(gates + (size_t)(row0 + ai * 128 + m * 16) * 16 + 8 * fq + 4 * n) = acc[ai][0][m][n] + bv; }
        }
    }
};
struct EpiRes {
    static constexpr bool PERM = false;
    float* H;
    __device__ __forceinline__ void operator()(const AccT& acc, const pg8::Unit& u, int wr, int wc, int fr, int fq) const {
        const int row0 = u.pm * 256 + wr * 64 + fr, col0 = u.pn * 256 + wc * 32 + 4 * fq;
#pragma unroll
        for (int ai = 0; ai < 2; ++ai)
#pragma unroll
            for (int m = 0; m < 4; ++m) { float* rowp = H + (size_t)(row0 + ai * 128 + m * 16) * D + col0;
#pragma unroll
                for (int bj = 0; bj < 2; ++bj)
#pragma unroll
                    for (int n = 0; n < 2; ++n) { float* p = rowp + bj * 128 + n * 16; const f32x4 h = *(const f32x4*)p; *(f32x4*)p = h * ALPHA + acc[ai][bj][m][n]; } }
    }
};
struct EpiSwiglu {
    static constexpr bool PERM = true;
    bf16_t* act; int ld;
    __device__ __forceinline__ static float silu_mul(float g, float u) { return g * u * __builtin_amdgcn_rcpf(1.0f + __builtin_amdgcn_exp2f(-g * 1.4426950408889634f)); }
    __device__ __forceinline__ void operator()(const AccT& acc, const pg8::Unit& u, int wr, int wc, int fr, int fq) const {
        const int row0 = u.pm * 256 + wr * 64 + fr, col0 = u.pn * 128 + wc * 32 + 8 * fq;
#pragma unroll
        for (int ai = 0; ai < 2; ++ai)
#pragma unroll
            for (int m = 0; m < 4; ++m) { const f32x4 g0 = acc[ai][0][m][0], g1 = acc[ai][0][m][1], u0 = acc[ai][1][m][0], u1 = acc[ai][1][m][1];
                u32x4 w; w.x = cvt_pk_bf16(silu_mul(g0[0], u0[0]), silu_mul(g0[1], u0[1])); w.y = cvt_pk_bf16(silu_mul(g0[2], u0[2]), silu_mul(g0[3], u0[3]));
                w.z = cvt_pk_bf16(silu_mul(g1[0], u1[0]), silu_mul(g1[1], u1[1])); w.w = cvt_pk_bf16(silu_mul(g1[2], u1[2]), silu_mul(g1[3], u1[3]));
                *(u32x4*)(act + (size_t)(row0 + ai * 128 + m * 16) * ld + col0) = w; }
    }
};
struct EpiScatter {
    static constexpr bool PERM = false;
    float* contrib; const int* rowdst; const float* rowgate;
    __device__ __forceinline__ void operator()(const AccT& acc, const pg8::Unit& u, int wr, int wc, int fr, int fq) const {
        const int row0 = u.pm * 256 + wr * 64 + fr, col0 = u.pn * 256 + wc * 32 + 4 * fq;
#pragma unroll
        for (int ai = 0; ai < 2; ++ai)
#pragma unroll
            for (int m = 0; m < 4; ++m) { const int pos = row0 + ai * 128 + m * 16; const int d = rowdst[pos];
                if (d >= 0) { const float g = rowgate[pos]; float* rowp = contrib + (size_t)d * D + col0;
#pragma unroll
                    for (int bj = 0; bj < 2; ++bj)
#pragma unroll
                        for (int n = 0; n < 2; ++n) *(f32x4*)(rowp + bj * 128 + n * 16) = acc[ai][bj][m][n] * g; } }
    }
};
struct EpiQKV {
    static constexpr bool PERM = true;
    bf16_t *Q, *KB, *VB; const float* rope;
    __device__ __forceinline__ void operator()(const AccT& acc, const pg8::Unit& u, int wr, int wc, int fr, int fq) const {
        const int row0 = u.pm * 256 + wr * 64 + fr, cl = wc * 32 + 8 * fq;
        bf16_t* base; int ld;
        if (u.pn < 4) { base = Q + u.pn * 256 + cl; ld = D; } else if (u.pn == 4) { base = KB + cl; ld = 256; } else { base = VB + cl; ld = 256; }
        const bool dorope = (u.pn <= 4) && ((wc & 1) == 0);
#pragma unroll
        for (int ai = 0; ai < 2; ++ai)
#pragma unroll
            for (int m = 0; m < 4; ++m) { const int row = row0 + ai * 128 + m * 16;
                f32x4 v[2][2];
#pragma unroll
                for (int bj = 0; bj < 2; ++bj)
#pragma unroll
                    for (int n = 0; n < 2; ++n) v[bj][n] = acc[ai][bj][m][n];
                if (dorope) {
                    int pos = row < MREAL ? (row & (SEQ - 1)) + NMETA : row - MREAL; pos = pos > SEQ + NMETA - 1 ? SEQ + NMETA - 1 : pos;
                    const float* rp = rope + (size_t)pos * 16;
                    const f32x4 c0 = *(const f32x4*)rp, c1 = *(const f32x4*)(rp + 4), s0 = *(const f32x4*)(rp + 8), s1 = *(const f32x4*)(rp + 12);
#pragma unroll
                    for (int bj = 0; bj < 2; ++bj)
#pragma unroll
                        for (int n = 0; n < 2; ++n) { const f32x4 c = n ? c1 : c0, s = n ? s1 : s0; f32x4 o;
#pragma unroll
                            for (int j = 0; j < 4; ++j) { const float x = v[bj][n][j]; const float y = __shfl_xor(x, 16);
                                o[j] = fq == 0 ? x * c[j] - y * s[j] : (fq == 1 ? x * c[j] + y * s[j] : x); }
                            v[bj][n] = o; }
                }
#pragma unroll
                for (int bj = 0; bj < 2; ++bj) { const f32x4 v0 = v[bj][0], v1 = v[bj][1];
                    u32x4 w; w.x = cvt_pk_bf16(v0[0], v0[1]); w.y = cvt_pk_bf16(v0[2], v0[3]); w.z = cvt_pk_bf16(v1[0], v1[1]); w.w = cvt_pk_bf16(v1[2], v1[3]);
                    *(u32x4*)(base + (size_t)row * ld + bj * 128) = w; } }
    }
};

struct Params { const float* in[18]; float* out; unsigned char* ws; int ph_lo, ph_hi, li, pad; };
enum { I_X = 0, I_META, I_WIN, I_BGATE, I_LNH, I_WOUT, I_WKV, I_WQ, I_SINKS, I_WO, I_WGUD, I_WDND, I_WROUTER, I_BROUTER, I_WGUE, I_WDNE, I_LNG, I_LNB };
constexpr int NWAVES = 8, NTHREADS = 512;

__device__ __forceinline__ void tr_item(const float* W, int Nsrc, int K, bf16_t* WT, int k0, int n0, int drow0, float scale, int nvalid, LAS float* scr, int lane) {
#pragma unroll 8
    for (int i = 0; i < 32; ++i) { const int kk = 2 * i + (lane >> 5), n = lane & 31; scr[kk * 33 + n] = (n < nvalid) ? W[(size_t)(k0 + kk) * Nsrc + n0 + n] * scale : 0.f; }
    LDS_WAIT(); asm volatile("" ::: "memory");
    const int c = lane & 7;
#pragma unroll
    for (int j = 0; j < 4; ++j) { const int n = (lane >> 3) + 8 * j; const LAS float* s = scr + (8 * c) * 33 + n;
        u32x4 o; o.x = pk2(s[0 * 33], s[1 * 33]); o.y = pk2(s[2 * 33], s[3 * 33]); o.z = pk2(s[4 * 33], s[5 * 33]); o.w = pk2(s[6 * 33], s[7 * 33]);
        if (n < nvalid) *(u32x4*)(WT + (size_t)(drow0 + n) * K + k0 + 8 * c) = o; }
    LDS_WAIT(); asm volatile("" ::: "memory");
}
__device__ __forceinline__ int pair_row(int n, int FF) { const int up = n >= FF ? 1 : 0, j = n - up * FF; return 256 * (j >> 7) + 128 * up + (j & 127); }

__device__ __forceinline__ void p0_prologue(const Params& P, LAS unsigned char* lds, int gw, int NGW, int wave, int lane) {
    unsigned char* ws = P.ws;
    LAS float* scr = (LAS float*)(lds + wave * 16384);
    constexpr int IT0 = 16 * 97, IT1 = 16 * 32, IT2 = 16 * 16, IT5 = 16 * 176, IT6 = 44 * 32, IT7 = 16 * 224, IT8 = 56 * 32;
    constexpr int C0 = 2 * IT0, C1 = C0 + 2 * IT1, C2 = C1 + IT2, C3 = C2 + 2 * IT1, C4 = C3 + 2 * IT1, C5 = C4 + 2 * IT5, C6 = C5 + 2 * IT6, C7 = C6 + 16 * IT7, C8 = C7 + 16 * IT8;
    for (int it = gw; it < C8; it += NGW) {
        if (it < C0) { const int mi = it / IT0, r = it % IT0, kb = r / 97, nb = r % 97; const int n0 = nb * 32;
            tr_item(P.in[I_WIN] + (size_t)mi * D * M_IN, M_IN, D, (bf16_t*)(ws + WS_WIN) + (size_t)mi * M_INP * D, kb * 64, n0, n0, n0 < 512 ? 0.125f : 1.f, nb == 96 ? 16 : 32, scr, lane);
        } else if (it < C1) { const int q = it - C0, mi = q / IT1, r = q % IT1, kb = r / 32, nb = r % 32;
            tr_item(P.in[I_WOUT] + (size_t)mi * D * D, D, D, (bf16_t*)(ws + WS_WOUT) + (size_t)mi * D * D, kb * 64, nb * 32, nb * 32, 1.f, 32, scr, lane);
        } else if (it < C2) { const int r = it - C1, kb = r / 16, nb = r % 16;
            tr_item(P.in[I_WKV], 512, D, (bf16_t*)(ws + WS_WQKV), kb * 64, nb * 32, 1024 + nb * 32, 1.f, 32, scr, lane);
        } else if (it < C3) { const int q = it - C2, mi = q / IT1, r = q % IT1, kb = r / 32, nb = r % 32;
            tr_item(P.in[I_WQ] + (size_t)mi * D * D, D, D, (bf16_t*)(ws + (mi ? WS_WQ3 : WS_WQKV)), kb * 64, nb * 32, nb * 32, 0.125f, 32, scr, lane);
        } else if (it < C4) { const int q = it - C3, mi = q / IT1, r = q % IT1, kb = r / 32, nb = r % 32;
            tr_item(P.in[I_WO] + (size_t)mi * D * D, D, D, (bf16_t*)(ws + WS_WO) + (size_t)mi * D * D, kb * 64, nb * 32, nb * 32, 1.f, 32, scr, lane);
        } else if (it < C5) { const int q = it - C4, mi = q / IT5, r = q % IT5, kb = r / 176, nb = r % 176;
            tr_item(P.in[I_WGUD] + (size_t)mi * D * 2 * D_FF, 2 * D_FF, D, (bf16_t*)(ws + WS_WGU) + (size_t)mi * 2 * D_FF * D, kb * 64, nb * 32, pair_row(nb * 32, D_FF), 1.f, 32, scr, lane);
        } else if (it < C6) { const int q = it - C5, mi = q / IT6, r = q % IT6, kb = r / 32, nb = r % 32;
            tr_item(P.in[I_WDND] + (size_t)mi * D_FF * D, D, D_FF, (bf16_t*)(ws + WS_WDN) + (size_t)mi * D * D_FF, kb * 64, nb * 32, nb * 32, 1.f, 32, scr, lane);
        } else if (it < C7) { const int q = it - C6, mi = q / IT7, r = q % IT7, kb = r / 224, nb = r % 224;
            tr_item(P.in[I_WGUE] + (size_t)mi * D * 2 * D_FF_EXP, 2 * D_FF_EXP, D, (bf16_t*)(ws + WS_WGUE) + (size_t)mi * 2 * D_FF_EXP * D, kb * 64, nb * 32, pair_row(nb * 32, D_FF_EXP), 1.f, 32, scr, lane);
        } else { const int q = it - C7, mi = q / IT8, r = q % IT8, kb = r / 32, nb = r % 32;
            tr_item(P.in[I_WDNE] + (size_t)mi * D_FF_EXP * D, D, D_FF_EXP, (bf16_t*)(ws + WS_WDNE) + (size_t)mi * D * D_FF_EXP, kb * 64, nb * 32, nb * 32, 1.f, 32, scr, lane);
        }
    }
    { float* sm = (float*)(ws + WS_SMALL); const int gt = gw * 64 + lane, NT = NGW * 64;
      for (int i = gt; i < SM_END; i += NT) { float v = 0.f;
          if (i < SM_SINKS) v = P.in[I_BGATE][i]; else if (i < SM_BROUTER) v = P.in[I_SINKS][i - SM_SINKS]; else if (i < SM_BROUTER + 16) v = P.in[I_BROUTER][i - SM_BROUTER];
          else if (i < SM_LNH) v = 0.f; else if (i < SM_LNG) v = P.in[I_LNH][i - SM_LNH]; else if (i < SM_LNB) v = P.in[I_LNG][i - SM_LNG]; else if (i < SM_WROUTER) v = P.in[I_LNB][i - SM_LNB]; else v = P.in[I_WROUTER][i - SM_WROUTER];
          sm[i] = v; } }
    { float* H = (float*)(ws + WS_H); bf16_t* HB = (bf16_t*)(ws + WS_HB);
      const size_t gt = (size_t)gw * 64 + lane, NT = (size_t)NGW * 64;
      for (size_t i = gt; i < (size_t)MV * (D / 4); i += NT) { const size_t row = i >> 8; const int c4 = (int)(i & 255);
          const f32x4 v = row < MREAL ? ((const f32x4*)P.in[I_X])[i] : ((const f32x4*)P.in[I_META])[(row - MREAL) * 256 + c4];
          ((f32x4*)H)[i] = v; u32x2 w; w.x = pk2(v[0], v[1]); w.y = pk2(v[2], v[3]); ((u32x2*)HB)[i] = w; }
      float* rope = (float*)(ws + WS_ROPE);
      for (size_t i = gt; i < (size_t)(SEQ + NMETA) * 8; i += NT) { const int pos = (int)(i >> 3), fi = (int)(i & 7);
          const double invf = fi == 0 ? 1.0 : fi == 1 ? 0.19392274474868576 : fi == 2 ? 0.03760603093086393 : fi == 3 ? 0.007292664737217109 : fi == 4 ? 0.001414213562373095
                            : fi == 5 ? 0.0002742481756762073 : fi == 6 ? 5.318295896944988e-05 : 1.031338537721246e-05;
          const float angf = (float)pos * (float)invf;
          double a = (double)angf; a -= 6.283185307179586476925 * __builtin_rint(a * 0.15915494309189533577); const double hx = 0.5 * a, h2 = hx * hx;
          double sp = 1.0, cp = 1.0;
#pragma unroll
          for (int k = 12; k >= 1; --k) { sp = 1.0 - sp * h2 / (double)((2 * k) * (2 * k + 1)); cp = 1.0 - cp * h2 / (double)((2 * k - 1) * (2 * k)); }
          const double sh = hx * sp, ch = cp;
          rope[(size_t)pos * 16 + fi] = (float)(1.0 - 2.0 * sh * sh); rope[(size_t)pos * 16 + 8 + fi] = (float)(2.0 * sh * ch); }
    }
}

__device__ __forceinline__ void ln_phase(unsigned char* ws, float* outp, LAS unsigned char* lds, int gw, int NGW, int lane, int tid,
                                         int lnidx, bool moe_src, bool router, int moe_idx, bool final) {
    const float* sm = (const float*)(ws + WS_SMALL);
    float* H = (float*)(ws + WS_H); bf16_t* HB = (bf16_t*)(ws + WS_HB); const float* contrib = (const float*)(ws + WS_CONTRIB);
    const float* lg = sm + SM_LNG + (size_t)lnidx * D; const float* lb = sm + SM_LNB + (size_t)lnidx * D;
    f32x4 gv[4], bv[4];
#pragma unroll
    for (int j = 0; j < 4; ++j) { gv[j] = *(const f32x4*)(lg + 256 * j + 4 * lane); bv[j] = *(const f32x4*)(lb + 256 * j + 4 * lane); }
    LAS float* wr = (LAS float*)lds;
    volatile LAS unsigned* misc = (volatile LAS unsigned*)(lds + MISC_OFF);
    if (router) {
        const float* src = sm + SM_WROUTER + (size_t)moe_idx * D * N_EXP;
        for (int i = tid; i < D * N_EXP / 4; i += NTHREADS) ((LAS f32x4*)wr)[i] = ((const f32x4*)src)[i];
        if (tid < 8) misc[16 + tid] = 0u;
        __syncthreads();
    }
    int* tope = (int*)(ws + WS_TOPE); float* topg = (float*)(ws + WS_TOPG);
    const float* br = sm + SM_BROUTER + moe_idx * N_EXP;
    for (int row = gw; row < MV; row += NGW) {
        f32x4 v[4];
        const f32x4* hr = (const f32x4*)(H + (size_t)row * D) + lane;
#pragma unroll
        for (int j = 0; j < 4; ++j) v[j] = hr[64 * j];
        if (moe_src) { const f32x4* c0 = (const f32x4*)(contrib + (size_t)(2 * row) * D) + lane; const f32x4* c1 = c0 + 256;
#pragma unroll
            for (int j = 0; j < 4; ++j) v[j] = v[j] * ALPHA + c0[64 * j] + c1[64 * j]; }
        float s = 0.f;
#pragma unroll
        for (int j = 0; j < 4; ++j) s += (v[j][0] + v[j][1]) + (v[j][2] + v[j][3]);
        const float mean = wave_sum(s) * (1.f / D); float s2 = 0.f;
#pragma unroll
        for (int j = 0; j < 4; ++j) { v[j] = v[j] - mean; s2 += (v[j][0] * v[j][0] + v[j][1] * v[j][1]) + (v[j][2] * v[j][2] + v[j][3] * v[j][3]); }
        const float rstd = 1.f / sqrtf(wave_sum(s2) * (1.f / D) + LN_EPS);
#pragma unroll
        for (int j = 0; j < 4; ++j) v[j] = v[j] * rstd * gv[j] + bv[j];
        if (final) { if (row < MREAL) { f32x4* o = (f32x4*)(outp + (size_t)row * D) + lane;
#pragma unroll
                for (int j = 0; j < 4; ++j) o[64 * j] = v[j]; } }
        else { f32x4* o = (f32x4*)(H + (size_t)row * D) + lane; u32x2* ob = (u32x2*)(HB + (size_t)row * D) + lane;
#pragma unroll
            for (int j = 0; j < 4; ++j) { o[64 * j] = v[j]; u32x2 w; w.x = pk2(v[j][0], v[j][1]); w.y = pk2(v[j][2], v[j][3]); ob[64 * j] = w; } }
        if (router) {
            float lg8[8];
#pragma unroll
            for (int e = 0; e < 8; ++e) lg8[e] = 0.f;
#pragma unroll
            for (int j = 0; j < 4; ++j)
#pragma unroll
                for (int c = 0; c < 4; ++c) { const LAS f32x4* w4 = (const LAS f32x4*)(wr + (size_t)(256 * j + 4 * lane + c) * 8); const f32x4 wa = w4[0], wb = w4[1]; const float x = v[j][c];
                    lg8[0] += x * wa[0]; lg8[1] += x * wa[1]; lg8[2] += x * wa[2]; lg8[3] += x * wa[3]; lg8[4] += x * wb[0]; lg8[5] += x * wb[1]; lg8[6] += x * wb[2]; lg8[7] += x * wb[3]; }
#pragma unroll
            for (int e = 0; e < 8; ++e) lg8[e] = wave_sum(lg8[e]) + br[e];
            int e1 = 0; float v1 = lg8[0];
#pragma unroll
            for (int e = 1; e < 8; ++e) if (lg8[e] > v1) { v1 = lg8[e]; e1 = e; }
            int e2 = -1; float v2 = -3.0e38f;
#pragma unroll
            for (int e = 0; e < 8; ++e) if (e != e1 && lg8[e] > v2) { v2 = lg8[e]; e2 = e; }
            const float ex = expf(v2 - v1), g1 = 1.f / (1.f + ex), g2 = ex / (1.f + ex);
            if (lane == 0) { tope[row] = e1 | (e2 << 8); topg[2 * row] = g1; topg[2 * row + 1] = g2;
                __hip_atomic_fetch_add((LAS unsigned*)&misc[16 + e1], 1u, __ATOMIC_RELAXED, __HIP_MEMORY_SCOPE_WORKGROUP);
                __hip_atomic_fetch_add((LAS unsigned*)&misc[16 + e2], 1u, __ATOMIC_RELAXED, __HIP_MEMORY_SCOPE_WORKGROUP); }
        }
    }
    if (router) { __syncthreads();
        if (tid < 8) __hip_atomic_fetch_add((unsigned*)(ws + WS_CTL) + CW_CNT + moe_idx * 64 + tid, misc[16 + tid], __ATOMIC_RELAXED, __HIP_MEMORY_SCOPE_AGENT);
        __syncthreads(); }
}

__device__ __forceinline__ void moe_starts(const unsigned char* ws, int moe_idx, int (&cnt)[8], int (&pstart)[9]) {
    const unsigned* c = (const unsigned*)(ws + WS_CTL) + CW_CNT + moe_idx * 64; int p = 0;
#pragma unroll
    for (int e = 0; e < 8; ++e) { cnt[e] = __builtin_amdgcn_readfirstlane((int)__hip_atomic_load(c + e, __ATOMIC_RELAXED, __HIP_MEMORY_SCOPE_AGENT)); pstart[e] = p; p += (cnt[e] + 255) >> 8; }
    pstart[8] = p;
}
__device__ __forceinline__ void assign_phase(unsigned char* ws, int gw, int NGW, int lane, int tid, int moe_idx) {
    int cnt[8], pstart[9]; moe_starts(ws, moe_idx, cnt, pstart);
    const int* tope = (const int*)(ws + WS_TOPE); const float* topg = (const float*)(ws + WS_TOPG);
    int* rowtok = (int*)(ws + WS_ROWTOK); int* rowdst = (int*)(ws + WS_ROWDST); float* rowgate = (float*)(ws + WS_ROWGATE);
    unsigned* cur = (unsigned*)(ws + WS_CTL) + CW_CUR + moe_idx * 64;
    for (int base = gw * 64; base < MV; base += NGW * 64) {
        const int row = base + lane; const bool valid = row < MV;
        const int te = valid ? tope[row] : 0xffff;
#pragma unroll
        for (int slot = 0; slot < 2; ++slot) {
            const int e = valid ? ((te >> (8 * slot)) & 255) : 255; int pos = -1;
#pragma unroll
            for (int ee = 0; ee < 8; ++ee) {
                const unsigned long long mask = __ballot(e == ee);
                if (mask) { const int n = __popcll(mask), leader = __ffsll((long long)mask) - 1; unsigned b0 = 0;
                    if (lane == leader) b0 = __hip_atomic_fetch_add(cur + ee, (unsigned)n, __ATOMIC_RELAXED, __HIP_MEMORY_SCOPE_AGENT);
                    b0 = __shfl(b0, leader);
                    if (e == ee) pos = pstart[ee] * 256 + (int)b0 + __popcll(mask & ((1ull << lane) - 1ull)); }
            }
            if (valid) { rowtok[pos] = row; rowdst[pos] = 2 * row + slot; rowgate[pos] = topg[2 * row + slot]; }
        }
    }
    if (blockIdx.x < 8) { const int e = blockIdx.x; int ps = 0, pe = 0, ce = 0;
#pragma unroll
        for (int ee = 0; ee < 8; ++ee) if (ee == e) { ps = pstart[ee]; pe = pstart[ee + 1]; ce = cnt[ee]; }
        for (int pos = ps * 256 + ce + tid; pos < pe * 256; pos += NTHREADS) { rowtok[pos] = -1; rowdst[pos] = -1; rowgate[pos] = 0.f; } }
}

constexpr int ML_RS = 72;
constexpr int ML_QS = 0, ML_KS = 9216, ML_KT = 18432, ML_PS = 27648, ML_VT = 36864, ML_CT = 57600, ML_HS = 78336, ML_SC = 112128;
constexpr int ML_HSS = 132;
__device__ __forceinline__ bf16x8 ml_frag(LAS unsigned char* lds, int base, int row, int kcol) { return *(const LAS bf16x8*)(lds + base + (row * ML_RS + kcol) * 2); }

template <int MODE>
__device__ __forceinline__ void mlstm_phase(unsigned char* ws, LAS unsigned char* lds, int layer, int tid, int wave, int lane) {
    const int item = blockIdx.x; const int bh = item >> 3, seg = item & 7, b = bh >> 3, h = bh & 7;
    if (MODE == 1 && seg == 7) return;
    const bf16_t* proj = (const bf16_t*)(ws + WS_PROJ); const float* gates = (const float*)(ws + WS_GATES);
    bf16_t* HG = (bf16_t*)(ws + WS_HG);
    float* STATE = (float*)(ws + WS_STATE); float* STSC = (float*)(ws + WS_STSC);
    LAS float* sc = (LAS float*)(lds + ML_SC);
    const int fr = lane & 15, quad = lane >> 4;
    f32x4 st[5]; float zero = 0.f; asm volatile("; opaque zero" : "+v"(zero));
#pragma unroll
    for (int i = 0; i < 5; ++i) st[i] = (f32x4){zero, zero, zero, zero};
    float m0 = (MODE == 1) ? -1.0e30f : 0.f, gsum = 0.f;
    for (int i = tid; i < 16 * ML_RS; i += NTHREADS) ((LAS bf16_t*)(lds + ML_VT))[128 * ML_RS + i] = (i < ML_RS) ? (bf16_t)0x3F80 : (bf16_t)0;
    if (MODE == 2 && seg > 0) {
        m0 = -1.0e30f;
        for (int s2 = 0; s2 < seg; ++s2) {
            const float ms = STSC[(bh * 7 + s2) * 4 + 0], Gs = STSC[(bh * 7 + s2) * 4 + 1];
            const float mn = fmaxf(Gs + m0, ms), fo = fast_exp(Gs + m0 - mn), fn = fast_exp(ms - mn);
            const f32x4* sp = (const f32x4*)(STATE + (size_t)(bh * 7 + s2) * ST_FLOATS) + (wave * 5) * 64 + lane;
#pragma unroll
            for (int i = 0; i < 5; ++i) st[i] = st[i] * fo + sp[i * 64] * fn;
            m0 = mn;
        }
    }
#pragma unroll
    for (int i = 0; i < 5; ++i) { const int dv = (i < 4) ? 16 * wave + fr : 128 + fr, dk = (i < 4) ? 16 * i + 4 * quad : 16 * wave + 4 * quad;
        if (i < 4 || wave < 4) { u32x2 w; w.x = pk2(st[i][0], st[i][1]); w.y = pk2(st[i][2], st[i][3]); *(LAS u32x2*)(lds + ML_CT + (dv * ML_RS + dk) * 2) = w; } }
    float lnh[16];
    if (MODE == 2) {
#pragma unroll
        for (int e = 0; e < 16; ++e) lnh[e] = ((const float*)(ws + WS_SMALL))[SM_LNH + layer * D + h * M_V + 16 * (tid & 7) + e]; }
    const int nch = SEG_CHUNKS + (seg == 0 ? 1 : 0);
    u32x4 rq, rk, rv0, rv1; float rli = 0.f, rlf = 0.f;
    auto chunk_rows = [&](int ci, int& rbase, int& nv) { if (seg == 0 && ci == 0) { rbase = MREAL; nv = NMETA; } else { const int c = seg * SEG_CHUNKS + ci - (seg == 0 ? 1 : 0); rbase = b * SEQ + c * 64; nv = 64; } };
    auto load_chunk = [&](int ci) {
        int rbase, nv; chunk_rows(ci, rbase, nv);
        { const int j = tid >> 3, c8 = (tid & 7) * 8; const bool ok = j < nv; const bf16_t* rp = proj + (size_t)(rbase + j) * PROJ_LD + h * 64 + c8;
          rq = (MODE == 2 && ok) ? *(const u32x4*)rp : (u32x4){0u, 0u, 0u, 0u}; rk = ok ? *(const u32x4*)(rp + 512) : (u32x4){0u, 0u, 0u, 0u}; }
        { const int j0 = tid >> 4, c8 = (tid & 15) * 8; const bf16_t* rp = proj + (size_t)(rbase + j0) * PROJ_LD + 1024 + h * 128 + c8;
          rv0 = (j0 < nv) ? *(const u32x4*)rp : (u32x4){0u, 0u, 0u, 0u}; rv1 = (j0 + 32 < nv) ? *(const u32x4*)(rp + (size_t)32 * PROJ_LD) : (u32x4){0u, 0u, 0u, 0u}; }
        if (tid < 64) { const bool ok = tid < nv; rli = ok ? gates[(size_t)(rbase + tid) * 16 + h] : -1.0e30f; rlf = ok ? gates[(size_t)(rbase + tid) * 16 + 8 + h] : 1.0e30f; }
    };
    load_chunk(0);
    __syncthreads();
    for (int ci = 0; ci < nch; ++ci) {
        int rbase, nv; chunk_rows(ci, rbase, nv);
        { const int j = tid >> 3, c8 = (tid & 7) * 8;
          if (MODE == 2) *(LAS u32x4*)(lds + ML_QS + (j * ML_RS + c8) * 2) = rq;
          *(LAS u32x4*)(lds + ML_KS + (j * ML_RS + c8) * 2) = rk; }
        { const int j0 = tid >> 4, c8 = (tid & 15) * 8; LAS bf16_t* vt = (LAS bf16_t*)(lds + ML_VT);
          const unsigned a[4] = {rv0.x, rv0.y, rv0.z, rv0.w}, c[4] = {rv1.x, rv1.y, rv1.z, rv1.w};
#pragma unroll
          for (int e = 0; e < 4; ++e) { vt[(c8 + 2 * e) * ML_RS + j0] = (bf16_t)(a[e] & 0xffffu); vt[(c8 + 2 * e + 1) * ML_RS + j0] = (bf16_t)(a[e] >> 16);
              vt[(c8 + 2 * e) * ML_RS + j0 + 32] = (bf16_t)(c[e] & 0xffffu); vt[(c8 + 2 * e + 1) * ML_RS + j0 + 32] = (bf16_t)(c[e] >> 16); } }
        if (wave == 0) {
            const float li = rli, f = rlf;
            const float lf = (f > 1.0e29f) ? 0.f : (fminf(f, 0.f) - logf(1.f + expf(-fabsf(f))));
            float bc = lf;
#pragma unroll
            for (int o = 1; o < 64; o <<= 1) { const float t = __shfl_up(bc, o); if (lane >= o) bc += t; }
            const float u = li - bc; float pm = u;
#pragma unroll
            for (int o = 1; o < 64; o <<= 1) { const float t = __shfl_up(pm, o); if (lane >= o) pm = fmaxf(pm, t); }
            const float blast = __shfl(bc, 63), umax = __shfl(pm, 63);
            const float MM = fmaxf(pm, m0), amax = blast + umax, mn = fmaxf(blast + m0, amax);
            const float sold = fast_exp(blast + m0 - mn), snew = fast_exp(amax - mn);
            sc[lane] = u; sc[64 + lane] = MM; sc[128 + lane] = fast_exp(m0 - MM); sc[192 + lane] = fast_exp(-(bc + MM)); sc[256 + lane] = snew * fast_exp(u - umax);
            if (lane == 0) { sc[384] = sold; sc[385] = mn; sc[386] = blast; }
        }
        __syncthreads();
        if (ci + 1 < nch) load_chunk(ci + 1);
        m0 = sc[385]; gsum += sc[386];
        const float sold = sc[384];
        { const int j = tid >> 3, c8 = (tid & 7) * 8; const u32x4 kv = *(const LAS u32x4*)(lds + ML_KS + (j * ML_RS + c8) * 2); const float wj = sc[256 + j];
          const unsigned a[4] = {kv.x, kv.y, kv.z, kv.w}; LAS bf16_t* kt = (LAS bf16_t*)(lds + ML_KT);
#pragma unroll
          for (int e = 0; e < 4; ++e) { kt[(c8 + 2 * e) * ML_RS + j] = (bf16_t)f2bf(bf2f((unsigned short)(a[e] & 0xffffu)) * wj); kt[(c8 + 2 * e + 1) * ML_RS + j] = (bf16_t)f2bf(bf2f((unsigned short)(a[e] >> 16)) * wj); } }
        if (MODE == 2) {
            const int mt = wave >> 1;
#pragma unroll
            for (int q = 0; q < 2; ++q) { const int nt = 2 * (wave & 1) + q; f32x4 s = (f32x4){0.f, 0.f, 0.f, 0.f};
                if (nt <= mt) {
#pragma unroll
                    for (int ks = 0; ks < 2; ++ks) s = __builtin_amdgcn_mfma_f32_16x16x32_bf16(ml_frag(lds, ML_QS, 16 * mt + fr, 32 * ks + 8 * quad), ml_frag(lds, ML_KS, 16 * nt + fr, 32 * ks + 8 * quad), s, 0, 0, 0); }
                const int j = 16 * nt + fr; const float uj = sc[j];
#pragma unroll
                for (int r = 0; r < 4; ++r) { const int i = 16 * mt + 4 * quad + r; const float p = (j <= i) ? s[r] * fast_exp(uj - sc[64 + i]) : 0.f;
                    ((LAS bf16_t*)(lds + ML_PS))[i * ML_RS + j] = (bf16_t)f2bf(p); } }
        }
        __syncthreads();
        f32x4 o1[4], o2[4];
        if (MODE == 2) {
            bf16x8 vb[2], cb[2];
#pragma unroll
            for (int ks = 0; ks < 2; ++ks) { vb[ks] = ml_frag(lds, ML_VT, 16 * wave + fr, 32 * ks + 8 * quad); cb[ks] = ml_frag(lds, ML_CT, 16 * wave + fr, 32 * ks + 8 * quad); }
#pragma unroll
            for (int mt = 0; mt < 4; ++mt) { o1[mt] = (f32x4){0.f, 0.f, 0.f, 0.f}; o2[mt] = (f32x4){0.f, 0.f, 0.f, 0.f};
#pragma unroll
                for (int ks = 0; ks < 2; ++ks) { o1[mt] = __builtin_amdgcn_mfma_f32_16x16x32_bf16(ml_frag(lds, ML_PS, 16 * mt + fr, 32 * ks + 8 * quad), vb[ks], o1[mt], 0, 0, 0);
                    o2[mt] = __builtin_amdgcn_mfma_f32_16x16x32_bf16(ml_frag(lds, ML_QS, 16 * mt + fr, 32 * ks + 8 * quad), cb[ks], o2[mt], 0, 0, 0); } }
            if (wave < 4) { f32x4 d1 = (f32x4){0.f, 0.f, 0.f, 0.f}, d2 = (f32x4){0.f, 0.f, 0.f, 0.f};
#pragma unroll
                for (int ks = 0; ks < 2; ++ks) { d1 = __builtin_amdgcn_mfma_f32_16x16x32_bf16(ml_frag(lds, ML_PS, 16 * wave + fr, 32 * ks + 8 * quad), ml_frag(lds, ML_VT, 128 + fr, 32 * ks + 8 * quad), d1, 0, 0, 0);
                    d2 = __builtin_amdgcn_mfma_f32_16x16x32_bf16(ml_frag(lds, ML_QS, 16 * wave + fr, 32 * ks + 8 * quad), ml_frag(lds, ML_CT, 128 + fr, 32 * ks + 8 * quad), d2, 0, 0, 0); }
                if (fr == 0) {
#pragma unroll
                    for (int r = 0; r < 4; ++r) { const int i = 16 * wave + 4 * quad + r; sc[320 + i] = d1[r] + sc[128 + i] * d2[r]; } } }
            __syncthreads();
        }
        if (MODE == 2) {
#pragma unroll
            for (int mt = 0; mt < 4; ++mt)
#pragma unroll
                for (int r = 0; r < 4; ++r) { const int i = 16 * mt + 4 * quad + r; const float num = o1[mt][r] + sc[128 + i] * o2[mt][r];
                    ((LAS float*)(lds + ML_HS))[i * ML_HSS + 16 * wave + fr] = num / fmaxf(fabsf(sc[320 + i]), sc[192 + i]); }
        }
        { bf16x8 vb[2];
#pragma unroll
          for (int ks = 0; ks < 2; ++ks) vb[ks] = ml_frag(lds, ML_VT, 16 * wave + fr, 32 * ks + 8 * quad);
#pragma unroll
          for (int mt = 0; mt < 4; ++mt) { st[mt] = st[mt] * sold;
#pragma unroll
              for (int ks = 0; ks < 2; ++ks) st[mt] = __builtin_amdgcn_mfma_f32_16x16x32_bf16(ml_frag(lds, ML_KT, 16 * mt + fr, 32 * ks + 8 * quad), vb[ks], st[mt], 0, 0, 0); }
          if (wave < 4) { st[4] = st[4] * sold;
#pragma unroll
              for (int ks = 0; ks < 2; ++ks) st[4] = __builtin_amdgcn_mfma_f32_16x16x32_bf16(ml_frag(lds, ML_KT, 16 * wave + fr, 32 * ks + 8 * quad), ml_frag(lds, ML_VT, 128 + fr, 32 * ks + 8 * quad), st[4], 0, 0, 0); }
          if (MODE == 2) {
#pragma unroll
              for (int i = 0; i < 5; ++i) { const int dv = (i < 4) ? 16 * wave + fr : 128 + fr, dk = (i < 4) ? 16 * i + 4 * quad : 16 * wave + 4 * quad;
                  if (i < 4 || wave < 4) { u32x2 w; w.x = pk2(st[i][0], st[i][1]); w.y = pk2(st[i][2], st[i][3]); *(LAS u32x2*)(lds + ML_CT + (dv * ML_RS + dk) * 2) = w; } } }
        }
        __syncthreads();
        if (MODE == 2) {
            const int i = tid >> 3, sg = tid & 7; const LAS float* hp = (const LAS float*)(lds + ML_HS) + i * ML_HSS + 16 * sg;
            float x[16]; float s = 0.f;
#pragma unroll
            for (int e = 0; e < 16; ++e) { x[e] = hp[e]; s += x[e]; }
            s += __shfl_xor(s, 1); s += __shfl_xor(s, 2); s += __shfl_xor(s, 4);
            const float mean = s * (1.f / M_V); float q = 0.f;
#pragma unroll
            for (int e = 0; e < 16; ++e) { x[e] -= mean; q += x[e] * x[e]; }
            q += __shfl_xor(q, 1); q += __shfl_xor(q, 2); q += __shfl_xor(q, 4);
            const float rstd = 1.f / sqrtf(q * (1.f / M_V) + LN_EPS);
            if (i < nv && (nv == 64 || b == 0)) {
                const size_t row = (size_t)(rbase + i);
                const u32x4* ogp = (const u32x4*)(proj + row * PROJ_LD + 2048 + h * M_V + 16 * sg); const u32x4 g0 = ogp[0], g1 = ogp[1];
                const unsigned gw8[8] = {g0.x, g0.y, g0.z, g0.w, g1.x, g1.y, g1.z, g1.w}; unsigned ow[8];
#pragma unroll
                for (int e = 0; e < 8; ++e) { const float oga = bf2f((unsigned short)(gw8[e] & 0xffffu)), ogb = bf2f((unsigned short)(gw8[e] >> 16));
                    const float ya = x[2 * e] * rstd * lnh[2 * e] / (1.f + fast_exp(-oga)), yb = x[2 * e + 1] * rstd * lnh[2 * e + 1] / (1.f + fast_exp(-ogb));
                    ow[e] = pk2(ya, yb); }
                u32x4* op = (u32x4*)(HG + row * D + h * M_V + 16 * sg);
                op[0] = (u32x4){ow[0], ow[1], ow[2], ow[3]}; op[1] = (u32x4){ow[4], ow[5], ow[6], ow[7]};
            }
        }
    }
    if (MODE == 1) {
        f32x4* sp = (f32x4*)(STATE + (size_t)(bh * 7 + seg) * ST_FLOATS) + (wave * 5) * 64 + lane;
#pragma unroll
        for (int i = 0; i < 5; ++i) sp[i * 64] = (i < 4 || wave < 4) ? st[i] : (f32x4){0.f, 0.f, 0.f, 0.f};
        if (tid == 0) { STSC[(bh * 7 + seg) * 4 + 0] = m0; STSC[(bh * 7 + seg) * 4 + 1] = gsum; }
    }
}

constexpr int AT_KRS = 72, AT_VRS = 296, AT_NK = 272;
constexpr int AT_KS = 0, AT_VT = AT_NK * AT_KRS * 2, AT_PS = AT_VT + 64 * AT_VRS * 2, AT_PSW = 16 * AT_VRS * 2;
static_assert(AT_PS + 8 * AT_PSW <= MISC_OFF, "attention LDS");
__device__ __forceinline__ void attn_phase(unsigned char* ws, LAS unsigned char* lds, int j_layer, int tid, int wave, int lane) {
    const bf16_t* Q = (const bf16_t*)(ws + WS_PROJ); const bf16_t* KB = (const bf16_t*)(ws + WS_KB); const bf16_t* VB = (const bf16_t*)(ws + WS_VB);
    bf16_t* HG = (bf16_t*)(ws + WS_HG);
    const float* sinks = (const float*)(ws + WS_SMALL) + SM_SINKS + j_layer * A_HEADS;
    const int fr = lane & 15, quad = lane >> 4;
    LAS bf16_t* ks = (LAS bf16_t*)(lds + AT_KS); LAS bf16_t* vt = (LAS bf16_t*)(lds + AT_VT); LAS bf16_t* ps = (LAS bf16_t*)(lds + AT_PS + wave * AT_PSW);
    for (int i = tid; i < 64 * 24; i += NTHREADS) vt[(i / 24) * AT_VRS + AT_NK + (i % 24)] = 0;
    for (int i = lane; i < 16 * 24; i += 64) ps[(i / 24) * AT_VRS + AT_NK + (i % 24)] = 0;
    for (int it = blockIdx.x; it < NBATCH * A_KV * (SEQ / WINDOW); it += gridDim.x) {
        const int b = it >> 8, g = (it >> 6) & 3, blk = it & 63;
        __syncthreads();
        for (int p = tid; p < AT_NK * 8; p += NTHREADS) { const int kk = p >> 3, c8 = (p & 7) * 8;
            int row; if (kk < 16) row = MREAL + kk; else { const int tk = (blk - 1) * WINDOW + (kk - 16); row = tk < 0 ? -1 : b * SEQ + tk; }
            u32x4 kv = (u32x4){0u, 0u, 0u, 0u}, vv = (u32x4){0u, 0u, 0u, 0u};
            if (row >= 0) { kv = *(const u32x4*)(KB + (size_t)row * 256 + g * 64 + c8); vv = *(const u32x4*)(VB + (size_t)row * 256 + g * 64 + c8); }
            *(LAS u32x4*)(ks + kk * AT_KRS + c8) = kv;
            const unsigned a[4] = {vv.x, vv.y, vv.z, vv.w};
#pragma unroll
            for (int e = 0; e < 4; ++e) { vt[(c8 + 2 * e) * AT_VRS + kk] = (bf16_t)(a[e] & 0xffffu); vt[(c8 + 2 * e + 1) * AT_VRS + kk] = (bf16_t)(a[e] >> 16); } }
        __syncthreads();
        const int qh = g * 4 + (wave >> 1); const float sink = sinks[qh];
        for (int mt = 0; mt < 4; ++mt) {
            const int qi0 = 64 * (wave & 1) + 16 * mt; const size_t rowq = (size_t)b * SEQ + blk * WINDOW + qi0;
            bf16x8 qf[2];
#pragma unroll
            for (int k2 = 0; k2 < 2; ++k2) qf[k2] = *(const bf16x8*)(Q + (rowq + fr) * D + qh * 64 + 32 * k2 + 8 * quad);
            f32x4 s[17];
#pragma unroll
            for (int nt = 0; nt < 17; ++nt) { s[nt] = (f32x4){0.f, 0.f, 0.f, 0.f};
#pragma unroll
                for (int k2 = 0; k2 < 2; ++k2) s[nt] = __builtin_amdgcn_mfma_f32_16x16x32_bf16(qf[k2], *(const LAS bf16x8*)(ks + (16 * nt + fr) * AT_KRS + 32 * k2 + 8 * quad), s[nt], 0, 0, 0); }
            float mx[4], sum[4], inv[4];
#pragma unroll
            for (int r = 0; r < 4; ++r) { const int qi = qi0 + 4 * quad + r; float m = -1.0e30f;
#pragma unroll
                for (int nt = 0; nt < 17; ++nt) { bool vis = true;
                    if (nt > 0) { const int j = 16 * nt + fr - 16, rel = qi + WINDOW - j; vis = (rel >= 0) && (rel < WINDOW) && (blk > 0 || j >= WINDOW); }
                    s[nt][r] = vis ? s[nt][r] : -1.0e30f; m = fmaxf(m, s[nt][r]); }
                m = fmaxf(m, __shfl_xor(m, 1)); m = fmaxf(m, __shfl_xor(m, 2)); m = fmaxf(m, __shfl_xor(m, 4)); m = fmaxf(m, __shfl_xor(m, 8));
                m = fmaxf(m, sink); mx[r] = m; float sm = 0.f;
#pragma unroll
                for (int nt = 0; nt < 17; ++nt) { const float p = fast_exp(s[nt][r] - m); s[nt][r] = p; sm += p; }
                sm += __shfl_xor(sm, 1); sm += __shfl_xor(sm, 2); sm += __shfl_xor(sm, 4); sm += __shfl_xor(sm, 8);
                sum[r] = sm; inv[r] = 1.f / (sm + fast_exp(sink - m)); }
#pragma unroll
            for (int nt = 0; nt < 17; ++nt)
#pragma unroll
                for (int r = 0; r < 4; ++r) ps[(4 * quad + r) * AT_VRS + 16 * nt + fr] = (bf16_t)f2bf(s[nt][r]);
            f32x4 o[4];
#pragma unroll
            for (int nd = 0; nd < 4; ++nd) o[nd] = (f32x4){0.f, 0.f, 0.f, 0.f};
#pragma unroll
            for (int k2 = 0; k2 < 9; ++k2) { const bf16x8 pf = *(const LAS bf16x8*)(ps + fr * AT_VRS + 32 * k2 + 8 * quad);
#pragma unroll
                for (int nd = 0; nd < 4; ++nd) o[nd] = __builtin_amdgcn_mfma_f32_16x16x32_bf16(pf, *(const LAS bf16x8*)(vt + (16 * nd + fr) * AT_VRS + 32 * k2 + 8 * quad), o[nd], 0, 0, 0); }
#pragma unroll
            for (int nd = 0; nd < 4; ++nd)
#pragma unroll
                for (int r = 0; r < 4; ++r) HG[(rowq + 4 * quad + r) * D + qh * 64 + 16 * nd + fr] = (bf16_t)f2bf(o[nd][r] * inv[r]);
        }
    }
    if (blockIdx.x == gridDim.x - 1 && tid < 256) {
        const int qm = tid >> 4, head = tid & 15, g = head >> 2; const float sink = sinks[head];
        const bf16_t* qp = Q + (size_t)(MREAL + qm) * D + head * 64;
        float sv[16]; float m = sink;
#pragma unroll
        for (int kk = 0; kk < 16; ++kk) { float d = 0.f; const bf16_t* kp = KB + (size_t)(MREAL + kk) * 256 + g * 64;
            for (int c = 0; c < 64; ++c) d += bf2f(qp[c]) * bf2f(kp[c]);
            sv[kk] = (kk <= qm) ? d : -1.0e30f; m = fmaxf(m, sv[kk]); }
        float den = fast_exp(sink - m);
#pragma unroll
        for (int kk = 0; kk < 16; ++kk) { sv[kk] = (kk <= qm) ? fast_exp(sv[kk] - m) : 0.f; den += sv[kk]; }
        const float invd = 1.f / den;
        for (int c = 0; c < 64; ++c) { float a = 0.f;
#pragma unroll
            for (int kk = 0; kk < 16; ++kk) a += sv[kk] * bf2f(VB[(size_t)(MREAL + kk) * 256 + g * 64 + c]);
            HG[(size_t)(MREAL + qm) * D + head * 64 + c] = (bf16_t)f2bf(a * invd); }
    }
}

#ifndef SITES
#define SITES 0xFFFF
#endif
#define SITE(n) ((SITES >> (n)) & 1)
#ifndef MK_PER_PHASE
#define MK_PER_PHASE 0
#endif
constexpr int PH_PER_LAYER = 12, N_PHASES = 1 + 4 * PH_PER_LAYER;

__global__ void __launch_bounds__(NTHREADS, 2) fwd(Params P) {
    extern __shared__ __attribute__((aligned(16))) unsigned char lds_raw[];
    LAS unsigned char* const lds0 = (LAS unsigned char*)lds_raw;
    const int G = gridDim.x;
    const int vcu = (G % 8 == 0) ? ((int)blockIdx.x % 8) * (G / 8) + (int)blockIdx.x / 8 : (int)blockIdx.x;
    const int NGW = G * NWAVES;
    unsigned char* const wsbase = P.ws;
    volatile LAS unsigned* misc = (volatile LAS unsigned*)(lds0 + MISC_OFF);
    if (threadIdx.x < 64) misc[threadIdx.x] = 0u;
    __syncthreads();
    XcdBarrier bar = xcd_barrier_post((unsigned*)(wsbase + WS_CTL) + CW_BAR + P.li * 4096, misc + 8);
    const int lo = P.ph_lo, hi = P.ph_hi;
#define RUN(idx) ((idx) >= lo && (idx) < hi)
#define SEAM(idx) do { if ((idx) + 1 < hi) xcd_barrier(bar); } while (0)
#define IDS() int tid = threadIdx.x; asm volatile("; opaque tid" : "+v"(tid)); unsigned char* ws = wsbase; asm volatile("; opaque ws" : "+s"(ws)); \
              LAS unsigned char* lds = lds0; asm volatile("; opaque lds" : "+s"(lds)); \
              const int lane = tid & 63, wave = __builtin_amdgcn_readfirstlane(tid >> 6); const int gw = vcu * NWAVES + wave; (void)lane; (void)gw; (void)ws

    if (SITE(0) && RUN(0)) { IDS(); p0_prologue(P, lds, gw, NGW, wave, lane); SEAM(0); }

    for (int l = 0; l < 4; ++l) {
        const int pb = 1 + l * PH_PER_LAYER;
        const bool moe = (l & 1) != 0; const int fi = l >> 1;
        if (l < 2) {
            if (SITE(1) && RUN(pb + 0)) {
                IDS();
                pg8::DenseOrder S; S.init(MP / 256, M_INP / 256, G, (int)blockIdx.x);
                EpiProj E{(bf16_t*)(ws + WS_PROJ), (float*)(ws + WS_GATES), (const float*)(ws + WS_SMALL) + SM_BGATE + l * 16};
                pg8::gemm_phase(lds, (const bf16_t*)(ws + WS_HB), (const bf16_t*)(ws + WS_WIN) + (size_t)l * M_INP * D, D, S, E);
                SEAM(pb + 0); }
            if (SITE(2) && RUN(pb + 1)) { IDS(); mlstm_phase<1>(ws, lds, l, tid, wave, lane); SEAM(pb + 1); }
            if (SITE(3) && RUN(pb + 2)) { IDS(); mlstm_phase<2>(ws, lds, l, tid, wave, lane); SEAM(pb + 2); }
        } else {
            if (SITE(4) && RUN(pb + 0)) {
                IDS();
                pg8::DenseOrder S; S.init(MP / 256, l == 2 ? 6 : 4, G, (int)blockIdx.x);
                EpiQKV E{(bf16_t*)(ws + WS_PROJ), (bf16_t*)(ws + WS_KB), (bf16_t*)(ws + WS_VB), (const float*)(ws + WS_ROPE)};
                pg8::gemm_phase(lds, (const bf16_t*)(ws + WS_HB), (const bf16_t*)(ws + (l == 2 ? WS_WQKV : WS_WQ3)), D, S, E);
                SEAM(pb + 0); }
            if (SITE(5) && RUN(pb + 1)) { IDS(); attn_phase(ws, lds, l - 2, tid, wave, lane); SEAM(pb + 1); }
        }
        if (SITE(6) && RUN(pb + 3)) {
            IDS();
            pg8::DenseOrder S; S.init(MP / 256, 4, G, (int)blockIdx.x);
            EpiRes E{(float*)(ws + WS_H)};
            pg8::gemm_phase(lds, (const bf16_t*)(ws + WS_HG), (const bf16_t*)(ws + (l < 2 ? WS_WOUT : WS_WO)) + (size_t)(l & 1) * D * D, D, S, E);
            SEAM(pb + 3); }
        if (SITE(7) && RUN(pb + 4)) { IDS(); ln_phase(ws, nullptr, lds, gw, NGW, lane, tid, l * 2 + 0, false, moe, fi, false); SEAM(pb + 4); }
        if (!moe) {
            if (SITE(8) && RUN(pb + 5)) {
                IDS();
                pg8::DenseOrder S; S.init(MP / 256, 2 * D_FF / 256, G, (int)blockIdx.x);
                EpiSwiglu E{(bf16_t*)(ws + WS_ACT), D_FF};
                pg8::gemm_phase(lds, (const bf16_t*)(ws + WS_HB), (const bf16_t*)(ws + WS_WGU) + (size_t)fi * 2 * D_FF * D, D, S, E);
                SEAM(pb + 5); }
            if (SITE(9) && RUN(pb + 6)) {
                IDS();
                pg8::DenseOrder S; S.init(MP / 256, 4, G, (int)blockIdx.x);
                EpiRes E{(float*)(ws + WS_H)};
                pg8::gemm_phase(lds, (const bf16_t*)(ws + WS_ACT), (const bf16_t*)(ws + WS_WDN) + (size_t)fi * D * D_FF, D_FF, S, E);
                SEAM(pb + 6); }
        } else {
            if (SITE(10) && RUN(pb + 5)) { IDS(); assign_phase(ws, gw, NGW, lane, tid, fi); SEAM(pb + 5); }
            if (SITE(11) && RUN(pb + 6)) {
                IDS();
                int cnt[8]; pg8::GroupedOrder S; moe_starts(ws, fi, cnt, S.pstart);
                S.o.init(S.pstart[8], 2 * D_FF_EXP / 256, G, (int)blockIdx.x); S.nexp_rows = 2 * D_FF_EXP; S.rowtok = (const int*)(ws + WS_ROWTOK);
                EpiSwiglu E{(bf16_t*)(ws + WS_ACT), D_FF_EXP};
                pg8::gemm_phase(lds, (const bf16_t*)(ws + WS_HB), (const bf16_t*)(ws + WS_WGUE) + (size_t)fi * 8 * 2 * D_FF_EXP * D, D, S, E);
                SEAM(pb + 6); }
            if (SITE(12) && RUN(pb + 7)) {
                IDS();
                int cnt[8]; pg8::GroupedOrder S; moe_starts(ws, fi, cnt, S.pstart);
                S.o.init(S.pstart[8], 4, G, (int)blockIdx.x); S.nexp_rows = D; S.rowtok = nullptr;
                EpiScatter E{(float*)(ws + WS_CONTRIB), (const int*)(ws + WS_ROWDST), (const float*)(ws + WS_ROWGATE)};
                pg8::gemm_phase(lds, (const bf16_t*)(ws + WS_ACT), (const bf16_t*)(ws + WS_WDNE) + (size_t)fi * 8 * D * D_FF_EXP, D_FF_EXP, S, E);
                SEAM(pb + 7); }
        }
        if (SITE(13) && RUN(pb + 10)) { IDS(); ln_phase(ws, P.out, lds, gw, NGW, lane, tid, l * 2 + 1, moe, false, 0, l == 3); SEAM(pb + 10); }
    }
#undef RUN
#undef SEAM
#undef IDS
}

extern "C" void kernel_launch(void* const* d_in, const int* in_sizes, int n_in, void* d_out, int out_size, void* d_ws, size_t ws_size, hipStream_t stream) {
    static int grid = 0;
    if (grid == 0) {
        if (n_in != 18 || out_size != MREAL * D || ws_size < WS_END) { fprintf(stderr, "kernel_launch: unexpected shapes (n_in %d, out %d, ws %zu < %zu)\n", n_in, out_size, ws_size, (size_t)WS_END); grid = -1; return; }
        int dev = 0, cus = 0, per_cu = 0;
        if (hipGetDevice(&dev) != hipSuccess || hipDeviceGetAttribute(&cus, hipDeviceAttributeMultiprocessorCount, dev) != hipSuccess) { grid = -1; return; }
        if (hipFuncSetAttribute((const void*)fwd, hipFuncAttributeMaxDynamicSharedMemorySize, LDS_BYTES) != hipSuccess) { fprintf(stderr, "kernel_launch: hipFuncSetAttribute failed\n"); grid = -1; return; }
        if (hipOccupancyMaxActiveBlocksPerMultiprocessor(&per_cu, (const void*)fwd, NTHREADS, LDS_BYTES) != hipSuccess || per_cu < 1) fprintf(stderr, "kernel_launch: occupancy query reports %d\n", per_cu);
        (void)hipGetLastError();
        grid = cus > 256 ? 256 : cus;
    }
    if (grid < 0) return;
    (void)in_sizes;
    if (hipMemsetAsync((char*)d_ws + WS_CTL, 0, CTL_BYTES, stream) != hipSuccess) return;
    Params p{};
    for (int i = 0; i < 18; ++i) p.in[i] = (const float*)d_in[i];
    p.out = (float*)d_out; p.ws = (unsigned char*)d_ws;
#if MK_PER_PHASE
    int li = 0;
    for (int ph = 0; ph < N_PHASES; ++ph) {
        const int k = (ph - 1) % PH_PER_LAYER, l = (ph - 1) / PH_PER_LAYER;
        if (ph > 0) { const bool moe = l & 1; if (k == 2 && l >= 2) continue; if (k == 8 || k == 9 || k == 11) continue; if (k == 7 && !moe) continue; }
        p.ph_lo = ph; p.ph_hi = ph + 1; p.li = li++; p.pad = 0;
        hipLaunchKernelGGL(fwd, dim3(grid), dim3(NTHREADS), LDS_BYTES, stream, p);
    }
#else
    p.ph_lo = 0; p.ph_hi = N_PHASES; p.li = 0; p.pad = 0;
    hipLaunchKernelGGL(fwd, dim3(grid), dim3(NTHREADS), LDS_BYTES, stream, p);
#endif
}
```

```cpp
#include <hip/hip_runtime.h>
#include <cstdio>
#include <cstdint>

#define LAS __attribute__((address_space(3)))
#define GAS __attribute__((address_space(1)))
typedef unsigned short bf16_t;
typedef short bf16x8 __attribute__((ext_vector_type(8)));
typedef float f32x4 __attribute__((ext_vector_type(4)));
typedef float f32x2 __attribute__((ext_vector_type(2)));
typedef unsigned u32x4 __attribute__((ext_vector_type(4)));
typedef unsigned u32x2 __attribute__((ext_vector_type(2)));

constexpr int D = 1024, NBATCH = 4, SEQ = 8192, NMETA = 16;
constexpr int MREAL = NBATCH * SEQ;
constexpr int MV = MREAL + NMETA;
constexpr int MP = 129 * 256;
constexpr int M_HEADS = 8, M_QK = 64, M_V = 128;
constexpr int M_IN = 3088, M_INP = 3328;
constexpr int PROJ_LD = 3072;
constexpr int A_HEADS = 16, A_KV = 4, A_HD = 64, WINDOW = 128;
constexpr int D_FF = 2816, N_EXP = 8, D_FF_EXP = 3584;
constexpr float ALPHA = 1.681792830507429f;
constexpr float LN_EPS = 1e-5f;
constexpr int RP = 265 * 256;
constexpr int NSEG = 8, SEG_CHUNKS = 16;
constexpr int ST_FLOATS = 8 * 5 * 64 * 4;

constexpr size_t MiB = 1u << 20;
constexpr size_t al(size_t x) { return (x + 4095) & ~(size_t)4095; }
constexpr size_t WS_CTL = 0, CTL_BYTES = 1 * MiB;
constexpr size_t WS_WIN = WS_CTL + CTL_BYTES;
constexpr size_t WS_WOUT = WS_WIN + al((size_t)2 * M_INP * D * 2);
constexpr size_t WS_WQKV = WS_WOUT + al((size_t)2 * D * D * 2);
constexpr size_t WS_WQ3 = WS_WQKV + al((size_t)1536 * D * 2);
constexpr size_t WS_WO = WS_WQ3 + al((size_t)D * D * 2);
constexpr size_t WS_WGU = WS_WO + al((size_t)2 * D * D * 2);
constexpr size_t WS_WDN = WS_WGU + al((size_t)2 * 2 * D_FF * D * 2);
constexpr size_t WS_WGUE = WS_WDN + al((size_t)2 * D * D_FF * 2);
constexpr size_t WS_WDNE = WS_WGUE + al((size_t)16 * 2 * D_FF_EXP * D * 2);
constexpr size_t WS_H = WS_WDNE + al((size_t)16 * D * D_FF_EXP * 2);
constexpr size_t WS_HB = WS_H + al((size_t)MP * D * 4);
constexpr size_t WS_PROJ = WS_HB + al((size_t)MP * D * 2);
constexpr size_t WS_HG = WS_PROJ + (size_t)MP * PROJ_LD * 2;
constexpr size_t WS_CONTRIB = WS_PROJ;
constexpr size_t WS_KB = WS_HG + al((size_t)MP * D * 2);
constexpr size_t WS_VB = WS_KB + al((size_t)MP * 256 * 2);
constexpr size_t WS_GATES = WS_VB + al((size_t)MP * 256 * 2);
constexpr size_t WS_ACT = WS_GATES + al((size_t)MP * 16 * 4);
constexpr size_t WS_STATE = WS_ACT + al((size_t)RP * D_FF_EXP * 2);
constexpr size_t WS_STSC = WS_STATE + al((size_t)32 * 7 * ST_FLOATS * 4);
constexpr size_t WS_ROPE = WS_STSC + al((size_t)32 * 7 * 4 * 4);
constexpr size_t WS_TOPE = WS_ROPE + al((size_t)8208 * 16 * 4);
constexpr size_t WS_TOPG = WS_TOPE + al((size_t)MP * 4);
constexpr size_t WS_ROWTOK = WS_TOPG + al((size_t)MP * 8);
constexpr size_t WS_ROWDST = WS_ROWTOK + al((size_t)RP * 4);
constexpr size_t WS_ROWGATE = WS_ROWDST + al((size_t)RP * 4);
constexpr size_t WS_SMALL = WS_ROWGATE + al((size_t)RP * 4);
constexpr int SM_BGATE = 0, SM_SINKS = 32, SM_BROUTER = 64, SM_LNH = 128, SM_LNG = SM_LNH + 2 * D, SM_LNB = SM_LNG + 8 * D, SM_WROUTER = SM_LNB + 8 * D, SM_END = SM_WROUTER + 2 * D * N_EXP;
constexpr size_t WS_END = WS_SMALL + al((size_t)SM_END * 4);
static_assert((size_t)MP * 2 * D * 4 <= (WS_KB - WS_PROJ), "contrib overlay fits PROJ+HG");

constexpr int CW_CNT = 1024;
constexpr int CW_CUR = 1024 + 256;
constexpr int CW_BAR = 16384;

constexpr int LDS_BYTES = 163840 - 512;
constexpr int RING_BYTES = 131072;
constexpr int MISC_OFF = LDS_BYTES - 256;

__device__ __forceinline__ unsigned f2bf(float f) { unsigned u = __builtin_bit_cast(unsigned, f); return (u + 0x7fffu + ((u >> 16) & 1u)) >> 16; }
__device__ __forceinline__ unsigned pk2(float lo, float hi) { return f2bf(lo) | (f2bf(hi) << 16); }
__device__ __forceinline__ unsigned cvt_pk_bf16(float lo, float hi) { unsigned r; asm volatile("v_cvt_pk_bf16_f32 %0, %1, %2" : "=v"(r) : "v"(lo), "v"(hi)); return r; }
__device__ __forceinline__ float bf2f(unsigned short b) { return __builtin_bit_cast(float, ((unsigned)b) << 16); }
__device__ __forceinline__ float wave_sum(float v) {
#pragma unroll
    for (int o = 1; o < 64; o <<= 1) v += __shfl_xor(v, o);
    return v;
}
__device__ __forceinline__ float fast_exp(float x) { return __builtin_amdgcn_exp2f(x * 1.4426950408889634f); }
#define LDS_WAIT() asm volatile("s_waitcnt lgkmcnt(0)" ::: "memory")
#define VM_WAIT() asm volatile("s_waitcnt vmcnt(0)" ::: "memory")

#define XB_TMO      128
#define XB_XCNT(j)  (256  + 64 * (j))
#define XB_XSUB(j)  (1280 + 64 * (j))
#define XB_XGEN(j)  (2304 + 64 * (j))
#define XB_TOP      3328
#define XB_TOPGEN   3392
#define XCD_BAR_WORDS 3456
#define XB_SPIN_CAP (1u << 18)
__device__ __forceinline__ unsigned xb_ld(unsigned* p)              { return __hip_atomic_load(p, __ATOMIC_RELAXED, __HIP_MEMORY_SCOPE_AGENT); }
__device__ __forceinline__ unsigned xb_add(unsigned* p, unsigned v) { return __hip_atomic_fetch_add(p, v, __ATOMIC_RELAXED, __HIP_MEMORY_SCOPE_AGENT); }
__device__ __forceinline__ unsigned xb_xcc_id() { return (unsigned)__builtin_amdgcn_s_getreg((3 << 11) | 20) & 0xFu; }
#define XB_SPIN(cond, bar) do { unsigned _sp = 0; while (cond) { __builtin_amdgcn_s_sleep(1); \
    if ((++_sp & 255u) == 0u) { if (xb_ld(&(bar)[XB_TMO])) break; if (_sp > XB_SPIN_CAP) { atomicAdd(&(bar)[XB_TMO], 1u); break; } } } } while (0)
struct XcdBarrier { unsigned* bar; unsigned x; volatile LAS unsigned* st; };
__device__ __forceinline__ XcdBarrier xcd_barrier_post(unsigned* bar, volatile LAS unsigned* st) {
    XcdBarrier b; b.bar = bar; b.x = xb_xcc_id(); b.st = st;
    if (threadIdx.x == 0) (void)xb_add(&bar[XB_XCNT(b.x)], 1u);
    return b;
}
__device__ __forceinline__ void xcd_barrier_complete(unsigned* bar, unsigned x, unsigned& nloc, unsigned& nx) {
    const unsigned G = gridDim.x * gridDim.y * gridDim.z;
    unsigned sum, cnt, mine, sp = 0u;
    for (;;) {
        sum = 0u; cnt = 0u; mine = 0u;
#pragma unroll
        for (unsigned j = 0; j < 16; ++j) { const unsigned c = xb_ld(&bar[XB_XCNT(j)]); sum += c; cnt += (c > 0u) ? 1u : 0u; mine = (j == x) ? c : mine; }
        if (sum == G) break;
        __builtin_amdgcn_s_sleep(1);
        if ((++sp & 255u) == 0u) { if (xb_ld(&bar[XB_TMO])) break; if (sp > XB_SPIN_CAP) { atomicAdd(&bar[XB_TMO], 1u); break; } }
    }
    nloc = mine > 0u ? mine : 1u; nx = cnt > 0u ? cnt : 1u;
}
__device__ __forceinline__ void xcd_barrier(const XcdBarrier& b) {
    asm volatile("s_waitcnt vmcnt(0)" ::: "memory");
    __syncthreads();
    if (threadIdx.x == 0) {
        unsigned* bar = b.bar;
        __builtin_amdgcn_s_waitcnt(0);
        unsigned nloc = b.st[0], nx = b.st[1];
        if (nloc == 0u) { xcd_barrier_complete(bar, b.x, nloc, nx); b.st[0] = nloc; b.st[1] = nx; }
        const unsigned old = xb_add(&bar[XB_XSUB(b.x)], 1u);
        const unsigned gen = old / nloc;
        if (old + 1u == (gen + 1u) * nloc) {
            __builtin_amdgcn_fence(__ATOMIC_RELEASE, "agent");
            asm volatile("s_waitcnt vmcnt(0)" ::: "memory");
            const unsigned og = xb_add(&bar[XB_TOP], 1u);
            const unsigned tg = og / nx;
            if (og + 1u == (tg + 1u) * nx) xb_add(&bar[XB_TOPGEN], 1u);
            else XB_SPIN(xb_ld(&bar[XB_TOPGEN]) == tg, bar);
            __builtin_amdgcn_fence(__ATOMIC_ACQUIRE, "agent");
            xb_add(&bar[XB_XGEN(b.x)], 1u);
            asm volatile("s_waitcnt vmcnt(0)" ::: "memory");
        } else {
            XB_SPIN(xb_ld(&bar[XB_XGEN(b.x)]) == gen, bar);
            __builtin_amdgcn_fence(__ATOMIC_ACQUIRE, "agent");
            asm volatile("s_waitcnt vmcnt(0)" ::: "memory");
        }
    }
    __syncthreads();
}

namespace pg8 {
constexpr int BM = 256, BK = 64, HALF = 128, HTB = HALF * BK * 2, STAGE_BYTES = 8 * HTB, NXCD = 8, WGM = 8;
__host__ __device__ __forceinline__ int lds_byte(int r, int c) { const int st = (r >> 4) * 2 + (c >> 5), rr = r & 15, cc = c & 31, ob = rr * 64 + cc * 2; return st * 1024 + (ob ^ (((ob >> 9) & 1) << 5)); }
__host__ __device__ __forceinline__ void stage_rc(int b, int& R, int& C) { const int st = b / 1024, sb = b % 1024, swz = sb ^ (((sb >> 9) & 1) << 5); R = (st >> 1) * 16 + swz / 64; C = (st & 1) * 32 + (swz % 64) / 2; }
__host__ __device__ __forceinline__ int perm32(int rho) { const int n = rho >> 4, i = rho & 15; return 8 * (i >> 2) + 4 * n + (i & 3); }

struct Unit { int pm, pn, brow; };

struct DenseOrder {
    int nM, nN, nwg, G, c;
    __device__ void init(int nM_, int nN_, int G_, int c_) { nM = nM_; nN = nN_; nwg = nM * nN; G = G_; c = c_; }
    __device__ __forceinline__ bool next(int i, Unit& u) const {
        const long L = (long)i * G + c; if (L >= nwg) return false;
        int wgid = (int)L; { const int q = nwg / NXCD, r = nwg % NXCD, xcd = wgid % NXCD, off = wgid / NXCD; wgid = (xcd < r ? xcd * (q + 1) : r * (q + 1) + (xcd - r) * q) + off; }
        const int nig = WGM * nN, gid = wgid / nig, fm = gid * WGM, gsz = (nM - fm) < WGM ? (nM - fm) : WGM;
        u.pm = fm + ((wgid % nig) % gsz); u.pn = (wgid % nig) / gsz; u.brow = u.pn * BM; return true;
    }
    __device__ __forceinline__ int a_row(const Unit& u, int r) const { return u.pm * BM + r; }
};
struct GroupedOrder {
    DenseOrder o; int pstart[9]; int nexp_rows;
    const int* rowtok;
    __device__ __forceinline__ bool next(int i, Unit& u) const {
        if (!o.next(i, u)) return false;
        int e = 0;
#pragma unroll
        for (int k = 1; k < 8; ++k) e += (u.pm >= pstart[k]) ? 1 : 0;
        u.brow = e * nexp_rows + u.pn * BM; return true;
    }
    __device__ __forceinline__ int a_row(const Unit& u, int r) const {
        const int pos = u.pm * BM + r; if (!rowtok) return pos;
        const int t = rowtok[pos]; return t < 0 ? 0 : t;
    }
};

template <class Epi, class Sched>
__device__ __forceinline__ void gemm_phase(LAS unsigned char* lds, const bf16_t* Abase, const bf16_t* Btbase, const int K, const Sched& S, const Epi& E) {
    int tid = threadIdx.x; asm volatile("; opaque tid" : "+v"(tid));
    const int wid = __builtin_amdgcn_readfirstlane(tid >> 6), lane = tid & 63, wr = wid >> 2, wc = wid & 3, fr = lane & 15, fq = lane >> 4;
    const int nt = K / BK;
    unsigned voffB[2];
#pragma unroll
    for (int i = 0; i < 2; ++i) { int R, C; stage_rc(tid * 16 + i * 8192, R, C); const int Rb = Epi::PERM ? ((R & ~31) + perm32(R & 31)) : R; voffB[i] = (unsigned)(Rb * K + C) * 2u; }
    const size_t kstep = (size_t)(BK * 2);
    const size_t hstep = (size_t)HALF * K * 2;
    const unsigned ldsw = (unsigned)wid * 1024u;
    const int aoff = lds_byte(wr * 64 + fr, fq * 8), boff = lds_byte(wc * 32 + fr, fq * 8);
#define PG8_SA(b, h) (((b) * 2 + (h)) * HTB)
#define PG8_SB(b, h) ((4 + (b) * 2 + (h)) * HTB)
#define PG8_STAGE(bufoff, gbase, voff) do { _Pragma("unroll") for (int _i = 0; _i < 2; ++_i) \
        __builtin_amdgcn_global_load_lds((const unsigned*)((const char*)(gbase) + (voff)[_i]), (LAS unsigned*)(lds + (bufoff) + ldsw + _i * 8192), 16, 0, 0); } while (0)
#define PG8_LDA(dst, b, h) do { _Pragma("unroll") for (int m = 0; m < 4; ++m) _Pragma("unroll") for (int k = 0; k < 2; ++k) dst[m][k] = *(const LAS bf16x8*)(lds + PG8_SA(b, h) + aoff + m * 2048 + k * 1024); } while (0)
#define PG8_LDB(dst, b, h) do { _Pragma("unroll") for (int n = 0; n < 2; ++n) _Pragma("unroll") for (int k = 0; k < 2; ++k) dst[n][k] = *(const LAS bf16x8*)(lds + PG8_SB(b, h) + boff + n * 2048 + k * 1024); } while (0)
#define PG8_MMA(ai, bj, At, Bt) do { __builtin_amdgcn_s_setprio(1); _Pragma("unroll") for (int m = 0; m < 4; ++m) _Pragma("unroll") for (int n = 0; n < 2; ++n) _Pragma("unroll") for (int k = 0; k < 2; ++k) \
        acc[ai][bj][m][n] = __builtin_amdgcn_mfma_f32_16x16x32_bf16(Bt[n][k], At[m][k], acc[ai][bj][m][n], 0, 0, 0); __builtin_amdgcn_s_setprio(0); } while (0)
#define PG8_WAIT_V(n) asm volatile("s_waitcnt vmcnt(" #n ")" ::: "memory")
#define PG8_WAIT_L(n) asm volatile("s_waitcnt lgkmcnt(" #n ")" ::: "memory")
#define PG8_BAR __builtin_amdgcn_s_barrier()
#define PG8_SCHED __builtin_amdgcn_sched_barrier(0)
#define PG8_AOFF(dst, u) do { _Pragma("unroll") for (int _i = 0; _i < 2; ++_i) { int _R, _C; stage_rc(tid * 16 + _i * 8192, _R, _C); _Pragma("unroll") for (int _h = 0; _h < 2; ++_h) \
        dst[_h][_i] = (unsigned)(((size_t)S.a_row(u, _h * HALF + _R) * K + _C) * 2u); } } while (0)
    Unit cur, nxt; int ui = 0;
    if (!S.next(0, cur)) return;
    f32x4 acc[2][2][4][2];
#pragma unroll
    for (int a = 0; a < 2; ++a)
#pragma unroll
        for (int b = 0; b < 2; ++b)
#pragma unroll
            for (int m = 0; m < 4; ++m)
#pragma unroll
                for (int n = 0; n < 2; ++n) acc[a][b][m][n] = (f32x4){0.f, 0.f, 0.f, 0.f};
    bf16x8 At[4][2], B0[2][2], B1[2][2];
    unsigned cao[2][2];
    PG8_AOFF(cao, cur);
    const char* cA = (const char*)Abase; const char* cB = (const char*)Btbase + (size_t)cur.brow * K * 2;
    PG8_STAGE(PG8_SB(0, 0), cB, voffB); PG8_STAGE(PG8_SB(0, 1), cB + hstep, voffB); PG8_STAGE(PG8_SA(0, 0), cA, cao[0]); PG8_STAGE(PG8_SA(0, 1), cA, cao[1]);
    if (wr == 1) PG8_BAR;
    PG8_WAIT_V(2); PG8_BAR;
    PG8_STAGE(PG8_SB(1, 0), cB + kstep, voffB); PG8_STAGE(PG8_SA(1, 0), cA + kstep, cao[0]); PG8_STAGE(PG8_SB(1, 1), cB + hstep + kstep, voffB);
    PG8_WAIT_V(6); PG8_BAR;
    for (;;) {
        const bool has_next = S.next(ui + 1, nxt);
        const char* nB = has_next ? (const char*)Btbase + (size_t)nxt.brow * K * 2 : cB;
        for (int t = 0; t < nt; t += 2) {
            const bool last = (t == nt - 2);
            const char* a1 = cA + (size_t)(t + 1) * kstep;
            const char* a2 = last ? cA : cA + (size_t)(t + 2) * kstep; const char* b2 = last ? nB : cB + (size_t)(t + 2) * kstep;
            const char* a3 = a2 + kstep; const char* b3 = b2 + kstep;
            PG8_LDB(B0, 0, 0); PG8_LDB(B1, 0, 1); PG8_SCHED; PG8_LDA(At, 0, 0); PG8_STAGE(PG8_SA(1, 1), a1, cao[1]);
            if (last && has_next) { PG8_AOFF(cao, nxt); }
            PG8_WAIT_V(8); PG8_WAIT_L(0); PG8_BAR; PG8_MMA(0, 0, At, B0); PG8_MMA(0, 1, At, B1); PG8_BAR; PG8_SCHED;
            PG8_LDA(At, 0, 1); PG8_STAGE(PG8_SB(0, 0), b2, voffB); PG8_STAGE(PG8_SB(0, 1), b2 + hstep, voffB); PG8_STAGE(PG8_SA(0, 0), a2, cao[0]);
            PG8_WAIT_V(8); PG8_WAIT_L(0); PG8_BAR; PG8_MMA(1, 0, At, B0); PG8_MMA(1, 1, At, B1); PG8_BAR; PG8_SCHED;
            PG8_LDB(B0, 1, 0); PG8_LDB(B1, 1, 1); PG8_SCHED; PG8_LDA(At, 1, 0); PG8_STAGE(PG8_SA(0, 1), a2, cao[1]);
            PG8_WAIT_V(8); PG8_WAIT_L(0); PG8_BAR; PG8_MMA(0, 0, At, B0); PG8_MMA(0, 1, At, B1); PG8_BAR; PG8_SCHED;
            PG8_LDA(At, 1, 1); PG8_STAGE(PG8_SB(1, 0), b3, voffB); PG8_STAGE(PG8_SB(1, 1), b3 + hstep, voffB); PG8_STAGE(PG8_SA(1, 0), a3, cao[0]);
            PG8_WAIT_V(8); PG8_WAIT_L(0); PG8_BAR; PG8_MMA(1, 0, At, B0); PG8_MMA(1, 1, At, B1); PG8_BAR; PG8_SCHED;
        }
        if (wr == 0) PG8_BAR;
        E(acc, cur, wr, wc, fr, fq);
        if (!has_next) break;
#pragma unroll
        for (int a = 0; a < 2; ++a)
#pragma unroll
            for (int b = 0; b < 2; ++b)
#pragma unroll
                for (int m = 0; m < 4; ++m)
#pragma unroll
                    for (int n = 0; n < 2; ++n) acc[a][b][m][n] = (f32x4){0.f, 0.f, 0.f, 0.f};
        cur = nxt; cB = nB; ++ui;
        if (wr == 1) PG8_BAR;
    }
    PG8_WAIT_V(0);
    PG8_BAR;
#undef PG8_SA
#undef PG8_SB
#undef PG8_STAGE
#undef PG8_LDA
#undef PG8_LDB
#undef PG8_MMA
#undef PG8_WAIT_V
#undef PG8_WAIT_L
#undef PG8_BAR
#undef PG8_SCHED
#undef PG8_AOFF
}
}

typedef f32x4 AccT[2][2][4][2];

struct EpiProj {
    static constexpr bool PERM = true;
    bf16_t* proj; float* gates; const float* bgate;
    __device__ __forceinline__ void operator()(const AccT& acc, const pg8::Unit& u, int wr, int wc, int fr, int fq) const {
        const int row0 = u.pm * 256 + wr * 64 + fr;
        if (u.pn < 12) {
            const int col0 = u.pn * 256 + wc * 32 + 8 * fq;
#pragma unroll
            for (int ai = 0; ai < 2; ++ai)
#pragma unroll
                for (int m = 0; m < 4; ++m) { bf16_t* rowp = proj + (size_t)(row0 + ai * 128 + m * 16) * PROJ_LD + col0;
#pragma unroll
                    for (int bj = 0; bj < 2; ++bj) { const f32x4 v0 = acc[ai][bj][m][0], v1 = acc[ai][bj][m][1];
                        u32x4 w; w.x = cvt_pk_bf16(v0[0], v0[1]); w.y = cvt_pk_bf16(v0[2], v0[3]); w.z = cvt_pk_bf16(v1[0], v1[1]); w.w = cvt_pk_bf16(v1[2], v1[3]);
                        *(u32x4*)(rowp + bj * 128) = w; } }
        } else if (wc == 0 && fq < 2) {
#pragma unroll
            for (int n = 0; n < 2; ++n) { const f32x4 bv = *(const f32x4*)(bgate + 8 * fq + 4 * n);
#pragma unroll
                for (int ai = 0; ai < 2; ++ai)
#pragma unroll
                    for (int m = 0; m < 4; ++m) *(f32x4*)(gates + (size_t)(row0 + ai * 128 + m * 16) * 16 + 8 * fq + 4 * n) = acc[ai][0][m][n] + bv; }
        }
    }
};
struct EpiRes {
    static constexpr bool PERM = false;
    float* H;
    __device__ __forceinline__ void operator()(const AccT& acc, const pg8::Unit& u, int wr, int wc, int fr, int fq) const {
        const int row0 = u.pm * 256 + wr * 64 + fr, col0 = u.pn * 256 + wc * 32 + 4 * fq;
#pragma unroll
        for (int ai = 0; ai < 2; ++ai)
#pragma unroll
            for (int m = 0; m < 4; ++m) { float* rowp = H + (size_t)(row0 + ai * 128 + m * 16) * D + col0;
#pragma unroll
                for (int bj = 0; bj < 2; ++bj)
#pragma unroll
                    for (int n = 0; n < 2; ++n) { float* p = rowp + bj * 128 + n * 16; const f32x4 h = *(const f32x4*)p; *(f32x4*)p = h * ALPHA + acc[ai][bj][m][n]; } }
    }
};
struct EpiSwiglu {
    static constexpr bool PERM = true;
    bf16_t* act; int ld;
    __device__ __forceinline__ static float silu_mul(float g, float u) { return g * u * __builtin_amdgcn_rcpf(1.0f + __builtin_amdgcn_exp2f(-g * 1.4426950408889634f)); }
    __device__ __forceinline__ void operator()(const AccT& acc, const pg8::Unit& u, int wr, int wc, int fr, int fq) const {
        const int row0 = u.pm * 256 + wr * 64 + fr, col0 = u.pn * 128 + wc * 32 + 8 * fq;
#pragma unroll
        for (int ai = 0; ai < 2; ++ai)
#pragma unroll
            for (int m = 0; m < 4; ++m) { const f32x4 g0 = acc[ai][0][m][0], g1 = acc[ai][0][m][1], u0 = acc[ai][1][m][0], u1 = acc[ai][1][m][1];
                u32x4 w; w.x = cvt_pk_bf16(silu_mul(g0[0], u0[0]), silu_mul(g0[1], u0[1])); w.y = cvt_pk_bf16(silu_mul(g0[2], u0[2]), silu_mul(g0[3], u0[3]));
                w.z = cvt_pk_bf16(silu_mul(g1[0], u1[0]), silu_mul(g1[1], u1[1])); w.w = cvt_pk_bf16(silu_mul(g1[2], u1[2]), silu_mul(g1[3], u1[3]));
                *(u32x4*)(act + (size_t)(row0 + ai * 128 + m * 16) * ld + col0) = w; }
    }
};
struct EpiScatter {
    static constexpr bool PERM = false;
    float* contrib; const int* rowdst; const float* rowgate;
    __device__ __forceinline__ void operator()(const AccT& acc, const pg8::Unit& u, int wr, int wc, int fr, int fq) const {
        const int row0 = u.pm * 256 + wr * 64 + fr, col0 = u.pn * 256 + wc * 32 + 4 * fq;
#pragma unroll
        for (int ai = 0; ai < 2; ++ai)
#pragma unroll
            for (int m = 0; m < 4; ++m) { const int pos = row0 + ai * 128 + m * 16; const int d = rowdst[pos];
                if (d >= 0) { const float g = rowgate[pos]; float* rowp = contrib + (size_t)d * D + col0;
#pragma unroll
                    for (int bj = 0; bj < 2; ++bj)
#pragma unroll
                        for (int n = 0; n < 2; ++n) *(f32x4*)(rowp + bj * 128 + n * 16) = acc[ai][bj][m][n] * g; } }
    }
};
struct EpiQKV {
    static constexpr bool PERM = true;
    bf16_t *Q, *KB, *VB; const float* rope;
    __device__ __forceinline__ void operator()(const AccT& acc, const pg8::Unit& u, int wr, int wc, int fr, int fq) const {
        const int row0 = u.pm * 256 + wr * 64 + fr, cl = wc * 32 + 8 * fq;
        bf16_t* base; int ld;
        if (u.pn == 5) {
#pragma unroll
            for (int ai = 0; ai < 2; ++ai)
#pragma unroll
                for (int m = 0; m < 4; ++m) { const int row = row0 + ai * 128 + m * 16;
#pragma unroll
                    for (int bj = 0; bj < 2; ++bj)
#pragma unroll
                        for (int n = 0; n < 2; ++n)
#pragma unroll
                            for (int j = 0; j < 4; ++j) VB[(size_t)(bj * 128 + cl + 4 * n + j) * MP + row] = (bf16_t)f2bf(acc[ai][bj][m][n][j]); }
            return; }
        if (u.pn < 4) { base = Q + u.pn * 256 + cl; ld = D; } else { base = KB + cl; ld = 256; }
        const bool dorope = (u.pn <= 4) && ((wc & 1) == 0);
#pragma unroll
        for (int ai = 0; ai < 2; ++ai)
#pragma unroll
            for (int m = 0; m < 4; ++m) { const int row = row0 + ai * 128 + m * 16;
                f32x4 v[2][2];
#pragma unroll
                for (int bj = 0; bj < 2; ++bj)
#pragma unroll
                    for (int n = 0; n < 2; ++n) v[bj][n] = acc[ai][bj][m][n];
                if (dorope) {
                    int pos = row < MREAL ? (row & (SEQ - 1)) + NMETA : row - MREAL; pos = pos > SEQ + NMETA - 1 ? SEQ + NMETA - 1 : pos;
                    const float* rp = rope + (size_t)pos * 16;
                    const f32x4 c0 = *(const f32x4*)rp, c1 = *(const f32x4*)(rp + 4), s0 = *(const f32x4*)(rp + 8), s1 = *(const f32x4*)(rp + 12);
#pragma unroll
                    for (int bj = 0; bj < 2; ++bj)
#pragma unroll
                        for (int n = 0; n < 2; ++n) { const f32x4 c = n ? c1 : c0, s = n ? s1 : s0; f32x4 o;
#pragma unroll
                            for (int j = 0; j < 4; ++j) { const float x = v[bj][n][j]; const float y = __shfl_xor(x, 16);
                                o[j] = fq == 0 ? x * c[j] - y * s[j] : (fq == 1 ? x * c[j] + y * s[j] : x); }
                            v[bj][n] = o; }
                }
#pragma unroll
                for (int bj = 0; bj < 2; ++bj) { const f32x4 v0 = v[bj][0], v1 = v[bj][1];
                    u32x4 w; w.x = cvt_pk_bf16(v0[0], v0[1]); w.y = cvt_pk_bf16(v0[2], v0[3]); w.z = cvt_pk_bf16(v1[0], v1[1]); w.w = cvt_pk_bf16(v1[2], v1[3]);
                    *(u32x4*)(base + (size_t)row * ld + bj * 128) = w; } }
    }
};

struct Params { const float* in[18]; float* out; unsigned char* ws; int ph_lo, ph_hi, li, pad; };
enum { I_X = 0, I_META, I_WIN, I_BGATE, I_LNH, I_WOUT, I_WKV, I_WQ, I_SINKS, I_WO, I_WGUD, I_WDND, I_WROUTER, I_BROUTER, I_WGUE, I_WDNE, I_LNG, I_LNB };
constexpr int NWAVES = 8, NTHREADS = 512;

__device__ __forceinline__ void tr_item(const float* W, int Nsrc, int K, bf16_t* WT, int k0, int n0, int drow0, float scale, int nvalid, LAS float* scr, int lane) {
#pragma unroll 8
    for (int i = 0; i < 32; ++i) { const int kk = 2 * i + (lane >> 5), n = lane & 31; scr[kk * 33 + n] = (n < nvalid) ? W[(size_t)(k0 + kk) * Nsrc + n0 + n] * scale : 0.f; }
    LDS_WAIT(); asm volatile("" ::: "memory");
    const int c = lane & 7;
#pragma unroll
    for (int j = 0; j < 4; ++j) { const int n = (lane >> 3) + 8 * j; const LAS float* s = scr + (8 * c) * 33 + n;
        u32x4 o; o.x = pk2(s[0 * 33], s[1 * 33]); o.y = pk2(s[2 * 33], s[3 * 33]); o.z = pk2(s[4 * 33], s[5 * 33]); o.w = pk2(s[6 * 33], s[7 * 33]);
        if (n < nvalid) *(u32x4*)(WT + (size_t)(drow0 + n) * K + k0 + 8 * c) = o; }
    LDS_WAIT(); asm volatile("" ::: "memory");
}
__device__ __forceinline__ int pair_row(int n, int FF) { const int up = n >= FF ? 1 : 0, j = n - up * FF; return 256 * (j >> 7) + 128 * up + (j & 127); }

__device__ __forceinline__ void p0_prologue(const Params& P, LAS unsigned char* lds, int gw, int NGW, int wave, int lane) {
    unsigned char* ws = P.ws;
    LAS float* scr = (LAS float*)(lds + wave * 16384);
    constexpr int IT0 = 16 * 97, IT1 = 16 * 32, IT2 = 16 * 16, IT5 = 16 * 176, IT6 = 44 * 32, IT7 = 16 * 224, IT8 = 56 * 32;
    constexpr int C0 = 2 * IT0, C1 = C0 + 2 * IT1, C2 = C1 + IT2, C3 = C2 + 2 * IT1, C4 = C3 + 2 * IT1, C5 = C4 + 2 * IT5, C6 = C5 + 2 * IT6, C7 = C6 + 16 * IT7, C8 = C7 + 16 * IT8;
    for (int it = gw; it < C8; it += NGW) {
        if (it < C0) { const int mi = it / IT0, r = it % IT0, kb = r / 97, nb = r % 97; const int n0 = nb * 32;
            tr_item(P.in[I_WIN] + (size_t)mi * D * M_IN, M_IN, D, (bf16_t*)(ws + WS_WIN) + (size_t)mi * M_INP * D, kb * 64, n0, n0, n0 < 512 ? 0.125f : 1.f, nb == 96 ? 16 : 32, scr, lane);
        } else if (it < C1) { const int q = it - C0, mi = q / IT1, r = q % IT1, kb = r / 32, nb = r % 32;
            tr_item(P.in[I_WOUT] + (size_t)mi * D * D, D, D, (bf16_t*)(ws + WS_WOUT) + (size_t)mi * D * D, kb * 64, nb * 32, nb * 32, 1.f, 32, scr, lane);
        } else if (it < C2) { const int r = it - C1, kb = r / 16, nb = r % 16;
            tr_item(P.in[I_WKV], 512, D, (bf16_t*)(ws + WS_WQKV), kb * 64, nb * 32, 1024 + nb * 32, 1.f, 32, scr, lane);
        } else if (it < C3) { const int q = it - C2, mi = q / IT1, r = q % IT1, kb = r / 32, nb = r % 32;
            tr_item(P.in[I_WQ] + (size_t)mi * D * D, D, D, (bf16_t*)(ws + (mi ? WS_WQ3 : WS_WQKV)), kb * 64, nb * 32, nb * 32, 0.125f, 32, scr, lane);
        } else if (it < C4) { const int q = it - C3, mi = q / IT1, r = q % IT1, kb = r / 32, nb = r % 32;
            tr_item(P.in[I_WO] + (size_t)mi * D * D, D, D, (bf16_t*)(ws + WS_WO) + (size_t)mi * D * D, kb * 64, nb * 32, nb * 32, 1.f, 32, scr, lane);
        } else if (it < C5) { const int q = it - C4, mi = q / IT5, r = q % IT5, kb = r / 176, nb = r % 176;
            tr_item(P.in[I_WGUD] + (size_t)mi * D * 2 * D_FF, 2 * D_FF, D, (bf16_t*)(ws + WS_WGU) + (size_t)mi * 2 * D_FF * D, kb * 64, nb * 32, pair_row(nb * 32, D_FF), 1.f, 32, scr, lane);
        } else if (it < C6) { const int q = it - C5, mi = q / IT6, r = q % IT6, kb = r / 32, nb = r % 32;
            tr_item(P.in[I_WDND] + (size_t)mi * D_FF * D, D, D_FF, (bf16_t*)(ws + WS_WDN) + (size_t)mi * D * D_FF, kb * 64, nb * 32, nb * 32, 1.f, 32, scr, lane);
        } else if (it < C7) { const int q = it - C6, mi = q / IT7, r = q % IT7, kb = r / 224, nb = r % 224;
            tr_item(P.in[I_WGUE] + (size_t)mi * D * 2 * D_FF_EXP, 2 * D_FF_EXP, D, (bf16_t*)(ws + WS_WGUE) + (size_t)mi * 2 * D_FF_EXP * D, kb * 64, nb * 32, pair_row(nb * 32, D_FF_EXP), 1.f, 32, scr, lane);
        } else { const int q = it - C7, mi = q / IT8, r = q % IT8, kb = r / 32, nb = r % 32;
            tr_item(P.in[I_WDNE] + (size_t)mi * D_FF_EXP * D, D, D_FF_EXP, (bf16_t*)(ws + WS_WDNE) + (size_t)mi * D * D_FF_EXP, kb * 64, nb * 32, nb * 32, 1.f, 32, scr, lane);
        }
    }
    { float* sm = (float*)(ws + WS_SMALL); const int gt = gw * 64 + lane, NT = NGW * 64;
      for (int i = gt; i < SM_END; i += NT) { float v = 0.f;
          if (i < SM_SINKS) v = P.in[I_BGATE][i]; else if (i < SM_BROUTER) v = P.in[I_SINKS][i - SM_SINKS]; else if (i < SM_BROUTER + 16) v = P.in[I_BROUTER][i - SM_BROUTER];
          else if (i < SM_LNH) v = 0.f; else if (i < SM_LNG) v = P.in[I_LNH][i - SM_LNH]; else if (i < SM_LNB) v = P.in[I_LNG][i - SM_LNG]; else if (i < SM_WROUTER) v = P.in[I_LNB][i - SM_LNB]; else v = P.in[I_WROUTER][i - SM_WROUTER];
          sm[i] = v; } }
    { float* H = (float*)(ws + WS_H); bf16_t* HB = (bf16_t*)(ws + WS_HB);
      const size_t gt = (size_t)gw * 64 + lane, NT = (size_t)NGW * 64;
      for (size_t i = gt; i < (size_t)MV * (D / 4); i += NT) { const size_t row = i >> 8; const int c4 = (int)(i & 255);
          const f32x4 v = row < MREAL ? ((const f32x4*)P.in[I_X])[i] : ((const f32x4*)P.in[I_META])[(row - MREAL) * 256 + c4];
          ((f32x4*)H)[i] = v; u32x2 w; w.x = pk2(v[0], v[1]); w.y = pk2(v[2], v[3]); ((u32x2*)HB)[i] = w; }
      float* rope = (float*)(ws + WS_ROPE);
      for (size_t i = gt; i < (size_t)(SEQ + NMETA) * 8; i += NT) { const int pos = (int)(i >> 3), fi = (int)(i & 7);
          const double invf = fi == 0 ? 1.0 : fi == 1 ? 0.19392274474868576 : fi == 2 ? 0.03760603093086393 : fi == 3 ? 0.007292664737217109 : fi == 4 ? 0.001414213562373095
                            : fi == 5 ? 0.0002742481756762073 : fi == 6 ? 5.318295896944988e-05 : 1.031338537721246e-05;
          const float angf = (float)pos * (float)invf;
          double a = (double)angf; a -= 6.283185307179586476925 * __builtin_rint(a * 0.15915494309189533577); const double hx = 0.5 * a, h2 = hx * hx;
          double sp = 1.0, cp = 1.0;
#pragma unroll
          for (int k = 12; k >= 1; --k) { sp = 1.0 - sp * h2 / (double)((2 * k) * (2 * k + 1)); cp = 1.0 - cp * h2 / (double)((2 * k - 1) * (2 * k)); }
          const double sh = hx * sp, ch = cp;
          rope[(size_t)pos * 16 + fi] = (float)(1.0 - 2.0 * sh * sh); rope[(size_t)pos * 16 + 8 + fi] = (float)(2.0 * sh * ch); }
    }
}

__device__ __forceinline__ void ln_phase(unsigned char* ws, float* outp, LAS unsigned char* lds, int gw, int NGW, int lane, int tid,
                                         int lnidx, bool moe_src, bool router, int moe_idx, bool final) {
    const float* sm = (const float*)(ws + WS_SMALL);
    float* H = (float*)(ws + WS_H); bf16_t* HB = (bf16_t*)(ws + WS_HB); const float* contrib = (const float*)(ws + WS_CONTRIB);
    const float* lg = sm + SM_LNG + (size_t)lnidx * D; const float* lb = sm + SM_LNB + (size_t)lnidx * D;
    f32x4 gv[4], bv[4];
#pragma unroll
    for (int j = 0; j < 4; ++j) { gv[j] = *(const f32x4*)(lg + 256 * j + 4 * lane); bv[j] = *(const f32x4*)(lb + 256 * j + 4 * lane); }
    LAS float* wr = (LAS float*)lds;
    volatile LAS unsigned* misc = (volatile LAS unsigned*)(lds + MISC_OFF);
    if (router) {
        const float* src = sm + SM_WROUTER + (size_t)moe_idx * D * N_EXP;
        for (int i = tid; i < D * N_EXP / 4; i += NTHREADS) ((LAS f32x4*)wr)[i] = ((const f32x4*)src)[i];
        if (tid < 8) misc[16 + tid] = 0u;
        __syncthreads();
    }
    int* tope = (int*)(ws + WS_TOPE); float* topg = (float*)(ws + WS_TOPG);
    const float* br = sm + SM_BROUTER + moe_idx * N_EXP;
    for (int row = gw; row < MV; row += NGW) {
        f32x4 v[4];
        const f32x4* hr = (const f32x4*)(H + (size_t)row * D) + lane;
#pragma unroll
        for (int j = 0; j < 4; ++j) v[j] = hr[64 * j];
        if (moe_src) { const f32x4* c0 = (const f32x4*)(contrib + (size_t)(2 * row) * D) + lane; const f32x4* c1 = c0 + 256;
#pragma unroll
            for (int j = 0; j < 4; ++j) v[j] = v[j] * ALPHA + c0[64 * j] + c1[64 * j]; }
        float s = 0.f;
#pragma unroll
        for (int j = 0; j < 4; ++j) s += (v[j][0] + v[j][1]) + (v[j][2] + v[j][3]);
        const float mean = wave_sum(s) * (1.f / D); float s2 = 0.f;
#pragma unroll
        for (int j = 0; j < 4; ++j) { v[j] = v[j] - mean; s2 += (v[j][0] * v[j][0] + v[j][1] * v[j][1]) + (v[j][2] * v[j][2] + v[j][3] * v[j][3]); }
        const float rstd = 1.f / sqrtf(wave_sum(s2) * (1.f / D) + LN_EPS);
#pragma unroll
        for (int j = 0; j < 4; ++j) v[j] = v[j] * rstd * gv[j] + bv[j];
        if (final) { if (row < MREAL) { f32x4* o = (f32x4*)(outp + (size_t)row * D) + lane;
#pragma unroll
                for (int j = 0; j < 4; ++j) o[64 * j] = v[j]; } }
        else { f32x4* o = (f32x4*)(H + (size_t)row * D) + lane; u32x2* ob = (u32x2*)(HB + (size_t)row * D) + lane;
#pragma unroll
            for (int j = 0; j < 4; ++j) { o[64 * j] = v[j]; u32x2 w; w.x = pk2(v[j][0], v[j][1]); w.y = pk2(v[j][2], v[j][3]); ob[64 * j] = w; } }
        if (router) {
            float lg8[8];
#pragma unroll
            for (int e = 0; e < 8; ++e) lg8[e] = 0.f;
#pragma unroll
            for (int j = 0; j < 4; ++j)
#pragma unroll
                for (int c = 0; c < 4; ++c) { const LAS f32x4* w4 = (const LAS f32x4*)(wr + (size_t)(256 * j + 4 * lane + c) * 8); const f32x4 wa = w4[0], wb = w4[1]; const float x = v[j][c];
                    lg8[0] += x * wa[0]; lg8[1] += x * wa[1]; lg8[2] += x * wa[2]; lg8[3] += x * wa[3]; lg8[4] += x * wb[0]; lg8[5] += x * wb[1]; lg8[6] += x * wb[2]; lg8[7] += x * wb[3]; }
#pragma unroll
            for (int e = 0; e < 8; ++e) lg8[e] = wave_sum(lg8[e]) + br[e];
            int e1 = 0; float v1 = lg8[0];
#pragma unroll
            for (int e = 1; e < 8; ++e) if (lg8[e] > v1) { v1 = lg8[e]; e1 = e; }
            int e2 = -1; float v2 = -3.0e38f;
#pragma unroll
            for (int e = 0; e < 8; ++e) if (e != e1 && lg8[e] > v2) { v2 = lg8[e]; e2 = e; }
            const float ex = expf(v2 - v1), g1 = 1.f / (1.f + ex), g2 = ex / (1.f + ex);
            if (lane == 0) { tope[row] = e1 | (e2 << 8); topg[2 * row] = g1; topg[2 * row + 1] = g2;
                __hip_atomic_fetch_add((LAS unsigned*)&misc[16 + e1], 1u, __ATOMIC_RELAXED, __HIP_MEMORY_SCOPE_WORKGROUP);
                __hip_atomic_fetch_add((LAS unsigned*)&misc[16 + e2], 1u, __ATOMIC_RELAXED, __HIP_MEMORY_SCOPE_WORKGROUP); }
        }
    }
    if (router) { __syncthreads();
        if (tid < 8) __hip_atomic_fetch_add((unsigned*)(ws + WS_CTL) + CW_CNT + moe_idx * 64 + tid, misc[16 + tid], __ATOMIC_RELAXED, __HIP_MEMORY_SCOPE_AGENT);
        __syncthreads(); }
}

__device__ __forceinline__ void moe_starts(const unsigned char* ws, int moe_idx, int (&cnt)[8], int (&pstart)[9]) {
    const unsigned* c = (const unsigned*)(ws + WS_CTL) + CW_CNT + moe_idx * 64; int p = 0;
#pragma unroll
    for (int e = 0; e < 8; ++e) { cnt[e] = __builtin_amdgcn_readfirstlane((int)__hip_atomic_load(c + e, __ATOMIC_RELAXED, __HIP_MEMORY_SCOPE_AGENT)); pstart[e] = p; p += (cnt[e] + 255) >> 8; }
    pstart[8] = p;
}
__device__ __forceinline__ void assign_phase(unsigned char* ws, int gw, int NGW, int lane, int tid, int moe_idx) {
    int cnt[8], pstart[9]; moe_starts(ws, moe_idx, cnt, pstart);
    const int* tope = (const int*)(ws + WS_TOPE); const float* topg = (const float*)(ws + WS_TOPG);
    int* rowtok = (int*)(ws + WS_ROWTOK); int* rowdst = (int*)(ws + WS_ROWDST); float* rowgate = (float*)(ws + WS_ROWGATE);
    unsigned* cur = (unsigned*)(ws + WS_CTL) + CW_CUR + moe_idx * 64;
    for (int base = gw * 64; base < MV; base += NGW * 64) {
        const int row = base + lane; const bool valid = row < MV;
        const int te = valid ? tope[row] : 0xffff;
#pragma unroll
        for (int slot = 0; slot < 2; ++slot) {
            const int e = valid ? ((te >> (8 * slot)) & 255) : 255; int pos = -1;
#pragma unroll
            for (int ee = 0; ee < 8; ++ee) {
                const unsigned long long mask = __ballot(e == ee);
                if (mask) { const int n = __popcll(mask), leader = __ffsll((long long)mask) - 1; unsigned b0 = 0;
                    if (lane == leader) b0 = __hip_atomic_fetch_add(cur + ee, (unsigned)n, __ATOMIC_RELAXED, __HIP_MEMORY_SCOPE_AGENT);
                    b0 = __shfl(b0, leader);
                    if (e == ee) pos = pstart[ee] * 256 + (int)b0 + __popcll(mask & ((1ull << lane) - 1ull)); }
            }
            if (valid) { rowtok[pos] = row; rowdst[pos] = 2 * row + slot; rowgate[pos] = topg[2 * row + slot]; }
        }
    }
    if (blockIdx.x < 8) { const int e = blockIdx.x; int ps = 0, pe = 0, ce = 0;
#pragma unroll
        for (int ee = 0; ee < 8; ++ee) if (ee == e) { ps = pstart[ee]; pe = pstart[ee + 1]; ce = cnt[ee]; }
        for (int pos = ps * 256 + ce + tid; pos < pe * 256; pos += NTHREADS) { rowtok[pos] = -1; rowdst[pos] = -1; rowgate[pos] = 0.f; } }
}

constexpr int ML_RS = 72;
constexpr int ML_QS = 0, ML_KS = 9216, ML_KT = 18432, ML_PS = 27648, ML_VT = 36864, ML_CT = 57600, ML_HS = 78336, ML_SC = 112128;
constexpr int ML_HSS = 132;
__device__ __forceinline__ bf16x8 ml_frag(LAS unsigned char* lds, int base, int row, int kcol) { return *(const LAS bf16x8*)(lds + base + (row * ML_RS + kcol) * 2); }

template <int MODE>
__device__ __forceinline__ void mlstm_phase(unsigned char* ws, LAS unsigned char* lds, int layer, int tid, int wave, int lane) {
    const int item = blockIdx.x; const int bh = item >> 3, seg = item & 7, b = bh >> 3, h = bh & 7;
    if (MODE == 1 && seg == 7) return;
    const bf16_t* proj = (const bf16_t*)(ws + WS_PROJ); const float* gates = (const float*)(ws + WS_GATES);
    bf16_t* HG = (bf16_t*)(ws + WS_HG);
    float* STATE = (float*)(ws + WS_STATE); float* STSC = (float*)(ws + WS_STSC);
    LAS float* sc = (LAS float*)(lds + ML_SC);
    const int fr = lane & 15, quad = lane >> 4;
    f32x4 st[5]; float zero = 0.f; asm volatile("; opaque zero" : "+v"(zero));
#pragma unroll
    for (int i = 0; i < 5; ++i) st[i] = (f32x4){zero, zero, zero, zero};
    float m0 = (MODE == 1) ? -1.0e30f : 0.f, gsum = 0.f;
    for (int i = tid; i < 16 * ML_RS; i += NTHREADS) ((LAS bf16_t*)(lds + ML_VT))[128 * ML_RS + i] = (i < ML_RS) ? (bf16_t)0x3F80 : (bf16_t)0;
    if (MODE == 2 && seg > 0) {
        m0 = -1.0e30f;
        for (int s2 = 0; s2 < seg; ++s2) {
            const float ms = STSC[(bh * 7 + s2) * 4 + 0], Gs = STSC[(bh * 7 + s2) * 4 + 1];
            const float mn = fmaxf(Gs + m0, ms), fo = fast_exp(Gs + m0 - mn), fn = fast_exp(ms - mn);
            const f32x4* sp = (const f32x4*)(STATE + (size_t)(bh * 7 + s2) * ST_FLOATS) + (wave * 5) * 64 + lane;
#pragma unroll
            for (int i = 0; i < 5; ++i) st[i] = st[i] * fo + sp[i * 64] * fn;
            m0 = mn;
        }
    }
#pragma unroll
    for (int i = 0; i < 5; ++i) { const int dv = (i < 4) ? 16 * wave + fr : 128 + fr, dk = (i < 4) ? 16 * i + 4 * quad : 16 * wave + 4 * quad;
        if (i < 4 || wave < 4) { u32x2 w; w.x = pk2(st[i][0], st[i][1]); w.y = pk2(st[i][2], st[i][3]); *(LAS u32x2*)(lds + ML_CT + (dv * ML_RS + dk) * 2) = w; } }
    float lnh[16];
    if (MODE == 2) {
#pragma unroll
        for (int e = 0; e < 16; ++e) lnh[e] = ((const float*)(ws + WS_SMALL))[SM_LNH + layer * D + h * M_V + 16 * (tid & 7) + e]; }
    const int nch = SEG_CHUNKS + (seg == 0 ? 1 : 0);
    u32x4 rq, rk, rv0, rv1; float rli = 0.f, rlf = 0.f;
    auto chunk_rows = [&](int ci, int& rbase, int& nv) { if (seg == 0 && ci == 0) { rbase = MREAL; nv = NMETA; } else { const int c = seg * SEG_CHUNKS + ci - (seg == 0 ? 1 : 0); rbase = b * SEQ + c * 64; nv = 64; } };
    auto load_chunk = [&](int ci) {
        int rbase, nv; chunk_rows(ci, rbase, nv);
        { const int j = tid >> 3, c8 = (tid & 7) * 8; const bool ok = j < nv; const bf16_t* rp = proj + (size_t)(rbase + j) * PROJ_LD + h * 64 + c8;
          rq = (MODE == 2 && ok) ? *(const u32x4*)rp : (u32x4){0u, 0u, 0u, 0u}; rk = ok ? *(const u32x4*)(rp + 512) : (u32x4){0u, 0u, 0u, 0u}; }
        { const int j0 = tid >> 4, c8 = (tid & 15) * 8; const bf16_t* rp = proj + (size_t)(rbase + j0) * PROJ_LD + 1024 + h * 128 + c8;
          rv0 = (j0 < nv) ? *(const u32x4*)rp : (u32x4){0u, 0u, 0u, 0u}; rv1 = (j0 + 32 < nv) ? *(const u32x4*)(rp + (size_t)32 * PROJ_LD) : (u32x4){0u, 0u, 0u, 0u}; }
        if (tid < 64) { const bool ok = tid < nv; rli = ok ? gates[(size_t)(rbase + tid) * 16 + h] : -1.0e30f; rlf = ok ? gates[(size_t)(rbase + tid) * 16 + 8 + h] : 1.0e30f; }
    };
    load_chunk(0);
    __syncthreads();
    for (int ci = 0; ci < nch; ++ci) {
        int rbase, nv; chunk_rows(ci, rbase, nv);
        { const int j = tid >> 3, c8 = (tid & 7) * 8;
          if (MODE == 2) *(LAS u32x4*)(lds + ML_QS + (j * ML_RS + c8) * 2) = rq;
          *(LAS u32x4*)(lds + ML_KS + (j * ML_RS + c8) * 2) = rk; }
        { const int j0 = tid >> 4, c8 = (tid & 15) * 8; LAS bf16_t* vt = (LAS bf16_t*)(lds + ML_VT);
          const unsigned a[4] = {rv0.x, rv0.y, rv0.z, rv0.w}, c[4] = {rv1.x, rv1.y, rv1.z, rv1.w};
#pragma unroll
          for (int e = 0; e < 4; ++e) { vt[(c8 + 2 * e) * ML_RS + j0] = (bf16_t)(a[e] & 0xffffu); vt[(c8 + 2 * e + 1) * ML_RS + j0] = (bf16_t)(a[e] >> 16);
              vt[(c8 + 2 * e) * ML_RS + j0 + 32] = (bf16_t)(c[e] & 0xffffu); vt[(c8 + 2 * e + 1) * ML_RS + j0 + 32] = (bf16_t)(c[e] >> 16); } }
        if (wave == 0) {
            const float li = rli, f = rlf;
            const float lf = (f > 1.0e29f) ? 0.f : (fminf(f, 0.f) - logf(1.f + expf(-fabsf(f))));
            float bc = lf;
#pragma unroll
            for (int o = 1; o < 64; o <<= 1) { const float t = __shfl_up(bc, o); if (lane >= o) bc += t; }
            const float u = li - bc; float pm = u;
#pragma unroll
            for (int o = 1; o < 64; o <<= 1) { const float t = __shfl_up(pm, o); if (lane >= o) pm = fmaxf(pm, t); }
            const float blast = __shfl(bc, 63), umax = __shfl(pm, 63);
            const float MM = fmaxf(pm, m0), amax = blast + umax, mn = fmaxf(blast + m0, amax);
            const float sold = fast_exp(blast + m0 - mn), snew = fast_exp(amax - mn);
            sc[lane] = u; sc[64 + lane] = MM; sc[128 + lane] = fast_exp(m0 - MM); sc[192 + lane] = fast_exp(-(bc + MM)); sc[256 + lane] = snew * fast_exp(u - umax);
            if (lane == 0) { sc[384] = sold; sc[385] = mn; sc[386] = blast; }
        }
        __syncthreads();
        if (ci + 1 < nch) load_chunk(ci + 1);
        m0 = sc[385]; gsum += sc[386];
        const float sold = sc[384];
        { const int j = tid >> 3, c8 = (tid & 7) * 8; const u32x4 kv = *(const LAS u32x4*)(lds + ML_KS + (j * ML_RS + c8) * 2); const float wj = sc[256 + j];
          const unsigned a[4] = {kv.x, kv.y, kv.z, kv.w}; LAS bf16_t* kt = (LAS bf16_t*)(lds + ML_KT);
#pragma unroll
          for (int e = 0; e < 4; ++e) { kt[(c8 + 2 * e) * ML_RS + j] = (bf16_t)f2bf(bf2f((unsigned short)(a[e] & 0xffffu)) * wj); kt[(c8 + 2 * e + 1) * ML_RS + j] = (bf16_t)f2bf(bf2f((unsigned short)(a[e] >> 16)) * wj); } }
        if (MODE == 2) {
            const int mt = wave >> 1;
#pragma unroll
            for (int q = 0; q < 2; ++q) { const int nt = 2 * (wave & 1) + q; f32x4 s = (f32x4){0.f, 0.f, 0.f, 0.f};
                if (nt <= mt) {
#pragma unroll
                    for (int ks = 0; ks < 2; ++ks) s = __builtin_amdgcn_mfma_f32_16x16x32_bf16(ml_frag(lds, ML_QS, 16 * mt + fr, 32 * ks + 8 * quad), ml_frag(lds, ML_KS, 16 * nt + fr, 32 * ks + 8 * quad), s, 0, 0, 0); }
                const int j = 16 * nt + fr; const float uj = sc[j];
#pragma unroll
                for (int r = 0; r < 4; ++r) { const int i = 16 * mt + 4 * quad + r; const float p = (j <= i) ? s[r] * fast_exp(uj - sc[64 + i]) : 0.f;
                    ((LAS bf16_t*)(lds + ML_PS))[i * ML_RS + j] = (bf16_t)f2bf(p); } }
        }
        __syncthreads();
        f32x4 o1[4], o2[4];
        if (MODE == 2) {
            bf16x8 vb[2], cb[2];
#pragma unroll
            for (int ks = 0; ks < 2; ++ks) { vb[ks] = ml_frag(lds, ML_VT, 16 * wave + fr, 32 * ks + 8 * quad); cb[ks] = ml_frag(lds, ML_CT, 16 * wave + fr, 32 * ks + 8 * quad); }
#pragma unroll
            for (int mt = 0; mt < 4; ++mt) { o1[mt] = (f32x4){0.f, 0.f, 0.f, 0.f}; o2[mt] = (f32x4){0.f, 0.f, 0.f, 0.f};
#pragma unroll
                for (int ks = 0; ks < 2; ++ks) { o1[mt] = __builtin_amdgcn_mfma_f32_16x16x32_bf16(ml_frag(lds, ML_PS, 16 * mt + fr, 32 * ks + 8 * quad), vb[ks], o1[mt], 0, 0, 0);
                    o2[mt] = __builtin_amdgcn_mfma_f32_16x16x32_bf16(ml_frag(lds, ML_QS, 16 * mt + fr, 32 * ks + 8 * quad), cb[ks], o2[mt], 0, 0, 0); } }
            if (wave < 4) { f32x4 d1 = (f32x4){0.f, 0.f, 0.f, 0.f}, d2 = (f32x4){0.f, 0.f, 0.f, 0.f};
#pragma unroll
                for (int ks = 0; ks < 2; ++ks) { d1 = __builtin_amdgcn_mfma_f32_16x16x32_bf16(ml_frag(lds, ML_PS, 16 * wave + fr, 32 * ks + 8 * quad), ml_frag(lds, ML_VT, 128 + fr, 32 * ks + 8 * quad), d1, 0, 0, 0);
                    d2 = __builtin_amdgcn_mfma_f32_16x16x32_bf16(ml_frag(lds, ML_QS, 16 * wave + fr, 32 * ks + 8 * quad), ml_frag(lds, ML_CT, 128 + fr, 32 * ks + 8 * quad), d2, 0, 0, 0); }
                if (fr == 0) {
#pragma unroll
                    for (int r = 0; r < 4; ++r) { const int i = 16 * wave + 4 * quad + r; sc[320 + i] = d1[r] + sc[128 + i] * d2[r]; } } }
            __syncthreads();
        }
        if (MODE == 2) {
#pragma unroll
            for (int mt = 0; mt < 4; ++mt)
#pragma unroll
                for (int r = 0; r < 4; ++r) { const int i = 16 * mt + 4 * quad + r; const float num = o1[mt][r] + sc[128 + i] * o2[mt][r];
                    ((LAS float*)(lds + ML_HS))[i * ML_HSS + 16 * wave + fr] = num / fmaxf(fabsf(sc[320 + i]), sc[192 + i]); }
        }
        { bf16x8 vb[2];
#pragma unroll
          for (int ks = 0; ks < 2; ++ks) vb[ks] = ml_frag(lds, ML_VT, 16 * wave + fr, 32 * ks + 8 * quad);
#pragma unroll
          for (int mt = 0; mt < 4; ++mt) { st[mt] = st[mt] * sold;
#pragma unroll
              for (int ks = 0; ks < 2; ++ks) st[mt] = __builtin_amdgcn_mfma_f32_16x16x32_bf16(ml_frag(lds, ML_KT, 16 * mt + fr, 32 * ks + 8 * quad), vb[ks], st[mt], 0, 0, 0); }
          if (wave < 4) { st[4] = st[4] * sold;
#pragma unroll
              for (int ks = 0; ks < 2; ++ks) st[4] = __builtin_amdgcn_mfma_f32_16x16x32_bf16(ml_frag(lds, ML_KT, 16 * wave + fr, 32 * ks + 8 * quad), ml_frag(lds, ML_VT, 128 + fr, 32 * ks + 8 * quad), st[4], 0, 0, 0); }
          if (MODE == 2) {
#pragma unroll
              for (int i = 0; i < 5; ++i) { const int dv = (i < 4) ? 16 * wave + fr : 128 + fr, dk = (i < 4) ? 16 * i + 4 * quad : 16 * wave + 4 * quad;
                  if (i < 4 || wave < 4) { u32x2 w; w.x = pk2(st[i][0], st[i][1]); w.y = pk2(st[i][2], st[i][3]); *(LAS u32x2*)(lds + ML_CT + (dv * ML_RS + dk) * 2) = w; } } }
        }
        __syncthreads();
        if (MODE == 2) {
            const int i = tid >> 3, sg = tid & 7; const LAS float* hp = (const LAS float*)(lds + ML_HS) + i * ML_HSS + 16 * sg;
            float x[16]; float s = 0.f;
#pragma unroll
            for (int e = 0; e < 16; ++e) { x[e] = hp[e]; s += x[e]; }
            s += __shfl_xor(s, 1); s += __shfl_xor(s, 2); s += __shfl_xor(s, 4);
            const float mean = s * (1.f / M_V); float q = 0.f;
#pragma unroll
            for (int e = 0; e < 16; ++e) { x[e] -= mean; q += x[e] * x[e]; }
            q += __shfl_xor(q, 1); q += __shfl_xor(q, 2); q += __shfl_xor(q, 4);
            const float rstd = 1.f / sqrtf(q * (1.f / M_V) + LN_EPS);
            if (i < nv && (nv == 64 || b == 0)) {
                const size_t row = (size_t)(rbase + i);
                const u32x4* ogp = (const u32x4*)(proj + row * PROJ_LD + 2048 + h * M_V + 16 * sg); const u32x4 g0 = ogp[0], g1 = ogp[1];
                const unsigned gw8[8] = {g0.x, g0.y, g0.z, g0.w, g1.x, g1.y, g1.z, g1.w}; unsigned ow[8];
#pragma unroll
                for (int e = 0; e < 8; ++e) { const float oga = bf2f((unsigned short)(gw8[e] & 0xffffu)), ogb = bf2f((unsigned short)(gw8[e] >> 16));
                    const float ya = x[2 * e] * rstd * lnh[2 * e] / (1.f + fast_exp(-oga)), yb = x[2 * e + 1] * rstd * lnh[2 * e + 1] / (1.f + fast_exp(-ogb));
                    ow[e] = pk2(ya, yb); }
                u32x4* op = (u32x4*)(HG + row * D + h * M_V + 16 * sg);
                op[0] = (u32x4){ow[0], ow[1], ow[2], ow[3]}; op[1] = (u32x4){ow[4], ow[5], ow[6], ow[7]};
            }
        }
    }
    if (MODE == 1) {
        f32x4* sp = (f32x4*)(STATE + (size_t)(bh * 7 + seg) * ST_FLOATS) + (wave * 5) * 64 + lane;
#pragma unroll
        for (int i = 0; i < 5; ++i) sp[i * 64] = (i < 4 || wave < 4) ? st[i] : (f32x4){0.f, 0.f, 0.f, 0.f};
        if (tid == 0) { STSC[(bh * 7 + seg) * 4 + 0] = m0; STSC[(bh * 7 + seg) * 4 + 1] = gsum; }
    }
}

constexpr int AT_KRS = 72, AT_VRS = 280, AT_NK = 272;
constexpr int AT_KS = 0, AT_VT = AT_NK * AT_KRS * 2, AT_END = AT_VT + 64 * AT_VRS * 2;
static_assert(AT_END <= MISC_OFF, "attention LDS");
__device__ __forceinline__ void attn_phase(unsigned char* ws, LAS unsigned char* lds, int j_layer, int tid, int wave, int lane) {
    const bf16_t* Q = (const bf16_t*)(ws + WS_PROJ); const bf16_t* KB = (const bf16_t*)(ws + WS_KB); const bf16_t* VT = (const bf16_t*)(ws + WS_VB);
    bf16_t* HG = (bf16_t*)(ws + WS_HG);
    const float* sinks = (const float*)(ws + WS_SMALL) + SM_SINKS + j_layer * A_HEADS;
    const int fr = lane & 15, quad = lane >> 4;
    LAS bf16_t* ks = (LAS bf16_t*)(lds + AT_KS); LAS bf16_t* vt = (LAS bf16_t*)(lds + AT_VT);
    u32x4 kreg[5], vreg[5]; bf16x8 qn[4][2];
    const int NIT = NBATCH * A_KV * (SEQ / WINDOW);
    auto prefetch = [&](int it) {
        const int b = it >> 8, g = (it >> 6) & 3, blk = it & 63;
#pragma unroll
        for (int i = 0; i < 5; ++i) { const int p = tid + i * NTHREADS; kreg[i] = (u32x4){0u, 0u, 0u, 0u}; vreg[i] = (u32x4){0u, 0u, 0u, 0u};
            if (p < AT_NK * 8) { const int kk = p >> 3, c8 = (p & 7) * 8;
                int row; if (kk >= 256) row = MREAL + kk - 256; else { const int tk = (blk - 1) * WINDOW + kk; row = tk < 0 ? -1 : b * SEQ + tk; }
                if (row >= 0) kreg[i] = *(const u32x4*)(KB + (size_t)row * 256 + g * 64 + c8);
                const int d = p / 34, pc = p % 34; const bf16_t* src = VT + (size_t)(g * 64 + d) * MP;
                if (pc >= 32) vreg[i] = *(const u32x4*)(src + MREAL + (pc - 32) * 8);
                else { const int tk = (blk - 1) * WINDOW + pc * 8; if (tk >= 0) vreg[i] = *(const u32x4*)(src + (size_t)b * SEQ + tk); } } }
    };
    auto qload = [&](int it, int mt) {
        const int b = it >> 8, g = (it >> 6) & 3, blk = it & 63, qh = g * 4 + (wave >> 1);
        const size_t rowq = (size_t)b * SEQ + blk * WINDOW + 16 * (4 * (wave & 1) + mt) + fr;
#pragma unroll
        for (int k2 = 0; k2 < 2; ++k2) qn[mt][k2] = *(const bf16x8*)(Q + rowq * D + qh * 64 + 32 * k2 + 8 * quad);
    };
    if ((int)blockIdx.x < NIT) { prefetch(blockIdx.x);
#pragma unroll
        for (int mt = 0; mt < 4; ++mt) qload(blockIdx.x, mt); }
    for (int it = blockIdx.x; it < NIT; it += gridDim.x) {
        const int b = it >> 8, g = (it >> 6) & 3, blk = it & 63;
        __syncthreads();
#pragma unroll
        for (int i = 0; i < 5; ++i) { const int p = tid + i * NTHREADS;
            if (p < AT_NK * 8) { *(LAS u32x4*)(ks + (p >> 3) * AT_KRS + (p & 7) * 8) = kreg[i]; *(LAS u32x4*)(vt + (p / 34) * AT_VRS + (p % 34) * 8) = vreg[i]; } }
        __syncthreads();
        const bool has_next = it + (int)gridDim.x < NIT;
        if (has_next) prefetch(it + gridDim.x);
        const int qh = g * 4 + (wave >> 1); const float sink = sinks[qh];
#pragma unroll
        for (int mt = 0; mt < 4; ++mt) {
            const int t0 = 4 * (wave & 1) + mt, qi = 16 * t0 + fr;
            const size_t rowq = (size_t)b * SEQ + blk * WINDOW + qi;
            f32x4 s[10];
#pragma unroll
            for (int c = 0; c < 10; ++c) { const int kb = (c < 9) ? 16 * (t0 + c) : 256; s[c] = (f32x4){0.f, 0.f, 0.f, 0.f};
#pragma unroll
                for (int k2 = 0; k2 < 2; ++k2) s[c] = __builtin_amdgcn_mfma_f32_16x16x32_bf16(*(const LAS bf16x8*)(ks + (kb + fr) * AT_KRS + 32 * k2 + 8 * quad), qn[mt][k2], s[c], 0, 0, 0); }
            if (has_next) qload(it + gridDim.x, mt);
            float m = sink;
#pragma unroll
            for (int c = 0; c < 9; ++c)
#pragma unroll
                for (int r = 0; r < 4; ++r) { const int j = 16 * (t0 + c) + 4 * quad + r, rel = qi + WINDOW - j; const bool vis = (rel >= 0) && (rel < WINDOW) && (blk > 0 || j >= WINDOW);
                    s[c][r] = vis ? s[c][r] : -1.0e30f; m = fmaxf(m, s[c][r]); }
#pragma unroll
            for (int r = 0; r < 4; ++r) m = fmaxf(m, s[9][r]);
            m = fmaxf(m, __shfl_xor(m, 16)); m = fmaxf(m, __shfl_xor(m, 32));
            float sm = 0.f;
#pragma unroll
            for (int c = 0; c < 10; ++c)
#pragma unroll
                for (int r = 0; r < 4; ++r) { const float p = fast_exp(s[c][r] - m); s[c][r] = p; sm += p; }
            sm += __shfl_xor(sm, 16); sm += __shfl_xor(sm, 32);
            const float inv = 1.f / (sm + fast_exp(sink - m));
            f32x4 o[4];
#pragma unroll
            for (int dt = 0; dt < 4; ++dt) o[dt] = (f32x4){0.f, 0.f, 0.f, 0.f};
#pragma unroll
            for (int u = 0; u < 5; ++u) {
                const int kb0 = 16 * (t0 + 2 * u), kb1 = (u < 4) ? 16 * (t0 + 2 * u + 1) : 256;
                u32x4 pw; pw.x = cvt_pk_bf16(s[2 * u][0], s[2 * u][1]); pw.y = cvt_pk_bf16(s[2 * u][2], s[2 * u][3]); pw.z = cvt_pk_bf16(s[2 * u + 1][0], s[2 * u + 1][1]); pw.w = cvt_pk_bf16(s[2 * u + 1][2], s[2 * u + 1][3]);
                const bf16x8 pf = __builtin_bit_cast(bf16x8, pw);
#pragma unroll
                for (int dt = 0; dt < 4; ++dt) { const LAS bf16_t* vr = vt + (16 * dt + fr) * AT_VRS + 4 * quad;
                    u32x4 vw; const u32x2 a = *(const LAS u32x2*)(vr + kb0), c2 = *(const LAS u32x2*)(vr + kb1); vw.x = a.x; vw.y = a.y; vw.z = c2.x; vw.w = c2.y;
                    o[dt] = __builtin_amdgcn_mfma_f32_16x16x32_bf16(__builtin_bit_cast(bf16x8, vw), pf, o[dt], 0, 0, 0); } }
#pragma unroll
            for (int dt = 0; dt < 4; ++dt) { u32x2 w; w.x = cvt_pk_bf16(o[dt][0] * inv, o[dt][1] * inv); w.y = cvt_pk_bf16(o[dt][2] * inv, o[dt][3] * inv);
                *(u32x2*)(HG + rowq * D + qh * 64 + 16 * dt + 4 * quad) = w; }
        }
    }
    if (blockIdx.x == gridDim.x - 1 && tid < 256) {
        const int qm = tid >> 4, head = tid & 15, g = head >> 2; const float sink = sinks[head];
        const bf16_t* qp = Q + (size_t)(MREAL + qm) * D + head * 64;
        float sv[16]; float m = sink;
#pragma unroll
        for (int kk = 0; kk < 16; ++kk) { float d = 0.f; const bf16_t* kp = KB + (size_t)(MREAL + kk) * 256 + g * 64;
            for (int c = 0; c < 64; ++c) d += bf2f(qp[c]) * bf2f(kp[c]);
            sv[kk] = (kk <= qm) ? d : -1.0e30f; m = fmaxf(m, sv[kk]); }
        float den = fast_exp(sink - m);
#pragma unroll
        for (int kk = 0; kk < 16; ++kk) { sv[kk] = (kk <= qm) ? fast_exp(sv[kk] - m) : 0.f; den += sv[kk]; }
        const float invd = 1.f / den;
        for (int c = 0; c < 64; ++c) { float a = 0.f;
#pragma unroll
            for (int kk = 0; kk < 16; ++kk) a += sv[kk] * bf2f(VT[(size_t)(g * 64 + c) * MP + MREAL + kk]);
            HG[(size_t)(MREAL + qm) * D + head * 64 + c] = (bf16_t)f2bf(a * invd); }
    }
}

#ifndef SITES
#define SITES 0xFFFF
#endif
#define SITE(n) ((SITES >> (n)) & 1)
#ifndef DUPMASK
#define DUPMASK 0
#endif
#define REPS(n) (1 + ((DUPMASK >> (n)) & 1))
#ifndef MK_PER_PHASE
#define MK_PER_PHASE 0
#endif
constexpr int PH_PER_LAYER = 12, N_PHASES = 1 + 4 * PH_PER_LAYER;

__global__ void __launch_bounds__(NTHREADS, 2) fwd(Params P) {
    extern __shared__ __attribute__((aligned(16))) unsigned char lds_raw[];
    LAS unsigned char* const lds0 = (LAS unsigned char*)lds_raw;
    const int G = gridDim.x;
    const int vcu = (G % 8 == 0) ? ((int)blockIdx.x % 8) * (G / 8) + (int)blockIdx.x / 8 : (int)blockIdx.x;
    const int NGW = G * NWAVES;
    unsigned char* const wsbase = P.ws;
    volatile LAS unsigned* misc = (volatile LAS unsigned*)(lds0 + MISC_OFF);
    if (threadIdx.x < 64) misc[threadIdx.x] = 0u;
    __syncthreads();
    XcdBarrier bar = xcd_barrier_post((unsigned*)(wsbase + WS_CTL) + CW_BAR + P.li * 4096, misc + 8);
    const int lo = P.ph_lo, hi = P.ph_hi;
#define RUN(idx) ((idx) >= lo && (idx) < hi)
#define SEAM(idx) do { if ((idx) + 1 < hi) xcd_barrier(bar); } while (0)
#define IDS() int tid = threadIdx.x; asm volatile("; opaque tid" : "+v"(tid)); unsigned char* ws = wsbase; asm volatile("; opaque ws" : "+s"(ws)); \
              LAS unsigned char* lds = lds0; asm volatile("; opaque lds" : "+s"(lds)); \
              const int lane = tid & 63, wave = __builtin_amdgcn_readfirstlane(tid >> 6); const int gw = vcu * NWAVES + wave; (void)lane; (void)gw; (void)ws

    for (int rep = 0; rep < REPS(0); ++rep) if (SITE(0) && RUN(0)) { IDS(); p0_prologue(P, lds, gw, NGW, wave, lane); SEAM(0); }

    for (int l = 0; l < 4; ++l) {
        const int pb = 1 + l * PH_PER_LAYER;
        const bool moe = (l & 1) != 0; const int fi = l >> 1;
        if (l < 2) {
            for (int rep = 0; rep < REPS(1); ++rep) if (SITE(1) && RUN(pb + 0)) {
                IDS();
                pg8::DenseOrder S; S.init(MP / 256, M_INP / 256, G, (int)blockIdx.x);
                EpiProj E{(bf16_t*)(ws + WS_PROJ), (float*)(ws + WS_GATES), (const float*)(ws + WS_SMALL) + SM_BGATE + l * 16};
                pg8::gemm_phase(lds, (const bf16_t*)(ws + WS_HB), (const bf16_t*)(ws + WS_WIN) + (size_t)l * M_INP * D, D, S, E);
                SEAM(pb + 0); }
            for (int rep = 0; rep < REPS(2); ++rep) if (SITE(2) && RUN(pb + 1)) { IDS(); mlstm_phase<1>(ws, lds, l, tid, wave, lane); SEAM(pb + 1); }
            for (int rep = 0; rep < REPS(3); ++rep) if (SITE(3) && RUN(pb + 2)) { IDS(); mlstm_phase<2>(ws, lds, l, tid, wave, lane); SEAM(pb + 2); }
        } else {
            for (int rep = 0; rep < REPS(4); ++rep) if (SITE(4) && RUN(pb + 0)) {
                IDS();
                pg8::DenseOrder S; S.init(MP / 256, l == 2 ? 6 : 4, G, (int)blockIdx.x);
                EpiQKV E{(bf16_t*)(ws + WS_PROJ), (bf16_t*)(ws + WS_KB), (bf16_t*)(ws + WS_VB), (const float*)(ws + WS_ROPE)};
                pg8::gemm_phase(lds, (const bf16_t*)(ws + WS_HB), (const bf16_t*)(ws + (l == 2 ? WS_WQKV : WS_WQ3)), D, S, E);
                SEAM(pb + 0); }
            for (int rep = 0; rep < REPS(5); ++rep) if (SITE(5) && RUN(pb + 1)) { IDS(); attn_phase(ws, lds, l - 2, tid, wave, lane); SEAM(pb + 1); }
        }
        for (int rep = 0; rep < REPS(6); ++rep) if (SITE(6) && RUN(pb + 3)) {
            IDS();
            pg8::DenseOrder S; S.init(MP / 256, 4, G, (int)blockIdx.x);
            EpiRes E{(float*)(ws + WS_H)};
            pg8::gemm_phase(lds, (const bf16_t*)(ws + WS_HG), (const bf16_t*)(ws + (l < 2 ? WS_WOUT : WS_WO)) + (size_t)(l & 1) * D * D, D, S, E);
            SEAM(pb + 3); }
        for (int rep = 0; rep < REPS(7); ++rep) if (SITE(7) && RUN(pb + 4)) { IDS(); ln_phase(ws, nullptr, lds, gw, NGW, lane, tid, l * 2 + 0, false, moe, fi, false); SEAM(pb + 4); }
        if (!moe) {
            for (int rep = 0; rep < REPS(8); ++rep) if (SITE(8) && RUN(pb + 5)) {
                IDS();
                pg8::DenseOrder S; S.init(MP / 256, 2 * D_FF / 256, G, (int)blockIdx.x);
                EpiSwiglu E{(bf16_t*)(ws + WS_ACT), D_FF};
                pg8::gemm_phase(lds, (const bf16_t*)(ws + WS_HB), (const bf16_t*)(ws + WS_WGU) + (size_t)fi * 2 * D_FF * D, D, S, E);
                SEAM(pb + 5); }
            for (int rep = 0; rep < REPS(9); ++rep) if (SITE(9) && RUN(pb + 6)) {
                IDS();
                pg8::DenseOrder S; S.init(MP / 256, 4, G, (int)blockIdx.x);
                EpiRes E{(float*)(ws + WS_H)};
                pg8::gemm_phase(lds, (const bf16_t*)(ws + WS_ACT), (const bf16_t*)(ws + WS_WDN) + (size_t)fi * D * D_FF, D_FF, S, E);
                SEAM(pb + 6); }
        } else {
            for (int rep = 0; rep < REPS(10); ++rep) if (SITE(10) && RUN(pb + 5)) { IDS(); assign_phase(ws, gw, NGW, lane, tid, fi); SEAM(pb + 5); }
            for (int rep = 0; rep < REPS(11); ++rep) if (SITE(11) && RUN(pb + 6)) {
                IDS();
                int cnt[8]; pg8::GroupedOrder S; moe_starts(ws, fi, cnt, S.pstart);
                S.o.init(S.pstart[8], 2 * D_FF_EXP / 256, G, (int)blockIdx.x); S.nexp_rows = 2 * D_FF_EXP; S.rowtok = (const int*)(ws + WS_ROWTOK);
                EpiSwiglu E{(bf16_t*)(ws + WS_ACT), D_FF_EXP};
                pg8::gemm_phase(lds, (const bf16_t*)(ws + WS_HB), (const bf16_t*)(ws + WS_WGUE) + (size_t)fi * 8 * 2 * D_FF_EXP * D, D, S, E);
                SEAM(pb + 6); }
            for (int rep = 0; rep < REPS(12); ++rep) if (SITE(12) && RUN(pb + 7)) {
                IDS();
                int cnt[8]; pg8::GroupedOrder S; moe_starts(ws, fi, cnt, S.pstart);
                S.o.init(S.pstart[8], 4, G, (int)blockIdx.x); S.nexp_rows = D; S.rowtok = nullptr;
                EpiScatter E{(float*)(ws + WS_CONTRIB), (const int*)(ws + WS_ROWDST), (const float*)(ws + WS_ROWGATE)};
                pg8::gemm_phase(lds, (const bf16_t*)(ws + WS_ACT), (const bf16_t*)(ws + WS_WDNE) + (size_t)fi * 8 * D * D_FF_EXP, D_FF_EXP, S, E);
                SEAM(pb + 7); }
        }
        for (int rep = 0; rep < REPS(13); ++rep) if (SITE(13) && RUN(pb + 10)) { IDS(); ln_phase(ws, P.out, lds, gw, NGW, lane, tid, l * 2 + 1, moe, false, 0, l == 3); SEAM(pb + 10); }
    }
#undef RUN
#undef SEAM
#undef IDS
}

extern "C" void kernel_launch(void* const* d_in, const int* in_sizes, int n_in, void* d_out, int out_size, void* d_ws, size_t ws_size, hipStream_t stream) {
    static int grid = 0;
    if (grid == 0) {
        if (n_in != 18 || out_size != MREAL * D || ws_size < WS_END) { fprintf(stderr, "kernel_launch: unexpected shapes (n_in %d, out %d, ws %zu < %zu)\n", n_in, out_size, ws_size, (size_t)WS_END); grid = -1; return; }
        int dev = 0, cus = 0, per_cu = 0;
        if (hipGetDevice(&dev) != hipSuccess || hipDeviceGetAttribute(&cus, hipDeviceAttributeMultiprocessorCount, dev) != hipSuccess) { grid = -1; return; }
        if (hipFuncSetAttribute((const void*)fwd, hipFuncAttributeMaxDynamicSharedMemorySize, LDS_BYTES) != hipSuccess) { fprintf(stderr, "kernel_launch: hipFuncSetAttribute failed\n"); grid = -1; return; }
        if (hipOccupancyMaxActiveBlocksPerMultiprocessor(&per_cu, (const void*)fwd, NTHREADS, LDS_BYTES) != hipSuccess || per_cu < 1) fprintf(stderr, "kernel_launch: occupancy query reports %d\n", per_cu);
        (void)hipGetLastError();
        grid = cus > 256 ? 256 : cus;
    }
    if (grid < 0) return;
    (void)in_sizes;
    if (hipMemsetAsync((char*)d_ws + WS_CTL, 0, CTL_BYTES, stream) != hipSuccess) return;
    Params p{};
    for (int i = 0; i < 18; ++i) p.in[i] = (const float*)d_in[i];
    p.out = (float*)d_out; p.ws = (unsigned char*)d_ws;
#if MK_PER_PHASE
    int li = 0;
    for (int ph = 0; ph < N_PHASES; ++ph) {
        const int k = (ph - 1) % PH_PER_LAYER, l = (ph - 1) / PH_PER_LAYER;
        if (ph > 0) { const bool moe = l & 1; if (k == 2 && l >= 2) continue; if (k == 8 || k == 9 || k == 11) continue; if (k == 7 && !moe) continue; }
        p.ph_lo = ph; p.ph_hi = ph + 1; p.li = li++; p.pad = 0;
        hipLaunchKernelGGL(fwd, dim3(grid), dim3(NTHREADS), LDS_BYTES, stream, p);
    }
#else
    p.ph_lo = 0; p.ph_hi = N_PHASES; p.li = 0; p.pad = 0;
    hipLaunchKernelGGL(fwd, dim3(grid), dim3(NTHREADS), LDS_BYTES, stream, p);
#endif
}
```

```cpp
#include <hip/hip_runtime.h>
#include <cstdio>
#include <cstdint>

#define LAS __attribute__((address_space(3)))
#define GAS __attribute__((address_space(1)))
typedef unsigned short bf16_t;
typedef short bf16x8 __attribute__((ext_vector_type(8)));
typedef float f32x4 __attribute__((ext_vector_type(4)));
typedef float f32x2 __attribute__((ext_vector_type(2)));
typedef unsigned u32x4 __attribute__((ext_vector_type(4)));
typedef unsigned u32x2 __attribute__((ext_vector_type(2)));

constexpr int D = 1024, NBATCH = 4, SEQ = 8192, NMETA = 16;
constexpr int MREAL = NBATCH * SEQ;
constexpr int MV = MREAL + NMETA;
constexpr int MP = 129 * 256;
constexpr int M_HEADS = 8, M_QK = 64, M_V = 128;
constexpr int M_IN = 3088, M_INP = 3328;
constexpr int PROJ_LD = 3072;
constexpr int A_HEADS = 16, A_KV = 4, A_HD = 64, WINDOW = 128;
constexpr int D_FF = 2816, N_EXP = 8, D_FF_EXP = 3584;
constexpr float ALPHA = 1.681792830507429f;
constexpr float LN_EPS = 1e-5f;
constexpr int RP = 265 * 256;
constexpr int NSEG = 8, SEG_CHUNKS = 16;
constexpr int ST_FLOATS = 8 * 5 * 64 * 4;

constexpr size_t MiB = 1u << 20;
constexpr size_t al(size_t x) { return (x + 4095) & ~(size_t)4095; }
constexpr size_t WS_CTL = 0, CTL_BYTES = 1 * MiB;
constexpr size_t WS_WIN = WS_CTL + CTL_BYTES;
constexpr size_t WS_WOUT = WS_WIN + al((size_t)2 * M_INP * D * 2);
constexpr size_t WS_WQKV = WS_WOUT + al((size_t)2 * D * D * 2);
constexpr size_t WS_WQ3 = WS_WQKV + al((size_t)1536 * D * 2);
constexpr size_t WS_WO = WS_WQ3 + al((size_t)D * D * 2);
constexpr size_t WS_WGU = WS_WO + al((size_t)2 * D * D * 2);
constexpr size_t WS_WDN = WS_WGU + al((size_t)2 * 2 * D_FF * D * 2);
constexpr size_t WS_WGUE = WS_WDN + al((size_t)2 * D * D_FF * 2);
constexpr size_t WS_WDNE = WS_WGUE + al((size_t)16 * 2 * D_FF_EXP * D * 2);
constexpr size_t WS_H = WS_WDNE + al((size_t)16 * D * D_FF_EXP * 2);
constexpr size_t WS_HB = WS_H + al((size_t)MP * D * 4);
constexpr size_t WS_PROJ = WS_HB + al((size_t)MP * D * 2);
constexpr size_t WS_HG = WS_PROJ + (size_t)MP * PROJ_LD * 2;
constexpr size_t WS_CONTRIB = WS_PROJ;
constexpr size_t WS_KB = WS_HG + al((size_t)MP * D * 2);
constexpr size_t WS_VB = WS_KB + al((size_t)MP * 256 * 2);
constexpr size_t WS_GATES = WS_VB + al((size_t)MP * 256 * 2);
constexpr size_t WS_ACT = WS_GATES + al((size_t)MP * 16 * 4);
constexpr size_t WS_STATE = WS_ACT + al((size_t)RP * D_FF_EXP * 2);
constexpr size_t WS_STSC = WS_STATE + al((size_t)32 * 7 * ST_FLOATS * 4);
constexpr size_t WS_ROPE = WS_STSC + al((size_t)32 * 7 * 4 * 4);
constexpr size_t WS_TOPE = WS_ROPE + al((size_t)8208 * 16 * 4);
constexpr size_t WS_TOPG = WS_TOPE + al((size_t)MP * 4);
constexpr size_t WS_ROWTOK = WS_TOPG + al((size_t)MP * 8);
constexpr size_t WS_ROWDST = WS_ROWTOK + al((size_t)RP * 4);
constexpr size_t WS_ROWGATE = WS_ROWDST + al((size_t)RP * 4);
constexpr size_t WS_STATS = WS_ROWGATE + al((size_t)RP * 4);
constexpr size_t WS_SMALL = WS_STATS + al((size_t)MP * 8);
constexpr int SM_BGATE = 0, SM_SINKS = 32, SM_BROUTER = 64, SM_LNH = 128, SM_LNG = SM_LNH + 2 * D, SM_LNB = SM_LNG + 8 * D, SM_WROUTER = SM_LNB + 8 * D, SM_END = SM_WROUTER + 2 * D * N_EXP;
constexpr size_t WS_END = WS_SMALL + al((size_t)SM_END * 4);
static_assert((size_t)MP * 2 * D * 4 <= (WS_KB - WS_PROJ), "contrib overlay fits PROJ+HG");

constexpr int CW_CNT = 1024;
constexpr int CW_CUR = 1024 + 256;
constexpr int CW_BAR = 16384;

constexpr int LDS_BYTES = 163840 - 512;
constexpr int RING_BYTES = 131072;
constexpr int MISC_OFF = LDS_BYTES - 256;

__device__ __forceinline__ unsigned f2bf(float f) { unsigned u = __builtin_bit_cast(unsigned, f); return (u + 0x7fffu + ((u >> 16) & 1u)) >> 16; }
__device__ __forceinline__ unsigned pk2(float lo, float hi) { return f2bf(lo) | (f2bf(hi) << 16); }
__device__ __forceinline__ unsigned cvt_pk_bf16(float lo, float hi) { unsigned r; asm volatile("v_cvt_pk_bf16_f32 %0, %1, %2" : "=v"(r) : "v"(lo), "v"(hi)); return r; }
__device__ __forceinline__ float bf2f(unsigned short b) { return __builtin_bit_cast(float, ((unsigned)b) << 16); }
__device__ __forceinline__ float wave_sum(float v) {
#pragma unroll
    for (int o = 1; o < 64; o <<= 1) v += __shfl_xor(v, o);
    return v;
}
__device__ __forceinline__ float fast_exp(float x) { return __builtin_amdgcn_exp2f(x * 1.4426950408889634f); }
#define LDS_WAIT() asm volatile("s_waitcnt lgkmcnt(0)" ::: "memory")
#define VM_WAIT() asm volatile("s_waitcnt vmcnt(0)" ::: "memory")

#define XB_TMO      128
#define XB_XCNT(j)  (256  + 64 * (j))
#define XB_XSUB(j)  (1280 + 64 * (j))
#define XB_XGEN(j)  (2304 + 64 * (j))
#define XB_TOP      3328
#define XB_TOPGEN   3392
#define XCD_BAR_WORDS 3456
#define XB_SPIN_CAP (1u << 18)
__device__ __forceinline__ unsigned xb_ld(unsigned* p)              { return __hip_atomic_load(p, __ATOMIC_RELAXED, __HIP_MEMORY_SCOPE_AGENT); }
__device__ __forceinline__ unsigned xb_add(unsigned* p, unsigned v) { return __hip_atomic_fetch_add(p, v, __ATOMIC_RELAXED, __HIP_MEMORY_SCOPE_AGENT); }
__device__ __forceinline__ unsigned xb_xcc_id() { return (unsigned)__builtin_amdgcn_s_getreg((3 << 11) | 20) & 0xFu; }
#define XB_SPIN(cond, bar) do { unsigned _sp = 0; while (cond) { __builtin_amdgcn_s_sleep(1); \
    if ((++_sp & 255u) == 0u) { if (xb_ld(&(bar)[XB_TMO])) break; if (_sp > XB_SPIN_CAP) { atomicAdd(&(bar)[XB_TMO], 1u); break; } } } } while (0)
struct XcdBarrier { unsigned* bar; unsigned x; volatile LAS unsigned* st; };
__device__ __forceinline__ XcdBarrier xcd_barrier_post(unsigned* bar, volatile LAS unsigned* st) {
    XcdBarrier b; b.bar = bar; b.x = xb_xcc_id(); b.st = st;
    if (threadIdx.x == 0) (void)xb_add(&bar[XB_XCNT(b.x)], 1u);
    return b;
}
__device__ __forceinline__ void xcd_barrier_complete(unsigned* bar, unsigned x, unsigned& nloc, unsigned& nx) {
    const unsigned G = gridDim.x * gridDim.y * gridDim.z;
    unsigned sum, cnt, mine, sp = 0u;
    for (;;) {
        sum = 0u; cnt = 0u; mine = 0u;
#pragma unroll
        for (unsigned j = 0; j < 16; ++j) { const unsigned c = xb_ld(&bar[XB_XCNT(j)]); sum += c; cnt += (c > 0u) ? 1u : 0u; mine = (j == x) ? c : mine; }
        if (sum == G) break;
        __builtin_amdgcn_s_sleep(1);
        if ((++sp & 255u) == 0u) { if (xb_ld(&bar[XB_TMO])) break; if (sp > XB_SPIN_CAP) { atomicAdd(&bar[XB_TMO], 1u); break; } }
    }
    nloc = mine > 0u ? mine : 1u; nx = cnt > 0u ? cnt : 1u;
}
__device__ __forceinline__ void xcd_barrier(const XcdBarrier& b) {
    asm volatile("s_waitcnt vmcnt(0)" ::: "memory");
    __syncthreads();
    if (threadIdx.x == 0) {
        unsigned* bar = b.bar;
        __builtin_amdgcn_s_waitcnt(0);
        unsigned nloc = b.st[0], nx = b.st[1];
        if (nloc == 0u) { xcd_barrier_complete(bar, b.x, nloc, nx); b.st[0] = nloc; b.st[1] = nx; }
        const unsigned old = xb_add(&bar[XB_XSUB(b.x)], 1u);
        const unsigned gen = old / nloc;
        if (old + 1u == (gen + 1u) * nloc) {
            __builtin_amdgcn_fence(__ATOMIC_RELEASE, "agent");
            asm volatile("s_waitcnt vmcnt(0)" ::: "memory");
            const unsigned og = xb_add(&bar[XB_TOP], 1u);
            const unsigned tg = og / nx;
            if (og + 1u == (tg + 1u) * nx) xb_add(&bar[XB_TOPGEN], 1u);
            else XB_SPIN(xb_ld(&bar[XB_TOPGEN]) == tg, bar);
            __builtin_amdgcn_fence(__ATOMIC_ACQUIRE, "agent");
            xb_add(&bar[XB_XGEN(b.x)], 1u);
            asm volatile("s_waitcnt vmcnt(0)" ::: "memory");
        } else {
            XB_SPIN(xb_ld(&bar[XB_XGEN(b.x)]) == gen, bar);
            __builtin_amdgcn_fence(__ATOMIC_ACQUIRE, "agent");
            asm volatile("s_waitcnt vmcnt(0)" ::: "memory");
        }
    }
    __syncthreads();
}

namespace pg8 {
constexpr int BM = 256, BK = 64, HALF = 128, HTB = HALF * BK * 2, STAGE_BYTES = 8 * HTB, NXCD = 8, WGM = 8;
__host__ __device__ __forceinline__ int lds_byte(int r, int c) { const int st = (r >> 4) * 2 + (c >> 5), rr = r & 15, cc = c & 31, ob = rr * 64 + cc * 2; return st * 1024 + (ob ^ (((ob >> 9) & 1) << 5)); }
__host__ __device__ __forceinline__ void stage_rc(int b, int& R, int& C) { const int st = b / 1024, sb = b % 1024, swz = sb ^ (((sb >> 9) & 1) << 5); R = (st >> 1) * 16 + swz / 64; C = (st & 1) * 32 + (swz % 64) / 2; }
__host__ __device__ __forceinline__ int perm32(int rho) { const int n = rho >> 4, i = rho & 15; return 8 * (i >> 2) + 4 * n + (i & 3); }

struct Unit { int pm, pn, brow; };

struct DenseOrder {
    int nM, nN, nwg, G, c;
    __device__ void init(int nM_, int nN_, int G_, int c_) { nM = nM_; nN = nN_; nwg = nM * nN; G = G_; c = c_; }
    __device__ __forceinline__ bool next(int i, Unit& u) const {
        const long L = (long)i * G + c; if (L >= nwg) return false;
        int wgid = (int)L; { const int q = nwg / NXCD, r = nwg % NXCD, xcd = wgid % NXCD, off = wgid / NXCD; wgid = (xcd < r ? xcd * (q + 1) : r * (q + 1) + (xcd - r) * q) + off; }
        const int nig = WGM * nN, gid = wgid / nig, fm = gid * WGM, gsz = (nM - fm) < WGM ? (nM - fm) : WGM;
        u.pm = fm + ((wgid % nig) % gsz); u.pn = (wgid % nig) / gsz; u.brow = u.pn * BM; return true;
    }
    __device__ __forceinline__ int a_row(const Unit& u, int r) const { return u.pm * BM + r; }
};
struct GroupedOrder {
    DenseOrder o; int pstart[9]; int nexp_rows;
    const int* rowtok;
    __device__ __forceinline__ bool next(int i, Unit& u) const {
        if (!o.next(i, u)) return false;
        int e = 0;
#pragma unroll
        for (int k = 1; k < 8; ++k) e += (u.pm >= pstart[k]) ? 1 : 0;
        u.brow = e * nexp_rows + u.pn * BM; return true;
    }
    __device__ __forceinline__ int a_row(const Unit& u, int r) const {
        const int pos = u.pm * BM + r; if (!rowtok) return pos;
        const int t = rowtok[pos]; return t < 0 ? 0 : t;
    }
};

template <class Epi, class Sched>
__device__ __forceinline__ void gemm_phase(LAS unsigned char* lds, const bf16_t* Abase, const bf16_t* Btbase, const int K, const Sched& S, const Epi& E) {
    int tid = threadIdx.x; asm volatile("; opaque tid" : "+v"(tid));
    const int wid = __builtin_amdgcn_readfirstlane(tid >> 6), lane = tid & 63, wr = wid >> 2, wc = wid & 3, fr = lane & 15, fq = lane >> 4;
    const int nt = K / BK;
    unsigned voffB[2];
#pragma unroll
    for (int i = 0; i < 2; ++i) { int R, C; stage_rc(tid * 16 + i * 8192, R, C); const int Rb = Epi::PERM ? ((R & ~31) + perm32(R & 31)) : R; voffB[i] = (unsigned)(Rb * K + C) * 2u; }
    const size_t kstep = (size_t)(BK * 2);
    const size_t hstep = (size_t)HALF * K * 2;
    const unsigned ldsw = (unsigned)wid * 1024u;
    const int aoff = lds_byte(wr * 64 + fr, fq * 8), boff = lds_byte(wc * 32 + fr, fq * 8);
#define PG8_SA(b, h) (((b) * 2 + (h)) * HTB)
#define PG8_SB(b, h) ((4 + (b) * 2 + (h)) * HTB)
#define PG8_STAGE(bufoff, gbase, voff) do { const char* _gb = (const char*)(gbase); asm volatile("" : "+s"(_gb)); _Pragma("unroll") for (int _i = 0; _i < 2; ++_i) \
        __builtin_amdgcn_global_load_lds((const unsigned*)(_gb + (voff)[_i]), (LAS unsigned*)(lds + (bufoff) + ldsw + _i * 8192), 16, 0, 0); } while (0)
#define PG8_LDA(dst, b, h) do { _Pragma("unroll") for (int m = 0; m < 4; ++m) _Pragma("unroll") for (int k = 0; k < 2; ++k) dst[m][k] = *(const LAS bf16x8*)(lds + PG8_SA(b, h) + aoff + m * 2048 + k * 1024); } while (0)
#define PG8_LDB(dst, b, h) do { _Pragma("unroll") for (int n = 0; n < 2; ++n) _Pragma("unroll") for (int k = 0; k < 2; ++k) dst[n][k] = *(const LAS bf16x8*)(lds + PG8_SB(b, h) + boff + n * 2048 + k * 1024); } while (0)
#define PG8_MMA(ai, bj, At, Bt) do { __builtin_amdgcn_s_setprio(1); _Pragma("unroll") for (int m = 0; m < 4; ++m) _Pragma("unroll") for (int n = 0; n < 2; ++n) _Pragma("unroll") for (int k = 0; k < 2; ++k) \
        acc[ai][bj][m][n] = __builtin_amdgcn_mfma_f32_16x16x32_bf16(Bt[n][k], At[m][k], acc[ai][bj][m][n], 0, 0, 0); __builtin_amdgcn_s_setprio(0); } while (0)
#define PG8_WAIT_V(n) asm volatile("s_waitcnt vmcnt(" #n ")" ::: "memory")
#define PG8_WAIT_L(n) asm volatile("s_waitcnt lgkmcnt(" #n ")" ::: "memory")
#define PG8_BAR __builtin_amdgcn_s_barrier()
#define PG8_SCHED __builtin_amdgcn_sched_barrier(0)
#define PG8_AOFF(dst, u) do { _Pragma("unroll") for (int _i = 0; _i < 2; ++_i) { int _R, _C; stage_rc(tid * 16 + _i * 8192, _R, _C); _Pragma("unroll") for (int _h = 0; _h < 2; ++_h) \
        dst[_h][_i] = (unsigned)(((size_t)S.a_row(u, _h * HALF + _R) * K + _C) * 2u); } } while (0)
    Unit cur, nxt; int ui = 0;
    if (!S.next(0, cur)) return;
    f32x4 acc[2][2][4][2];
#pragma unroll
    for (int a = 0; a < 2; ++a)
#pragma unroll
        for (int b = 0; b < 2; ++b)
#pragma unroll
            for (int m = 0; m < 4; ++m)
#pragma unroll
                for (int n = 0; n < 2; ++n) acc[a][b][m][n] = (f32x4){0.f, 0.f, 0.f, 0.f};
    bf16x8 At[4][2], B0[2][2], B1[2][2];
    unsigned cao[2][2];
    PG8_AOFF(cao, cur);
    const char* cA = (const char*)Abase; const char* cB = (const char*)Btbase + (size_t)cur.brow * K * 2;
    PG8_STAGE(PG8_SB(0, 0), cB, voffB); PG8_STAGE(PG8_SB(0, 1), cB + hstep, voffB); PG8_STAGE(PG8_SA(0, 0), cA, cao[0]); PG8_STAGE(PG8_SA(0, 1), cA, cao[1]);
    if (wr == 1) PG8_BAR;
    PG8_WAIT_V(2); PG8_BAR;
    PG8_STAGE(PG8_SB(1, 0), cB + kstep, voffB); PG8_STAGE(PG8_SA(1, 0), cA + kstep, cao[0]); PG8_STAGE(PG8_SB(1, 1), cB + hstep + kstep, voffB);
    PG8_WAIT_V(6); PG8_BAR;
    for (;;) {
        const bool has_next = S.next(ui + 1, nxt);
        const char* nB = has_next ? (const char*)Btbase + (size_t)nxt.brow * K * 2 : cB;
        for (int t = 0; t < nt; t += 2) {
            const bool last = (t == nt - 2);
            const char* a1 = cA + (size_t)(t + 1) * kstep;
            const char* a2 = last ? cA : cA + (size_t)(t + 2) * kstep; const char* b2 = last ? nB : cB + (size_t)(t + 2) * kstep;
            const char* a3 = a2 + kstep; const char* b3 = b2 + kstep;
            PG8_LDB(B0, 0, 0); PG8_LDB(B1, 0, 1); PG8_SCHED; PG8_LDA(At, 0, 0); PG8_STAGE(PG8_SA(1, 1), a1, cao[1]);
            if (last && has_next) { PG8_AOFF(cao, nxt); }
            PG8_WAIT_V(8); PG8_WAIT_L(0); PG8_BAR; PG8_MMA(0, 0, At, B0); PG8_MMA(0, 1, At, B1); PG8_BAR; PG8_SCHED;
            PG8_LDA(At, 0, 1); PG8_STAGE(PG8_SB(0, 0), b2, voffB); PG8_STAGE(PG8_SB(0, 1), b2 + hstep, voffB); PG8_STAGE(PG8_SA(0, 0), a2, cao[0]);
            PG8_WAIT_V(8); PG8_WAIT_L(0); PG8_BAR; PG8_MMA(1, 0, At, B0); PG8_MMA(1, 1, At, B1); PG8_BAR; PG8_SCHED;
            PG8_LDB(B0, 1, 0); PG8_LDB(B1, 1, 1); PG8_SCHED; PG8_LDA(At, 1, 0); PG8_STAGE(PG8_SA(0, 1), a2, cao[1]);
            PG8_WAIT_V(8); PG8_WAIT_L(0); PG8_BAR; PG8_MMA(0, 0, At, B0); PG8_MMA(0, 1, At, B1); PG8_BAR; PG8_SCHED;
            PG8_LDA(At, 1, 1); PG8_STAGE(PG8_SB(1, 0), b3, voffB); PG8_STAGE(PG8_SB(1, 1), b3 + hstep, voffB); PG8_STAGE(PG8_SA(1, 0), a3, cao[0]);
            PG8_WAIT_V(8); PG8_WAIT_L(0); PG8_BAR; PG8_MMA(1, 0, At, B0); PG8_MMA(1, 1, At, B1); PG8_BAR; PG8_SCHED;
        }
        if (wr == 0) PG8_BAR;
        E(acc, cur, wr, wc, fr, fq);
        if (!has_next) break;
#pragma unroll
        for (int a = 0; a < 2; ++a)
#pragma unroll
            for (int b = 0; b < 2; ++b)
#pragma unroll
                for (int m = 0; m < 4; ++m)
#pragma unroll
                    for (int n = 0; n < 2; ++n) acc[a][b][m][n] = (f32x4){0.f, 0.f, 0.f, 0.f};
        cur = nxt; cB = nB; ++ui;
        if (wr == 1) PG8_BAR;
    }
    PG8_WAIT_V(0);
    PG8_BAR;
#undef PG8_SA
#undef PG8_SB
#undef PG8_STAGE
#undef PG8_LDA
#undef PG8_LDB
#undef PG8_MMA
#undef PG8_WAIT_V
#undef PG8_WAIT_L
#undef PG8_BAR
#undef PG8_SCHED
#undef PG8_AOFF
}
}

typedef f32x4 AccT[2][2][4][2];

struct EpiProj {
    static constexpr bool PERM = true;
    bf16_t* proj; float* gates; const float* bgate;
    __device__ __forceinline__ void operator()(const AccT& acc, const pg8::Unit& u, int wr, int wc, int fr, int fq) const {
        const int row0 = u.pm * 256 + wr * 64 + fr;
        if (u.pn < 12) {
            const int col0 = u.pn * 256 + wc * 32 + 8 * fq;
#pragma unroll
            for (int ai = 0; ai < 2; ++ai)
#pragma unroll
                for (int m = 0; m < 4; ++m) { bf16_t* rowp = proj + (size_t)(row0 + ai * 128 + m * 16) * PROJ_LD + col0;
#pragma unroll
                    for (int bj = 0; bj < 2; ++bj) { const f32x4 v0 = acc[ai][bj][m][0], v1 = acc[ai][bj][m][1];
                        u32x4 w; w.x = cvt_pk_bf16(v0[0], v0[1]); w.y = cvt_pk_bf16(v0[2], v0[3]); w.z = cvt_pk_bf16(v1[0], v1[1]); w.w = cvt_pk_bf16(v1[2], v1[3]);
                        *(u32x4*)(rowp + bj * 128) = w; } }
        } else if (wc == 0 && fq < 2) {
#pragma unroll
            for (int n = 0; n < 2; ++n) { const f32x4 bv = *(const f32x4*)(bgate + 8 * fq + 4 * n);
#pragma unroll
                for (int ai = 0; ai < 2; ++ai)
#pragma unroll
                    for (int m = 0; m < 4; ++m) *(f32x4*)(gates + (size_t)(row0 + ai * 128 + m * 16) * 16 + 8 * fq + 4 * n) = acc[ai][0][m][n] + bv; }
        }
    }
};
struct EpiRes {
    static constexpr bool PERM = false;
    float* H; const float* stats; const float* lg; const float* lb;
    __device__ __forceinline__ void operator()(const AccT& acc, const pg8::Unit& u, int wr, int wc, int fr, int fq) const {
        const int row0 = u.pm * 256 + wr * 64 + fr, col0 = u.pn * 256 + wc * 32 + 4 * fq;
        f32x4 gv[2][2], bv[2][2];
        if (lg) {
#pragma unroll
            for (int bj = 0; bj < 2; ++bj)
#pragma unroll
                for (int n = 0; n < 2; ++n) { gv[bj][n] = *(const f32x4*)(lg + col0 + bj * 128 + n * 16); bv[bj][n] = *(const f32x4*)(lb + col0 + bj * 128 + n * 16); } }
#pragma unroll
        for (int ai = 0; ai < 2; ++ai)
#pragma unroll
            for (int m = 0; m < 4; ++m) { const int row = row0 + ai * 128 + m * 16; float* rowp = H + (size_t)row * D + col0;
                f32x2 st = (f32x2){0.f, 1.f}; if (lg) st = *(const f32x2*)(stats + 2 * (size_t)row);
#pragma unroll
                for (int bj = 0; bj < 2; ++bj)
#pragma unroll
                    for (int n = 0; n < 2; ++n) { float* p = rowp + bj * 128 + n * 16; f32x4 h = *(const f32x4*)p;
                        if (lg) h = (h - st.x) * st.y * gv[bj][n] + bv[bj][n];
                        *(f32x4*)p = h * ALPHA + acc[ai][bj][m][n]; } }
    }
};
struct EpiSwiglu {
    static constexpr bool PERM = true;
    bf16_t* act; int ld;
    __device__ __forceinline__ static float silu_mul(float g, float u) { return g * u * __builtin_amdgcn_rcpf(1.0f + __builtin_amdgcn_exp2f(-g * 1.4426950408889634f)); }
    __device__ __forceinline__ void operator()(const AccT& acc, const pg8::Unit& u, int wr, int wc, int fr, int fq) const {
        const int row0 = u.pm * 256 + wr * 64 + fr, col0 = u.pn * 128 + wc * 32 + 8 * fq;
#pragma unroll
        for (int ai = 0; ai < 2; ++ai)
#pragma unroll
            for (int m = 0; m < 4; ++m) { const f32x4 g0 = acc[ai][0][m][0], g1 = acc[ai][0][m][1], u0 = acc[ai][1][m][0], u1 = acc[ai][1][m][1];
                u32x4 w; w.x = cvt_pk_bf16(silu_mul(g0[0], u0[0]), silu_mul(g0[1], u0[1])); w.y = cvt_pk_bf16(silu_mul(g0[2], u0[2]), silu_mul(g0[3], u0[3]));
                w.z = cvt_pk_bf16(silu_mul(g1[0], u1[0]), silu_mul(g1[1], u1[1])); w.w = cvt_pk_bf16(silu_mul(g1[2], u1[2]), silu_mul(g1[3], u1[3]));
                *(u32x4*)(act + (size_t)(row0 + ai * 128 + m * 16) * ld + col0) = w; }
    }
};
struct EpiScatter {
    static constexpr bool PERM = false;
    float* contrib; const int* rowdst; const float* rowgate;
    __device__ __forceinline__ void operator()(const AccT& acc, const pg8::Unit& u, int wr, int wc, int fr, int fq) const {
        const int row0 = u.pm * 256 + wr * 64 + fr, col0 = u.pn * 256 + wc * 32 + 4 * fq;
#pragma unroll
        for (int ai = 0; ai < 2; ++ai)
#pragma unroll
            for (int m = 0; m < 4; ++m) { const int pos = row0 + ai * 128 + m * 16; const int d = rowdst[pos];
                if (d >= 0) { const float g = rowgate[pos]; float* rowp = contrib + (size_t)d * D + col0;
#pragma unroll
                    for (int bj = 0; bj < 2; ++bj)
#pragma unroll
                        for (int n = 0; n < 2; ++n) *(f32x4*)(rowp + bj * 128 + n * 16) = acc[ai][bj][m][n] * g; } }
    }
};
struct EpiQKV {
    static constexpr bool PERM = true;
    bf16_t *Q, *KB, *VB; const float* rope;
    __device__ __forceinline__ void operator()(const AccT& acc, const pg8::Unit& u, int wr, int wc, int fr, int fq) const {
        const int row0 = u.pm * 256 + wr * 64 + fr, cl = wc * 32 + 8 * fq;
        bf16_t* base; int ld;
        if (u.pn == 5) {
#pragma unroll
            for (int ai = 0; ai < 2; ++ai)
#pragma unroll
                for (int m = 0; m < 4; ++m) { const int row = row0 + ai * 128 + m * 16;
#pragma unroll
                    for (int bj = 0; bj < 2; ++bj)
#pragma unroll
                        for (int n = 0; n < 2; ++n)
#pragma unroll
                            for (int j = 0; j < 4; ++j) VB[(size_t)(bj * 128 + cl + 4 * n + j) * MP + row] = (bf16_t)f2bf(acc[ai][bj][m][n][j]); }
            return; }
        if (u.pn < 4) { base = Q + u.pn * 256 + cl; ld = D; } else { base = KB + cl; ld = 256; }
        const bool dorope = (u.pn <= 4) && ((wc & 1) == 0);
#pragma unroll
        for (int ai = 0; ai < 2; ++ai)
#pragma unroll
            for (int m = 0; m < 4; ++m) { const int row = row0 + ai * 128 + m * 16;
                f32x4 v[2][2];
#pragma unroll
                for (int bj = 0; bj < 2; ++bj)
#pragma unroll
                    for (int n = 0; n < 2; ++n) v[bj][n] = acc[ai][bj][m][n];
                if (dorope) {
                    int pos = row < MREAL ? (row & (SEQ - 1)) + NMETA : row - MREAL; pos = pos > SEQ + NMETA - 1 ? SEQ + NMETA - 1 : pos;
                    const float* rp = rope + (size_t)pos * 16;
                    const f32x4 c0 = *(const f32x4*)rp, c1 = *(const f32x4*)(rp + 4), s0 = *(const f32x4*)(rp + 8), s1 = *(const f32x4*)(rp + 12);
#pragma unroll
                    for (int bj = 0; bj < 2; ++bj)
#pragma unroll
                        for (int n = 0; n < 2; ++n) { const f32x4 c = n ? c1 : c0, s = n ? s1 : s0; f32x4 o;
#pragma unroll
                            for (int j = 0; j < 4; ++j) { const float x = v[bj][n][j]; const float y = __shfl_xor(x, 16);
                                o[j] = fq == 0 ? x * c[j] - y * s[j] : (fq == 1 ? x * c[j] + y * s[j] : x); }
                            v[bj][n] = o; }
                }
#pragma unroll
                for (int bj = 0; bj < 2; ++bj) { const f32x4 v0 = v[bj][0], v1 = v[bj][1];
                    u32x4 w; w.x = cvt_pk_bf16(v0[0], v0[1]); w.y = cvt_pk_bf16(v0[2], v0[3]); w.z = cvt_pk_bf16(v1[0], v1[1]); w.w = cvt_pk_bf16(v1[2], v1[3]);
                    *(u32x4*)(base + (size_t)row * ld + bj * 128) = w; } }
    }
};

struct Params { const float* in[18]; float* out; unsigned char* ws; int ph_lo, ph_hi, li, pad; };
enum { I_X = 0, I_META, I_WIN, I_BGATE, I_LNH, I_WOUT, I_WKV, I_WQ, I_SINKS, I_WO, I_WGUD, I_WDND, I_WROUTER, I_BROUTER, I_WGUE, I_WDNE, I_LNG, I_LNB };
constexpr int NWAVES = 8, NTHREADS = 512;

__device__ __forceinline__ void tr_item(const float* W, int Nsrc, int K, bf16_t* WT, int k0, int n0, int drow0, float scale, int nvalid, LAS float* scr, int lane) {
#pragma unroll 8
    for (int i = 0; i < 32; ++i) { const int kk = 2 * i + (lane >> 5), n = lane & 31; scr[kk * 33 + n] = (n < nvalid) ? W[(size_t)(k0 + kk) * Nsrc + n0 + n] * scale : 0.f; }
    LDS_WAIT(); asm volatile("" ::: "memory");
    const int c = lane & 7;
#pragma unroll
    for (int j = 0; j < 4; ++j) { const int n = (lane >> 3) + 8 * j; const LAS float* s = scr + (8 * c) * 33 + n;
        u32x4 o; o.x = pk2(s[0 * 33], s[1 * 33]); o.y = pk2(s[2 * 33], s[3 * 33]); o.z = pk2(s[4 * 33], s[5 * 33]); o.w = pk2(s[6 * 33], s[7 * 33]);
        if (n < nvalid) *(u32x4*)(WT + (size_t)(drow0 + n) * K + k0 + 8 * c) = o; }
    LDS_WAIT(); asm volatile("" ::: "memory");
}
__device__ __forceinline__ int pair_row(int n, int FF) { const int up = n >= FF ? 1 : 0, j = n - up * FF; return 256 * (j >> 7) + 128 * up + (j & 127); }

__device__ __forceinline__ void p0_prologue(const Params& P, LAS unsigned char* lds, int gw, int NGW, int wave, int lane) {
    unsigned char* ws = P.ws;
    LAS float* scr = (LAS float*)(lds + wave * 16384);
    constexpr int IT0 = 16 * 97, IT1 = 16 * 32, IT2 = 16 * 16, IT5 = 16 * 176, IT6 = 44 * 32, IT7 = 16 * 224, IT8 = 56 * 32;
    constexpr int C0 = 2 * IT0, C1 = C0 + 2 * IT1, C2 = C1 + IT2, C3 = C2 + 2 * IT1, C4 = C3 + 2 * IT1, C5 = C4 + 2 * IT5, C6 = C5 + 2 * IT6, C7 = C6 + 16 * IT7, C8 = C7 + 16 * IT8;
    for (int it = gw; it < C8; it += NGW) {
        if (it < C0) { const int mi = it / IT0, r = it % IT0, kb = r / 97, nb = r % 97; const int n0 = nb * 32;
            tr_item(P.in[I_WIN] + (size_t)mi * D * M_IN, M_IN, D, (bf16_t*)(ws + WS_WIN) + (size_t)mi * M_INP * D, kb * 64, n0, n0, n0 < 512 ? 0.125f : 1.f, nb == 96 ? 16 : 32, scr, lane);
        } else if (it < C1) { const int q = it - C0, mi = q / IT1, r = q % IT1, kb = r / 32, nb = r % 32;
            tr_item(P.in[I_WOUT] + (size_t)mi * D * D, D, D, (bf16_t*)(ws + WS_WOUT) + (size_t)mi * D * D, kb * 64, nb * 32, nb * 32, 1.f, 32, scr, lane);
        } else if (it < C2) { const int r = it - C1, kb = r / 16, nb = r % 16;
            tr_item(P.in[I_WKV], 512, D, (bf16_t*)(ws + WS_WQKV), kb * 64, nb * 32, 1024 + nb * 32, 1.f, 32, scr, lane);
        } else if (it < C3) { const int q = it - C2, mi = q / IT1, r = q % IT1, kb = r / 32, nb = r % 32;
            tr_item(P.in[I_WQ] + (size_t)mi * D * D, D, D, (bf16_t*)(ws + (mi ? WS_WQ3 : WS_WQKV)), kb * 64, nb * 32, nb * 32, 0.125f, 32, scr, lane);
        } else if (it < C4) { const int q = it - C3, mi = q / IT1, r = q % IT1, kb = r / 32, nb = r % 32;
            tr_item(P.in[I_WO] + (size_t)mi * D * D, D, D, (bf16_t*)(ws + WS_WO) + (size_t)mi * D * D, kb * 64, nb * 32, nb * 32, 1.f, 32, scr, lane);
        } else if (it < C5) { const int q = it - C4, mi = q / IT5, r = q % IT5, kb = r / 176, nb = r % 176;
            tr_item(P.in[I_WGUD] + (size_t)mi * D * 2 * D_FF, 2 * D_FF, D, (bf16_t*)(ws + WS_WGU) + (size_t)mi * 2 * D_FF * D, kb * 64, nb * 32, pair_row(nb * 32, D_FF), 1.f, 32, scr, lane);
        } else if (it < C6) { const int q = it - C5, mi = q / IT6, r = q % IT6, kb = r / 32, nb = r % 32;
            tr_item(P.in[I_WDND] + (size_t)mi * D_FF * D, D, D_FF, (bf16_t*)(ws + WS_WDN) + (size_t)mi * D * D_FF, kb * 64, nb * 32, nb * 32, 1.f, 32, scr, lane);
        } else if (it < C7) { const int q = it - C6, mi = q / IT7, r = q % IT7, kb = r / 224, nb = r % 224;
            tr_item(P.in[I_WGUE] + (size_t)mi * D * 2 * D_FF_EXP, 2 * D_FF_EXP, D, (bf16_t*)(ws + WS_WGUE) + (size_t)mi * 2 * D_FF_EXP * D, kb * 64, nb * 32, pair_row(nb * 32, D_FF_EXP), 1.f, 32, scr, lane);
        } else { const int q = it - C7, mi = q / IT8, r = q % IT8, kb = r / 32, nb = r % 32;
            tr_item(P.in[I_WDNE] + (size_t)mi * D_FF_EXP * D, D, D_FF_EXP, (bf16_t*)(ws + WS_WDNE) + (size_t)mi * D * D_FF_EXP, kb * 64, nb * 32, nb * 32, 1.f, 32, scr, lane);
        }
    }
    { float* sm = (float*)(ws + WS_SMALL); const int gt = gw * 64 + lane, NT = NGW * 64;
      for (int i = gt; i < SM_END; i += NT) { float v = 0.f;
          if (i < SM_SINKS) v = P.in[I_BGATE][i]; else if (i < SM_BROUTER) v = P.in[I_SINKS][i - SM_SINKS]; else if (i < SM_BROUTER + 16) v = P.in[I_BROUTER][i - SM_BROUTER];
          else if (i < SM_LNH) v = 0.f; else if (i < SM_LNG) v = P.in[I_LNH][i - SM_LNH]; else if (i < SM_LNB) v = P.in[I_LNG][i - SM_LNG]; else if (i < SM_WROUTER) v = P.in[I_LNB][i - SM_LNB]; else v = P.in[I_WROUTER][i - SM_WROUTER];
          sm[i] = v; } }
    { float* H = (float*)(ws + WS_H); bf16_t* HB = (bf16_t*)(ws + WS_HB);
      const size_t gt = (size_t)gw * 64 + lane, NT = (size_t)NGW * 64;
      for (size_t i = gt; i < (size_t)MV * (D / 4); i += NT) { const size_t row = i >> 8; const int c4 = (int)(i & 255);
          const f32x4 v = row < MREAL ? ((const f32x4*)P.in[I_X])[i] : ((const f32x4*)P.in[I_META])[(row - MREAL) * 256 + c4];
          ((f32x4*)H)[i] = v; u32x2 w; w.x = pk2(v[0], v[1]); w.y = pk2(v[2], v[3]); ((u32x2*)HB)[i] = w; }
      float* rope = (float*)(ws + WS_ROPE);
      for (size_t i = gt; i < (size_t)(SEQ + NMETA) * 8; i += NT) { const int pos = (int)(i >> 3), fi = (int)(i & 7);
          const double invf = fi == 0 ? 1.0 : fi == 1 ? 0.19392274474868576 : fi == 2 ? 0.03760603093086393 : fi == 3 ? 0.007292664737217109 : fi == 4 ? 0.001414213562373095
                            : fi == 5 ? 0.0002742481756762073 : fi == 6 ? 5.318295896944988e-05 : 1.031338537721246e-05;
          const float angf = (float)pos * (float)invf;
          double a = (double)angf; a -= 6.283185307179586476925 * __builtin_rint(a * 0.15915494309189533577); const double hx = 0.5 * a, h2 = hx * hx;
          double sp = 1.0, cp = 1.0;
#pragma unroll
          for (int k = 12; k >= 1; --k) { sp = 1.0 - sp * h2 / (double)((2 * k) * (2 * k + 1)); cp = 1.0 - cp * h2 / (double)((2 * k - 1) * (2 * k)); }
          const double sh = hx * sp, ch = cp;
          rope[(size_t)pos * 16 + fi] = (float)(1.0 - 2.0 * sh * sh); rope[(size_t)pos * 16 + 8 + fi] = (float)(2.0 * sh * ch); }
    }
}

__device__ __forceinline__ void ln_phase(unsigned char* ws, float* outp, LAS unsigned char* lds, int gw, int NGW, int lane, int tid,
                                         int lnidx, bool moe_src, bool router, int moe_idx, bool final) {
    const float* sm = (const float*)(ws + WS_SMALL);
    float* H = (float*)(ws + WS_H); bf16_t* HB = (bf16_t*)(ws + WS_HB); const float* contrib = (const float*)(ws + WS_CONTRIB); float* stats = (float*)(ws + WS_STATS);
    const float* lg = sm + SM_LNG + (size_t)lnidx * D; const float* lb = sm + SM_LNB + (size_t)lnidx * D;
    f32x4 gv[4], bv[4];
#pragma unroll
    for (int j = 0; j < 4; ++j) { gv[j] = *(const f32x4*)(lg + 256 * j + 4 * lane); bv[j] = *(const f32x4*)(lb + 256 * j + 4 * lane); }
    LAS float* wr = (LAS float*)lds;
    volatile LAS unsigned* misc = (volatile LAS unsigned*)(lds + MISC_OFF);
    if (router) {
        const float* src = sm + SM_WROUTER + (size_t)moe_idx * D * N_EXP;
        for (int i = tid; i < D * N_EXP / 4; i += NTHREADS) ((LAS f32x4*)wr)[i] = ((const f32x4*)src)[i];
        if (tid < 8) misc[16 + tid] = 0u;
        __syncthreads();
    }
    int* tope = (int*)(ws + WS_TOPE); float* topg = (float*)(ws + WS_TOPG);
    const float* br = sm + SM_BROUTER + moe_idx * N_EXP;
    f32x4 nv[4], nc0[4], nc1[4]; f32x2 nst;
    auto fetch = [&](int row) {
        const f32x4* hr = (const f32x4*)(H + (size_t)row * D) + lane;
#pragma unroll
        for (int j = 0; j < 4; ++j) nv[j] = hr[64 * j];
        if (moe_src) { const f32x4* c0 = (const f32x4*)(contrib + (size_t)(2 * row) * D) + lane; const f32x4* c1 = c0 + 256;
#pragma unroll
            for (int j = 0; j < 4; ++j) { nc0[j] = c0[64 * j]; nc1[j] = c1[64 * j]; } }
        nst = *(const f32x2*)(stats + 2 * (size_t)row);
    };
    if (gw < MV) fetch(gw);
    for (int row = gw; row < MV; row += NGW) {
        f32x4 v[4], c0v[4], c1v[4]; const f32x2 st = nst;
#pragma unroll
        for (int j = 0; j < 4; ++j) { v[j] = nv[j]; c0v[j] = nc0[j]; c1v[j] = nc1[j]; }
        if (row + NGW < MV) fetch(row + NGW);
        if (moe_src) { const float* pg = lg - D; const float* pb = lb - D;
#pragma unroll
            for (int j = 0; j < 4; ++j) { const f32x4 g1 = *(const f32x4*)(pg + 256 * j + 4 * lane), b1 = *(const f32x4*)(pb + 256 * j + 4 * lane);
                v[j] = ((v[j] - st.x) * st.y * g1 + b1) * ALPHA + c0v[j] + c1v[j]; }
            if (!final) { f32x4* o = (f32x4*)(H + (size_t)row * D) + lane;
#pragma unroll
                for (int j = 0; j < 4; ++j) o[64 * j] = v[j]; } }
        float s = 0.f;
#pragma unroll
        for (int j = 0; j < 4; ++j) s += (v[j][0] + v[j][1]) + (v[j][2] + v[j][3]);
        const float mean = wave_sum(s) * (1.f / D); float s2 = 0.f;
#pragma unroll
        for (int j = 0; j < 4; ++j) { v[j] = v[j] - mean; s2 += (v[j][0] * v[j][0] + v[j][1] * v[j][1]) + (v[j][2] * v[j][2] + v[j][3] * v[j][3]); }
        const float rstd = 1.f / sqrtf(wave_sum(s2) * (1.f / D) + LN_EPS);
#pragma unroll
        for (int j = 0; j < 4; ++j) v[j] = v[j] * rstd * gv[j] + bv[j];
        if (final) { if (row < MREAL) { f32x4* o = (f32x4*)(outp + (size_t)row * D) + lane;
#pragma unroll
                for (int j = 0; j < 4; ++j) o[64 * j] = v[j]; } }
        else { u32x2* ob = (u32x2*)(HB + (size_t)row * D) + lane;
            if (lane == 0) *(f32x2*)(stats + 2 * (size_t)row) = (f32x2){mean, rstd};
#pragma unroll
            for (int j = 0; j < 4; ++j) { u32x2 w; w.x = pk2(v[j][0], v[j][1]); w.y = pk2(v[j][2], v[j][3]); ob[64 * j] = w; } }
        if (router) {
            float lg8[8];
#pragma unroll
            for (int e = 0; e < 8; ++e) lg8[e] = 0.f;
#pragma unroll
            for (int j = 0; j < 4; ++j)
#pragma unroll
                for (int c = 0; c < 4; ++c) { const LAS f32x4* w4 = (const LAS f32x4*)(wr + (size_t)(256 * j + 4 * lane + c) * 8); const f32x4 wa = w4[0], wb = w4[1]; const float x = v[j][c];
                    lg8[0] += x * wa[0]; lg8[1] += x * wa[1]; lg8[2] += x * wa[2]; lg8[3] += x * wa[3]; lg8[4] += x * wb[0]; lg8[5] += x * wb[1]; lg8[6] += x * wb[2]; lg8[7] += x * wb[3]; }
#pragma unroll
            for (int e = 0; e < 8; ++e) lg8[e] = wave_sum(lg8[e]) + br[e];
            int e1 = 0; float v1 = lg8[0];
#pragma unroll
            for (int e = 1; e < 8; ++e) if (lg8[e] > v1) { v1 = lg8[e]; e1 = e; }
            int e2 = -1; float v2 = -3.0e38f;
#pragma unroll
            for (int e = 0; e < 8; ++e) if (e != e1 && lg8[e] > v2) { v2 = lg8[e]; e2 = e; }
            const float ex = expf(v2 - v1), g1 = 1.f / (1.f + ex), g2 = ex / (1.f + ex);
            if (lane == 0) { tope[row] = e1 | (e2 << 8); topg[2 * row] = g1; topg[2 * row + 1] = g2;
                __hip_atomic_fetch_add((LAS unsigned*)&misc[16 + e1], 1u, __ATOMIC_RELAXED, __HIP_MEMORY_SCOPE_WORKGROUP);
                __hip_atomic_fetch_add((LAS unsigned*)&misc[16 + e2], 1u, __ATOMIC_RELAXED, __HIP_MEMORY_SCOPE_WORKGROUP); }
        }
    }
    if (router) { __syncthreads();
        if (tid < 8) __hip_atomic_fetch_add((unsigned*)(ws + WS_CTL) + CW_CNT + moe_idx * 64 + tid, misc[16 + tid], __ATOMIC_RELAXED, __HIP_MEMORY_SCOPE_AGENT);
        __syncthreads(); }
}

__device__ __forceinline__ void moe_starts(const unsigned char* ws, int moe_idx, int (&cnt)[8], int (&pstart)[9]) {
    const unsigned* c = (const unsigned*)(ws + WS_CTL) + CW_CNT + moe_idx * 64; int p = 0;
#pragma unroll
    for (int e = 0; e < 8; ++e) { cnt[e] = __builtin_amdgcn_readfirstlane((int)__hip_atomic_load(c + e, __ATOMIC_RELAXED, __HIP_MEMORY_SCOPE_AGENT)); pstart[e] = p; p += (cnt[e] + 255) >> 8; }
    pstart[8] = p;
}
__device__ __forceinline__ void assign_phase(unsigned char* ws, int gw, int NGW, int lane, int tid, int moe_idx) {
    int cnt[8], pstart[9]; moe_starts(ws, moe_idx, cnt, pstart);
    const int* tope = (const int*)(ws + WS_TOPE); const float* topg = (const float*)(ws + WS_TOPG);
    int* rowtok = (int*)(ws + WS_ROWTOK); int* rowdst = (int*)(ws + WS_ROWDST); float* rowgate = (float*)(ws + WS_ROWGATE);
    unsigned* cur = (unsigned*)(ws + WS_CTL) + CW_CUR + moe_idx * 64;
    for (int base = gw * 64; base < MV; base += NGW * 64) {
        const int row = base + lane; const bool valid = row < MV;
        const int te = valid ? tope[row] : 0xffff;
#pragma unroll
        for (int slot = 0; slot < 2; ++slot) {
            const int e = valid ? ((te >> (8 * slot)) & 255) : 255; int pos = -1;
#pragma unroll
            for (int ee = 0; ee < 8; ++ee) {
                const unsigned long long mask = __ballot(e == ee);
                if (mask) { const int n = __popcll(mask), leader = __ffsll((long long)mask) - 1; unsigned b0 = 0;
                    if (lane == leader) b0 = __hip_atomic_fetch_add(cur + ee, (unsigned)n, __ATOMIC_RELAXED, __HIP_MEMORY_SCOPE_AGENT);
                    b0 = __shfl(b0, leader);
                    if (e == ee) pos = pstart[ee] * 256 + (int)b0 + __popcll(mask & ((1ull << lane) - 1ull)); }
            }
            if (valid) { rowtok[pos] = row; rowdst[pos] = 2 * row + slot; rowgate[pos] = topg[2 * row + slot]; }
        }
    }
    if (blockIdx.x < 8) { const int e = blockIdx.x; int ps = 0, pe = 0, ce = 0;
#pragma unroll
        for (int ee = 0; ee < 8; ++ee) if (ee == e) { ps = pstart[ee]; pe = pstart[ee + 1]; ce = cnt[ee]; }
        for (int pos = ps * 256 + ce + tid; pos < pe * 256; pos += NTHREADS) { rowtok[pos] = -1; rowdst[pos] = -1; rowgate[pos] = 0.f; } }
}

constexpr int ML_RS = 72;
constexpr int ML_QS = 0, ML_KS = 9216, ML_KT = 18432, ML_PS = 27648, ML_VT = 36864, ML_CT = 57600, ML_HS = 78336, ML_SC = 112128;
constexpr int ML_HSS = 132;
__device__ __forceinline__ bf16x8 ml_frag(LAS unsigned char* lds, int base, int row, int kcol) { return *(const LAS bf16x8*)(lds + base + (row * ML_RS + kcol) * 2); }

template <int MODE>
__device__ __forceinline__ void mlstm_phase(unsigned char* ws, LAS unsigned char* lds, int layer, int tid, int wave, int lane) {
    const int item = blockIdx.x; const int bh = item >> 3, seg = item & 7, b = bh >> 3, h = bh & 7;
    if (MODE == 1 && seg == 7) return;
    const bf16_t* proj = (const bf16_t*)(ws + WS_PROJ); const float* gates = (const float*)(ws + WS_GATES);
    bf16_t* HG = (bf16_t*)(ws + WS_HG);
    float* STATE = (float*)(ws + WS_STATE); float* STSC = (float*)(ws + WS_STSC);
    LAS float* sc = (LAS float*)(lds + ML_SC);
    const int fr = lane & 15, quad = lane >> 4;
    f32x4 st[5]; float zero = 0.f; asm volatile("; opaque zero" : "+v"(zero));
#pragma unroll
    for (int i = 0; i < 5; ++i) st[i] = (f32x4){zero, zero, zero, zero};
    float m0 = (MODE == 1) ? -1.0e30f : 0.f, gsum = 0.f;
    for (int i = tid; i < 16 * ML_RS; i += NTHREADS) ((LAS bf16_t*)(lds + ML_VT))[128 * ML_RS + i] = (i < ML_RS) ? (bf16_t)0x3F80 : (bf16_t)0;
    if (MODE == 2 && seg > 0) {
        m0 = -1.0e30f;
        for (int s2 = 0; s2 < seg; ++s2) {
            const float ms = STSC[(bh * 7 + s2) * 4 + 0], Gs = STSC[(bh * 7 + s2) * 4 + 1];
            const float mn = fmaxf(Gs + m0, ms), fo = fast_exp(Gs + m0 - mn), fn = fast_exp(ms - mn);
            const f32x4* sp = (const f32x4*)(STATE + (size_t)(bh * 7 + s2) * ST_FLOATS) + (wave * 5) * 64 + lane;
#pragma unroll
            for (int i = 0; i < 5; ++i) st[i] = st[i] * fo + sp[i * 64] * fn;
            m0 = mn;
        }
    }
#pragma unroll
    for (int i = 0; i < 5; ++i) { const int dv = (i < 4) ? 16 * wave + fr : 128 + fr, dk = (i < 4) ? 16 * i + 4 * quad : 16 * wave + 4 * quad;
        if (i < 4 || wave < 4) { u32x2 w; w.x = pk2(st[i][0], st[i][1]); w.y = pk2(st[i][2], st[i][3]); *(LAS u32x2*)(lds + ML_CT + (dv * ML_RS + dk) * 2) = w; } }
    float lnh[16];
    if (MODE == 2) {
#pragma unroll
        for (int e = 0; e < 16; ++e) lnh[e] = ((const float*)(ws + WS_SMALL))[SM_LNH + layer * D + h * M_V + 16 * (tid & 7) + e]; }
    const int nch = SEG_CHUNKS + (seg == 0 ? 1 : 0);
    u32x4 rq, rk, rv0, rv1; float rli = 0.f, rlf = 0.f;
    auto chunk_rows = [&](int ci, int& rbase, int& nv) { if (seg == 0 && ci == 0) { rbase = MREAL; nv = NMETA; } else { const int c = seg * SEG_CHUNKS + ci - (seg == 0 ? 1 : 0); rbase = b * SEQ + c * 64; nv = 64; } };
    auto load_chunk = [&](int ci) {
        int rbase, nv; chunk_rows(ci, rbase, nv);
        { const int j = tid >> 3, c8 = (tid & 7) * 8; const bool ok = j < nv; const bf16_t* rp = proj + (size_t)(rbase + j) * PROJ_LD + h * 64 + c8;
          rq = (MODE == 2 && ok) ? *(const u32x4*)rp : (u32x4){0u, 0u, 0u, 0u}; rk = ok ? *(const u32x4*)(rp + 512) : (u32x4){0u, 0u, 0u, 0u}; }
        { const int j0 = tid >> 4, c8 = (tid & 15) * 8; const bf16_t* rp = proj + (size_t)(rbase + j0) * PROJ_LD + 1024 + h * 128 + c8;
          rv0 = (j0 < nv) ? *(const u32x4*)rp : (u32x4){0u, 0u, 0u, 0u}; rv1 = (j0 + 32 < nv) ? *(const u32x4*)(rp + (size_t)32 * PROJ_LD) : (u32x4){0u, 0u, 0u, 0u}; }
        if (tid < 64) { const bool ok = tid < nv; rli = ok ? gates[(size_t)(rbase + tid) * 16 + h] : -1.0e30f; rlf = ok ? gates[(size_t)(rbase + tid) * 16 + 8 + h] : 1.0e30f; }
    };
    load_chunk(0);
    __syncthreads();
    for (int ci = 0; ci < nch; ++ci) {
        int rbase, nv; chunk_rows(ci, rbase, nv);
        { const int j = tid >> 3, c8 = (tid & 7) * 8;
          if (MODE == 2) *(LAS u32x4*)(lds + ML_QS + (j * ML_RS + c8) * 2) = rq;
          *(LAS u32x4*)(lds + ML_KS + (j * ML_RS + c8) * 2) = rk; }
        { const int j0 = tid >> 4, c8 = (tid & 15) * 8; LAS bf16_t* vt = (LAS bf16_t*)(lds + ML_VT);
          const unsigned a[4] = {rv0.x, rv0.y, rv0.z, rv0.w}, c[4] = {rv1.x, rv1.y, rv1.z, rv1.w};
#pragma unroll
          for (int e = 0; e < 4; ++e) { vt[(c8 + 2 * e) * ML_RS + j0] = (bf16_t)(a[e] & 0xffffu); vt[(c8 + 2 * e + 1) * ML_RS + j0] = (bf16_t)(a[e] >> 16);
              vt[(c8 + 2 * e) * ML_RS + j0 + 32] = (bf16_t)(c[e] & 0xffffu); vt[(c8 + 2 * e + 1) * ML_RS + j0 + 32] = (bf16_t)(c[e] >> 16); } }
        if (wave == 0) {
            const float li = rli, f = rlf;
            const float lf = (f > 1.0e29f) ? 0.f : (fminf(f, 0.f) - logf(1.f + expf(-fabsf(f))));
            float bc = lf;
#pragma unroll
            for (int o = 1; o < 64; o <<= 1) { const float t = __shfl_up(bc, o); if (lane >= o) bc += t; }
            const float u = li - bc; float pm = u;
#pragma unroll
            for (int o = 1; o < 64; o <<= 1) { const float t = __shfl_up(pm, o); if (lane >= o) pm = fmaxf(pm, t); }
            const float blast = __shfl(bc, 63), umax = __shfl(pm, 63);
            const float MM = fmaxf(pm, m0), amax = blast + umax, mn = fmaxf(blast + m0, amax);
            const float sold = fast_exp(blast + m0 - mn), snew = fast_exp(amax - mn);
            sc[lane] = u; sc[64 + lane] = MM; sc[128 + lane] = fast_exp(m0 - MM); sc[192 + lane] = fast_exp(-(bc + MM)); sc[256 + lane] = snew * fast_exp(u - umax);
            if (lane == 0) { sc[384] = sold; sc[385] = mn; sc[386] = blast; }
        }
        __syncthreads();
        if (ci + 1 < nch) load_chunk(ci + 1);
        m0 = sc[385]; gsum += sc[386];
        const float sold = sc[384];
        { const int j = tid >> 3, c8 = (tid & 7) * 8; const u32x4 kv = *(const LAS u32x4*)(lds + ML_KS + (j * ML_RS + c8) * 2); const float wj = sc[256 + j];
          const unsigned a[4] = {kv.x, kv.y, kv.z, kv.w}; LAS bf16_t* kt = (LAS bf16_t*)(lds + ML_KT);
#pragma unroll
          for (int e = 0; e < 4; ++e) { kt[(c8 + 2 * e) * ML_RS + j] = (bf16_t)f2bf(bf2f((unsigned short)(a[e] & 0xffffu)) * wj); kt[(c8 + 2 * e + 1) * ML_RS + j] = (bf16_t)f2bf(bf2f((unsigned short)(a[e] >> 16)) * wj); } }
        if (MODE == 2) {
            const int mt = wave >> 1;
#pragma unroll
            for (int q = 0; q < 2; ++q) { const int nt = 2 * (wave & 1) + q; f32x4 s = (f32x4){0.f, 0.f, 0.f, 0.f};
                if (nt <= mt) {
#pragma unroll
                    for (int ks = 0; ks < 2; ++ks) s = __builtin_amdgcn_mfma_f32_16x16x32_bf16(ml_frag(lds, ML_QS, 16 * mt + fr, 32 * ks + 8 * quad), ml_frag(lds, ML_KS, 16 * nt + fr, 32 * ks + 8 * quad), s, 0, 0, 0); }
                const int j = 16 * nt + fr; const float uj = sc[j];
#pragma unroll
                for (int r = 0; r < 4; ++r) { const int i = 16 * mt + 4 * quad + r; const float p = (j <= i) ? s[r] * fast_exp(uj - sc[64 + i]) : 0.f;
                    ((LAS bf16_t*)(lds + ML_PS))[i * ML_RS + j] = (bf16_t)f2bf(p); } }
        }
        __syncthreads();
        f32x4 o1[4], o2[4];
        if (MODE == 2) {
            bf16x8 vb[2], cb[2];
#pragma unroll
            for (int ks = 0; ks < 2; ++ks) { vb[ks] = ml_frag(lds, ML_VT, 16 * wave + fr, 32 * ks + 8 * quad); cb[ks] = ml_frag(lds, ML_CT, 16 * wave + fr, 32 * ks + 8 * quad); }
#pragma unroll
            for (int mt = 0; mt < 4; ++mt) { o1[mt] = (f32x4){0.f, 0.f, 0.f, 0.f}; o2[mt] = (f32x4){0.f, 0.f, 0.f, 0.f};
#pragma unroll
                for (int ks = 0; ks < 2; ++ks) { o1[mt] = __builtin_amdgcn_mfma_f32_16x16x32_bf16(ml_frag(lds, ML_PS, 16 * mt + fr, 32 * ks + 8 * quad), vb[ks], o1[mt], 0, 0, 0);
                    o2[mt] = __builtin_amdgcn_mfma_f32_16x16x32_bf16(ml_frag(lds, ML_QS, 16 * mt + fr, 32 * ks + 8 * quad), cb[ks], o2[mt], 0, 0, 0); } }
            if (wave < 4) { f32x4 d1 = (f32x4){0.f, 0.f, 0.f, 0.f}, d2 = (f32x4){0.f, 0.f, 0.f, 0.f};
#pragma unroll
                for (int ks = 0; ks < 2; ++ks) { d1 = __builtin_amdgcn_mfma_f32_16x16x32_bf16(ml_frag(lds, ML_PS, 16 * wave + fr, 32 * ks + 8 * quad), ml_frag(lds, ML_VT, 128 + fr, 32 * ks + 8 * quad), d1, 0, 0, 0);
                    d2 = __builtin_amdgcn_mfma_f32_16x16x32_bf16(ml_frag(lds, ML_QS, 16 * wave + fr, 32 * ks + 8 * quad), ml_frag(lds, ML_CT, 128 + fr, 32 * ks + 8 * quad), d2, 0, 0, 0); }
                if (fr == 0) {
#pragma unroll
                    for (int r = 0; r < 4; ++r) { const int i = 16 * wave + 4 * quad + r; sc[320 + i] = d1[r] + sc[128 + i] * d2[r]; } } }
            __syncthreads();
        }
        if (MODE == 2) {
#pragma unroll
            for (int mt = 0; mt < 4; ++mt)
#pragma unroll
                for (int r = 0; r < 4; ++r) { const int i = 16 * mt + 4 * quad + r; const float num = o1[mt][r] + sc[128 + i] * o2[mt][r];
                    ((LAS float*)(lds + ML_HS))[i * ML_HSS + 16 * wave + fr] = num / fmaxf(fabsf(sc[320 + i]), sc[192 + i]); }
        }
        { bf16x8 vb[2];
#pragma unroll
          for (int ks = 0; ks < 2; ++ks) vb[ks] = ml_frag(lds, ML_VT, 16 * wave + fr, 32 * ks + 8 * quad);
#pragma unroll
          for (int mt = 0; mt < 4; ++mt) { st[mt] = st[mt] * sold;
#pragma unroll
              for (int ks = 0; ks < 2; ++ks) st[mt] = __builtin_amdgcn_mfma_f32_16x16x32_bf16(ml_frag(lds, ML_KT, 16 * mt + fr, 32 * ks + 8 * quad), vb[ks], st[mt], 0, 0, 0); }
          if (wave < 4) { st[4] = st[4] * sold;
#pragma unroll
              for (int ks = 0; ks < 2; ++ks) st[4] = __builtin_amdgcn_mfma_f32_16x16x32_bf16(ml_frag(lds, ML_KT, 16 * wave + fr, 32 * ks + 8 * quad), ml_frag(lds, ML_VT, 128 + fr, 32 * ks + 8 * quad), st[4], 0, 0, 0); }
          if (MODE == 2) {
#pragma unroll
              for (int i = 0; i < 5; ++i) { const int dv = (i < 4) ? 16 * wave + fr : 128 + fr, dk = (i < 4) ? 16 * i + 4 * quad : 16 * wave + 4 * quad;
                  if (i < 4 || wave < 4) { u32x2 w; w.x = pk2(st[i][0], st[i][1]); w.y = pk2(st[i][2], st[i][3]); *(LAS u32x2*)(lds + ML_CT + (dv * ML_RS + dk) * 2) = w; } } }
        }
        __syncthreads();
        if (MODE == 2) {
            const int i = tid >> 3, sg = tid & 7; const LAS float* hp = (const LAS float*)(lds + ML_HS) + i * ML_HSS + 16 * sg;
            float x[16]; float s = 0.f;
#pragma unroll
            for (int e = 0; e < 16; ++e) { x[e] = hp[e]; s += x[e]; }
            s += __shfl_xor(s, 1); s += __shfl_xor(s, 2); s += __shfl_xor(s, 4);
            const float mean = s * (1.f / M_V); float q = 0.f;
#pragma unroll
            for (int e = 0; e < 16; ++e) { x[e] -= mean; q += x[e] * x[e]; }
            q += __shfl_xor(q, 1); q += __shfl_xor(q, 2); q += __shfl_xor(q, 4);
            const float rstd = 1.f / sqrtf(q * (1.f / M_V) + LN_EPS);
            if (i < nv && (nv == 64 || b == 0)) {
                const size_t row = (size_t)(rbase + i);
                const u32x4* ogp = (const u32x4*)(proj + row * PROJ_LD + 2048 + h * M_V + 16 * sg); const u32x4 g0 = ogp[0], g1 = ogp[1];
                const unsigned gw8[8] = {g0.x, g0.y, g0.z, g0.w, g1.x, g1.y, g1.z, g1.w}; unsigned ow[8];
#pragma unroll
                for (int e = 0; e < 8; ++e) { const float oga = bf2f((unsigned short)(gw8[e] & 0xffffu)), ogb = bf2f((unsigned short)(gw8[e] >> 16));
                    const float ya = x[2 * e] * rstd * lnh[2 * e] / (1.f + fast_exp(-oga)), yb = x[2 * e + 1] * rstd * lnh[2 * e + 1] / (1.f + fast_exp(-ogb));
                    ow[e] = pk2(ya, yb); }
                u32x4* op = (u32x4*)(HG + row * D + h * M_V + 16 * sg);
                op[0] = (u32x4){ow[0], ow[1], ow[2], ow[3]}; op[1] = (u32x4){ow[4], ow[5], ow[6], ow[7]};
            }
        }
    }
    if (MODE == 1) {
        f32x4* sp = (f32x4*)(STATE + (size_t)(bh * 7 + seg) * ST_FLOATS) + (wave * 5) * 64 + lane;
#pragma unroll
        for (int i = 0; i < 5; ++i) sp[i * 64] = (i < 4 || wave < 4) ? st[i] : (f32x4){0.f, 0.f, 0.f, 0.f};
        if (tid == 0) { STSC[(bh * 7 + seg) * 4 + 0] = m0; STSC[(bh * 7 + seg) * 4 + 1] = gsum; }
    }
}

constexpr int AT_KRS = 72, AT_VRS = 280, AT_NK = 272;
constexpr int AT_KS = 0, AT_VT = AT_NK * AT_KRS * 2, AT_END = AT_VT + 64 * AT_VRS * 2;
static_assert(AT_END <= MISC_OFF, "attention LDS");
__device__ __forceinline__ void attn_phase(unsigned char* ws, LAS unsigned char* lds, int j_layer, int tid, int wave, int lane) {
    const bf16_t* Q = (const bf16_t*)(ws + WS_PROJ); const bf16_t* KB = (const bf16_t*)(ws + WS_KB); const bf16_t* VT = (const bf16_t*)(ws + WS_VB);
    bf16_t* HG = (bf16_t*)(ws + WS_HG);
    const float* sinks = (const float*)(ws + WS_SMALL) + SM_SINKS + j_layer * A_HEADS;
    const int fr = lane & 15, quad = lane >> 4;
    LAS bf16_t* ks = (LAS bf16_t*)(lds + AT_KS); LAS bf16_t* vt = (LAS bf16_t*)(lds + AT_VT);
    u32x4 kreg[5], vreg[5]; bf16x8 qn[4][2];
    const int NREG = NBATCH * A_KV * (SEQ / WINDOW), NIT = NREG + A_KV;
    auto prefetch = [&](int it) {
        const bool meta = it >= NREG; const int b = meta ? 0 : it >> 8, g = meta ? it - NREG : (it >> 6) & 3, blk = meta ? -1 : it & 63;
#pragma unroll
        for (int i = 0; i < 5; ++i) { const int p = tid + i * NTHREADS; kreg[i] = (u32x4){0u, 0u, 0u, 0u}; vreg[i] = (u32x4){0u, 0u, 0u, 0u};
            if (p < AT_NK * 8) { const int kk = p >> 3, c8 = (p & 7) * 8;
                int row; if (kk >= 256) row = MREAL + kk - 256; else { const int tk = (blk - 1) * WINDOW + kk; row = (tk < 0 || meta) ? -1 : b * SEQ + tk; }
                if (row >= 0) kreg[i] = *(const u32x4*)(KB + (size_t)row * 256 + g * 64 + c8);
                const int d = p / 34, pc = p % 34; const bf16_t* src = VT + (size_t)(g * 64 + d) * MP;
                if (pc >= 32) vreg[i] = *(const u32x4*)(src + MREAL + (pc - 32) * 8);
                else { const int tk = (blk - 1) * WINDOW + pc * 8; if (tk >= 0 && !meta) vreg[i] = *(const u32x4*)(src + (size_t)b * SEQ + tk); } } }
    };
    auto qload = [&](int it, int mt) {
        const bool meta = it >= NREG; const int b = it >> 8, g = meta ? it - NREG : (it >> 6) & 3, blk = it & 63, qh = g * 4 + (wave >> 1);
        const size_t rowq = meta ? (size_t)MREAL + fr : (size_t)b * SEQ + blk * WINDOW + 16 * (4 * (wave & 1) + mt) + fr;
#pragma unroll
        for (int k2 = 0; k2 < 2; ++k2) qn[mt][k2] = *(const bf16x8*)(Q + rowq * D + qh * 64 + 32 * k2 + 8 * quad);
    };
    if ((int)blockIdx.x < NIT) { prefetch(blockIdx.x);
#pragma unroll
        for (int mt = 0; mt < 4; ++mt) qload(blockIdx.x, mt); }
    for (int it = blockIdx.x; it < NIT; it += gridDim.x) {
        const bool meta = it >= NREG; const int b = it >> 8, g = meta ? it - NREG : (it >> 6) & 3, blk = it & 63;
        __syncthreads();
#pragma unroll
        for (int i = 0; i < 5; ++i) { const int p = tid + i * NTHREADS;
            if (p < AT_NK * 8) { *(LAS u32x4*)(ks + (p >> 3) * AT_KRS + (p & 7) * 8) = kreg[i]; *(LAS u32x4*)(vt + (p / 34) * AT_VRS + (p % 34) * 8) = vreg[i]; } }
        __syncthreads();
        const bool has_next = it + (int)gridDim.x < NIT;
        if (has_next) prefetch(it + gridDim.x);
        const int qh = g * 4 + (wave >> 1); const float sink = sinks[qh];
#pragma unroll
        for (int mt = 0; mt < 4; ++mt) {
            if (meta && (mt > 0 || (wave & 1))) continue;
            const int t0 = meta ? 0 : 4 * (wave & 1) + mt, qi = 16 * t0 + fr;
            const size_t rowq = meta ? (size_t)MREAL + fr : (size_t)b * SEQ + blk * WINDOW + qi;
            f32x4 s[10];
#pragma unroll
            for (int c = 0; c < 10; ++c) { const int kb = (c < 9) ? 16 * (t0 + c) : 256; s[c] = (f32x4){0.f, 0.f, 0.f, 0.f};
#pragma unroll
                for (int k2 = 0; k2 < 2; ++k2) s[c] = __builtin_amdgcn_mfma_f32_16x16x32_bf16(*(const LAS bf16x8*)(ks + (kb + fr) * AT_KRS + 32 * k2 + 8 * quad), qn[mt][k2], s[c], 0, 0, 0); }
            if (has_next) qload(it + gridDim.x, mt);
            float m = sink;
#pragma unroll
            for (int c = 0; c < 9; ++c)
#pragma unroll
                for (int r = 0; r < 4; ++r) { const int j = 16 * (t0 + c) + 4 * quad + r, rel = qi + WINDOW - j; const bool vis = !meta && (rel >= 0) && (rel < WINDOW) && (blk > 0 || j >= WINDOW);
                    s[c][r] = vis ? s[c][r] : -1.0e30f; m = fmaxf(m, s[c][r]); }
#pragma unroll
            for (int r = 0; r < 4; ++r) { const bool vis = !meta || (4 * quad + r <= fr); s[9][r] = vis ? s[9][r] : -1.0e30f; m = fmaxf(m, s[9][r]); }
            m = fmaxf(m, __shfl_xor(m, 16)); m = fmaxf(m, __shfl_xor(m, 32));
            float sm = 0.f;
#pragma unroll
            for (int c = 0; c < 10; ++c)
#pragma unroll
                for (int r = 0; r < 4; ++r) { const float p = fast_exp(s[c][r] - m); s[c][r] = p; sm += p; }
            sm += __shfl_xor(sm, 16); sm += __shfl_xor(sm, 32);
            const float inv = 1.f / (sm + fast_exp(sink - m));
            f32x4 o[4];
#pragma unroll
            for (int dt = 0; dt < 4; ++dt) o[dt] = (f32x4){0.f, 0.f, 0.f, 0.f};
#pragma unroll
            for (int u = 0; u < 5; ++u) {
                const int kb0 = 16 * (t0 + 2 * u), kb1 = (u < 4) ? 16 * (t0 + 2 * u + 1) : 256;
                u32x4 pw; pw.x = cvt_pk_bf16(s[2 * u][0], s[2 * u][1]); pw.y = cvt_pk_bf16(s[2 * u][2], s[2 * u][3]); pw.z = cvt_pk_bf16(s[2 * u + 1][0], s[2 * u + 1][1]); pw.w = cvt_pk_bf16(s[2 * u + 1][2], s[2 * u + 1][3]);
                const bf16x8 pf = __builtin_bit_cast(bf16x8, pw);
#pragma unroll
                for (int dt = 0; dt < 4; ++dt) { const LAS bf16_t* vr = vt + (16 * dt + fr) * AT_VRS + 4 * quad;
                    u32x4 vw; const u32x2 a = *(const LAS u32x2*)(vr + kb0), c2 = *(const LAS u32x2*)(vr + kb1); vw.x = a.x; vw.y = a.y; vw.z = c2.x; vw.w = c2.y;
                    o[dt] = __builtin_amdgcn_mfma_f32_16x16x32_bf16(__builtin_bit_cast(bf16x8, vw), pf, o[dt], 0, 0, 0); } }
#pragma unroll
            for (int dt = 0; dt < 4; ++dt) { u32x2 w; w.x = cvt_pk_bf16(o[dt][0] * inv, o[dt][1] * inv); w.y = cvt_pk_bf16(o[dt][2] * inv, o[dt][3] * inv);
                *(u32x2*)(HG + rowq * D + qh * 64 + 16 * dt + 4 * quad) = w; }
        }
    }
}

#ifndef SITES
#define SITES 0xFFFF
#endif
#define SITE(n) ((SITES >> (n)) & 1)
#ifndef DUPMASK
#define DUPMASK 0
#endif
#define REPS(n) (1 + ((DUPMASK >> (n)) & 1))
#ifndef MK_PER_PHASE
#define MK_PER_PHASE 0
#endif
constexpr int PH_PER_LAYER = 12, N_PHASES = 1 + 4 * PH_PER_LAYER;

__global__ void __launch_bounds__(NTHREADS, 2) fwd(Params P) {
    extern __shared__ __attribute__((aligned(16))) unsigned char lds_raw[];
    LAS unsigned char* const lds0 = (LAS unsigned char*)lds_raw;
    const int G = gridDim.x;
    const int vcu = (G % 8 == 0) ? ((int)blockIdx.x % 8) * (G / 8) + (int)blockIdx.x / 8 : (int)blockIdx.x;
    const int NGW = G * NWAVES;
    unsigned char* const wsbase = P.ws;
    volatile LAS unsigned* misc = (volatile LAS unsigned*)(lds0 + MISC_OFF);
    if (threadIdx.x < 64) misc[threadIdx.x] = 0u;
    __syncthreads();
    XcdBarrier bar = xcd_barrier_post((unsigned*)(wsbase + WS_CTL) + CW_BAR + P.li * 4096, misc + 8);
    const int lo = P.ph_lo, hi = P.ph_hi;
#define RUN(idx) ((idx) >= lo && (idx) < hi)
#define SEAM(idx) do { if ((idx) + 1 < hi) xcd_barrier(bar); } while (0)
#define IDS() int tid = threadIdx.x; asm volatile("; opaque tid" : "+v"(tid)); unsigned char* ws = wsbase; asm volatile("; opaque ws" : "+s"(ws)); \
              LAS unsigned char* lds = lds0; asm volatile("; opaque lds" : "+s"(lds)); \
              const int lane = tid & 63, wave = __builtin_amdgcn_readfirstlane(tid >> 6); const int gw = vcu * NWAVES + wave; (void)lane; (void)gw; (void)ws

    for (int rep = 0; rep < REPS(0); ++rep) if (SITE(0) && RUN(0)) { IDS(); p0_prologue(P, lds, gw, NGW, wave, lane); SEAM(0); }

    for (int l = 0; l < 4; ++l) {
        const int pb = 1 + l * PH_PER_LAYER;
        const bool moe = (l & 1) != 0; const int fi = l >> 1;
        if (l < 2) {
            for (int rep = 0; rep < REPS(1); ++rep) if (SITE(1) && RUN(pb + 0)) {
                IDS();
                pg8::DenseOrder S; S.init(MP / 256, M_INP / 256, G, (int)blockIdx.x);
                EpiProj E{(bf16_t*)(ws + WS_PROJ), (float*)(ws + WS_GATES), (const float*)(ws + WS_SMALL) + SM_BGATE + l * 16};
                pg8::gemm_phase(lds, (const bf16_t*)(ws + WS_HB), (const bf16_t*)(ws + WS_WIN) + (size_t)l * M_INP * D, D, S, E);
                SEAM(pb + 0); }
            for (int rep = 0; rep < REPS(2); ++rep) if (SITE(2) && RUN(pb + 1)) { IDS(); mlstm_phase<1>(ws, lds, l, tid, wave, lane); SEAM(pb + 1); }
            for (int rep = 0; rep < REPS(3); ++rep) if (SITE(3) && RUN(pb + 2)) { IDS(); mlstm_phase<2>(ws, lds, l, tid, wave, lane); SEAM(pb + 2); }
        } else {
            for (int rep = 0; rep < REPS(4); ++rep) if (SITE(4) && RUN(pb + 0)) {
                IDS();
                pg8::DenseOrder S; S.init(MP / 256, l == 2 ? 6 : 4, G, (int)blockIdx.x);
                EpiQKV E{(bf16_t*)(ws + WS_PROJ), (bf16_t*)(ws + WS_KB), (bf16_t*)(ws + WS_VB), (const float*)(ws + WS_ROPE)};
                pg8::gemm_phase(lds, (const bf16_t*)(ws + WS_HB), (const bf16_t*)(ws + (l == 2 ? WS_WQKV : WS_WQ3)), D, S, E);
                SEAM(pb + 0); }
            for (int rep = 0; rep < REPS(5); ++rep) if (SITE(5) && RUN(pb + 1)) { IDS(); attn_phase(ws, lds, l - 2, tid, wave, lane); SEAM(pb + 1); }
        }
        for (int rep = 0; rep < REPS(6); ++rep) if (SITE(6) && RUN(pb + 3)) {
            IDS();
            pg8::DenseOrder S; S.init(MP / 256, 4, G, (int)blockIdx.x);
            const float* smp = (const float*)(ws + WS_SMALL);
            EpiRes E{(float*)(ws + WS_H), (const float*)(ws + WS_STATS), l > 0 ? smp + SM_LNG + (size_t)(2 * l - 1) * D : nullptr, smp + SM_LNB + (size_t)(l > 0 ? 2 * l - 1 : 0) * D};
            pg8::gemm_phase(lds, (const bf16_t*)(ws + WS_HG), (const bf16_t*)(ws + (l < 2 ? WS_WOUT : WS_WO)) + (size_t)(l & 1) * D * D, D, S, E);
            SEAM(pb + 3); }
        for (int rep = 0; rep < REPS(7); ++rep) if (SITE(7) && RUN(pb + 4)) { IDS(); ln_phase(ws, nullptr, lds, gw, NGW, lane, tid, l * 2 + 0, false, moe, fi, false); SEAM(pb + 4); }
        if (!moe) {
            for (int rep = 0; rep < REPS(8); ++rep) if (SITE(8) && RUN(pb + 5)) {
                IDS();
                pg8::DenseOrder S; S.init(MP / 256, 2 * D_FF / 256, G, (int)blockIdx.x);
                EpiSwiglu E{(bf16_t*)(ws + WS_ACT), D_FF};
                pg8::gemm_phase(lds, (const bf16_t*)(ws + WS_HB), (const bf16_t*)(ws + WS_WGU) + (size_t)fi * 2 * D_FF * D, D, S, E);
                SEAM(pb + 5); }
            for (int rep = 0; rep < REPS(9); ++rep) if (SITE(9) && RUN(pb + 6)) {
                IDS();
                pg8::DenseOrder S; S.init(MP / 256, 4, G, (int)blockIdx.x);
                const float* smp = (const float*)(ws + WS_SMALL);
                EpiRes E{(float*)(ws + WS_H), (const float*)(ws + WS_STATS), smp + SM_LNG + (size_t)(2 * l) * D, smp + SM_LNB + (size_t)(2 * l) * D};
                pg8::gemm_phase(lds, (const bf16_t*)(ws + WS_ACT), (const bf16_t*)(ws + WS_WDN) + (size_t)fi * D * D_FF, D_FF, S, E);
                SEAM(pb + 6); }
        } else {
            for (int rep = 0; rep < REPS(10); ++rep) if (SITE(10) && RUN(pb + 5)) { IDS(); assign_phase(ws, gw, NGW, lane, tid, fi); SEAM(pb + 5); }
            for (int rep = 0; rep < REPS(11); ++rep) if (SITE(11) && RUN(pb + 6)) {
                IDS();
                int cnt[8]; pg8::GroupedOrder S; moe_starts(ws, fi, cnt, S.pstart);
                S.o.init(S.pstart[8], 2 * D_FF_EXP / 256, G, (int)blockIdx.x); S.nexp_rows = 2 * D_FF_EXP; S.rowtok = (const int*)(ws + WS_ROWTOK);
                EpiSwiglu E{(bf16_t*)(ws + WS_ACT), D_FF_EXP};
                pg8::gemm_phase(lds, (const bf16_t*)(ws + WS_HB), (const bf16_t*)(ws + WS_WGUE) + (size_t)fi * 8 * 2 * D_FF_EXP * D, D, S, E);
                SEAM(pb + 6); }
            for (int rep = 0; rep < REPS(12); ++rep) if (SITE(12) && RUN(pb + 7)) {
                IDS();
                int cnt[8]; pg8::GroupedOrder S; moe_starts(ws, fi, cnt, S.pstart);
                S.o.init(S.pstart[8], 4, G, (int)blockIdx.x); S.nexp_rows = D; S.rowtok = nullptr;
                EpiScatter E{(float*)(ws + WS_CONTRIB), (const int*)(ws + WS_ROWDST), (const float*)(ws + WS_ROWGATE)};
                pg8::gemm_phase(lds, (const bf16_t*)(ws + WS_ACT), (const bf16_t*)(ws + WS_WDNE) + (size_t)fi * 8 * D * D_FF_EXP, D_FF_EXP, S, E);
                SEAM(pb + 7); }
        }
        for (int rep = 0; rep < REPS(13); ++rep) if (SITE(13) && RUN(pb + 10)) { IDS(); ln_phase(ws, P.out, lds, gw, NGW, lane, tid, l * 2 + 1, moe, false, 0, l == 3); SEAM(pb + 10); }
    }
#undef RUN
#undef SEAM
#undef IDS
}

extern "C" void kernel_launch(void* const* d_in, const int* in_sizes, int n_in, void* d_out, int out_size, void* d_ws, size_t ws_size, hipStream_t stream) {
    static int grid = 0;
    if (grid == 0) {
        if (n_in != 18 || out_size != MREAL * D || ws_size < WS_END) { fprintf(stderr, "kernel_launch: unexpected shapes (n_in %d, out %d, ws %zu < %zu)\n", n_in, out_size, ws_size, (size_t)WS_END); grid = -1; return; }
        int dev = 0, cus = 0, per_cu = 0;
        if (hipGetDevice(&dev) != hipSuccess || hipDeviceGetAttribute(&cus, hipDeviceAttributeMultiprocessorCount, dev) != hipSuccess) { grid = -1; return; }
        if (hipFuncSetAttribute((const void*)fwd, hipFuncAttributeMaxDynamicSharedMemorySize, LDS_BYTES) != hipSuccess) { fprintf(stderr, "kernel_launch: hipFuncSetAttribute failed\n"); grid = -1; return; }
        if (hipOccupancyMaxActiveBlocksPerMultiprocessor(&per_cu, (const void*)fwd, NTHREADS, LDS_BYTES) != hipSuccess || per_cu < 1) fprintf(stderr, "kernel_launch: occupancy query reports %d\n", per_cu);
        (void)hipGetLastError();
        grid = cus > 256 ? 256 : cus;
    }
    if (grid < 0) return;
    (void)in_sizes;
    if (hipMemsetAsync((char*)d_ws + WS_CTL, 0, CTL_BYTES, stream) != hipSuccess) return;
    Params p{};
    for (int i = 0; i < 18; ++i) p.in[i] = (const float*)d_in[i];
    p.out = (float*)d_out; p.ws = (unsigned char*)d_ws;
#if MK_PER_PHASE
    int li = 0;
    for (int ph = 0; ph < N_PHASES; ++ph) {
        const int k = (ph - 1) % PH_PER_LAYER, l = (ph - 1) / PH_PER_LAYER;
        if (ph > 0) { const bool moe = l & 1; if (k == 2 && l >= 2) continue; if (k == 8 || k == 9 || k == 11) continue; if (k == 7 && !moe) continue; }
        p.ph_lo = ph; p.ph_hi = ph + 1; p.li = li++; p.pad = 0;
        hipLaunchKernelGGL(fwd, dim3(grid), dim3(NTHREADS), LDS_BYTES, stream, p);
    }
#else
    p.ph_lo = 0; p.ph_hi = N_PHASES; p.li = 0; p.pad = 0;
    hipLaunchKernelGGL(fwd, dim3(grid), dim3(NTHREADS), LDS_BYTES, stream, p);
#endif
}
```

```cpp
#include <hip/hip_runtime.h>
#include <cstdio>
#include <cstdint>

#define LAS __attribute__((address_space(3)))
#define GAS __attribute__((address_space(1)))
typedef unsigned short bf16_t;
typedef short bf16x8 __attribute__((ext_vector_type(8)));
typedef float f32x4 __attribute__((ext_vector_type(4)));
typedef float f32x2 __attribute__((ext_vector_type(2)));
typedef unsigned u32x4 __attribute__((ext_vector_type(4)));
typedef unsigned u32x2 __attribute__((ext_vector_type(2)));

constexpr int D = 1024, NBATCH = 4, SEQ = 8192, NMETA = 16;
constexpr int MREAL = NBATCH * SEQ;
constexpr int MV = MREAL + NMETA;
constexpr int MP = 129 * 256;
constexpr int M_HEADS = 8, M_QK = 64, M_V = 128;
constexpr int M_IN = 3088, M_INP = 3328;
constexpr int PROJ_LD = 3072;
constexpr int A_HEADS = 16, A_KV = 4, A_HD = 64, WINDOW = 128;
constexpr int D_FF = 2816, N_EXP = 8, D_FF_EXP = 3584;
constexpr float ALPHA = 1.681792830507429f;
constexpr float LN_EPS = 1e-5f;
constexpr int RP = 265 * 256;
constexpr int NSEG = 8, SEG_CHUNKS = 16;
constexpr int ST_FLOATS = 8 * 5 * 64 * 4;

constexpr size_t MiB = 1u << 20;
constexpr size_t al(size_t x) { return (x + 4095) & ~(size_t)4095; }
constexpr size_t WS_CTL = 0, CTL_BYTES = 1 * MiB;
constexpr size_t WS_WIN = WS_CTL + CTL_BYTES;
constexpr size_t WS_WOUT = WS_WIN + al((size_t)2 * M_INP * D * 2);
constexpr size_t WS_WQKV = WS_WOUT + al((size_t)2 * D * D * 2);
constexpr size_t WS_WQ3 = WS_WQKV + al((size_t)1536 * D * 2);
constexpr size_t WS_WO = WS_WQ3 + al((size_t)D * D * 2);
constexpr size_t WS_WGU = WS_WO + al((size_t)2 * D * D * 2);
constexpr size_t WS_WDN = WS_WGU + al((size_t)2 * 2 * D_FF * D * 2);
constexpr size_t WS_WGUE = WS_WDN + al((size_t)2 * D * D_FF * 2);
constexpr size_t WS_WDNE = WS_WGUE + al((size_t)16 * 2 * D_FF_EXP * D * 2);
constexpr size_t WS_H = WS_WDNE + al((size_t)16 * D * D_FF_EXP * 2);
constexpr size_t WS_HB = WS_H + al((size_t)MP * D * 4);
constexpr size_t WS_PROJ = WS_HB + al((size_t)MP * D * 2);
constexpr size_t WS_HG = WS_PROJ + (size_t)MP * PROJ_LD * 2;
constexpr size_t WS_CONTRIB = WS_PROJ;
constexpr size_t WS_KB = WS_HG + al((size_t)MP * D * 2);
constexpr size_t WS_VB = WS_KB + al((size_t)MP * 256 * 2);
constexpr size_t WS_GATES = WS_VB + al((size_t)MP * 256 * 2);
constexpr size_t WS_ACT = WS_GATES + al((size_t)MP * 16 * 4);
constexpr size_t WS_STATE = WS_ACT + al((size_t)RP * D_FF_EXP * 2);
constexpr size_t WS_STSC = WS_STATE + al((size_t)32 * 7 * ST_FLOATS * 4);
constexpr size_t WS_ROPE = WS_STSC + al((size_t)32 * 7 * 4 * 4);
constexpr size_t WS_TOPE = WS_ROPE + al((size_t)8208 * 16 * 4);
constexpr size_t WS_TOPG = WS_TOPE + al((size_t)MP * 4);
constexpr size_t WS_ROWTOK = WS_TOPG + al((size_t)MP * 8);
constexpr size_t WS_ROWDST = WS_ROWTOK + al((size_t)RP * 4);
constexpr size_t WS_ROWGATE = WS_ROWDST + al((size_t)RP * 4);
constexpr size_t WS_STATS = WS_ROWGATE + al((size_t)RP * 4);
constexpr size_t WS_SMALL = WS_STATS + al((size_t)MP * 8);
constexpr int SM_BGATE = 0, SM_SINKS = 32, SM_BROUTER = 64, SM_LNH = 128, SM_LNG = SM_LNH + 2 * D, SM_LNB = SM_LNG + 8 * D, SM_WROUTER = SM_LNB + 8 * D, SM_END = SM_WROUTER + 2 * D * N_EXP;
constexpr size_t WS_END = WS_SMALL + al((size_t)SM_END * 4);
static_assert((size_t)MP * 2 * D * 4 <= (WS_KB - WS_PROJ), "contrib overlay fits PROJ+HG");

constexpr int CW_CNT = 1024;
constexpr int CW_CUR = 1024 + 256;
constexpr int CW_BAR = 16384;

constexpr int LDS_BYTES = 163840 - 512;
constexpr int RING_BYTES = 131072;
constexpr int MISC_OFF = LDS_BYTES - 256;

__device__ __forceinline__ unsigned f2bf(float f) { unsigned u = __builtin_bit_cast(unsigned, f); return (u + 0x7fffu + ((u >> 16) & 1u)) >> 16; }
__device__ __forceinline__ unsigned pk2(float lo, float hi) { return f2bf(lo) | (f2bf(hi) << 16); }
__device__ __forceinline__ unsigned cvt_pk_bf16(float lo, float hi) { unsigned r; asm volatile("v_cvt_pk_bf16_f32 %0, %1, %2" : "=v"(r) : "v"(lo), "v"(hi)); return r; }
__device__ __forceinline__ float bf2f(unsigned short b) { return __builtin_bit_cast(float, ((unsigned)b) << 16); }
__device__ __forceinline__ float wave_sum(float v) {
#pragma unroll
    for (int o = 1; o < 64; o <<= 1) v += __shfl_xor(v, o);
    return v;
}
__device__ __forceinline__ float fast_exp(float x) { return __builtin_amdgcn_exp2f(x * 1.4426950408889634f); }
#define LDS_WAIT() asm volatile("s_waitcnt lgkmcnt(0)" ::: "memory")
#define VM_WAIT() asm volatile("s_waitcnt vmcnt(0)" ::: "memory")

#define XB_TMO      128
#define XB_XCNT(j)  (256  + 64 * (j))
#define XB_XSUB(j)  (1280 + 64 * (j))
#define XB_XGEN(j)  (2304 + 64 * (j))
#define XB_TOP      3328
#define XB_TOPGEN   3392
#define XCD_BAR_WORDS 3456
#define XB_SPIN_CAP (1u << 18)
__device__ __forceinline__ unsigned xb_ld(unsigned* p)              { return __hip_atomic_load(p, __ATOMIC_RELAXED, __HIP_MEMORY_SCOPE_AGENT); }
__device__ __forceinline__ unsigned xb_add(unsigned* p, unsigned v) { return __hip_atomic_fetch_add(p, v, __ATOMIC_RELAXED, __HIP_MEMORY_SCOPE_AGENT); }
__device__ __forceinline__ unsigned xb_xcc_id() { return (unsigned)__builtin_amdgcn_s_getreg((3 << 11) | 20) & 0xFu; }
#define XB_SPIN(cond, bar) do { unsigned _sp = 0; while (cond) { __builtin_amdgcn_s_sleep(1); \
    if ((++_sp & 255u) == 0u) { if (xb_ld(&(bar)[XB_TMO])) break; if (_sp > XB_SPIN_CAP) { atomicAdd(&(bar)[XB_TMO], 1u); break; } } } } while (0)
struct XcdBarrier { unsigned* bar; unsigned x; volatile LAS unsigned* st; };
__device__ __forceinline__ XcdBarrier xcd_barrier_post(unsigned* bar, volatile LAS unsigned* st) {
    XcdBarrier b; b.bar = bar; b.x = xb_xcc_id(); b.st = st;
    if (threadIdx.x == 0) (void)xb_add(&bar[XB_XCNT(b.x)], 1u);
    return b;
}
__device__ __forceinline__ void xcd_barrier_complete(unsigned* bar, unsigned x, unsigned& nloc, unsigned& nx) {
    const unsigned G = gridDim.x * gridDim.y * gridDim.z;
    unsigned sum, cnt, mine, sp = 0u;
    for (;;) {
        sum = 0u; cnt = 0u; mine = 0u;
#pragma unroll
        for (unsigned j = 0; j < 16; ++j) { const unsigned c = xb_ld(&bar[XB_XCNT(j)]); sum += c; cnt += (c > 0u) ? 1u : 0u; mine = (j == x) ? c : mine; }
        if (sum == G) break;
        __builtin_amdgcn_s_sleep(1);
        if ((++sp & 255u) == 0u) { if (xb_ld(&bar[XB_TMO])) break; if (sp > XB_SPIN_CAP) { atomicAdd(&bar[XB_TMO], 1u); break; } }
    }
    nloc = mine > 0u ? mine : 1u; nx = cnt > 0u ? cnt : 1u;
}
__device__ __forceinline__ void xcd_barrier(const XcdBarrier& b) {
    asm volatile("s_waitcnt vmcnt(0)" ::: "memory");
    __syncthreads();
    if (threadIdx.x == 0) {
        unsigned* bar = b.bar;
        __builtin_amdgcn_s_waitcnt(0);
        unsigned nloc = b.st[0], nx = b.st[1];
        if (nloc == 0u) { xcd_barrier_complete(bar, b.x, nloc, nx); b.st[0] = nloc; b.st[1] = nx; }
        const unsigned old = xb_add(&bar[XB_XSUB(b.x)], 1u);
        const unsigned gen = old / nloc;
        if (old + 1u == (gen + 1u) * nloc) {
            __builtin_amdgcn_fence(__ATOMIC_RELEASE, "agent");
            asm volatile("s_waitcnt vmcnt(0)" ::: "memory");
            const unsigned og = xb_add(&bar[XB_TOP], 1u);
            const unsigned tg = og / nx;
            if (og + 1u == (tg + 1u) * nx) xb_add(&bar[XB_TOPGEN], 1u);
            else XB_SPIN(xb_ld(&bar[XB_TOPGEN]) == tg, bar);
            __builtin_amdgcn_fence(__ATOMIC_ACQUIRE, "agent");
            xb_add(&bar[XB_XGEN(b.x)], 1u);
            asm volatile("s_waitcnt vmcnt(0)" ::: "memory");
        } else {
            XB_SPIN(xb_ld(&bar[XB_XGEN(b.x)]) == gen, bar);
            __builtin_amdgcn_fence(__ATOMIC_ACQUIRE, "agent");
            asm volatile("s_waitcnt vmcnt(0)" ::: "memory");
        }
    }
    __syncthreads();
}

namespace pg8 {
constexpr int BM = 256, BK = 64, HALF = 128, HTB = HALF * BK * 2, STAGE_BYTES = 8 * HTB, NXCD = 8, WGM = 8;
__host__ __device__ __forceinline__ int lds_byte(int r, int c) { const int st = (r >> 4) * 2 + (c >> 5), rr = r & 15, cc = c & 31, ob = rr * 64 + cc * 2; return st * 1024 + (ob ^ (((ob >> 9) & 1) << 5)); }
__host__ __device__ __forceinline__ void stage_rc(int b, int& R, int& C) { const int st = b / 1024, sb = b % 1024, swz = sb ^ (((sb >> 9) & 1) << 5); R = (st >> 1) * 16 + swz / 64; C = (st & 1) * 32 + (swz % 64) / 2; }
__host__ __device__ __forceinline__ int perm32(int rho) { const int n = rho >> 4, i = rho & 15; return 8 * (i >> 2) + 4 * n + (i & 3); }

struct Unit { int pm, pn, brow; };

struct DenseOrder {
    int nM, nN, nwg, G, c;
    __device__ void init(int nM_, int nN_, int G_, int c_) { nM = nM_; nN = nN_; nwg = nM * nN; G = G_; c = c_; }
    __device__ __forceinline__ bool next(int i, Unit& u) const {
        const long L = (long)i * G + c; if (L >= nwg) return false;
        int wgid = (int)L; { const int q = nwg / NXCD, r = nwg % NXCD, xcd = wgid % NXCD, off = wgid / NXCD; wgid = (xcd < r ? xcd * (q + 1) : r * (q + 1) + (xcd - r) * q) + off; }
        const int nig = WGM * nN, gid = wgid / nig, fm = gid * WGM, gsz = (nM - fm) < WGM ? (nM - fm) : WGM;
        u.pm = fm + ((wgid % nig) % gsz); u.pn = (wgid % nig) / gsz; u.brow = u.pn * BM; return true;
    }
    __device__ __forceinline__ int a_row(const Unit& u, int r) const { return u.pm * BM + r; }
};
struct GroupedOrder {
    DenseOrder o; int pstart[9]; int nexp_rows;
    const int* rowtok;
    __device__ __forceinline__ bool next(int i, Unit& u) const {
        if (!o.next(i, u)) return false;
        int e = 0;
#pragma unroll
        for (int k = 1; k < 8; ++k) e += (u.pm >= pstart[k]) ? 1 : 0;
        u.brow = e * nexp_rows + u.pn * BM; return true;
    }
    __device__ __forceinline__ int a_row(const Unit& u, int r) const {
        const int pos = u.pm * BM + r; if (!rowtok) return pos;
        const int t = rowtok[pos]; return t < 0 ? 0 : t;
    }
};

template <class Epi, class Sched>
__device__ __forceinline__ void gemm_phase(LAS unsigned char* lds, const bf16_t* Abase, const bf16_t* Btbase, const int K, const Sched& S, const Epi& E) {
    int tid = threadIdx.x; asm volatile("; opaque tid" : "+v"(tid));
    const int wid = __builtin_amdgcn_readfirstlane(tid >> 6), lane = tid & 63, wr = wid >> 2, wc = wid & 3, fr = lane & 15, fq = lane >> 4;
    const int nt = K / BK;
    unsigned voffB[2];
#pragma unroll
    for (int i = 0; i < 2; ++i) { int R, C; stage_rc(tid * 16 + i * 8192, R, C); const int Rb = Epi::PERM ? ((R & ~31) + perm32(R & 31)) : R; voffB[i] = (unsigned)(Rb * K + C) * 2u; }
    const size_t kstep = (size_t)(BK * 2);
    const size_t hstep = (size_t)HALF * K * 2;
    const unsigned ldsw = (unsigned)wid * 1024u;
    const int aoff = lds_byte(wr * 64 + fr, fq * 8), boff = lds_byte(wc * 32 + fr, fq * 8);
#define PG8_SA(b, h) (((b) * 2 + (h)) * HTB)
#define PG8_SB(b, h) ((4 + (b) * 2 + (h)) * HTB)
#define PG8_STAGE(bufoff, gbase, voff) do { const char* _gb = (const char*)(gbase); asm volatile("" : "+s"(_gb)); _Pragma("unroll") for (int _i = 0; _i < 2; ++_i) \
        __builtin_amdgcn_global_load_lds((const unsigned*)(_gb + (voff)[_i]), (LAS unsigned*)(lds + (bufoff) + ldsw + _i * 8192), 16, 0, 0); } while (0)
#define PG8_LDA(dst, b, h) do { _Pragma("unroll") for (int m = 0; m < 4; ++m) _Pragma("unroll") for (int k = 0; k < 2; ++k) dst[m][k] = *(const LAS bf16x8*)(lds + PG8_SA(b, h) + aoff + m * 2048 + k * 1024); } while (0)
#define PG8_LDB(dst, b, h) do { _Pragma("unroll") for (int n = 0; n < 2; ++n) _Pragma("unroll") for (int k = 0; k < 2; ++k) dst[n][k] = *(const LAS bf16x8*)(lds + PG8_SB(b, h) + boff + n * 2048 + k * 1024); } while (0)
#define PG8_MMA(ai, bj, At, Bt) do { __builtin_amdgcn_s_setprio(1); _Pragma("unroll") for (int m = 0; m < 4; ++m) _Pragma("unroll") for (int n = 0; n < 2; ++n) _Pragma("unroll") for (int k = 0; k < 2; ++k) \
        acc[ai][bj][m][n] = __builtin_amdgcn_mfma_f32_16x16x32_bf16(Bt[n][k], At[m][k], acc[ai][bj][m][n], 0, 0, 0); __builtin_amdgcn_s_setprio(0); } while (0)
#define PG8_WAIT_V(n) asm volatile("s_waitcnt vmcnt(" #n ")" ::: "memory")
#define PG8_WAIT_L(n) asm volatile("s_waitcnt lgkmcnt(" #n ")" ::: "memory")
#define PG8_BAR __builtin_amdgcn_s_barrier()
#define PG8_SCHED __builtin_amdgcn_sched_barrier(0)
#define PG8_AOFF(dst, u) do { _Pragma("unroll") for (int _i = 0; _i < 2; ++_i) { int _R, _C; stage_rc(tid * 16 + _i * 8192, _R, _C); _Pragma("unroll") for (int _h = 0; _h < 2; ++_h) \
        dst[_h][_i] = (unsigned)(((size_t)S.a_row(u, _h * HALF + _R) * K + _C) * 2u); } } while (0)
    Unit cur, nxt; int ui = 0;
    if (!S.next(0, cur)) return;
    f32x4 acc[2][2][4][2];
#pragma unroll
    for (int a = 0; a < 2; ++a)
#pragma unroll
        for (int b = 0; b < 2; ++b)
#pragma unroll
            for (int m = 0; m < 4; ++m)
#pragma unroll
                for (int n = 0; n < 2; ++n) acc[a][b][m][n] = (f32x4){0.f, 0.f, 0.f, 0.f};
    bf16x8 At[4][2], B0[2][2], B1[2][2];
    unsigned cao[2][2];
    PG8_AOFF(cao, cur);
    const char* cA = (const char*)Abase; const char* cB = (const char*)Btbase + (size_t)cur.brow * K * 2;
    PG8_STAGE(PG8_SB(0, 0), cB, voffB); PG8_STAGE(PG8_SB(0, 1), cB + hstep, voffB); PG8_STAGE(PG8_SA(0, 0), cA, cao[0]); PG8_STAGE(PG8_SA(0, 1), cA, cao[1]);
    if (wr == 1) PG8_BAR;
    PG8_WAIT_V(2); PG8_BAR;
    PG8_STAGE(PG8_SB(1, 0), cB + kstep, voffB); PG8_STAGE(PG8_SA(1, 0), cA + kstep, cao[0]); PG8_STAGE(PG8_SB(1, 1), cB + hstep + kstep, voffB);
    PG8_WAIT_V(6); PG8_BAR;
    for (;;) {
        const bool has_next = S.next(ui + 1, nxt);
        const char* nB = has_next ? (const char*)Btbase + (size_t)nxt.brow * K * 2 : cB;
        for (int t = 0; t < nt; t += 2) {
            const bool last = (t == nt - 2);
            const char* a1 = cA + (size_t)(t + 1) * kstep;
            const char* a2 = last ? cA : cA + (size_t)(t + 2) * kstep; const char* b2 = last ? nB : cB + (size_t)(t + 2) * kstep;
            const char* a3 = a2 + kstep; const char* b3 = b2 + kstep;
            PG8_LDB(B0, 0, 0); PG8_LDB(B1, 0, 1); PG8_SCHED; PG8_LDA(At, 0, 0); PG8_STAGE(PG8_SA(1, 1), a1, cao[1]);
            if (last && has_next) { PG8_AOFF(cao, nxt); }
            PG8_WAIT_V(8); PG8_WAIT_L(0); PG8_BAR; PG8_MMA(0, 0, At, B0); PG8_MMA(0, 1, At, B1); PG8_BAR; PG8_SCHED;
            PG8_LDA(At, 0, 1); PG8_STAGE(PG8_SB(0, 0), b2, voffB); PG8_STAGE(PG8_SB(0, 1), b2 + hstep, voffB); PG8_STAGE(PG8_SA(0, 0), a2, cao[0]);
            PG8_WAIT_V(8); PG8_WAIT_L(0); PG8_BAR; PG8_MMA(1, 0, At, B0); PG8_MMA(1, 1, At, B1); PG8_BAR; PG8_SCHED;
            PG8_LDB(B0, 1, 0); PG8_LDB(B1, 1, 1); PG8_SCHED; PG8_LDA(At, 1, 0); PG8_STAGE(PG8_SA(0, 1), a2, cao[1]);
            PG8_WAIT_V(8); PG8_WAIT_L(0); PG8_BAR; PG8_MMA(0, 0, At, B0); PG8_MMA(0, 1, At, B1); PG8_BAR; PG8_SCHED;
            PG8_LDA(At, 1, 1); PG8_STAGE(PG8_SB(1, 0), b3, voffB); PG8_STAGE(PG8_SB(1, 1), b3 + hstep, voffB); PG8_STAGE(PG8_SA(1, 0), a3, cao[0]);
            PG8_WAIT_V(8); PG8_WAIT_L(0); PG8_BAR; PG8_MMA(1, 0, At, B0); PG8_MMA(1, 1, At, B1); PG8_BAR; PG8_SCHED;
        }
        if (wr == 0) PG8_BAR;
        E(acc, cur, wr, wc, fr, fq);
        if (!has_next) break;
#pragma unroll
        for (int a = 0; a < 2; ++a)
#pragma unroll
            for (int b = 0; b < 2; ++b)
#pragma unroll
                for (int m = 0; m < 4; ++m)
#pragma unroll
                    for (int n = 0; n < 2; ++n) acc[a][b][m][n] = (f32x4){0.f, 0.f, 0.f, 0.f};
        cur = nxt; cB = nB; ++ui;
        if (wr == 1) PG8_BAR;
    }
    PG8_WAIT_V(0);
    PG8_BAR;
#undef PG8_SA
#undef PG8_SB
#undef PG8_STAGE
#undef PG8_LDA
#undef PG8_LDB
#undef PG8_MMA
#undef PG8_WAIT_V
#undef PG8_WAIT_L
#undef PG8_BAR
#undef PG8_SCHED
#undef PG8_AOFF
}
}

typedef f32x4 AccT[2][2][4][2];

struct EpiProj {
    static constexpr bool PERM = true;
    bf16_t* proj; float* gates; const float* bgate;
    __device__ __forceinline__ void operator()(const AccT& acc, const pg8::Unit& u, int wr, int wc, int fr, int fq) const {
        const int row0 = u.pm * 256 + wr * 64 + fr;
        if (u.pn < 12) {
            const int col0 = u.pn * 256 + wc * 32 + 8 * fq;
#pragma unroll
            for (int ai = 0; ai < 2; ++ai)
#pragma unroll
                for (int m = 0; m < 4; ++m) { bf16_t* rowp = proj + (size_t)(row0 + ai * 128 + m * 16) * PROJ_LD + col0;
#pragma unroll
                    for (int bj = 0; bj < 2; ++bj) { const f32x4 v0 = acc[ai][bj][m][0], v1 = acc[ai][bj][m][1];
                        u32x4 w; w.x = cvt_pk_bf16(v0[0], v0[1]); w.y = cvt_pk_bf16(v0[2], v0[3]); w.z = cvt_pk_bf16(v1[0], v1[1]); w.w = cvt_pk_bf16(v1[2], v1[3]);
                        *(u32x4*)(rowp + bj * 128) = w; } }
        } else if (wc == 0 && fq < 2) {
#pragma unroll
            for (int n = 0; n < 2; ++n) { const f32x4 bv = *(const f32x4*)(bgate + 8 * fq + 4 * n);
#pragma unroll
                for (int ai = 0; ai < 2; ++ai)
#pragma unroll
                    for (int m = 0; m < 4; ++m) *(f32x4*)(gates + (size_t)(row0 + ai * 128 + m * 16) * 16 + 8 * fq + 4 * n) = acc[ai][0][m][n] + bv; }
        }
    }
};
struct EpiRes {
    static constexpr bool PERM = false;
    float* H; const float* stats; const float* lg; const float* lb;
    __device__ __forceinline__ void operator()(const AccT& acc, const pg8::Unit& u, int wr, int wc, int fr, int fq) const {
        const int row0 = u.pm * 256 + wr * 64 + fr, col0 = u.pn * 256 + wc * 32 + 4 * fq;
        f32x4 gv[2][2], bv[2][2];
        if (lg) {
#pragma unroll
            for (int bj = 0; bj < 2; ++bj)
#pragma unroll
                for (int n = 0; n < 2; ++n) { gv[bj][n] = *(const f32x4*)(lg + col0 + bj * 128 + n * 16); bv[bj][n] = *(const f32x4*)(lb + col0 + bj * 128 + n * 16); } }
#pragma unroll
        for (int ai = 0; ai < 2; ++ai)
#pragma unroll
            for (int m = 0; m < 4; ++m) { const int row = row0 + ai * 128 + m * 16; float* rowp = H + (size_t)row * D + col0;
                f32x2 st = (f32x2){0.f, 1.f}; if (lg) st = *(const f32x2*)(stats + 2 * (size_t)row);
#pragma unroll
                for (int bj = 0; bj < 2; ++bj)
#pragma unroll
                    for (int n = 0; n < 2; ++n) { float* p = rowp + bj * 128 + n * 16; f32x4 h = *(const f32x4*)p;
                        if (lg) h = (h - st.x) * st.y * gv[bj][n] + bv[bj][n];
                        *(f32x4*)p = h * ALPHA + acc[ai][bj][m][n]; } }
    }
};
struct EpiSwiglu {
    static constexpr bool PERM = true;
    bf16_t* act; int ld;
    __device__ __forceinline__ static float silu_mul(float g, float u) { return g * u * __builtin_amdgcn_rcpf(1.0f + __builtin_amdgcn_exp2f(-g * 1.4426950408889634f)); }
    __device__ __forceinline__ void operator()(const AccT& acc, const pg8::Unit& u, int wr, int wc, int fr, int fq) const {
        const int row0 = u.pm * 256 + wr * 64 + fr, col0 = u.pn * 128 + wc * 32 + 8 * fq;
#pragma unroll
        for (int ai = 0; ai < 2; ++ai)
#pragma unroll
            for (int m = 0; m < 4; ++m) { const f32x4 g0 = acc[ai][0][m][0], g1 = acc[ai][0][m][1], u0 = acc[ai][1][m][0], u1 = acc[ai][1][m][1];
                u32x4 w; w.x = cvt_pk_bf16(silu_mul(g0[0], u0[0]), silu_mul(g0[1], u0[1])); w.y = cvt_pk_bf16(silu_mul(g0[2], u0[2]), silu_mul(g0[3], u0[3]));
                w.z = cvt_pk_bf16(silu_mul(g1[0], u1[0]), silu_mul(g1[1], u1[1])); w.w = cvt_pk_bf16(silu_mul(g1[2], u1[2]), silu_mul(g1[3], u1[3]));
                *(u32x4*)(act + (size_t)(row0 + ai * 128 + m * 16) * ld + col0) = w; }
    }
};
struct EpiScatter {
    static constexpr bool PERM = false;
    float* contrib; const int* rowdst; const float* rowgate;
    __device__ __forceinline__ void operator()(const AccT& acc, const pg8::Unit& u, int wr, int wc, int fr, int fq) const {
        const int row0 = u.pm * 256 + wr * 64 + fr, col0 = u.pn * 256 + wc * 32 + 4 * fq;
#pragma unroll
        for (int ai = 0; ai < 2; ++ai)
#pragma unroll
            for (int m = 0; m < 4; ++m) { const int pos = row0 + ai * 128 + m * 16; const int d = rowdst[pos];
                if (d >= 0) { const float g = rowgate[pos]; float* rowp = contrib + (size_t)d * D + col0;
#pragma unroll
                    for (int bj = 0; bj < 2; ++bj)
#pragma unroll
                        for (int n = 0; n < 2; ++n) *(f32x4*)(rowp + bj * 128 + n * 16) = acc[ai][bj][m][n] * g; } }
    }
};
struct EpiQKV {
    static constexpr bool PERM = true;
    bf16_t *Q, *KB, *VB; const float* rope;
    __device__ __forceinline__ void operator()(const AccT& acc, const pg8::Unit& u, int wr, int wc, int fr, int fq) const {
        const int row0 = u.pm * 256 + wr * 64 + fr, cl = wc * 32 + 8 * fq;
        bf16_t* base; int ld;
        if (u.pn == 5) {
#pragma unroll
            for (int ai = 0; ai < 2; ++ai)
#pragma unroll
                for (int m = 0; m < 4; ++m) { const int row = row0 + ai * 128 + m * 16;
#pragma unroll
                    for (int bj = 0; bj < 2; ++bj)
#pragma unroll
                        for (int n = 0; n < 2; ++n)
#pragma unroll
                            for (int j = 0; j < 4; ++j) VB[(size_t)(bj * 128 + cl + 4 * n + j) * MP + row] = (bf16_t)f2bf(acc[ai][bj][m][n][j]); }
            return; }
        if (u.pn < 4) { base = Q + u.pn * 256 + cl; ld = D; } else { base = KB + cl; ld = 256; }
        const bool dorope = (u.pn <= 4) && ((wc & 1) == 0);
#pragma unroll
        for (int ai = 0; ai < 2; ++ai)
#pragma unroll
            for (int m = 0; m < 4; ++m) { const int row = row0 + ai * 128 + m * 16;
                f32x4 v[2][2];
#pragma unroll
                for (int bj = 0; bj < 2; ++bj)
#pragma unroll
                    for (int n = 0; n < 2; ++n) v[bj][n] = acc[ai][bj][m][n];
                if (dorope) {
                    int pos = row < MREAL ? (row & (SEQ - 1)) + NMETA : row - MREAL; pos = pos > SEQ + NMETA - 1 ? SEQ + NMETA - 1 : pos;
                    const float* rp = rope + (size_t)pos * 16;
                    const f32x4 c0 = *(const f32x4*)rp, c1 = *(const f32x4*)(rp + 4), s0 = *(const f32x4*)(rp + 8), s1 = *(const f32x4*)(rp + 12);
#pragma unroll
                    for (int bj = 0; bj < 2; ++bj)
#pragma unroll
                        for (int n = 0; n < 2; ++n) { const f32x4 c = n ? c1 : c0, s = n ? s1 : s0; f32x4 o;
#pragma unroll
                            for (int j = 0; j < 4; ++j) { const float x = v[bj][n][j]; const float y = __shfl_xor(x, 16);
                                o[j] = fq == 0 ? x * c[j] - y * s[j] : (fq == 1 ? x * c[j] + y * s[j] : x); }
                            v[bj][n] = o; }
                }
#pragma unroll
                for (int bj = 0; bj < 2; ++bj) { const f32x4 v0 = v[bj][0], v1 = v[bj][1];
                    u32x4 w; w.x = cvt_pk_bf16(v0[0], v0[1]); w.y = cvt_pk_bf16(v0[2], v0[3]); w.z = cvt_pk_bf16(v1[0], v1[1]); w.w = cvt_pk_bf16(v1[2], v1[3]);
                    *(u32x4*)(base + (size_t)row * ld + bj * 128) = w; } }
    }
};

template <int NACC, class F>
__device__ __forceinline__ void skinny_item(const bf16_t* A, int lda, const bf16_t* (&Bt)[NACC], int K, int wave, int lane, LAS unsigned char* lds, int parity, const F& epi) {
    const int fr = lane & 15, quad = lane >> 4, kw = K >> 3;
    const bf16_t* ap = A + (size_t)fr * lda + wave * kw + 8 * quad;
    f32x4 acc[NACC];
#pragma unroll
    for (int i = 0; i < NACC; ++i) acc[i] = (f32x4){0.f, 0.f, 0.f, 0.f};
#pragma unroll 2
    for (int k = 0; k < kw; k += 32) { const bf16x8 a = *(const bf16x8*)(ap + k);
#pragma unroll
        for (int i = 0; i < NACC; ++i) acc[i] = __builtin_amdgcn_mfma_f32_16x16x32_bf16(a, *(const bf16x8*)(Bt[i] + (size_t)fr * K + wave * kw + 8 * quad + k), acc[i], 0, 0, 0); }
    LAS f32x4* red = (LAS f32x4*)(lds + parity * 16384);
#pragma unroll
    for (int i = 0; i < NACC; ++i) red[(wave * NACC + i) * 64 + lane] = acc[i];
    __syncthreads();
    if (wave == 0) {
#pragma unroll
        for (int i = 0; i < NACC; ++i) { f32x4 t = red[i * 64 + lane];
#pragma unroll
            for (int w = 1; w < 8; ++w) t += red[(w * NACC + i) * 64 + lane];
            acc[i] = t; }
        epi(acc, fr, quad);
    }
}

struct Params { const float* in[18]; float* out; unsigned char* ws; int ph_lo, ph_hi, li, pad; };
enum { I_X = 0, I_META, I_WIN, I_BGATE, I_LNH, I_WOUT, I_WKV, I_WQ, I_SINKS, I_WO, I_WGUD, I_WDND, I_WROUTER, I_BROUTER, I_WGUE, I_WDNE, I_LNG, I_LNB };
constexpr int NWAVES = 8, NTHREADS = 512;

__device__ __forceinline__ void tr_item(const float* W, int Nsrc, int K, bf16_t* WT, int k0, int n0, int drow0, float scale, int nvalid, LAS float* scr, int lane) {
#pragma unroll 8
    for (int i = 0; i < 32; ++i) { const int kk = 2 * i + (lane >> 5), n = lane & 31; scr[kk * 33 + n] = (n < nvalid) ? W[(size_t)(k0 + kk) * Nsrc + n0 + n] * scale : 0.f; }
    LDS_WAIT(); asm volatile("" ::: "memory");
    const int c = lane & 7;
#pragma unroll
    for (int j = 0; j < 4; ++j) { const int n = (lane >> 3) + 8 * j; const LAS float* s = scr + (8 * c) * 33 + n;
        u32x4 o; o.x = pk2(s[0 * 33], s[1 * 33]); o.y = pk2(s[2 * 33], s[3 * 33]); o.z = pk2(s[4 * 33], s[5 * 33]); o.w = pk2(s[6 * 33], s[7 * 33]);
        if (n < nvalid) *(u32x4*)(WT + (size_t)(drow0 + n) * K + k0 + 8 * c) = o; }
    LDS_WAIT(); asm volatile("" ::: "memory");
}
__device__ __forceinline__ int pair_row(int n, int FF) { const int up = n >= FF ? 1 : 0, j = n - up * FF; return 256 * (j >> 7) + 128 * up + (j & 127); }

__device__ __forceinline__ void p0_prologue(const Params& P, LAS unsigned char* lds, int gw, int NGW, int wave, int lane) {
    unsigned char* ws = P.ws;
    LAS float* scr = (LAS float*)(lds + wave * 16384);
    constexpr int IT0 = 16 * 97, IT1 = 16 * 32, IT2 = 16 * 16, IT5 = 16 * 176, IT6 = 44 * 32, IT7 = 16 * 224, IT8 = 56 * 32;
    constexpr int C0 = 2 * IT0, C1 = C0 + 2 * IT1, C2 = C1 + IT2, C3 = C2 + 2 * IT1, C4 = C3 + 2 * IT1, C5 = C4 + 2 * IT5, C6 = C5 + 2 * IT6, C7 = C6 + 16 * IT7, C8 = C7 + 16 * IT8;
    for (int it = gw; it < C8; it += NGW) {
        if (it < C0) { const int mi = it / IT0, r = it % IT0, kb = r / 97, nb = r % 97; const int n0 = nb * 32;
            tr_item(P.in[I_WIN] + (size_t)mi * D * M_IN, M_IN, D, (bf16_t*)(ws + WS_WIN) + (size_t)mi * M_INP * D, kb * 64, n0, n0, n0 < 512 ? 0.125f : 1.f, nb == 96 ? 16 : 32, scr, lane);
        } else if (it < C1) { const int q = it - C0, mi = q / IT1, r = q % IT1, kb = r / 32, nb = r % 32;
            tr_item(P.in[I_WOUT] + (size_t)mi * D * D, D, D, (bf16_t*)(ws + WS_WOUT) + (size_t)mi * D * D, kb * 64, nb * 32, nb * 32, 1.f, 32, scr, lane);
        } else if (it < C2) { const int r = it - C1, kb = r / 16, nb = r % 16;
            tr_item(P.in[I_WKV], 512, D, (bf16_t*)(ws + WS_WQKV), kb * 64, nb * 32, 1024 + nb * 32, 1.f, 32, scr, lane);
        } else if (it < C3) { const int q = it - C2, mi = q / IT1, r = q % IT1, kb = r / 32, nb = r % 32;
            tr_item(P.in[I_WQ] + (size_t)mi * D * D, D, D, (bf16_t*)(ws + (mi ? WS_WQ3 : WS_WQKV)), kb * 64, nb * 32, nb * 32, 0.125f, 32, scr, lane);
        } else if (it < C4) { const int q = it - C3, mi = q / IT1, r = q % IT1, kb = r / 32, nb = r % 32;
            tr_item(P.in[I_WO] + (size_t)mi * D * D, D, D, (bf16_t*)(ws + WS_WO) + (size_t)mi * D * D, kb * 64, nb * 32, nb * 32, 1.f, 32, scr, lane);
        } else if (it < C5) { const int q = it - C4, mi = q / IT5, r = q % IT5, kb = r / 176, nb = r % 176;
            tr_item(P.in[I_WGUD] + (size_t)mi * D * 2 * D_FF, 2 * D_FF, D, (bf16_t*)(ws + WS_WGU) + (size_t)mi * 2 * D_FF * D, kb * 64, nb * 32, pair_row(nb * 32, D_FF), 1.f, 32, scr, lane);
        } else if (it < C6) { const int q = it - C5, mi = q / IT6, r = q % IT6, kb = r / 32, nb = r % 32;
            tr_item(P.in[I_WDND] + (size_t)mi * D_FF * D, D, D_FF, (bf16_t*)(ws + WS_WDN) + (size_t)mi * D * D_FF, kb * 64, nb * 32, nb * 32, 1.f, 32, scr, lane);
        } else if (it < C7) { const int q = it - C6, mi = q / IT7, r = q % IT7, kb = r / 224, nb = r % 224;
            tr_item(P.in[I_WGUE] + (size_t)mi * D * 2 * D_FF_EXP, 2 * D_FF_EXP, D, (bf16_t*)(ws + WS_WGUE) + (size_t)mi * 2 * D_FF_EXP * D, kb * 64, nb * 32, pair_row(nb * 32, D_FF_EXP), 1.f, 32, scr, lane);
        } else { const int q = it - C7, mi = q / IT8, r = q % IT8, kb = r / 32, nb = r % 32;
            tr_item(P.in[I_WDNE] + (size_t)mi * D_FF_EXP * D, D, D_FF_EXP, (bf16_t*)(ws + WS_WDNE) + (size_t)mi * D * D_FF_EXP, kb * 64, nb * 32, nb * 32, 1.f, 32, scr, lane);
        }
    }
    { float* sm = (float*)(ws + WS_SMALL); const int gt = gw * 64 + lane, NT = NGW * 64;
      for (int i = gt; i < SM_END; i += NT) { float v = 0.f;
          if (i < SM_SINKS) v = P.in[I_BGATE][i]; else if (i < SM_BROUTER) v = P.in[I_SINKS][i - SM_SINKS]; else if (i < SM_BROUTER + 16) v = P.in[I_BROUTER][i - SM_BROUTER];
          else if (i < SM_LNH) v = 0.f; else if (i < SM_LNG) v = P.in[I_LNH][i - SM_LNH]; else if (i < SM_LNB) v = P.in[I_LNG][i - SM_LNG]; else if (i < SM_WROUTER) v = P.in[I_LNB][i - SM_LNB]; else v = P.in[I_WROUTER][i - SM_WROUTER];
          sm[i] = v; } }
    { float* H = (float*)(ws + WS_H); bf16_t* HB = (bf16_t*)(ws + WS_HB);
      const size_t gt = (size_t)gw * 64 + lane, NT = (size_t)NGW * 64;
      for (size_t i = gt; i < (size_t)MV * (D / 4); i += NT) { const size_t row = i >> 8; const int c4 = (int)(i & 255);
          const f32x4 v = row < MREAL ? ((const f32x4*)P.in[I_X])[i] : ((const f32x4*)P.in[I_META])[(row - MREAL) * 256 + c4];
          ((f32x4*)H)[i] = v; u32x2 w; w.x = pk2(v[0], v[1]); w.y = pk2(v[2], v[3]); ((u32x2*)HB)[i] = w; }
      float* rope = (float*)(ws + WS_ROPE);
      for (size_t i = gt; i < (size_t)(SEQ + NMETA) * 8; i += NT) { const int pos = (int)(i >> 3), fi = (int)(i & 7);
          const double invf = fi == 0 ? 1.0 : fi == 1 ? 0.19392274474868576 : fi == 2 ? 0.03760603093086393 : fi == 3 ? 0.007292664737217109 : fi == 4 ? 0.001414213562373095
                            : fi == 5 ? 0.0002742481756762073 : fi == 6 ? 5.318295896944988e-05 : 1.031338537721246e-05;
          const float angf = (float)pos * (float)invf;
          double a = (double)angf; a -= 6.283185307179586476925 * __builtin_rint(a * 0.15915494309189533577); const double hx = 0.5 * a, h2 = hx * hx;
          double sp = 1.0, cp = 1.0;
#pragma unroll
          for (int k = 12; k >= 1; --k) { sp = 1.0 - sp * h2 / (double)((2 * k) * (2 * k + 1)); cp = 1.0 - cp * h2 / (double)((2 * k - 1) * (2 * k)); }
          const double sh = hx * sp, ch = cp;
          rope[(size_t)pos * 16 + fi] = (float)(1.0 - 2.0 * sh * sh); rope[(size_t)pos * 16 + 8 + fi] = (float)(2.0 * sh * ch); }
    }
}

__device__ __forceinline__ void ln_phase(unsigned char* ws, float* outp, LAS unsigned char* lds, int gw, int NGW, int lane, int tid,
                                         int lnidx, bool moe_src, bool router, int moe_idx, bool final) {
    const float* sm = (const float*)(ws + WS_SMALL);
    float* H = (float*)(ws + WS_H); bf16_t* HB = (bf16_t*)(ws + WS_HB); const float* contrib = (const float*)(ws + WS_CONTRIB); float* stats = (float*)(ws + WS_STATS);
    const float* lg = sm + SM_LNG + (size_t)lnidx * D; const float* lb = sm + SM_LNB + (size_t)lnidx * D;
    f32x4 gv[4], bv[4];
#pragma unroll
    for (int j = 0; j < 4; ++j) { gv[j] = *(const f32x4*)(lg + 256 * j + 4 * lane); bv[j] = *(const f32x4*)(lb + 256 * j + 4 * lane); }
    LAS float* wr = (LAS float*)lds;
    volatile LAS unsigned* misc = (volatile LAS unsigned*)(lds + MISC_OFF);
    if (router) {
        const float* src = sm + SM_WROUTER + (size_t)moe_idx * D * N_EXP;
        for (int i = tid; i < D * N_EXP / 4; i += NTHREADS) ((LAS f32x4*)wr)[i] = ((const f32x4*)src)[i];
        if (tid < 8) misc[16 + tid] = 0u;
        __syncthreads();
    }
    int* tope = (int*)(ws + WS_TOPE); float* topg = (float*)(ws + WS_TOPG);
    const float* br = sm + SM_BROUTER + moe_idx * N_EXP;
    f32x4 nv[4], nc0[4], nc1[4]; f32x2 nst;
    auto fetch = [&](int row) {
        const f32x4* hr = (const f32x4*)(H + (size_t)row * D) + lane;
#pragma unroll
        for (int j = 0; j < 4; ++j) nv[j] = hr[64 * j];
        if (moe_src) { const f32x4* c0 = (const f32x4*)(contrib + (size_t)(2 * row) * D) + lane; const f32x4* c1 = c0 + 256;
#pragma unroll
            for (int j = 0; j < 4; ++j) { nc0[j] = c0[64 * j]; nc1[j] = c1[64 * j]; } }
        nst = *(const f32x2*)(stats + 2 * (size_t)row);
    };
    if (gw < MV) fetch(gw);
    for (int row = gw; row < MV; row += NGW) {
        f32x4 v[4], c0v[4], c1v[4]; const f32x2 st = nst;
#pragma unroll
        for (int j = 0; j < 4; ++j) { v[j] = nv[j]; c0v[j] = nc0[j]; c1v[j] = nc1[j]; }
        if (row + NGW < MV) fetch(row + NGW);
        if (moe_src) { const float* pg = lg - D; const float* pb = lb - D;
#pragma unroll
            for (int j = 0; j < 4; ++j) { const f32x4 g1 = *(const f32x4*)(pg + 256 * j + 4 * lane), b1 = *(const f32x4*)(pb + 256 * j + 4 * lane);
                v[j] = ((v[j] - st.x) * st.y * g1 + b1) * ALPHA + c0v[j] + c1v[j]; }
            if (!final) { f32x4* o = (f32x4*)(H + (size_t)row * D) + lane;
#pragma unroll
                for (int j = 0; j < 4; ++j) o[64 * j] = v[j]; } }
        float s = 0.f;
#pragma unroll
        for (int j = 0; j < 4; ++j) s += (v[j][0] + v[j][1]) + (v[j][2] + v[j][3]);
        const float mean = wave_sum(s) * (1.f / D); float s2 = 0.f;
#pragma unroll
        for (int j = 0; j < 4; ++j) { v[j] = v[j] - mean; s2 += (v[j][0] * v[j][0] + v[j][1] * v[j][1]) + (v[j][2] * v[j][2] + v[j][3] * v[j][3]); }
        const float rstd = 1.f / sqrtf(wave_sum(s2) * (1.f / D) + LN_EPS);
#pragma unroll
        for (int j = 0; j < 4; ++j) v[j] = v[j] * rstd * gv[j] + bv[j];
        if (final) { if (row < MREAL) { f32x4* o = (f32x4*)(outp + (size_t)row * D) + lane;
#pragma unroll
                for (int j = 0; j < 4; ++j) o[64 * j] = v[j]; } }
        else { u32x2* ob = (u32x2*)(HB + (size_t)row * D) + lane;
            if (lane == 0) *(f32x2*)(stats + 2 * (size_t)row) = (f32x2){mean, rstd};
#pragma unroll
            for (int j = 0; j < 4; ++j) { u32x2 w; w.x = pk2(v[j][0], v[j][1]); w.y = pk2(v[j][2], v[j][3]); ob[64 * j] = w; } }
        if (router) {
            float lg8[8];
#pragma unroll
            for (int e = 0; e < 8; ++e) lg8[e] = 0.f;
#pragma unroll
            for (int j = 0; j < 4; ++j)
#pragma unroll
                for (int c = 0; c < 4; ++c) { const LAS f32x4* w4 = (const LAS f32x4*)(wr + (size_t)(256 * j + 4 * lane + c) * 8); const f32x4 wa = w4[0], wb = w4[1]; const float x = v[j][c];
                    lg8[0] += x * wa[0]; lg8[1] += x * wa[1]; lg8[2] += x * wa[2]; lg8[3] += x * wa[3]; lg8[4] += x * wb[0]; lg8[5] += x * wb[1]; lg8[6] += x * wb[2]; lg8[7] += x * wb[3]; }
#pragma unroll
            for (int e = 0; e < 8; ++e) lg8[e] = wave_sum(lg8[e]) + br[e];
            int e1 = 0; float v1 = lg8[0];
#pragma unroll
            for (int e = 1; e < 8; ++e) if (lg8[e] > v1) { v1 = lg8[e]; e1 = e; }
            int e2 = -1; float v2 = -3.0e38f;
#pragma unroll
            for (int e = 0; e < 8; ++e) if (e != e1 && lg8[e] > v2) { v2 = lg8[e]; e2 = e; }
            const float ex = expf(v2 - v1), g1 = 1.f / (1.f + ex), g2 = ex / (1.f + ex);
            if (lane == 0) { tope[row] = e1 | (e2 << 8); topg[2 * row] = g1; topg[2 * row + 1] = g2;
                __hip_atomic_fetch_add((LAS unsigned*)&misc[16 + e1], 1u, __ATOMIC_RELAXED, __HIP_MEMORY_SCOPE_WORKGROUP);
                __hip_atomic_fetch_add((LAS unsigned*)&misc[16 + e2], 1u, __ATOMIC_RELAXED, __HIP_MEMORY_SCOPE_WORKGROUP); }
        }
    }
    if (router) { __syncthreads();
        if (tid < 8) __hip_atomic_fetch_add((unsigned*)(ws + WS_CTL) + CW_CNT + moe_idx * 64 + tid, misc[16 + tid], __ATOMIC_RELAXED, __HIP_MEMORY_SCOPE_AGENT);
        __syncthreads(); }
}

__device__ __forceinline__ void moe_starts(const unsigned char* ws, int moe_idx, int (&cnt)[8], int (&pstart)[9]) {
    const unsigned* c = (const unsigned*)(ws + WS_CTL) + CW_CNT + moe_idx * 64; int p = 0;
#pragma unroll
    for (int e = 0; e < 8; ++e) { cnt[e] = __builtin_amdgcn_readfirstlane((int)__hip_atomic_load(c + e, __ATOMIC_RELAXED, __HIP_MEMORY_SCOPE_AGENT)); pstart[e] = p; p += (cnt[e] + 255) >> 8; }
    pstart[8] = p;
}
__device__ __forceinline__ void assign_phase(unsigned char* ws, int gw, int NGW, int lane, int tid, int moe_idx) {
    int cnt[8], pstart[9]; moe_starts(ws, moe_idx, cnt, pstart);
    const int* tope = (const int*)(ws + WS_TOPE); const float* topg = (const float*)(ws + WS_TOPG);
    int* rowtok = (int*)(ws + WS_ROWTOK); int* rowdst = (int*)(ws + WS_ROWDST); float* rowgate = (float*)(ws + WS_ROWGATE);
    unsigned* cur = (unsigned*)(ws + WS_CTL) + CW_CUR + moe_idx * 64;
    for (int base = gw * 64; base < MV; base += NGW * 64) {
        const int row = base + lane; const bool valid = row < MV;
        const int te = valid ? tope[row] : 0xffff;
#pragma unroll
        for (int slot = 0; slot < 2; ++slot) {
            const int e = valid ? ((te >> (8 * slot)) & 255) : 255; int pos = -1;
#pragma unroll
            for (int ee = 0; ee < 8; ++ee) {
                const unsigned long long mask = __ballot(e == ee);
                if (mask) { const int n = __popcll(mask), leader = __ffsll((long long)mask) - 1; unsigned b0 = 0;
                    if (lane == leader) b0 = __hip_atomic_fetch_add(cur + ee, (unsigned)n, __ATOMIC_RELAXED, __HIP_MEMORY_SCOPE_AGENT);
                    b0 = __shfl(b0, leader);
                    if (e == ee) pos = pstart[ee] * 256 + (int)b0 + __popcll(mask & ((1ull << lane) - 1ull)); }
            }
            if (valid) { rowtok[pos] = row; rowdst[pos] = 2 * row + slot; rowgate[pos] = topg[2 * row + slot]; }
        }
    }
    if (blockIdx.x < 8) { const int e = blockIdx.x; int ps = 0, pe = 0, ce = 0;
#pragma unroll
        for (int ee = 0; ee < 8; ++ee) if (ee == e) { ps = pstart[ee]; pe = pstart[ee + 1]; ce = cnt[ee]; }
        for (int pos = ps * 256 + ce + tid; pos < pe * 256; pos += NTHREADS) { rowtok[pos] = -1; rowdst[pos] = -1; rowgate[pos] = 0.f; } }
}

constexpr int ML_RS = 72;
constexpr int ML_QS = 0, ML_KS = 9216, ML_KT = 18432, ML_PS = 27648, ML_VT = 36864, ML_CT = 57600, ML_HS = 78336, ML_SC = 112128;
constexpr int ML_HSS = 132;
__device__ __forceinline__ bf16x8 ml_frag(LAS unsigned char* lds, int base, int row, int kcol) { return *(const LAS bf16x8*)(lds + base + (row * ML_RS + kcol) * 2); }

template <int MODE>
__device__ __forceinline__ void mlstm_phase(unsigned char* ws, LAS unsigned char* lds, int layer, int tid, int wave, int lane) {
    const int item = blockIdx.x; const int bh = item >> 3, seg = item & 7, b = bh >> 3, h = bh & 7;
    if (MODE == 1 && seg == 7) return;
    const bf16_t* proj = (const bf16_t*)(ws + WS_PROJ); const float* gates = (const float*)(ws + WS_GATES);
    bf16_t* HG = (bf16_t*)(ws + WS_HG);
    float* STATE = (float*)(ws + WS_STATE); float* STSC = (float*)(ws + WS_STSC);
    LAS float* sc = (LAS float*)(lds + ML_SC);
    const int fr = lane & 15, quad = lane >> 4;
    f32x4 st[5]; float zero = 0.f; asm volatile("; opaque zero" : "+v"(zero));
#pragma unroll
    for (int i = 0; i < 5; ++i) st[i] = (f32x4){zero, zero, zero, zero};
    float m0 = (MODE == 1) ? -1.0e30f : 0.f, gsum = 0.f;
    for (int i = tid; i < 16 * ML_RS; i += NTHREADS) ((LAS bf16_t*)(lds + ML_VT))[128 * ML_RS + i] = (i < ML_RS) ? (bf16_t)0x3F80 : (bf16_t)0;
    if (MODE == 2 && seg > 0) {
        m0 = -1.0e30f;
        for (int s2 = 0; s2 < seg; ++s2) {
            const float ms = STSC[(bh * 7 + s2) * 4 + 0], Gs = STSC[(bh * 7 + s2) * 4 + 1];
            const float mn = fmaxf(Gs + m0, ms), fo = fast_exp(Gs + m0 - mn), fn = fast_exp(ms - mn);
            const f32x4* sp = (const f32x4*)(STATE + (size_t)(bh * 7 + s2) * ST_FLOATS) + (wave * 5) * 64 + lane;
#pragma unroll
            for (int i = 0; i < 5; ++i) st[i] = st[i] * fo + sp[i * 64] * fn;
            m0 = mn;
        }
    }
#pragma unroll
    for (int i = 0; i < 5; ++i) { const int dv = (i < 4) ? 16 * wave + fr : 128 + fr, dk = (i < 4) ? 16 * i + 4 * quad : 16 * wave + 4 * quad;
        if (i < 4 || wave < 4) { u32x2 w; w.x = pk2(st[i][0], st[i][1]); w.y = pk2(st[i][2], st[i][3]); *(LAS u32x2*)(lds + ML_CT + (dv * ML_RS + dk) * 2) = w; } }
    float lnh[16];
    if (MODE == 2) {
#pragma unroll
        for (int e = 0; e < 16; ++e) lnh[e] = ((const float*)(ws + WS_SMALL))[SM_LNH + layer * D + h * M_V + 16 * (tid & 7) + e]; }
    const int nch = SEG_CHUNKS + (seg == 0 ? 1 : 0);
    u32x4 rq, rk, rv0, rv1; float rli = 0.f, rlf = 0.f;
    auto chunk_rows = [&](int ci, int& rbase, int& nv) { if (seg == 0 && ci == 0) { rbase = MREAL; nv = NMETA; } else { const int c = seg * SEG_CHUNKS + ci - (seg == 0 ? 1 : 0); rbase = b * SEQ + c * 64; nv = 64; } };
    auto load_chunk = [&](int ci) {
        int rbase, nv; chunk_rows(ci, rbase, nv);
        { const int j = tid >> 3, c8 = (tid & 7) * 8; const bool ok = j < nv; const bf16_t* rp = proj + (size_t)(rbase + j) * PROJ_LD + h * 64 + c8;
          rq = (MODE == 2 && ok) ? *(const u32x4*)rp : (u32x4){0u, 0u, 0u, 0u}; rk = ok ? *(const u32x4*)(rp + 512) : (u32x4){0u, 0u, 0u, 0u}; }
        { const int j0 = tid >> 4, c8 = (tid & 15) * 8; const bf16_t* rp = proj + (size_t)(rbase + j0) * PROJ_LD + 1024 + h * 128 + c8;
          rv0 = (j0 < nv) ? *(const u32x4*)rp : (u32x4){0u, 0u, 0u, 0u}; rv1 = (j0 + 32 < nv) ? *(const u32x4*)(rp + (size_t)32 * PROJ_LD) : (u32x4){0u, 0u, 0u, 0u}; }
        if (tid < 64) { const bool ok = tid < nv; rli = ok ? gates[(size_t)(rbase + tid) * 16 + h] : -1.0e30f; rlf = ok ? gates[(size_t)(rbase + tid) * 16 + 8 + h] : 1.0e30f; }
    };
    load_chunk(0);
    __syncthreads();
    for (int ci = 0; ci < nch; ++ci) {
        int rbase, nv; chunk_rows(ci, rbase, nv);
        { const int j = tid >> 3, c8 = (tid & 7) * 8;
          if (MODE == 2) *(LAS u32x4*)(lds + ML_QS + (j * ML_RS + c8) * 2) = rq;
          *(LAS u32x4*)(lds + ML_KS + (j * ML_RS + c8) * 2) = rk; }
        { const int j0 = tid >> 4, c8 = (tid & 15) * 8; LAS bf16_t* vt = (LAS bf16_t*)(lds + ML_VT);
          const unsigned a[4] = {rv0.x, rv0.y, rv0.z, rv0.w}, c[4] = {rv1.x, rv1.y, rv1.z, rv1.w};
#pragma unroll
          for (int e = 0; e < 4; ++e) { vt[(c8 + 2 * e) * ML_RS + j0] = (bf16_t)(a[e] & 0xffffu); vt[(c8 + 2 * e + 1) * ML_RS + j0] = (bf16_t)(a[e] >> 16);
              vt[(c8 + 2 * e) * ML_RS + j0 + 32] = (bf16_t)(c[e] & 0xffffu); vt[(c8 + 2 * e + 1) * ML_RS + j0 + 32] = (bf16_t)(c[e] >> 16); } }
        if (wave == 0) {
            const float li = rli, f = rlf;
            const float lf = (f > 1.0e29f) ? 0.f : (fminf(f, 0.f) - logf(1.f + expf(-fabsf(f))));
            float bc = lf;
#pragma unroll
            for (int o = 1; o < 64; o <<= 1) { const float t = __shfl_up(bc, o); if (lane >= o) bc += t; }
            const float u = li - bc; float pm = u;
#pragma unroll
            for (int o = 1; o < 64; o <<= 1) { const float t = __shfl_up(pm, o); if (lane >= o) pm = fmaxf(pm, t); }
            const float blast = __shfl(bc, 63), umax = __shfl(pm, 63);
            const float MM = fmaxf(pm, m0), amax = blast + umax, mn = fmaxf(blast + m0, amax);
            const float sold = fast_exp(blast + m0 - mn), snew = fast_exp(amax - mn);
            sc[lane] = u; sc[64 + lane] = MM; sc[128 + lane] = fast_exp(m0 - MM); sc[192 + lane] = fast_exp(-(bc + MM)); sc[256 + lane] = snew * fast_exp(u - umax);
            if (lane == 0) { sc[384] = sold; sc[385] = mn; sc[386] = blast; }
        }
        __syncthreads();
        if (ci + 1 < nch) load_chunk(ci + 1);
        m0 = sc[385]; gsum += sc[386];
        const float sold = sc[384];
        { const int j = tid >> 3, c8 = (tid & 7) * 8; const u32x4 kv = *(const LAS u32x4*)(lds + ML_KS + (j * ML_RS + c8) * 2); const float wj = sc[256 + j];
          const unsigned a[4] = {kv.x, kv.y, kv.z, kv.w}; LAS bf16_t* kt = (LAS bf16_t*)(lds + ML_KT);
#pragma unroll
          for (int e = 0; e < 4; ++e) { kt[(c8 + 2 * e) * ML_RS + j] = (bf16_t)f2bf(bf2f((unsigned short)(a[e] & 0xffffu)) * wj); kt[(c8 + 2 * e + 1) * ML_RS + j] = (bf16_t)f2bf(bf2f((unsigned short)(a[e] >> 16)) * wj); } }
        if (MODE == 2) {
            const int mt = wave >> 1;
#pragma unroll
            for (int q = 0; q < 2; ++q) { const int nt = 2 * (wave & 1) + q; f32x4 s = (f32x4){0.f, 0.f, 0.f, 0.f};
                if (nt <= mt) {
#pragma unroll
                    for (int ks = 0; ks < 2; ++ks) s = __builtin_amdgcn_mfma_f32_16x16x32_bf16(ml_frag(lds, ML_QS, 16 * mt + fr, 32 * ks + 8 * quad), ml_frag(lds, ML_KS, 16 * nt + fr, 32 * ks + 8 * quad), s, 0, 0, 0); }
                const int j = 16 * nt + fr; const float uj = sc[j];
#pragma unroll
                for (int r = 0; r < 4; ++r) { const int i = 16 * mt + 4 * quad + r; const float p = (j <= i) ? s[r] * fast_exp(uj - sc[64 + i]) : 0.f;
                    ((LAS bf16_t*)(lds + ML_PS))[i * ML_RS + j] = (bf16_t)f2bf(p); } }
        }
        __syncthreads();
        f32x4 o1[4], o2[4];
        if (MODE == 2) {
            bf16x8 vb[2], cb[2];
#pragma unroll
            for (int ks = 0; ks < 2; ++ks) { vb[ks] = ml_frag(lds, ML_VT, 16 * wave + fr, 32 * ks + 8 * quad); cb[ks] = ml_frag(lds, ML_CT, 16 * wave + fr, 32 * ks + 8 * quad); }
#pragma unroll
            for (int mt = 0; mt < 4; ++mt) { o1[mt] = (f32x4){0.f, 0.f, 0.f, 0.f}; o2[mt] = (f32x4){0.f, 0.f, 0.f, 0.f};
#pragma unroll
                for (int ks = 0; ks < 2; ++ks) { o1[mt] = __builtin_amdgcn_mfma_f32_16x16x32_bf16(ml_frag(lds, ML_PS, 16 * mt + fr, 32 * ks + 8 * quad), vb[ks], o1[mt], 0, 0, 0);
                    o2[mt] = __builtin_amdgcn_mfma_f32_16x16x32_bf16(ml_frag(lds, ML_QS, 16 * mt + fr, 32 * ks + 8 * quad), cb[ks], o2[mt], 0, 0, 0); } }
            if (wave < 4) { f32x4 d1 = (f32x4){0.f, 0.f, 0.f, 0.f}, d2 = (f32x4){0.f, 0.f, 0.f, 0.f};
#pragma unroll
                for (int ks = 0; ks < 2; ++ks) { d1 = __builtin_amdgcn_mfma_f32_16x16x32_bf16(ml_frag(lds, ML_PS, 16 * wave + fr, 32 * ks + 8 * quad), ml_frag(lds, ML_VT, 128 + fr, 32 * ks + 8 * quad), d1, 0, 0, 0);
                    d2 = __builtin_amdgcn_mfma_f32_16x16x32_bf16(ml_frag(lds, ML_QS, 16 * wave + fr, 32 * ks + 8 * quad), ml_frag(lds, ML_CT, 128 + fr, 32 * ks + 8 * quad), d2, 0, 0, 0); }
                if (fr == 0) {
#pragma unroll
                    for (int r = 0; r < 4; ++r) { const int i = 16 * wave + 4 * quad + r; sc[320 + i] = d1[r] + sc[128 + i] * d2[r]; } } }
            __syncthreads();
        }
        if (MODE == 2) {
#pragma unroll
            for (int mt = 0; mt < 4; ++mt)
#pragma unroll
                for (int r = 0; r < 4; ++r) { const int i = 16 * mt + 4 * quad + r; const float num = o1[mt][r] + sc[128 + i] * o2[mt][r];
                    ((LAS float*)(lds + ML_HS))[i * ML_HSS + 16 * wave + fr] = num / fmaxf(fabsf(sc[320 + i]), sc[192 + i]); }
        }
        { bf16x8 vb[2];
#pragma unroll
          for (int ks = 0; ks < 2; ++ks) vb[ks] = ml_frag(lds, ML_VT, 16 * wave + fr, 32 * ks + 8 * quad);
#pragma unroll
          for (int mt = 0; mt < 4; ++mt) { st[mt] = st[mt] * sold;
#pragma unroll
              for (int ks = 0; ks < 2; ++ks) st[mt] = __builtin_amdgcn_mfma_f32_16x16x32_bf16(ml_frag(lds, ML_KT, 16 * mt + fr, 32 * ks + 8 * quad), vb[ks], st[mt], 0, 0, 0); }
          if (wave < 4) { st[4] = st[4] * sold;
#pragma unroll
              for (int ks = 0; ks < 2; ++ks) st[4] = __builtin_amdgcn_mfma_f32_16x16x32_bf16(ml_frag(lds, ML_KT, 16 * wave + fr, 32 * ks + 8 * quad), ml_frag(lds, ML_VT, 128 + fr, 32 * ks + 8 * quad), st[4], 0, 0, 0); }
          if (MODE == 2) {
#pragma unroll
              for (int i = 0; i < 5; ++i) { const int dv = (i < 4) ? 16 * wave + fr : 128 + fr, dk = (i < 4) ? 16 * i + 4 * quad : 16 * wave + 4 * quad;
                  if (i < 4 || wave < 4) { u32x2 w; w.x = pk2(st[i][0], st[i][1]); w.y = pk2(st[i][2], st[i][3]); *(LAS u32x2*)(lds + ML_CT + (dv * ML_RS + dk) * 2) = w; } } }
        }
        __syncthreads();
        if (MODE == 2) {
            const int i = tid >> 3, sg = tid & 7; const LAS float* hp = (const LAS float*)(lds + ML_HS) + i * ML_HSS + 16 * sg;
            float x[16]; float s = 0.f;
#pragma unroll
            for (int e = 0; e < 16; ++e) { x[e] = hp[e]; s += x[e]; }
            s += __shfl_xor(s, 1); s += __shfl_xor(s, 2); s += __shfl_xor(s, 4);
            const float mean = s * (1.f / M_V); float q = 0.f;
#pragma unroll
            for (int e = 0; e < 16; ++e) { x[e] -= mean; q += x[e] * x[e]; }
            q += __shfl_xor(q, 1); q += __shfl_xor(q, 2); q += __shfl_xor(q, 4);
            const float rstd = 1.f / sqrtf(q * (1.f / M_V) + LN_EPS);
            if (i < nv && (nv == 64 || b == 0)) {
                const size_t row = (size_t)(rbase + i);
                const u32x4* ogp = (const u32x4*)(proj + row * PROJ_LD + 2048 + h * M_V + 16 * sg); const u32x4 g0 = ogp[0], g1 = ogp[1];
                const unsigned gw8[8] = {g0.x, g0.y, g0.z, g0.w, g1.x, g1.y, g1.z, g1.w}; unsigned ow[8];
#pragma unroll
                for (int e = 0; e < 8; ++e) { const float oga = bf2f((unsigned short)(gw8[e] & 0xffffu)), ogb = bf2f((unsigned short)(gw8[e] >> 16));
                    const float ya = x[2 * e] * rstd * lnh[2 * e] / (1.f + fast_exp(-oga)), yb = x[2 * e + 1] * rstd * lnh[2 * e + 1] / (1.f + fast_exp(-ogb));
                    ow[e] = pk2(ya, yb); }
                u32x4* op = (u32x4*)(HG + row * D + h * M_V + 16 * sg);
                op[0] = (u32x4){ow[0], ow[1], ow[2], ow[3]}; op[1] = (u32x4){ow[4], ow[5], ow[6], ow[7]};
            }
        }
    }
    if (MODE == 1) {
        f32x4* sp = (f32x4*)(STATE + (size_t)(bh * 7 + seg) * ST_FLOATS) + (wave * 5) * 64 + lane;
#pragma unroll
        for (int i = 0; i < 5; ++i) sp[i * 64] = (i < 4 || wave < 4) ? st[i] : (f32x4){0.f, 0.f, 0.f, 0.f};
        if (tid == 0) { STSC[(bh * 7 + seg) * 4 + 0] = m0; STSC[(bh * 7 + seg) * 4 + 1] = gsum; }
    }
}

constexpr int AT_KRS = 72, AT_VRS = 280, AT_NK = 272;
constexpr int AT_KS = 0, AT_VT = AT_NK * AT_KRS * 2, AT_END = AT_VT + 64 * AT_VRS * 2;
static_assert(AT_END <= MISC_OFF, "attention LDS");
__device__ __forceinline__ void attn_phase(unsigned char* ws, LAS unsigned char* lds, int j_layer, int tid, int wave, int lane) {
    const bf16_t* Q = (const bf16_t*)(ws + WS_PROJ); const bf16_t* KB = (const bf16_t*)(ws + WS_KB); const bf16_t* VT = (const bf16_t*)(ws + WS_VB);
    bf16_t* HG = (bf16_t*)(ws + WS_HG);
    const float* sinks = (const float*)(ws + WS_SMALL) + SM_SINKS + j_layer * A_HEADS;
    const int fr = lane & 15, quad = lane >> 4;
    LAS bf16_t* ks = (LAS bf16_t*)(lds + AT_KS); LAS bf16_t* vt = (LAS bf16_t*)(lds + AT_VT);
    u32x4 kreg[5], vreg[5]; bf16x8 qn[4][2];
    const int NREG = NBATCH * A_KV * (SEQ / WINDOW), NIT = NREG + A_KV;
    auto prefetch = [&](int it) {
        const bool meta = it >= NREG; const int b = meta ? 0 : it >> 8, g = meta ? it - NREG : (it >> 6) & 3, blk = meta ? -1 : it & 63;
#pragma unroll
        for (int i = 0; i < 5; ++i) { const int p = tid + i * NTHREADS; kreg[i] = (u32x4){0u, 0u, 0u, 0u}; vreg[i] = (u32x4){0u, 0u, 0u, 0u};
            if (p < AT_NK * 8) { const int kk = p >> 3, c8 = (p & 7) * 8;
                int row; if (kk >= 256) row = MREAL + kk - 256; else { const int tk = (blk - 1) * WINDOW + kk; row = (tk < 0 || meta) ? -1 : b * SEQ + tk; }
                if (row >= 0) kreg[i] = *(const u32x4*)(KB + (size_t)row * 256 + g * 64 + c8);
                const int d = p / 34, pc = p % 34; const bf16_t* src = VT + (size_t)(g * 64 + d) * MP;
                if (pc >= 32) vreg[i] = *(const u32x4*)(src + MREAL + (pc - 32) * 8);
                else { const int tk = (blk - 1) * WINDOW + pc * 8; if (tk >= 0 && !meta) vreg[i] = *(const u32x4*)(src + (size_t)b * SEQ + tk); } } }
    };
    auto qload = [&](int it, int mt) {
        const bool meta = it >= NREG; const int b = it >> 8, g = meta ? it - NREG : (it >> 6) & 3, blk = it & 63, qh = g * 4 + (wave >> 1);
        const size_t rowq = meta ? (size_t)MREAL + fr : (size_t)b * SEQ + blk * WINDOW + 16 * (4 * (wave & 1) + mt) + fr;
#pragma unroll
        for (int k2 = 0; k2 < 2; ++k2) qn[mt][k2] = *(const bf16x8*)(Q + rowq * D + qh * 64 + 32 * k2 + 8 * quad);
    };
    if ((int)blockIdx.x < NIT) { prefetch(blockIdx.x);
#pragma unroll
        for (int mt = 0; mt < 4; ++mt) qload(blockIdx.x, mt); }
    for (int it = blockIdx.x; it < NIT; it += gridDim.x) {
        const bool meta = it >= NREG; const int b = it >> 8, g = meta ? it - NREG : (it >> 6) & 3, blk = it & 63;
        __syncthreads();
#pragma unroll
        for (int i = 0; i < 5; ++i) { const int p = tid + i * NTHREADS;
            if (p < AT_NK * 8) { *(LAS u32x4*)(ks + (p >> 3) * AT_KRS + (p & 7) * 8) = kreg[i]; *(LAS u32x4*)(vt + (p / 34) * AT_VRS + (p % 34) * 8) = vreg[i]; } }
        __syncthreads();
        const bool has_next = it + (int)gridDim.x < NIT;
        if (has_next) prefetch(it + gridDim.x);
        const int qh = g * 4 + (wave >> 1); const float sink = sinks[qh];
#pragma unroll
        for (int mt = 0; mt < 4; ++mt) {
            if (meta && (mt > 0 || (wave & 1))) continue;
            const int t0 = meta ? 0 : 4 * (wave & 1) + mt, qi = 16 * t0 + fr;
            const size_t rowq = meta ? (size_t)MREAL + fr : (size_t)b * SEQ + blk * WINDOW + qi;
            f32x4 s[10];
#pragma unroll
            for (int c = 0; c < 10; ++c) { const int kb = (c < 9) ? 16 * (t0 + c) : 256; s[c] = (f32x4){0.f, 0.f, 0.f, 0.f};
#pragma unroll
                for (int k2 = 0; k2 < 2; ++k2) s[c] = __builtin_amdgcn_mfma_f32_16x16x32_bf16(*(const LAS bf16x8*)(ks + (kb + fr) * AT_KRS + 32 * k2 + 8 * quad), qn[mt][k2], s[c], 0, 0, 0); }
            if (has_next) qload(it + gridDim.x, mt);
            float m = sink;
#pragma unroll
            for (int c = 0; c < 9; ++c)
#pragma unroll
                for (int r = 0; r < 4; ++r) { const int j = 16 * (t0 + c) + 4 * quad + r, rel = qi + WINDOW - j; const bool vis = !meta && (rel >= 0) && (rel < WINDOW) && (blk > 0 || j >= WINDOW);
                    s[c][r] = vis ? s[c][r] : -1.0e30f; m = fmaxf(m, s[c][r]); }
#pragma unroll
            for (int r = 0; r < 4; ++r) { const bool vis = !meta || (4 * quad + r <= fr); s[9][r] = vis ? s[9][r] : -1.0e30f; m = fmaxf(m, s[9][r]); }
            m = fmaxf(m, __shfl_xor(m, 16)); m = fmaxf(m, __shfl_xor(m, 32));
            float sm = 0.f;
#pragma unroll
            for (int c = 0; c < 10; ++c)
#pragma unroll
                for (int r = 0; r < 4; ++r) { const float p = fast_exp(s[c][r] - m); s[c][r] = p; sm += p; }
            sm += __shfl_xor(sm, 16); sm += __shfl_xor(sm, 32);
            const float inv = 1.f / (sm + fast_exp(sink - m));
            f32x4 o[4];
#pragma unroll
            for (int dt = 0; dt < 4; ++dt) o[dt] = (f32x4){0.f, 0.f, 0.f, 0.f};
#pragma unroll
            for (int u = 0; u < 5; ++u) {
                const int kb0 = 16 * (t0 + 2 * u), kb1 = (u < 4) ? 16 * (t0 + 2 * u + 1) : 256;
                u32x4 pw; pw.x = cvt_pk_bf16(s[2 * u][0], s[2 * u][1]); pw.y = cvt_pk_bf16(s[2 * u][2], s[2 * u][3]); pw.z = cvt_pk_bf16(s[2 * u + 1][0], s[2 * u + 1][1]); pw.w = cvt_pk_bf16(s[2 * u + 1][2], s[2 * u + 1][3]);
                const bf16x8 pf = __builtin_bit_cast(bf16x8, pw);
#pragma unroll
                for (int dt = 0; dt < 4; ++dt) { const LAS bf16_t* vr = vt + (16 * dt + fr) * AT_VRS + 4 * quad;
                    u32x4 vw; const u32x2 a = *(const LAS u32x2*)(vr + kb0), c2 = *(const LAS u32x2*)(vr + kb1); vw.x = a.x; vw.y = a.y; vw.z = c2.x; vw.w = c2.y;
                    o[dt] = __builtin_amdgcn_mfma_f32_16x16x32_bf16(__builtin_bit_cast(bf16x8, vw), pf, o[dt], 0, 0, 0); } }
#pragma unroll
            for (int dt = 0; dt < 4; ++dt) { u32x2 w; w.x = cvt_pk_bf16(o[dt][0] * inv, o[dt][1] * inv); w.y = cvt_pk_bf16(o[dt][2] * inv, o[dt][3] * inv);
                *(u32x2*)(HG + rowq * D + qh * 64 + 16 * dt + 4 * quad) = w; }
        }
    }
}

#ifndef SITES
#define SITES 0xFFFF
#endif
#define SITE(n) ((SITES >> (n)) & 1)
#ifndef DUPMASK
#define DUPMASK 0
#endif
#define REPS(n) (1 + ((DUPMASK >> (n)) & 1))
#ifndef MK_PER_PHASE
#define MK_PER_PHASE 0
#endif
constexpr int PH_PER_LAYER = 12, N_PHASES = 1 + 4 * PH_PER_LAYER;

__global__ void __launch_bounds__(NTHREADS, 2) fwd(Params P) {
    extern __shared__ __attribute__((aligned(16))) unsigned char lds_raw[];
    LAS unsigned char* const lds0 = (LAS unsigned char*)lds_raw;
    const int G = gridDim.x;
    const int vcu = (G % 8 == 0) ? ((int)blockIdx.x % 8) * (G / 8) + (int)blockIdx.x / 8 : (int)blockIdx.x;
    const int NGW = G * NWAVES;
    unsigned char* const wsbase = P.ws;
    volatile LAS unsigned* misc = (volatile LAS unsigned*)(lds0 + MISC_OFF);
    if (threadIdx.x < 64) misc[threadIdx.x] = 0u;
    __syncthreads();
    XcdBarrier bar = xcd_barrier_post((unsigned*)(wsbase + WS_CTL) + CW_BAR + P.li * 4096, misc + 8);
    const int lo = P.ph_lo, hi = P.ph_hi;
#define RUN(idx) ((idx) >= lo && (idx) < hi)
#define SEAM(idx) do { if ((idx) + 1 < hi) xcd_barrier(bar); } while (0)
#define IDS() int tid = threadIdx.x; asm volatile("; opaque tid" : "+v"(tid)); unsigned char* ws = wsbase; asm volatile("; opaque ws" : "+s"(ws)); \
              LAS unsigned char* lds = lds0; asm volatile("; opaque lds" : "+s"(lds)); \
              const int lane = tid & 63, wave = __builtin_amdgcn_readfirstlane(tid >> 6); const int gw = vcu * NWAVES + wave; (void)lane; (void)gw; (void)ws

    for (int rep = 0; rep < REPS(0); ++rep) if (SITE(0) && RUN(0)) { IDS(); p0_prologue(P, lds, gw, NGW, wave, lane); SEAM(0); }

    for (int l = 0; l < 4; ++l) {
        const int pb = 1 + l * PH_PER_LAYER;
        const bool moe = (l & 1) != 0; const int fi = l >> 1;
        if (l < 2) {
            for (int rep = 0; rep < REPS(1); ++rep) if (SITE(1) && RUN(pb + 0)) {
                IDS();
                pg8::DenseOrder S; S.init(MREAL / 256, 12, G, (int)blockIdx.x);
                EpiProj E{(bf16_t*)(ws + WS_PROJ), (float*)(ws + WS_GATES), (const float*)(ws + WS_SMALL) + SM_BGATE + l * 16};
                const bf16_t* HBp = (const bf16_t*)(ws + WS_HB); const bf16_t* Wp = (const bf16_t*)(ws + WS_WIN) + (size_t)l * M_INP * D;
                pg8::gemm_phase(lds, HBp, Wp, D, S, E);
                bf16_t* PROJ = (bf16_t*)(ws + WS_PROJ); float* GATES = (float*)(ws + WS_GATES); const float* bg = (const float*)(ws + WS_SMALL) + SM_BGATE + l * 16;
                int par = 0;
                for (int item = (int)blockIdx.x; item < 192 + (MV / 16); item += G, par ^= 1) {
                    if (item < 192) { const bf16_t* B1[1] = {Wp + (size_t)item * 16 * D};
                        skinny_item<1>(HBp + (size_t)MREAL * D, D, B1, D, wave, lane, lds, par, [&](const f32x4 (&a)[1], int fr, int quad) {
#pragma unroll
                            for (int r = 0; r < 4; ++r) PROJ[(size_t)(MREAL + 4 * quad + r) * PROJ_LD + item * 16 + fr] = (bf16_t)f2bf(a[0][r]); });
                    } else { const int rt = item - 192; const bf16_t* B1[1] = {Wp + (size_t)3072 * D};
                        skinny_item<1>(HBp + (size_t)rt * 16 * D, D, B1, D, wave, lane, lds, par, [&](const f32x4 (&a)[1], int fr, int quad) { const float bias = bg[fr];
#pragma unroll
                            for (int r = 0; r < 4; ++r) GATES[(size_t)(rt * 16 + 4 * quad + r) * 16 + fr] = a[0][r] + bias; }); }
                }
                SEAM(pb + 0); }
            for (int rep = 0; rep < REPS(2); ++rep) if (SITE(2) && RUN(pb + 1)) { IDS(); mlstm_phase<1>(ws, lds, l, tid, wave, lane); SEAM(pb + 1); }
            for (int rep = 0; rep < REPS(3); ++rep) if (SITE(3) && RUN(pb + 2)) { IDS(); mlstm_phase<2>(ws, lds, l, tid, wave, lane); SEAM(pb + 2); }
        } else {
            for (int rep = 0; rep < REPS(4); ++rep) if (SITE(4) && RUN(pb + 0)) {
                IDS();
                pg8::DenseOrder S; S.init(MREAL / 256, l == 2 ? 6 : 4, G, (int)blockIdx.x);
                EpiQKV E{(bf16_t*)(ws + WS_PROJ), (bf16_t*)(ws + WS_KB), (bf16_t*)(ws + WS_VB), (const float*)(ws + WS_ROPE)};
                const bf16_t* HBp = (const bf16_t*)(ws + WS_HB); const bf16_t* Wp = (const bf16_t*)(ws + (l == 2 ? WS_WQKV : WS_WQ3));
                pg8::gemm_phase(lds, HBp, Wp, D, S, E);
                bf16_t* Qp = (bf16_t*)(ws + WS_PROJ); bf16_t* KBp = (bf16_t*)(ws + WS_KB); bf16_t* VTp = (bf16_t*)(ws + WS_VB); const float* rope = (const float*)(ws + WS_ROPE);
                int par = 0;
                for (int item = (int)blockIdx.x; item < (l == 2 ? 96 : 64); item += G, par ^= 1) { const bf16_t* B1[1] = {Wp + (size_t)item * 16 * D};
                    skinny_item<1>(HBp + (size_t)MREAL * D, D, B1, D, wave, lane, lds, par, [&](const f32x4 (&a)[1], int fr, int quad) {
                        const int col = item * 16 + fr; const bool dorope = (item < 80) && ((item & 3) == 0);
#pragma unroll
                        for (int r = 0; r < 4; ++r) { const int pos = 4 * quad + r; float x = a[0][r]; const float y = __shfl_xor(x, 8);
                            if (dorope) { const float c = rope[pos * 16 + (fr & 7)], sn = rope[pos * 16 + 8 + (fr & 7)]; x = (fr < 8) ? x * c - y * sn : x * c + y * sn; }
                            const bf16_t o = (bf16_t)f2bf(x); const size_t row = (size_t)MREAL + pos;
                            if (item < 64) Qp[row * D + col] = o; else if (item < 80) KBp[row * 256 + col - 1024] = o; else VTp[(size_t)(col - 1280) * MP + row] = o; } });
                }
                SEAM(pb + 0); }
            for (int rep = 0; rep < REPS(5); ++rep) if (SITE(5) && RUN(pb + 1)) { IDS(); attn_phase(ws, lds, l - 2, tid, wave, lane); SEAM(pb + 1); }
        }
        for (int rep = 0; rep < REPS(6); ++rep) if (SITE(6) && RUN(pb + 3)) {
            IDS();
            pg8::DenseOrder S; S.init(MREAL / 256, 4, G, (int)blockIdx.x);
            const float* smp = (const float*)(ws + WS_SMALL);
            EpiRes E{(float*)(ws + WS_H), (const float*)(ws + WS_STATS), l > 0 ? smp + SM_LNG + (size_t)(2 * l - 1) * D : nullptr, smp + SM_LNB + (size_t)(l > 0 ? 2 * l - 1 : 0) * D};
            const bf16_t* Ap = (const bf16_t*)(ws + WS_HG); const bf16_t* Wp = (const bf16_t*)(ws + (l < 2 ? WS_WOUT : WS_WO)) + (size_t)(l & 1) * D * D;
            pg8::gemm_phase(lds, Ap, Wp, D, S, E);
            int par = 0;
            for (int item = (int)blockIdx.x; item < 64; item += G, par ^= 1) { const bf16_t* B1[1] = {Wp + (size_t)item * 16 * D};
                skinny_item<1>(Ap + (size_t)MREAL * D, D, B1, D, wave, lane, lds, par, [&](const f32x4 (&a)[1], int fr, int quad) { const int col = item * 16 + fr;
#pragma unroll
                    for (int r = 0; r < 4; ++r) { const size_t row = (size_t)MREAL + 4 * quad + r; float h = E.H[row * D + col];
                        if (E.lg) h = (h - E.stats[2 * row]) * E.stats[2 * row + 1] * E.lg[col] + E.lb[col];
                        E.H[row * D + col] = h * ALPHA + a[0][r]; } });
            }
            SEAM(pb + 3); }
        for (int rep = 0; rep < REPS(7); ++rep) if (SITE(7) && RUN(pb + 4)) { IDS(); ln_phase(ws, nullptr, lds, gw, NGW, lane, tid, l * 2 + 0, false, moe, fi, false); SEAM(pb + 4); }
        if (!moe) {
            for (int rep = 0; rep < REPS(8); ++rep) if (SITE(8) && RUN(pb + 5)) {
                IDS();
                pg8::DenseOrder S; S.init(MREAL / 256, 2 * D_FF / 256, G, (int)blockIdx.x);
                EpiSwiglu E{(bf16_t*)(ws + WS_ACT), D_FF};
                const bf16_t* HBp = (const bf16_t*)(ws + WS_HB); const bf16_t* Wp = (const bf16_t*)(ws + WS_WGU) + (size_t)fi * 2 * D_FF * D;
                pg8::gemm_phase(lds, HBp, Wp, D, S, E);
                int par = 0;
                for (int item = (int)blockIdx.x; item < D_FF / 16; item += G, par ^= 1) {
                    const int brow = 256 * (item >> 3) + 16 * (item & 7); const bf16_t* B2[2] = {Wp + (size_t)brow * D, Wp + (size_t)(brow + 128) * D};
                    skinny_item<2>(HBp + (size_t)MREAL * D, D, B2, D, wave, lane, lds, par, [&](const f32x4 (&a)[2], int fr, int quad) {
#pragma unroll
                        for (int r = 0; r < 4; ++r) E.act[(size_t)(MREAL + 4 * quad + r) * D_FF + item * 16 + fr] = (bf16_t)f2bf(EpiSwiglu::silu_mul(a[0][r], a[1][r])); });
                }
                SEAM(pb + 5); }
            for (int rep = 0; rep < REPS(9); ++rep) if (SITE(9) && RUN(pb + 6)) {
                IDS();
                pg8::DenseOrder S; S.init(MREAL / 256, 4, G, (int)blockIdx.x);
                const float* smp = (const float*)(ws + WS_SMALL);
                EpiRes E{(float*)(ws + WS_H), (const float*)(ws + WS_STATS), smp + SM_LNG + (size_t)(2 * l) * D, smp + SM_LNB + (size_t)(2 * l) * D};
                const bf16_t* Ap = (const bf16_t*)(ws + WS_ACT); const bf16_t* Wp = (const bf16_t*)(ws + WS_WDN) + (size_t)fi * D * D_FF;
                pg8::gemm_phase(lds, Ap, Wp, D_FF, S, E);
                int par = 0;
                for (int item = (int)blockIdx.x; item < 64; item += G, par ^= 1) { const bf16_t* B1[1] = {Wp + (size_t)item * 16 * D_FF};
                    skinny_item<1>(Ap + (size_t)MREAL * D_FF, D_FF, B1, D_FF, wave, lane, lds, par, [&](const f32x4 (&a)[1], int fr, int quad) { const int col = item * 16 + fr;
#pragma unroll
                        for (int r = 0; r < 4; ++r) { const size_t row = (size_t)MREAL + 4 * quad + r; float h = E.H[row * D + col];
                            h = (h - E.stats[2 * row]) * E.stats[2 * row + 1] * E.lg[col] + E.lb[col];
                            E.H[row * D + col] = h * ALPHA + a[0][r]; } });
                }
                SEAM(pb + 6); }
        } else {
            for (int rep = 0; rep < REPS(10); ++rep) if (SITE(10) && RUN(pb + 5)) { IDS(); assign_phase(ws, gw, NGW, lane, tid, fi); SEAM(pb + 5); }
            for (int rep = 0; rep < REPS(11); ++rep) if (SITE(11) && RUN(pb + 6)) {
                IDS();
                int cnt[8]; pg8::GroupedOrder S; moe_starts(ws, fi, cnt, S.pstart);
                S.o.init(S.pstart[8], 2 * D_FF_EXP / 256, G, (int)blockIdx.x); S.nexp_rows = 2 * D_FF_EXP; S.rowtok = (const int*)(ws + WS_ROWTOK);
                EpiSwiglu E{(bf16_t*)(ws + WS_ACT), D_FF_EXP};
                pg8::gemm_phase(lds, (const bf16_t*)(ws + WS_HB), (const bf16_t*)(ws + WS_WGUE) + (size_t)fi * 8 * 2 * D_FF_EXP * D, D, S, E);
                SEAM(pb + 6); }
            for (int rep = 0; rep < REPS(12); ++rep) if (SITE(12) && RUN(pb + 7)) {
                IDS();
                int cnt[8]; pg8::GroupedOrder S; moe_starts(ws, fi, cnt, S.pstart);
                S.o.init(S.pstart[8], 4, G, (int)blockIdx.x); S.nexp_rows = D; S.rowtok = nullptr;
                EpiScatter E{(float*)(ws + WS_CONTRIB), (const int*)(ws + WS_ROWDST), (const float*)(ws + WS_ROWGATE)};
                pg8::gemm_phase(lds, (const bf16_t*)(ws + WS_ACT), (const bf16_t*)(ws + WS_WDNE) + (size_t)fi * 8 * D * D_FF_EXP, D_FF_EXP, S, E);
                SEAM(pb + 7); }
        }
        for (int rep = 0; rep < REPS(13); ++rep) if (SITE(13) && RUN(pb + 10)) { IDS(); ln_phase(ws, P.out, lds, gw, NGW, lane, tid, l * 2 + 1, moe, false, 0, l == 3); SEAM(pb + 10); }
    }
#undef RUN
#undef SEAM
#undef IDS
}

extern "C" void kernel_launch(void* const* d_in, const int* in_sizes, int n_in, void* d_out, int out_size, void* d_ws, size_t ws_size, hipStream_t stream) {
    static int grid = 0;
    if (grid == 0) {
        if (n_in != 18 || out_size != MREAL * D || ws_size < WS_END) { fprintf(stderr, "kernel_launch: unexpected shapes (n_in %d, out %d, ws %zu < %zu)\n", n_in, out_size, ws_size, (size_t)WS_END); grid = -1; return; }
        int dev = 0, cus = 0, per_cu = 0;
        if (hipGetDevice(&dev) != hipSuccess || hipDeviceGetAttribute(&cus, hipDeviceAttributeMultiprocessorCount, dev) != hipSuccess) { grid = -1; return; }
        if (hipFuncSetAttribute((const void*)fwd, hipFuncAttributeMaxDynamicSharedMemorySize, LDS_BYTES) != hipSuccess) { fprintf(stderr, "kernel_launch: hipFuncSetAttribute failed\n"); grid = -1; return; }
        if (hipOccupancyMaxActiveBlocksPerMultiprocessor(&per_cu, (const void*)fwd, NTHREADS, LDS_BYTES) != hipSuccess || per_cu < 1) fprintf(stderr, "kernel_launch: occupancy query reports %d\n", per_cu);
        (void)hipGetLastError();
        grid = cus > 256 ? 256 : cus;
    }
    if (grid < 0) return;
    (void)in_sizes;
    if (hipMemsetAsync((char*)d_ws + WS_CTL, 0, CTL_BYTES, stream) != hipSuccess) return;
    Params p{};
    for (int i = 0; i < 18; ++i) p.in[i] = (const float*)d_in[i];
    p.out = (float*)d_out; p.ws = (unsigned char*)d_ws;
#if MK_PER_PHASE
    int li = 0;
    for (int ph = 0; ph < N_PHASES; ++ph) {
        const int k = (ph - 1) % PH_PER_LAYER, l = (ph - 1) / PH_PER_LAYER;
        if (ph > 0) { const bool moe = l & 1; if (k == 2 && l >= 2) continue; if (k == 8 || k == 9 || k == 11) continue; if (k == 7 && !moe) continue; }
        p.ph_lo = ph; p.ph_hi = ph + 1; p.li = li++; p.pad = 0;
        hipLaunchKernelGGL(fwd, dim3(grid), dim3(NTHREADS), LDS_BYTES, stream, p);
    }
#else
    p.ph_lo = 0; p.ph_hi = N_PHASES; p.li = 0; p.pad = 0;
    hipLaunchKernelGGL(fwd, dim3(grid), dim3(NTHREADS), LDS_BYTES, stream, p);
#endif
}
```

```cpp
#include <hip/hip_runtime.h>
#include <cstdio>
#include <cstdint>

#define LAS __attribute__((address_space(3)))
#define GAS __attribute__((address_space(1)))
typedef unsigned short bf16_t;
typedef short bf16x8 __attribute__((ext_vector_type(8)));
typedef float f32x4 __attribute__((ext_vector_type(4)));
typedef float f32x2 __attribute__((ext_vector_type(2)));
typedef unsigned u32x4 __attribute__((ext_vector_type(4)));
typedef unsigned u32x2 __attribute__((ext_vector_type(2)));

constexpr int D = 1024, NBATCH = 4, SEQ = 8192, NMETA = 16;
constexpr int MREAL = NBATCH * SEQ;
constexpr int MV = MREAL + NMETA;
constexpr int MP = 129 * 256;
constexpr int M_HEADS = 8, M_QK = 64, M_V = 128;
constexpr int M_IN = 3088, M_INP = 3328;
constexpr int PROJ_LD = 3072;
constexpr int A_HEADS = 16, A_KV = 4, A_HD = 64, WINDOW = 128;
constexpr int D_FF = 2816, N_EXP = 8, D_FF_EXP = 3584;
constexpr float ALPHA = 1.681792830507429f;
constexpr float LN_EPS = 1e-5f;
constexpr int RP = 265 * 256;
constexpr int NSEG = 8, SEG_CHUNKS = 16;
constexpr int ST_FLOATS = 8 * 5 * 64 * 4;

constexpr size_t MiB = 1u << 20;
constexpr size_t al(size_t x) { return (x + 4095) & ~(size_t)4095; }
constexpr size_t WS_CTL = 0, CTL_BYTES = 1 * MiB;
constexpr size_t WS_WIN = WS_CTL + CTL_BYTES;
constexpr size_t WS_WOUT = WS_WIN + al((size_t)2 * M_INP * D * 2);
constexpr size_t WS_WQKV = WS_WOUT + al((size_t)2 * D * D * 2);
constexpr size_t WS_WQ3 = WS_WQKV + al((size_t)1536 * D * 2);
constexpr size_t WS_WO = WS_WQ3 + al((size_t)D * D * 2);
constexpr size_t WS_WGU = WS_WO + al((size_t)2 * D * D * 2);
constexpr size_t WS_WDN = WS_WGU + al((size_t)2 * 2 * D_FF * D * 2);
constexpr size_t WS_WGUE = WS_WDN + al((size_t)2 * D * D_FF * 2);
constexpr size_t WS_WDNE = WS_WGUE + al((size_t)16 * 2 * D_FF_EXP * D * 2);
constexpr size_t WS_H = WS_WDNE + al((size_t)16 * D * D_FF_EXP * 2);
constexpr size_t WS_HB = WS_H + al((size_t)MP * D * 4);
constexpr size_t WS_PROJ = WS_HB + al((size_t)MP * D * 2);
constexpr size_t WS_HG = WS_PROJ + (size_t)MP * PROJ_LD * 2;
constexpr size_t WS_CONTRIB = WS_PROJ;
constexpr size_t WS_KB = WS_HG + al((size_t)MP * D * 2);
constexpr size_t WS_VB = WS_KB + al((size_t)MP * 256 * 2);
constexpr size_t WS_GATES = WS_VB + al((size_t)MP * 256 * 2);
constexpr size_t WS_ACT = WS_GATES + al((size_t)MP * 16 * 4);
constexpr size_t WS_STATE = WS_ACT + al((size_t)RP * D_FF_EXP * 2);
constexpr size_t WS_STSC = WS_STATE + al((size_t)32 * 7 * ST_FLOATS * 4);
constexpr size_t WS_ROPE = WS_STSC + al((size_t)32 * 7 * 4 * 4);
constexpr size_t WS_TOPE = WS_ROPE + al((size_t)8208 * 16 * 4);
constexpr size_t WS_TOPG = WS_TOPE + al((size_t)MP * 4);
constexpr size_t WS_ROWTOK = WS_TOPG + al((size_t)MP * 8);
constexpr size_t WS_ROWDST = WS_ROWTOK + al((size_t)RP * 4);
constexpr size_t WS_ROWGATE = WS_ROWDST + al((size_t)RP * 4);
constexpr size_t WS_STATS = WS_ROWGATE + al((size_t)RP * 4);
constexpr size_t WS_SMALL = WS_STATS + al((size_t)MP * 8);
constexpr int SM_BGATE = 0, SM_SINKS = 32, SM_BROUTER = 64, SM_LNH = 128, SM_LNG = SM_LNH + 2 * D, SM_LNB = SM_LNG + 8 * D, SM_WROUTER = SM_LNB + 8 * D, SM_END = SM_WROUTER + 2 * D * N_EXP;
constexpr size_t WS_END = WS_SMALL + al((size_t)SM_END * 4);
static_assert((size_t)MP * 2 * D * 4 <= (WS_KB - WS_PROJ), "contrib overlay fits PROJ+HG");

constexpr int CW_CNT = 1024;
constexpr int CW_CUR = 1024 + 256;
constexpr int CW_BAR = 16384;

constexpr int LDS_BYTES = 163840 - 512;
constexpr int RING_BYTES = 131072;
constexpr int MISC_OFF = LDS_BYTES - 256;

__device__ __forceinline__ unsigned f2bf(float f) { unsigned u = __builtin_bit_cast(unsigned, f); return (u + 0x7fffu + ((u >> 16) & 1u)) >> 16; }
__device__ __forceinline__ unsigned pk2(float lo, float hi) { return f2bf(lo) | (f2bf(hi) << 16); }
__device__ __forceinline__ unsigned cvt_pk_bf16(float lo, float hi) { unsigned r; asm volatile("v_cvt_pk_bf16_f32 %0, %1, %2" : "=v"(r) : "v"(lo), "v"(hi)); return r; }
__device__ __forceinline__ float bf2f(unsigned short b) { return __builtin_bit_cast(float, ((unsigned)b) << 16); }
__device__ __forceinline__ float wave_sum(float v) {
#pragma unroll
    for (int o = 1; o < 64; o <<= 1) v += __shfl_xor(v, o);
    return v;
}
__device__ __forceinline__ float fast_exp(float x) { return __builtin_amdgcn_exp2f(x * 1.4426950408889634f); }
#define LDS_WAIT() asm volatile("s_waitcnt lgkmcnt(0)" ::: "memory")
#define VM_WAIT() asm volatile("s_waitcnt vmcnt(0)" ::: "memory")

#define XB_TMO      128
#define XB_XCNT(j)  (256  + 64 * (j))
#define XB_XSUB(j)  (1280 + 64 * (j))
#define XB_XGEN(j)  (2304 + 64 * (j))
#define XB_TOP      3328
#define XB_TOPGEN   3392
#define XCD_BAR_WORDS 3456
#define XB_SPIN_CAP (1u << 18)
__device__ __forceinline__ unsigned xb_ld(unsigned* p)              { return __hip_atomic_load(p, __ATOMIC_RELAXED, __HIP_MEMORY_SCOPE_AGENT); }
__device__ __forceinline__ unsigned xb_add(unsigned* p, unsigned v) { return __hip_atomic_fetch_add(p, v, __ATOMIC_RELAXED, __HIP_MEMORY_SCOPE_AGENT); }
__device__ __forceinline__ unsigned xb_xcc_id() { return (unsigned)__builtin_amdgcn_s_getreg((3 << 11) | 20) & 0xFu; }
#define XB_SPIN(cond, bar) do { unsigned _sp = 0; while (cond) { __builtin_amdgcn_s_sleep(1); \
    if ((++_sp & 255u) == 0u) { if (xb_ld(&(bar)[XB_TMO])) break; if (_sp > XB_SPIN_CAP) { atomicAdd(&(bar)[XB_TMO], 1u); break; } } } } while (0)
struct XcdBarrier { unsigned* bar; unsigned x; volatile LAS unsigned* st; };
__device__ __forceinline__ XcdBarrier xcd_barrier_post(unsigned* bar, volatile LAS unsigned* st) {
    XcdBarrier b; b.bar = bar; b.x = xb_xcc_id(); b.st = st;
    if (threadIdx.x == 0) (void)xb_add(&bar[XB_XCNT(b.x)], 1u);
    return b;
}
__device__ __forceinline__ void xcd_barrier_complete(unsigned* bar, unsigned x, unsigned& nloc, unsigned& nx) {
    const unsigned G = gridDim.x * gridDim.y * gridDim.z;
    unsigned sum, cnt, mine, sp = 0u;
    for (;;) {
        sum = 0u; cnt = 0u; mine = 0u;
#pragma unroll
        for (unsigned j = 0; j < 16; ++j) { const unsigned c = xb_ld(&bar[XB_XCNT(j)]); sum += c; cnt += (c > 0u) ? 1u : 0u; mine = (j == x) ? c : mine; }
        if (sum == G) break;
        __builtin_amdgcn_s_sleep(1);
        if ((++sp & 255u) == 0u) { if (xb_ld(&bar[XB_TMO])) break; if (sp > XB_SPIN_CAP) { atomicAdd(&bar[XB_TMO], 1u); break; } }
    }
    nloc = mine > 0u ? mine : 1u; nx = cnt > 0u ? cnt : 1u;
}
__device__ __forceinline__ void xcd_barrier(const XcdBarrier& b) {
    asm volatile("s_waitcnt vmcnt(0)" ::: "memory");
    __syncthreads();
    if (threadIdx.x == 0) {
        unsigned* bar = b.bar;
        __builtin_amdgcn_s_waitcnt(0);
        unsigned nloc = b.st[0], nx = b.st[1];
        if (nloc == 0u) { xcd_barrier_complete(bar, b.x, nloc, nx); b.st[0] = nloc; b.st[1] = nx; }
        const unsigned old = xb_add(&bar[XB_XSUB(b.x)], 1u);
        const unsigned gen = old / nloc;
        if (old + 1u == (gen + 1u) * nloc) {
            __builtin_amdgcn_fence(__ATOMIC_RELEASE, "agent");
            asm volatile("s_waitcnt vmcnt(0)" ::: "memory");
            const unsigned og = xb_add(&bar[XB_TOP], 1u);
            const unsigned tg = og / nx;
            if (og + 1u == (tg + 1u) * nx) xb_add(&bar[XB_TOPGEN], 1u);
            else XB_SPIN(xb_ld(&bar[XB_TOPGEN]) == tg, bar);
            __builtin_amdgcn_fence(__ATOMIC_ACQUIRE, "agent");
            xb_add(&bar[XB_XGEN(b.x)], 1u);
            asm volatile("s_waitcnt vmcnt(0)" ::: "memory");
        } else {
            XB_SPIN(xb_ld(&bar[XB_XGEN(b.x)]) == gen, bar);
            __builtin_amdgcn_fence(__ATOMIC_ACQUIRE, "agent");
            asm volatile("s_waitcnt vmcnt(0)" ::: "memory");
        }
    }
    __syncthreads();
}

namespace pg8 {
constexpr int BM = 256, BK = 64, HALF = 128, HTB = HALF * BK * 2, STAGE_BYTES = 8 * HTB, NXCD = 8, WGM = 8;
__host__ __device__ __forceinline__ int lds_byte(int r, int c) { const int st = (r >> 4) * 2 + (c >> 5), rr = r & 15, cc = c & 31, ob = rr * 64 + cc * 2; return st * 1024 + (ob ^ (((ob >> 9) & 1) << 5)); }
__host__ __device__ __forceinline__ void stage_rc(int b, int& R, int& C) { const int st = b / 1024, sb = b % 1024, swz = sb ^ (((sb >> 9) & 1) << 5); R = (st >> 1) * 16 + swz / 64; C = (st & 1) * 32 + (swz % 64) / 2; }
__host__ __device__ __forceinline__ int perm32(int rho) { const int n = rho >> 4, i = rho & 15; return 8 * (i >> 2) + 4 * n + (i & 3); }

struct Unit { int pm, pn, brow; };

struct DenseOrder {
    int nM, nN, nwg, G, c;
    __device__ void init(int nM_, int nN_, int G_, int c_) { nM = nM_; nN = nN_; nwg = nM * nN; G = G_; c = c_; }
    __device__ __forceinline__ bool next(int i, Unit& u) const {
        const long L = (long)i * G + c; if (L >= nwg) return false;
        int wgid = (int)L; { const int q = nwg / NXCD, r = nwg % NXCD, xcd = wgid % NXCD, off = wgid / NXCD; wgid = (xcd < r ? xcd * (q + 1) : r * (q + 1) + (xcd - r) * q) + off; }
        const int nig = WGM * nN, gid = wgid / nig, fm = gid * WGM, gsz = (nM - fm) < WGM ? (nM - fm) : WGM;
        u.pm = fm + ((wgid % nig) % gsz); u.pn = (wgid % nig) / gsz; u.brow = u.pn * BM; return true;
    }
    __device__ __forceinline__ int a_row(const Unit& u, int r) const { return u.pm * BM + r; }
};
struct GroupedOrder {
    DenseOrder o; int pstart[9]; int nexp_rows;
    const int* rowtok;
    __device__ __forceinline__ bool next(int i, Unit& u) const {
        if (!o.next(i, u)) return false;
        int e = 0;
#pragma unroll
        for (int k = 1; k < 8; ++k) e += (u.pm >= pstart[k]) ? 1 : 0;
        u.brow = e * nexp_rows + u.pn * BM; return true;
    }
    __device__ __forceinline__ int a_row(const Unit& u, int r) const {
        const int pos = u.pm * BM + r; if (!rowtok) return pos;
        const int t = rowtok[pos]; return t < 0 ? 0 : t;
    }
};

template <class Epi, class Sched>
__device__ __forceinline__ void gemm_phase(LAS unsigned char* lds, const bf16_t* Abase, const bf16_t* Btbase, const int K, const Sched& S, const Epi& E) {
    int tid = threadIdx.x; asm volatile("; opaque tid" : "+v"(tid));
    const int wid = __builtin_amdgcn_readfirstlane(tid >> 6), lane = tid & 63, wr = wid >> 2, wc = wid & 3, fr = lane & 15, fq = lane >> 4;
    const int nt = K / BK;
    unsigned voffB[2];
#pragma unroll
    for (int i = 0; i < 2; ++i) { int R, C; stage_rc(tid * 16 + i * 8192, R, C); const int Rb = Epi::PERM ? ((R & ~31) + perm32(R & 31)) : R; voffB[i] = (unsigned)(Rb * K + C) * 2u; }
    const size_t kstep = (size_t)(BK * 2);
    const size_t hstep = (size_t)HALF * K * 2;
    const unsigned ldsw = (unsigned)wid * 1024u;
    const int aoff = lds_byte(wr * 64 + fr, fq * 8), boff = lds_byte(wc * 32 + fr, fq * 8);
#define PG8_SA(b, h) (((b) * 2 + (h)) * HTB)
#define PG8_SB(b, h) ((4 + (b) * 2 + (h)) * HTB)
#define PG8_STAGE(bufoff, gbase, voff) do { const char* _gb = (const char*)(gbase); asm volatile("" : "+s"(_gb)); _Pragma("unroll") for (int _i = 0; _i < 2; ++_i) \
        __builtin_amdgcn_global_load_lds((const unsigned*)(_gb + (voff)[_i]), (LAS unsigned*)(lds + (bufoff) + ldsw + _i * 8192), 16, 0, 0); } while (0)
#define PG8_LDA(dst, b, h) do { _Pragma("unroll") for (int m = 0; m < 4; ++m) _Pragma("unroll") for (int k = 0; k < 2; ++k) dst[m][k] = *(const LAS bf16x8*)(lds + PG8_SA(b, h) + aoff + m * 2048 + k * 1024); } while (0)
#define PG8_LDB(dst, b, h) do { _Pragma("unroll") for (int n = 0; n < 2; ++n) _Pragma("unroll") for (int k = 0; k < 2; ++k) dst[n][k] = *(const LAS bf16x8*)(lds + PG8_SB(b, h) + boff + n * 2048 + k * 1024); } while (0)
#define PG8_MMA(ai, bj, At, Bt) do { __builtin_amdgcn_s_setprio(1); _Pragma("unroll") for (int m = 0; m < 4; ++m) _Pragma("unroll") for (int n = 0; n < 2; ++n) _Pragma("unroll") for (int k = 0; k < 2; ++k) \
        acc[ai][bj][m][n] = __builtin_amdgcn_mfma_f32_16x16x32_bf16(Bt[n][k], At[m][k], acc[ai][bj][m][n], 0, 0, 0); __builtin_amdgcn_s_setprio(0); } while (0)
#define PG8_WAIT_V(n) asm volatile("s_waitcnt vmcnt(" #n ")" ::: "memory")
#define PG8_WAIT_L(n) asm volatile("s_waitcnt lgkmcnt(" #n ")" ::: "memory")
#define PG8_BAR __builtin_amdgcn_s_barrier()
#define PG8_SCHED __builtin_amdgcn_sched_barrier(0)
#define PG8_AOFF(dst, u) do { _Pragma("unroll") for (int _i = 0; _i < 2; ++_i) { int _R, _C; stage_rc(tid * 16 + _i * 8192, _R, _C); _Pragma("unroll") for (int _h = 0; _h < 2; ++_h) \
        dst[_h][_i] = (unsigned)(((size_t)S.a_row(u, _h * HALF + _R) * K + _C) * 2u); } } while (0)
    Unit cur, nxt; int ui = 0;
    if (!S.next(0, cur)) return;
    f32x4 acc[2][2][4][2];
#pragma unroll
    for (int a = 0; a < 2; ++a)
#pragma unroll
        for (int b = 0; b < 2; ++b)
#pragma unroll
            for (int m = 0; m < 4; ++m)
#pragma unroll
                for (int n = 0; n < 2; ++n) acc[a][b][m][n] = (f32x4){0.f, 0.f, 0.f, 0.f};
    bf16x8 At[4][2], B0[2][2], B1[2][2];
    unsigned cao[2][2];
    PG8_AOFF(cao, cur);
    const char* cA = (const char*)Abase; const char* cB = (const char*)Btbase + (size_t)cur.brow * K * 2;
    PG8_STAGE(PG8_SB(0, 0), cB, voffB); PG8_STAGE(PG8_SB(0, 1), cB + hstep, voffB); PG8_STAGE(PG8_SA(0, 0), cA, cao[0]); PG8_STAGE(PG8_SA(0, 1), cA, cao[1]);
    if (wr == 1) PG8_BAR;
    PG8_WAIT_V(2); PG8_BAR;
    PG8_STAGE(PG8_SB(1, 0), cB + kstep, voffB); PG8_STAGE(PG8_SA(1, 0), cA + kstep, cao[0]); PG8_STAGE(PG8_SB(1, 1), cB + hstep + kstep, voffB);
    PG8_WAIT_V(6); PG8_BAR;
    for (;;) {
        const bool has_next = S.next(ui + 1, nxt);
        const char* nB = has_next ? (const char*)Btbase + (size_t)nxt.brow * K * 2 : cB;
        for (int t = 0; t < nt; t += 2) {
            const bool last = (t == nt - 2);
            const char* a1 = cA + (size_t)(t + 1) * kstep;
            const char* a2 = last ? cA : cA + (size_t)(t + 2) * kstep; const char* b2 = last ? nB : cB + (size_t)(t + 2) * kstep;
            const char* a3 = a2 + kstep; const char* b3 = b2 + kstep;
            PG8_LDB(B0, 0, 0); PG8_LDB(B1, 0, 1); PG8_SCHED; PG8_LDA(At, 0, 0); PG8_STAGE(PG8_SA(1, 1), a1, cao[1]);
            if (last && has_next) { PG8_AOFF(cao, nxt); }
            PG8_WAIT_V(8); PG8_WAIT_L(0); PG8_BAR; PG8_MMA(0, 0, At, B0); PG8_MMA(0, 1, At, B1); PG8_BAR; PG8_SCHED;
            PG8_LDA(At, 0, 1); PG8_STAGE(PG8_SB(0, 0), b2, voffB); PG8_STAGE(PG8_SB(0, 1), b2 + hstep, voffB); PG8_STAGE(PG8_SA(0, 0), a2, cao[0]);
            PG8_WAIT_V(8); PG8_WAIT_L(0); PG8_BAR; PG8_MMA(1, 0, At, B0); PG8_MMA(1, 1, At, B1); PG8_BAR; PG8_SCHED;
            PG8_LDB(B0, 1, 0); PG8_LDB(B1, 1, 1); PG8_SCHED; PG8_LDA(At, 1, 0); PG8_STAGE(PG8_SA(0, 1), a2, cao[1]);
            PG8_WAIT_V(8); PG8_WAIT_L(0); PG8_BAR; PG8_MMA(0, 0, At, B0); PG8_MMA(0, 1, At, B1); PG8_BAR; PG8_SCHED;
            PG8_LDA(At, 1, 1); PG8_STAGE(PG8_SB(1, 0), b3, voffB); PG8_STAGE(PG8_SB(1, 1), b3 + hstep, voffB); PG8_STAGE(PG8_SA(1, 0), a3, cao[0]);
            PG8_WAIT_V(8); PG8_WAIT_L(0); PG8_BAR; PG8_MMA(1, 0, At, B0); PG8_MMA(1, 1, At, B1); PG8_BAR; PG8_SCHED;
        }
        if (wr == 0) PG8_BAR;
#pragma unroll 1
        for (int er = 0; er < Epi::NREP; ++er) E(acc, cur, wr, wc, fr, fq);
        if (!has_next) break;
#pragma unroll
        for (int a = 0; a < 2; ++a)
#pragma unroll
            for (int b = 0; b < 2; ++b)
#pragma unroll
                for (int m = 0; m < 4; ++m)
#pragma unroll
                    for (int n = 0; n < 2; ++n) acc[a][b][m][n] = (f32x4){0.f, 0.f, 0.f, 0.f};
        cur = nxt; cB = nB; ++ui;
        if (wr == 1) PG8_BAR;
    }
    PG8_WAIT_V(0);
    PG8_BAR;
#undef PG8_SA
#undef PG8_SB
#undef PG8_STAGE
#undef PG8_LDA
#undef PG8_LDB
#undef PG8_MMA
#undef PG8_WAIT_V
#undef PG8_WAIT_L
#undef PG8_BAR
#undef PG8_SCHED
#undef PG8_AOFF
}
}

typedef f32x4 AccT[2][2][4][2];

struct EpiProj {
    static constexpr int NREP = 1; static constexpr bool PERM = true;
    bf16_t* proj; float* gates; const float* bgate;
    __device__ __forceinline__ void operator()(const AccT& acc, const pg8::Unit& u, int wr, int wc, int fr, int fq) const {
        const int row0 = u.pm * 256 + wr * 64 + fr;
        if (u.pn < 12) {
            const int col0 = u.pn * 256 + wc * 32 + 8 * fq;
#pragma unroll
            for (int ai = 0; ai < 2; ++ai)
#pragma unroll
                for (int m = 0; m < 4; ++m) { bf16_t* rowp = proj + (size_t)(row0 + ai * 128 + m * 16) * PROJ_LD + col0;
#pragma unroll
                    for (int bj = 0; bj < 2; ++bj) { const f32x4 v0 = acc[ai][bj][m][0], v1 = acc[ai][bj][m][1];
                        u32x4 w; w.x = cvt_pk_bf16(v0[0], v0[1]); w.y = cvt_pk_bf16(v0[2], v0[3]); w.z = cvt_pk_bf16(v1[0], v1[1]); w.w = cvt_pk_bf16(v1[2], v1[3]);
                        *(u32x4*)(rowp + bj * 128) = w; } }
        } else if (wc == 0 && fq < 2) {
#pragma unroll
            for (int n = 0; n < 2; ++n) { const f32x4 bv = *(const f32x4*)(bgate + 8 * fq + 4 * n);
#pragma unroll
                for (int ai = 0; ai < 2; ++ai)
#pragma unroll
                    for (int m = 0; m < 4; ++m) *(f32x4*)(gates + (size_t)(row0 + ai * 128 + m * 16) * 16 + 8 * fq + 4 * n) = acc[ai][0][m][n] + bv; }
        }
    }
};
struct EpiRes {
    static constexpr int NREP = 1; static constexpr bool PERM = false;
    float* H; const float* stats; const float* lg; const float* lb;
    __device__ __forceinline__ void operator()(const AccT& acc, const pg8::Unit& u, int wr, int wc, int fr, int fq) const {
        const int row0 = u.pm * 256 + wr * 64 + fr, col0 = u.pn * 256 + wc * 32 + 4 * fq;
        f32x4 gv[2][2], bv[2][2];
        if (lg) {
#pragma unroll
            for (int bj = 0; bj < 2; ++bj)
#pragma unroll
                for (int n = 0; n < 2; ++n) { gv[bj][n] = *(const f32x4*)(lg + col0 + bj * 128 + n * 16); bv[bj][n] = *(const f32x4*)(lb + col0 + bj * 128 + n * 16); } }
#pragma unroll
        for (int ai = 0; ai < 2; ++ai)
#pragma unroll
            for (int m = 0; m < 4; ++m) { const int row = row0 + ai * 128 + m * 16; float* rowp = H + (size_t)row * D + col0;
                f32x2 st = (f32x2){0.f, 1.f}; if (lg) st = *(const f32x2*)(stats + 2 * (size_t)row);
#pragma unroll
                for (int bj = 0; bj < 2; ++bj)
#pragma unroll
                    for (int n = 0; n < 2; ++n) { float* p = rowp + bj * 128 + n * 16; f32x4 h = *(const f32x4*)p;
                        if (lg) h = (h - st.x) * st.y * gv[bj][n] + bv[bj][n];
                        *(f32x4*)p = h * ALPHA + acc[ai][bj][m][n]; } }
    }
};
struct EpiSwiglu {
    static constexpr int NREP = 1; static constexpr bool PERM = true;
    bf16_t* act; int ld;
    __device__ __forceinline__ static float silu_mul(float g, float u) { return g * u * __builtin_amdgcn_rcpf(1.0f + __builtin_amdgcn_exp2f(-g * 1.4426950408889634f)); }
    __device__ __forceinline__ void operator()(const AccT& acc, const pg8::Unit& u, int wr, int wc, int fr, int fq) const {
        const int row0 = u.pm * 256 + wr * 64 + fr, col0 = u.pn * 128 + wc * 32 + 8 * fq;
#pragma unroll
        for (int ai = 0; ai < 2; ++ai)
#pragma unroll
            for (int m = 0; m < 4; ++m) { const f32x4 g0 = acc[ai][0][m][0], g1 = acc[ai][0][m][1], u0 = acc[ai][1][m][0], u1 = acc[ai][1][m][1];
                u32x4 w; w.x = cvt_pk_bf16(silu_mul(g0[0], u0[0]), silu_mul(g0[1], u0[1])); w.y = cvt_pk_bf16(silu_mul(g0[2], u0[2]), silu_mul(g0[3], u0[3]));
                w.z = cvt_pk_bf16(silu_mul(g1[0], u1[0]), silu_mul(g1[1], u1[1])); w.w = cvt_pk_bf16(silu_mul(g1[2], u1[2]), silu_mul(g1[3], u1[3]));
                *(u32x4*)(act + (size_t)(row0 + ai * 128 + m * 16) * ld + col0) = w; }
    }
};
struct EpiSwigluProbe : EpiSwiglu { static constexpr int NREP = 2; };
struct EpiScatter {
    static constexpr int NREP = 1; static constexpr bool PERM = true;
    bf16_t* contrib; const int* rowdst; const float* rowgate;
    __device__ __forceinline__ void operator()(const AccT& acc, const pg8::Unit& u, int wr, int wc, int fr, int fq) const {
        const int row0 = u.pm * 256 + wr * 64 + fr, col0 = u.pn * 256 + wc * 32 + 8 * fq;
#pragma unroll
        for (int ai = 0; ai < 2; ++ai)
#pragma unroll
            for (int m = 0; m < 4; ++m) { const int pos = row0 + ai * 128 + m * 16; const int d = rowdst[pos];
                if (d >= 0) { const float g = rowgate[pos]; bf16_t* rowp = contrib + (size_t)d * D + col0;
#pragma unroll
                    for (int bj = 0; bj < 2; ++bj) { const f32x4 v0 = acc[ai][bj][m][0] * g, v1 = acc[ai][bj][m][1] * g;
                        u32x4 w; w.x = cvt_pk_bf16(v0[0], v0[1]); w.y = cvt_pk_bf16(v0[2], v0[3]); w.z = cvt_pk_bf16(v1[0], v1[1]); w.w = cvt_pk_bf16(v1[2], v1[3]);
                        *(u32x4*)(rowp + bj * 128) = w; } } }
    }
};
struct EpiQKV {
    static constexpr int NREP = 1; static constexpr bool PERM = true;
    bf16_t *Q, *KB, *VB; const float* rope;
    __device__ __forceinline__ void operator()(const AccT& acc, const pg8::Unit& u, int wr, int wc, int fr, int fq) const {
        const int row0 = u.pm * 256 + wr * 64 + fr, cl = wc * 32 + 8 * fq;
        bf16_t* base; int ld;
        if (u.pn == 5) {
#pragma unroll
            for (int ai = 0; ai < 2; ++ai)
#pragma unroll
                for (int m = 0; m < 4; ++m) { const int row = row0 + ai * 128 + m * 16;
#pragma unroll
                    for (int bj = 0; bj < 2; ++bj)
#pragma unroll
                        for (int n = 0; n < 2; ++n)
#pragma unroll
                            for (int j = 0; j < 4; ++j) VB[(size_t)(bj * 128 + cl + 4 * n + j) * MP + row] = (bf16_t)f2bf(acc[ai][bj][m][n][j]); }
            return; }
        if (u.pn < 4) { base = Q + u.pn * 256 + cl; ld = D; } else { base = KB + cl; ld = 256; }
        const bool dorope = (u.pn <= 4) && ((wc & 1) == 0);
#pragma unroll
        for (int ai = 0; ai < 2; ++ai)
#pragma unroll
            for (int m = 0; m < 4; ++m) { const int row = row0 + ai * 128 + m * 16;
                f32x4 v[2][2];
#pragma unroll
                for (int bj = 0; bj < 2; ++bj)
#pragma unroll
                    for (int n = 0; n < 2; ++n) v[bj][n] = acc[ai][bj][m][n];
                if (dorope) {
                    int pos = row < MREAL ? (row & (SEQ - 1)) + NMETA : row - MREAL; pos = pos > SEQ + NMETA - 1 ? SEQ + NMETA - 1 : pos;
                    const float* rp = rope + (size_t)pos * 16;
                    const f32x4 c0 = *(const f32x4*)rp, c1 = *(const f32x4*)(rp + 4), s0 = *(const f32x4*)(rp + 8), s1 = *(const f32x4*)(rp + 12);
#pragma unroll
                    for (int bj = 0; bj < 2; ++bj)
#pragma unroll
                        for (int n = 0; n < 2; ++n) { const f32x4 c = n ? c1 : c0, s = n ? s1 : s0; f32x4 o;
#pragma unroll
                            for (int j = 0; j < 4; ++j) { const float x = v[bj][n][j]; const float y = __shfl_xor(x, 16);
                                o[j] = fq == 0 ? x * c[j] - y * s[j] : (fq == 1 ? x * c[j] + y * s[j] : x); }
                            v[bj][n] = o; }
                }
#pragma unroll
                for (int bj = 0; bj < 2; ++bj) { const f32x4 v0 = v[bj][0], v1 = v[bj][1];
                    u32x4 w; w.x = cvt_pk_bf16(v0[0], v0[1]); w.y = cvt_pk_bf16(v0[2], v0[3]); w.z = cvt_pk_bf16(v1[0], v1[1]); w.w = cvt_pk_bf16(v1[2], v1[3]);
                    *(u32x4*)(base + (size_t)row * ld + bj * 128) = w; } }
    }
};

template <int NACC, class F>
__device__ __forceinline__ void skinny_item(const bf16_t* A, int lda, const bf16_t* (&Bt)[NACC], int K, int wave, int lane, LAS unsigned char* lds, int parity, const F& epi) {
    const int fr = lane & 15, quad = lane >> 4, kw = K >> 3;
    const bf16_t* ap = A + (size_t)fr * lda + wave * kw + 8 * quad;
    f32x4 acc[NACC];
#pragma unroll
    for (int i = 0; i < NACC; ++i) acc[i] = (f32x4){0.f, 0.f, 0.f, 0.f};
#pragma unroll 2
    for (int k = 0; k < kw; k += 32) { const bf16x8 a = *(const bf16x8*)(ap + k);
#pragma unroll
        for (int i = 0; i < NACC; ++i) acc[i] = __builtin_amdgcn_mfma_f32_16x16x32_bf16(a, *(const bf16x8*)(Bt[i] + (size_t)fr * K + wave * kw + 8 * quad + k), acc[i], 0, 0, 0); }
    LAS f32x4* red = (LAS f32x4*)(lds + parity * 16384);
#pragma unroll
    for (int i = 0; i < NACC; ++i) red[(wave * NACC + i) * 64 + lane] = acc[i];
    __syncthreads();
    if (wave == 0) {
#pragma unroll
        for (int i = 0; i < NACC; ++i) { f32x4 t = red[i * 64 + lane];
#pragma unroll
            for (int w = 1; w < 8; ++w) t += red[(w * NACC + i) * 64 + lane];
            acc[i] = t; }
        epi(acc, fr, quad);
    }
}

struct Params { const float* in[18]; float* out; unsigned char* ws; int ph_lo, ph_hi, li, pad; };
enum { I_X = 0, I_META, I_WIN, I_BGATE, I_LNH, I_WOUT, I_WKV, I_WQ, I_SINKS, I_WO, I_WGUD, I_WDND, I_WROUTER, I_BROUTER, I_WGUE, I_WDNE, I_LNG, I_LNB };
constexpr int NWAVES = 8, NTHREADS = 512;

__device__ __forceinline__ void tr_item(const float* W, int Nsrc, int K, bf16_t* WT, int k0, int n0, int drow0, float scale, int nvalid, LAS float* scr, int lane) {
#pragma unroll 8
    for (int i = 0; i < 32; ++i) { const int kk = 2 * i + (lane >> 5), n = lane & 31; scr[kk * 33 + n] = (n < nvalid) ? W[(size_t)(k0 + kk) * Nsrc + n0 + n] * scale : 0.f; }
    LDS_WAIT(); asm volatile("" ::: "memory");
    const int c = lane & 7;
#pragma unroll
    for (int j = 0; j < 4; ++j) { const int n = (lane >> 3) + 8 * j; const LAS float* s = scr + (8 * c) * 33 + n;
        u32x4 o; o.x = pk2(s[0 * 33], s[1 * 33]); o.y = pk2(s[2 * 33], s[3 * 33]); o.z = pk2(s[4 * 33], s[5 * 33]); o.w = pk2(s[6 * 33], s[7 * 33]);
        if (n < nvalid) *(u32x4*)(WT + (size_t)(drow0 + n) * K + k0 + 8 * c) = o; }
    LDS_WAIT(); asm volatile("" ::: "memory");
}
__device__ __forceinline__ int pair_row(int n, int FF) { const int up = n >= FF ? 1 : 0, j = n - up * FF; return 256 * (j >> 7) + 128 * up + (j & 127); }

__device__ __forceinline__ void p0_prologue(const Params& P, LAS unsigned char* lds, int gw, int NGW, int wave, int lane) {
    unsigned char* ws = P.ws;
    LAS float* scr = (LAS float*)(lds + wave * 16384);
    constexpr int IT0 = 16 * 97, IT1 = 16 * 32, IT2 = 16 * 16, IT5 = 16 * 176, IT6 = 44 * 32, IT7 = 16 * 224, IT8 = 56 * 32;
    constexpr int C0 = 2 * IT0, C1 = C0 + 2 * IT1, C2 = C1 + IT2, C3 = C2 + 2 * IT1, C4 = C3 + 2 * IT1, C5 = C4 + 2 * IT5, C6 = C5 + 2 * IT6, C7 = C6 + 16 * IT7, C8 = C7 + 16 * IT8;
    for (int it = gw; it < C8; it += NGW) {
        if (it < C0) { const int mi = it / IT0, r = it % IT0, kb = r / 97, nb = r % 97; const int n0 = nb * 32;
            tr_item(P.in[I_WIN] + (size_t)mi * D * M_IN, M_IN, D, (bf16_t*)(ws + WS_WIN) + (size_t)mi * M_INP * D, kb * 64, n0, n0, n0 < 512 ? 0.125f : 1.f, nb == 96 ? 16 : 32, scr, lane);
        } else if (it < C1) { const int q = it - C0, mi = q / IT1, r = q % IT1, kb = r / 32, nb = r % 32;
            tr_item(P.in[I_WOUT] + (size_t)mi * D * D, D, D, (bf16_t*)(ws + WS_WOUT) + (size_t)mi * D * D, kb * 64, nb * 32, nb * 32, 1.f, 32, scr, lane);
        } else if (it < C2) { const int r = it - C1, kb = r / 16, nb = r % 16;
            tr_item(P.in[I_WKV], 512, D, (bf16_t*)(ws + WS_WQKV), kb * 64, nb * 32, 1024 + nb * 32, 1.f, 32, scr, lane);
        } else if (it < C3) { const int q = it - C2, mi = q / IT1, r = q % IT1, kb = r / 32, nb = r % 32;
            tr_item(P.in[I_WQ] + (size_t)mi * D * D, D, D, (bf16_t*)(ws + (mi ? WS_WQ3 : WS_WQKV)), kb * 64, nb * 32, nb * 32, 0.125f, 32, scr, lane);
        } else if (it < C4) { const int q = it - C3, mi = q / IT1, r = q % IT1, kb = r / 32, nb = r % 32;
            tr_item(P.in[I_WO] + (size_t)mi * D * D, D, D, (bf16_t*)(ws + WS_WO) + (size_t)mi * D * D, kb * 64, nb * 32, nb * 32, 1.f, 32, scr, lane);
        } else if (it < C5) { const int q = it - C4, mi = q / IT5, r = q % IT5, kb = r / 176, nb = r % 176;
            tr_item(P.in[I_WGUD] + (size_t)mi * D * 2 * D_FF, 2 * D_FF, D, (bf16_t*)(ws + WS_WGU) + (size_t)mi * 2 * D_FF * D, kb * 64, nb * 32, pair_row(nb * 32, D_FF), 1.f, 32, scr, lane);
        } else if (it < C6) { const int q = it - C5, mi = q / IT6, r = q % IT6, kb = r / 32, nb = r % 32;
            tr_item(P.in[I_WDND] + (size_t)mi * D_FF * D, D, D_FF, (bf16_t*)(ws + WS_WDN) + (size_t)mi * D * D_FF, kb * 64, nb * 32, nb * 32, 1.f, 32, scr, lane);
        } else if (it < C7) { const int q = it - C6, mi = q / IT7, r = q % IT7, kb = r / 224, nb = r % 224;
            tr_item(P.in[I_WGUE] + (size_t)mi * D * 2 * D_FF_EXP, 2 * D_FF_EXP, D, (bf16_t*)(ws + WS_WGUE) + (size_t)mi * 2 * D_FF_EXP * D, kb * 64, nb * 32, pair_row(nb * 32, D_FF_EXP), 1.f, 32, scr, lane);
        } else { const int q = it - C7, mi = q / IT8, r = q % IT8, kb = r / 32, nb = r % 32;
            tr_item(P.in[I_WDNE] + (size_t)mi * D_FF_EXP * D, D, D_FF_EXP, (bf16_t*)(ws + WS_WDNE) + (size_t)mi * D * D_FF_EXP, kb * 64, nb * 32, nb * 32, 1.f, 32, scr, lane);
        }
    }
    { float* sm = (float*)(ws + WS_SMALL); const int gt = gw * 64 + lane, NT = NGW * 64;
      for (int i = gt; i < SM_END; i += NT) { float v = 0.f;
          if (i < SM_SINKS) v = P.in[I_BGATE][i]; else if (i < SM_BROUTER) v = P.in[I_SINKS][i - SM_SINKS]; else if (i < SM_BROUTER + 16) v = P.in[I_BROUTER][i - SM_BROUTER];
          else if (i < SM_LNH) v = 0.f; else if (i < SM_LNG) v = P.in[I_LNH][i - SM_LNH]; else if (i < SM_LNB) v = P.in[I_LNG][i - SM_LNG]; else if (i < SM_WROUTER) v = P.in[I_LNB][i - SM_LNB]; else v = P.in[I_WROUTER][i - SM_WROUTER];
          sm[i] = v; } }
    { float* H = (float*)(ws + WS_H); bf16_t* HB = (bf16_t*)(ws + WS_HB);
      const size_t gt = (size_t)gw * 64 + lane, NT = (size_t)NGW * 64;
      for (size_t i = gt; i < (size_t)MV * (D / 4); i += NT) { const size_t row = i >> 8; const int c4 = (int)(i & 255);
          const f32x4 v = row < MREAL ? ((const f32x4*)P.in[I_X])[i] : ((const f32x4*)P.in[I_META])[(row - MREAL) * 256 + c4];
          ((f32x4*)H)[i] = v; u32x2 w; w.x = pk2(v[0], v[1]); w.y = pk2(v[2], v[3]); ((u32x2*)HB)[i] = w; }
      float* rope = (float*)(ws + WS_ROPE);
      for (size_t i = gt; i < (size_t)(SEQ + NMETA) * 8; i += NT) { const int pos = (int)(i >> 3), fi = (int)(i & 7);
          const double invf = fi == 0 ? 1.0 : fi == 1 ? 0.19392274474868576 : fi == 2 ? 0.03760603093086393 : fi == 3 ? 0.007292664737217109 : fi == 4 ? 0.001414213562373095
                            : fi == 5 ? 0.0002742481756762073 : fi == 6 ? 5.318295896944988e-05 : 1.031338537721246e-05;
          const float angf = (float)pos * (float)invf;
          double a = (double)angf; a -= 6.283185307179586476925 * __builtin_rint(a * 0.15915494309189533577); const double hx = 0.5 * a, h2 = hx * hx;
          double sp = 1.0, cp = 1.0;
#pragma unroll
          for (int k = 12; k >= 1; --k) { sp = 1.0 - sp * h2 / (double)((2 * k) * (2 * k + 1)); cp = 1.0 - cp * h2 / (double)((2 * k - 1) * (2 * k)); }
          const double sh = hx * sp, ch = cp;
          rope[(size_t)pos * 16 + fi] = (float)(1.0 - 2.0 * sh * sh); rope[(size_t)pos * 16 + 8 + fi] = (float)(2.0 * sh * ch); }
    }
}

__device__ __forceinline__ void ln_phase(unsigned char* ws, float* outp, LAS unsigned char* lds, int gw, int NGW, int lane, int tid,
                                         int lnidx, bool moe_src, bool router, int moe_idx, bool final) {
    const float* sm = (const float*)(ws + WS_SMALL);
    float* H = (float*)(ws + WS_H); bf16_t* HB = (bf16_t*)(ws + WS_HB); const bf16_t* contrib = (const bf16_t*)(ws + WS_CONTRIB); float* stats = (float*)(ws + WS_STATS);
    const float* lg = sm + SM_LNG + (size_t)lnidx * D; const float* lb = sm + SM_LNB + (size_t)lnidx * D;
    f32x4 gv[4], bv[4];
#pragma unroll
    for (int j = 0; j < 4; ++j) { gv[j] = *(const f32x4*)(lg + 256 * j + 4 * lane); bv[j] = *(const f32x4*)(lb + 256 * j + 4 * lane); }
    LAS float* wr = (LAS float*)lds;
    volatile LAS unsigned* misc = (volatile LAS unsigned*)(lds + MISC_OFF);
    if (router) {
        const float* src = sm + SM_WROUTER + (size_t)moe_idx * D * N_EXP;
        for (int i = tid; i < D * N_EXP / 4; i += NTHREADS) ((LAS f32x4*)wr)[i] = ((const f32x4*)src)[i];
        if (tid < 8) misc[16 + tid] = 0u;
        __syncthreads();
    }
    int* tope = (int*)(ws + WS_TOPE); float* topg = (float*)(ws + WS_TOPG);
    const float* br = sm + SM_BROUTER + moe_idx * N_EXP;
    f32x4 nv[4]; u32x2 nc0[4], nc1[4]; f32x2 nst;
    auto fetch = [&](int row) {
        const f32x4* hr = (const f32x4*)(H + (size_t)row * D) + lane;
#pragma unroll
        for (int j = 0; j < 4; ++j) nv[j] = hr[64 * j];
        if (moe_src) { const u32x2* c0 = (const u32x2*)(contrib + (size_t)(2 * row) * D) + lane; const u32x2* c1 = c0 + 256;
#pragma unroll
            for (int j = 0; j < 4; ++j) { nc0[j] = c0[64 * j]; nc1[j] = c1[64 * j]; } }
        nst = *(const f32x2*)(stats + 2 * (size_t)row);
    };
    if (gw < MV) fetch(gw);
    for (int row = gw; row < MV; row += NGW) {
        f32x4 v[4], c0v[4], c1v[4]; const f32x2 st = nst;
#pragma unroll
        for (int j = 0; j < 4; ++j) { v[j] = nv[j];
            c0v[j] = (f32x4){__builtin_bit_cast(float, nc0[j].x << 16), __builtin_bit_cast(float, nc0[j].x & 0xffff0000u), __builtin_bit_cast(float, nc0[j].y << 16), __builtin_bit_cast(float, nc0[j].y & 0xffff0000u)};
            c1v[j] = (f32x4){__builtin_bit_cast(float, nc1[j].x << 16), __builtin_bit_cast(float, nc1[j].x & 0xffff0000u), __builtin_bit_cast(float, nc1[j].y << 16), __builtin_bit_cast(float, nc1[j].y & 0xffff0000u)}; }
        if (row + NGW < MV) fetch(row + NGW);
        if (moe_src) { const float* pg = lg - D; const float* pb = lb - D;
#pragma unroll
            for (int j = 0; j < 4; ++j) { const f32x4 g1 = *(const f32x4*)(pg + 256 * j + 4 * lane), b1 = *(const f32x4*)(pb + 256 * j + 4 * lane);
                v[j] = ((v[j] - st.x) * st.y * g1 + b1) * ALPHA + c0v[j] + c1v[j]; }
            if (!final) { f32x4* o = (f32x4*)(H + (size_t)row * D) + lane;
#pragma unroll
                for (int j = 0; j < 4; ++j) o[64 * j] = v[j]; } }
        float s = 0.f;
#pragma unroll
        for (int j = 0; j < 4; ++j) s += (v[j][0] + v[j][1]) + (v[j][2] + v[j][3]);
        const float mean = wave_sum(s) * (1.f / D); float s2 = 0.f;
#pragma unroll
        for (int j = 0; j < 4; ++j) { v[j] = v[j] - mean; s2 += (v[j][0] * v[j][0] + v[j][1] * v[j][1]) + (v[j][2] * v[j][2] + v[j][3] * v[j][3]); }
        const float rstd = 1.f / sqrtf(wave_sum(s2) * (1.f / D) + LN_EPS);
#pragma unroll
        for (int j = 0; j < 4; ++j) v[j] = v[j] * rstd * gv[j] + bv[j];
        if (final) { if (row < MREAL) { f32x4* o = (f32x4*)(outp + (size_t)row * D) + lane;
#pragma unroll
                for (int j = 0; j < 4; ++j) o[64 * j] = v[j]; } }
        else { u32x2* ob = (u32x2*)(HB + (size_t)row * D) + lane;
            if (lane == 0) *(f32x2*)(stats + 2 * (size_t)row) = (f32x2){mean, rstd};
#pragma unroll
            for (int j = 0; j < 4; ++j) { u32x2 w; w.x = pk2(v[j][0], v[j][1]); w.y = pk2(v[j][2], v[j][3]); ob[64 * j] = w; } }
        if (router) {
            float lg8[8];
#pragma unroll
            for (int e = 0; e < 8; ++e) lg8[e] = 0.f;
#pragma unroll
            for (int j = 0; j < 4; ++j)
#pragma unroll
                for (int c = 0; c < 4; ++c) { const LAS f32x4* w4 = (const LAS f32x4*)(wr + (size_t)(256 * j + 4 * lane + c) * 8); const f32x4 wa = w4[0], wb = w4[1]; const float x = v[j][c];
                    lg8[0] += x * wa[0]; lg8[1] += x * wa[1]; lg8[2] += x * wa[2]; lg8[3] += x * wa[3]; lg8[4] += x * wb[0]; lg8[5] += x * wb[1]; lg8[6] += x * wb[2]; lg8[7] += x * wb[3]; }
#pragma unroll
            for (int e = 0; e < 8; ++e) lg8[e] = wave_sum(lg8[e]) + br[e];
            int e1 = 0; float v1 = lg8[0];
#pragma unroll
            for (int e = 1; e < 8; ++e) if (lg8[e] > v1) { v1 = lg8[e]; e1 = e; }
            int e2 = -1; float v2 = -3.0e38f;
#pragma unroll
            for (int e = 0; e < 8; ++e) if (e != e1 && lg8[e] > v2) { v2 = lg8[e]; e2 = e; }
            const float ex = expf(v2 - v1), g1 = 1.f / (1.f + ex), g2 = ex / (1.f + ex);
            if (lane == 0) { tope[row] = e1 | (e2 << 8); topg[2 * row] = g1; topg[2 * row + 1] = g2;
                __hip_atomic_fetch_add((LAS unsigned*)&misc[16 + e1], 1u, __ATOMIC_RELAXED, __HIP_MEMORY_SCOPE_WORKGROUP);
                __hip_atomic_fetch_add((LAS unsigned*)&misc[16 + e2], 1u, __ATOMIC_RELAXED, __HIP_MEMORY_SCOPE_WORKGROUP); }
        }
    }
    if (router) { __syncthreads();
        if (tid < 8) __hip_atomic_fetch_add((unsigned*)(ws + WS_CTL) + CW_CNT + moe_idx * 64 + tid, misc[16 + tid], __ATOMIC_RELAXED, __HIP_MEMORY_SCOPE_AGENT);
        __syncthreads(); }
}

__device__ __forceinline__ void moe_starts(const unsigned char* ws, int moe_idx, int (&cnt)[8], int (&pstart)[9]) {
    const unsigned* c = (const unsigned*)(ws + WS_CTL) + CW_CNT + moe_idx * 64; int p = 0;
#pragma unroll
    for (int e = 0; e < 8; ++e) { cnt[e] = __builtin_amdgcn_readfirstlane((int)__hip_atomic_load(c + e, __ATOMIC_RELAXED, __HIP_MEMORY_SCOPE_AGENT)); pstart[e] = p; p += (cnt[e] + 255) >> 8; }
    pstart[8] = p;
}
__device__ __forceinline__ void assign_phase(unsigned char* ws, int gw, int NGW, int lane, int tid, int moe_idx) {
    int cnt[8], pstart[9]; moe_starts(ws, moe_idx, cnt, pstart);
    const int* tope = (const int*)(ws + WS_TOPE); const float* topg = (const float*)(ws + WS_TOPG);
    int* rowtok = (int*)(ws + WS_ROWTOK); int* rowdst = (int*)(ws + WS_ROWDST); float* rowgate = (float*)(ws + WS_ROWGATE);
    unsigned* cur = (unsigned*)(ws + WS_CTL) + CW_CUR + moe_idx * 64;
    for (int base = gw * 64; base < MV; base += NGW * 64) {
        const int row = base + lane; const bool valid = row < MV;
        const int te = valid ? tope[row] : 0xffff;
#pragma unroll
        for (int slot = 0; slot < 2; ++slot) {
            const int e = valid ? ((te >> (8 * slot)) & 255) : 255; int pos = -1;
#pragma unroll
            for (int ee = 0; ee < 8; ++ee) {
                const unsigned long long mask = __ballot(e == ee);
                if (mask) { const int n = __popcll(mask), leader = __ffsll((long long)mask) - 1; unsigned b0 = 0;
                    if (lane == leader) b0 = __hip_atomic_fetch_add(cur + ee, (unsigned)n, __ATOMIC_RELAXED, __HIP_MEMORY_SCOPE_AGENT);
                    b0 = __shfl(b0, leader);
                    if (e == ee) pos = pstart[ee] * 256 + (int)b0 + __popcll(mask & ((1ull << lane) - 1ull)); }
            }
            if (valid) { rowtok[pos] = row; rowdst[pos] = 2 * row + slot; rowgate[pos] = topg[2 * row + slot]; }
        }
    }
    if (blockIdx.x < 8) { const int e = blockIdx.x; int ps = 0, pe = 0, ce = 0;
#pragma unroll
        for (int ee = 0; ee < 8; ++ee) if (ee == e) { ps = pstart[ee]; pe = pstart[ee + 1]; ce = cnt[ee]; }
        for (int pos = ps * 256 + ce + tid; pos < pe * 256; pos += NTHREADS) { rowtok[pos] = -1; rowdst[pos] = -1; rowgate[pos] = 0.f; } }
}

constexpr int ML_RS = 72;
constexpr int ML_QS = 0, ML_KS = 9216, ML_KT = 18432, ML_PS = 27648, ML_VT = 36864, ML_CT = 57600, ML_HS = 78336, ML_SC = 112128;
constexpr int ML_HSS = 132;
constexpr int ML_TAB = 114688, ML_NCH = 17;
constexpr int ML_TSC = ML_TAB + 7 * ML_NCH * 64 * 4;
static_assert(ML_TSC + 1024 <= MISC_OFF, "mLSTM LDS");
__device__ __forceinline__ bf16x8 ml_frag(LAS unsigned char* lds, int base, int row, int kcol) { return *(const LAS bf16x8*)(lds + base + (row * ML_RS + kcol) * 2); }

template <int MODE>
__device__ __forceinline__ void mlstm_phase(unsigned char* ws, LAS unsigned char* lds, int layer, int tid, int wave, int lane) {
    const int item = blockIdx.x; const int bh = item >> 3, seg = item & 7, b = bh >> 3, h = bh & 7;
    if (MODE == 1 && seg == 7) return;
    const bf16_t* proj = (const bf16_t*)(ws + WS_PROJ); const float* gates = (const float*)(ws + WS_GATES);
    bf16_t* HG = (bf16_t*)(ws + WS_HG);
    float* STATE = (float*)(ws + WS_STATE); float* STSC = (float*)(ws + WS_STSC);
    LAS float* sc = (LAS float*)(lds + ML_SC);
    LAS float* tab = (LAS float*)(lds + ML_TAB); LAS float* tsc = (LAS float*)(lds + ML_TSC);
    const int fr = lane & 15, quad = lane >> 4;
    f32x4 st[5]; float zero = 0.f; asm volatile("; opaque zero" : "+v"(zero));
#pragma unroll
    for (int i = 0; i < 5; ++i) st[i] = (f32x4){zero, zero, zero, zero};
    float m0 = (MODE == 1) ? -1.0e30f : 0.f;
    const int nch = SEG_CHUNKS + (seg == 0 ? 1 : 0);
    auto chunk_rows = [&](int ci, int& rbase, int& nv) { if (seg == 0 && ci == 0) { rbase = MREAL; nv = NMETA; } else { const int c = seg * SEG_CHUNKS + ci - (seg == 0 ? 1 : 0); rbase = b * SEQ + c * 64; nv = 64; } };
    for (int i = tid; i < 16 * ML_RS; i += NTHREADS) ((LAS bf16_t*)(lds + ML_VT))[128 * ML_RS + i] = (i < ML_RS) ? (bf16_t)0x3F80 : (bf16_t)0;
    for (int ci = wave; ci < nch; ci += NWAVES) {
        int rbase, nv; chunk_rows(ci, rbase, nv); const bool ok = lane < nv;
        const float li = ok ? gates[(size_t)(rbase + lane) * 16 + h] : -1.0e30f, f = ok ? gates[(size_t)(rbase + lane) * 16 + 8 + h] : 0.f;
        const float lf = ok ? (fminf(f, 0.f) - logf(1.f + expf(-fabsf(f)))) : 0.f;
        float bc = lf;
#pragma unroll
        for (int o = 1; o < 64; o <<= 1) { const float t = __shfl_up(bc, o); if (lane >= o) bc += t; }
        const float u = li - bc; float pm = u;
#pragma unroll
        for (int o = 1; o < 64; o <<= 1) { const float t = __shfl_up(pm, o); if (lane >= o) pm = fmaxf(pm, t); }
        tab[(0 * ML_NCH + ci) * 64 + lane] = bc; tab[(1 * ML_NCH + ci) * 64 + lane] = u; tab[(2 * ML_NCH + ci) * 64 + lane] = pm;
        if (lane == 63) { tsc[ci] = bc; tsc[32 + ci] = pm; }
    }
    if (MODE == 2 && seg > 0) {
        m0 = -1.0e30f;
        for (int s2 = 0; s2 < seg; ++s2) {
            const float ms = STSC[(bh * 7 + s2) * 4 + 0], Gs = STSC[(bh * 7 + s2) * 4 + 1];
            const float mn = fmaxf(Gs + m0, ms), fo = fast_exp(Gs + m0 - mn), fn = fast_exp(ms - mn);
            const f32x4* sp = (const f32x4*)(STATE + (size_t)(bh * 7 + s2) * ST_FLOATS) + (wave * 5) * 64 + lane;
#pragma unroll
            for (int i = 0; i < 5; ++i) st[i] = st[i] * fo + sp[i * 64] * fn;
            m0 = mn;
        }
    }
#pragma unroll
    for (int i = 0; i < 5; ++i) { const int dv = (i < 4) ? 16 * wave + fr : 128 + fr, dk = (i < 4) ? 16 * i + 4 * quad : 16 * wave + 4 * quad;
        if (i < 4 || wave < 4) { u32x2 w; w.x = pk2(st[i][0], st[i][1]); w.y = pk2(st[i][2], st[i][3]); *(LAS u32x2*)(lds + ML_CT + (dv * ML_RS + dk) * 2) = w; } }
    __syncthreads();
    if (wave == 0) {
        const float bl = lane < nch ? tsc[lane] : 0.f, um = lane < nch ? tsc[32 + lane] : 0.f; float m = m0, gs = 0.f;
        for (int ci = 0; ci < nch; ++ci) { const float blast = __shfl(bl, ci), umax = __shfl(um, ci), amax = blast + umax, mn = fmaxf(blast + m, amax);
            if (lane == 0) { tsc[64 + ci] = m; tsc[96 + ci] = fast_exp(blast + m - mn); tsc[128 + ci] = fast_exp(amax - mn); }
            m = mn; gs += blast; }
        if (lane == 0) { tsc[160] = m; tsc[161] = gs; }
    }
    __syncthreads();
    for (int idx = tid; idx < nch * 64; idx += NTHREADS) { const int ci = idx >> 6, j = idx & 63;
        const float bc = tab[(0 * ML_NCH + ci) * 64 + j], u = tab[(1 * ML_NCH + ci) * 64 + j], pm = tab[(2 * ML_NCH + ci) * 64 + j], mc = tsc[64 + ci], MM = fmaxf(pm, mc);
        tab[(3 * ML_NCH + ci) * 64 + j] = MM; tab[(4 * ML_NCH + ci) * 64 + j] = fast_exp(mc - MM); tab[(5 * ML_NCH + ci) * 64 + j] = fast_exp(-(bc + MM));
        tab[(6 * ML_NCH + ci) * 64 + j] = tsc[128 + ci] * fast_exp(u - tsc[32 + ci]); }
    float lnh[16];
    if (MODE == 2) {
#pragma unroll
        for (int e = 0; e < 16; ++e) lnh[e] = ((const float*)(ws + WS_SMALL))[SM_LNH + layer * D + h * M_V + 16 * (tid & 7) + e]; }
    u32x4 rq, rk, rv0, rv1, rg0, rg1;
    auto load_chunk = [&](int ci) {
        int rbase, nv; chunk_rows(ci, rbase, nv);
        if (MODE == 2) { const int i = tid >> 3, sg = tid & 7; const u32x4* ogp = (const u32x4*)(proj + (size_t)(rbase + (i < nv ? i : 0)) * PROJ_LD + 2048 + h * M_V + 16 * sg); rg0 = ogp[0]; rg1 = ogp[1]; }
        { const int j = tid >> 3, c8 = (tid & 7) * 8; const bf16_t* rp = proj + (size_t)(rbase + j) * PROJ_LD + h * 64 + c8;
          rq = (MODE == 2 && j < nv) ? *(const u32x4*)rp : (u32x4){0u, 0u, 0u, 0u}; }
        { const bf16_t* rp = proj + (size_t)(rbase + lane) * PROJ_LD; const bool ok = lane < nv;
          rk = ok ? *(const u32x4*)(rp + 512 + h * 64 + 8 * wave) : (u32x4){0u, 0u, 0u, 0u};
          rv0 = ok ? *(const u32x4*)(rp + 1024 + h * 128 + 16 * wave) : (u32x4){0u, 0u, 0u, 0u}; rv1 = ok ? *(const u32x4*)(rp + 1024 + h * 128 + 16 * wave + 8) : (u32x4){0u, 0u, 0u, 0u}; }
    };
    load_chunk(0);
    __syncthreads();
    for (int ci = 0; ci < nch; ++ci) {
        int rbase, nv; chunk_rows(ci, rbase, nv);
        const u32x4 g0 = rg0, g1 = rg1;
        const LAS float* tU = tab + (1 * ML_NCH + ci) * 64; const LAS float* tMM = tab + (3 * ML_NCH + ci) * 64; const LAS float* tSI = tab + (4 * ML_NCH + ci) * 64;
        const LAS float* tFL = tab + (5 * ML_NCH + ci) * 64; const LAS float* tWP = tab + (6 * ML_NCH + ci) * 64;
        const float sold = tsc[96 + ci];
        { if (MODE == 2) { const int j = tid >> 3, c8 = (tid & 7) * 8; *(LAS u32x4*)(lds + ML_QS + (j * ML_RS + c8) * 2) = rq; }
          const float wj = tWP[lane]; LAS bf16_t* kt = (LAS bf16_t*)(lds + ML_KT); LAS bf16_t* vt = (LAS bf16_t*)(lds + ML_VT);
          if (MODE == 2) *(LAS u32x4*)(lds + ML_KS + (lane * ML_RS + 8 * wave) * 2) = rk;
          const unsigned kk[4] = {rk.x, rk.y, rk.z, rk.w}, a[4] = {rv0.x, rv0.y, rv0.z, rv0.w}, c[4] = {rv1.x, rv1.y, rv1.z, rv1.w};
#pragma unroll
          for (int e = 0; e < 4; ++e) { kt[(8 * wave + 2 * e) * ML_RS + lane] = (bf16_t)f2bf(bf2f((unsigned short)(kk[e] & 0xffffu)) * wj); kt[(8 * wave + 2 * e + 1) * ML_RS + lane] = (bf16_t)f2bf(bf2f((unsigned short)(kk[e] >> 16)) * wj);
              vt[(16 * wave + 2 * e) * ML_RS + lane] = (bf16_t)(a[e] & 0xffffu); vt[(16 * wave + 2 * e + 1) * ML_RS + lane] = (bf16_t)(a[e] >> 16);
              vt[(16 * wave + 8 + 2 * e) * ML_RS + lane] = (bf16_t)(c[e] & 0xffffu); vt[(16 * wave + 8 + 2 * e + 1) * ML_RS + lane] = (bf16_t)(c[e] >> 16); } }
        __syncthreads();
        if (ci + 1 < nch) load_chunk(ci + 1);
        f32x4 o1[4], o2[4];
        if (MODE == 2) {
            const int mt = wave >> 1;
#pragma unroll
            for (int q = 0; q < 2; ++q) { const int nt = 2 * (wave & 1) + q; f32x4 s = (f32x4){0.f, 0.f, 0.f, 0.f};
                if (nt <= mt) {
#pragma unroll
                    for (int ks = 0; ks < 2; ++ks) s = __builtin_amdgcn_mfma_f32_16x16x32_bf16(ml_frag(lds, ML_QS, 16 * mt + fr, 32 * ks + 8 * quad), ml_frag(lds, ML_KS, 16 * nt + fr, 32 * ks + 8 * quad), s, 0, 0, 0); }
                const int j = 16 * nt + fr; const float uj = tU[j];
#pragma unroll
                for (int r = 0; r < 4; ++r) { const int i = 16 * mt + 4 * quad + r; const float p = (j <= i) ? s[r] * fast_exp(uj - tMM[i]) : 0.f;
                    ((LAS bf16_t*)(lds + ML_PS))[i * ML_RS + j] = (bf16_t)f2bf(p); } }
            __syncthreads();
            bf16x8 vb[2], cb[2];
#pragma unroll
            for (int ks = 0; ks < 2; ++ks) { vb[ks] = ml_frag(lds, ML_VT, 16 * wave + fr, 32 * ks + 8 * quad); cb[ks] = ml_frag(lds, ML_CT, 16 * wave + fr, 32 * ks + 8 * quad); }
#pragma unroll
            for (int mt2 = 0; mt2 < 4; ++mt2) { o1[mt2] = (f32x4){0.f, 0.f, 0.f, 0.f}; o2[mt2] = (f32x4){0.f, 0.f, 0.f, 0.f};
#pragma unroll
                for (int ks = 0; ks < 2; ++ks) { o1[mt2] = __builtin_amdgcn_mfma_f32_16x16x32_bf16(ml_frag(lds, ML_PS, 16 * mt2 + fr, 32 * ks + 8 * quad), vb[ks], o1[mt2], 0, 0, 0);
                    o2[mt2] = __builtin_amdgcn_mfma_f32_16x16x32_bf16(ml_frag(lds, ML_QS, 16 * mt2 + fr, 32 * ks + 8 * quad), cb[ks], o2[mt2], 0, 0, 0); } }
            if (wave < 4) { f32x4 d1 = (f32x4){0.f, 0.f, 0.f, 0.f}, d2 = (f32x4){0.f, 0.f, 0.f, 0.f};
#pragma unroll
                for (int ks = 0; ks < 2; ++ks) { d1 = __builtin_amdgcn_mfma_f32_16x16x32_bf16(ml_frag(lds, ML_PS, 16 * wave + fr, 32 * ks + 8 * quad), ml_frag(lds, ML_VT, 128 + fr, 32 * ks + 8 * quad), d1, 0, 0, 0);
                    d2 = __builtin_amdgcn_mfma_f32_16x16x32_bf16(ml_frag(lds, ML_QS, 16 * wave + fr, 32 * ks + 8 * quad), ml_frag(lds, ML_CT, 128 + fr, 32 * ks + 8 * quad), d2, 0, 0, 0); }
                if (fr == 0) {
#pragma unroll
                    for (int r = 0; r < 4; ++r) { const int i = 16 * wave + 4 * quad + r; sc[320 + i] = d1[r] + tSI[i] * d2[r]; } } }
            __syncthreads();
#pragma unroll
            for (int mt2 = 0; mt2 < 4; ++mt2)
#pragma unroll
                for (int r = 0; r < 4; ++r) { const int i = 16 * mt2 + 4 * quad + r; const float num = o1[mt2][r] + tSI[i] * o2[mt2][r];
                    ((LAS float*)(lds + ML_HS))[i * ML_HSS + 16 * wave + fr] = num * __builtin_amdgcn_rcpf(fmaxf(fabsf(sc[320 + i]), tFL[i])); }
        }
        { bf16x8 vb[2];
#pragma unroll
          for (int ks = 0; ks < 2; ++ks) vb[ks] = ml_frag(lds, ML_VT, 16 * wave + fr, 32 * ks + 8 * quad);
#pragma unroll
          for (int mt2 = 0; mt2 < 4; ++mt2) { st[mt2] = st[mt2] * sold;
#pragma unroll
              for (int ks = 0; ks < 2; ++ks) st[mt2] = __builtin_amdgcn_mfma_f32_16x16x32_bf16(ml_frag(lds, ML_KT, 16 * mt2 + fr, 32 * ks + 8 * quad), vb[ks], st[mt2], 0, 0, 0); }
          if (wave < 4) { st[4] = st[4] * sold;
#pragma unroll
              for (int ks = 0; ks < 2; ++ks) st[4] = __builtin_amdgcn_mfma_f32_16x16x32_bf16(ml_frag(lds, ML_KT, 16 * wave + fr, 32 * ks + 8 * quad), ml_frag(lds, ML_VT, 128 + fr, 32 * ks + 8 * quad), st[4], 0, 0, 0); }
          if (MODE == 2) {
#pragma unroll
              for (int i = 0; i < 5; ++i) { const int dv = (i < 4) ? 16 * wave + fr : 128 + fr, dk = (i < 4) ? 16 * i + 4 * quad : 16 * wave + 4 * quad;
                  if (i < 4 || wave < 4) { u32x2 w; w.x = pk2(st[i][0], st[i][1]); w.y = pk2(st[i][2], st[i][3]); *(LAS u32x2*)(lds + ML_CT + (dv * ML_RS + dk) * 2) = w; } } }
        }
        __syncthreads();
        if (MODE == 2) {
            const int i = tid >> 3, sg = tid & 7; const LAS float* hp = (const LAS float*)(lds + ML_HS) + i * ML_HSS + 16 * sg;
            float x[16]; float s = 0.f;
#pragma unroll
            for (int e = 0; e < 16; ++e) { x[e] = hp[e]; s += x[e]; }
            s += __shfl_xor(s, 1); s += __shfl_xor(s, 2); s += __shfl_xor(s, 4);
            const float mean = s * (1.f / M_V); float q = 0.f;
#pragma unroll
            for (int e = 0; e < 16; ++e) { x[e] -= mean; q += x[e] * x[e]; }
            q += __shfl_xor(q, 1); q += __shfl_xor(q, 2); q += __shfl_xor(q, 4);
            const float rstd = 1.f / sqrtf(q * (1.f / M_V) + LN_EPS);
            if (i < nv && (nv == 64 || b == 0)) {
                const size_t row = (size_t)(rbase + i);
                const unsigned gw8[8] = {g0.x, g0.y, g0.z, g0.w, g1.x, g1.y, g1.z, g1.w}; unsigned ow[8];
#pragma unroll
                for (int e = 0; e < 8; ++e) { const float oga = bf2f((unsigned short)(gw8[e] & 0xffffu)), ogb = bf2f((unsigned short)(gw8[e] >> 16));
                    const float ya = x[2 * e] * rstd * lnh[2 * e] * __builtin_amdgcn_rcpf(1.f + fast_exp(-oga)), yb = x[2 * e + 1] * rstd * lnh[2 * e + 1] * __builtin_amdgcn_rcpf(1.f + fast_exp(-ogb));
                    ow[e] = pk2(ya, yb); }
                u32x4* op = (u32x4*)(HG + row * D + h * M_V + 16 * sg);
                op[0] = (u32x4){ow[0], ow[1], ow[2], ow[3]}; op[1] = (u32x4){ow[4], ow[5], ow[6], ow[7]};
            }
        }
    }
    if (MODE == 1) {
        f32x4* sp = (f32x4*)(STATE + (size_t)(bh * 7 + seg) * ST_FLOATS) + (wave * 5) * 64 + lane;
#pragma unroll
        for (int i = 0; i < 5; ++i) sp[i * 64] = (i < 4 || wave < 4) ? st[i] : (f32x4){0.f, 0.f, 0.f, 0.f};
        if (tid == 0) { STSC[(bh * 7 + seg) * 4 + 0] = tsc[160]; STSC[(bh * 7 + seg) * 4 + 1] = tsc[161]; }
    }
}

constexpr int AT_KRS = 72, AT_VRS = 280, AT_NK = 272;
constexpr int AT_KS = 0, AT_VT = AT_NK * AT_KRS * 2, AT_END = AT_VT + 64 * AT_VRS * 2;
static_assert(AT_END <= MISC_OFF, "attention LDS");
__device__ __forceinline__ void attn_phase(unsigned char* ws, LAS unsigned char* lds, int j_layer, int tid, int wave, int lane) {
    const bf16_t* Q = (const bf16_t*)(ws + WS_PROJ); const bf16_t* KB = (const bf16_t*)(ws + WS_KB); const bf16_t* VT = (const bf16_t*)(ws + WS_VB);
    bf16_t* HG = (bf16_t*)(ws + WS_HG);
    const float* sinks = (const float*)(ws + WS_SMALL) + SM_SINKS + j_layer * A_HEADS;
    const int fr = lane & 15, quad = lane >> 4;
    LAS bf16_t* ks = (LAS bf16_t*)(lds + AT_KS); LAS bf16_t* vt = (LAS bf16_t*)(lds + AT_VT);
    u32x4 kreg[5], vreg[5]; bf16x8 qn[4][2];
    const int NREG = NBATCH * A_KV * (SEQ / WINDOW), NIT = NREG + A_KV;
    auto prefetch = [&](int it) {
        const bool meta = it >= NREG; const int b = meta ? 0 : it >> 8, g = meta ? it - NREG : (it >> 6) & 3, blk = meta ? -1 : it & 63;
#pragma unroll
        for (int i = 0; i < 5; ++i) { const int p = tid + i * NTHREADS; kreg[i] = (u32x4){0u, 0u, 0u, 0u}; vreg[i] = (u32x4){0u, 0u, 0u, 0u};
            if (p < AT_NK * 8) { const int kk = p >> 3, c8 = (p & 7) * 8;
                int row; if (kk >= 256) row = MREAL + kk - 256; else { const int tk = (blk - 1) * WINDOW + kk; row = (tk < 0 || meta) ? -1 : b * SEQ + tk; }
                if (row >= 0) kreg[i] = *(const u32x4*)(KB + (size_t)row * 256 + g * 64 + c8);
                const int d = p / 34, pc = p % 34; const bf16_t* src = VT + (size_t)(g * 64 + d) * MP;
                if (pc >= 32) vreg[i] = *(const u32x4*)(src + MREAL + (pc - 32) * 8);
                else { const int tk = (blk - 1) * WINDOW + pc * 8; if (tk >= 0 && !meta) vreg[i] = *(const u32x4*)(src + (size_t)b * SEQ + tk); } } }
    };
    auto qload = [&](int it, int mt) {
        const bool meta = it >= NREG; const int b = it >> 8, g = meta ? it - NREG : (it >> 6) & 3, blk = it & 63, qh = g * 4 + (wave >> 1);
        const size_t rowq = meta ? (size_t)MREAL + fr : (size_t)b * SEQ + blk * WINDOW + 16 * (4 * (wave & 1) + mt) + fr;
#pragma unroll
        for (int k2 = 0; k2 < 2; ++k2) qn[mt][k2] = *(const bf16x8*)(Q + rowq * D + qh * 64 + 32 * k2 + 8 * quad);
    };
    if ((int)blockIdx.x < NIT) { prefetch(blockIdx.x);
#pragma unroll
        for (int mt = 0; mt < 4; ++mt) qload(blockIdx.x, mt); }
    for (int it = blockIdx.x; it < NIT; it += gridDim.x) {
        const bool meta = it >= NREG; const int b = it >> 8, g = meta ? it - NREG : (it >> 6) & 3, blk = it & 63;
        __syncthreads();
#pragma unroll
        for (int i = 0; i < 5; ++i) { const int p = tid + i * NTHREADS;
            if (p < AT_NK * 8) { *(LAS u32x4*)(ks + (p >> 3) * AT_KRS + (p & 7) * 8) = kreg[i]; *(LAS u32x4*)(vt + (p / 34) * AT_VRS + (p % 34) * 8) = vreg[i]; } }
        __syncthreads();
        const bool has_next = it + (int)gridDim.x < NIT;
        if (has_next) prefetch(it + gridDim.x);
        const int qh = g * 4 + (wave >> 1); const float sink = sinks[qh];
#pragma unroll
        for (int mt = 0; mt < 4; ++mt) {
            if (meta && (mt > 0 || (wave & 1))) continue;
            const int t0 = meta ? 0 : 4 * (wave & 1) + mt, qi = 16 * t0 + fr;
            const size_t rowq = meta ? (size_t)MREAL + fr : (size_t)b * SEQ + blk * WINDOW + qi;
            f32x4 s[10];
#pragma unroll
            for (int c = 0; c < 10; ++c) { const int kb = (c < 9) ? 16 * (t0 + c) : 256; s[c] = (f32x4){0.f, 0.f, 0.f, 0.f};
#pragma unroll
                for (int k2 = 0; k2 < 2; ++k2) s[c] = __builtin_amdgcn_mfma_f32_16x16x32_bf16(*(const LAS bf16x8*)(ks + (kb + fr) * AT_KRS + 32 * k2 + 8 * quad), qn[mt][k2], s[c], 0, 0, 0); }
            if (has_next) qload(it + gridDim.x, mt);
            float m = sink;
#pragma unroll
            for (int c = 0; c < 9; ++c)
#pragma unroll
                for (int r = 0; r < 4; ++r) { const int j = 16 * (t0 + c) + 4 * quad + r, rel = qi + WINDOW - j; const bool vis = !meta && (rel >= 0) && (rel < WINDOW) && (blk > 0 || j >= WINDOW);
                    s[c][r] = vis ? s[c][r] : -1.0e30f; m = fmaxf(m, s[c][r]); }
#pragma unroll
            for (int r = 0; r < 4; ++r) { const bool vis = !meta || (4 * quad + r <= fr); s[9][r] = vis ? s[9][r] : -1.0e30f; m = fmaxf(m, s[9][r]); }
            m = fmaxf(m, __shfl_xor(m, 16)); m = fmaxf(m, __shfl_xor(m, 32));
            float sm = 0.f;
#pragma unroll
            for (int c = 0; c < 10; ++c)
#pragma unroll
                for (int r = 0; r < 4; ++r) { const float p = fast_exp(s[c][r] - m); s[c][r] = p; sm += p; }
            sm += __shfl_xor(sm, 16); sm += __shfl_xor(sm, 32);
            const float inv = 1.f / (sm + fast_exp(sink - m));
            f32x4 o[4];
#pragma unroll
            for (int dt = 0; dt < 4; ++dt) o[dt] = (f32x4){0.f, 0.f, 0.f, 0.f};
#pragma unroll
            for (int u = 0; u < 5; ++u) {
                const int kb0 = 16 * (t0 + 2 * u), kb1 = (u < 4) ? 16 * (t0 + 2 * u + 1) : 256;
                u32x4 pw; pw.x = cvt_pk_bf16(s[2 * u][0], s[2 * u][1]); pw.y = cvt_pk_bf16(s[2 * u][2], s[2 * u][3]); pw.z = cvt_pk_bf16(s[2 * u + 1][0], s[2 * u + 1][1]); pw.w = cvt_pk_bf16(s[2 * u + 1][2], s[2 * u + 1][3]);
                const bf16x8 pf = __builtin_bit_cast(bf16x8, pw);
#pragma unroll
                for (int dt = 0; dt < 4; ++dt) { const LAS bf16_t* vr = vt + (16 * dt + fr) * AT_VRS + 4 * quad;
                    u32x4 vw; const u32x2 a = *(const LAS u32x2*)(vr + kb0), c2 = *(const LAS u32x2*)(vr + kb1); vw.x = a.x; vw.y = a.y; vw.z = c2.x; vw.w = c2.y;
                    o[dt] = __builtin_amdgcn_mfma_f32_16x16x32_bf16(__builtin_bit_cast(bf16x8, vw), pf, o[dt], 0, 0, 0); } }
#pragma unroll
            for (int dt = 0; dt < 4; ++dt) { u32x2 w; w.x = cvt_pk_bf16(o[dt][0] * inv, o[dt][1] * inv); w.y = cvt_pk_bf16(o[dt][2] * inv, o[dt][3] * inv);
                *(u32x2*)(HG + rowq * D + qh * 64 + 16 * dt + 4 * quad) = w; }
        }
    }
}

#ifndef SITES
#define SITES 0xFFFF
#endif
#define SITE(n) ((SITES >> (n)) & 1)
#ifndef DUPMASK
#define DUPMASK 0
#endif
#define REPS(n) (1 + ((DUPMASK >> (n)) & 1))
#ifndef MK_PER_PHASE
#define MK_PER_PHASE 0
#endif
constexpr int PH_PER_LAYER = 12, N_PHASES = 1 + 4 * PH_PER_LAYER;

__global__ void __launch_bounds__(NTHREADS, 2) fwd(Params P) {
    extern __shared__ __attribute__((aligned(16))) unsigned char lds_raw[];
    LAS unsigned char* const lds0 = (LAS unsigned char*)lds_raw;
    const int G = gridDim.x;
    const int vcu = (G % 8 == 0) ? ((int)blockIdx.x % 8) * (G / 8) + (int)blockIdx.x / 8 : (int)blockIdx.x;
    const int NGW = G * NWAVES;
    unsigned char* const wsbase = P.ws;
    volatile LAS unsigned* misc = (volatile LAS unsigned*)(lds0 + MISC_OFF);
    if (threadIdx.x < 64) misc[threadIdx.x] = 0u;
    __syncthreads();
    XcdBarrier bar = xcd_barrier_post((unsigned*)(wsbase + WS_CTL) + CW_BAR + P.li * 4096, misc + 8);
    const int lo = P.ph_lo, hi = P.ph_hi;
#define RUN(idx) ((idx) >= lo && (idx) < hi)
#define SEAM(idx) do { if ((idx) + 1 < hi) xcd_barrier(bar); } while (0)
#define IDS() int tid = threadIdx.x; asm volatile("; opaque tid" : "+v"(tid)); unsigned char* ws = wsbase; asm volatile("; opaque ws" : "+s"(ws)); \
              LAS unsigned char* lds = lds0; asm volatile("; opaque lds" : "+s"(lds)); \
              const int lane = tid & 63, wave = __builtin_amdgcn_readfirstlane(tid >> 6); const int gw = vcu * NWAVES + wave; (void)lane; (void)gw; (void)ws

    for (int rep = 0; rep < REPS(0); ++rep) if (SITE(0) && RUN(0)) { IDS(); p0_prologue(P, lds, gw, NGW, wave, lane); SEAM(0); }

    for (int l = 0; l < 4; ++l) {
        const int pb = 1 + l * PH_PER_LAYER;
        const bool moe = (l & 1) != 0; const int fi = l >> 1;
        if (l < 2) {
            for (int rep = 0; rep < REPS(1); ++rep) if (SITE(1) && RUN(pb + 0)) {
                IDS();
                pg8::DenseOrder S; S.init(MREAL / 256, 12, G, (int)blockIdx.x);
                EpiProj E{(bf16_t*)(ws + WS_PROJ), (float*)(ws + WS_GATES), (const float*)(ws + WS_SMALL) + SM_BGATE + l * 16};
                const bf16_t* HBp = (const bf16_t*)(ws + WS_HB); const bf16_t* Wp = (const bf16_t*)(ws + WS_WIN) + (size_t)l * M_INP * D;
                pg8::gemm_phase(lds, HBp, Wp, D, S, E);
                bf16_t* PROJ = (bf16_t*)(ws + WS_PROJ); float* GATES = (float*)(ws + WS_GATES); const float* bg = (const float*)(ws + WS_SMALL) + SM_BGATE + l * 16;
                int par = 0;
                for (int item = (int)blockIdx.x; item < 192 + (MV / 16); item += G, par ^= 1) {
                    if (item < 192) { const bf16_t* B1[1] = {Wp + (size_t)item * 16 * D};
                        skinny_item<1>(HBp + (size_t)MREAL * D, D, B1, D, wave, lane, lds, par, [&](const f32x4 (&a)[1], int fr, int quad) {
#pragma unroll
                            for (int r = 0; r < 4; ++r) PROJ[(size_t)(MREAL + 4 * quad + r) * PROJ_LD + item * 16 + fr] = (bf16_t)f2bf(a[0][r]); });
                    } else { const int rt = item - 192; const bf16_t* B1[1] = {Wp + (size_t)3072 * D};
                        skinny_item<1>(HBp + (size_t)rt * 16 * D, D, B1, D, wave, lane, lds, par, [&](const f32x4 (&a)[1], int fr, int quad) { const float bias = bg[fr];
#pragma unroll
                            for (int r = 0; r < 4; ++r) GATES[(size_t)(rt * 16 + 4 * quad + r) * 16 + fr] = a[0][r] + bias; }); }
                }
                SEAM(pb + 0); }
            for (int rep = 0; rep < REPS(2); ++rep) if (SITE(2) && RUN(pb + 1)) { IDS(); mlstm_phase<1>(ws, lds, l, tid, wave, lane); SEAM(pb + 1); }
            for (int rep = 0; rep < REPS(3); ++rep) if (SITE(3) && RUN(pb + 2)) { IDS(); mlstm_phase<2>(ws, lds, l, tid, wave, lane); SEAM(pb + 2); }
        } else {
            for (int rep = 0; rep < REPS(4); ++rep) if (SITE(4) && RUN(pb + 0)) {
                IDS();
                pg8::DenseOrder S; S.init(MREAL / 256, l == 2 ? 6 : 4, G, (int)blockIdx.x);
                EpiQKV E{(bf16_t*)(ws + WS_PROJ), (bf16_t*)(ws + WS_KB), (bf16_t*)(ws + WS_VB), (const float*)(ws + WS_ROPE)};
                const bf16_t* HBp = (const bf16_t*)(ws + WS_HB); const bf16_t* Wp = (const bf16_t*)(ws + (l == 2 ? WS_WQKV : WS_WQ3));
                pg8::gemm_phase(lds, HBp, Wp, D, S, E);
                bf16_t* Qp = (bf16_t*)(ws + WS_PROJ); bf16_t* KBp = (bf16_t*)(ws + WS_KB); bf16_t* VTp = (bf16_t*)(ws + WS_VB); const float* rope = (const float*)(ws + WS_ROPE);
                int par = 0;
                for (int item = (int)blockIdx.x; item < (l == 2 ? 96 : 64); item += G, par ^= 1) { const bf16_t* B1[1] = {Wp + (size_t)item * 16 * D};
                    skinny_item<1>(HBp + (size_t)MREAL * D, D, B1, D, wave, lane, lds, par, [&](const f32x4 (&a)[1], int fr, int quad) {
                        const int col = item * 16 + fr; const bool dorope = (item < 80) && ((item & 3) == 0);
#pragma unroll
                        for (int r = 0; r < 4; ++r) { const int pos = 4 * quad + r; float x = a[0][r]; const float y = __shfl_xor(x, 8);
                            if (dorope) { const float c = rope[pos * 16 + (fr & 7)], sn = rope[pos * 16 + 8 + (fr & 7)]; x = (fr < 8) ? x * c - y * sn : x * c + y * sn; }
                            const bf16_t o = (bf16_t)f2bf(x); const size_t row = (size_t)MREAL + pos;
                            if (item < 64) Qp[row * D + col] = o; else if (item < 80) KBp[row * 256 + col - 1024] = o; else VTp[(size_t)(col - 1280) * MP + row] = o; } });
                }
                SEAM(pb + 0); }
            for (int rep = 0; rep < REPS(5); ++rep) if (SITE(5) && RUN(pb + 1)) { IDS(); attn_phase(ws, lds, l - 2, tid, wave, lane); SEAM(pb + 1); }
        }
        for (int rep = 0; rep < REPS(6); ++rep) if (SITE(6) && RUN(pb + 3)) {
            IDS();
            pg8::DenseOrder S; S.init(MREAL / 256, 4, G, (int)blockIdx.x);
            const float* smp = (const float*)(ws + WS_SMALL);
            EpiRes E{(float*)(ws + WS_H), (const float*)(ws + WS_STATS), l > 0 ? smp + SM_LNG + (size_t)(2 * l - 1) * D : nullptr, smp + SM_LNB + (size_t)(l > 0 ? 2 * l - 1 : 0) * D};
            const bf16_t* Ap = (const bf16_t*)(ws + WS_HG); const bf16_t* Wp = (const bf16_t*)(ws + (l < 2 ? WS_WOUT : WS_WO)) + (size_t)(l & 1) * D * D;
            pg8::gemm_phase(lds, Ap, Wp, D, S, E);
            int par = 0;
            for (int item = (int)blockIdx.x; item < 64; item += G, par ^= 1) { const bf16_t* B1[1] = {Wp + (size_t)item * 16 * D};
                skinny_item<1>(Ap + (size_t)MREAL * D, D, B1, D, wave, lane, lds, par, [&](const f32x4 (&a)[1], int fr, int quad) { const int col = item * 16 + fr;
#pragma unroll
                    for (int r = 0; r < 4; ++r) { const size_t row = (size_t)MREAL + 4 * quad + r; float h = E.H[row * D + col];
                        if (E.lg) h = (h - E.stats[2 * row]) * E.stats[2 * row + 1] * E.lg[col] + E.lb[col];
                        E.H[row * D + col] = h * ALPHA + a[0][r]; } });
            }
            SEAM(pb + 3); }
        for (int rep = 0; rep < (moe ? 1 : REPS(7)); ++rep) if (SITE(7) && RUN(pb + 4)) { IDS(); ln_phase(ws, nullptr, lds, gw, NGW, lane, tid, l * 2 + 0, false, moe, fi, false); SEAM(pb + 4); }
        if (!moe) {
            for (int rep = 0; rep < REPS(8); ++rep) if (SITE(8) && RUN(pb + 5)) {
                IDS();
                pg8::DenseOrder S; S.init(MREAL / 256, 2 * D_FF / 256, G, (int)blockIdx.x);
                EpiSwiglu E{(bf16_t*)(ws + WS_ACT), D_FF};
                const bf16_t* HBp = (const bf16_t*)(ws + WS_HB); const bf16_t* Wp = (const bf16_t*)(ws + WS_WGU) + (size_t)fi * 2 * D_FF * D;
                pg8::gemm_phase(lds, HBp, Wp, D, S, E);
                int par = 0;
                for (int item = (int)blockIdx.x; item < D_FF / 16; item += G, par ^= 1) {
                    const int brow = 256 * (item >> 3) + 16 * (item & 7); const bf16_t* B2[2] = {Wp + (size_t)brow * D, Wp + (size_t)(brow + 128) * D};
                    skinny_item<2>(HBp + (size_t)MREAL * D, D, B2, D, wave, lane, lds, par, [&](const f32x4 (&a)[2], int fr, int quad) {
#pragma unroll
                        for (int r = 0; r < 4; ++r) E.act[(size_t)(MREAL + 4 * quad + r) * D_FF + item * 16 + fr] = (bf16_t)f2bf(EpiSwiglu::silu_mul(a[0][r], a[1][r])); });
                }
                SEAM(pb + 5); }
            for (int rep = 0; rep < REPS(9); ++rep) if (SITE(9) && RUN(pb + 6)) {
                IDS();
                pg8::DenseOrder S; S.init(MREAL / 256, 4, G, (int)blockIdx.x);
                const float* smp = (const float*)(ws + WS_SMALL);
                EpiRes E{(float*)(ws + WS_H), (const float*)(ws + WS_STATS), smp + SM_LNG + (size_t)(2 * l) * D, smp + SM_LNB + (size_t)(2 * l) * D};
                const bf16_t* Ap = (const bf16_t*)(ws + WS_ACT); const bf16_t* Wp = (const bf16_t*)(ws + WS_WDN) + (size_t)fi * D * D_FF;
                pg8::gemm_phase(lds, Ap, Wp, D_FF, S, E);
                int par = 0;
                for (int item = (int)blockIdx.x; item < 64; item += G, par ^= 1) { const bf16_t* B1[1] = {Wp + (size_t)item * 16 * D_FF};
                    skinny_item<1>(Ap + (size_t)MREAL * D_FF, D_FF, B1, D_FF, wave, lane, lds, par, [&](const f32x4 (&a)[1], int fr, int quad) { const int col = item * 16 + fr;
#pragma unroll
                        for (int r = 0; r < 4; ++r) { const size_t row = (size_t)MREAL + 4 * quad + r; float h = E.H[row * D + col];
                            h = (h - E.stats[2 * row]) * E.stats[2 * row + 1] * E.lg[col] + E.lb[col];
                            E.H[row * D + col] = h * ALPHA + a[0][r]; } });
                }
                SEAM(pb + 6); }
        } else {
            for (int rep = 0; rep < REPS(10); ++rep) if (SITE(10) && RUN(pb + 5)) { IDS(); assign_phase(ws, gw, NGW, lane, tid, fi); SEAM(pb + 5); }
            for (int rep = 0; rep < REPS(11); ++rep) if (SITE(11) && RUN(pb + 6)) {
                IDS();
                int cnt[8]; pg8::GroupedOrder S; moe_starts(ws, fi, cnt, S.pstart);
                S.o.init(S.pstart[8], 2 * D_FF_EXP / 256, G, (int)blockIdx.x); S.nexp_rows = 2 * D_FF_EXP; S.rowtok = (const int*)(ws + WS_ROWTOK);
                EpiSwiglu E{(bf16_t*)(ws + WS_ACT), D_FF_EXP};
                pg8::gemm_phase(lds, (const bf16_t*)(ws + WS_HB), (const bf16_t*)(ws + WS_WGUE) + (size_t)fi * 8 * 2 * D_FF_EXP * D, D, S, E);
                SEAM(pb + 6); }
            for (int rep = 0; rep < REPS(12); ++rep) if (SITE(12) && RUN(pb + 7)) {
                IDS();
                int cnt[8]; pg8::GroupedOrder S; moe_starts(ws, fi, cnt, S.pstart);
                S.o.init(S.pstart[8], 4, G, (int)blockIdx.x); S.nexp_rows = D; S.rowtok = nullptr;
                EpiScatter E{(bf16_t*)(ws + WS_CONTRIB), (const int*)(ws + WS_ROWDST), (const float*)(ws + WS_ROWGATE)};
                pg8::gemm_phase(lds, (const bf16_t*)(ws + WS_ACT), (const bf16_t*)(ws + WS_WDNE) + (size_t)fi * 8 * D * D_FF_EXP, D_FF_EXP, S, E);
                SEAM(pb + 7); }
        }
        for (int rep = 0; rep < (moe ? 1 : REPS(13)); ++rep) if (SITE(13) && RUN(pb + 10)) { IDS(); ln_phase(ws, P.out, lds, gw, NGW, lane, tid, l * 2 + 1, moe, false, 0, l == 3); SEAM(pb + 10); }
    }
#undef RUN
#undef SEAM
#undef IDS
}

extern "C" void kernel_launch(void* const* d_in, const int* in_sizes, int n_in, void* d_out, int out_size, void* d_ws, size_t ws_size, hipStream_t stream) {
    static int grid = 0;
    if (grid == 0) {
        if (n_in != 18 || out_size != MREAL * D || ws_size < WS_END) { fprintf(stderr, "kernel_launch: unexpected shapes (n_in %d, out %d, ws %zu < %zu)\n", n_in, out_size, ws_size, (size_t)WS_END); grid = -1; return; }
        int dev = 0, cus = 0, per_cu = 0;
        if (hipGetDevice(&dev) != hipSuccess || hipDeviceGetAttribute(&cus, hipDeviceAttributeMultiprocessorCount, dev) != hipSuccess) { grid = -1; return; }
        if (hipFuncSetAttribute((const void*)fwd, hipFuncAttributeMaxDynamicSharedMemorySize, LDS_BYTES) != hipSuccess) { fprintf(stderr, "kernel_launch: hipFuncSetAttribute failed\n"); grid = -1; return; }
        if (hipOccupancyMaxActiveBlocksPerMultiprocessor(&per_cu, (const void*)fwd, NTHREADS, LDS_BYTES) != hipSuccess || per_cu < 1) fprintf(stderr, "kernel_launch: occupancy query reports %d\n", per_cu);
        (void)hipGetLastError();
        grid = cus > 256 ? 256 : cus;
    }
    if (grid < 0) return;
    (void)in_sizes;
    if (hipMemsetAsync((char*)d_ws + WS_CTL, 0, CTL_BYTES, stream) != hipSuccess) return;
    Params p{};
    for (int i = 0; i < 18; ++i) p.in[i] = (const float*)d_in[i];
    p.out = (float*)d_out; p.ws = (unsigned char*)d_ws;
#if MK_PER_PHASE
    int li = 0;
    for (int ph = 0; ph < N_PHASES; ++ph) {
        const int k = (ph - 1) % PH_PER_LAYER, l = (ph - 1) / PH_PER_LAYER;
        if (ph > 0) { const bool moe = l & 1; if (k == 2 && l >= 2) continue; if (k == 8 || k == 9 || k == 11) continue; if (k == 7 && !moe) continue; }
        p.ph_lo = ph; p.ph_hi = ph + 1; p.li = li++; p.pad = 0;
        hipLaunchKernelGGL(fwd, dim3(grid), dim3(NTHREADS), LDS_BYTES, stream, p);
    }
#else
    p.ph_lo = 0; p.ph_hi = N_PHASES; p.li = 0; p.pad = 0;
    hipLaunchKernelGGL(fwd, dim3(grid), dim3(NTHREADS), LDS_BYTES, stream, p);
#endif
}
```

```cpp
#include <hip/hip_runtime.h>
#include <cstdio>
#include <cstdint>

#define LAS __attribute__((address_space(3)))
#define GAS __attribute__((address_space(1)))
typedef unsigned short bf16_t;
typedef short bf16x8 __attribute__((ext_vector_type(8)));
typedef float f32x4 __attribute__((ext_vector_type(4)));
typedef float f32x2 __attribute__((ext_vector_type(2)));
typedef unsigned u32x4 __attribute__((ext_vector_type(4)));
typedef unsigned u32x2 __attribute__((ext_vector_type(2)));
typedef int i32x8 __attribute__((ext_vector_type(8)));

constexpr int D = 1024, NBATCH = 4, SEQ = 8192, NMETA = 16;
constexpr int MREAL = NBATCH * SEQ;
constexpr int MV = MREAL + NMETA;
constexpr int MP = 129 * 256;
constexpr int M_HEADS = 8, M_QK = 64, M_V = 128;
constexpr int M_IN = 3088, M_INP = 3328;
constexpr int PROJ_LD = 3072;
constexpr int A_HEADS = 16, A_KV = 4, A_HD = 64, WINDOW = 128;
constexpr int D_FF = 2816, N_EXP = 8, D_FF_EXP = 3584;
constexpr float ALPHA = 1.681792830507429f;
constexpr float LN_EPS = 1e-5f;
constexpr int RP = 265 * 256;
constexpr int NSEG = 8, SEG_CHUNKS = 16;
constexpr int ST_FLOATS = 8 * 5 * 64 * 4;

constexpr size_t MiB = 1u << 20;
constexpr size_t al(size_t x) { return (x + 4095) & ~(size_t)4095; }
constexpr size_t WS_CTL = 0, CTL_BYTES = 1 * MiB;
constexpr size_t WS_WIN = WS_CTL + CTL_BYTES;
constexpr size_t WS_WOUT = WS_WIN + al((size_t)2 * M_INP * D * 2);
constexpr size_t WS_WQKV = WS_WOUT + al((size_t)2 * D * D * 2);
constexpr size_t WS_WQ3 = WS_WQKV + al((size_t)1536 * D * 2);
constexpr size_t WS_WO = WS_WQ3 + al((size_t)D * D * 2);
constexpr size_t WS_WGU = WS_WO + al((size_t)2 * D * D * 2);
constexpr size_t WS_WDN = WS_WGU + al((size_t)2 * 2 * D_FF * D * 2);
constexpr size_t WS_WGUE = WS_WDN + al((size_t)2 * D * D_FF * 2);
constexpr size_t WS_WDNE = WS_WGUE + al((size_t)16 * 2 * D_FF_EXP * D * 2);
constexpr size_t WS_H = WS_WDNE + al((size_t)16 * D * D_FF_EXP * 2);
constexpr size_t WS_HB = WS_H + al((size_t)MP * D * 4);
constexpr size_t WS_PROJ = WS_HB + al((size_t)MP * D * 2);
constexpr size_t WS_HG = WS_PROJ + (size_t)MP * PROJ_LD * 2;
constexpr size_t WS_CONTRIB = WS_PROJ;
constexpr size_t WS_KB = WS_HG + al((size_t)MP * D * 2);
constexpr size_t WS_VB = WS_KB + al((size_t)MP * 256 * 2);
constexpr size_t WS_GATES = WS_VB + al((size_t)MP * 256 * 2);
constexpr size_t WS_ACT = WS_GATES + al((size_t)MP * 16 * 4);
constexpr size_t WS_STATE = WS_ACT + al((size_t)RP * D_FF_EXP * 2);
constexpr size_t WS_STSC = WS_STATE + al((size_t)32 * 7 * ST_FLOATS * 4);
constexpr size_t WS_ROPE = WS_STSC + al((size_t)32 * 7 * 4 * 4);
constexpr size_t WS_TOPE = WS_ROPE + al((size_t)8208 * 16 * 4);
constexpr size_t WS_TOPG = WS_TOPE + al((size_t)MP * 4);
constexpr size_t WS_ROWTOK = WS_TOPG + al((size_t)MP * 8);
constexpr size_t WS_ROWDST = WS_ROWTOK + al((size_t)RP * 4);
constexpr size_t WS_ROWGATE = WS_ROWDST + al((size_t)RP * 4);
constexpr size_t WS_HB8 = WS_ROWGATE + al((size_t)RP * 4);
constexpr size_t WS_WGUE8 = WS_HB8 + al((size_t)MP * D);
constexpr size_t WS_WDNE8 = WS_WGUE8 + al((size_t)16 * 2 * D_FF_EXP * D);
constexpr size_t WS_STATS = WS_WDNE8 + al((size_t)16 * D * D_FF_EXP);
constexpr size_t WS_SMALL = WS_STATS + al((size_t)MP * 8);
constexpr int SM_BGATE = 0, SM_SINKS = 32, SM_BROUTER = 64, SM_LNH = 128, SM_LNG = SM_LNH + 2 * D, SM_LNB = SM_LNG + 8 * D, SM_WROUTER = SM_LNB + 8 * D, SM_END = SM_WROUTER + 2 * D * N_EXP;
constexpr size_t WS_END = WS_SMALL + al((size_t)SM_END * 4);
static_assert((size_t)MP * 2 * D * 4 <= (WS_KB - WS_PROJ), "contrib overlay fits PROJ+HG");
static_assert(WS_END <= (size_t)1792 * MiB, "workspace map exceeds the guaranteed d_ws size");

constexpr int CW_CNT = 1024;
constexpr int CW_CUR = 1024 + 256;
constexpr int CW_BAR = 16384;

constexpr int LDS_BYTES = 163840 - 512;
constexpr int RING_BYTES = 131072;
constexpr int MISC_OFF = LDS_BYTES - 256;

__device__ __forceinline__ unsigned f2bf(float f) { unsigned u = __builtin_bit_cast(unsigned, f); return (u + 0x7fffu + ((u >> 16) & 1u)) >> 16; }
__device__ __forceinline__ unsigned pk2(float lo, float hi) { return f2bf(lo) | (f2bf(hi) << 16); }
__device__ __forceinline__ unsigned cvt_pk_bf16(float lo, float hi) { unsigned r; asm volatile("v_cvt_pk_bf16_f32 %0, %1, %2" : "=v"(r) : "v"(lo), "v"(hi)); return r; }
__device__ __forceinline__ float bf2f(unsigned short b) { return __builtin_bit_cast(float, ((unsigned)b) << 16); }
__device__ __forceinline__ float wave_sum(float v) {
#pragma unroll
    for (int o = 1; o < 64; o <<= 1) v += __shfl_xor(v, o);
    return v;
}
__device__ __forceinline__ float fast_exp(float x) { return __builtin_amdgcn_exp2f(x * 1.4426950408889634f); }
__device__ __forceinline__ unsigned pk4_fp8(float a, float b, float c, float d) {
    a = __builtin_amdgcn_fmed3f(a, -448.f, 448.f); b = __builtin_amdgcn_fmed3f(b, -448.f, 448.f); c = __builtin_amdgcn_fmed3f(c, -448.f, 448.f); d = __builtin_amdgcn_fmed3f(d, -448.f, 448.f);
    int p = __builtin_amdgcn_cvt_pk_fp8_f32(a, b, 0, false); p = __builtin_amdgcn_cvt_pk_fp8_f32(c, d, p, true); return (unsigned)p; }
constexpr float F8_SA = 16.f, F8_SB = 256.f, F8_INV = 1.f / (16.f * 256.f);
constexpr float F8_SACT = 8.f, F8_SBD = 1024.f, F8_INVD = 1.f / (8.f * 1024.f);
#define LDS_WAIT() asm volatile("s_waitcnt lgkmcnt(0)" ::: "memory")
#define VM_WAIT() asm volatile("s_waitcnt vmcnt(0)" ::: "memory")

#define XB_TMO      128
#define XB_XCNT(j)  (256  + 64 * (j))
#define XB_XSUB(j)  (1280 + 64 * (j))
#define XB_XGEN(j)  (2304 + 64 * (j))
#define XB_TOP      3328
#define XB_TOPGEN   3392
#define XCD_BAR_WORDS 3456
#define XB_SPIN_CAP (1u << 18)
__device__ __forceinline__ unsigned xb_ld(unsigned* p)              { return __hip_atomic_load(p, __ATOMIC_RELAXED, __HIP_MEMORY_SCOPE_AGENT); }
__device__ __forceinline__ unsigned xb_add(unsigned* p, unsigned v) { return __hip_atomic_fetch_add(p, v, __ATOMIC_RELAXED, __HIP_MEMORY_SCOPE_AGENT); }
__device__ __forceinline__ unsigned xb_xcc_id() { return (unsigned)__builtin_amdgcn_s_getreg((3 << 11) | 20) & 0xFu; }
#define XB_SPIN(cond, bar) do { unsigned _sp = 0; while (cond) { __builtin_amdgcn_s_sleep(1); \
    if ((++_sp & 255u) == 0u) { if (xb_ld(&(bar)[XB_TMO])) break; if (_sp > XB_SPIN_CAP) { atomicAdd(&(bar)[XB_TMO], 1u); break; } } } } while (0)
struct XcdBarrier { unsigned* bar; unsigned x; volatile LAS unsigned* st; };
__device__ __forceinline__ XcdBarrier xcd_barrier_post(unsigned* bar, volatile LAS unsigned* st) {
    XcdBarrier b; b.bar = bar; b.x = xb_xcc_id(); b.st = st;
    if (threadIdx.x == 0) (void)xb_add(&bar[XB_XCNT(b.x)], 1u);
    return b;
}
__device__ __forceinline__ void xcd_barrier_complete(unsigned* bar, unsigned x, unsigned& nloc, unsigned& nx) {
    const unsigned G = gridDim.x * gridDim.y * gridDim.z;
    unsigned sum, cnt, mine, sp = 0u;
    for (;;) {
        sum = 0u; cnt = 0u; mine = 0u;
#pragma unroll
        for (unsigned j = 0; j < 16; ++j) { const unsigned c = xb_ld(&bar[XB_XCNT(j)]); sum += c; cnt += (c > 0u) ? 1u : 0u; mine = (j == x) ? c : mine; }
        if (sum == G) break;
        __builtin_amdgcn_s_sleep(1);
        if ((++sp & 255u) == 0u) { if (xb_ld(&bar[XB_TMO])) break; if (sp > XB_SPIN_CAP) { atomicAdd(&bar[XB_TMO], 1u); break; } }
    }
    nloc = mine > 0u ? mine : 1u; nx = cnt > 0u ? cnt : 1u;
}
__device__ __forceinline__ void xcd_barrier(const XcdBarrier& b) {
    asm volatile("s_waitcnt vmcnt(0)" ::: "memory");
    __syncthreads();
    if (threadIdx.x == 0) {
        unsigned* bar = b.bar;
        __builtin_amdgcn_s_waitcnt(0);
        unsigned nloc = b.st[0], nx = b.st[1];
        if (nloc == 0u) { xcd_barrier_complete(bar, b.x, nloc, nx); b.st[0] = nloc; b.st[1] = nx; }
        const unsigned old = xb_add(&bar[XB_XSUB(b.x)], 1u);
        const unsigned gen = old / nloc;
        if (old + 1u == (gen + 1u) * nloc) {
            __builtin_amdgcn_fence(__ATOMIC_RELEASE, "agent");
            asm volatile("s_waitcnt vmcnt(0)" ::: "memory");
            const unsigned og = xb_add(&bar[XB_TOP], 1u);
            const unsigned tg = og / nx;
            if (og + 1u == (tg + 1u) * nx) xb_add(&bar[XB_TOPGEN], 1u);
            else XB_SPIN(xb_ld(&bar[XB_TOPGEN]) == tg, bar);
            __builtin_amdgcn_fence(__ATOMIC_ACQUIRE, "agent");
            xb_add(&bar[XB_XGEN(b.x)], 1u);
            asm volatile("s_waitcnt vmcnt(0)" ::: "memory");
        } else {
            XB_SPIN(xb_ld(&bar[XB_XGEN(b.x)]) == gen, bar);
            __builtin_amdgcn_fence(__ATOMIC_ACQUIRE, "agent");
            asm volatile("s_waitcnt vmcnt(0)" ::: "memory");
        }
    }
    __syncthreads();
}

namespace pg8 {
constexpr int BM = 256, BK = 64, HALF = 128, HTB = HALF * BK * 2, STAGE_BYTES = 8 * HTB, NXCD = 8, WGM = 8;
__host__ __device__ __forceinline__ int lds_byte(int r, int c) { const int st = (r >> 4) * 2 + (c >> 5), rr = r & 15, cc = c & 31, ob = rr * 64 + cc * 2; return st * 1024 + (ob ^ (((ob >> 9) & 1) << 5)); }
__host__ __device__ __forceinline__ void stage_rc(int b, int& R, int& C) { const int st = b / 1024, sb = b % 1024, swz = sb ^ (((sb >> 9) & 1) << 5); R = (st >> 1) * 16 + swz / 64; C = (st & 1) * 32 + (swz % 64) / 2; }
__host__ __device__ __forceinline__ int perm32(int rho) { const int n = rho >> 4, i = rho & 15; return 8 * (i >> 2) + 4 * n + (i & 3); }

struct Unit { int pm, pn, brow; };

struct DenseOrder {
    int nM, nN, nwg, G, c;
    __device__ void init(int nM_, int nN_, int G_, int c_) { nM = nM_; nN = nN_; nwg = nM * nN; G = G_; c = c_; }
    __device__ __forceinline__ bool next(int i, Unit& u) const {
        const long L = (long)i * G + c; if (L >= nwg) return false;
        int wgid = (int)L; { const int q = nwg / NXCD, r = nwg % NXCD, xcd = wgid % NXCD, off = wgid / NXCD; wgid = (xcd < r ? xcd * (q + 1) : r * (q + 1) + (xcd - r) * q) + off; }
        const int nig = WGM * nN, gid = wgid / nig, fm = gid * WGM, gsz = (nM - fm) < WGM ? (nM - fm) : WGM;
        u.pm = fm + ((wgid % nig) % gsz); u.pn = (wgid % nig) / gsz; u.brow = u.pn * BM; return true;
    }
    __device__ __forceinline__ int a_row(const Unit& u, int r) const { return u.pm * BM + r; }
};
struct GroupedOrder {
    DenseOrder o; int pstart[9]; int nexp_rows;
    const int* rowtok;
    __device__ __forceinline__ bool next(int i, Unit& u) const {
        if (!o.next(i, u)) return false;
        int e = 0;
#pragma unroll
        for (int k = 1; k < 8; ++k) e += (u.pm >= pstart[k]) ? 1 : 0;
        u.brow = e * nexp_rows + u.pn * BM; return true;
    }
    __device__ __forceinline__ int a_row(const Unit& u, int r) const {
        const int pos = u.pm * BM + r; if (!rowtok) return pos;
        const int t = rowtok[pos]; return t < 0 ? 0 : t;
    }
};

template <class Epi, class Sched, bool FP8 = false>
__device__ __forceinline__ void gemm_phase(LAS unsigned char* lds, const void* Abase, const void* Btbase, const int K, const Sched& S, const Epi& E) {
    constexpr int ES = FP8 ? 1 : 2;
    int tid = threadIdx.x; asm volatile("; opaque tid" : "+v"(tid));
    const int wid = __builtin_amdgcn_readfirstlane(tid >> 6), lane = tid & 63, wr = wid >> 2, wc = wid & 3, fr = lane & 15, fq = lane >> 4;
    const int nt = K * ES / 128;
    unsigned voffB[2];
#pragma unroll
    for (int i = 0; i < 2; ++i) { int R, C; stage_rc(tid * 16 + i * 8192, R, C); const int Rb = Epi::PERM ? ((R & ~31) + perm32(R & 31)) : R; voffB[i] = (unsigned)(Rb * K * ES + C * 2); }
    const size_t kstep = (size_t)128;
    const size_t hstep = (size_t)HALF * K * ES;
    const unsigned ldsw = (unsigned)wid * 1024u;
    const int aoff = FP8 ? lds_byte(wr * 64 + fr, 16 * (fq & 1)) + (fq >> 1) * 1024 : lds_byte(wr * 64 + fr, fq * 8);
    const int boff = FP8 ? lds_byte(wc * 32 + fr, 16 * (fq & 1)) + (fq >> 1) * 1024 : lds_byte(wc * 32 + fr, fq * 8);
#define PG8_SA(b, h) (((b) * 2 + (h)) * HTB)
#define PG8_SB(b, h) ((4 + (b) * 2 + (h)) * HTB)
#define PG8_STAGE(bufoff, gbase, voff) do { const char* _gb = (const char*)(gbase); asm volatile("" : "+s"(_gb)); _Pragma("unroll") for (int _i = 0; _i < 2; ++_i) \
        __builtin_amdgcn_global_load_lds((const unsigned*)(_gb + (voff)[_i]), (LAS unsigned*)(lds + (bufoff) + ldsw + _i * 8192), 16, 0, 0); } while (0)
#define PG8_LDA(dst, b, h) do { _Pragma("unroll") for (int m = 0; m < 4; ++m) _Pragma("unroll") for (int k = 0; k < 2; ++k) dst[m][k] = *(const LAS bf16x8*)(lds + PG8_SA(b, h) + aoff + m * 2048 + k * (FP8 ? 16 : 1024)); } while (0)
#define PG8_LDB(dst, b, h) do { _Pragma("unroll") for (int n = 0; n < 2; ++n) _Pragma("unroll") for (int k = 0; k < 2; ++k) dst[n][k] = *(const LAS bf16x8*)(lds + PG8_SB(b, h) + boff + n * 2048 + k * (FP8 ? 16 : 1024)); } while (0)
#define PG8_MMA(ai, bj, At, Bt) do { __builtin_amdgcn_s_setprio(1); _Pragma("unroll") for (int m = 0; m < 4; ++m) _Pragma("unroll") for (int n = 0; n < 2; ++n) { \
        if constexpr (FP8) { const u32x4 _b0 = __builtin_bit_cast(u32x4, Bt[n][0]), _b1 = __builtin_bit_cast(u32x4, Bt[n][1]), _a0 = __builtin_bit_cast(u32x4, At[m][0]), _a1 = __builtin_bit_cast(u32x4, At[m][1]); \
            const i32x8 _bv = {(int)_b0.x, (int)_b0.y, (int)_b0.z, (int)_b0.w, (int)_b1.x, (int)_b1.y, (int)_b1.z, (int)_b1.w}, _av = {(int)_a0.x, (int)_a0.y, (int)_a0.z, (int)_a0.w, (int)_a1.x, (int)_a1.y, (int)_a1.z, (int)_a1.w}; \
            acc[ai][bj][m][n] = __builtin_amdgcn_mfma_scale_f32_16x16x128_f8f6f4(_bv, _av, acc[ai][bj][m][n], 0, 0, 0, 0x7F7F7F7F, 0, 0x7F7F7F7F); } \
        else { _Pragma("unroll") for (int k = 0; k < 2; ++k) acc[ai][bj][m][n] = __builtin_amdgcn_mfma_f32_16x16x32_bf16(Bt[n][k], At[m][k], acc[ai][bj][m][n], 0, 0, 0); } } \
        __builtin_amdgcn_s_setprio(0); } while (0)
#define PG8_WAIT_V(n) asm volatile("s_waitcnt vmcnt(" #n ")" ::: "memory")
#define PG8_WAIT_L(n) asm volatile("s_waitcnt lgkmcnt(" #n ")" ::: "memory")
#define PG8_BAR __builtin_amdgcn_s_barrier()
#define PG8_SCHED __builtin_amdgcn_sched_barrier(0)
#define PG8_AOFF(dst, u) do { _Pragma("unroll") for (int _i = 0; _i < 2; ++_i) { int _R, _C; stage_rc(tid * 16 + _i * 8192, _R, _C); _Pragma("unroll") for (int _h = 0; _h < 2; ++_h) \
        dst[_h][_i] = (unsigned)((size_t)S.a_row(u, _h * HALF + _R) * K * ES + _C * 2); } } while (0)
    Unit cur, nxt; int ui = 0;
    if (!S.next(0, cur)) return;
    f32x4 acc[2][2][4][2];
#pragma unroll
    for (int a = 0; a < 2; ++a)
#pragma unroll
        for (int b = 0; b < 2; ++b)
#pragma unroll
            for (int m = 0; m < 4; ++m)
#pragma unroll
                for (int n = 0; n < 2; ++n) acc[a][b][m][n] = (f32x4){0.f, 0.f, 0.f, 0.f};
    bf16x8 At[4][2], B0[2][2], B1[2][2];
    unsigned cao[2][2];
    PG8_AOFF(cao, cur);
    const char* cA = (const char*)Abase; const char* cB = (const char*)Btbase + (size_t)cur.brow * K * ES;
    PG8_STAGE(PG8_SB(0, 0), cB, voffB); PG8_STAGE(PG8_SB(0, 1), cB + hstep, voffB); PG8_STAGE(PG8_SA(0, 0), cA, cao[0]); PG8_STAGE(PG8_SA(0, 1), cA, cao[1]);
    if (wr == 1) PG8_BAR;
    PG8_WAIT_V(2); PG8_BAR;
    PG8_STAGE(PG8_SB(1, 0), cB + kstep, voffB); PG8_STAGE(PG8_SA(1, 0), cA + kstep, cao[0]); PG8_STAGE(PG8_SB(1, 1), cB + hstep + kstep, voffB);
    PG8_WAIT_V(6); PG8_BAR;
    for (;;) {
        const bool has_next = S.next(ui + 1, nxt);
        const char* nB = has_next ? (const char*)Btbase + (size_t)nxt.brow * K * ES : cB;
        for (int t = 0; t < nt; t += 2) {
            const bool last = (t == nt - 2);
            const char* a1 = cA + (size_t)(t + 1) * kstep;
            const char* a2 = last ? cA : cA + (size_t)(t + 2) * kstep; const char* b2 = last ? nB : cB + (size_t)(t + 2) * kstep;
            const char* a3 = a2 + kstep; const char* b3 = b2 + kstep;
            PG8_LDB(B0, 0, 0); PG8_LDB(B1, 0, 1); PG8_SCHED; PG8_LDA(At, 0, 0); PG8_STAGE(PG8_SA(1, 1), a1, cao[1]);
            if (last && has_next) { PG8_AOFF(cao, nxt); }
            PG8_WAIT_V(8); PG8_WAIT_L(0); PG8_BAR; PG8_MMA(0, 0, At, B0); PG8_MMA(0, 1, At, B1); PG8_BAR; PG8_SCHED;
            PG8_LDA(At, 0, 1); PG8_STAGE(PG8_SB(0, 0), b2, voffB); PG8_STAGE(PG8_SB(0, 1), b2 + hstep, voffB); PG8_STAGE(PG8_SA(0, 0), a2, cao[0]);
            PG8_WAIT_V(8); PG8_WAIT_L(0); PG8_BAR; PG8_MMA(1, 0, At, B0); PG8_MMA(1, 1, At, B1); PG8_BAR; PG8_SCHED;
            PG8_LDB(B0, 1, 0); PG8_LDB(B1, 1, 1); PG8_SCHED; PG8_LDA(At, 1, 0); PG8_STAGE(PG8_SA(0, 1), a2, cao[1]);
            PG8_WAIT_V(8); PG8_WAIT_L(0); PG8_BAR; PG8_MMA(0, 0, At, B0); PG8_MMA(0, 1, At, B1); PG8_BAR; PG8_SCHED;
            PG8_LDA(At, 1, 1); PG8_STAGE(PG8_SB(1, 0), b3, voffB); PG8_STAGE(PG8_SB(1, 1), b3 + hstep, voffB); PG8_STAGE(PG8_SA(1, 0), a3, cao[0]);
            PG8_WAIT_V(8); PG8_WAIT_L(0); PG8_BAR; PG8_MMA(1, 0, At, B0); PG8_MMA(1, 1, At, B1); PG8_BAR; PG8_SCHED;
        }
        if (wr == 0) PG8_BAR;
#pragma unroll 1
        for (int er = 0; er < Epi::NREP; ++er) E(acc, cur, wr, wc, fr, fq);
        if (!has_next) break;
#pragma unroll
        for (int a = 0; a < 2; ++a)
#pragma unroll
            for (int b = 0; b < 2; ++b)
#pragma unroll
                for (int m = 0; m < 4; ++m)
#pragma unroll
                    for (int n = 0; n < 2; ++n) acc[a][b][m][n] = (f32x4){0.f, 0.f, 0.f, 0.f};
        cur = nxt; cB = nB; ++ui;
        if (wr == 1) PG8_BAR;
    }
    PG8_WAIT_V(0);
    PG8_BAR;
#undef PG8_SA
#undef PG8_SB
#undef PG8_STAGE
#undef PG8_LDA
#undef PG8_LDB
#undef PG8_MMA
#undef PG8_WAIT_V
#undef PG8_WAIT_L
#undef PG8_BAR
#undef PG8_SCHED
#undef PG8_AOFF
}
}

typedef f32x4 AccT[2][2][4][2];

struct EpiProj {
    static constexpr int NREP = 1; static constexpr bool PERM = true;
    bf16_t* proj; float* gates; const float* bgate;
    __device__ __forceinline__ void operator()(const AccT& acc, const pg8::Unit& u, int wr, int wc, int fr, int fq) const {
        const int row0 = u.pm * 256 + wr * 64 + fr;
        if (u.pn < 12) {
            const int col0 = u.pn * 256 + wc * 32 + 8 * fq;
#pragma unroll
            for (int ai = 0; ai < 2; ++ai)
#pragma unroll
                for (int m = 0; m < 4; ++m) { bf16_t* rowp = proj + (size_t)(row0 + ai * 128 + m * 16) * PROJ_LD + col0;
#pragma unroll
                    for (int bj = 0; bj < 2; ++bj) { const f32x4 v0 = acc[ai][bj][m][0], v1 = acc[ai][bj][m][1];
                        u32x4 w; w.x = cvt_pk_bf16(v0[0], v0[1]); w.y = cvt_pk_bf16(v0[2], v0[3]); w.z = cvt_pk_bf16(v1[0], v1[1]); w.w = cvt_pk_bf16(v1[2], v1[3]);
                        *(u32x4*)(rowp + bj * 128) = w; } }
        } else if (wc == 0 && fq < 2) {
#pragma unroll
            for (int n = 0; n < 2; ++n) { const f32x4 bv = *(const f32x4*)(bgate + 8 * fq + 4 * n);
#pragma unroll
                for (int ai = 0; ai < 2; ++ai)
#pragma unroll
                    for (int m = 0; m < 4; ++m) *(f32x4*)(gates + (size_t)(row0 + ai * 128 + m * 16) * 16 + 8 * fq + 4 * n) = acc[ai][0][m][n] + bv; }
        }
    }
};
struct EpiRes {
    static constexpr int NREP = 1; static constexpr bool PERM = false;
    float* H; const float* stats; const float* lg; const float* lb; const float* src;
    __device__ __forceinline__ void operator()(const AccT& acc, const pg8::Unit& u, int wr, int wc, int fr, int fq) const {
        const int row0 = u.pm * 256 + wr * 64 + fr, col0 = u.pn * 256 + wc * 32 + 4 * fq;
        f32x4 gv[2][2], bv[2][2];
        if (lg) {
#pragma unroll
            for (int bj = 0; bj < 2; ++bj)
#pragma unroll
                for (int n = 0; n < 2; ++n) { gv[bj][n] = *(const f32x4*)(lg + col0 + bj * 128 + n * 16); bv[bj][n] = *(const f32x4*)(lb + col0 + bj * 128 + n * 16); } }
#pragma unroll
        for (int ai = 0; ai < 2; ++ai)
#pragma unroll
            for (int m = 0; m < 4; ++m) { const int row = row0 + ai * 128 + m * 16; float* rowp = H + (size_t)row * D + col0; const float* srcp = src + (size_t)row * D + col0;
                f32x2 st = (f32x2){0.f, 1.f}; if (lg) st = *(const f32x2*)(stats + 2 * (size_t)row);
#pragma unroll
                for (int bj = 0; bj < 2; ++bj)
#pragma unroll
                    for (int n = 0; n < 2; ++n) { float* p = rowp + bj * 128 + n * 16; f32x4 h = *(const f32x4*)(srcp + bj * 128 + n * 16);
                        if (lg) h = (h - st.x) * st.y * gv[bj][n] + bv[bj][n];
                        *(f32x4*)p = h * ALPHA + acc[ai][bj][m][n]; } }
    }
};
struct EpiSwiglu {
    static constexpr int NREP = 1; static constexpr bool PERM = true;
    bf16_t* act; int ld; float sc;
    __device__ __forceinline__ static float silu_mul(float g, float u) { return g * u * __builtin_amdgcn_rcpf(1.0f + __builtin_amdgcn_exp2f(-g * 1.4426950408889634f)); }
    __device__ __forceinline__ void operator()(const AccT& acc, const pg8::Unit& u, int wr, int wc, int fr, int fq) const {
        const int row0 = u.pm * 256 + wr * 64 + fr, col0 = u.pn * 128 + wc * 32 + 8 * fq;
#pragma unroll
        for (int ai = 0; ai < 2; ++ai)
#pragma unroll
            for (int m = 0; m < 4; ++m) { const f32x4 g0 = acc[ai][0][m][0] * sc, g1 = acc[ai][0][m][1] * sc, u0 = acc[ai][1][m][0] * sc, u1 = acc[ai][1][m][1] * sc;
                u32x4 w; w.x = cvt_pk_bf16(silu_mul(g0[0], u0[0]), silu_mul(g0[1], u0[1])); w.y = cvt_pk_bf16(silu_mul(g0[2], u0[2]), silu_mul(g0[3], u0[3]));
                w.z = cvt_pk_bf16(silu_mul(g1[0], u1[0]), silu_mul(g1[1], u1[1])); w.w = cvt_pk_bf16(silu_mul(g1[2], u1[2]), silu_mul(g1[3], u1[3]));
                *(u32x4*)(act + (size_t)(row0 + ai * 128 + m * 16) * ld + col0) = w; }
    }
};
struct EpiSwiglu8 {
    static constexpr int NREP = 1; static constexpr bool PERM = true;
    unsigned char* act; int ld; float sc;
    __device__ __forceinline__ void operator()(const AccT& acc, const pg8::Unit& u, int wr, int wc, int fr, int fq) const {
        const int row0 = u.pm * 256 + wr * 64 + fr, col0 = u.pn * 128 + wc * 32 + 8 * fq;
#pragma unroll
        for (int ai = 0; ai < 2; ++ai)
#pragma unroll
            for (int m = 0; m < 4; ++m) { const f32x4 g0 = acc[ai][0][m][0] * sc, g1 = acc[ai][0][m][1] * sc, u0 = acc[ai][1][m][0] * sc, u1 = acc[ai][1][m][1] * sc;
                u32x2 w; w.x = pk4_fp8(EpiSwiglu::silu_mul(g0[0], u0[0]) * F8_SACT, EpiSwiglu::silu_mul(g0[1], u0[1]) * F8_SACT, EpiSwiglu::silu_mul(g0[2], u0[2]) * F8_SACT, EpiSwiglu::silu_mul(g0[3], u0[3]) * F8_SACT);
                w.y = pk4_fp8(EpiSwiglu::silu_mul(g1[0], u1[0]) * F8_SACT, EpiSwiglu::silu_mul(g1[1], u1[1]) * F8_SACT, EpiSwiglu::silu_mul(g1[2], u1[2]) * F8_SACT, EpiSwiglu::silu_mul(g1[3], u1[3]) * F8_SACT);
                *(u32x2*)(act + (size_t)(row0 + ai * 128 + m * 16) * ld + col0) = w; }
    }
};
struct EpiSwigluProbe : EpiSwiglu { static constexpr int NREP = 2; };
struct EpiScatter {
    static constexpr int NREP = 1; static constexpr bool PERM = true;
    bf16_t* contrib; const int* rowdst; const float* rowgate; float sc;
    __device__ __forceinline__ void operator()(const AccT& acc, const pg8::Unit& u, int wr, int wc, int fr, int fq) const {
        const int row0 = u.pm * 256 + wr * 64 + fr, col0 = u.pn * 256 + wc * 32 + 8 * fq;
#pragma unroll
        for (int ai = 0; ai < 2; ++ai)
#pragma unroll
            for (int m = 0; m < 4; ++m) { const int pos = row0 + ai * 128 + m * 16; const int d = rowdst[pos];
                if (d >= 0) { const float g = rowgate[pos] * sc; bf16_t* rowp = contrib + (size_t)d * D + col0;
#pragma unroll
                    for (int bj = 0; bj < 2; ++bj) { const f32x4 v0 = acc[ai][bj][m][0] * g, v1 = acc[ai][bj][m][1] * g;
                        u32x4 w; w.x = cvt_pk_bf16(v0[0], v0[1]); w.y = cvt_pk_bf16(v0[2], v0[3]); w.z = cvt_pk_bf16(v1[0], v1[1]); w.w = cvt_pk_bf16(v1[2], v1[3]);
                        *(u32x4*)(rowp + bj * 128) = w; } } }
    }
};
struct EpiQKV {
    static constexpr int NREP = 1; static constexpr bool PERM = true;
    bf16_t *Q, *KB, *VB; const float* rope;
    __device__ __forceinline__ void operator()(const AccT& acc, const pg8::Unit& u, int wr, int wc, int fr, int fq) const {
        const int row0 = u.pm * 256 + wr * 64 + fr, cl = wc * 32 + 8 * fq;
        bf16_t* base; int ld;
        if (u.pn == 5) {
#pragma unroll
            for (int ai = 0; ai < 2; ++ai)
#pragma unroll
                for (int m = 0; m < 4; ++m) { const int row = row0 + ai * 128 + m * 16;
#pragma unroll
                    for (int bj = 0; bj < 2; ++bj)
#pragma unroll
                        for (int n = 0; n < 2; ++n)
#pragma unroll
                            for (int j = 0; j < 4; ++j) VB[(size_t)(bj * 128 + cl + 4 * n + j) * MP + row] = (bf16_t)f2bf(acc[ai][bj][m][n][j]); }
            return; }
        if (u.pn < 4) { base = Q + u.pn * 256 + cl; ld = D; } else { base = KB + cl; ld = 256; }
        const bool dorope = (u.pn <= 4) && ((wc & 1) == 0);
#pragma unroll
        for (int ai = 0; ai < 2; ++ai)
#pragma unroll
            for (int m = 0; m < 4; ++m) { const int row = row0 + ai * 128 + m * 16;
                f32x4 v[2][2];
#pragma unroll
                for (int bj = 0; bj < 2; ++bj)
#pragma unroll
                    for (int n = 0; n < 2; ++n) v[bj][n] = acc[ai][bj][m][n];
                if (dorope) {
                    int pos = row < MREAL ? (row & (SEQ - 1)) + NMETA : row - MREAL; pos = pos > SEQ + NMETA - 1 ? SEQ + NMETA - 1 : pos;
                    const float* rp = rope + (size_t)pos * 16;
                    const f32x4 c0 = *(const f32x4*)rp, c1 = *(const f32x4*)(rp + 4), s0 = *(const f32x4*)(rp + 8), s1 = *(const f32x4*)(rp + 12);
#pragma unroll
                    for (int bj = 0; bj < 2; ++bj)
#pragma unroll
                        for (int n = 0; n < 2; ++n) { const f32x4 c = n ? c1 : c0, s = n ? s1 : s0; f32x4 o;
#pragma unroll
                            for (int j = 0; j < 4; ++j) { const float x = v[bj][n][j]; const float y = __shfl_xor(x, 16);
                                o[j] = fq == 0 ? x * c[j] - y * s[j] : (fq == 1 ? x * c[j] + y * s[j] : x); }
                            v[bj][n] = o; }
                }
#pragma unroll
                for (int bj = 0; bj < 2; ++bj) { const f32x4 v0 = v[bj][0], v1 = v[bj][1];
                    u32x4 w; w.x = cvt_pk_bf16(v0[0], v0[1]); w.y = cvt_pk_bf16(v0[2], v0[3]); w.z = cvt_pk_bf16(v1[0], v1[1]); w.w = cvt_pk_bf16(v1[2], v1[3]);
                    *(u32x4*)(base + (size_t)row * ld + bj * 128) = w; } }
    }
};

template <int NACC, class F>
__device__ __forceinline__ void skinny_item(const bf16_t* A, int lda, const bf16_t* (&Bt)[NACC], int K, int wave, int lane, LAS unsigned char* lds, int parity, const F& epi) {
    const int fr = lane & 15, quad = lane >> 4, kw = K >> 3;
    const bf16_t* ap = A + (size_t)fr * lda + wave * kw + 8 * quad;
    f32x4 acc[NACC];
#pragma unroll
    for (int i = 0; i < NACC; ++i) acc[i] = (f32x4){0.f, 0.f, 0.f, 0.f};
#pragma unroll 2
    for (int k = 0; k < kw; k += 32) { const bf16x8 a = *(const bf16x8*)(ap + k);
#pragma unroll
        for (int i = 0; i < NACC; ++i) acc[i] = __builtin_amdgcn_mfma_f32_16x16x32_bf16(a, *(const bf16x8*)(Bt[i] + (size_t)fr * K + wave * kw + 8 * quad + k), acc[i], 0, 0, 0); }
    LAS f32x4* red = (LAS f32x4*)(lds + parity * 16384);
#pragma unroll
    for (int i = 0; i < NACC; ++i) red[(wave * NACC + i) * 64 + lane] = acc[i];
    __syncthreads();
    if (wave == 0) {
#pragma unroll
        for (int i = 0; i < NACC; ++i) { f32x4 t = red[i * 64 + lane];
#pragma unroll
            for (int w = 1; w < 8; ++w) t += red[(w * NACC + i) * 64 + lane];
            acc[i] = t; }
        epi(acc, fr, quad);
    }
}

struct Params { const float* in[18]; float* out; unsigned char* ws; int ph_lo, ph_hi, li, pad; };
enum { I_X = 0, I_META, I_WIN, I_BGATE, I_LNH, I_WOUT, I_WKV, I_WQ, I_SINKS, I_WO, I_WGUD, I_WDND, I_WROUTER, I_BROUTER, I_WGUE, I_WDNE, I_LNG, I_LNB };
constexpr int NWAVES = 8, NTHREADS = 512;

template <bool F8 = false>
__device__ __forceinline__ void tr_item(const float* W, int Nsrc, int K, void* WTv, int k0, int n0, int drow0, float scale, int nvalid, LAS float* scr, int lane) {
    bf16_t* WT = (bf16_t*)WTv;
#pragma unroll 8
    for (int i = 0; i < 32; ++i) { const int kk = 2 * i + (lane >> 5), n = lane & 31; scr[kk * 33 + n] = (n < nvalid) ? W[(size_t)(k0 + kk) * Nsrc + n0 + n] * scale : 0.f; }
    LDS_WAIT(); asm volatile("" ::: "memory");
    const int c = lane & 7;
#pragma unroll
    for (int j = 0; j < 4; ++j) { const int n = (lane >> 3) + 8 * j; const LAS float* s = scr + (8 * c) * 33 + n;
        if constexpr (F8) { u32x2 o; o.x = pk4_fp8(s[0 * 33], s[1 * 33], s[2 * 33], s[3 * 33]); o.y = pk4_fp8(s[4 * 33], s[5 * 33], s[6 * 33], s[7 * 33]);
            if (n < nvalid) *(u32x2*)((unsigned char*)WTv + (size_t)(drow0 + n) * K + k0 + 8 * c) = o; }
        else { u32x4 o; o.x = pk2(s[0 * 33], s[1 * 33]); o.y = pk2(s[2 * 33], s[3 * 33]); o.z = pk2(s[4 * 33], s[5 * 33]); o.w = pk2(s[6 * 33], s[7 * 33]);
            if (n < nvalid) *(u32x4*)(WT + (size_t)(drow0 + n) * K + k0 + 8 * c) = o; } }
    LDS_WAIT(); asm volatile("" ::: "memory");
}
__device__ __forceinline__ int pair_row(int n, int FF) { const int up = n >= FF ? 1 : 0, j = n - up * FF; return 256 * (j >> 7) + 128 * up + (j & 127); }

__device__ __forceinline__ void p0_prologue(const Params& P, LAS unsigned char* lds, int gw, int NGW, int wave, int lane) {
    unsigned char* ws = P.ws;
    LAS float* scr = (LAS float*)(lds + wave * 16384);
    constexpr int IT0 = 16 * 97, IT1 = 16 * 32, IT2 = 16 * 16, IT5 = 16 * 176, IT6 = 44 * 32, IT7 = 16 * 224, IT8 = 56 * 32;
    constexpr int C0 = 2 * IT0, C1 = C0 + 2 * IT1, C2 = C1 + IT2, C3 = C2 + 2 * IT1, C4 = C3 + 2 * IT1, C5 = C4 + 2 * IT5, C6 = C5 + 2 * IT6, C7 = C6 + 16 * IT7, C8 = C7 + 16 * IT8;
    for (int it = gw; it < C8; it += NGW) {
        if (it < C0) { const int mi = it / IT0, r = it % IT0, kb = r / 97, nb = r % 97; const int n0 = nb * 32;
            tr_item(P.in[I_WIN] + (size_t)mi * D * M_IN, M_IN, D, (bf16_t*)(ws + WS_WIN) + (size_t)mi * M_INP * D, kb * 64, n0, n0, n0 < 512 ? 0.125f : 1.f, nb == 96 ? 16 : 32, scr, lane);
        } else if (it < C1) { const int q = it - C0, mi = q / IT1, r = q % IT1, kb = r / 32, nb = r % 32;
            tr_item(P.in[I_WOUT] + (size_t)mi * D * D, D, D, (bf16_t*)(ws + WS_WOUT) + (size_t)mi * D * D, kb * 64, nb * 32, nb * 32, 1.f, 32, scr, lane);
        } else if (it < C2) { const int r = it - C1, kb = r / 16, nb = r % 16;
            tr_item(P.in[I_WKV], 512, D, (bf16_t*)(ws + WS_WQKV), kb * 64, nb * 32, 1024 + nb * 32, 1.f, 32, scr, lane);
        } else if (it < C3) { const int q = it - C2, mi = q / IT1, r = q % IT1, kb = r / 32, nb = r % 32;
            tr_item(P.in[I_WQ] + (size_t)mi * D * D, D, D, (bf16_t*)(ws + (mi ? WS_WQ3 : WS_WQKV)), kb * 64, nb * 32, nb * 32, 0.125f, 32, scr, lane);
        } else if (it < C4) { const int q = it - C3, mi = q / IT1, r = q % IT1, kb = r / 32, nb = r % 32;
            tr_item(P.in[I_WO] + (size_t)mi * D * D, D, D, (bf16_t*)(ws + WS_WO) + (size_t)mi * D * D, kb * 64, nb * 32, nb * 32, 1.f, 32, scr, lane);
        } else if (it < C5) { const int q = it - C4, mi = q / IT5, r = q % IT5, kb = r / 176, nb = r % 176;
            tr_item(P.in[I_WGUD] + (size_t)mi * D * 2 * D_FF, 2 * D_FF, D, (bf16_t*)(ws + WS_WGU) + (size_t)mi * 2 * D_FF * D, kb * 64, nb * 32, pair_row(nb * 32, D_FF), 1.f, 32, scr, lane);
        } else if (it < C6) { const int q = it - C5, mi = q / IT6, r = q % IT6, kb = r / 32, nb = r % 32;
            tr_item(P.in[I_WDND] + (size_t)mi * D_FF * D, D, D_FF, (bf16_t*)(ws + WS_WDN) + (size_t)mi * D * D_FF, kb * 64, nb * 32, nb * 32, 1.f, 32, scr, lane);
        } else if (it < C7) { const int q = it - C6, mi = q / IT7, r = q % IT7, kb = r / 224, nb = r % 224;
            tr_item<true>(P.in[I_WGUE] + (size_t)mi * D * 2 * D_FF_EXP, 2 * D_FF_EXP, D, (ws + WS_WGUE8) + (size_t)mi * 2 * D_FF_EXP * D, kb * 64, nb * 32, pair_row(nb * 32, D_FF_EXP), F8_SB, 32, scr, lane);
        } else { const int q = it - C7, mi = q / IT8, r = q % IT8, kb = r / 32, nb = r % 32;
            tr_item<true>(P.in[I_WDNE] + (size_t)mi * D_FF_EXP * D, D, D_FF_EXP, (ws + WS_WDNE8) + (size_t)mi * D * D_FF_EXP, kb * 64, nb * 32, nb * 32, F8_SBD, 32, scr, lane);
        }
    }
    { float* sm = (float*)(ws + WS_SMALL); const int gt = gw * 64 + lane, NT = NGW * 64;
      for (int i = gt; i < SM_END; i += NT) { float v = 0.f;
          if (i < SM_SINKS) v = P.in[I_BGATE][i]; else if (i < SM_BROUTER) v = P.in[I_SINKS][i - SM_SINKS]; else if (i < SM_BROUTER + 16) v = P.in[I_BROUTER][i - SM_BROUTER];
          else if (i < SM_LNH) v = 0.f; else if (i < SM_LNG) v = P.in[I_LNH][i - SM_LNH]; else if (i < SM_LNB) v = P.in[I_LNG][i - SM_LNG]; else if (i < SM_WROUTER) v = P.in[I_LNB][i - SM_LNB]; else v = P.in[I_WROUTER][i - SM_WROUTER];
          sm[i] = v; } }
    { bf16_t* HB = (bf16_t*)(ws + WS_HB);
      const size_t gt = (size_t)gw * 64 + lane, NT = (size_t)NGW * 64;
      for (size_t i = gt; i < (size_t)MV * (D / 4); i += NT) { const size_t row = i >> 8; const int c4 = (int)(i & 255);
          const f32x4 v = row < MREAL ? ((const f32x4*)P.in[I_X])[i] : ((const f32x4*)P.in[I_META])[(row - MREAL) * 256 + c4];
          u32x2 w; w.x = pk2(v[0], v[1]); w.y = pk2(v[2], v[3]); ((u32x2*)HB)[i] = w; }
      float* rope = (float*)(ws + WS_ROPE);
      for (size_t i = gt; i < (size_t)(SEQ + NMETA) * 8; i += NT) { const int pos = (int)(i >> 3), fi = (int)(i & 7);
          const double invf = fi == 0 ? 1.0 : fi == 1 ? 0.19392274474868576 : fi == 2 ? 0.03760603093086393 : fi == 3 ? 0.007292664737217109 : fi == 4 ? 0.001414213562373095
                            : fi == 5 ? 0.0002742481756762073 : fi == 6 ? 5.318295896944988e-05 : 1.031338537721246e-05;
          const float angf = (float)pos * (float)invf;
          double a = (double)angf; a -= 6.283185307179586476925 * __builtin_rint(a * 0.15915494309189533577); const double hx = 0.5 * a, h2 = hx * hx;
          double sp = 1.0, cp = 1.0;
#pragma unroll
          for (int k = 12; k >= 1; --k) { sp = 1.0 - sp * h2 / (double)((2 * k) * (2 * k + 1)); cp = 1.0 - cp * h2 / (double)((2 * k - 1) * (2 * k)); }
          const double sh = hx * sp, ch = cp;
          rope[(size_t)pos * 16 + fi] = (float)(1.0 - 2.0 * sh * sh); rope[(size_t)pos * 16 + 8 + fi] = (float)(2.0 * sh * ch); }
    }
}

__device__ __forceinline__ void ln_phase(unsigned char* ws, float* outp, LAS unsigned char* lds, int gw, int NGW, int lane, int tid,
                                         int lnidx, bool moe_src, bool router, int moe_idx, bool final) {
    const float* sm = (const float*)(ws + WS_SMALL);
    float* H = (float*)(ws + WS_H); bf16_t* HB = (bf16_t*)(ws + WS_HB); const bf16_t* contrib = (const bf16_t*)(ws + WS_CONTRIB); float* stats = (float*)(ws + WS_STATS);
    const float* lg = sm + SM_LNG + (size_t)lnidx * D; const float* lb = sm + SM_LNB + (size_t)lnidx * D;
    f32x4 gv[4], bv[4];
#pragma unroll
    for (int j = 0; j < 4; ++j) { gv[j] = *(const f32x4*)(lg + 256 * j + 4 * lane); bv[j] = *(const f32x4*)(lb + 256 * j + 4 * lane); }
    LAS float* wr = (LAS float*)lds;
    volatile LAS unsigned* misc = (volatile LAS unsigned*)(lds + MISC_OFF);
    if (router) {
        const float* src = sm + SM_WROUTER + (size_t)moe_idx * D * N_EXP;
        for (int i = tid; i < D * N_EXP / 4; i += NTHREADS) ((LAS f32x4*)wr)[i] = ((const f32x4*)src)[i];
        if (tid < 8) misc[16 + tid] = 0u;
        __syncthreads();
    }
    int* tope = (int*)(ws + WS_TOPE); float* topg = (float*)(ws + WS_TOPG);
    const float* br = sm + SM_BROUTER + moe_idx * N_EXP;
    f32x4 nv[4]; u32x2 nc0[4], nc1[4]; f32x2 nst;
    auto fetch = [&](int row) {
        const f32x4* hr = (const f32x4*)(H + (size_t)row * D) + lane;
#pragma unroll
        for (int j = 0; j < 4; ++j) nv[j] = hr[64 * j];
        if (moe_src) { const u32x2* c0 = (const u32x2*)(contrib + (size_t)(2 * row) * D) + lane; const u32x2* c1 = c0 + 256;
#pragma unroll
            for (int j = 0; j < 4; ++j) { nc0[j] = c0[64 * j]; nc1[j] = c1[64 * j]; } }
        nst = *(const f32x2*)(stats + 2 * (size_t)row);
    };
    if (gw < MV) fetch(gw);
    for (int row = gw; row < MV; row += NGW) {
        f32x4 v[4], c0v[4], c1v[4]; const f32x2 st = nst;
#pragma unroll
        for (int j = 0; j < 4; ++j) { v[j] = nv[j];
            c0v[j] = (f32x4){__builtin_bit_cast(float, nc0[j].x << 16), __builtin_bit_cast(float, nc0[j].x & 0xffff0000u), __builtin_bit_cast(float, nc0[j].y << 16), __builtin_bit_cast(float, nc0[j].y & 0xffff0000u)};
            c1v[j] = (f32x4){__builtin_bit_cast(float, nc1[j].x << 16), __builtin_bit_cast(float, nc1[j].x & 0xffff0000u), __builtin_bit_cast(float, nc1[j].y << 16), __builtin_bit_cast(float, nc1[j].y & 0xffff0000u)}; }
        if (row + NGW < MV) fetch(row + NGW);
        if (moe_src) { const float* pg = lg - D; const float* pb = lb - D;
#pragma unroll
            for (int j = 0; j < 4; ++j) { const f32x4 g1 = *(const f32x4*)(pg + 256 * j + 4 * lane), b1 = *(const f32x4*)(pb + 256 * j + 4 * lane);
                v[j] = ((v[j] - st.x) * st.y * g1 + b1) * ALPHA + c0v[j] + c1v[j]; }
            if (!final) { f32x4* o = (f32x4*)(H + (size_t)row * D) + lane;
#pragma unroll
                for (int j = 0; j < 4; ++j) o[64 * j] = v[j]; } }
        float s = 0.f;
#pragma unroll
        for (int j = 0; j < 4; ++j) s += (v[j][0] + v[j][1]) + (v[j][2] + v[j][3]);
        const float mean = wave_sum(s) * (1.f / D); float s2 = 0.f;
#pragma unroll
        for (int j = 0; j < 4; ++j) { v[j] = v[j] - mean; s2 += (v[j][0] * v[j][0] + v[j][1] * v[j][1]) + (v[j][2] * v[j][2] + v[j][3] * v[j][3]); }
        const float rstd = 1.f / sqrtf(wave_sum(s2) * (1.f / D) + LN_EPS);
#pragma unroll
        for (int j = 0; j < 4; ++j) v[j] = v[j] * rstd * gv[j] + bv[j];
        if (final) { if (row < MREAL) { f32x4* o = (f32x4*)(outp + (size_t)row * D) + lane;
#pragma unroll
                for (int j = 0; j < 4; ++j) o[64 * j] = v[j]; } }
        else { if (lane == 0) *(f32x2*)(stats + 2 * (size_t)row) = (f32x2){mean, rstd};
            if (router) { unsigned* o8 = (unsigned*)(ws + WS_HB8 + (size_t)row * D) + lane;
#pragma unroll
                for (int j = 0; j < 4; ++j) o8[64 * j] = pk4_fp8(v[j][0] * F8_SA, v[j][1] * F8_SA, v[j][2] * F8_SA, v[j][3] * F8_SA); }
            else { u32x2* ob = (u32x2*)(HB + (size_t)row * D) + lane;
#pragma unroll
                for (int j = 0; j < 4; ++j) { u32x2 w; w.x = pk2(v[j][0], v[j][1]); w.y = pk2(v[j][2], v[j][3]); ob[64 * j] = w; } } }
        if (router) {
            float lg8[8];
#pragma unroll
            for (int e = 0; e < 8; ++e) lg8[e] = 0.f;
#pragma unroll
            for (int j = 0; j < 4; ++j)
#pragma unroll
                for (int c = 0; c < 4; ++c) { const LAS f32x4* w4 = (const LAS f32x4*)(wr + (size_t)(256 * j + 4 * lane + c) * 8); const f32x4 wa = w4[0], wb = w4[1]; const float x = v[j][c];
                    lg8[0] += x * wa[0]; lg8[1] += x * wa[1]; lg8[2] += x * wa[2]; lg8[3] += x * wa[3]; lg8[4] += x * wb[0]; lg8[5] += x * wb[1]; lg8[6] += x * wb[2]; lg8[7] += x * wb[3]; }
#pragma unroll
            for (int e = 0; e < 8; ++e) lg8[e] = wave_sum(lg8[e]) + br[e];
            int e1 = 0; float v1 = lg8[0];
#pragma unroll
            for (int e = 1; e < 8; ++e) if (lg8[e] > v1) { v1 = lg8[e]; e1 = e; }
            int e2 = -1; float v2 = -3.0e38f;
#pragma unroll
            for (int e = 0; e < 8; ++e) if (e != e1 && lg8[e] > v2) { v2 = lg8[e]; e2 = e; }
            const float ex = expf(v2 - v1), g1 = 1.f / (1.f + ex), g2 = ex / (1.f + ex);
            if (lane == 0) { tope[row] = e1 | (e2 << 8); topg[2 * row] = g1; topg[2 * row + 1] = g2;
                __hip_atomic_fetch_add((LAS unsigned*)&misc[16 + e1], 1u, __ATOMIC_RELAXED, __HIP_MEMORY_SCOPE_WORKGROUP);
                __hip_atomic_fetch_add((LAS unsigned*)&misc[16 + e2], 1u, __ATOMIC_RELAXED, __HIP_MEMORY_SCOPE_WORKGROUP); }
        }
    }
    if (router) { __syncthreads();
        if (tid < 8) __hip_atomic_fetch_add((unsigned*)(ws + WS_CTL) + CW_CNT + moe_idx * 64 + tid, misc[16 + tid], __ATOMIC_RELAXED, __HIP_MEMORY_SCOPE_AGENT);
        __syncthreads(); }
}

__device__ __forceinline__ void moe_starts(const unsigned char* ws, int moe_idx, int (&cnt)[8], int (&pstart)[9]) {
    const unsigned* c = (const unsigned*)(ws + WS_CTL) + CW_CNT + moe_idx * 64; int p = 0;
#pragma unroll
    for (int e = 0; e < 8; ++e) { cnt[e] = __builtin_amdgcn_readfirstlane((int)__hip_atomic_load(c + e, __ATOMIC_RELAXED, __HIP_MEMORY_SCOPE_AGENT)); pstart[e] = p; p += (cnt[e] + 255) >> 8; }
    pstart[8] = p;
}
__device__ __forceinline__ void assign_phase(unsigned char* ws, int gw, int NGW, int lane, int tid, int moe_idx) {
    int cnt[8], pstart[9]; moe_starts(ws, moe_idx, cnt, pstart);
    const int* tope = (const int*)(ws + WS_TOPE); const float* topg = (const float*)(ws + WS_TOPG);
    int* rowtok = (int*)(ws + WS_ROWTOK); int* rowdst = (int*)(ws + WS_ROWDST); float* rowgate = (float*)(ws + WS_ROWGATE);
    unsigned* cur = (unsigned*)(ws + WS_CTL) + CW_CUR + moe_idx * 64;
    for (int base = gw * 64; base < MV; base += NGW * 64) {
        const int row = base + lane; const bool valid = row < MV;
        const int te = valid ? tope[row] : 0xffff;
#pragma unroll
        for (int slot = 0; slot < 2; ++slot) {
            const int e = valid ? ((te >> (8 * slot)) & 255) : 255; int pos = -1;
#pragma unroll
            for (int ee = 0; ee < 8; ++ee) {
                const unsigned long long mask = __ballot(e == ee);
                if (mask) { const int n = __popcll(mask), leader = __ffsll((long long)mask) - 1; unsigned b0 = 0;
                    if (lane == leader) b0 = __hip_atomic_fetch_add(cur + ee, (unsigned)n, __ATOMIC_RELAXED, __HIP_MEMORY_SCOPE_AGENT);
                    b0 = __shfl(b0, leader);
                    if (e == ee) pos = pstart[ee] * 256 + (int)b0 + __popcll(mask & ((1ull << lane) - 1ull)); }
            }
            if (valid) { rowtok[pos] = row; rowdst[pos] = 2 * row + slot; rowgate[pos] = topg[2 * row + slot]; }
        }
    }
    if (blockIdx.x < 8) { const int e = blockIdx.x; int ps = 0, pe = 0, ce = 0;
#pragma unroll
        for (int ee = 0; ee < 8; ++ee) if (ee == e) { ps = pstart[ee]; pe = pstart[ee + 1]; ce = cnt[ee]; }
        for (int pos = ps * 256 + ce + tid; pos < pe * 256; pos += NTHREADS) { rowtok[pos] = -1; rowdst[pos] = -1; rowgate[pos] = 0.f; } }
}

constexpr int ML_RS = 72;
constexpr int ML_QS = 0, ML_KS = 9216, ML_KT = 18432, ML_PS = 27648, ML_VT = 36864, ML_CT = 57600, ML_HS = 78336, ML_SC = 112128;
constexpr int ML_HSS = 132;
constexpr int ML_TAB = 114688, ML_NCH = 17;
constexpr int ML_TSC = ML_TAB + 7 * ML_NCH * 64 * 4;
static_assert(ML_TSC + 1024 <= MISC_OFF, "mLSTM LDS");
__device__ __forceinline__ bf16x8 ml_frag(LAS unsigned char* lds, int base, int row, int kcol) { return *(const LAS bf16x8*)(lds + base + (row * ML_RS + kcol) * 2); }

template <int MODE>
__device__ __forceinline__ void mlstm_phase(unsigned char* ws, LAS unsigned char* lds, int layer, int tid, int wave, int lane) {
    const int item = blockIdx.x; const int bh = item >> 3, seg = item & 7, b = bh >> 3, h = bh & 7;
    if (MODE == 1 && seg == 7) return;
    const bf16_t* proj = (const bf16_t*)(ws + WS_PROJ); const float* gates = (const float*)(ws + WS_GATES);
    bf16_t* HG = (bf16_t*)(ws + WS_HG);
    float* STATE = (float*)(ws + WS_STATE); float* STSC = (float*)(ws + WS_STSC);
    LAS float* sc = (LAS float*)(lds + ML_SC);
    LAS float* tab = (LAS float*)(lds + ML_TAB); LAS float* tsc = (LAS float*)(lds + ML_TSC);
    const int fr = lane & 15, quad = lane >> 4;
    f32x4 st[5]; float zero = 0.f; asm volatile("; opaque zero" : "+v"(zero));
#pragma unroll
    for (int i = 0; i < 5; ++i) st[i] = (f32x4){zero, zero, zero, zero};
    float m0 = (MODE == 1) ? -1.0e30f : 0.f;
    const int nch = SEG_CHUNKS + (seg == 0 ? 1 : 0);
    auto chunk_rows = [&](int ci, int& rbase, int& nv) { if (seg == 0 && ci == 0) { rbase = MREAL; nv = NMETA; } else { const int c = seg * SEG_CHUNKS + ci - (seg == 0 ? 1 : 0); rbase = b * SEQ + c * 64; nv = 64; } };
    for (int i = tid; i < 16 * ML_RS; i += NTHREADS) ((LAS bf16_t*)(lds + ML_VT))[128 * ML_RS + i] = (i < ML_RS) ? (bf16_t)0x3F80 : (bf16_t)0;
    for (int ci = wave; ci < nch; ci += NWAVES) {
        int rbase, nv; chunk_rows(ci, rbase, nv); const bool ok = lane < nv;
        const float li = ok ? gates[(size_t)(rbase + lane) * 16 + h] : -1.0e30f, f = ok ? gates[(size_t)(rbase + lane) * 16 + 8 + h] : 0.f;
        const float lf = ok ? (fminf(f, 0.f) - logf(1.f + expf(-fabsf(f)))) : 0.f;
        float bc = lf;
#pragma unroll
        for (int o = 1; o < 64; o <<= 1) { const float t = __shfl_up(bc, o); if (lane >= o) bc += t; }
        const float u = li - bc; float pm = u;
#pragma unroll
        for (int o = 1; o < 64; o <<= 1) { const float t = __shfl_up(pm, o); if (lane >= o) pm = fmaxf(pm, t); }
        tab[(0 * ML_NCH + ci) * 64 + lane] = bc; tab[(1 * ML_NCH + ci) * 64 + lane] = u; tab[(2 * ML_NCH + ci) * 64 + lane] = pm;
        if (lane == 63) { tsc[ci] = bc; tsc[32 + ci] = pm; }
    }
    if (MODE == 2 && seg > 0) {
        m0 = -1.0e30f;
        for (int s2 = 0; s2 < seg; ++s2) {
            const float ms = STSC[(bh * 7 + s2) * 4 + 0], Gs = STSC[(bh * 7 + s2) * 4 + 1];
            const float mn = fmaxf(Gs + m0, ms), fo = fast_exp(Gs + m0 - mn), fn = fast_exp(ms - mn);
            const f32x4* sp = (const f32x4*)(STATE + (size_t)(bh * 7 + s2) * ST_FLOATS) + (wave * 5) * 64 + lane;
#pragma unroll
            for (int i = 0; i < 5; ++i) st[i] = st[i] * fo + sp[i * 64] * fn;
            m0 = mn;
        }
    }
#pragma unroll
    for (int i = 0; i < 5; ++i) { const int dv = (i < 4) ? 16 * wave + fr : 128 + fr, dk = (i < 4) ? 16 * i + 4 * quad : 16 * wave + 4 * quad;
        if (i < 4 || wave < 4) { u32x2 w; w.x = pk2(st[i][0], st[i][1]); w.y = pk2(st[i][2], st[i][3]); *(LAS u32x2*)(lds + ML_CT + (dv * ML_RS + dk) * 2) = w; } }
    __syncthreads();
    if (wave == 0) {
        const float bl = lane < nch ? tsc[lane] : 0.f, um = lane < nch ? tsc[32 + lane] : 0.f; float m = m0, gs = 0.f;
        for (int ci = 0; ci < nch; ++ci) { const float blast = __shfl(bl, ci), umax = __shfl(um, ci), amax = blast + umax, mn = fmaxf(blast + m, amax);
            if (lane == 0) { tsc[64 + ci] = m; tsc[96 + ci] = fast_exp(blast + m - mn); tsc[128 + ci] = fast_exp(amax - mn); }
            m = mn; gs += blast; }
        if (lane == 0) { tsc[160] = m; tsc[161] = gs; }
    }
    __syncthreads();
    for (int idx = tid; idx < nch * 64; idx += NTHREADS) { const int ci = idx >> 6, j = idx & 63;
        const float bc = tab[(0 * ML_NCH + ci) * 64 + j], u = tab[(1 * ML_NCH + ci) * 64 + j], pm = tab[(2 * ML_NCH + ci) * 64 + j], mc = tsc[64 + ci], MM = fmaxf(pm, mc);
        tab[(3 * ML_NCH + ci) * 64 + j] = MM; tab[(4 * ML_NCH + ci) * 64 + j] = fast_exp(mc - MM); tab[(5 * ML_NCH + ci) * 64 + j] = fast_exp(-(bc + MM));
        tab[(6 * ML_NCH + ci) * 64 + j] = tsc[128 + ci] * fast_exp(u - tsc[32 + ci]); }
    float lnh[16];
    if (MODE == 2) {
#pragma unroll
        for (int e = 0; e < 16; ++e) lnh[e] = ((const float*)(ws + WS_SMALL))[SM_LNH + layer * D + h * M_V + 16 * (tid & 7) + e]; }
    u32x4 rq, rk, rv0, rv1, rg0, rg1;
    auto load_chunk = [&](int ci) {
        int rbase, nv; chunk_rows(ci, rbase, nv);
        if (MODE == 2) { const int i = tid >> 3, sg = tid & 7; const u32x4* ogp = (const u32x4*)(proj + (size_t)(rbase + (i < nv ? i : 0)) * PROJ_LD + 2048 + h * M_V + 16 * sg); rg0 = ogp[0]; rg1 = ogp[1]; }
        { const int j = tid >> 3, c8 = (tid & 7) * 8; const bf16_t* rp = proj + (size_t)(rbase + j) * PROJ_LD + h * 64 + c8;
          rq = (MODE == 2 && j < nv) ? *(const u32x4*)rp : (u32x4){0u, 0u, 0u, 0u}; }
        { const bf16_t* rp = proj + (size_t)(rbase + lane) * PROJ_LD; const bool ok = lane < nv;
          rk = ok ? *(const u32x4*)(rp + 512 + h * 64 + 8 * wave) : (u32x4){0u, 0u, 0u, 0u};
          rv0 = ok ? *(const u32x4*)(rp + 1024 + h * 128 + 16 * wave) : (u32x4){0u, 0u, 0u, 0u}; rv1 = ok ? *(const u32x4*)(rp + 1024 + h * 128 + 16 * wave + 8) : (u32x4){0u, 0u, 0u, 0u}; }
    };
    load_chunk(0);
    __syncthreads();
    for (int ci = 0; ci < nch; ++ci) {
        int rbase, nv; chunk_rows(ci, rbase, nv);
        const u32x4 g0 = rg0, g1 = rg1;
        const LAS float* tU = tab + (1 * ML_NCH + ci) * 64; const LAS float* tMM = tab + (3 * ML_NCH + ci) * 64; const LAS float* tSI = tab + (4 * ML_NCH + ci) * 64;
        const LAS float* tFL = tab + (5 * ML_NCH + ci) * 64; const LAS float* tWP = tab + (6 * ML_NCH + ci) * 64;
        const float sold = tsc[96 + ci];
        { if (MODE == 2) { const int j = tid >> 3, c8 = (tid & 7) * 8; *(LAS u32x4*)(lds + ML_QS + (j * ML_RS + c8) * 2) = rq; }
          const float wj = tWP[lane]; LAS bf16_t* kt = (LAS bf16_t*)(lds + ML_KT); LAS bf16_t* vt = (LAS bf16_t*)(lds + ML_VT);
          if (MODE == 2) *(LAS u32x4*)(lds + ML_KS + (lane * ML_RS + 8 * wave) * 2) = rk;
          const unsigned kk[4] = {rk.x, rk.y, rk.z, rk.w}, a[4] = {rv0.x, rv0.y, rv0.z, rv0.w}, c[4] = {rv1.x, rv1.y, rv1.z, rv1.w};
#pragma unroll
          for (int e = 0; e < 4; ++e) { kt[(8 * wave + 2 * e) * ML_RS + lane] = (bf16_t)f2bf(bf2f((unsigned short)(kk[e] & 0xffffu)) * wj); kt[(8 * wave + 2 * e + 1) * ML_RS + lane] = (bf16_t)f2bf(bf2f((unsigned short)(kk[e] >> 16)) * wj);
              vt[(16 * wave + 2 * e) * ML_RS + lane] = (bf16_t)(a[e] & 0xffffu); vt[(16 * wave + 2 * e + 1) * ML_RS + lane] = (bf16_t)(a[e] >> 16);
              vt[(16 * wave + 8 + 2 * e) * ML_RS + lane] = (bf16_t)(c[e] & 0xffffu); vt[(16 * wave + 8 + 2 * e + 1) * ML_RS + lane] = (bf16_t)(c[e] >> 16); } }
        __syncthreads();
        if (ci + 1 < nch) load_chunk(ci + 1);
        f32x4 o1[4], o2[4];
        if (MODE == 2) {
            const int mt = wave >> 1;
#pragma unroll
            for (int q = 0; q < 2; ++q) { const int nt = 2 * (wave & 1) + q; f32x4 s = (f32x4){0.f, 0.f, 0.f, 0.f};
                if (nt <= mt) {
#pragma unroll
                    for (int ks = 0; ks < 2; ++ks) s = __builtin_amdgcn_mfma_f32_16x16x32_bf16(ml_frag(lds, ML_QS, 16 * mt + fr, 32 * ks + 8 * quad), ml_frag(lds, ML_KS, 16 * nt + fr, 32 * ks + 8 * quad), s, 0, 0, 0); }
                const int j = 16 * nt + fr; const float uj = tU[j];
#pragma unroll
                for (int r = 0; r < 4; ++r) { const int i = 16 * mt + 4 * quad + r; const float p = (j <= i) ? s[r] * fast_exp(uj - tMM[i]) : 0.f;
                    ((LAS bf16_t*)(lds + ML_PS))[i * ML_RS + j] = (bf16_t)f2bf(p); } }
            __syncthreads();
            bf16x8 vb[2], cb[2];
#pragma unroll
            for (int ks = 0; ks < 2; ++ks) { vb[ks] = ml_frag(lds, ML_VT, 16 * wave + fr, 32 * ks + 8 * quad); cb[ks] = ml_frag(lds, ML_CT, 16 * wave + fr, 32 * ks + 8 * quad); }
#pragma unroll
            for (int mt2 = 0; mt2 < 4; ++mt2) { o1[mt2] = (f32x4){0.f, 0.f, 0.f, 0.f}; o2[mt2] = (f32x4){0.f, 0.f, 0.f, 0.f};
#pragma unroll
                for (int ks = 0; ks < 2; ++ks) { o1[mt2] = __builtin_amdgcn_mfma_f32_16x16x32_bf16(ml_frag(lds, ML_PS, 16 * mt2 + fr, 32 * ks + 8 * quad), vb[ks], o1[mt2], 0, 0, 0);
                    o2[mt2] = __builtin_amdgcn_mfma_f32_16x16x32_bf16(ml_frag(lds, ML_QS, 16 * mt2 + fr, 32 * ks + 8 * quad), cb[ks], o2[mt2], 0, 0, 0); } }
            if (wave < 4) { f32x4 d1 = (f32x4){0.f, 0.f, 0.f, 0.f}, d2 = (f32x4){0.f, 0.f, 0.f, 0.f};
#pragma unroll
                for (int ks = 0; ks < 2; ++ks) { d1 = __builtin_amdgcn_mfma_f32_16x16x32_bf16(ml_frag(lds, ML_PS, 16 * wave + fr, 32 * ks + 8 * quad), ml_frag(lds, ML_VT, 128 + fr, 32 * ks + 8 * quad), d1, 0, 0, 0);
                    d2 = __builtin_amdgcn_mfma_f32_16x16x32_bf16(ml_frag(lds, ML_QS, 16 * wave + fr, 32 * ks + 8 * quad), ml_frag(lds, ML_CT, 128 + fr, 32 * ks + 8 * quad), d2, 0, 0, 0); }
                if (fr == 0) {
#pragma unroll
                    for (int r = 0; r < 4; ++r) { const int i = 16 * wave + 4 * quad + r; sc[320 + i] = d1[r] + tSI[i] * d2[r]; } } }
            __syncthreads();
#pragma unroll
            for (int mt2 = 0; mt2 < 4; ++mt2)
#pragma unroll
                for (int r = 0; r < 4; ++r) { const int i = 16 * mt2 + 4 * quad + r; const float num = o1[mt2][r] + tSI[i] * o2[mt2][r];
                    ((LAS float*)(lds + ML_HS))[i * ML_HSS + 16 * wave + fr] = num * __builtin_amdgcn_rcpf(fmaxf(fabsf(sc[320 + i]), tFL[i])); }
        }
        { bf16x8 vb[2];
#pragma unroll
          for (int ks = 0; ks < 2; ++ks) vb[ks] = ml_frag(lds, ML_VT, 16 * wave + fr, 32 * ks + 8 * quad);
#pragma unroll
          for (int mt2 = 0; mt2 < 4; ++mt2) { st[mt2] = st[mt2] * sold;
#pragma unroll
              for (int ks = 0; ks < 2; ++ks) st[mt2] = __builtin_amdgcn_mfma_f32_16x16x32_bf16(ml_frag(lds, ML_KT, 16 * mt2 + fr, 32 * ks + 8 * quad), vb[ks], st[mt2], 0, 0, 0); }
          if (wave < 4) { st[4] = st[4] * sold;
#pragma unroll
              for (int ks = 0; ks < 2; ++ks) st[4] = __builtin_amdgcn_mfma_f32_16x16x32_bf16(ml_frag(lds, ML_KT, 16 * wave + fr, 32 * ks + 8 * quad), ml_frag(lds, ML_VT, 128 + fr, 32 * ks + 8 * quad), st[4], 0, 0, 0); }
          if (MODE == 2) {
#pragma unroll
              for (int i = 0; i < 5; ++i) { const int dv = (i < 4) ? 16 * wave + fr : 128 + fr, dk = (i < 4) ? 16 * i + 4 * quad : 16 * wave + 4 * quad;
                  if (i < 4 || wave < 4) { u32x2 w; w.x = pk2(st[i][0], st[i][1]); w.y = pk2(st[i][2], st[i][3]); *(LAS u32x2*)(lds + ML_CT + (dv * ML_RS + dk) * 2) = w; } } }
        }
        __syncthreads();
        if (MODE == 2) {
            const int i = tid >> 3, sg = tid & 7; const LAS float* hp = (const LAS float*)(lds + ML_HS) + i * ML_HSS + 16 * sg;
            float x[16]; float s = 0.f;
#pragma unroll
            for (int e = 0; e < 16; ++e) { x[e] = hp[e]; s += x[e]; }
            s += __shfl_xor(s, 1); s += __shfl_xor(s, 2); s += __shfl_xor(s, 4);
            const float mean = s * (1.f / M_V); float q = 0.f;
#pragma unroll
            for (int e = 0; e < 16; ++e) { x[e] -= mean; q += x[e] * x[e]; }
            q += __shfl_xor(q, 1); q += __shfl_xor(q, 2); q += __shfl_xor(q, 4);
            const float rstd = 1.f / sqrtf(q * (1.f / M_V) + LN_EPS);
            if (i < nv && (nv == 64 || b == 0)) {
                const size_t row = (size_t)(rbase + i);
                const unsigned gw8[8] = {g0.x, g0.y, g0.z, g0.w, g1.x, g1.y, g1.z, g1.w}; unsigned ow[8];
#pragma unroll
                for (int e = 0; e < 8; ++e) { const float oga = bf2f((unsigned short)(gw8[e] & 0xffffu)), ogb = bf2f((unsigned short)(gw8[e] >> 16));
                    const float ya = x[2 * e] * rstd * lnh[2 * e] * __builtin_amdgcn_rcpf(1.f + fast_exp(-oga)), yb = x[2 * e + 1] * rstd * lnh[2 * e + 1] * __builtin_amdgcn_rcpf(1.f + fast_exp(-ogb));
                    ow[e] = pk2(ya, yb); }
                u32x4* op = (u32x4*)(HG + row * D + h * M_V + 16 * sg);
                op[0] = (u32x4){ow[0], ow[1], ow[2], ow[3]}; op[1] = (u32x4){ow[4], ow[5], ow[6], ow[7]};
            }
        }
    }
    if (MODE == 1) {
        f32x4* sp = (f32x4*)(STATE + (size_t)(bh * 7 + seg) * ST_FLOATS) + (wave * 5) * 64 + lane;
#pragma unroll
        for (int i = 0; i < 5; ++i) sp[i * 64] = (i < 4 || wave < 4) ? st[i] : (f32x4){0.f, 0.f, 0.f, 0.f};
        if (tid == 0) { STSC[(bh * 7 + seg) * 4 + 0] = tsc[160]; STSC[(bh * 7 + seg) * 4 + 1] = tsc[161]; }
    }
}

constexpr int AT_KRS = 72, AT_VRS = 280, AT_NK = 272;
constexpr int AT_KS = 0, AT_VT = AT_NK * AT_KRS * 2, AT_END = AT_VT + 64 * AT_VRS * 2;
static_assert(AT_END <= MISC_OFF, "attention LDS");
__device__ __forceinline__ void attn_phase(unsigned char* ws, LAS unsigned char* lds, int j_layer, int tid, int wave, int lane) {
    const bf16_t* Q = (const bf16_t*)(ws + WS_PROJ); const bf16_t* KB = (const bf16_t*)(ws + WS_KB); const bf16_t* VT = (const bf16_t*)(ws + WS_VB);
    bf16_t* HG = (bf16_t*)(ws + WS_HG);
    const float* sinks = (const float*)(ws + WS_SMALL) + SM_SINKS + j_layer * A_HEADS;
    const int fr = lane & 15, quad = lane >> 4;
    LAS bf16_t* ks = (LAS bf16_t*)(lds + AT_KS); LAS bf16_t* vt = (LAS bf16_t*)(lds + AT_VT);
    u32x4 kreg[5], vreg[5]; bf16x8 qn[4][2];
    const int NREG = NBATCH * A_KV * (SEQ / WINDOW), NIT = NREG + A_KV;
    auto prefetch = [&](int it) {
        const bool meta = it >= NREG; const int b = meta ? 0 : it >> 8, g = meta ? it - NREG : (it >> 6) & 3, blk = meta ? -1 : it & 63;
#pragma unroll
        for (int i = 0; i < 5; ++i) { const int p = tid + i * NTHREADS; kreg[i] = (u32x4){0u, 0u, 0u, 0u}; vreg[i] = (u32x4){0u, 0u, 0u, 0u};
            if (p < AT_NK * 8) { const int kk = p >> 3, c8 = (p & 7) * 8;
                int row; if (kk >= 256) row = MREAL + kk - 256; else { const int tk = (blk - 1) * WINDOW + kk; row = (tk < 0 || meta) ? -1 : b * SEQ + tk; }
                if (row >= 0) kreg[i] = *(const u32x4*)(KB + (size_t)row * 256 + g * 64 + c8);
                const int d = p / 34, pc = p % 34; const bf16_t* src = VT + (size_t)(g * 64 + d) * MP;
                if (pc >= 32) vreg[i] = *(const u32x4*)(src + MREAL + (pc - 32) * 8);
                else { const int tk = (blk - 1) * WINDOW + pc * 8; if (tk >= 0 && !meta) vreg[i] = *(const u32x4*)(src + (size_t)b * SEQ + tk); } } }
    };
    auto qload = [&](int it, int mt) {
        const bool meta = it >= NREG; const int b = it >> 8, g = meta ? it - NREG : (it >> 6) & 3, blk = it & 63, qh = g * 4 + (wave >> 1);
        const size_t rowq = meta ? (size_t)MREAL + fr : (size_t)b * SEQ + blk * WINDOW + 16 * (4 * (wave & 1) + mt) + fr;
#pragma unroll
        for (int k2 = 0; k2 < 2; ++k2) qn[mt][k2] = *(const bf16x8*)(Q + rowq * D + qh * 64 + 32 * k2 + 8 * quad);
    };
    if ((int)blockIdx.x < NIT) { prefetch(blockIdx.x);
#pragma unroll
        for (int mt = 0; mt < 4; ++mt) qload(blockIdx.x, mt); }
    for (int it = blockIdx.x; it < NIT; it += gridDim.x) {
        const bool meta = it >= NREG; const int b = it >> 8, g = meta ? it - NREG : (it >> 6) & 3, blk = it & 63;
        __syncthreads();
#pragma unroll
        for (int i = 0; i < 5; ++i) { const int p = tid + i * NTHREADS;
            if (p < AT_NK * 8) { *(LAS u32x4*)(ks + (p >> 3) * AT_KRS + (p & 7) * 8) = kreg[i]; *(LAS u32x4*)(vt + (p / 34) * AT_VRS + (p % 34) * 8) = vreg[i]; } }
        __syncthreads();
        const bool has_next = it + (int)gridDim.x < NIT;
        if (has_next) prefetch(it + gridDim.x);
        const int qh = g * 4 + (wave >> 1); const float sink = sinks[qh];
#pragma unroll
        for (int mt = 0; mt < 4; ++mt) {
            if (meta && (mt > 0 || (wave & 1))) continue;
            const int t0 = meta ? 0 : 4 * (wave & 1) + mt, qi = 16 * t0 + fr;
            const size_t rowq = meta ? (size_t)MREAL + fr : (size_t)b * SEQ + blk * WINDOW + qi;
            f32x4 s[10];
#pragma unroll
            for (int c = 0; c < 10; ++c) { const int kb = (c < 9) ? 16 * (t0 + c) : 256; s[c] = (f32x4){0.f, 0.f, 0.f, 0.f};
#pragma unroll
                for (int k2 = 0; k2 < 2; ++k2) s[c] = __builtin_amdgcn_mfma_f32_16x16x32_bf16(*(const LAS bf16x8*)(ks + (kb + fr) * AT_KRS + 32 * k2 + 8 * quad), qn[mt][k2], s[c], 0, 0, 0); }
            if (has_next) qload(it + gridDim.x, mt);
            float m = sink;
#pragma unroll
            for (int c = 0; c < 9; ++c)
#pragma unroll
                for (int r = 0; r < 4; ++r) { const int j = 16 * (t0 + c) + 4 * quad + r, rel = qi + WINDOW - j; const bool vis = !meta && (rel >= 0) && (rel < WINDOW) && (blk > 0 || j >= WINDOW);
                    s[c][r] = vis ? s[c][r] : -1.0e30f; m = fmaxf(m, s[c][r]); }
#pragma unroll
            for (int r = 0; r < 4; ++r) { const bool vis = !meta || (4 * quad + r <= fr); s[9][r] = vis ? s[9][r] : -1.0e30f; m = fmaxf(m, s[9][r]); }
            m = fmaxf(m, __shfl_xor(m, 16)); m = fmaxf(m, __shfl_xor(m, 32));
            float sm = 0.f;
#pragma unroll
            for (int c = 0; c < 10; ++c)
#pragma unroll
                for (int r = 0; r < 4; ++r) { const float p = fast_exp(s[c][r] - m); s[c][r] = p; sm += p; }
            sm += __shfl_xor(sm, 16); sm += __shfl_xor(sm, 32);
            const float inv = 1.f / (sm + fast_exp(sink - m));
            f32x4 o[4];
#pragma unroll
            for (int dt = 0; dt < 4; ++dt) o[dt] = (f32x4){0.f, 0.f, 0.f, 0.f};
#pragma unroll
            for (int u = 0; u < 5; ++u) {
                const int kb0 = 16 * (t0 + 2 * u), kb1 = (u < 4) ? 16 * (t0 + 2 * u + 1) : 256;
                u32x4 pw; pw.x = cvt_pk_bf16(s[2 * u][0], s[2 * u][1]); pw.y = cvt_pk_bf16(s[2 * u][2], s[2 * u][3]); pw.z = cvt_pk_bf16(s[2 * u + 1][0], s[2 * u + 1][1]); pw.w = cvt_pk_bf16(s[2 * u + 1][2], s[2 * u + 1][3]);
                const bf16x8 pf = __builtin_bit_cast(bf16x8, pw);
#pragma unroll
                for (int dt = 0; dt < 4; ++dt) { const LAS bf16_t* vr = vt + (16 * dt + fr) * AT_VRS + 4 * quad;
                    u32x4 vw; const u32x2 a = *(const LAS u32x2*)(vr + kb0), c2 = *(const LAS u32x2*)(vr + kb1); vw.x = a.x; vw.y = a.y; vw.z = c2.x; vw.w = c2.y;
                    o[dt] = __builtin_amdgcn_mfma_f32_16x16x32_bf16(__builtin_bit_cast(bf16x8, vw), pf, o[dt], 0, 0, 0); } }
#pragma unroll
            for (int dt = 0; dt < 4; ++dt) { u32x2 w; w.x = cvt_pk_bf16(o[dt][0] * inv, o[dt][1] * inv); w.y = cvt_pk_bf16(o[dt][2] * inv, o[dt][3] * inv);
                *(u32x2*)(HG + rowq * D + qh * 64 + 16 * dt + 4 * quad) = w; }
        }
    }
}

#ifndef SITES
#define SITES 0xFFFF
#endif
#define SITE(n) ((SITES >> (n)) & 1)
#ifndef DUPMASK
#define DUPMASK 0
#endif
#define REPS(n) (1 + ((DUPMASK >> (n)) & 1))
#ifndef MK_PER_PHASE
#define MK_PER_PHASE 0
#endif
constexpr int PH_PER_LAYER = 12, N_PHASES = 1 + 4 * PH_PER_LAYER;

__global__ void __launch_bounds__(NTHREADS, 2) fwd(Params P) {
    extern __shared__ __attribute__((aligned(16))) unsigned char lds_raw[];
    LAS unsigned char* const lds0 = (LAS unsigned char*)lds_raw;
    const int G = gridDim.x;
    const int vcu = (G % 8 == 0) ? ((int)blockIdx.x % 8) * (G / 8) + (int)blockIdx.x / 8 : (int)blockIdx.x;
    const int NGW = G * NWAVES;
    unsigned char* const wsbase = P.ws;
    volatile LAS unsigned* misc = (volatile LAS unsigned*)(lds0 + MISC_OFF);
    if (threadIdx.x < 64) misc[threadIdx.x] = 0u;
    __syncthreads();
    XcdBarrier bar = xcd_barrier_post((unsigned*)(wsbase + WS_CTL) + CW_BAR + P.li * 4096, misc + 8);
    const int lo = P.ph_lo, hi = P.ph_hi;
#define RUN(idx) ((idx) >= lo && (idx) < hi)
#define SEAM(idx) do { if ((idx) + 1 < hi) xcd_barrier(bar); } while (0)
#define IDS() int tid = threadIdx.x; asm volatile("; opaque tid" : "+v"(tid)); unsigned char* ws = wsbase; asm volatile("; opaque ws" : "+s"(ws)); \
              LAS unsigned char* lds = lds0; asm volatile("; opaque lds" : "+s"(lds)); \
              const int lane = tid & 63, wave = __builtin_amdgcn_readfirstlane(tid >> 6); const int gw = vcu * NWAVES + wave; (void)lane; (void)gw; (void)ws

    for (int rep = 0; rep < REPS(0); ++rep) if (SITE(0) && RUN(0)) { IDS(); p0_prologue(P, lds, gw, NGW, wave, lane); SEAM(0); }

    for (int l = 0; l < 4; ++l) {
        const int pb = 1 + l * PH_PER_LAYER;
        const bool moe = (l & 1) != 0; const int fi = l >> 1;
        if (l < 2) {
            for (int rep = 0; rep < REPS(1); ++rep) if (SITE(1) && RUN(pb + 0)) {
                IDS();
                pg8::DenseOrder S; S.init(MREAL / 256, 12, G, (int)blockIdx.x);
                EpiProj E{(bf16_t*)(ws + WS_PROJ), (float*)(ws + WS_GATES), (const float*)(ws + WS_SMALL) + SM_BGATE + l * 16};
                const bf16_t* HBp = (const bf16_t*)(ws + WS_HB); const bf16_t* Wp = (const bf16_t*)(ws + WS_WIN) + (size_t)l * M_INP * D;
                pg8::gemm_phase(lds, HBp, Wp, D, S, E);
                bf16_t* PROJ = (bf16_t*)(ws + WS_PROJ); float* GATES = (float*)(ws + WS_GATES); const float* bg = (const float*)(ws + WS_SMALL) + SM_BGATE + l * 16;
                int par = 0;
                for (int item = (int)blockIdx.x; item < 192; item += G, par ^= 1) { const bf16_t* B1[1] = {Wp + (size_t)item * 16 * D};
                    skinny_item<1>(HBp + (size_t)MREAL * D, D, B1, D, wave, lane, lds, par, [&](const f32x4 (&a)[1], int fr, int quad) {
#pragma unroll
                        for (int r = 0; r < 4; ++r) PROJ[(size_t)(MREAL + 4 * quad + r) * PROJ_LD + item * 16 + fr] = (bf16_t)f2bf(a[0][r]); }); }
                { const int fr = lane & 15, quad = lane >> 4; const bf16_t* bp = Wp + (size_t)(3072 + fr) * D + 8 * quad; const float bias = bg[fr];
                  for (int rt = gw; rt < MV / 16; rt += NGW) { const bf16_t* ap = HBp + (size_t)(rt * 16 + fr) * D + 8 * quad;
                      f32x4 a0 = (f32x4){0.f, 0.f, 0.f, 0.f}, a1 = (f32x4){0.f, 0.f, 0.f, 0.f};
#pragma unroll 8
                      for (int k = 0; k < D; k += 64) { a0 = __builtin_amdgcn_mfma_f32_16x16x32_bf16(*(const bf16x8*)(ap + k), *(const bf16x8*)(bp + k), a0, 0, 0, 0);
                          a1 = __builtin_amdgcn_mfma_f32_16x16x32_bf16(*(const bf16x8*)(ap + k + 32), *(const bf16x8*)(bp + k + 32), a1, 0, 0, 0); }
#pragma unroll
                      for (int r = 0; r < 4; ++r) GATES[(size_t)(rt * 16 + 4 * quad + r) * 16 + fr] = a0[r] + a1[r] + bias; } }
                SEAM(pb + 0); }
            for (int rep = 0; rep < REPS(2); ++rep) if (SITE(2) && RUN(pb + 1)) { IDS(); mlstm_phase<1>(ws, lds, l, tid, wave, lane); SEAM(pb + 1); }
            for (int rep = 0; rep < REPS(3); ++rep) if (SITE(3) && RUN(pb + 2)) { IDS(); mlstm_phase<2>(ws, lds, l, tid, wave, lane); SEAM(pb + 2); }
        } else {
            for (int rep = 0; rep < REPS(4); ++rep) if (SITE(4) && RUN(pb + 0)) {
                IDS();
                pg8::DenseOrder S; S.init(MREAL / 256, l == 2 ? 6 : 4, G, (int)blockIdx.x);
                EpiQKV E{(bf16_t*)(ws + WS_PROJ), (bf16_t*)(ws + WS_KB), (bf16_t*)(ws + WS_VB), (const float*)(ws + WS_ROPE)};
                const bf16_t* HBp = (const bf16_t*)(ws + WS_HB); const bf16_t* Wp = (const bf16_t*)(ws + (l == 2 ? WS_WQKV : WS_WQ3));
                pg8::gemm_phase(lds, HBp, Wp, D, S, E);
                bf16_t* Qp = (bf16_t*)(ws + WS_PROJ); bf16_t* KBp = (bf16_t*)(ws + WS_KB); bf16_t* VTp = (bf16_t*)(ws + WS_VB); const float* rope = (const float*)(ws + WS_ROPE);
                int par = 0;
                for (int item = (int)blockIdx.x; item < (l == 2 ? 96 : 64); item += G, par ^= 1) { const bf16_t* B1[1] = {Wp + (size_t)item * 16 * D};
                    skinny_item<1>(HBp + (size_t)MREAL * D, D, B1, D, wave, lane, lds, par, [&](const f32x4 (&a)[1], int fr, int quad) {
                        const int col = item * 16 + fr; const bool dorope = (item < 80) && ((item & 3) == 0);
#pragma unroll
                        for (int r = 0; r < 4; ++r) { const int pos = 4 * quad + r; float x = a[0][r]; const float y = __shfl_xor(x, 8);
                            if (dorope) { const float c = rope[pos * 16 + (fr & 7)], sn = rope[pos * 16 + 8 + (fr & 7)]; x = (fr < 8) ? x * c - y * sn : x * c + y * sn; }
                            const bf16_t o = (bf16_t)f2bf(x); const size_t row = (size_t)MREAL + pos;
                            if (item < 64) Qp[row * D + col] = o; else if (item < 80) KBp[row * 256 + col - 1024] = o; else VTp[(size_t)(col - 1280) * MP + row] = o; } });
                }
                SEAM(pb + 0); }
            for (int rep = 0; rep < REPS(5); ++rep) if (SITE(5) && RUN(pb + 1)) { IDS(); attn_phase(ws, lds, l - 2, tid, wave, lane); SEAM(pb + 1); }
        }
        for (int rep = 0; rep < REPS(6); ++rep) if (SITE(6) && RUN(pb + 3)) {
            IDS();
            pg8::DenseOrder S; S.init(MREAL / 256, 4, G, (int)blockIdx.x);
            const float* smp = (const float*)(ws + WS_SMALL);
            EpiRes E{(float*)(ws + WS_H), (const float*)(ws + WS_STATS), l > 0 ? smp + SM_LNG + (size_t)(2 * l - 1) * D : nullptr, smp + SM_LNB + (size_t)(l > 0 ? 2 * l - 1 : 0) * D, l > 0 ? (const float*)(ws + WS_H) : P.in[I_X]};
            const bf16_t* Ap = (const bf16_t*)(ws + WS_HG); const bf16_t* Wp = (const bf16_t*)(ws + (l < 2 ? WS_WOUT : WS_WO)) + (size_t)(l & 1) * D * D;
            pg8::gemm_phase(lds, Ap, Wp, D, S, E);
            int par = 0;
            for (int item = (int)blockIdx.x; item < 64; item += G, par ^= 1) { const bf16_t* B1[1] = {Wp + (size_t)item * 16 * D};
                skinny_item<1>(Ap + (size_t)MREAL * D, D, B1, D, wave, lane, lds, par, [&](const f32x4 (&a)[1], int fr, int quad) { const int col = item * 16 + fr;
#pragma unroll
                    for (int r = 0; r < 4; ++r) { const size_t row = (size_t)MREAL + 4 * quad + r; float h = E.lg ? E.H[row * D + col] : P.in[I_META][(size_t)(4 * quad + r) * D + col];
                        if (E.lg) h = (h - E.stats[2 * row]) * E.stats[2 * row + 1] * E.lg[col] + E.lb[col];
                        E.H[row * D + col] = h * ALPHA + a[0][r]; } });
            }
            SEAM(pb + 3); }
        for (int rep = 0; rep < (moe ? 1 : REPS(7)); ++rep) if (SITE(7) && RUN(pb + 4)) { IDS(); ln_phase(ws, nullptr, lds, gw, NGW, lane, tid, l * 2 + 0, false, moe, fi, false); SEAM(pb + 4); }
        if (!moe) {
            for (int rep = 0; rep < REPS(8); ++rep) if (SITE(8) && RUN(pb + 5)) {
                IDS();
                pg8::DenseOrder S; S.init(MREAL / 256, 2 * D_FF / 256, G, (int)blockIdx.x);
                EpiSwiglu E{(bf16_t*)(ws + WS_ACT), D_FF, 1.f};
                const bf16_t* HBp = (const bf16_t*)(ws + WS_HB); const bf16_t* Wp = (const bf16_t*)(ws + WS_WGU) + (size_t)fi * 2 * D_FF * D;
                pg8::gemm_phase(lds, HBp, Wp, D, S, E);
                int par = 0;
                for (int item = (int)blockIdx.x; item < D_FF / 16; item += G, par ^= 1) {
                    const int brow = 256 * (item >> 3) + 16 * (item & 7); const bf16_t* B2[2] = {Wp + (size_t)brow * D, Wp + (size_t)(brow + 128) * D};
                    skinny_item<2>(HBp + (size_t)MREAL * D, D, B2, D, wave, lane, lds, par, [&](const f32x4 (&a)[2], int fr, int quad) {
#pragma unroll
                        for (int r = 0; r < 4; ++r) E.act[(size_t)(MREAL + 4 * quad + r) * D_FF + item * 16 + fr] = (bf16_t)f2bf(EpiSwiglu::silu_mul(a[0][r], a[1][r])); });
                }
                SEAM(pb + 5); }
            for (int rep = 0; rep < REPS(9); ++rep) if (SITE(9) && RUN(pb + 6)) {
                IDS();
                pg8::DenseOrder S; S.init(MREAL / 256, 4, G, (int)blockIdx.x);
                const float* smp = (const float*)(ws + WS_SMALL);
                EpiRes E{(float*)(ws + WS_H), (const float*)(ws + WS_STATS), smp + SM_LNG + (size_t)(2 * l) * D, smp + SM_LNB + (size_t)(2 * l) * D, (const float*)(ws + WS_H)};
                const bf16_t* Ap = (const bf16_t*)(ws + WS_ACT); const bf16_t* Wp = (const bf16_t*)(ws + WS_WDN) + (size_t)fi * D * D_FF;
                pg8::gemm_phase(lds, Ap, Wp, D_FF, S, E);
                int par = 0;
                for (int item = (int)blockIdx.x; item < 64; item += G, par ^= 1) { const bf16_t* B1[1] = {Wp + (size_t)item * 16 * D_FF};
                    skinny_item<1>(Ap + (size_t)MREAL * D_FF, D_FF, B1, D_FF, wave, lane, lds, par, [&](const f32x4 (&a)[1], int fr, int quad) { const int col = item * 16 + fr;
#pragma unroll
                        for (int r = 0; r < 4; ++r) { const size_t row = (size_t)MREAL + 4 * quad + r; float h = E.H[row * D + col];
                            h = (h - E.stats[2 * row]) * E.stats[2 * row + 1] * E.lg[col] + E.lb[col];
                            E.H[row * D + col] = h * ALPHA + a[0][r]; } });
                }
                SEAM(pb + 6); }
        } else {
            for (int rep = 0; rep < REPS(10); ++rep) if (SITE(10) && RUN(pb + 5)) { IDS(); assign_phase(ws, gw, NGW, lane, tid, fi); SEAM(pb + 5); }
            for (int rep = 0; rep < REPS(11); ++rep) if (SITE(11) && RUN(pb + 6)) {
                IDS();
                int cnt[8]; pg8::GroupedOrder S; moe_starts(ws, fi, cnt, S.pstart);
                S.o.init(S.pstart[8], 2 * D_FF_EXP / 256, G, (int)blockIdx.x); S.nexp_rows = 2 * D_FF_EXP; S.rowtok = (const int*)(ws + WS_ROWTOK);
                EpiSwiglu8 E{ws + WS_ACT, D_FF_EXP, F8_INV};
                pg8::gemm_phase<EpiSwiglu8, pg8::GroupedOrder, true>(lds, ws + WS_HB8, ws + WS_WGUE8 + (size_t)fi * 8 * 2 * D_FF_EXP * D, D, S, E);
                SEAM(pb + 6); }
            for (int rep = 0; rep < REPS(12); ++rep) if (SITE(12) && RUN(pb + 7)) {
                IDS();
                int cnt[8]; pg8::GroupedOrder S; moe_starts(ws, fi, cnt, S.pstart);
                S.o.init(S.pstart[8], 4, G, (int)blockIdx.x); S.nexp_rows = D; S.rowtok = nullptr;
                EpiScatter E{(bf16_t*)(ws + WS_CONTRIB), (const int*)(ws + WS_ROWDST), (const float*)(ws + WS_ROWGATE), F8_INVD};
                pg8::gemm_phase<EpiScatter, pg8::GroupedOrder, true>(lds, ws + WS_ACT, ws + WS_WDNE8 + (size_t)fi * 8 * D * D_FF_EXP, D_FF_EXP, S, E);
                SEAM(pb + 7); }
        }
        for (int rep = 0; rep < (moe ? 1 : REPS(13)); ++rep) if (SITE(13) && RUN(pb + 10)) { IDS(); ln_phase(ws, P.out, lds, gw, NGW, lane, tid, l * 2 + 1, moe, false, 0, l == 3); SEAM(pb + 10); }
    }
#undef RUN
#undef SEAM
#undef IDS
}

extern "C" void kernel_launch(void* const* d_in, const int* in_sizes, int n_in, void* d_out, int out_size, void* d_ws, size_t ws_size, hipStream_t stream) {
    static int grid = 0;
    if (grid == 0) {
        if (n_in != 18 || out_size != MREAL * D || ws_size < WS_END) { fprintf(stderr, "kernel_launch: unexpected shapes (n_in %d, out %d, ws %zu < %zu)\n", n_in, out_size, ws_size, (size_t)WS_END); grid = -1; return; }
        int dev = 0, cus = 0, per_cu = 0;
        if (hipGetDevice(&dev) != hipSuccess || hipDeviceGetAttribute(&cus, hipDeviceAttributeMultiprocessorCount, dev) != hipSuccess) { grid = -1; return; }
        if (hipFuncSetAttribute((const void*)fwd, hipFuncAttributeMaxDynamicSharedMemorySize, LDS_BYTES) != hipSuccess) { fprintf(stderr, "kernel_launch: hipFuncSetAttribute failed\n"); grid = -1; return; }
        if (hipOccupancyMaxActiveBlocksPerMultiprocessor(&per_cu, (const void*)fwd, NTHREADS, LDS_BYTES) != hipSuccess || per_cu < 1) fprintf(stderr, "kernel_launch: occupancy query reports %d\n", per_cu);
        (void)hipGetLastError();
        grid = cus > 256 ? 256 : cus;
    }
    if (grid < 0) return;
    (void)in_sizes;
    if (hipMemsetAsync((char*)d_ws + WS_CTL, 0, CTL_BYTES, stream) != hipSuccess) return;
    Params p{};
    for (int i = 0; i < 18; ++i) p.in[i] = (const float*)d_in[i];
    p.out = (float*)d_out; p.ws = (unsigned char*)d_ws;
#if MK_PER_PHASE
    int li = 0;
    for (int ph = 0; ph < N_PHASES; ++ph) {
        const int k = (ph - 1) % PH_PER_LAYER, l = (ph - 1) / PH_PER_LAYER;
        if (ph > 0) { const bool moe = l & 1; if (k == 2 && l >= 2) continue; if (k == 8 || k == 9 || k == 11) continue; if (k == 7 && !moe) continue; }
        p.ph_lo = ph; p.ph_hi = ph + 1; p.li = li++; p.pad = 0;
        hipLaunchKernelGGL(fwd, dim3(grid), dim3(NTHREADS), LDS_BYTES, stream, p);
    }
#else
    p.ph_lo = 0; p.ph_hi = N_PHASES; p.li = 0; p.pad = 0;
    hipLaunchKernelGGL(fwd, dim3(grid), dim3(NTHREADS), LDS_BYTES, stream, p);
#endif
}
```

```cpp
#include <hip/hip_runtime.h>
#include <cstdio>
#include <cstdint>

#define LAS __attribute__((address_space(3)))
#define GAS __attribute__((address_space(1)))
typedef unsigned short bf16_t;
typedef short bf16x8 __attribute__((ext_vector_type(8)));
typedef float f32x4 __attribute__((ext_vector_type(4)));
typedef float f32x2 __attribute__((ext_vector_type(2)));
typedef unsigned u32x4 __attribute__((ext_vector_type(4)));
typedef unsigned u32x2 __attribute__((ext_vector_type(2)));
typedef int i32x8 __attribute__((ext_vector_type(8)));

constexpr int D = 1024, NBATCH = 4, SEQ = 8192, NMETA = 16;
constexpr int MREAL = NBATCH * SEQ;
constexpr int MV = MREAL + NMETA;
constexpr int MP = 129 * 256;
constexpr int M_HEADS = 8, M_QK = 64, M_V = 128;
constexpr int M_IN = 3088, M_INP = 3328;
constexpr int PROJ_LD = 3072;
constexpr int A_HEADS = 16, A_KV = 4, A_HD = 64, WINDOW = 128;
constexpr int D_FF = 2816, N_EXP = 8, D_FF_EXP = 3584;
constexpr float ALPHA = 1.681792830507429f;
constexpr float LN_EPS = 1e-5f;
constexpr int RP = 265 * 256;
constexpr int NSEG = 8, SEG_CHUNKS = 16;
constexpr int ST_FLOATS = 8 * 5 * 64 * 4;

constexpr size_t MiB = 1u << 20;
constexpr size_t al(size_t x) { return (x + 4095) & ~(size_t)4095; }
constexpr size_t WS_CTL = 0, CTL_BYTES = 1 * MiB;
constexpr size_t WS_WIN = WS_CTL + CTL_BYTES;
constexpr size_t WS_WOUT = WS_WIN + al((size_t)2 * M_INP * D * 2);
constexpr size_t WS_WQKV = WS_WOUT + al((size_t)2 * D * D * 2);
constexpr size_t WS_WQ3 = WS_WQKV + al((size_t)1536 * D * 2);
constexpr size_t WS_WO = WS_WQ3 + al((size_t)D * D * 2);
constexpr size_t WS_WGU = WS_WO + al((size_t)2 * D * D * 2);
constexpr size_t WS_WDN = WS_WGU + al((size_t)2 * 2 * D_FF * D * 2);
constexpr size_t WS_WGUE = WS_WDN + al((size_t)2 * D * D_FF * 2);
constexpr size_t WS_WDNE = WS_WGUE + al((size_t)16 * 2 * D_FF_EXP * D * 2);
constexpr size_t WS_H = WS_WDNE + al((size_t)16 * D * D_FF_EXP * 2);
constexpr size_t WS_HB = WS_H + al((size_t)MP * D * 4);
constexpr size_t WS_PROJ = WS_HB + al((size_t)MP * D * 2);
constexpr size_t WS_HG = WS_PROJ + (size_t)MP * PROJ_LD * 2;
constexpr size_t WS_CONTRIB = WS_PROJ;
constexpr size_t WS_KB = WS_HG + al((size_t)MP * D * 2);
constexpr size_t WS_VB = WS_KB + al((size_t)MP * 256 * 2);
constexpr size_t WS_GATES = WS_VB + al((size_t)MP * 256 * 2);
constexpr size_t WS_ACT = WS_GATES + al((size_t)MP * 16 * 4);
constexpr size_t WS_STATE = WS_ACT + al((size_t)RP * D_FF_EXP * 2);
constexpr size_t WS_STSC = WS_STATE + al((size_t)32 * 7 * ST_FLOATS * 4);
constexpr size_t WS_ROPE = WS_STSC + al((size_t)32 * 7 * 4 * 4);
constexpr size_t WS_TOPE = WS_ROPE + al((size_t)8208 * 16 * 4);
constexpr size_t WS_TOPG = WS_TOPE + al((size_t)MP * 4);
constexpr size_t WS_ROWTOK = WS_TOPG + al((size_t)MP * 8);
constexpr size_t WS_ROWDST = WS_ROWTOK + al((size_t)RP * 4);
constexpr size_t WS_ROWGATE = WS_ROWDST + al((size_t)RP * 4);
constexpr size_t WS_HB8 = WS_ROWGATE + al((size_t)RP * 4);
constexpr size_t WS_WGUE8 = WS_HB8 + al((size_t)MP * D);
constexpr size_t WS_WDNE8 = WS_WGUE8 + al((size_t)16 * 2 * D_FF_EXP * D);
constexpr size_t WS_WDN8 = WS_WDNE8 + al((size_t)16 * D * D_FF_EXP);
constexpr size_t WS_STATS = WS_WDN8 + al((size_t)2 * D * D_FF);
constexpr size_t WS_SMALL = WS_STATS + al((size_t)MP * 8);
constexpr int SM_BGATE = 0, SM_SINKS = 32, SM_BROUTER = 64, SM_LNH = 128, SM_LNG = SM_LNH + 2 * D, SM_LNB = SM_LNG + 8 * D, SM_WROUTER = SM_LNB + 8 * D, SM_END = SM_WROUTER + 2 * D * N_EXP;
constexpr size_t WS_END = WS_SMALL + al((size_t)SM_END * 4);
static_assert((size_t)MP * 2 * D * 4 <= (WS_KB - WS_PROJ), "contrib overlay fits PROJ+HG");
static_assert(WS_END <= (size_t)1792 * MiB, "workspace map exceeds the guaranteed d_ws size");

constexpr int CW_CNT = 1024;
constexpr int CW_CUR = 1024 + 256;
constexpr int CW_BAR = 16384;

constexpr int LDS_BYTES = 163840 - 512;
constexpr int RING_BYTES = 131072;
constexpr int MISC_OFF = LDS_BYTES - 256;

__device__ __forceinline__ unsigned f2bf(float f) { unsigned u = __builtin_bit_cast(unsigned, f); return (u + 0x7fffu + ((u >> 16) & 1u)) >> 16; }
__device__ __forceinline__ unsigned pk2(float lo, float hi) { return f2bf(lo) | (f2bf(hi) << 16); }
__device__ __forceinline__ unsigned cvt_pk_bf16(float lo, float hi) { unsigned r; asm volatile("v_cvt_pk_bf16_f32 %0, %1, %2" : "=v"(r) : "v"(lo), "v"(hi)); return r; }
__device__ __forceinline__ float bf2f(unsigned short b) { return __builtin_bit_cast(float, ((unsigned)b) << 16); }
__device__ __forceinline__ float wave_sum(float v) {
#pragma unroll
    for (int o = 1; o < 64; o <<= 1) v += __shfl_xor(v, o);
    return v;
}
__device__ __forceinline__ float fast_exp(float x) { return __builtin_amdgcn_exp2f(x * 1.4426950408889634f); }
__device__ __forceinline__ unsigned pk4_fp8(float a, float b, float c, float d) {
    a = __builtin_amdgcn_fmed3f(a, -448.f, 448.f); b = __builtin_amdgcn_fmed3f(b, -448.f, 448.f); c = __builtin_amdgcn_fmed3f(c, -448.f, 448.f); d = __builtin_amdgcn_fmed3f(d, -448.f, 448.f);
    int p = __builtin_amdgcn_cvt_pk_fp8_f32(a, b, 0, false); p = __builtin_amdgcn_cvt_pk_fp8_f32(c, d, p, true); return (unsigned)p; }
constexpr float F8_SA = 16.f, F8_SB = 256.f, F8_INV = 1.f / (16.f * 256.f);
constexpr float F8_SACT = 8.f, F8_SBD = 1024.f, F8_INVD = 1.f / (8.f * 1024.f);
#define LDS_WAIT() asm volatile("s_waitcnt lgkmcnt(0)" ::: "memory")
#define VM_WAIT() asm volatile("s_waitcnt vmcnt(0)" ::: "memory")

#define XB_TMO      128
#define XB_XCNT(j)  (256  + 64 * (j))
#define XB_XSUB(j)  (1280 + 64 * (j))
#define XB_XGEN(j)  (2304 + 64 * (j))
#define XB_TOP      3328
#define XB_TOPGEN   3392
#define XCD_BAR_WORDS 3456
#define XB_SPIN_CAP (1u << 18)
__device__ __forceinline__ unsigned xb_ld(unsigned* p)              { return __hip_atomic_load(p, __ATOMIC_RELAXED, __HIP_MEMORY_SCOPE_AGENT); }
__device__ __forceinline__ unsigned xb_add(unsigned* p, unsigned v) { return __hip_atomic_fetch_add(p, v, __ATOMIC_RELAXED, __HIP_MEMORY_SCOPE_AGENT); }
__device__ __forceinline__ unsigned xb_xcc_id() { return (unsigned)__builtin_amdgcn_s_getreg((3 << 11) | 20) & 0xFu; }
#define XB_SPIN(cond, bar) do { unsigned _sp = 0; while (cond) { __builtin_amdgcn_s_sleep(1); \
    if ((++_sp & 255u) == 0u) { if (xb_ld(&(bar)[XB_TMO])) break; if (_sp > XB_SPIN_CAP) { atomicAdd(&(bar)[XB_TMO], 1u); break; } } } } while (0)
struct XcdBarrier { unsigned* bar; unsigned x; volatile LAS unsigned* st; };
__device__ __forceinline__ XcdBarrier xcd_barrier_post(unsigned* bar, volatile LAS unsigned* st) {
    XcdBarrier b; b.bar = bar; b.x = xb_xcc_id(); b.st = st;
    if (threadIdx.x == 0) (void)xb_add(&bar[XB_XCNT(b.x)], 1u);
    return b;
}
__device__ __forceinline__ void xcd_barrier_complete(unsigned* bar, unsigned x, unsigned& nloc, unsigned& nx) {
    const unsigned G = gridDim.x * gridDim.y * gridDim.z;
    unsigned sum, cnt, mine, sp = 0u;
    for (;;) {
        sum = 0u; cnt = 0u; mine = 0u;
#pragma unroll
        for (unsigned j = 0; j < 16; ++j) { const unsigned c = xb_ld(&bar[XB_XCNT(j)]); sum += c; cnt += (c > 0u) ? 1u : 0u; mine = (j == x) ? c : mine; }
        if (sum == G) break;
        __builtin_amdgcn_s_sleep(1);
        if ((++sp & 255u) == 0u) { if (xb_ld(&bar[XB_TMO])) break; if (sp > XB_SPIN_CAP) { atomicAdd(&bar[XB_TMO], 1u); break; } }
    }
    nloc = mine > 0u ? mine : 1u; nx = cnt > 0u ? cnt : 1u;
}
__device__ __forceinline__ void xcd_barrier(const XcdBarrier& b) {
    asm volatile("s_waitcnt vmcnt(0)" ::: "memory");
    __syncthreads();
    if (threadIdx.x == 0) {
        unsigned* bar = b.bar;
        __builtin_amdgcn_s_waitcnt(0);
        unsigned nloc = b.st[0], nx = b.st[1];
        if (nloc == 0u) { xcd_barrier_complete(bar, b.x, nloc, nx); b.st[0] = nloc; b.st[1] = nx; }
        const unsigned old = xb_add(&bar[XB_XSUB(b.x)], 1u);
        const unsigned gen = old / nloc;
        if (old + 1u == (gen + 1u) * nloc) {
            __builtin_amdgcn_fence(__ATOMIC_RELEASE, "agent");
            asm volatile("s_waitcnt vmcnt(0)" ::: "memory");
            const unsigned og = xb_add(&bar[XB_TOP], 1u);
            const unsigned tg = og / nx;
            if (og + 1u == (tg + 1u) * nx) xb_add(&bar[XB_TOPGEN], 1u);
            else XB_SPIN(xb_ld(&bar[XB_TOPGEN]) == tg, bar);
            __builtin_amdgcn_fence(__ATOMIC_ACQUIRE, "agent");
            xb_add(&bar[XB_XGEN(b.x)], 1u);
            asm volatile("s_waitcnt vmcnt(0)" ::: "memory");
        } else {
            XB_SPIN(xb_ld(&bar[XB_XGEN(b.x)]) == gen, bar);
            __builtin_amdgcn_fence(__ATOMIC_ACQUIRE, "agent");
            asm volatile("s_waitcnt vmcnt(0)" ::: "memory");
        }
    }
    __syncthreads();
}

namespace pg8 {
constexpr int BM = 256, BK = 64, HALF = 128, HTB = HALF * BK * 2, STAGE_BYTES = 8 * HTB, NXCD = 8, WGM = 8;
__host__ __device__ __forceinline__ int lds_byte(int r, int c) { const int st = (r >> 4) * 2 + (c >> 5), rr = r & 15, cc = c & 31, ob = rr * 64 + cc * 2; return st * 1024 + (ob ^ (((ob >> 9) & 1) << 5)); }
__host__ __device__ __forceinline__ void stage_rc(int b, int& R, int& C) { const int st = b / 1024, sb = b % 1024, swz = sb ^ (((sb >> 9) & 1) << 5); R = (st >> 1) * 16 + swz / 64; C = (st & 1) * 32 + (swz % 64) / 2; }
__host__ __device__ __forceinline__ int perm32(int rho) { const int n = rho >> 4, i = rho & 15; return 8 * (i >> 2) + 4 * n + (i & 3); }

struct Unit { int pm, pn, brow; };

struct DenseOrder {
    int nM, nN, nwg, G, c;
    __device__ void init(int nM_, int nN_, int G_, int c_) { nM = nM_; nN = nN_; nwg = nM * nN; G = G_; c = c_; }
    __device__ __forceinline__ bool next(int i, Unit& u) const {
        const long L = (long)i * G + c; if (L >= nwg) return false;
        int wgid = (int)L; { const int q = nwg / NXCD, r = nwg % NXCD, xcd = wgid % NXCD, off = wgid / NXCD; wgid = (xcd < r ? xcd * (q + 1) : r * (q + 1) + (xcd - r) * q) + off; }
        const int nig = WGM * nN, gid = wgid / nig, fm = gid * WGM, gsz = (nM - fm) < WGM ? (nM - fm) : WGM;
        u.pm = fm + ((wgid % nig) % gsz); u.pn = (wgid % nig) / gsz; u.brow = u.pn * BM; return true;
    }
    __device__ __forceinline__ int a_row(const Unit& u, int r) const { return u.pm * BM + r; }
};
struct GroupedOrder {
    DenseOrder o; int pstart[9]; int nexp_rows;
    const int* rowtok;
    __device__ __forceinline__ bool next(int i, Unit& u) const {
        if (!o.next(i, u)) return false;
        int e = 0;
#pragma unroll
        for (int k = 1; k < 8; ++k) e += (u.pm >= pstart[k]) ? 1 : 0;
        u.brow = e * nexp_rows + u.pn * BM; return true;
    }
    __device__ __forceinline__ int a_row(const Unit& u, int r) const {
        const int pos = u.pm * BM + r; if (!rowtok) return pos;
        const int t = rowtok[pos]; return t < 0 ? 0 : t;
    }
};

template <class Epi, class Sched, bool FP8 = false>
__device__ __forceinline__ void gemm_phase(LAS unsigned char* lds, const void* Abase, const void* Btbase, const int K, const Sched& S, const Epi& E) {
    constexpr int ES = FP8 ? 1 : 2;
    int tid = threadIdx.x; asm volatile("; opaque tid" : "+v"(tid));
    const int wid = __builtin_amdgcn_readfirstlane(tid >> 6), lane = tid & 63, wr = wid >> 2, wc = wid & 3, fr = lane & 15, fq = lane >> 4;
    const int nt = K * ES / 128;
    unsigned voffB[2];
#pragma unroll
    for (int i = 0; i < 2; ++i) { int R, C; stage_rc(tid * 16 + i * 8192, R, C); const int Rb = Epi::PERM ? ((R & ~31) + perm32(R & 31)) : R; voffB[i] = (unsigned)(Rb * K * ES + C * 2); }
    const size_t kstep = (size_t)128;
    const size_t hstep = (size_t)HALF * K * ES;
    const unsigned ldsw = (unsigned)wid * 1024u;
    const int aoff = FP8 ? lds_byte(wr * 64 + fr, 16 * (fq & 1)) + (fq >> 1) * 1024 : lds_byte(wr * 64 + fr, fq * 8);
    const int boff = FP8 ? lds_byte(wc * 32 + fr, 16 * (fq & 1)) + (fq >> 1) * 1024 : lds_byte(wc * 32 + fr, fq * 8);
#define PG8_SA(b, h) (((b) * 2 + (h)) * HTB)
#define PG8_SB(b, h) ((4 + (b) * 2 + (h)) * HTB)
#define PG8_STAGE(bufoff, gbase, voff) do { const char* _gb = (const char*)(gbase); asm volatile("" : "+s"(_gb)); _Pragma("unroll") for (int _i = 0; _i < 2; ++_i) \
        __builtin_amdgcn_global_load_lds((const unsigned*)(_gb + (voff)[_i]), (LAS unsigned*)(lds + (bufoff) + ldsw + _i * 8192), 16, 0, 0); } while (0)
#define PG8_LDA(dst, b, h) do { _Pragma("unroll") for (int m = 0; m < 4; ++m) _Pragma("unroll") for (int k = 0; k < 2; ++k) dst[m][k] = *(const LAS bf16x8*)(lds + PG8_SA(b, h) + aoff + m * 2048 + k * (FP8 ? 16 : 1024)); } while (0)
#define PG8_LDB(dst, b, h) do { _Pragma("unroll") for (int n = 0; n < 2; ++n) _Pragma("unroll") for (int k = 0; k < 2; ++k) dst[n][k] = *(const LAS bf16x8*)(lds + PG8_SB(b, h) + boff + n * 2048 + k * (FP8 ? 16 : 1024)); } while (0)
#define PG8_MMA(ai, bj, At, Bt) do { __builtin_amdgcn_s_setprio(1); _Pragma("unroll") for (int m = 0; m < 4; ++m) _Pragma("unroll") for (int n = 0; n < 2; ++n) { \
        if constexpr (FP8) { const u32x4 _b0 = __builtin_bit_cast(u32x4, Bt[n][0]), _b1 = __builtin_bit_cast(u32x4, Bt[n][1]), _a0 = __builtin_bit_cast(u32x4, At[m][0]), _a1 = __builtin_bit_cast(u32x4, At[m][1]); \
            const i32x8 _bv = {(int)_b0.x, (int)_b0.y, (int)_b0.z, (int)_b0.w, (int)_b1.x, (int)_b1.y, (int)_b1.z, (int)_b1.w}, _av = {(int)_a0.x, (int)_a0.y, (int)_a0.z, (int)_a0.w, (int)_a1.x, (int)_a1.y, (int)_a1.z, (int)_a1.w}; \
            acc[ai][bj][m][n] = __builtin_amdgcn_mfma_scale_f32_16x16x128_f8f6f4(_bv, _av, acc[ai][bj][m][n], 0, 0, 0, 0x7F7F7F7F, 0, 0x7F7F7F7F); } \
        else { _Pragma("unroll") for (int k = 0; k < 2; ++k) acc[ai][bj][m][n] = __builtin_amdgcn_mfma_f32_16x16x32_bf16(Bt[n][k], At[m][k], acc[ai][bj][m][n], 0, 0, 0); } } \
        __builtin_amdgcn_s_setprio(0); } while (0)
#define PG8_WAIT_V(n) asm volatile("s_waitcnt vmcnt(" #n ")" ::: "memory")
#define PG8_WAIT_L(n) asm volatile("s_waitcnt lgkmcnt(" #n ")" ::: "memory")
#define PG8_BAR __builtin_amdgcn_s_barrier()
#define PG8_SCHED __builtin_amdgcn_sched_barrier(0)
#define PG8_AOFF(dst, u) do { _Pragma("unroll") for (int _i = 0; _i < 2; ++_i) { int _R, _C; stage_rc(tid * 16 + _i * 8192, _R, _C); _Pragma("unroll") for (int _h = 0; _h < 2; ++_h) \
        dst[_h][_i] = (unsigned)((size_t)S.a_row(u, _h * HALF + _R) * K * ES + _C * 2); } } while (0)
    Unit cur, nxt; int ui = 0;
    if (!S.next(0, cur)) return;
    f32x4 acc[2][2][4][2];
#pragma unroll
    for (int a = 0; a < 2; ++a)
#pragma unroll
        for (int b = 0; b < 2; ++b)
#pragma unroll
            for (int m = 0; m < 4; ++m)
#pragma unroll
                for (int n = 0; n < 2; ++n) acc[a][b][m][n] = (f32x4){0.f, 0.f, 0.f, 0.f};
    bf16x8 At[4][2], B0[2][2], B1[2][2];
    unsigned cao[2][2];
    PG8_AOFF(cao, cur);
    const char* cA = (const char*)Abase; const char* cB = (const char*)Btbase + (size_t)cur.brow * K * ES;
    PG8_STAGE(PG8_SB(0, 0), cB, voffB); PG8_STAGE(PG8_SB(0, 1), cB + hstep, voffB); PG8_STAGE(PG8_SA(0, 0), cA, cao[0]); PG8_STAGE(PG8_SA(0, 1), cA, cao[1]);
    if (wr == 1) PG8_BAR;
    PG8_WAIT_V(2); PG8_BAR;
    PG8_STAGE(PG8_SB(1, 0), cB + kstep, voffB); PG8_STAGE(PG8_SA(1, 0), cA + kstep, cao[0]); PG8_STAGE(PG8_SB(1, 1), cB + hstep + kstep, voffB);
    PG8_WAIT_V(6); PG8_BAR;
    for (;;) {
        const bool has_next = S.next(ui + 1, nxt);
        const char* nB = has_next ? (const char*)Btbase + (size_t)nxt.brow * K * ES : cB;
        for (int t = 0; t < nt; t += 2) {
            const bool last = (t == nt - 2);
            const char* a1 = cA + (size_t)(t + 1) * kstep;
            const char* a2 = last ? cA : cA + (size_t)(t + 2) * kstep; const char* b2 = last ? nB : cB + (size_t)(t + 2) * kstep;
            const char* a3 = a2 + kstep; const char* b3 = b2 + kstep;
            PG8_LDB(B0, 0, 0); PG8_LDB(B1, 0, 1); PG8_SCHED; PG8_LDA(At, 0, 0); PG8_STAGE(PG8_SA(1, 1), a1, cao[1]);
            if (last && has_next) { PG8_AOFF(cao, nxt); }
            PG8_WAIT_V(8); PG8_WAIT_L(0); PG8_BAR; PG8_MMA(0, 0, At, B0); PG8_MMA(0, 1, At, B1); PG8_BAR; PG8_SCHED;
            PG8_LDA(At, 0, 1); PG8_STAGE(PG8_SB(0, 0), b2, voffB); PG8_STAGE(PG8_SB(0, 1), b2 + hstep, voffB); PG8_STAGE(PG8_SA(0, 0), a2, cao[0]);
            PG8_WAIT_V(8); PG8_WAIT_L(0); PG8_BAR; PG8_MMA(1, 0, At, B0); PG8_MMA(1, 1, At, B1); PG8_BAR; PG8_SCHED;
            PG8_LDB(B0, 1, 0); PG8_LDB(B1, 1, 1); PG8_SCHED; PG8_LDA(At, 1, 0); PG8_STAGE(PG8_SA(0, 1), a2, cao[1]);
            PG8_WAIT_V(8); PG8_WAIT_L(0); PG8_BAR; PG8_MMA(0, 0, At, B0); PG8_MMA(0, 1, At, B1); PG8_BAR; PG8_SCHED;
            PG8_LDA(At, 1, 1); PG8_STAGE(PG8_SB(1, 0), b3, voffB); PG8_STAGE(PG8_SB(1, 1), b3 + hstep, voffB); PG8_STAGE(PG8_SA(1, 0), a3, cao[0]);
            PG8_WAIT_V(8); PG8_WAIT_L(0); PG8_BAR; PG8_MMA(1, 0, At, B0); PG8_MMA(1, 1, At, B1); PG8_BAR; PG8_SCHED;
        }
        if (wr == 0) PG8_BAR;
#pragma unroll 1
        for (int er = 0; er < Epi::NREP; ++er) E(acc, cur, wr, wc, fr, fq);
        if (!has_next) break;
#pragma unroll
        for (int a = 0; a < 2; ++a)
#pragma unroll
            for (int b = 0; b < 2; ++b)
#pragma unroll
                for (int m = 0; m < 4; ++m)
#pragma unroll
                    for (int n = 0; n < 2; ++n) acc[a][b][m][n] = (f32x4){0.f, 0.f, 0.f, 0.f};
        cur = nxt; cB = nB; ++ui;
        if (wr == 1) PG8_BAR;
    }
    PG8_WAIT_V(0);
    PG8_BAR;
#undef PG8_SA
#undef PG8_SB
#undef PG8_STAGE
#undef PG8_LDA
#undef PG8_LDB
#undef PG8_MMA
#undef PG8_WAIT_V
#undef PG8_WAIT_L
#undef PG8_BAR
#undef PG8_SCHED
#undef PG8_AOFF
}
}

typedef f32x4 AccT[2][2][4][2];

struct EpiProj {
    static constexpr int NREP = 1; static constexpr bool PERM = true;
    bf16_t* proj; float* gates; const float* bgate;
    __device__ __forceinline__ void operator()(const AccT& acc, const pg8::Unit& u, int wr, int wc, int fr, int fq) const {
        const int row0 = u.pm * 256 + wr * 64 + fr;
        if (u.pn < 12) {
            const int col0 = u.pn * 256 + wc * 32 + 8 * fq;
#pragma unroll
            for (int ai = 0; ai < 2; ++ai)
#pragma unroll
                for (int m = 0; m < 4; ++m) { bf16_t* rowp = proj + (size_t)(row0 + ai * 128 + m * 16) * PROJ_LD + col0;
#pragma unroll
                    for (int bj = 0; bj < 2; ++bj) { const f32x4 v0 = acc[ai][bj][m][0], v1 = acc[ai][bj][m][1];
                        u32x4 w; w.x = cvt_pk_bf16(v0[0], v0[1]); w.y = cvt_pk_bf16(v0[2], v0[3]); w.z = cvt_pk_bf16(v1[0], v1[1]); w.w = cvt_pk_bf16(v1[2], v1[3]);
                        *(u32x4*)(rowp + bj * 128) = w; } }
        } else if (wc == 0 && fq < 2) {
#pragma unroll
            for (int n = 0; n < 2; ++n) { const f32x4 bv = *(const f32x4*)(bgate + 8 * fq + 4 * n);
#pragma unroll
                for (int ai = 0; ai < 2; ++ai)
#pragma unroll
                    for (int m = 0; m < 4; ++m) *(f32x4*)(gates + (size_t)(row0 + ai * 128 + m * 16) * 16 + 8 * fq + 4 * n) = acc[ai][0][m][n] + bv; }
        }
    }
};
struct EpiRes {
    static constexpr int NREP = 1; static constexpr bool PERM = false;
    float* H; const float* stats; const float* lg; const float* lb; const float* src; float sc;
    __device__ __forceinline__ void operator()(const AccT& acc, const pg8::Unit& u, int wr, int wc, int fr, int fq) const {
        const int row0 = u.pm * 256 + wr * 64 + fr, col0 = u.pn * 256 + wc * 32 + 4 * fq;
        f32x4 gv[2][2], bv[2][2];
        if (lg) {
#pragma unroll
            for (int bj = 0; bj < 2; ++bj)
#pragma unroll
                for (int n = 0; n < 2; ++n) { gv[bj][n] = *(const f32x4*)(lg + col0 + bj * 128 + n * 16); bv[bj][n] = *(const f32x4*)(lb + col0 + bj * 128 + n * 16); } }
#pragma unroll
        for (int ai = 0; ai < 2; ++ai)
#pragma unroll
            for (int m = 0; m < 4; ++m) { const int row = row0 + ai * 128 + m * 16; float* rowp = H + (size_t)row * D + col0; const float* srcp = src + (size_t)row * D + col0;
                f32x2 st = (f32x2){0.f, 1.f}; if (lg) st = *(const f32x2*)(stats + 2 * (size_t)row);
#pragma unroll
                for (int bj = 0; bj < 2; ++bj)
#pragma unroll
                    for (int n = 0; n < 2; ++n) { float* p = rowp + bj * 128 + n * 16; f32x4 h = *(const f32x4*)(srcp + bj * 128 + n * 16);
                        if (lg) h = (h - st.x) * st.y * gv[bj][n] + bv[bj][n];
                        *(f32x4*)p = h * ALPHA + acc[ai][bj][m][n] * sc; } }
    }
};
struct EpiSwiglu {
    static constexpr int NREP = 1; static constexpr bool PERM = true;
    bf16_t* act; int ld; float sc;
    __device__ __forceinline__ static float silu_mul(float g, float u) { return g * u * __builtin_amdgcn_rcpf(1.0f + __builtin_amdgcn_exp2f(-g * 1.4426950408889634f)); }
    __device__ __forceinline__ void operator()(const AccT& acc, const pg8::Unit& u, int wr, int wc, int fr, int fq) const {
        const int row0 = u.pm * 256 + wr * 64 + fr, col0 = u.pn * 128 + wc * 32 + 8 * fq;
#pragma unroll
        for (int ai = 0; ai < 2; ++ai)
#pragma unroll
            for (int m = 0; m < 4; ++m) { const f32x4 g0 = acc[ai][0][m][0] * sc, g1 = acc[ai][0][m][1] * sc, u0 = acc[ai][1][m][0] * sc, u1 = acc[ai][1][m][1] * sc;
                u32x4 w; w.x = cvt_pk_bf16(silu_mul(g0[0], u0[0]), silu_mul(g0[1], u0[1])); w.y = cvt_pk_bf16(silu_mul(g0[2], u0[2]), silu_mul(g0[3], u0[3]));
                w.z = cvt_pk_bf16(silu_mul(g1[0], u1[0]), silu_mul(g1[1], u1[1])); w.w = cvt_pk_bf16(silu_mul(g1[2], u1[2]), silu_mul(g1[3], u1[3]));
                *(u32x4*)(act + (size_t)(row0 + ai * 128 + m * 16) * ld + col0) = w; }
    }
};
struct EpiSwiglu8 {
    static constexpr int NREP = 1; static constexpr bool PERM = true;
    unsigned char* act; int ld; float sc;
    __device__ __forceinline__ void operator()(const AccT& acc, const pg8::Unit& u, int wr, int wc, int fr, int fq) const {
        const int row0 = u.pm * 256 + wr * 64 + fr, col0 = u.pn * 128 + wc * 32 + 8 * fq;
#pragma unroll
        for (int ai = 0; ai < 2; ++ai)
#pragma unroll
            for (int m = 0; m < 4; ++m) { const f32x4 g0 = acc[ai][0][m][0] * sc, g1 = acc[ai][0][m][1] * sc, u0 = acc[ai][1][m][0] * sc, u1 = acc[ai][1][m][1] * sc;
                u32x2 w; w.x = pk4_fp8(EpiSwiglu::silu_mul(g0[0], u0[0]) * F8_SACT, EpiSwiglu::silu_mul(g0[1], u0[1]) * F8_SACT, EpiSwiglu::silu_mul(g0[2], u0[2]) * F8_SACT, EpiSwiglu::silu_mul(g0[3], u0[3]) * F8_SACT);
                w.y = pk4_fp8(EpiSwiglu::silu_mul(g1[0], u1[0]) * F8_SACT, EpiSwiglu::silu_mul(g1[1], u1[1]) * F8_SACT, EpiSwiglu::silu_mul(g1[2], u1[2]) * F8_SACT, EpiSwiglu::silu_mul(g1[3], u1[3]) * F8_SACT);
                *(u32x2*)(act + (size_t)(row0 + ai * 128 + m * 16) * ld + col0) = w; }
    }
};
struct EpiSwigluProbe : EpiSwiglu { static constexpr int NREP = 2; };
struct EpiScatter {
    static constexpr int NREP = 1; static constexpr bool PERM = true;
    bf16_t* contrib; const int* rowdst; const float* rowgate; float sc;
    __device__ __forceinline__ void operator()(const AccT& acc, const pg8::Unit& u, int wr, int wc, int fr, int fq) const {
        const int row0 = u.pm * 256 + wr * 64 + fr, col0 = u.pn * 256 + wc * 32 + 8 * fq;
#pragma unroll
        for (int ai = 0; ai < 2; ++ai)
#pragma unroll
            for (int m = 0; m < 4; ++m) { const int pos = row0 + ai * 128 + m * 16; const int d = rowdst[pos];
                if (d >= 0) { const float g = rowgate[pos] * sc; bf16_t* rowp = contrib + (size_t)d * D + col0;
#pragma unroll
                    for (int bj = 0; bj < 2; ++bj) { const f32x4 v0 = acc[ai][bj][m][0] * g, v1 = acc[ai][bj][m][1] * g;
                        u32x4 w; w.x = cvt_pk_bf16(v0[0], v0[1]); w.y = cvt_pk_bf16(v0[2], v0[3]); w.z = cvt_pk_bf16(v1[0], v1[1]); w.w = cvt_pk_bf16(v1[2], v1[3]);
                        *(u32x4*)(rowp + bj * 128) = w; } } }
    }
};
struct EpiQKV {
    static constexpr int NREP = 1; static constexpr bool PERM = true;
    bf16_t *Q, *KB, *VB; const float* rope;
    __device__ __forceinline__ void operator()(const AccT& acc, const pg8::Unit& u, int wr, int wc, int fr, int fq) const {
        const int row0 = u.pm * 256 + wr * 64 + fr, cl = wc * 32 + 8 * fq;
        bf16_t* base; int ld;
        if (u.pn == 5) {
#pragma unroll
            for (int ai = 0; ai < 2; ++ai)
#pragma unroll
                for (int m = 0; m < 4; ++m) { const int row = row0 + ai * 128 + m * 16;
#pragma unroll
                    for (int bj = 0; bj < 2; ++bj)
#pragma unroll
                        for (int n = 0; n < 2; ++n)
#pragma unroll
                            for (int j = 0; j < 4; ++j) VB[(size_t)(bj * 128 + cl + 4 * n + j) * MP + row] = (bf16_t)f2bf(acc[ai][bj][m][n][j]); }
            return; }
        if (u.pn < 4) { base = Q + u.pn * 256 + cl; ld = D; } else { base = KB + cl; ld = 256; }
        const bool dorope = (u.pn <= 4) && ((wc & 1) == 0);
#pragma unroll
        for (int ai = 0; ai < 2; ++ai)
#pragma unroll
            for (int m = 0; m < 4; ++m) { const int row = row0 + ai * 128 + m * 16;
                f32x4 v[2][2];
#pragma unroll
                for (int bj = 0; bj < 2; ++bj)
#pragma unroll
                    for (int n = 0; n < 2; ++n) v[bj][n] = acc[ai][bj][m][n];
                if (dorope) {
                    int pos = row < MREAL ? (row & (SEQ - 1)) + NMETA : row - MREAL; pos = pos > SEQ + NMETA - 1 ? SEQ + NMETA - 1 : pos;
                    const float* rp = rope + (size_t)pos * 16;
                    const f32x4 c0 = *(const f32x4*)rp, c1 = *(const f32x4*)(rp + 4), s0 = *(const f32x4*)(rp + 8), s1 = *(const f32x4*)(rp + 12);
#pragma unroll
                    for (int bj = 0; bj < 2; ++bj)
#pragma unroll
                        for (int n = 0; n < 2; ++n) { const f32x4 c = n ? c1 : c0, s = n ? s1 : s0; f32x4 o;
#pragma unroll
                            for (int j = 0; j < 4; ++j) { const float x = v[bj][n][j]; const float y = __shfl_xor(x, 16);
                                o[j] = fq == 0 ? x * c[j] - y * s[j] : (fq == 1 ? x * c[j] + y * s[j] : x); }
                            v[bj][n] = o; }
                }
#pragma unroll
                for (int bj = 0; bj < 2; ++bj) { const f32x4 v0 = v[bj][0], v1 = v[bj][1];
                    u32x4 w; w.x = cvt_pk_bf16(v0[0], v0[1]); w.y = cvt_pk_bf16(v0[2], v0[3]); w.z = cvt_pk_bf16(v1[0], v1[1]); w.w = cvt_pk_bf16(v1[2], v1[3]);
                    *(u32x4*)(base + (size_t)row * ld + bj * 128) = w; } }
    }
};

template <int NACC, class F>
__device__ __forceinline__ void skinny_item(const bf16_t* A, int lda, const bf16_t* (&Bt)[NACC], int K, int wave, int lane, LAS unsigned char* lds, int parity, const F& epi) {
    const int fr = lane & 15, quad = lane >> 4, kw = K >> 3;
    const bf16_t* ap = A + (size_t)fr * lda + wave * kw + 8 * quad;
    f32x4 acc[NACC];
#pragma unroll
    for (int i = 0; i < NACC; ++i) acc[i] = (f32x4){0.f, 0.f, 0.f, 0.f};
#pragma unroll 2
    for (int k = 0; k < kw; k += 32) { const bf16x8 a = *(const bf16x8*)(ap + k);
#pragma unroll
        for (int i = 0; i < NACC; ++i) acc[i] = __builtin_amdgcn_mfma_f32_16x16x32_bf16(a, *(const bf16x8*)(Bt[i] + (size_t)fr * K + wave * kw + 8 * quad + k), acc[i], 0, 0, 0); }
    LAS f32x4* red = (LAS f32x4*)(lds + parity * 16384);
#pragma unroll
    for (int i = 0; i < NACC; ++i) red[(wave * NACC + i) * 64 + lane] = acc[i];
    __syncthreads();
    if (wave == 0) {
#pragma unroll
        for (int i = 0; i < NACC; ++i) { f32x4 t = red[i * 64 + lane];
#pragma unroll
            for (int w = 1; w < 8; ++w) t += red[(w * NACC + i) * 64 + lane];
            acc[i] = t; }
        epi(acc, fr, quad);
    }
}

template <int NACC, class F>
__device__ __forceinline__ void skinny_item8(const unsigned char* A, int lda, const unsigned char* (&Bt)[NACC], int K, int wave, int lane, LAS unsigned char* lds, int parity, const F& epi) {
    const int fr = lane & 15, quad = lane >> 4, nblk = K >> 7, b0 = (wave * nblk) >> 3, b1 = ((wave + 1) * nblk) >> 3;
    f32x4 acc[NACC];
#pragma unroll
    for (int i = 0; i < NACC; ++i) acc[i] = (f32x4){0.f, 0.f, 0.f, 0.f};
    for (int kb = b0; kb < b1; ++kb) { const u32x4* ap = (const u32x4*)(A + (size_t)fr * lda + kb * 128 + 32 * quad); const u32x4 a0 = ap[0], a1 = ap[1];
        const i32x8 av = {(int)a0.x, (int)a0.y, (int)a0.z, (int)a0.w, (int)a1.x, (int)a1.y, (int)a1.z, (int)a1.w};
#pragma unroll
        for (int i = 0; i < NACC; ++i) { const u32x4* bp = (const u32x4*)(Bt[i] + (size_t)fr * K + kb * 128 + 32 * quad); const u32x4 q0 = bp[0], q1 = bp[1];
            const i32x8 bv = {(int)q0.x, (int)q0.y, (int)q0.z, (int)q0.w, (int)q1.x, (int)q1.y, (int)q1.z, (int)q1.w};
            acc[i] = __builtin_amdgcn_mfma_scale_f32_16x16x128_f8f6f4(av, bv, acc[i], 0, 0, 0, 0x7F7F7F7F, 0, 0x7F7F7F7F); } }
    LAS f32x4* red = (LAS f32x4*)(lds + parity * 16384);
#pragma unroll
    for (int i = 0; i < NACC; ++i) red[(wave * NACC + i) * 64 + lane] = acc[i];
    __syncthreads();
    if (wave == 0) {
#pragma unroll
        for (int i = 0; i < NACC; ++i) { f32x4 t = red[i * 64 + lane];
#pragma unroll
            for (int w = 1; w < 8; ++w) t += red[(w * NACC + i) * 64 + lane];
            acc[i] = t; }
        epi(acc, fr, quad);
    }
}

struct Params { const float* in[18]; float* out; unsigned char* ws; int ph_lo, ph_hi, li, pad; };
enum { I_X = 0, I_META, I_WIN, I_BGATE, I_LNH, I_WOUT, I_WKV, I_WQ, I_SINKS, I_WO, I_WGUD, I_WDND, I_WROUTER, I_BROUTER, I_WGUE, I_WDNE, I_LNG, I_LNB };
constexpr int NWAVES = 8, NTHREADS = 512;

template <bool F8 = false>
__device__ __forceinline__ void tr_item(const float* W, int Nsrc, int K, void* WTv, int k0, int n0, int drow0, float scale, int nvalid, LAS float* scr, int lane) {
    bf16_t* WT = (bf16_t*)WTv;
    float ld[32];
#pragma unroll
    for (int i = 0; i < 32; ++i) { const int kk = 2 * i + (lane >> 5), n = lane & 31; ld[i] = (n < nvalid) ? W[(size_t)(k0 + kk) * Nsrc + n0 + n] : 0.f; }
#pragma unroll
    for (int i = 0; i < 32; ++i) { const int kk = 2 * i + (lane >> 5), n = lane & 31; scr[kk * 33 + n] = ld[i] * scale; }
    LDS_WAIT(); asm volatile("" ::: "memory");
    const int c = lane & 7;
#pragma unroll
    for (int j = 0; j < 4; ++j) { const int n = (lane >> 3) + 8 * j; const LAS float* s = scr + (8 * c) * 33 + n;
        if constexpr (F8) { u32x2 o; o.x = pk4_fp8(s[0 * 33], s[1 * 33], s[2 * 33], s[3 * 33]); o.y = pk4_fp8(s[4 * 33], s[5 * 33], s[6 * 33], s[7 * 33]);
            if (n < nvalid) *(u32x2*)((unsigned char*)WTv + (size_t)(drow0 + n) * K + k0 + 8 * c) = o; }
        else { u32x4 o; o.x = pk2(s[0 * 33], s[1 * 33]); o.y = pk2(s[2 * 33], s[3 * 33]); o.z = pk2(s[4 * 33], s[5 * 33]); o.w = pk2(s[6 * 33], s[7 * 33]);
            if (n < nvalid) *(u32x4*)(WT + (size_t)(drow0 + n) * K + k0 + 8 * c) = o; } }
    LDS_WAIT(); asm volatile("" ::: "memory");
}
__device__ __forceinline__ int pair_row(int n, int FF) { const int up = n >= FF ? 1 : 0, j = n - up * FF; return 256 * (j >> 7) + 128 * up + (j & 127); }

__device__ __forceinline__ void p0_prologue(const Params& P, LAS unsigned char* lds, int gw, int NGW, int wave, int lane) {
    unsigned char* ws = P.ws;
    LAS float* scr = (LAS float*)(lds + wave * 16384);
    constexpr int IT0 = 16 * 97, IT1 = 16 * 32, IT2 = 16 * 16, IT5 = 16 * 176, IT6 = 44 * 32, IT7 = 16 * 224, IT8 = 56 * 32;
    constexpr int C0 = 2 * IT0, C1 = C0 + 2 * IT1, C2 = C1 + IT2, C3 = C2 + 2 * IT1, C4 = C3 + 2 * IT1, C5 = C4 + 2 * IT5, C6 = C5 + 2 * IT6, C7 = C6 + 16 * IT7, C8 = C7 + 16 * IT8;
    for (int it = gw; it < C8; it += NGW) {
        if (it < C0) { const int mi = it / IT0, r = it % IT0, kb = r / 97, nb = r % 97; const int n0 = nb * 32;
            tr_item(P.in[I_WIN] + (size_t)mi * D * M_IN, M_IN, D, (bf16_t*)(ws + WS_WIN) + (size_t)mi * M_INP * D, kb * 64, n0, n0, n0 < 512 ? 0.125f : 1.f, nb == 96 ? 16 : 32, scr, lane);
        } else if (it < C1) { const int q = it - C0, mi = q / IT1, r = q % IT1, kb = r / 32, nb = r % 32;
            tr_item(P.in[I_WOUT] + (size_t)mi * D * D, D, D, (bf16_t*)(ws + WS_WOUT) + (size_t)mi * D * D, kb * 64, nb * 32, nb * 32, 1.f, 32, scr, lane);
        } else if (it < C2) { const int r = it - C1, kb = r / 16, nb = r % 16;
            tr_item(P.in[I_WKV], 512, D, (bf16_t*)(ws + WS_WQKV), kb * 64, nb * 32, 1024 + nb * 32, 1.f, 32, scr, lane);
        } else if (it < C3) { const int q = it - C2, mi = q / IT1, r = q % IT1, kb = r / 32, nb = r % 32;
            tr_item(P.in[I_WQ] + (size_t)mi * D * D, D, D, (bf16_t*)(ws + (mi ? WS_WQ3 : WS_WQKV)), kb * 64, nb * 32, nb * 32, 0.125f, 32, scr, lane);
        } else if (it < C4) { const int q = it - C3, mi = q / IT1, r = q % IT1, kb = r / 32, nb = r % 32;
            tr_item(P.in[I_WO] + (size_t)mi * D * D, D, D, (bf16_t*)(ws + WS_WO) + (size_t)mi * D * D, kb * 64, nb * 32, nb * 32, 1.f, 32, scr, lane);
        } else if (it < C5) { const int q = it - C4, mi = q / IT5, r = q % IT5, kb = r / 176, nb = r % 176;
            tr_item(P.in[I_WGUD] + (size_t)mi * D * 2 * D_FF, 2 * D_FF, D, (bf16_t*)(ws + WS_WGU) + (size_t)mi * 2 * D_FF * D, kb * 64, nb * 32, pair_row(nb * 32, D_FF), 1.f, 32, scr, lane);
        } else if (it < C6) { const int q = it - C5, mi = q / IT6, r = q % IT6, kb = r / 32, nb = r % 32;
            tr_item<true>(P.in[I_WDND] + (size_t)mi * D_FF * D, D, D_FF, (ws + WS_WDN8) + (size_t)mi * D * D_FF, kb * 64, nb * 32, nb * 32, F8_SBD, 32, scr, lane);
        } else if (it < C7) { const int q = it - C6, mi = q / IT7, r = q % IT7, kb = r / 224, nb = r % 224;
            tr_item<true>(P.in[I_WGUE] + (size_t)mi * D * 2 * D_FF_EXP, 2 * D_FF_EXP, D, (ws + WS_WGUE8) + (size_t)mi * 2 * D_FF_EXP * D, kb * 64, nb * 32, pair_row(nb * 32, D_FF_EXP), F8_SB, 32, scr, lane);
        } else { const int q = it - C7, mi = q / IT8, r = q % IT8, kb = r / 32, nb = r % 32;
            tr_item<true>(P.in[I_WDNE] + (size_t)mi * D_FF_EXP * D, D, D_FF_EXP, (ws + WS_WDNE8) + (size_t)mi * D * D_FF_EXP, kb * 64, nb * 32, nb * 32, F8_SBD, 32, scr, lane);
        }
    }
    { float* sm = (float*)(ws + WS_SMALL); const int gt = gw * 64 + lane, NT = NGW * 64;
      for (int i = gt; i < SM_END; i += NT) { float v = 0.f;
          if (i < SM_SINKS) v = P.in[I_BGATE][i]; else if (i < SM_BROUTER) v = P.in[I_SINKS][i - SM_SINKS]; else if (i < SM_BROUTER + 16) v = P.in[I_BROUTER][i - SM_BROUTER];
          else if (i < SM_LNH) v = 0.f; else if (i < SM_LNG) v = P.in[I_LNH][i - SM_LNH]; else if (i < SM_LNB) v = P.in[I_LNG][i - SM_LNG]; else if (i < SM_WROUTER) v = P.in[I_LNB][i - SM_LNB]; else v = P.in[I_WROUTER][i - SM_WROUTER];
          sm[i] = v; } }
    { bf16_t* HB = (bf16_t*)(ws + WS_HB);
      const size_t gt = (size_t)gw * 64 + lane, NT = (size_t)NGW * 64;
      for (size_t i = gt; i < (size_t)MV * (D / 4); i += NT) { const size_t row = i >> 8; const int c4 = (int)(i & 255);
          const f32x4 v = row < MREAL ? ((const f32x4*)P.in[I_X])[i] : ((const f32x4*)P.in[I_META])[(row - MREAL) * 256 + c4];
          u32x2 w; w.x = pk2(v[0], v[1]); w.y = pk2(v[2], v[3]); ((u32x2*)HB)[i] = w; }
      float* rope = (float*)(ws + WS_ROPE);
      for (size_t i = gt; i < (size_t)(SEQ + NMETA) * 8; i += NT) { const int pos = (int)(i >> 3), fi = (int)(i & 7);
          const double invf = fi == 0 ? 1.0 : fi == 1 ? 0.19392274474868576 : fi == 2 ? 0.03760603093086393 : fi == 3 ? 0.007292664737217109 : fi == 4 ? 0.001414213562373095
                            : fi == 5 ? 0.0002742481756762073 : fi == 6 ? 5.318295896944988e-05 : 1.031338537721246e-05;
          const float angf = (float)pos * (float)invf;
          double a = (double)angf; a -= 6.283185307179586476925 * __builtin_rint(a * 0.15915494309189533577); const double hx = 0.5 * a, h2 = hx * hx;
          double sp = 1.0, cp = 1.0;
#pragma unroll
          for (int k = 12; k >= 1; --k) { sp = 1.0 - sp * h2 / (double)((2 * k) * (2 * k + 1)); cp = 1.0 - cp * h2 / (double)((2 * k - 1) * (2 * k)); }
          const double sh = hx * sp, ch = cp;
          rope[(size_t)pos * 16 + fi] = (float)(1.0 - 2.0 * sh * sh); rope[(size_t)pos * 16 + 8 + fi] = (float)(2.0 * sh * ch); }
    }
}

__device__ __forceinline__ void ln_phase(unsigned char* ws, float* outp, LAS unsigned char* lds, int gw, int NGW, int lane, int tid,
                                         int lnidx, bool moe_src, bool router, int moe_idx, bool final) {
    const float* sm = (const float*)(ws + WS_SMALL);
    float* H = (float*)(ws + WS_H); bf16_t* HB = (bf16_t*)(ws + WS_HB); const bf16_t* contrib = (const bf16_t*)(ws + WS_CONTRIB); float* stats = (float*)(ws + WS_STATS);
    const float* lg = sm + SM_LNG + (size_t)lnidx * D; const float* lb = sm + SM_LNB + (size_t)lnidx * D;
    f32x4 gv[4], bv[4];
#pragma unroll
    for (int j = 0; j < 4; ++j) { gv[j] = *(const f32x4*)(lg + 256 * j + 4 * lane); bv[j] = *(const f32x4*)(lb + 256 * j + 4 * lane); }
    LAS float* wr = (LAS float*)lds;
    volatile LAS unsigned* misc = (volatile LAS unsigned*)(lds + MISC_OFF);
    if (router) {
        const float* src = sm + SM_WROUTER + (size_t)moe_idx * D * N_EXP;
        for (int i = tid; i < D * N_EXP / 4; i += NTHREADS) ((LAS f32x4*)wr)[i] = ((const f32x4*)src)[i];
        if (tid < 8) misc[16 + tid] = 0u;
        __syncthreads();
    }
    int* tope = (int*)(ws + WS_TOPE); float* topg = (float*)(ws + WS_TOPG);
    const float* br = sm + SM_BROUTER + moe_idx * N_EXP;
    f32x4 nv[4]; u32x2 nc0[4], nc1[4]; f32x2 nst;
    auto fetch = [&](int row) {
        const f32x4* hr = (const f32x4*)(H + (size_t)row * D) + lane;
#pragma unroll
        for (int j = 0; j < 4; ++j) nv[j] = hr[64 * j];
        if (moe_src) { const u32x2* c0 = (const u32x2*)(contrib + (size_t)(2 * row) * D) + lane; const u32x2* c1 = c0 + 256;
#pragma unroll
            for (int j = 0; j < 4; ++j) { nc0[j] = c0[64 * j]; nc1[j] = c1[64 * j]; } }
        nst = *(const f32x2*)(stats + 2 * (size_t)row);
    };
    if (gw < MV) fetch(gw);
    for (int row = gw; row < MV; row += NGW) {
        f32x4 v[4], c0v[4], c1v[4]; const f32x2 st = nst;
#pragma unroll
        for (int j = 0; j < 4; ++j) { v[j] = nv[j];
            c0v[j] = (f32x4){__builtin_bit_cast(float, nc0[j].x << 16), __builtin_bit_cast(float, nc0[j].x & 0xffff0000u), __builtin_bit_cast(float, nc0[j].y << 16), __builtin_bit_cast(float, nc0[j].y & 0xffff0000u)};
            c1v[j] = (f32x4){__builtin_bit_cast(float, nc1[j].x << 16), __builtin_bit_cast(float, nc1[j].x & 0xffff0000u), __builtin_bit_cast(float, nc1[j].y << 16), __builtin_bit_cast(float, nc1[j].y & 0xffff0000u)}; }
        if (row + NGW < MV) fetch(row + NGW);
        if (moe_src) { const float* pg = lg - D; const float* pb = lb - D;
#pragma unroll
            for (int j = 0; j < 4; ++j) { const f32x4 g1 = *(const f32x4*)(pg + 256 * j + 4 * lane), b1 = *(const f32x4*)(pb + 256 * j + 4 * lane);
                v[j] = ((v[j] - st.x) * st.y * g1 + b1) * ALPHA + c0v[j] + c1v[j]; }
            if (!final) { f32x4* o = (f32x4*)(H + (size_t)row * D) + lane;
#pragma unroll
                for (int j = 0; j < 4; ++j) o[64 * j] = v[j]; } }
        float s = 0.f;
#pragma unroll
        for (int j = 0; j < 4; ++j) s += (v[j][0] + v[j][1]) + (v[j][2] + v[j][3]);
        const float mean = wave_sum(s) * (1.f / D); float s2 = 0.f;
#pragma unroll
        for (int j = 0; j < 4; ++j) { v[j] = v[j] - mean; s2 += (v[j][0] * v[j][0] + v[j][1] * v[j][1]) + (v[j][2] * v[j][2] + v[j][3] * v[j][3]); }
        const float rstd = 1.f / sqrtf(wave_sum(s2) * (1.f / D) + LN_EPS);
#pragma unroll
        for (int j = 0; j < 4; ++j) v[j] = v[j] * rstd * gv[j] + bv[j];
        if (final) { if (row < MREAL) { f32x4* o = (f32x4*)(outp + (size_t)row * D) + lane;
#pragma unroll
                for (int j = 0; j < 4; ++j) o[64 * j] = v[j]; } }
        else { if (lane == 0) *(f32x2*)(stats + 2 * (size_t)row) = (f32x2){mean, rstd};
            if (router) { unsigned* o8 = (unsigned*)(ws + WS_HB8 + (size_t)row * D) + lane;
#pragma unroll
                for (int j = 0; j < 4; ++j) o8[64 * j] = pk4_fp8(v[j][0] * F8_SA, v[j][1] * F8_SA, v[j][2] * F8_SA, v[j][3] * F8_SA); }
            else { u32x2* ob = (u32x2*)(HB + (size_t)row * D) + lane;
#pragma unroll
                for (int j = 0; j < 4; ++j) { u32x2 w; w.x = pk2(v[j][0], v[j][1]); w.y = pk2(v[j][2], v[j][3]); ob[64 * j] = w; } } }
        if (router) {
            float lg8[8];
#pragma unroll
            for (int e = 0; e < 8; ++e) lg8[e] = 0.f;
#pragma unroll
            for (int j = 0; j < 4; ++j)
#pragma unroll
                for (int c = 0; c < 4; ++c) { const LAS f32x4* w4 = (const LAS f32x4*)(wr + (size_t)(256 * j + 4 * lane + c) * 8); const f32x4 wa = w4[0], wb = w4[1]; const float x = v[j][c];
                    lg8[0] += x * wa[0]; lg8[1] += x * wa[1]; lg8[2] += x * wa[2]; lg8[3] += x * wa[3]; lg8[4] += x * wb[0]; lg8[5] += x * wb[1]; lg8[6] += x * wb[2]; lg8[7] += x * wb[3]; }
#pragma unroll
            for (int e = 0; e < 8; ++e) lg8[e] = wave_sum(lg8[e]) + br[e];
            int e1 = 0; float v1 = lg8[0];
#pragma unroll
            for (int e = 1; e < 8; ++e) if (lg8[e] > v1) { v1 = lg8[e]; e1 = e; }
            int e2 = -1; float v2 = -3.0e38f;
#pragma unroll
            for (int e = 0; e < 8; ++e) if (e != e1 && lg8[e] > v2) { v2 = lg8[e]; e2 = e; }
            const float ex = expf(v2 - v1), g1 = 1.f / (1.f + ex), g2 = ex / (1.f + ex);
            if (lane == 0) { tope[row] = e1 | (e2 << 8); topg[2 * row] = g1; topg[2 * row + 1] = g2;
                __hip_atomic_fetch_add((LAS unsigned*)&misc[16 + e1], 1u, __ATOMIC_RELAXED, __HIP_MEMORY_SCOPE_WORKGROUP);
                __hip_atomic_fetch_add((LAS unsigned*)&misc[16 + e2], 1u, __ATOMIC_RELAXED, __HIP_MEMORY_SCOPE_WORKGROUP); }
        }
    }
    if (router) { __syncthreads();
        if (tid < 8) __hip_atomic_fetch_add((unsigned*)(ws + WS_CTL) + CW_CNT + moe_idx * 64 + tid, misc[16 + tid], __ATOMIC_RELAXED, __HIP_MEMORY_SCOPE_AGENT);
        __syncthreads(); }
}

__device__ __forceinline__ void moe_starts(const unsigned char* ws, int moe_idx, int (&cnt)[8], int (&pstart)[9]) {
    const unsigned* c = (const unsigned*)(ws + WS_CTL) + CW_CNT + moe_idx * 64; int p = 0;
#pragma unroll
    for (int e = 0; e < 8; ++e) { cnt[e] = __builtin_amdgcn_readfirstlane((int)__hip_atomic_load(c + e, __ATOMIC_RELAXED, __HIP_MEMORY_SCOPE_AGENT)); pstart[e] = p; p += (cnt[e] + 255) >> 8; }
    pstart[8] = p;
}
__device__ __forceinline__ void assign_phase(unsigned char* ws, int gw, int NGW, int lane, int tid, int moe_idx) {
    int cnt[8], pstart[9]; moe_starts(ws, moe_idx, cnt, pstart);
    const int* tope = (const int*)(ws + WS_TOPE); const float* topg = (const float*)(ws + WS_TOPG);
    int* rowtok = (int*)(ws + WS_ROWTOK); int* rowdst = (int*)(ws + WS_ROWDST); float* rowgate = (float*)(ws + WS_ROWGATE);
    unsigned* cur = (unsigned*)(ws + WS_CTL) + CW_CUR + moe_idx * 64;
    for (int base = gw * 64; base < MV; base += NGW * 64) {
        const int row = base + lane; const bool valid = row < MV;
        const int te = valid ? tope[row] : 0xffff;
#pragma unroll
        for (int slot = 0; slot < 2; ++slot) {
            const int e = valid ? ((te >> (8 * slot)) & 255) : 255; int pos = -1;
#pragma unroll
            for (int ee = 0; ee < 8; ++ee) {
                const unsigned long long mask = __ballot(e == ee);
                if (mask) { const int n = __popcll(mask), leader = __ffsll((long long)mask) - 1; unsigned b0 = 0;
                    if (lane == leader) b0 = __hip_atomic_fetch_add(cur + ee, (unsigned)n, __ATOMIC_RELAXED, __HIP_MEMORY_SCOPE_AGENT);
                    b0 = __shfl(b0, leader);
                    if (e == ee) pos = pstart[ee] * 256 + (int)b0 + __popcll(mask & ((1ull << lane) - 1ull)); }
            }
            if (valid) { rowtok[pos] = row; rowdst[pos] = 2 * row + slot; rowgate[pos] = topg[2 * row + slot]; }
        }
    }
    if (blockIdx.x < 8) { const int e = blockIdx.x; int ps = 0, pe = 0, ce = 0;
#pragma unroll
        for (int ee = 0; ee < 8; ++ee) if (ee == e) { ps = pstart[ee]; pe = pstart[ee + 1]; ce = cnt[ee]; }
        for (int pos = ps * 256 + ce + tid; pos < pe * 256; pos += NTHREADS) { rowtok[pos] = -1; rowdst[pos] = -1; rowgate[pos] = 0.f; } }
}

constexpr int ML_RS = 72;
constexpr int ML_QS = 0, ML_KS = 9216, ML_KT = 18432, ML_PS = 27648, ML_VT = 36864, ML_CT = 57600, ML_HS = 78336, ML_SC = 112128;
constexpr int ML_HSS = 132;
constexpr int ML_TAB = 114688, ML_NCH = 17;
constexpr int ML_TSC = ML_TAB + 7 * ML_NCH * 64 * 4;
static_assert(ML_TSC + 1024 <= MISC_OFF, "mLSTM LDS");
__device__ __forceinline__ bf16x8 ml_frag(LAS unsigned char* lds, int base, int row, int kcol) { return *(const LAS bf16x8*)(lds + base + (row * ML_RS + kcol) * 2); }

template <int MODE>
__device__ __forceinline__ void mlstm_phase(unsigned char* ws, LAS unsigned char* lds, int layer, int tid, int wave, int lane) {
    const int item = blockIdx.x; const int bh = item >> 3, seg = item & 7, b = bh >> 3, h = bh & 7;
    if (MODE == 1 && seg == 7) return;
    const bf16_t* proj = (const bf16_t*)(ws + WS_PROJ); const float* gates = (const float*)(ws + WS_GATES);
    bf16_t* HG = (bf16_t*)(ws + WS_HG);
    float* STATE = (float*)(ws + WS_STATE); float* STSC = (float*)(ws + WS_STSC);
    LAS float* sc = (LAS float*)(lds + ML_SC);
    LAS float* tab = (LAS float*)(lds + ML_TAB); LAS float* tsc = (LAS float*)(lds + ML_TSC);
    const int fr = lane & 15, quad = lane >> 4;
    f32x4 st[5]; float zero = 0.f; asm volatile("; opaque zero" : "+v"(zero));
#pragma unroll
    for (int i = 0; i < 5; ++i) st[i] = (f32x4){zero, zero, zero, zero};
    float m0 = (MODE == 1) ? -1.0e30f : 0.f;
    const int nch = SEG_CHUNKS + (seg == 0 ? 1 : 0);
    auto chunk_rows = [&](int ci, int& rbase, int& nv) { if (seg == 0 && ci == 0) { rbase = MREAL; nv = NMETA; } else { const int c = seg * SEG_CHUNKS + ci - (seg == 0 ? 1 : 0); rbase = b * SEQ + c * 64; nv = 64; } };
    for (int i = tid; i < 16 * ML_RS; i += NTHREADS) ((LAS bf16_t*)(lds + ML_VT))[128 * ML_RS + i] = (i < ML_RS) ? (bf16_t)0x3F80 : (bf16_t)0;
    for (int ci = wave; ci < nch; ci += NWAVES) {
        int rbase, nv; chunk_rows(ci, rbase, nv); const bool ok = lane < nv;
        const float li = ok ? gates[(size_t)(rbase + lane) * 16 + h] : -1.0e30f, f = ok ? gates[(size_t)(rbase + lane) * 16 + 8 + h] : 0.f;
        const float lf = ok ? (fminf(f, 0.f) - logf(1.f + expf(-fabsf(f)))) : 0.f;
        float bc = lf;
#pragma unroll
        for (int o = 1; o < 64; o <<= 1) { const float t = __shfl_up(bc, o); if (lane >= o) bc += t; }
        const float u = li - bc; float pm = u;
#pragma unroll
        for (int o = 1; o < 64; o <<= 1) { const float t = __shfl_up(pm, o); if (lane >= o) pm = fmaxf(pm, t); }
        tab[(0 * ML_NCH + ci) * 64 + lane] = bc; tab[(1 * ML_NCH + ci) * 64 + lane] = u; tab[(2 * ML_NCH + ci) * 64 + lane] = pm;
        if (lane == 63) { tsc[ci] = bc; tsc[32 + ci] = pm; }
    }
    if (MODE == 2 && seg > 0) {
        m0 = -1.0e30f;
        for (int s2 = 0; s2 < seg; ++s2) {
            const float ms = STSC[(bh * 7 + s2) * 4 + 0], Gs = STSC[(bh * 7 + s2) * 4 + 1];
            const float mn = fmaxf(Gs + m0, ms), fo = fast_exp(Gs + m0 - mn), fn = fast_exp(ms - mn);
            const f32x4* sp = (const f32x4*)(STATE + (size_t)(bh * 7 + s2) * ST_FLOATS) + (wave * 5) * 64 + lane;
#pragma unroll
            for (int i = 0; i < 5; ++i) st[i] = st[i] * fo + sp[i * 64] * fn;
            m0 = mn;
        }
    }
#pragma unroll
    for (int i = 0; i < 5; ++i) { const int dv = (i < 4) ? 16 * wave + fr : 128 + fr, dk = (i < 4) ? 16 * i + 4 * quad : 16 * wave + 4 * quad;
        if (i < 4 || wave < 4) { u32x2 w; w.x = pk2(st[i][0], st[i][1]); w.y = pk2(st[i][2], st[i][3]); *(LAS u32x2*)(lds + ML_CT + (dv * ML_RS + dk) * 2) = w; } }
    __syncthreads();
    if (wave == 0) {
        const float bl = lane < nch ? tsc[lane] : 0.f, um = lane < nch ? tsc[32 + lane] : 0.f; float m = m0, gs = 0.f;
        for (int ci = 0; ci < nch; ++ci) { const float blast = __shfl(bl, ci), umax = __shfl(um, ci), amax = blast + umax, mn = fmaxf(blast + m, amax);
            if (lane == 0) { tsc[64 + ci] = m; tsc[96 + ci] = fast_exp(blast + m - mn); tsc[128 + ci] = fast_exp(amax - mn); }
            m = mn; gs += blast; }
        if (lane == 0) { tsc[160] = m; tsc[161] = gs; }
    }
    __syncthreads();
    for (int idx = tid; idx < nch * 64; idx += NTHREADS) { const int ci = idx >> 6, j = idx & 63;
        const float bc = tab[(0 * ML_NCH + ci) * 64 + j], u = tab[(1 * ML_NCH + ci) * 64 + j], pm = tab[(2 * ML_NCH + ci) * 64 + j], mc = tsc[64 + ci], MM = fmaxf(pm, mc);
        tab[(3 * ML_NCH + ci) * 64 + j] = MM; tab[(4 * ML_NCH + ci) * 64 + j] = fast_exp(mc - MM); tab[(5 * ML_NCH + ci) * 64 + j] = fast_exp(-(bc + MM));
        tab[(6 * ML_NCH + ci) * 64 + j] = tsc[128 + ci] * fast_exp(u - tsc[32 + ci]); }
    float lnh[16];
    if (MODE == 2) {
#pragma unroll
        for (int e = 0; e < 16; ++e) lnh[e] = ((const float*)(ws + WS_SMALL))[SM_LNH + layer * D + h * M_V + 16 * (tid & 7) + e]; }
    u32x4 rq, rk, rv0, rv1, rg0, rg1;
    auto load_chunk = [&](int ci) {
        int rbase, nv; chunk_rows(ci, rbase, nv);
        if (MODE == 2) { const int i = tid >> 3, sg = tid & 7; const u32x4* ogp = (const u32x4*)(proj + (size_t)(rbase + (i < nv ? i : 0)) * PROJ_LD + 2048 + h * M_V + 16 * sg); rg0 = ogp[0]; rg1 = ogp[1]; }
        { const int j = tid >> 3, c8 = (tid & 7) * 8; const bf16_t* rp = proj + (size_t)(rbase + j) * PROJ_LD + h * 64 + c8;
          rq = (MODE == 2 && j < nv) ? *(const u32x4*)rp : (u32x4){0u, 0u, 0u, 0u}; }
        { const bf16_t* rp = proj + (size_t)(rbase + lane) * PROJ_LD; const bool ok = lane < nv;
          rk = ok ? *(const u32x4*)(rp + 512 + h * 64 + 8 * wave) : (u32x4){0u, 0u, 0u, 0u};
          rv0 = ok ? *(const u32x4*)(rp + 1024 + h * 128 + 16 * wave) : (u32x4){0u, 0u, 0u, 0u}; rv1 = ok ? *(const u32x4*)(rp + 1024 + h * 128 + 16 * wave + 8) : (u32x4){0u, 0u, 0u, 0u}; }
    };
    load_chunk(0);
    __syncthreads();
    for (int ci = 0; ci < nch; ++ci) {
        int rbase, nv; chunk_rows(ci, rbase, nv);
        const u32x4 g0 = rg0, g1 = rg1;
        const LAS float* tU = tab + (1 * ML_NCH + ci) * 64; const LAS float* tMM = tab + (3 * ML_NCH + ci) * 64; const LAS float* tSI = tab + (4 * ML_NCH + ci) * 64;
        const LAS float* tFL = tab + (5 * ML_NCH + ci) * 64; const LAS float* tWP = tab + (6 * ML_NCH + ci) * 64;
        const float sold = tsc[96 + ci];
        { if (MODE == 2) { const int j = tid >> 3, c8 = (tid & 7) * 8; *(LAS u32x4*)(lds + ML_QS + (j * ML_RS + c8) * 2) = rq; }
          const float wj = tWP[lane]; LAS bf16_t* kt = (LAS bf16_t*)(lds + ML_KT); LAS bf16_t* vt = (LAS bf16_t*)(lds + ML_VT);
          if (MODE == 2) *(LAS u32x4*)(lds + ML_KS + (lane * ML_RS + 8 * wave) * 2) = rk;
          const unsigned kk[4] = {rk.x, rk.y, rk.z, rk.w}, a[4] = {rv0.x, rv0.y, rv0.z, rv0.w}, c[4] = {rv1.x, rv1.y, rv1.z, rv1.w};
#pragma unroll
          for (int e = 0; e < 4; ++e) { kt[(8 * wave + 2 * e) * ML_RS + lane] = (bf16_t)f2bf(bf2f((unsigned short)(kk[e] & 0xffffu)) * wj); kt[(8 * wave + 2 * e + 1) * ML_RS + lane] = (bf16_t)f2bf(bf2f((unsigned short)(kk[e] >> 16)) * wj);
              vt[(16 * wave + 2 * e) * ML_RS + lane] = (bf16_t)(a[e] & 0xffffu); vt[(16 * wave + 2 * e + 1) * ML_RS + lane] = (bf16_t)(a[e] >> 16);
              vt[(16 * wave + 8 + 2 * e) * ML_RS + lane] = (bf16_t)(c[e] & 0xffffu); vt[(16 * wave + 8 + 2 * e + 1) * ML_RS + lane] = (bf16_t)(c[e] >> 16); } }
        __syncthreads();
        if (ci + 1 < nch) load_chunk(ci + 1);
        f32x4 o1[4], o2[4];
        if (MODE == 2) {
            const int mt = wave >> 1;
#pragma unroll
            for (int q = 0; q < 2; ++q) { const int nt = 2 * (wave & 1) + q; f32x4 s = (f32x4){0.f, 0.f, 0.f, 0.f};
                if (nt <= mt) {
#pragma unroll
                    for (int ks = 0; ks < 2; ++ks) s = __builtin_amdgcn_mfma_f32_16x16x32_bf16(ml_frag(lds, ML_QS, 16 * mt + fr, 32 * ks + 8 * quad), ml_frag(lds, ML_KS, 16 * nt + fr, 32 * ks + 8 * quad), s, 0, 0, 0); }
                const int j = 16 * nt + fr; const float uj = tU[j];
#pragma unroll
                for (int r = 0; r < 4; ++r) { const int i = 16 * mt + 4 * quad + r; const float p = (j <= i) ? s[r] * fast_exp(uj - tMM[i]) : 0.f;
                    ((LAS bf16_t*)(lds + ML_PS))[i * ML_RS + j] = (bf16_t)f2bf(p); } }
            __syncthreads();
            bf16x8 vb[2], cb[2];
#pragma unroll
            for (int ks = 0; ks < 2; ++ks) { vb[ks] = ml_frag(lds, ML_VT, 16 * wave + fr, 32 * ks + 8 * quad); cb[ks] = ml_frag(lds, ML_CT, 16 * wave + fr, 32 * ks + 8 * quad); }
#pragma unroll
            for (int mt2 = 0; mt2 < 4; ++mt2) { o1[mt2] = (f32x4){0.f, 0.f, 0.f, 0.f}; o2[mt2] = (f32x4){0.f, 0.f, 0.f, 0.f};
#pragma unroll
                for (int ks = 0; ks < 2; ++ks) { o1[mt2] = __builtin_amdgcn_mfma_f32_16x16x32_bf16(ml_frag(lds, ML_PS, 16 * mt2 + fr, 32 * ks + 8 * quad), vb[ks], o1[mt2], 0, 0, 0);
                    o2[mt2] = __builtin_amdgcn_mfma_f32_16x16x32_bf16(ml_frag(lds, ML_QS, 16 * mt2 + fr, 32 * ks + 8 * quad), cb[ks], o2[mt2], 0, 0, 0); } }
            if (wave < 4) { f32x4 d1 = (f32x4){0.f, 0.f, 0.f, 0.f}, d2 = (f32x4){0.f, 0.f, 0.f, 0.f};
#pragma unroll
                for (int ks = 0; ks < 2; ++ks) { d1 = __builtin_amdgcn_mfma_f32_16x16x32_bf16(ml_frag(lds, ML_PS, 16 * wave + fr, 32 * ks + 8 * quad), ml_frag(lds, ML_VT, 128 + fr, 32 * ks + 8 * quad), d1, 0, 0, 0);
                    d2 = __builtin_amdgcn_mfma_f32_16x16x32_bf16(ml_frag(lds, ML_QS, 16 * wave + fr, 32 * ks + 8 * quad), ml_frag(lds, ML_CT, 128 + fr, 32 * ks + 8 * quad), d2, 0, 0, 0); }
                if (fr == 0) {
#pragma unroll
                    for (int r = 0; r < 4; ++r) { const int i = 16 * wave + 4 * quad + r; sc[320 + i] = d1[r] + tSI[i] * d2[r]; } } }
            __syncthreads();
#pragma unroll
            for (int mt2 = 0; mt2 < 4; ++mt2)
#pragma unroll
                for (int r = 0; r < 4; ++r) { const int i = 16 * mt2 + 4 * quad + r; const float num = o1[mt2][r] + tSI[i] * o2[mt2][r];
                    ((LAS float*)(lds + ML_HS))[i * ML_HSS + 16 * wave + fr] = num * __builtin_amdgcn_rcpf(fmaxf(fabsf(sc[320 + i]), tFL[i])); }
        }
        { bf16x8 vb[2];
#pragma unroll
          for (int ks = 0; ks < 2; ++ks) vb[ks] = ml_frag(lds, ML_VT, 16 * wave + fr, 32 * ks + 8 * quad);
#pragma unroll
          for (int mt2 = 0; mt2 < 4; ++mt2) { st[mt2] = st[mt2] * sold;
#pragma unroll
              for (int ks = 0; ks < 2; ++ks) st[mt2] = __builtin_amdgcn_mfma_f32_16x16x32_bf16(ml_frag(lds, ML_KT, 16 * mt2 + fr, 32 * ks + 8 * quad), vb[ks], st[mt2], 0, 0, 0); }
          if (wave < 4) { st[4] = st[4] * sold;
#pragma unroll
              for (int ks = 0; ks < 2; ++ks) st[4] = __builtin_amdgcn_mfma_f32_16x16x32_bf16(ml_frag(lds, ML_KT, 16 * wave + fr, 32 * ks + 8 * quad), ml_frag(lds, ML_VT, 128 + fr, 32 * ks + 8 * quad), st[4], 0, 0, 0); }
          if (MODE == 2) {
#pragma unroll
              for (int i = 0; i < 5; ++i) { const int dv = (i < 4) ? 16 * wave + fr : 128 + fr, dk = (i < 4) ? 16 * i + 4 * quad : 16 * wave + 4 * quad;
                  if (i < 4 || wave < 4) { u32x2 w; w.x = pk2(st[i][0], st[i][1]); w.y = pk2(st[i][2], st[i][3]); *(LAS u32x2*)(lds + ML_CT + (dv * ML_RS + dk) * 2) = w; } } }
        }
        __syncthreads();
        if (MODE == 2) {
            const int i = tid >> 3, sg = tid & 7; const LAS float* hp = (const LAS float*)(lds + ML_HS) + i * ML_HSS + 16 * sg;
            float x[16]; float s = 0.f;
#pragma unroll
            for (int e = 0; e < 16; ++e) { x[e] = hp[e]; s += x[e]; }
            s += __shfl_xor(s, 1); s += __shfl_xor(s, 2); s += __shfl_xor(s, 4);
            const float mean = s * (1.f / M_V); float q = 0.f;
#pragma unroll
            for (int e = 0; e < 16; ++e) { x[e] -= mean; q += x[e] * x[e]; }
            q += __shfl_xor(q, 1); q += __shfl_xor(q, 2); q += __shfl_xor(q, 4);
            const float rstd = 1.f / sqrtf(q * (1.f / M_V) + LN_EPS);
            if (i < nv && (nv == 64 || b == 0)) {
                const size_t row = (size_t)(rbase + i);
                const unsigned gw8[8] = {g0.x, g0.y, g0.z, g0.w, g1.x, g1.y, g1.z, g1.w}; unsigned ow[8];
#pragma unroll
                for (int e = 0; e < 8; ++e) { const float oga = bf2f((unsigned short)(gw8[e] & 0xffffu)), ogb = bf2f((unsigned short)(gw8[e] >> 16));
                    const float ya = x[2 * e] * rstd * lnh[2 * e] * __builtin_amdgcn_rcpf(1.f + fast_exp(-oga)), yb = x[2 * e + 1] * rstd * lnh[2 * e + 1] * __builtin_amdgcn_rcpf(1.f + fast_exp(-ogb));
                    ow[e] = pk2(ya, yb); }
                u32x4* op = (u32x4*)(HG + row * D + h * M_V + 16 * sg);
                op[0] = (u32x4){ow[0], ow[1], ow[2], ow[3]}; op[1] = (u32x4){ow[4], ow[5], ow[6], ow[7]};
            }
        }
    }
    if (MODE == 1) {
        f32x4* sp = (f32x4*)(STATE + (size_t)(bh * 7 + seg) * ST_FLOATS) + (wave * 5) * 64 + lane;
#pragma unroll
        for (int i = 0; i < 5; ++i) sp[i * 64] = (i < 4 || wave < 4) ? st[i] : (f32x4){0.f, 0.f, 0.f, 0.f};
        if (tid == 0) { STSC[(bh * 7 + seg) * 4 + 0] = tsc[160]; STSC[(bh * 7 + seg) * 4 + 1] = tsc[161]; }
    }
}

constexpr int AT_KRS = 72, AT_VRS = 280, AT_NK = 272;
constexpr int AT_KS = 0, AT_VT = AT_NK * AT_KRS * 2, AT_END = AT_VT + 64 * AT_VRS * 2;
static_assert(AT_END <= MISC_OFF, "attention LDS");
__device__ __forceinline__ void attn_phase(unsigned char* ws, LAS unsigned char* lds, int j_layer, int tid, int wave, int lane) {
    const bf16_t* Q = (const bf16_t*)(ws + WS_PROJ); const bf16_t* KB = (const bf16_t*)(ws + WS_KB); const bf16_t* VT = (const bf16_t*)(ws + WS_VB);
    bf16_t* HG = (bf16_t*)(ws + WS_HG);
    const float* sinks = (const float*)(ws + WS_SMALL) + SM_SINKS + j_layer * A_HEADS;
    const int fr = lane & 15, quad = lane >> 4;
    LAS bf16_t* ks = (LAS bf16_t*)(lds + AT_KS); LAS bf16_t* vt = (LAS bf16_t*)(lds + AT_VT);
    u32x4 kreg[5], vreg[5]; bf16x8 qn[4][2];
    const int NREG = NBATCH * A_KV * (SEQ / WINDOW), NIT = NREG + A_KV;
    auto prefetch = [&](int it) {
        const bool meta = it >= NREG; const int b = meta ? 0 : it >> 8, g = meta ? it - NREG : (it >> 6) & 3, blk = meta ? -1 : it & 63;
#pragma unroll
        for (int i = 0; i < 5; ++i) { const int p = tid + i * NTHREADS; kreg[i] = (u32x4){0u, 0u, 0u, 0u}; vreg[i] = (u32x4){0u, 0u, 0u, 0u};
            if (p < AT_NK * 8) { const int kk = p >> 3, c8 = (p & 7) * 8;
                int row; if (kk >= 256) row = MREAL + kk - 256; else { const int tk = (blk - 1) * WINDOW + kk; row = (tk < 0 || meta) ? -1 : b * SEQ + tk; }
                if (row >= 0) kreg[i] = *(const u32x4*)(KB + (size_t)row * 256 + g * 64 + c8);
                const int d = p / 34, pc = p % 34; const bf16_t* src = VT + (size_t)(g * 64 + d) * MP;
                if (pc >= 32) vreg[i] = *(const u32x4*)(src + MREAL + (pc - 32) * 8);
                else { const int tk = (blk - 1) * WINDOW + pc * 8; if (tk >= 0 && !meta) vreg[i] = *(const u32x4*)(src + (size_t)b * SEQ + tk); } } }
    };
    auto qload = [&](int it, int mt) {
        const bool meta = it >= NREG; const int b = it >> 8, g = meta ? it - NREG : (it >> 6) & 3, blk = it & 63, qh = g * 4 + (wave >> 1);
        const size_t rowq = meta ? (size_t)MREAL + fr : (size_t)b * SEQ + blk * WINDOW + 16 * (4 * (wave & 1) + mt) + fr;
#pragma unroll
        for (int k2 = 0; k2 < 2; ++k2) qn[mt][k2] = *(const bf16x8*)(Q + rowq * D + qh * 64 + 32 * k2 + 8 * quad);
    };
    if ((int)blockIdx.x < NIT) { prefetch(blockIdx.x);
#pragma unroll
        for (int mt = 0; mt < 4; ++mt) qload(blockIdx.x, mt); }
    for (int it = blockIdx.x; it < NIT; it += gridDim.x) {
        const bool meta = it >= NREG; const int b = it >> 8, g = meta ? it - NREG : (it >> 6) & 3, blk = it & 63;
        __syncthreads();
#pragma unroll
        for (int i = 0; i < 5; ++i) { const int p = tid + i * NTHREADS;
            if (p < AT_NK * 8) { *(LAS u32x4*)(ks + (p >> 3) * AT_KRS + (p & 7) * 8) = kreg[i]; *(LAS u32x4*)(vt + (p / 34) * AT_VRS + (p % 34) * 8) = vreg[i]; } }
        __syncthreads();
        const bool has_next = it + (int)gridDim.x < NIT;
        if (has_next) prefetch(it + gridDim.x);
        const int qh = g * 4 + (wave >> 1); const float sink = sinks[qh];
#pragma unroll
        for (int mt = 0; mt < 4; ++mt) {
            if (meta && (mt > 0 || (wave & 1))) continue;
            const int t0 = meta ? 0 : 4 * (wave & 1) + mt, qi = 16 * t0 + fr;
            const size_t rowq = meta ? (size_t)MREAL + fr : (size_t)b * SEQ + blk * WINDOW + qi;
            f32x4 s[10];
#pragma unroll
            for (int c = 0; c < 10; ++c) { const int kb = (c < 9) ? 16 * (t0 + c) : 256; s[c] = (f32x4){0.f, 0.f, 0.f, 0.f};
#pragma unroll
                for (int k2 = 0; k2 < 2; ++k2) s[c] = __builtin_amdgcn_mfma_f32_16x16x32_bf16(*(const LAS bf16x8*)(ks + (kb + fr) * AT_KRS + 32 * k2 + 8 * quad), qn[mt][k2], s[c], 0, 0, 0); }
            if (has_next) qload(it + gridDim.x, mt);
            float m = sink;
#pragma unroll
            for (int c = 0; c < 9; ++c)
#pragma unroll
                for (int r = 0; r < 4; ++r) { const int j = 16 * (t0 + c) + 4 * quad + r, rel = qi + WINDOW - j; const bool vis = !meta && (rel >= 0) && (rel < WINDOW) && (blk > 0 || j >= WINDOW);
                    s[c][r] = vis ? s[c][r] : -1.0e30f; m = fmaxf(m, s[c][r]); }
#pragma unroll
            for (int r = 0; r < 4; ++r) { const bool vis = !meta || (4 * quad + r <= fr); s[9][r] = vis ? s[9][r] : -1.0e30f; m = fmaxf(m, s[9][r]); }
            m = fmaxf(m, __shfl_xor(m, 16)); m = fmaxf(m, __shfl_xor(m, 32));
            float sm = 0.f;
#pragma unroll
            for (int c = 0; c < 10; ++c)
#pragma unroll
                for (int r = 0; r < 4; ++r) { const float p = fast_exp(s[c][r] - m); s[c][r] = p; sm += p; }
            sm += __shfl_xor(sm, 16); sm += __shfl_xor(sm, 32);
            const float inv = 1.f / (sm + fast_exp(sink - m));
            f32x4 o[4];
#pragma unroll
            for (int dt = 0; dt < 4; ++dt) o[dt] = (f32x4){0.f, 0.f, 0.f, 0.f};
#pragma unroll
            for (int u = 0; u < 5; ++u) {
                const int kb0 = 16 * (t0 + 2 * u), kb1 = (u < 4) ? 16 * (t0 + 2 * u + 1) : 256;
                u32x4 pw; pw.x = cvt_pk_bf16(s[2 * u][0], s[2 * u][1]); pw.y = cvt_pk_bf16(s[2 * u][2], s[2 * u][3]); pw.z = cvt_pk_bf16(s[2 * u + 1][0], s[2 * u + 1][1]); pw.w = cvt_pk_bf16(s[2 * u + 1][2], s[2 * u + 1][3]);
                const bf16x8 pf = __builtin_bit_cast(bf16x8, pw);
#pragma unroll
                for (int dt = 0; dt < 4; ++dt) { const LAS bf16_t* vr = vt + (16 * dt + fr) * AT_VRS + 4 * quad;
                    u32x4 vw; const u32x2 a = *(const LAS u32x2*)(vr + kb0), c2 = *(const LAS u32x2*)(vr + kb1); vw.x = a.x; vw.y = a.y; vw.z = c2.x; vw.w = c2.y;
                    o[dt] = __builtin_amdgcn_mfma_f32_16x16x32_bf16(__builtin_bit_cast(bf16x8, vw), pf, o[dt], 0, 0, 0); } }
#pragma unroll
            for (int dt = 0; dt < 4; ++dt) { u32x2 w; w.x = cvt_pk_bf16(o[dt][0] * inv, o[dt][1] * inv); w.y = cvt_pk_bf16(o[dt][2] * inv, o[dt][3] * inv);
                *(u32x2*)(HG + rowq * D + qh * 64 + 16 * dt + 4 * quad) = w; }
        }
    }
}

#ifndef SITES
#define SITES 0xFFFF
#endif
#define SITE(n) ((SITES >> (n)) & 1)
#ifndef DUPMASK
#define DUPMASK 0
#endif
#define REPS(n) (1 + ((DUPMASK >> (n)) & 1))
#ifndef MK_PER_PHASE
#define MK_PER_PHASE 0
#endif
constexpr int PH_PER_LAYER = 12, N_PHASES = 1 + 4 * PH_PER_LAYER;

__global__ void __launch_bounds__(NTHREADS, 2) fwd(Params P) {
    extern __shared__ __attribute__((aligned(16))) unsigned char lds_raw[];
    LAS unsigned char* const lds0 = (LAS unsigned char*)lds_raw;
    const int G = gridDim.x;
    const int vcu = (G % 8 == 0) ? ((int)blockIdx.x % 8) * (G / 8) + (int)blockIdx.x / 8 : (int)blockIdx.x;
    const int NGW = G * NWAVES;
    unsigned char* const wsbase = P.ws;
    volatile LAS unsigned* misc = (volatile LAS unsigned*)(lds0 + MISC_OFF);
    if (threadIdx.x < 64) misc[threadIdx.x] = 0u;
    __syncthreads();
    XcdBarrier bar = xcd_barrier_post((unsigned*)(wsbase + WS_CTL) + CW_BAR + P.li * 4096, misc + 8);
    const int lo = P.ph_lo, hi = P.ph_hi;
#define RUN(idx) ((idx) >= lo && (idx) < hi)
#define SEAM(idx) do { if ((idx) + 1 < hi) xcd_barrier(bar); } while (0)
#define IDS() int tid = threadIdx.x; asm volatile("; opaque tid" : "+v"(tid)); unsigned char* ws = wsbase; asm volatile("; opaque ws" : "+s"(ws)); \
              LAS unsigned char* lds = lds0; asm volatile("; opaque lds" : "+s"(lds)); \
              const int lane = tid & 63, wave = __builtin_amdgcn_readfirstlane(tid >> 6); const int gw = vcu * NWAVES + wave; (void)lane; (void)gw; (void)ws

    for (int rep = 0; rep < REPS(0); ++rep) if (SITE(0) && RUN(0)) { IDS(); p0_prologue(P, lds, gw, NGW, wave, lane); SEAM(0); }

    for (int l = 0; l < 4; ++l) {
        const int pb = 1 + l * PH_PER_LAYER;
        const bool moe = (l & 1) != 0; const int fi = l >> 1;
        if (l < 2) {
            for (int rep = 0; rep < REPS(1); ++rep) if (SITE(1) && RUN(pb + 0)) {
                IDS();
                pg8::DenseOrder S; S.init(MREAL / 256, 12, G, (int)blockIdx.x);
                EpiProj E{(bf16_t*)(ws + WS_PROJ), (float*)(ws + WS_GATES), (const float*)(ws + WS_SMALL) + SM_BGATE + l * 16};
                const bf16_t* HBp = (const bf16_t*)(ws + WS_HB); const bf16_t* Wp = (const bf16_t*)(ws + WS_WIN) + (size_t)l * M_INP * D;
                pg8::gemm_phase(lds, HBp, Wp, D, S, E);
                bf16_t* PROJ = (bf16_t*)(ws + WS_PROJ); float* GATES = (float*)(ws + WS_GATES); const float* bg = (const float*)(ws + WS_SMALL) + SM_BGATE + l * 16;
                int par = 0;
                for (int item = (int)blockIdx.x; item < 192; item += G, par ^= 1) { const bf16_t* B1[1] = {Wp + (size_t)item * 16 * D};
                    skinny_item<1>(HBp + (size_t)MREAL * D, D, B1, D, wave, lane, lds, par, [&](const f32x4 (&a)[1], int fr, int quad) {
#pragma unroll
                        for (int r = 0; r < 4; ++r) PROJ[(size_t)(MREAL + 4 * quad + r) * PROJ_LD + item * 16 + fr] = (bf16_t)f2bf(a[0][r]); }); }
                { const int fr = lane & 15, quad = lane >> 4; const bf16_t* bp = Wp + (size_t)(3072 + fr) * D + 8 * quad; const float bias = bg[fr];
                  for (int rt = gw; rt < MV / 16; rt += NGW) { const bf16_t* ap = HBp + (size_t)(rt * 16 + fr) * D + 8 * quad;
                      f32x4 a0 = (f32x4){0.f, 0.f, 0.f, 0.f}, a1 = (f32x4){0.f, 0.f, 0.f, 0.f};
#pragma unroll 8
                      for (int k = 0; k < D; k += 64) { a0 = __builtin_amdgcn_mfma_f32_16x16x32_bf16(*(const bf16x8*)(ap + k), *(const bf16x8*)(bp + k), a0, 0, 0, 0);
                          a1 = __builtin_amdgcn_mfma_f32_16x16x32_bf16(*(const bf16x8*)(ap + k + 32), *(const bf16x8*)(bp + k + 32), a1, 0, 0, 0); }
#pragma unroll
                      for (int r = 0; r < 4; ++r) GATES[(size_t)(rt * 16 + 4 * quad + r) * 16 + fr] = a0[r] + a1[r] + bias; } }
                SEAM(pb + 0); }
            for (int rep = 0; rep < REPS(2); ++rep) if (SITE(2) && RUN(pb + 1)) { IDS(); mlstm_phase<1>(ws, lds, l, tid, wave, lane); SEAM(pb + 1); }
            for (int rep = 0; rep < REPS(3); ++rep) if (SITE(3) && RUN(pb + 2)) { IDS(); mlstm_phase<2>(ws, lds, l, tid, wave, lane); SEAM(pb + 2); }
        } else {
            for (int rep = 0; rep < REPS(4); ++rep) if (SITE(4) && RUN(pb + 0)) {
                IDS();
                pg8::DenseOrder S; S.init(MREAL / 256, l == 2 ? 6 : 4, G, (int)blockIdx.x);
                EpiQKV E{(bf16_t*)(ws + WS_PROJ), (bf16_t*)(ws + WS_KB), (bf16_t*)(ws + WS_VB), (const float*)(ws + WS_ROPE)};
                const bf16_t* HBp = (const bf16_t*)(ws + WS_HB); const bf16_t* Wp = (const bf16_t*)(ws + (l == 2 ? WS_WQKV : WS_WQ3));
                pg8::gemm_phase(lds, HBp, Wp, D, S, E);
                bf16_t* Qp = (bf16_t*)(ws + WS_PROJ); bf16_t* KBp = (bf16_t*)(ws + WS_KB); bf16_t* VTp = (bf16_t*)(ws + WS_VB); const float* rope = (const float*)(ws + WS_ROPE);
                int par = 0;
                for (int item = (int)blockIdx.x; item < (l == 2 ? 96 : 64); item += G, par ^= 1) { const bf16_t* B1[1] = {Wp + (size_t)item * 16 * D};
                    skinny_item<1>(HBp + (size_t)MREAL * D, D, B1, D, wave, lane, lds, par, [&](const f32x4 (&a)[1], int fr, int quad) {
                        const int col = item * 16 + fr; const bool dorope = (item < 80) && ((item & 3) == 0);
#pragma unroll
                        for (int r = 0; r < 4; ++r) { const int pos = 4 * quad + r; float x = a[0][r]; const float y = __shfl_xor(x, 8);
                            if (dorope) { const float c = rope[pos * 16 + (fr & 7)], sn = rope[pos * 16 + 8 + (fr & 7)]; x = (fr < 8) ? x * c - y * sn : x * c + y * sn; }
                            const bf16_t o = (bf16_t)f2bf(x); const size_t row = (size_t)MREAL + pos;
                            if (item < 64) Qp[row * D + col] = o; else if (item < 80) KBp[row * 256 + col - 1024] = o; else VTp[(size_t)(col - 1280) * MP + row] = o; } });
                }
                SEAM(pb + 0); }
            for (int rep = 0; rep < REPS(5); ++rep) if (SITE(5) && RUN(pb + 1)) { IDS(); attn_phase(ws, lds, l - 2, tid, wave, lane); SEAM(pb + 1); }
        }
        for (int rep = 0; rep < REPS(6); ++rep) if (SITE(6) && RUN(pb + 3)) {
            IDS();
            pg8::DenseOrder S; S.init(MREAL / 256, 4, G, (int)blockIdx.x);
            const float* smp = (const float*)(ws + WS_SMALL);
            EpiRes E{(float*)(ws + WS_H), (const float*)(ws + WS_STATS), l > 0 ? smp + SM_LNG + (size_t)(2 * l - 1) * D : nullptr, smp + SM_LNB + (size_t)(l > 0 ? 2 * l - 1 : 0) * D, l > 0 ? (const float*)(ws + WS_H) : P.in[I_X], 1.f};
            const bf16_t* Ap = (const bf16_t*)(ws + WS_HG); const bf16_t* Wp = (const bf16_t*)(ws + (l < 2 ? WS_WOUT : WS_WO)) + (size_t)(l & 1) * D * D;
            pg8::gemm_phase(lds, Ap, Wp, D, S, E);
            int par = 0;
            for (int item = (int)blockIdx.x; item < 64; item += G, par ^= 1) { const bf16_t* B1[1] = {Wp + (size_t)item * 16 * D};
                skinny_item<1>(Ap + (size_t)MREAL * D, D, B1, D, wave, lane, lds, par, [&](const f32x4 (&a)[1], int fr, int quad) { const int col = item * 16 + fr;
#pragma unroll
                    for (int r = 0; r < 4; ++r) { const size_t row = (size_t)MREAL + 4 * quad + r; float h = E.lg ? E.H[row * D + col] : P.in[I_META][(size_t)(4 * quad + r) * D + col];
                        if (E.lg) h = (h - E.stats[2 * row]) * E.stats[2 * row + 1] * E.lg[col] + E.lb[col];
                        E.H[row * D + col] = h * ALPHA + a[0][r]; } });
            }
            SEAM(pb + 3); }
        for (int rep = 0; rep < (moe ? 1 : REPS(7)); ++rep) if (SITE(7) && RUN(pb + 4)) { IDS(); ln_phase(ws, nullptr, lds, gw, NGW, lane, tid, l * 2 + 0, false, moe, fi, false); SEAM(pb + 4); }
        if (!moe) {
            for (int rep = 0; rep < REPS(8); ++rep) if (SITE(8) && RUN(pb + 5)) {
                IDS();
                pg8::DenseOrder S; S.init(MREAL / 256, 2 * D_FF / 256, G, (int)blockIdx.x);
                EpiSwiglu8 E{ws + WS_ACT, D_FF, 1.f};
                const bf16_t* HBp = (const bf16_t*)(ws + WS_HB); const bf16_t* Wp = (const bf16_t*)(ws + WS_WGU) + (size_t)fi * 2 * D_FF * D;
                pg8::gemm_phase(lds, HBp, Wp, D, S, E);
                int par = 0;
                for (int item = (int)blockIdx.x; item < D_FF / 16; item += G, par ^= 1) {
                    const int brow = 256 * (item >> 3) + 16 * (item & 7); const bf16_t* B2[2] = {Wp + (size_t)brow * D, Wp + (size_t)(brow + 128) * D};
                    skinny_item<2>(HBp + (size_t)MREAL * D, D, B2, D, wave, lane, lds, par, [&](const f32x4 (&a)[2], int fr, int quad) {
#pragma unroll
                        for (int r = 0; r < 4; ++r) E.act[(size_t)(MREAL + 4 * quad + r) * D_FF + item * 16 + fr] = (unsigned char)(pk4_fp8(EpiSwiglu::silu_mul(a[0][r], a[1][r]) * F8_SACT, 0.f, 0.f, 0.f) & 0xffu); });
                }
                SEAM(pb + 5); }
            for (int rep = 0; rep < REPS(9); ++rep) if (SITE(9) && RUN(pb + 6)) {
                IDS();
                pg8::DenseOrder S; S.init(MREAL / 256, 4, G, (int)blockIdx.x);
                const float* smp = (const float*)(ws + WS_SMALL);
                EpiRes E{(float*)(ws + WS_H), (const float*)(ws + WS_STATS), smp + SM_LNG + (size_t)(2 * l) * D, smp + SM_LNB + (size_t)(2 * l) * D, (const float*)(ws + WS_H), F8_INVD};
                const unsigned char* Ap = ws + WS_ACT; const unsigned char* Wp = ws + WS_WDN8 + (size_t)fi * D * D_FF;
                pg8::gemm_phase<EpiRes, pg8::DenseOrder, true>(lds, Ap, Wp, D_FF, S, E);
                int par = 0;
                for (int item = (int)blockIdx.x; item < 64; item += G, par ^= 1) { const unsigned char* B1[1] = {Wp + (size_t)item * 16 * D_FF};
                    skinny_item8<1>(Ap + (size_t)MREAL * D_FF, D_FF, B1, D_FF, wave, lane, lds, par, [&](const f32x4 (&a)[1], int fr, int quad) { const int col = item * 16 + fr;
#pragma unroll
                        for (int r = 0; r < 4; ++r) { const size_t row = (size_t)MREAL + 4 * quad + r; float h = E.H[row * D + col];
                            h = (h - E.stats[2 * row]) * E.stats[2 * row + 1] * E.lg[col] + E.lb[col];
                            E.H[row * D + col] = h * ALPHA + a[0][r] * E.sc; } });
                }
                SEAM(pb + 6); }
        } else {
            for (int rep = 0; rep < REPS(10); ++rep) if (SITE(10) && RUN(pb + 5)) { IDS(); assign_phase(ws, gw, NGW, lane, tid, fi); SEAM(pb + 5); }
            for (int rep = 0; rep < REPS(11); ++rep) if (SITE(11) && RUN(pb + 6)) {
                IDS();
                int cnt[8]; pg8::GroupedOrder S; moe_starts(ws, fi, cnt, S.pstart);
                S.o.init(S.pstart[8], 2 * D_FF_EXP / 256, G, (int)blockIdx.x); S.nexp_rows = 2 * D_FF_EXP; S.rowtok = (const int*)(ws + WS_ROWTOK);
                EpiSwiglu8 E{ws + WS_ACT, D_FF_EXP, F8_INV};
                pg8::gemm_phase<EpiSwiglu8, pg8::GroupedOrder, true>(lds, ws + WS_HB8, ws + WS_WGUE8 + (size_t)fi * 8 * 2 * D_FF_EXP * D, D, S, E);
                SEAM(pb + 6); }
            for (int rep = 0; rep < REPS(12); ++rep) if (SITE(12) && RUN(pb + 7)) {
                IDS();
                int cnt[8]; pg8::GroupedOrder S; moe_starts(ws, fi, cnt, S.pstart);
                S.o.init(S.pstart[8], 4, G, (int)blockIdx.x); S.nexp_rows = D; S.rowtok = nullptr;
                EpiScatter E{(bf16_t*)(ws + WS_CONTRIB), (const int*)(ws + WS_ROWDST), (const float*)(ws + WS_ROWGATE), F8_INVD};
                pg8::gemm_phase<EpiScatter, pg8::GroupedOrder, true>(lds, ws + WS_ACT, ws + WS_WDNE8 + (size_t)fi * 8 * D * D_FF_EXP, D_FF_EXP, S, E);
                SEAM(pb + 7); }
        }
        for (int rep = 0; rep < (moe ? 1 : REPS(13)); ++rep) if (SITE(13) && RUN(pb + 10)) { IDS(); ln_phase(ws, P.out, lds, gw, NGW, lane, tid, l * 2 + 1, moe, false, 0, l == 3); SEAM(pb + 10); }
    }
#undef RUN
#undef SEAM
#undef IDS
}

extern "C" void kernel_launch(void* const* d_in, const int* in_sizes, int n_in, void* d_out, int out_size, void* d_ws, size_t ws_size, hipStream_t stream) {
    static int grid = 0;
    if (grid == 0) {
        if (n_in != 18 || out_size != MREAL * D || ws_size < WS_END) { fprintf(stderr, "kernel_launch: unexpected shapes (n_in %d, out %d, ws %zu < %zu)\n", n_in, out_size, ws_size, (size_t)WS_END); grid = -1; return; }
        int dev = 0, cus = 0, per_cu = 0;
        if (hipGetDevice(&dev) != hipSuccess || hipDeviceGetAttribute(&cus, hipDeviceAttributeMultiprocessorCount, dev) != hipSuccess) { grid = -1; return; }
        if (hipFuncSetAttribute((const void*)fwd, hipFuncAttributeMaxDynamicSharedMemorySize, LDS_BYTES) != hipSuccess) { fprintf(stderr, "kernel_launch: hipFuncSetAttribute failed\n"); grid = -1; return; }
        if (hipOccupancyMaxActiveBlocksPerMultiprocessor(&per_cu, (const void*)fwd, NTHREADS, LDS_BYTES) != hipSuccess || per_cu < 1) fprintf(stderr, "kernel_launch: occupancy query reports %d\n", per_cu);
        (void)hipGetLastError();
        grid = cus > 256 ? 256 : cus;
    }
    if (grid < 0) return;
    (void)in_sizes;
    if (hipMemsetAsync((char*)d_ws + WS_CTL, 0, CTL_BYTES, stream) != hipSuccess) return;
    Params p{};
    for (int i = 0; i < 18; ++i) p.in[i] = (const float*)d_in[i];
    p.out = (float*)d_out; p.ws = (unsigned char*)d_ws;
#if MK_PER_PHASE
    int li = 0;
    for (int ph = 0; ph < N_PHASES; ++ph) {
        const int k = (ph - 1) % PH_PER_LAYER, l = (ph - 1) / PH_PER_LAYER;
        if (ph > 0) { const bool moe = l & 1; if (k == 2 && l >= 2) continue; if (k == 8 || k == 9 || k == 11) continue; if (k == 7 && !moe) continue; }
        p.ph_lo = ph; p.ph_hi = ph + 1; p.li = li++; p.pad = 0;
        hipLaunchKernelGGL(fwd, dim3(grid), dim3(NTHREADS), LDS_BYTES, stream, p);
    }
#else
    p.ph_lo = 0; p.ph_hi = N_PHASES; p.li = 0; p.pad = 0;
    hipLaunchKernelGGL(fwd, dim3(grid), dim3(NTHREADS), LDS_BYTES, stream, p);
#endif
}
```

```cpp
#include <hip/hip_runtime.h>
#include <cstdio>
#include <cstdint>

#define LAS __attribute__((address_space(3)))
#define GAS __attribute__((address_space(1)))
typedef unsigned short bf16_t;
typedef short bf16x8 __attribute__((ext_vector_type(8)));
typedef float f32x4 __attribute__((ext_vector_type(4)));
typedef float f32x2 __attribute__((ext_vector_type(2)));
typedef unsigned u32x4 __attribute__((ext_vector_type(4)));
typedef unsigned u32x2 __attribute__((ext_vector_type(2)));
typedef int i32x8 __attribute__((ext_vector_type(8)));

constexpr int D = 1024, NBATCH = 4, SEQ = 8192, NMETA = 16;
constexpr int MREAL = NBATCH * SEQ;
constexpr int MV = MREAL + NMETA;
constexpr int MP = 129 * 256;
constexpr int M_HEADS = 8, M_QK = 64, M_V = 128;
constexpr int M_IN = 3088, M_INP = 3328;
constexpr int PROJ_LD = 3072;
constexpr int A_HEADS = 16, A_KV = 4, A_HD = 64, WINDOW = 128;
constexpr int D_FF = 2816, N_EXP = 8, D_FF_EXP = 3584;
constexpr float ALPHA = 1.681792830507429f;
constexpr float LN_EPS = 1e-5f;
constexpr int RP = 265 * 256;
constexpr int NSEG = 8, SEG_CHUNKS = 16;
constexpr int ST_FLOATS = 8 * 5 * 64 * 4;

constexpr size_t MiB = 1u << 20;
constexpr size_t al(size_t x) { return (x + 4095) & ~(size_t)4095; }
constexpr size_t WS_CTL = 0, CTL_BYTES = 1 * MiB;
constexpr size_t WS_WIN = WS_CTL + CTL_BYTES;
constexpr size_t WS_WOUT = WS_WIN + al((size_t)2 * M_INP * D * 2);
constexpr size_t WS_WQKV = WS_WOUT + al((size_t)2 * D * D * 2);
constexpr size_t WS_WQ3 = WS_WQKV + al((size_t)1536 * D * 2);
constexpr size_t WS_WO = WS_WQ3 + al((size_t)D * D * 2);
constexpr size_t WS_WGU = WS_WO + al((size_t)2 * D * D * 2);
constexpr size_t WS_WDN = WS_WGU + al((size_t)2 * 2 * D_FF * D * 2);
constexpr size_t WS_WGUE = WS_WDN + al((size_t)2 * D * D_FF * 2);
constexpr size_t WS_WDNE = WS_WGUE + al((size_t)16 * 2 * D_FF_EXP * D * 2);
constexpr size_t WS_H = WS_WDNE + al((size_t)16 * D * D_FF_EXP * 2);
constexpr size_t WS_HB = WS_H + al((size_t)MP * D * 4);
constexpr size_t WS_PROJ = WS_HB + al((size_t)MP * D * 2);
constexpr size_t WS_HG = WS_PROJ + (size_t)MP * PROJ_LD * 2;
constexpr size_t WS_CONTRIB = WS_PROJ;
constexpr size_t WS_KB = WS_HG + al((size_t)MP * D * 2);
constexpr size_t WS_VB = WS_KB + al((size_t)MP * 256 * 2);
constexpr size_t WS_GATES = WS_VB + al((size_t)MP * 256 * 2);
constexpr size_t WS_ACT = WS_GATES + al((size_t)MP * 16 * 4);
constexpr size_t WS_STATE = WS_ACT + al((size_t)RP * D_FF_EXP * 2);
constexpr size_t WS_STSC = WS_STATE + al((size_t)32 * 7 * ST_FLOATS * 4);
constexpr size_t WS_ROPE = WS_STSC + al((size_t)32 * 7 * 4 * 4);
constexpr size_t WS_TOPE = WS_ROPE + al((size_t)8208 * 16 * 4);
constexpr size_t WS_TOPG = WS_TOPE + al((size_t)MP * 4);
constexpr size_t WS_ROWTOK = WS_TOPG + al((size_t)MP * 8);
constexpr size_t WS_ROWDST = WS_ROWTOK + al((size_t)RP * 4);
constexpr size_t WS_ROWGATE = WS_ROWDST + al((size_t)RP * 4);
constexpr size_t WS_HB8 = WS_ROWGATE + al((size_t)RP * 4);
constexpr size_t WS_WGUE8 = WS_HB8 + al((size_t)MP * D);
constexpr size_t WS_WDNE8 = WS_WGUE8 + al((size_t)16 * 2 * D_FF_EXP * D);
constexpr size_t WS_WDN8 = WS_WDNE8 + al((size_t)16 * D * D_FF_EXP);
constexpr size_t WS_STATS = WS_WDN8 + al((size_t)2 * D * D_FF);
constexpr size_t WS_SMALL = WS_STATS + al((size_t)MP * 8);
constexpr int SM_BGATE = 0, SM_SINKS = 32, SM_BROUTER = 64, SM_LNH = 128, SM_LNG = SM_LNH + 2 * D, SM_LNB = SM_LNG + 8 * D, SM_WROUTER = SM_LNB + 8 * D, SM_END = SM_WROUTER + 2 * D * N_EXP;
constexpr size_t WS_END = WS_SMALL + al((size_t)SM_END * 4);
static_assert((size_t)MP * 2 * D * 4 <= (WS_KB - WS_PROJ), "contrib overlay fits PROJ+HG");
static_assert(WS_END <= (size_t)1792 * MiB, "workspace map exceeds the guaranteed d_ws size");

constexpr int CW_CNT = 1024;
constexpr int CW_CUR = 1024 + 256;
constexpr int CW_BAR = 16384;

constexpr int LDS_BYTES = 163840 - 512;
constexpr int RING_BYTES = 131072;
constexpr int MISC_OFF = LDS_BYTES - 256;

__device__ __forceinline__ unsigned f2bf(float f) { unsigned u = __builtin_bit_cast(unsigned, f); return (u + 0x7fffu + ((u >> 16) & 1u)) >> 16; }
__device__ __forceinline__ unsigned pk2(float lo, float hi) { return f2bf(lo) | (f2bf(hi) << 16); }
__device__ __forceinline__ unsigned cvt_pk_bf16(float lo, float hi) { unsigned r; asm volatile("v_cvt_pk_bf16_f32 %0, %1, %2" : "=v"(r) : "v"(lo), "v"(hi)); return r; }
__device__ __forceinline__ float bf2f(unsigned short b) { return __builtin_bit_cast(float, ((unsigned)b) << 16); }
__device__ __forceinline__ float wave_sum(float v) {
#pragma unroll
    for (int o = 1; o < 64; o <<= 1) v += __shfl_xor(v, o);
    return v;
}
__device__ __forceinline__ float fast_exp(float x) { return __builtin_amdgcn_exp2f(x * 1.4426950408889634f); }
__device__ __forceinline__ unsigned pk4_fp8(float a, float b, float c, float d) {
    a = __builtin_amdgcn_fmed3f(a, -448.f, 448.f); b = __builtin_amdgcn_fmed3f(b, -448.f, 448.f); c = __builtin_amdgcn_fmed3f(c, -448.f, 448.f); d = __builtin_amdgcn_fmed3f(d, -448.f, 448.f);
    int p = __builtin_amdgcn_cvt_pk_fp8_f32(a, b, 0, false); p = __builtin_amdgcn_cvt_pk_fp8_f32(c, d, p, true); return (unsigned)p; }
constexpr float F8_SA = 16.f, F8_SB = 256.f, F8_INV = 1.f / (16.f * 256.f);
constexpr float F8_SACT = 8.f, F8_SBD = 1024.f, F8_INVD = 1.f / (8.f * 1024.f);
#define LDS_WAIT() asm volatile("s_waitcnt lgkmcnt(0)" ::: "memory")
#define VM_WAIT() asm volatile("s_waitcnt vmcnt(0)" ::: "memory")

#define XB_TMO      128
#define XB_XCNT(j)  (256  + 64 * (j))
#define XB_XSUB(j)  (1280 + 64 * (j))
#define XB_XGEN(j)  (2304 + 64 * (j))
#define XB_TOP      3328
#define XB_TOPGEN   3392
#define XCD_BAR_WORDS 3456
#define XB_SPIN_CAP (1u << 18)
__device__ __forceinline__ unsigned xb_ld(unsigned* p)              { return __hip_atomic_load(p, __ATOMIC_RELAXED, __HIP_MEMORY_SCOPE_AGENT); }
__device__ __forceinline__ unsigned xb_add(unsigned* p, unsigned v) { return __hip_atomic_fetch_add(p, v, __ATOMIC_RELAXED, __HIP_MEMORY_SCOPE_AGENT); }
__device__ __forceinline__ unsigned xb_xcc_id() { return (unsigned)__builtin_amdgcn_s_getreg((3 << 11) | 20) & 0xFu; }
#define XB_SPIN(cond, bar) do { unsigned _sp = 0; while (cond) { __builtin_amdgcn_s_sleep(1); \
    if ((++_sp & 255u) == 0u) { if (xb_ld(&(bar)[XB_TMO])) break; if (_sp > XB_SPIN_CAP) { atomicAdd(&(bar)[XB_TMO], 1u); break; } } } } while (0)
struct XcdBarrier { unsigned* bar; unsigned x; volatile LAS unsigned* st; };
__device__ __forceinline__ XcdBarrier xcd_barrier_post(unsigned* bar, volatile LAS unsigned* st) {
    XcdBarrier b; b.bar = bar; b.x = xb_xcc_id(); b.st = st;
    if (threadIdx.x == 0) (void)xb_add(&bar[XB_XCNT(b.x)], 1u);
    return b;
}
__device__ __forceinline__ void xcd_barrier_complete(unsigned* bar, unsigned x, unsigned& nloc, unsigned& nx) {
    const unsigned G = gridDim.x * gridDim.y * gridDim.z;
    unsigned sum, cnt, mine, sp = 0u;
    for (;;) {
        sum = 0u; cnt = 0u; mine = 0u;
#pragma unroll
        for (unsigned j = 0; j < 16; ++j) { const unsigned c = xb_ld(&bar[XB_XCNT(j)]); sum += c; cnt += (c > 0u) ? 1u : 0u; mine = (j == x) ? c : mine; }
        if (sum == G) break;
        __builtin_amdgcn_s_sleep(1);
        if ((++sp & 255u) == 0u) { if (xb_ld(&bar[XB_TMO])) break; if (sp > XB_SPIN_CAP) { atomicAdd(&bar[XB_TMO], 1u); break; } }
    }
    nloc = mine > 0u ? mine : 1u; nx = cnt > 0u ? cnt : 1u;
}
__device__ __forceinline__ void xcd_barrier(const XcdBarrier& b) {
    asm volatile("s_waitcnt vmcnt(0)" ::: "memory");
    __syncthreads();
    if (threadIdx.x == 0) {
        unsigned* bar = b.bar;
        __builtin_amdgcn_s_waitcnt(0);
        unsigned nloc = b.st[0], nx = b.st[1];
        if (nloc == 0u) { xcd_barrier_complete(bar, b.x, nloc, nx); b.st[0] = nloc; b.st[1] = nx; }
        const unsigned old = xb_add(&bar[XB_XSUB(b.x)], 1u);
        const unsigned gen = old / nloc;
        if (old + 1u == (gen + 1u) * nloc) {
            __builtin_amdgcn_fence(__ATOMIC_RELEASE, "agent");
            asm volatile("s_waitcnt vmcnt(0)" ::: "memory");
            const unsigned og = xb_add(&bar[XB_TOP], 1u);
            const unsigned tg = og / nx;
            if (og + 1u == (tg + 1u) * nx) xb_add(&bar[XB_TOPGEN], 1u);
            else XB_SPIN(xb_ld(&bar[XB_TOPGEN]) == tg, bar);
            __builtin_amdgcn_fence(__ATOMIC_ACQUIRE, "agent");
            xb_add(&bar[XB_XGEN(b.x)], 1u);
            asm volatile("s_waitcnt vmcnt(0)" ::: "memory");
        } else {
            XB_SPIN(xb_ld(&bar[XB_XGEN(b.x)]) == gen, bar);
            __builtin_amdgcn_fence(__ATOMIC_ACQUIRE, "agent");
            asm volatile("s_waitcnt vmcnt(0)" ::: "memory");
        }
    }
    __syncthreads();
}

namespace pg8 {
constexpr int BM = 256, BK = 64, HALF = 128, HTB = HALF * BK * 2, STAGE_BYTES = 8 * HTB, NXCD = 8, WGM = 8;
__host__ __device__ __forceinline__ int lds_byte(int r, int c) { const int st = (r >> 4) * 2 + (c >> 5), rr = r & 15, cc = c & 31, ob = rr * 64 + cc * 2; return st * 1024 + (ob ^ (((ob >> 9) & 1) << 5)); }
__host__ __device__ __forceinline__ void stage_rc(int b, int& R, int& C) { const int st = b / 1024, sb = b % 1024, swz = sb ^ (((sb >> 9) & 1) << 5); R = (st >> 1) * 16 + swz / 64; C = (st & 1) * 32 + (swz % 64) / 2; }
__host__ __device__ __forceinline__ int perm32(int rho) { const int n = rho >> 4, i = rho & 15; return 8 * (i >> 2) + 4 * n + (i & 3); }

struct Unit { int pm, pn, brow; };

struct DenseOrder {
    int nM, nN, nwg, G, c;
    __device__ void init(int nM_, int nN_, int G_, int c_) { nM = nM_; nN = nN_; nwg = nM * nN; G = G_; c = c_; }
    __device__ __forceinline__ bool next(int i, Unit& u) const {
        const long L = (long)i * G + c; if (L >= nwg) return false;
        int wgid = (int)L; { const int q = nwg / NXCD, r = nwg % NXCD, xcd = wgid % NXCD, off = wgid / NXCD; wgid = (xcd < r ? xcd * (q + 1) : r * (q + 1) + (xcd - r) * q) + off; }
        const int nig = WGM * nN, gid = wgid / nig, fm = gid * WGM, gsz = (nM - fm) < WGM ? (nM - fm) : WGM;
        u.pm = fm + ((wgid % nig) % gsz); u.pn = (wgid % nig) / gsz; u.brow = u.pn * BM; return true;
    }
    __device__ __forceinline__ int a_row(const Unit& u, int r) const { return u.pm * BM + r; }
};
struct GroupedOrder {
    DenseOrder o; int pstart[9]; int nexp_rows;
    const int* rowtok;
    __device__ __forceinline__ bool next(int i, Unit& u) const {
        if (!o.next(i, u)) return false;
        int e = 0;
#pragma unroll
        for (int k = 1; k < 8; ++k) e += (u.pm >= pstart[k]) ? 1 : 0;
        u.brow = e * nexp_rows + u.pn * BM; return true;
    }
    __device__ __forceinline__ int a_row(const Unit& u, int r) const {
        const int pos = u.pm * BM + r; if (!rowtok) return pos;
        const int t = rowtok[pos]; return t < 0 ? 0 : t;
    }
};

template <class Epi, class Sched, bool FP8 = false>
__device__ __forceinline__ void gemm_phase(LAS unsigned char* lds, const void* Abase, const void* Btbase, const int K, const Sched& S, const Epi& E) {
    constexpr int ES = FP8 ? 1 : 2;
    int tid = threadIdx.x; asm volatile("; opaque tid" : "+v"(tid));
    const int wid = __builtin_amdgcn_readfirstlane(tid >> 6), lane = tid & 63, wr = wid >> 2, wc = wid & 3, fr = lane & 15, fq = lane >> 4;
    const int nt = K * ES / 128;
    unsigned voffB[2];
#pragma unroll
    for (int i = 0; i < 2; ++i) { int R, C; stage_rc(tid * 16 + i * 8192, R, C); const int Rb = Epi::PERM ? ((R & ~31) + perm32(R & 31)) : R; voffB[i] = (unsigned)(Rb * K * ES + C * 2); }
    const size_t kstep = (size_t)128;
    const size_t hstep = (size_t)HALF * K * ES;
    const unsigned ldsw = (unsigned)wid * 1024u;
    const int aoff = FP8 ? lds_byte(wr * 64 + fr, 16 * (fq & 1)) + (fq >> 1) * 1024 : lds_byte(wr * 64 + fr, fq * 8);
    const int boff = FP8 ? lds_byte(wc * 32 + fr, 16 * (fq & 1)) + (fq >> 1) * 1024 : lds_byte(wc * 32 + fr, fq * 8);
#define PG8_SA(b, h) (((b) * 2 + (h)) * HTB)
#define PG8_SB(b, h) ((4 + (b) * 2 + (h)) * HTB)
#define PG8_STAGE(bufoff, gbase, voff) do { const char* _gb = (const char*)(gbase); asm volatile("" : "+s"(_gb)); _Pragma("unroll") for (int _i = 0; _i < 2; ++_i) \
        __builtin_amdgcn_global_load_lds((const unsigned*)(_gb + (voff)[_i]), (LAS unsigned*)(lds + (bufoff) + ldsw + _i * 8192), 16, 0, 0); } while (0)
#define PG8_LDA(dst, b, h) do { _Pragma("unroll") for (int m = 0; m < 4; ++m) _Pragma("unroll") for (int k = 0; k < 2; ++k) dst[m][k] = *(const LAS bf16x8*)(lds + PG8_SA(b, h) + aoff + m * 2048 + k * (FP8 ? 16 : 1024)); } while (0)
#define PG8_LDB(dst, b, h) do { _Pragma("unroll") for (int n = 0; n < 2; ++n) _Pragma("unroll") for (int k = 0; k < 2; ++k) dst[n][k] = *(const LAS bf16x8*)(lds + PG8_SB(b, h) + boff + n * 2048 + k * (FP8 ? 16 : 1024)); } while (0)
#define PG8_MMA(ai, bj, At, Bt) do { __builtin_amdgcn_s_setprio(1); _Pragma("unroll") for (int m = 0; m < 4; ++m) _Pragma("unroll") for (int n = 0; n < 2; ++n) { \
        if constexpr (FP8) { const u32x4 _b0 = __builtin_bit_cast(u32x4, Bt[n][0]), _b1 = __builtin_bit_cast(u32x4, Bt[n][1]), _a0 = __builtin_bit_cast(u32x4, At[m][0]), _a1 = __builtin_bit_cast(u32x4, At[m][1]); \
            const i32x8 _bv = {(int)_b0.x, (int)_b0.y, (int)_b0.z, (int)_b0.w, (int)_b1.x, (int)_b1.y, (int)_b1.z, (int)_b1.w}, _av = {(int)_a0.x, (int)_a0.y, (int)_a0.z, (int)_a0.w, (int)_a1.x, (int)_a1.y, (int)_a1.z, (int)_a1.w}; \
            acc[ai][bj][m][n] = __builtin_amdgcn_mfma_scale_f32_16x16x128_f8f6f4(_bv, _av, acc[ai][bj][m][n], 0, 0, 0, 0x7F7F7F7F, 0, 0x7F7F7F7F); } \
        else { _Pragma("unroll") for (int k = 0; k < 2; ++k) acc[ai][bj][m][n] = __builtin_amdgcn_mfma_f32_16x16x32_bf16(Bt[n][k], At[m][k], acc[ai][bj][m][n], 0, 0, 0); } } \
        __builtin_amdgcn_s_setprio(0); } while (0)
#define PG8_WAIT_V(n) asm volatile("s_waitcnt vmcnt(" #n ")" ::: "memory")
#define PG8_WAIT_L(n) asm volatile("s_waitcnt lgkmcnt(" #n ")" ::: "memory")
#define PG8_BAR __builtin_amdgcn_s_barrier()
#define PG8_SCHED __builtin_amdgcn_sched_barrier(0)
#define PG8_AOFF(dst, u) do { _Pragma("unroll") for (int _i = 0; _i < 2; ++_i) { int _R, _C; stage_rc(tid * 16 + _i * 8192, _R, _C); _Pragma("unroll") for (int _h = 0; _h < 2; ++_h) \
        dst[_h][_i] = (unsigned)((size_t)S.a_row(u, _h * HALF + _R) * K * ES + _C * 2); } } while (0)
    Unit cur, nxt; int ui = 0;
    if (!S.next(0, cur)) return;
    f32x4 acc[2][2][4][2];
#pragma unroll
    for (int a = 0; a < 2; ++a)
#pragma unroll
        for (int b = 0; b < 2; ++b)
#pragma unroll
            for (int m = 0; m < 4; ++m)
#pragma unroll
                for (int n = 0; n < 2; ++n) acc[a][b][m][n] = (f32x4){0.f, 0.f, 0.f, 0.f};
    bf16x8 At[4][2], B0[2][2], B1[2][2];
    unsigned cao[2][2];
    PG8_AOFF(cao, cur);
    const char* cA = (const char*)Abase; const char* cB = (const char*)Btbase + (size_t)cur.brow * K * ES;
    PG8_STAGE(PG8_SB(0, 0), cB, voffB); PG8_STAGE(PG8_SB(0, 1), cB + hstep, voffB); PG8_STAGE(PG8_SA(0, 0), cA, cao[0]); PG8_STAGE(PG8_SA(0, 1), cA, cao[1]);
    if (wr == 1) PG8_BAR;
    PG8_WAIT_V(2); PG8_BAR;
    PG8_STAGE(PG8_SB(1, 0), cB + kstep, voffB); PG8_STAGE(PG8_SA(1, 0), cA + kstep, cao[0]); PG8_STAGE(PG8_SB(1, 1), cB + hstep + kstep, voffB);
    PG8_WAIT_V(6); PG8_BAR;
    for (;;) {
        const bool has_next = S.next(ui + 1, nxt);
        const char* nB = has_next ? (const char*)Btbase + (size_t)nxt.brow * K * ES : cB;
        for (int t = 0; t < nt; t += 2) {
            const bool last = (t == nt - 2);
            const char* a1 = cA + (size_t)(t + 1) * kstep;
            const char* a2 = last ? cA : cA + (size_t)(t + 2) * kstep; const char* b2 = last ? nB : cB + (size_t)(t + 2) * kstep;
            const char* a3 = a2 + kstep; const char* b3 = b2 + kstep;
            PG8_LDB(B0, 0, 0); PG8_LDB(B1, 0, 1); PG8_SCHED; PG8_LDA(At, 0, 0); PG8_STAGE(PG8_SA(1, 1), a1, cao[1]);
            if (last && has_next) { PG8_AOFF(cao, nxt); }
            PG8_WAIT_V(8); PG8_WAIT_L(0); PG8_BAR; PG8_MMA(0, 0, At, B0); PG8_MMA(0, 1, At, B1); PG8_BAR; PG8_SCHED;
            PG8_LDA(At, 0, 1); PG8_STAGE(PG8_SB(0, 0), b2, voffB); PG8_STAGE(PG8_SB(0, 1), b2 + hstep, voffB); PG8_STAGE(PG8_SA(0, 0), a2, cao[0]);
            PG8_WAIT_V(8); PG8_WAIT_L(0); PG8_BAR; PG8_MMA(1, 0, At, B0); PG8_MMA(1, 1, At, B1); PG8_BAR; PG8_SCHED;
            PG8_LDB(B0, 1, 0); PG8_LDB(B1, 1, 1); PG8_SCHED; PG8_LDA(At, 1, 0); PG8_STAGE(PG8_SA(0, 1), a2, cao[1]);
            PG8_WAIT_V(8); PG8_WAIT_L(0); PG8_BAR; PG8_MMA(0, 0, At, B0); PG8_MMA(0, 1, At, B1); PG8_BAR; PG8_SCHED;
            PG8_LDA(At, 1, 1); PG8_STAGE(PG8_SB(1, 0), b3, voffB); PG8_STAGE(PG8_SB(1, 1), b3 + hstep, voffB); PG8_STAGE(PG8_SA(1, 0), a3, cao[0]);
            PG8_WAIT_V(8); PG8_WAIT_L(0); PG8_BAR; PG8_MMA(1, 0, At, B0); PG8_MMA(1, 1, At, B1); PG8_BAR; PG8_SCHED;
        }
        if (wr == 0) PG8_BAR;
#pragma unroll 1
        for (int er = 0; er < Epi::NREP; ++er) E(acc, cur, wr, wc, fr, fq);
        if (!has_next) break;
#pragma unroll
        for (int a = 0; a < 2; ++a)
#pragma unroll
            for (int b = 0; b < 2; ++b)
#pragma unroll
                for (int m = 0; m < 4; ++m)
#pragma unroll
                    for (int n = 0; n < 2; ++n) acc[a][b][m][n] = (f32x4){0.f, 0.f, 0.f, 0.f};
        cur = nxt; cB = nB; ++ui;
        if (wr == 1) PG8_BAR;
    }
    PG8_WAIT_V(0);
    PG8_BAR;
#undef PG8_SA
#undef PG8_SB
#undef PG8_STAGE
#undef PG8_LDA
#undef PG8_LDB
#undef PG8_MMA
#undef PG8_WAIT_V
#undef PG8_WAIT_L
#undef PG8_BAR
#undef PG8_SCHED
#undef PG8_AOFF
}
}

typedef f32x4 AccT[2][2][4][2];

struct EpiProj {
    static constexpr int NREP = 1; static constexpr bool PERM = true;
    bf16_t* proj; float* gates; const float* bgate;
    __device__ __forceinline__ void operator()(const AccT& acc, const pg8::Unit& u, int wr, int wc, int fr, int fq) const {
        const int row0 = u.pm * 256 + wr * 64 + fr;
        if (u.pn < 12) {
            const int col0 = u.pn * 256 + wc * 32 + 8 * fq;
#pragma unroll
            for (int ai = 0; ai < 2; ++ai)
#pragma unroll
                for (int m = 0; m < 4; ++m) { bf16_t* rowp = proj + (size_t)(row0 + ai * 128 + m * 16) * PROJ_LD + col0;
#pragma unroll
                    for (int bj = 0; bj < 2; ++bj) { const f32x4 v0 = acc[ai][bj][m][0], v1 = acc[ai][bj][m][1];
                        u32x4 w; w.x = cvt_pk_bf16(v0[0], v0[1]); w.y = cvt_pk_bf16(v0[2], v0[3]); w.z = cvt_pk_bf16(v1[0], v1[1]); w.w = cvt_pk_bf16(v1[2], v1[3]);
                        *(u32x4*)(rowp + bj * 128) = w; } }
        } else if (wc == 0 && fq < 2) {
#pragma unroll
            for (int n = 0; n < 2; ++n) { const f32x4 bv = *(const f32x4*)(bgate + 8 * fq + 4 * n);
#pragma unroll
                for (int ai = 0; ai < 2; ++ai)
#pragma unroll
                    for (int m = 0; m < 4; ++m) *(f32x4*)(gates + (size_t)(row0 + ai * 128 + m * 16) * 16 + 8 * fq + 4 * n) = acc[ai][0][m][n] + bv; }
        }
    }
};
__device__ __forceinline__ f32x4 bf4_lo(u32x4 w) { return (f32x4){__builtin_bit_cast(float, w.x << 16), __builtin_bit_cast(float, w.x & 0xffff0000u), __builtin_bit_cast(float, w.y << 16), __builtin_bit_cast(float, w.y & 0xffff0000u)}; }
__device__ __forceinline__ f32x4 bf4_hi(u32x4 w) { return (f32x4){__builtin_bit_cast(float, w.z << 16), __builtin_bit_cast(float, w.z & 0xffff0000u), __builtin_bit_cast(float, w.w << 16), __builtin_bit_cast(float, w.w & 0xffff0000u)}; }
struct EpiRes {
    static constexpr int NREP = 1; static constexpr bool PERM = true;
    bf16_t* H; const float* stats; const float* lg; const float* lb; const float* xsrc; float sc;
    __device__ __forceinline__ void operator()(const AccT& acc, const pg8::Unit& u, int wr, int wc, int fr, int fq) const {
        const int row0 = u.pm * 256 + wr * 64 + fr, col0 = u.pn * 256 + wc * 32 + 8 * fq;
        f32x4 gv[2][2], bv[2][2];
        if (lg) {
#pragma unroll
            for (int bj = 0; bj < 2; ++bj)
#pragma unroll
                for (int n = 0; n < 2; ++n) { gv[bj][n] = *(const f32x4*)(lg + col0 + bj * 128 + n * 4); bv[bj][n] = *(const f32x4*)(lb + col0 + bj * 128 + n * 4); } }
#pragma unroll
        for (int ai = 0; ai < 2; ++ai)
#pragma unroll
            for (int m = 0; m < 4; ++m) { const int row = row0 + ai * 128 + m * 16; bf16_t* rowp = H + (size_t)row * D + col0;
                f32x2 st = (f32x2){0.f, 1.f}; if (lg) st = *(const f32x2*)(stats + 2 * (size_t)row);
#pragma unroll
                for (int bj = 0; bj < 2; ++bj) { f32x4 h0, h1;
                    if (lg) { const u32x4 w = *(const u32x4*)(rowp + bj * 128); h0 = (bf4_lo(w) - st.x) * st.y * gv[bj][0] + bv[bj][0]; h1 = (bf4_hi(w) - st.x) * st.y * gv[bj][1] + bv[bj][1]; }
                    else { const float* xp = xsrc + (size_t)row * D + col0 + bj * 128; h0 = *(const f32x4*)xp; h1 = *(const f32x4*)(xp + 4); }
                    const f32x4 o0 = h0 * ALPHA + acc[ai][bj][m][0] * sc, o1 = h1 * ALPHA + acc[ai][bj][m][1] * sc;
                    u32x4 w; w.x = cvt_pk_bf16(o0[0], o0[1]); w.y = cvt_pk_bf16(o0[2], o0[3]); w.z = cvt_pk_bf16(o1[0], o1[1]); w.w = cvt_pk_bf16(o1[2], o1[3]);
                    *(u32x4*)(rowp + bj * 128) = w; } }
    }
};
struct EpiSwiglu {
    static constexpr int NREP = 1; static constexpr bool PERM = true;
    bf16_t* act; int ld; float sc;
    __device__ __forceinline__ static float silu_mul(float g, float u) { return g * u * __builtin_amdgcn_rcpf(1.0f + __builtin_amdgcn_exp2f(-g * 1.4426950408889634f)); }
    __device__ __forceinline__ void operator()(const AccT& acc, const pg8::Unit& u, int wr, int wc, int fr, int fq) const {
        const int row0 = u.pm * 256 + wr * 64 + fr, col0 = u.pn * 128 + wc * 32 + 8 * fq;
#pragma unroll
        for (int ai = 0; ai < 2; ++ai)
#pragma unroll
            for (int m = 0; m < 4; ++m) { const f32x4 g0 = acc[ai][0][m][0] * sc, g1 = acc[ai][0][m][1] * sc, u0 = acc[ai][1][m][0] * sc, u1 = acc[ai][1][m][1] * sc;
                u32x4 w; w.x = cvt_pk_bf16(silu_mul(g0[0], u0[0]), silu_mul(g0[1], u0[1])); w.y = cvt_pk_bf16(silu_mul(g0[2], u0[2]), silu_mul(g0[3], u0[3]));
                w.z = cvt_pk_bf16(silu_mul(g1[0], u1[0]), silu_mul(g1[1], u1[1])); w.w = cvt_pk_bf16(silu_mul(g1[2], u1[2]), silu_mul(g1[3], u1[3]));
                *(u32x4*)(act + (size_t)(row0 + ai * 128 + m * 16) * ld + col0) = w; }
    }
};
struct EpiSwiglu8 {
    static constexpr int NREP = 1; static constexpr bool PERM = true;
    unsigned char* act; int ld; float sc;
    __device__ __forceinline__ void operator()(const AccT& acc, const pg8::Unit& u, int wr, int wc, int fr, int fq) const {
        const int row0 = u.pm * 256 + wr * 64 + fr, col0 = u.pn * 128 + wc * 32 + 8 * fq;
#pragma unroll
        for (int ai = 0; ai < 2; ++ai)
#pragma unroll
            for (int m = 0; m < 4; ++m) { const f32x4 g0 = acc[ai][0][m][0] * sc, g1 = acc[ai][0][m][1] * sc, u0 = acc[ai][1][m][0] * sc, u1 = acc[ai][1][m][1] * sc;
                u32x2 w; w.x = pk4_fp8(EpiSwiglu::silu_mul(g0[0], u0[0]) * F8_SACT, EpiSwiglu::silu_mul(g0[1], u0[1]) * F8_SACT, EpiSwiglu::silu_mul(g0[2], u0[2]) * F8_SACT, EpiSwiglu::silu_mul(g0[3], u0[3]) * F8_SACT);
                w.y = pk4_fp8(EpiSwiglu::silu_mul(g1[0], u1[0]) * F8_SACT, EpiSwiglu::silu_mul(g1[1], u1[1]) * F8_SACT, EpiSwiglu::silu_mul(g1[2], u1[2]) * F8_SACT, EpiSwiglu::silu_mul(g1[3], u1[3]) * F8_SACT);
                *(u32x2*)(act + (size_t)(row0 + ai * 128 + m * 16) * ld + col0) = w; }
    }
};
struct EpiSwigluProbe : EpiSwiglu { static constexpr int NREP = 2; };
struct EpiScatter {
    static constexpr int NREP = 1; static constexpr bool PERM = true;
    bf16_t* contrib; const int* rowdst; const float* rowgate; float sc;
    __device__ __forceinline__ void operator()(const AccT& acc, const pg8::Unit& u, int wr, int wc, int fr, int fq) const {
        const int row0 = u.pm * 256 + wr * 64 + fr, col0 = u.pn * 256 + wc * 32 + 8 * fq;
#pragma unroll
        for (int ai = 0; ai < 2; ++ai)
#pragma unroll
            for (int m = 0; m < 4; ++m) { const int pos = row0 + ai * 128 + m * 16; const int d = rowdst[pos];
                if (d >= 0) { const float g = rowgate[pos] * sc; bf16_t* rowp = contrib + (size_t)d * D + col0;
#pragma unroll
                    for (int bj = 0; bj < 2; ++bj) { const f32x4 v0 = acc[ai][bj][m][0] * g, v1 = acc[ai][bj][m][1] * g;
                        u32x4 w; w.x = cvt_pk_bf16(v0[0], v0[1]); w.y = cvt_pk_bf16(v0[2], v0[3]); w.z = cvt_pk_bf16(v1[0], v1[1]); w.w = cvt_pk_bf16(v1[2], v1[3]);
                        *(u32x4*)(rowp + bj * 128) = w; } } }
    }
};
struct EpiQKV {
    static constexpr int NREP = 1; static constexpr bool PERM = true;
    bf16_t *Q, *KB, *VB; const float* rope;
    __device__ __forceinline__ void operator()(const AccT& acc, const pg8::Unit& u, int wr, int wc, int fr, int fq) const {
        const int row0 = u.pm * 256 + wr * 64 + fr, cl = wc * 32 + 8 * fq;
        bf16_t* base; int ld;
        if (u.pn == 5) {
#pragma unroll
            for (int ai = 0; ai < 2; ++ai)
#pragma unroll
                for (int m = 0; m < 4; ++m) { const int row = row0 + ai * 128 + m * 16;
#pragma unroll
                    for (int bj = 0; bj < 2; ++bj)
#pragma unroll
                        for (int n = 0; n < 2; ++n)
#pragma unroll
                            for (int j = 0; j < 4; ++j) VB[(size_t)(bj * 128 + cl + 4 * n + j) * MP + row] = (bf16_t)f2bf(acc[ai][bj][m][n][j]); }
            return; }
        if (u.pn < 4) { base = Q + u.pn * 256 + cl; ld = D; } else { base = KB + cl; ld = 256; }
        const bool dorope = (u.pn <= 4) && ((wc & 1) == 0);
#pragma unroll
        for (int ai = 0; ai < 2; ++ai)
#pragma unroll
            for (int m = 0; m < 4; ++m) { const int row = row0 + ai * 128 + m * 16;
                f32x4 v[2][2];
#pragma unroll
                for (int bj = 0; bj < 2; ++bj)
#pragma unroll
                    for (int n = 0; n < 2; ++n) v[bj][n] = acc[ai][bj][m][n];
                if (dorope) {
                    int pos = row < MREAL ? (row & (SEQ - 1)) + NMETA : row - MREAL; pos = pos > SEQ + NMETA - 1 ? SEQ + NMETA - 1 : pos;
                    const float* rp = rope + (size_t)pos * 16;
                    const f32x4 c0 = *(const f32x4*)rp, c1 = *(const f32x4*)(rp + 4), s0 = *(const f32x4*)(rp + 8), s1 = *(const f32x4*)(rp + 12);
#pragma unroll
                    for (int bj = 0; bj < 2; ++bj)
#pragma unroll
                        for (int n = 0; n < 2; ++n) { const f32x4 c = n ? c1 : c0, s = n ? s1 : s0; f32x4 o;
#pragma unroll
                            for (int j = 0; j < 4; ++j) { const float x = v[bj][n][j]; const float y = __shfl_xor(x, 16);
                                o[j] = fq == 0 ? x * c[j] - y * s[j] : (fq == 1 ? x * c[j] + y * s[j] : x); }
                            v[bj][n] = o; }
                }
#pragma unroll
                for (int bj = 0; bj < 2; ++bj) { const f32x4 v0 = v[bj][0], v1 = v[bj][1];
                    u32x4 w; w.x = cvt_pk_bf16(v0[0], v0[1]); w.y = cvt_pk_bf16(v0[2], v0[3]); w.z = cvt_pk_bf16(v1[0], v1[1]); w.w = cvt_pk_bf16(v1[2], v1[3]);
                    *(u32x4*)(base + (size_t)row * ld + bj * 128) = w; } }
    }
};

template <int NACC, class F>
__device__ __forceinline__ void skinny_item(const bf16_t* A, int lda, const bf16_t* (&Bt)[NACC], int K, int wave, int lane, LAS unsigned char* lds, int parity, const F& epi) {
    const int fr = lane & 15, quad = lane >> 4, kw = K >> 3;
    const bf16_t* ap = A + (size_t)fr * lda + wave * kw + 8 * quad;
    f32x4 acc[NACC];
#pragma unroll
    for (int i = 0; i < NACC; ++i) acc[i] = (f32x4){0.f, 0.f, 0.f, 0.f};
#pragma unroll 2
    for (int k = 0; k < kw; k += 32) { const bf16x8 a = *(const bf16x8*)(ap + k);
#pragma unroll
        for (int i = 0; i < NACC; ++i) acc[i] = __builtin_amdgcn_mfma_f32_16x16x32_bf16(a, *(const bf16x8*)(Bt[i] + (size_t)fr * K + wave * kw + 8 * quad + k), acc[i], 0, 0, 0); }
    LAS f32x4* red = (LAS f32x4*)(lds + parity * 16384);
#pragma unroll
    for (int i = 0; i < NACC; ++i) red[(wave * NACC + i) * 64 + lane] = acc[i];
    __syncthreads();
    if (wave == 0) {
#pragma unroll
        for (int i = 0; i < NACC; ++i) { f32x4 t = red[i * 64 + lane];
#pragma unroll
            for (int w = 1; w < 8; ++w) t += red[(w * NACC + i) * 64 + lane];
            acc[i] = t; }
        epi(acc, fr, quad);
    }
}

template <int NACC, class F>
__device__ __forceinline__ void skinny_item8(const unsigned char* A, int lda, const unsigned char* (&Bt)[NACC], int K, int wave, int lane, LAS unsigned char* lds, int parity, const F& epi) {
    const int fr = lane & 15, quad = lane >> 4, nblk = K >> 7, b0 = (wave * nblk) >> 3, b1 = ((wave + 1) * nblk) >> 3;
    f32x4 acc[NACC];
#pragma unroll
    for (int i = 0; i < NACC; ++i) acc[i] = (f32x4){0.f, 0.f, 0.f, 0.f};
    for (int kb = b0; kb < b1; ++kb) { const u32x4* ap = (const u32x4*)(A + (size_t)fr * lda + kb * 128 + 32 * quad); const u32x4 a0 = ap[0], a1 = ap[1];
        const i32x8 av = {(int)a0.x, (int)a0.y, (int)a0.z, (int)a0.w, (int)a1.x, (int)a1.y, (int)a1.z, (int)a1.w};
#pragma unroll
        for (int i = 0; i < NACC; ++i) { const u32x4* bp = (const u32x4*)(Bt[i] + (size_t)fr * K + kb * 128 + 32 * quad); const u32x4 q0 = bp[0], q1 = bp[1];
            const i32x8 bv = {(int)q0.x, (int)q0.y, (int)q0.z, (int)q0.w, (int)q1.x, (int)q1.y, (int)q1.z, (int)q1.w};
            acc[i] = __builtin_amdgcn_mfma_scale_f32_16x16x128_f8f6f4(av, bv, acc[i], 0, 0, 0, 0x7F7F7F7F, 0, 0x7F7F7F7F); } }
    LAS f32x4* red = (LAS f32x4*)(lds + parity * 16384);
#pragma unroll
    for (int i = 0; i < NACC; ++i) red[(wave * NACC + i) * 64 + lane] = acc[i];
    __syncthreads();
    if (wave == 0) {
#pragma unroll
        for (int i = 0; i < NACC; ++i) { f32x4 t = red[i * 64 + lane];
#pragma unroll
            for (int w = 1; w < 8; ++w) t += red[(w * NACC + i) * 64 + lane];
            acc[i] = t; }
        epi(acc, fr, quad);
    }
}

struct Params { const float* in[18]; float* out; unsigned char* ws; int ph_lo, ph_hi, li, pad; };
enum { I_X = 0, I_META, I_WIN, I_BGATE, I_LNH, I_WOUT, I_WKV, I_WQ, I_SINKS, I_WO, I_WGUD, I_WDND, I_WROUTER, I_BROUTER, I_WGUE, I_WDNE, I_LNG, I_LNB };
constexpr int NWAVES = 8, NTHREADS = 512;

template <bool F8 = false>
__device__ __forceinline__ void tr_item(const float* W, int Nsrc, int K, void* WTv, int k0, int n0, int drow0, float scale, int nvalid, LAS float* scr, int lane) {
    bf16_t* WT = (bf16_t*)WTv;
    float ld[32];
#pragma unroll
    for (int i = 0; i < 32; ++i) { const int kk = 2 * i + (lane >> 5), n = lane & 31; ld[i] = (n < nvalid) ? W[(size_t)(k0 + kk) * Nsrc + n0 + n] : 0.f; }
#pragma unroll
    for (int i = 0; i < 32; ++i) { const int kk = 2 * i + (lane >> 5), n = lane & 31; scr[kk * 33 + n] = ld[i] * scale; }
    LDS_WAIT(); asm volatile("" ::: "memory");
    const int c = lane & 7;
#pragma unroll
    for (int j = 0; j < 4; ++j) { const int n = (lane >> 3) + 8 * j; const LAS float* s = scr + (8 * c) * 33 + n;
        if constexpr (F8) { u32x2 o; o.x = pk4_fp8(s[0 * 33], s[1 * 33], s[2 * 33], s[3 * 33]); o.y = pk4_fp8(s[4 * 33], s[5 * 33], s[6 * 33], s[7 * 33]);
            if (n < nvalid) *(u32x2*)((unsigned char*)WTv + (size_t)(drow0 + n) * K + k0 + 8 * c) = o; }
        else { u32x4 o; o.x = pk2(s[0 * 33], s[1 * 33]); o.y = pk2(s[2 * 33], s[3 * 33]); o.z = pk2(s[4 * 33], s[5 * 33]); o.w = pk2(s[6 * 33], s[7 * 33]);
            if (n < nvalid) *(u32x4*)(WT + (size_t)(drow0 + n) * K + k0 + 8 * c) = o; } }
    LDS_WAIT(); asm volatile("" ::: "memory");
}
__device__ __forceinline__ int pair_row(int n, int FF) { const int up = n >= FF ? 1 : 0, j = n - up * FF; return 256 * (j >> 7) + 128 * up + (j & 127); }

__device__ __forceinline__ void p0_prologue(const Params& P, LAS unsigned char* lds, int gw, int NGW, int wave, int lane) {
    unsigned char* ws = P.ws;
    LAS float* scr = (LAS float*)(lds + wave * 16384);
    constexpr int IT0 = 16 * 97, IT1 = 16 * 32, IT2 = 16 * 16, IT5 = 16 * 176, IT6 = 44 * 32, IT7 = 16 * 224, IT8 = 56 * 32;
    constexpr int C0 = 2 * IT0, C1 = C0 + 2 * IT1, C2 = C1 + IT2, C3 = C2 + 2 * IT1, C4 = C3 + 2 * IT1, C5 = C4 + 2 * IT5, C6 = C5 + 2 * IT6, C7 = C6 + 16 * IT7, C8 = C7 + 16 * IT8;
    for (int it = gw; it < C8; it += NGW) {
        if (it < C0) { const int mi = it / IT0, r = it % IT0, kb = r / 97, nb = r % 97; const int n0 = nb * 32;
            tr_item(P.in[I_WIN] + (size_t)mi * D * M_IN, M_IN, D, (bf16_t*)(ws + WS_WIN) + (size_t)mi * M_INP * D, kb * 64, n0, n0, n0 < 512 ? 0.125f : 1.f, nb == 96 ? 16 : 32, scr, lane);
        } else if (it < C1) { const int q = it - C0, mi = q / IT1, r = q % IT1, kb = r / 32, nb = r % 32;
            tr_item(P.in[I_WOUT] + (size_t)mi * D * D, D, D, (bf16_t*)(ws + WS_WOUT) + (size_t)mi * D * D, kb * 64, nb * 32, nb * 32, 1.f, 32, scr, lane);
        } else if (it < C2) { const int r = it - C1, kb = r / 16, nb = r % 16;
            tr_item(P.in[I_WKV], 512, D, (bf16_t*)(ws + WS_WQKV), kb * 64, nb * 32, 1024 + nb * 32, 1.f, 32, scr, lane);
        } else if (it < C3) { const int q = it - C2, mi = q / IT1, r = q % IT1, kb = r / 32, nb = r % 32;
            tr_item(P.in[I_WQ] + (size_t)mi * D * D, D, D, (bf16_t*)(ws + (mi ? WS_WQ3 : WS_WQKV)), kb * 64, nb * 32, nb * 32, 0.125f, 32, scr, lane);
        } else if (it < C4) { const int q = it - C3, mi = q / IT1, r = q % IT1, kb = r / 32, nb = r % 32;
            tr_item(P.in[I_WO] + (size_t)mi * D * D, D, D, (bf16_t*)(ws + WS_WO) + (size_t)mi * D * D, kb * 64, nb * 32, nb * 32, 1.f, 32, scr, lane);
        } else if (it < C5) { const int q = it - C4, mi = q / IT5, r = q % IT5, kb = r / 176, nb = r % 176;
            tr_item(P.in[I_WGUD] + (size_t)mi * D * 2 * D_FF, 2 * D_FF, D, (bf16_t*)(ws + WS_WGU) + (size_t)mi * 2 * D_FF * D, kb * 64, nb * 32, pair_row(nb * 32, D_FF), 1.f, 32, scr, lane);
        } else if (it < C6) { const int q = it - C5, mi = q / IT6, r = q % IT6, kb = r / 32, nb = r % 32;
            tr_item<true>(P.in[I_WDND] + (size_t)mi * D_FF * D, D, D_FF, (ws + WS_WDN8) + (size_t)mi * D * D_FF, kb * 64, nb * 32, nb * 32, F8_SBD, 32, scr, lane);
        } else if (it < C7) { const int q = it - C6, mi = q / IT7, r = q % IT7, kb = r / 224, nb = r % 224;
            tr_item<true>(P.in[I_WGUE] + (size_t)mi * D * 2 * D_FF_EXP, 2 * D_FF_EXP, D, (ws + WS_WGUE8) + (size_t)mi * 2 * D_FF_EXP * D, kb * 64, nb * 32, pair_row(nb * 32, D_FF_EXP), F8_SB, 32, scr, lane);
        } else { const int q = it - C7, mi = q / IT8, r = q % IT8, kb = r / 32, nb = r % 32;
            tr_item<true>(P.in[I_WDNE] + (size_t)mi * D_FF_EXP * D, D, D_FF_EXP, (ws + WS_WDNE8) + (size_t)mi * D * D_FF_EXP, kb * 64, nb * 32, nb * 32, F8_SBD, 32, scr, lane);
        }
    }
    { float* sm = (float*)(ws + WS_SMALL); const int gt = gw * 64 + lane, NT = NGW * 64;
      for (int i = gt; i < SM_END; i += NT) { float v = 0.f;
          if (i < SM_SINKS) v = P.in[I_BGATE][i]; else if (i < SM_BROUTER) v = P.in[I_SINKS][i - SM_SINKS]; else if (i < SM_BROUTER + 16) v = P.in[I_BROUTER][i - SM_BROUTER];
          else if (i < SM_LNH) v = 0.f; else if (i < SM_LNG) v = P.in[I_LNH][i - SM_LNH]; else if (i < SM_LNB) v = P.in[I_LNG][i - SM_LNG]; else if (i < SM_WROUTER) v = P.in[I_LNB][i - SM_LNB]; else v = P.in[I_WROUTER][i - SM_WROUTER];
          sm[i] = v; } }
    { bf16_t* HB = (bf16_t*)(ws + WS_HB);
      const size_t gt = (size_t)gw * 64 + lane, NT = (size_t)NGW * 64;
      for (size_t i = gt; i < (size_t)MV * (D / 4); i += NT) { const size_t row = i >> 8; const int c4 = (int)(i & 255);
          const f32x4 v = row < MREAL ? ((const f32x4*)P.in[I_X])[i] : ((const f32x4*)P.in[I_META])[(row - MREAL) * 256 + c4];
          u32x2 w; w.x = pk2(v[0], v[1]); w.y = pk2(v[2], v[3]); ((u32x2*)HB)[i] = w; }
      float* rope = (float*)(ws + WS_ROPE);
      for (size_t i = gt; i < (size_t)(SEQ + NMETA) * 8; i += NT) { const int pos = (int)(i >> 3), fi = (int)(i & 7);
          const double invf = fi == 0 ? 1.0 : fi == 1 ? 0.19392274474868576 : fi == 2 ? 0.03760603093086393 : fi == 3 ? 0.007292664737217109 : fi == 4 ? 0.001414213562373095
                            : fi == 5 ? 0.0002742481756762073 : fi == 6 ? 5.318295896944988e-05 : 1.031338537721246e-05;
          const float angf = (float)pos * (float)invf;
          double a = (double)angf; a -= 6.283185307179586476925 * __builtin_rint(a * 0.15915494309189533577); const double hx = 0.5 * a, h2 = hx * hx;
          double sp = 1.0, cp = 1.0;
#pragma unroll
          for (int k = 12; k >= 1; --k) { sp = 1.0 - sp * h2 / (double)((2 * k) * (2 * k + 1)); cp = 1.0 - cp * h2 / (double)((2 * k - 1) * (2 * k)); }
          const double sh = hx * sp, ch = cp;
          rope[(size_t)pos * 16 + fi] = (float)(1.0 - 2.0 * sh * sh); rope[(size_t)pos * 16 + 8 + fi] = (float)(2.0 * sh * ch); }
    }
}

__device__ __forceinline__ void ln_phase(unsigned char* ws, float* outp, LAS unsigned char* lds, int gw, int NGW, int lane, int tid,
                                         int lnidx, bool moe_src, bool router, int moe_idx, bool final, bool dry = false) {
    const float* sm = (const float*)(ws + WS_SMALL);
    unsigned char* wo = dry ? ws + WS_ACT : ws;
    const bf16_t* H = (const bf16_t*)(ws + WS_H); bf16_t* Hw = dry ? (bf16_t*)(ws + WS_ACT) : (bf16_t*)(ws + WS_H);
    bf16_t* HB = dry ? (bf16_t*)(ws + WS_ACT + 160 * MiB) : (bf16_t*)(ws + WS_HB); const bf16_t* contrib = (const bf16_t*)(ws + WS_CONTRIB);
    const float* stats = (const float*)(ws + WS_STATS); float* statsw = dry ? (float*)(ws + WS_ACT + 240 * MiB) : (float*)(ws + WS_STATS);
    unsigned char* HB8 = dry ? ws + WS_ACT + 250 * MiB : ws + WS_HB8; (void)wo;
    const float* lg = sm + SM_LNG + (size_t)lnidx * D; const float* lb = sm + SM_LNB + (size_t)lnidx * D;
    f32x4 gv[4], bv[4];
#pragma unroll
    for (int j = 0; j < 4; ++j) { gv[j] = *(const f32x4*)(lg + 256 * j + 4 * lane); bv[j] = *(const f32x4*)(lb + 256 * j + 4 * lane); }
    volatile LAS unsigned* misc = (volatile LAS unsigned*)(lds + MISC_OFF);
    f32x4 wra[4][4], wrb[4][4];
    if (router) {
        const float* src = sm + SM_WROUTER + (size_t)moe_idx * D * N_EXP;
#pragma unroll
        for (int j = 0; j < 4; ++j)
#pragma unroll
            for (int c = 0; c < 4; ++c) { const f32x4* w4 = (const f32x4*)(src + (size_t)(256 * j + 4 * lane + c) * 8); wra[j][c] = w4[0]; wrb[j][c] = w4[1]; }
        if (tid < 8) misc[16 + tid] = 0u;
        __syncthreads();
    }
    int* tope = dry ? (int*)(ws + WS_ACT + 300 * MiB) : (int*)(ws + WS_TOPE); float* topg = dry ? (float*)(ws + WS_ACT + 310 * MiB) : (float*)(ws + WS_TOPG);
    const float* br = sm + SM_BROUTER + moe_idx * N_EXP;
    u32x2 nv[4], nc0[4], nc1[4]; f32x2 nst;
    auto fetch = [&](int row) {
        const u32x2* hr = (const u32x2*)(H + (size_t)row * D) + lane;
#pragma unroll
        for (int j = 0; j < 4; ++j) nv[j] = hr[64 * j];
        if (moe_src) { const u32x2* c0 = (const u32x2*)(contrib + (size_t)(2 * row) * D) + lane; const u32x2* c1 = c0 + 256;
#pragma unroll
            for (int j = 0; j < 4; ++j) { nc0[j] = c0[64 * j]; nc1[j] = c1[64 * j]; } }
        nst = *(const f32x2*)(stats + 2 * (size_t)row);
    };
    if (gw < MV) fetch(gw);
    for (int row = gw; row < MV; row += NGW) {
        f32x4 v[4], c0v[4], c1v[4]; const f32x2 st = nst;
#pragma unroll
        for (int j = 0; j < 4; ++j) { v[j] = (f32x4){__builtin_bit_cast(float, nv[j].x << 16), __builtin_bit_cast(float, nv[j].x & 0xffff0000u), __builtin_bit_cast(float, nv[j].y << 16), __builtin_bit_cast(float, nv[j].y & 0xffff0000u)};
            c0v[j] = (f32x4){__builtin_bit_cast(float, nc0[j].x << 16), __builtin_bit_cast(float, nc0[j].x & 0xffff0000u), __builtin_bit_cast(float, nc0[j].y << 16), __builtin_bit_cast(float, nc0[j].y & 0xffff0000u)};
            c1v[j] = (f32x4){__builtin_bit_cast(float, nc1[j].x << 16), __builtin_bit_cast(float, nc1[j].x & 0xffff0000u), __builtin_bit_cast(float, nc1[j].y << 16), __builtin_bit_cast(float, nc1[j].y & 0xffff0000u)}; }
        if (row + NGW < MV) fetch(row + NGW);
        if (moe_src) { const float* pg = lg - D; const float* pb = lb - D;
#pragma unroll
            for (int j = 0; j < 4; ++j) { const f32x4 g1 = *(const f32x4*)(pg + 256 * j + 4 * lane), b1 = *(const f32x4*)(pb + 256 * j + 4 * lane);
                v[j] = ((v[j] - st.x) * st.y * g1 + b1) * ALPHA + c0v[j] + c1v[j]; }
            if (!final) { u32x2* o = (u32x2*)(Hw + (size_t)row * D) + lane;
#pragma unroll
                for (int j = 0; j < 4; ++j) { u32x2 w; w.x = pk2(v[j][0], v[j][1]); w.y = pk2(v[j][2], v[j][3]); o[64 * j] = w;
                    v[j] = (f32x4){__builtin_bit_cast(float, w.x << 16), __builtin_bit_cast(float, w.x & 0xffff0000u), __builtin_bit_cast(float, w.y << 16), __builtin_bit_cast(float, w.y & 0xffff0000u)}; } } }
        float s = 0.f;
#pragma unroll
        for (int j = 0; j < 4; ++j) s += (v[j][0] + v[j][1]) + (v[j][2] + v[j][3]);
        const float mean = wave_sum(s) * (1.f / D); float s2 = 0.f;
#pragma unroll
        for (int j = 0; j < 4; ++j) { v[j] = v[j] - mean; s2 += (v[j][0] * v[j][0] + v[j][1] * v[j][1]) + (v[j][2] * v[j][2] + v[j][3] * v[j][3]); }
        const float rstd = 1.f / sqrtf(wave_sum(s2) * (1.f / D) + LN_EPS);
#pragma unroll
        for (int j = 0; j < 4; ++j) v[j] = v[j] * rstd * gv[j] + bv[j];
        if (final) { if (row < MREAL) { f32x4* o = (f32x4*)(outp + (size_t)row * D) + lane;
#pragma unroll
                for (int j = 0; j < 4; ++j) o[64 * j] = v[j]; } }
        else { if (lane == 0) *(f32x2*)(statsw + 2 * (size_t)row) = (f32x2){mean, rstd};
            if (router) { unsigned* o8 = (unsigned*)(HB8 + (size_t)row * D) + lane;
#pragma unroll
                for (int j = 0; j < 4; ++j) o8[64 * j] = pk4_fp8(v[j][0] * F8_SA, v[j][1] * F8_SA, v[j][2] * F8_SA, v[j][3] * F8_SA); }
            else { u32x2* ob = (u32x2*)(HB + (size_t)row * D) + lane;
#pragma unroll
                for (int j = 0; j < 4; ++j) { u32x2 w; w.x = pk2(v[j][0], v[j][1]); w.y = pk2(v[j][2], v[j][3]); ob[64 * j] = w; } } }
        if (router) {
            f32x4 la = (f32x4){0.f, 0.f, 0.f, 0.f}, lb4 = (f32x4){0.f, 0.f, 0.f, 0.f};
#pragma unroll
            for (int j = 0; j < 4; ++j)
#pragma unroll
                for (int c = 0; c < 4; ++c) { const float x = v[j][c]; la += wra[j][c] * x; lb4 += wrb[j][c] * x; }
            const bool h5 = (lane & 32) != 0, h4 = (lane & 16) != 0, h3 = (lane & 8) != 0;
            f32x4 k4; { const f32x4 send = h5 ? la : lb4, keep = h5 ? lb4 : la; f32x4 got;
#pragma unroll
                for (int i = 0; i < 4; ++i) got[i] = __shfl_xor(send[i], 32);
                k4 = keep + got; }
            f32x2 k2; { const f32x2 send = h4 ? (f32x2){k4[0], k4[1]} : (f32x2){k4[2], k4[3]}, keep = h4 ? (f32x2){k4[2], k4[3]} : (f32x2){k4[0], k4[1]};
                k2 = keep + (f32x2){__shfl_xor(send[0], 16), __shfl_xor(send[1], 16)}; }
            float k1 = (h3 ? k2[1] : k2[0]) + __shfl_xor(h3 ? k2[0] : k2[1], 8);
            k1 += __shfl_xor(k1, 4); k1 += __shfl_xor(k1, 2); k1 += __shfl_xor(k1, 1);
            float lg8[8];
#pragma unroll
            for (int e = 0; e < 8; ++e) lg8[e] = __shfl(k1, 8 * e) + br[e];
            int e1 = 0; float v1 = lg8[0];
#pragma unroll
            for (int e = 1; e < 8; ++e) if (lg8[e] > v1) { v1 = lg8[e]; e1 = e; }
            int e2 = -1; float v2 = -3.0e38f;
#pragma unroll
            for (int e = 0; e < 8; ++e) if (e != e1 && lg8[e] > v2) { v2 = lg8[e]; e2 = e; }
            const float ex = expf(v2 - v1), g1 = 1.f / (1.f + ex), g2 = ex / (1.f + ex);
            if (lane == 0) { tope[row] = e1 | (e2 << 8); topg[2 * row] = g1; topg[2 * row + 1] = g2;
                __hip_atomic_fetch_add((LAS unsigned*)&misc[16 + e1], 1u, __ATOMIC_RELAXED, __HIP_MEMORY_SCOPE_WORKGROUP);
                __hip_atomic_fetch_add((LAS unsigned*)&misc[16 + e2], 1u, __ATOMIC_RELAXED, __HIP_MEMORY_SCOPE_WORKGROUP); }
        }
    }
    if (router) { __syncthreads();
        if (tid < 8 && !dry) __hip_atomic_fetch_add((unsigned*)(ws + WS_CTL) + CW_CNT + moe_idx * 64 + tid, misc[16 + tid], __ATOMIC_RELAXED, __HIP_MEMORY_SCOPE_AGENT);
        __syncthreads(); }
}

__device__ __forceinline__ void moe_starts(const unsigned char* ws, int moe_idx, int (&cnt)[8], int (&pstart)[9]) {
    const unsigned* c = (const unsigned*)(ws + WS_CTL) + CW_CNT + moe_idx * 64; int p = 0;
#pragma unroll
    for (int e = 0; e < 8; ++e) { cnt[e] = __builtin_amdgcn_readfirstlane((int)__hip_atomic_load(c + e, __ATOMIC_RELAXED, __HIP_MEMORY_SCOPE_AGENT)); pstart[e] = p; p += (cnt[e] + 255) >> 8; }
    pstart[8] = p;
}
__device__ __forceinline__ void assign_phase(unsigned char* ws, int gw, int NGW, int lane, int tid, int moe_idx) {
    int cnt[8], pstart[9]; moe_starts(ws, moe_idx, cnt, pstart);
    const int* tope = (const int*)(ws + WS_TOPE); const float* topg = (const float*)(ws + WS_TOPG);
    int* rowtok = (int*)(ws + WS_ROWTOK); int* rowdst = (int*)(ws + WS_ROWDST); float* rowgate = (float*)(ws + WS_ROWGATE);
    unsigned* cur = (unsigned*)(ws + WS_CTL) + CW_CUR + moe_idx * 64;
    for (int base = gw * 64; base < MV; base += NGW * 64) {
        const int row = base + lane; const bool valid = row < MV;
        const int te = valid ? tope[row] : 0xffff;
#pragma unroll
        for (int slot = 0; slot < 2; ++slot) {
            const int e = valid ? ((te >> (8 * slot)) & 255) : 255; int pos = -1;
#pragma unroll
            for (int ee = 0; ee < 8; ++ee) {
                const unsigned long long mask = __ballot(e == ee);
                if (mask) { const int n = __popcll(mask), leader = __ffsll((long long)mask) - 1; unsigned b0 = 0;
                    if (lane == leader) b0 = __hip_atomic_fetch_add(cur + ee, (unsigned)n, __ATOMIC_RELAXED, __HIP_MEMORY_SCOPE_AGENT);
                    b0 = __shfl(b0, leader);
                    if (e == ee) pos = pstart[ee] * 256 + (int)b0 + __popcll(mask & ((1ull << lane) - 1ull)); }
            }
            if (valid) { rowtok[pos] = row; rowdst[pos] = 2 * row + slot; rowgate[pos] = topg[2 * row + slot]; }
        }
    }
    if (blockIdx.x < 8) { const int e = blockIdx.x; int ps = 0, pe = 0, ce = 0;
#pragma unroll
        for (int ee = 0; ee < 8; ++ee) if (ee == e) { ps = pstart[ee]; pe = pstart[ee + 1]; ce = cnt[ee]; }
        for (int pos = ps * 256 + ce + tid; pos < pe * 256; pos += NTHREADS) { rowtok[pos] = -1; rowdst[pos] = -1; rowgate[pos] = 0.f; } }
}

constexpr int ML_RS = 72;
constexpr int ML_QS = 0, ML_KS = 9216, ML_KT = 18432, ML_PS = 27648, ML_VT = 36864, ML_CT = 57600, ML_HS = 78336, ML_SC = 112128;
constexpr int ML_HSS = 132;
constexpr int ML_TAB = 114688, ML_NCH = 17;
constexpr int ML_TSC = ML_TAB + 7 * ML_NCH * 64 * 4;
static_assert(ML_TSC + 1024 <= MISC_OFF, "mLSTM LDS");
__device__ __forceinline__ bf16x8 ml_frag(LAS unsigned char* lds, int base, int row, int kcol) { return *(const LAS bf16x8*)(lds + base + (row * ML_RS + kcol) * 2); }

template <int MODE>
__device__ __forceinline__ void mlstm_phase(unsigned char* ws, LAS unsigned char* lds, int layer, int tid, int wave, int lane) {
    const int item = blockIdx.x; const int bh = item >> 3, seg = item & 7, b = bh >> 3, h = bh & 7;
    if (MODE == 1 && seg == 7) return;
    const bf16_t* proj = (const bf16_t*)(ws + WS_PROJ); const float* gates = (const float*)(ws + WS_GATES);
    bf16_t* HG = (bf16_t*)(ws + WS_HG);
    float* STATE = (float*)(ws + WS_STATE); float* STSC = (float*)(ws + WS_STSC);
    LAS float* sc = (LAS float*)(lds + ML_SC);
    LAS float* tab = (LAS float*)(lds + ML_TAB); LAS float* tsc = (LAS float*)(lds + ML_TSC);
    const int fr = lane & 15, quad = lane >> 4;
    f32x4 st[5]; float zero = 0.f; asm volatile("; opaque zero" : "+v"(zero));
#pragma unroll
    for (int i = 0; i < 5; ++i) st[i] = (f32x4){zero, zero, zero, zero};
    float m0 = (MODE == 1) ? -1.0e30f : 0.f;
    const int nch = SEG_CHUNKS + (seg == 0 ? 1 : 0);
    auto chunk_rows = [&](int ci, int& rbase, int& nv) { if (seg == 0 && ci == 0) { rbase = MREAL; nv = NMETA; } else { const int c = seg * SEG_CHUNKS + ci - (seg == 0 ? 1 : 0); rbase = b * SEQ + c * 64; nv = 64; } };
    for (int i = tid; i < 16 * ML_RS; i += NTHREADS) ((LAS bf16_t*)(lds + ML_VT))[128 * ML_RS + i] = (i < ML_RS) ? (bf16_t)0x3F80 : (bf16_t)0;
    for (int ci = wave; ci < nch; ci += NWAVES) {
        int rbase, nv; chunk_rows(ci, rbase, nv); const bool ok = lane < nv;
        const float li = ok ? gates[(size_t)(rbase + lane) * 16 + h] : -1.0e30f, f = ok ? gates[(size_t)(rbase + lane) * 16 + 8 + h] : 0.f;
        const float lf = ok ? (fminf(f, 0.f) - logf(1.f + expf(-fabsf(f)))) : 0.f;
        float bc = lf;
#pragma unroll
        for (int o = 1; o < 64; o <<= 1) { const float t = __shfl_up(bc, o); if (lane >= o) bc += t; }
        const float u = li - bc; float pm = u;
#pragma unroll
        for (int o = 1; o < 64; o <<= 1) { const float t = __shfl_up(pm, o); if (lane >= o) pm = fmaxf(pm, t); }
        tab[(0 * ML_NCH + ci) * 64 + lane] = bc; tab[(1 * ML_NCH + ci) * 64 + lane] = u; tab[(2 * ML_NCH + ci) * 64 + lane] = pm;
        if (lane == 63) { tsc[ci] = bc; tsc[32 + ci] = pm; }
    }
    if (MODE == 2 && seg > 0) {
        m0 = -1.0e30f;
        for (int s2 = 0; s2 < seg; ++s2) {
            const float ms = STSC[(bh * 7 + s2) * 4 + 0], Gs = STSC[(bh * 7 + s2) * 4 + 1];
            const float mn = fmaxf(Gs + m0, ms), fo = fast_exp(Gs + m0 - mn), fn = fast_exp(ms - mn);
            const f32x4* sp = (const f32x4*)(STATE + (size_t)(bh * 7 + s2) * ST_FLOATS) + (wave * 5) * 64 + lane;
#pragma unroll
            for (int i = 0; i < 5; ++i) st[i] = st[i] * fo + sp[i * 64] * fn;
            m0 = mn;
        }
    }
#pragma unroll
    for (int i = 0; i < 5; ++i) { const int dv = (i < 4) ? 16 * wave + fr : 128 + fr, dk = (i < 4) ? 16 * i + 4 * quad : 16 * wave + 4 * quad;
        if (i < 4 || wave < 4) { u32x2 w; w.x = pk2(st[i][0], st[i][1]); w.y = pk2(st[i][2], st[i][3]); *(LAS u32x2*)(lds + ML_CT + (dv * ML_RS + dk) * 2) = w; } }
    __syncthreads();
    if (wave == 0) {
        const float bl = lane < nch ? tsc[lane] : 0.f, um = lane < nch ? tsc[32 + lane] : 0.f; float m = m0, gs = 0.f;
        for (int ci = 0; ci < nch; ++ci) { const float blast = __shfl(bl, ci), umax = __shfl(um, ci), amax = blast + umax, mn = fmaxf(blast + m, amax);
            if (lane == 0) { tsc[64 + ci] = m; tsc[96 + ci] = fast_exp(blast + m - mn); tsc[128 + ci] = fast_exp(amax - mn); }
            m = mn; gs += blast; }
        if (lane == 0) { tsc[160] = m; tsc[161] = gs; }
    }
    __syncthreads();
    for (int idx = tid; idx < nch * 64; idx += NTHREADS) { const int ci = idx >> 6, j = idx & 63;
        const float bc = tab[(0 * ML_NCH + ci) * 64 + j], u = tab[(1 * ML_NCH + ci) * 64 + j], pm = tab[(2 * ML_NCH + ci) * 64 + j], mc = tsc[64 + ci], MM = fmaxf(pm, mc);
        tab[(3 * ML_NCH + ci) * 64 + j] = MM; tab[(4 * ML_NCH + ci) * 64 + j] = fast_exp(mc - MM); tab[(5 * ML_NCH + ci) * 64 + j] = fast_exp(-(bc + MM));
        tab[(6 * ML_NCH + ci) * 64 + j] = tsc[128 + ci] * fast_exp(u - tsc[32 + ci]); }
    float lnh[16];
    if (MODE == 2) {
#pragma unroll
        for (int e = 0; e < 16; ++e) lnh[e] = ((const float*)(ws + WS_SMALL))[SM_LNH + layer * D + h * M_V + 16 * (tid & 7) + e]; }
    u32x4 rq, rk, rv0, rv1, rg0, rg1;
    auto load_chunk = [&](int ci) {
        int rbase, nv; chunk_rows(ci, rbase, nv);
        if (MODE == 2) { const int i = tid >> 3, sg = tid & 7; const u32x4* ogp = (const u32x4*)(proj + (size_t)(rbase + (i < nv ? i : 0)) * PROJ_LD + 2048 + h * M_V + 16 * sg); rg0 = ogp[0]; rg1 = ogp[1]; }
        { const int j = tid >> 3, c8 = (tid & 7) * 8; const bf16_t* rp = proj + (size_t)(rbase + j) * PROJ_LD + h * 64 + c8;
          rq = (MODE == 2 && j < nv) ? *(const u32x4*)rp : (u32x4){0u, 0u, 0u, 0u}; }
        { const bf16_t* rp = proj + (size_t)(rbase + lane) * PROJ_LD; const bool ok = lane < nv;
          rk = ok ? *(const u32x4*)(rp + 512 + h * 64 + 8 * wave) : (u32x4){0u, 0u, 0u, 0u};
          rv0 = ok ? *(const u32x4*)(rp + 1024 + h * 128 + 16 * wave) : (u32x4){0u, 0u, 0u, 0u}; rv1 = ok ? *(const u32x4*)(rp + 1024 + h * 128 + 16 * wave + 8) : (u32x4){0u, 0u, 0u, 0u}; }
    };
    load_chunk(0);
    __syncthreads();
    for (int ci = 0; ci < nch; ++ci) {
        int rbase, nv; chunk_rows(ci, rbase, nv);
        const u32x4 g0 = rg0, g1 = rg1;
        const LAS float* tU = tab + (1 * ML_NCH + ci) * 64; const LAS float* tMM = tab + (3 * ML_NCH + ci) * 64; const LAS float* tSI = tab + (4 * ML_NCH + ci) * 64;
        const LAS float* tFL = tab + (5 * ML_NCH + ci) * 64; const LAS float* tWP = tab + (6 * ML_NCH + ci) * 64;
        const float sold = tsc[96 + ci];
        { if (MODE == 2) { const int j = tid >> 3, c8 = (tid & 7) * 8; *(LAS u32x4*)(lds + ML_QS + (j * ML_RS + c8) * 2) = rq; }
          const float wj = tWP[lane]; LAS bf16_t* kt = (LAS bf16_t*)(lds + ML_KT); LAS bf16_t* vt = (LAS bf16_t*)(lds + ML_VT);
          if (MODE == 2) *(LAS u32x4*)(lds + ML_KS + (lane * ML_RS + 8 * wave) * 2) = rk;
          const unsigned kk[4] = {rk.x, rk.y, rk.z, rk.w}, a[4] = {rv0.x, rv0.y, rv0.z, rv0.w}, c[4] = {rv1.x, rv1.y, rv1.z, rv1.w};
#pragma unroll
          for (int e = 0; e < 4; ++e) { kt[(8 * wave + 2 * e) * ML_RS + lane] = (bf16_t)f2bf(bf2f((unsigned short)(kk[e] & 0xffffu)) * wj); kt[(8 * wave + 2 * e + 1) * ML_RS + lane] = (bf16_t)f2bf(bf2f((unsigned short)(kk[e] >> 16)) * wj);
              vt[(16 * wave + 2 * e) * ML_RS + lane] = (bf16_t)(a[e] & 0xffffu); vt[(16 * wave + 2 * e + 1) * ML_RS + lane] = (bf16_t)(a[e] >> 16);
              vt[(16 * wave + 8 + 2 * e) * ML_RS + lane] = (bf16_t)(c[e] & 0xffffu); vt[(16 * wave + 8 + 2 * e + 1) * ML_RS + lane] = (bf16_t)(c[e] >> 16); } }
        __syncthreads();
        if (ci + 1 < nch) load_chunk(ci + 1);
        f32x4 o1[4], o2[4];
        if (MODE == 2) {
            const int mt = wave >> 1;
#pragma unroll
            for (int q = 0; q < 2; ++q) { const int nt = 2 * (wave & 1) + q; f32x4 s = (f32x4){0.f, 0.f, 0.f, 0.f};
                if (nt <= mt) {
#pragma unroll
                    for (int ks = 0; ks < 2; ++ks) s = __builtin_amdgcn_mfma_f32_16x16x32_bf16(ml_frag(lds, ML_QS, 16 * mt + fr, 32 * ks + 8 * quad), ml_frag(lds, ML_KS, 16 * nt + fr, 32 * ks + 8 * quad), s, 0, 0, 0); }
                const int j = 16 * nt + fr; const float uj = tU[j];
#pragma unroll
                for (int r = 0; r < 4; ++r) { const int i = 16 * mt + 4 * quad + r; const float p = (j <= i) ? s[r] * fast_exp(uj - tMM[i]) : 0.f;
                    ((LAS bf16_t*)(lds + ML_PS))[i * ML_RS + j] = (bf16_t)f2bf(p); } }
            __syncthreads();
            bf16x8 vb[2], cb[2];
#pragma unroll
            for (int ks = 0; ks < 2; ++ks) { vb[ks] = ml_frag(lds, ML_VT, 16 * wave + fr, 32 * ks + 8 * quad); cb[ks] = ml_frag(lds, ML_CT, 16 * wave + fr, 32 * ks + 8 * quad); }
#pragma unroll
            for (int mt2 = 0; mt2 < 4; ++mt2) { o1[mt2] = (f32x4){0.f, 0.f, 0.f, 0.f}; o2[mt2] = (f32x4){0.f, 0.f, 0.f, 0.f};
#pragma unroll
                for (int ks = 0; ks < 2; ++ks) { o1[mt2] = __builtin_amdgcn_mfma_f32_16x16x32_bf16(ml_frag(lds, ML_PS, 16 * mt2 + fr, 32 * ks + 8 * quad), vb[ks], o1[mt2], 0, 0, 0);
                    o2[mt2] = __builtin_amdgcn_mfma_f32_16x16x32_bf16(ml_frag(lds, ML_QS, 16 * mt2 + fr, 32 * ks + 8 * quad), cb[ks], o2[mt2], 0, 0, 0); } }
            if (wave < 4) { f32x4 d1 = (f32x4){0.f, 0.f, 0.f, 0.f}, d2 = (f32x4){0.f, 0.f, 0.f, 0.f};
#pragma unroll
                for (int ks = 0; ks < 2; ++ks) { d1 = __builtin_amdgcn_mfma_f32_16x16x32_bf16(ml_frag(lds, ML_PS, 16 * wave + fr, 32 * ks + 8 * quad), ml_frag(lds, ML_VT, 128 + fr, 32 * ks + 8 * quad), d1, 0, 0, 0);
                    d2 = __builtin_amdgcn_mfma_f32_16x16x32_bf16(ml_frag(lds, ML_QS, 16 * wave + fr, 32 * ks + 8 * quad), ml_frag(lds, ML_CT, 128 + fr, 32 * ks + 8 * quad), d2, 0, 0, 0); }
                if (fr == 0) {
#pragma unroll
                    for (int r = 0; r < 4; ++r) { const int i = 16 * wave + 4 * quad + r; sc[320 + i] = d1[r] + tSI[i] * d2[r]; } } }
            __syncthreads();
#pragma unroll
            for (int mt2 = 0; mt2 < 4; ++mt2)
#pragma unroll
                for (int r = 0; r < 4; ++r) { const int i = 16 * mt2 + 4 * quad + r; const float num = o1[mt2][r] + tSI[i] * o2[mt2][r];
                    ((LAS float*)(lds + ML_HS))[i * ML_HSS + 16 * wave + fr] = num * __builtin_amdgcn_rcpf(fmaxf(fabsf(sc[320 + i]), tFL[i])); }
        }
        { bf16x8 vb[2];
#pragma unroll
          for (int ks = 0; ks < 2; ++ks) vb[ks] = ml_frag(lds, ML_VT, 16 * wave + fr, 32 * ks + 8 * quad);
#pragma unroll
          for (int mt2 = 0; mt2 < 4; ++mt2) { st[mt2] = st[mt2] * sold;
#pragma unroll
              for (int ks = 0; ks < 2; ++ks) st[mt2] = __builtin_amdgcn_mfma_f32_16x16x32_bf16(ml_frag(lds, ML_KT, 16 * mt2 + fr, 32 * ks + 8 * quad), vb[ks], st[mt2], 0, 0, 0); }
          if (wave < 4) { st[4] = st[4] * sold;
#pragma unroll
              for (int ks = 0; ks < 2; ++ks) st[4] = __builtin_amdgcn_mfma_f32_16x16x32_bf16(ml_frag(lds, ML_KT, 16 * wave + fr, 32 * ks + 8 * quad), ml_frag(lds, ML_VT, 128 + fr, 32 * ks + 8 * quad), st[4], 0, 0, 0); }
          if (MODE == 2) {
#pragma unroll
              for (int i = 0; i < 5; ++i) { const int dv = (i < 4) ? 16 * wave + fr : 128 + fr, dk = (i < 4) ? 16 * i + 4 * quad : 16 * wave + 4 * quad;
                  if (i < 4 || wave < 4) { u32x2 w; w.x = pk2(st[i][0], st[i][1]); w.y = pk2(st[i][2], st[i][3]); *(LAS u32x2*)(lds + ML_CT + (dv * ML_RS + dk) * 2) = w; } } }
        }
        __syncthreads();
        if (MODE == 2) {
            const int i = tid >> 3, sg = tid & 7; const LAS float* hp = (const LAS float*)(lds + ML_HS) + i * ML_HSS + 16 * sg;
            float x[16]; float s = 0.f;
#pragma unroll
            for (int e = 0; e < 16; ++e) { x[e] = hp[e]; s += x[e]; }
            s += __shfl_xor(s, 1); s += __shfl_xor(s, 2); s += __shfl_xor(s, 4);
            const float mean = s * (1.f / M_V); float q = 0.f;
#pragma unroll
            for (int e = 0; e < 16; ++e) { x[e] -= mean; q += x[e] * x[e]; }
            q += __shfl_xor(q, 1); q += __shfl_xor(q, 2); q += __shfl_xor(q, 4);
            const float rstd = 1.f / sqrtf(q * (1.f / M_V) + LN_EPS);
            if (i < nv && (nv == 64 || b == 0)) {
                const size_t row = (size_t)(rbase + i);
                const unsigned gw8[8] = {g0.x, g0.y, g0.z, g0.w, g1.x, g1.y, g1.z, g1.w}; unsigned ow[8];
#pragma unroll
                for (int e = 0; e < 8; ++e) { const float oga = bf2f((unsigned short)(gw8[e] & 0xffffu)), ogb = bf2f((unsigned short)(gw8[e] >> 16));
                    const float ya = x[2 * e] * rstd * lnh[2 * e] * __builtin_amdgcn_rcpf(1.f + fast_exp(-oga)), yb = x[2 * e + 1] * rstd * lnh[2 * e + 1] * __builtin_amdgcn_rcpf(1.f + fast_exp(-ogb));
                    ow[e] = pk2(ya, yb); }
                u32x4* op = (u32x4*)(HG + row * D + h * M_V + 16 * sg);
                op[0] = (u32x4){ow[0], ow[1], ow[2], ow[3]}; op[1] = (u32x4){ow[4], ow[5], ow[6], ow[7]};
            }
        }
    }
    if (MODE == 1) {
        f32x4* sp = (f32x4*)(STATE + (size_t)(bh * 7 + seg) * ST_FLOATS) + (wave * 5) * 64 + lane;
#pragma unroll
        for (int i = 0; i < 5; ++i) sp[i * 64] = (i < 4 || wave < 4) ? st[i] : (f32x4){0.f, 0.f, 0.f, 0.f};
        if (tid == 0) { STSC[(bh * 7 + seg) * 4 + 0] = tsc[160]; STSC[(bh * 7 + seg) * 4 + 1] = tsc[161]; }
    }
}

constexpr int AT_KRS = 72, AT_VRS = 280, AT_NK = 272;
constexpr int AT_KS = 0, AT_VT = AT_NK * AT_KRS * 2, AT_END = AT_VT + 64 * AT_VRS * 2;
static_assert(AT_END <= MISC_OFF, "attention LDS");
__device__ __forceinline__ void attn_phase(unsigned char* ws, LAS unsigned char* lds, int j_layer, int tid, int wave, int lane) {
    const bf16_t* Q = (const bf16_t*)(ws + WS_PROJ); const bf16_t* KB = (const bf16_t*)(ws + WS_KB); const bf16_t* VT = (const bf16_t*)(ws + WS_VB);
    bf16_t* HG = (bf16_t*)(ws + WS_HG);
    const float* sinks = (const float*)(ws + WS_SMALL) + SM_SINKS + j_layer * A_HEADS;
    const int fr = lane & 15, quad = lane >> 4;
    LAS bf16_t* ks = (LAS bf16_t*)(lds + AT_KS); LAS bf16_t* vt = (LAS bf16_t*)(lds + AT_VT);
    u32x4 kreg[5], vreg[5]; bf16x8 qn[4][2];
    const int NREG = NBATCH * A_KV * (SEQ / WINDOW), NIT = NREG + A_KV;
    auto prefetch = [&](int it) {
        const bool meta = it >= NREG; const int b = meta ? 0 : it >> 8, g = meta ? it - NREG : (it >> 6) & 3, blk = meta ? -1 : it & 63;
#pragma unroll
        for (int i = 0; i < 5; ++i) { const int p = tid + i * NTHREADS; kreg[i] = (u32x4){0u, 0u, 0u, 0u}; vreg[i] = (u32x4){0u, 0u, 0u, 0u};
            if (p < AT_NK * 8) { const int kk = p >> 3, c8 = (p & 7) * 8;
                int row; if (kk >= 256) row = MREAL + kk - 256; else { const int tk = (blk - 1) * WINDOW + kk; row = (tk < 0 || meta) ? -1 : b * SEQ + tk; }
                if (row >= 0) kreg[i] = *(const u32x4*)(KB + (size_t)row * 256 + g * 64 + c8);
                const int d = p / 34, pc = p % 34; const bf16_t* src = VT + (size_t)(g * 64 + d) * MP;
                if (pc >= 32) vreg[i] = *(const u32x4*)(src + MREAL + (pc - 32) * 8);
                else { const int tk = (blk - 1) * WINDOW + pc * 8; if (tk >= 0 && !meta) vreg[i] = *(const u32x4*)(src + (size_t)b * SEQ + tk); } } }
    };
    auto qload = [&](int it, int mt) {
        const bool meta = it >= NREG; const int b = it >> 8, g = meta ? it - NREG : (it >> 6) & 3, blk = it & 63, qh = g * 4 + (wave >> 1);
        const size_t rowq = meta ? (size_t)MREAL + fr : (size_t)b * SEQ + blk * WINDOW + 16 * (4 * (wave & 1) + mt) + fr;
#pragma unroll
        for (int k2 = 0; k2 < 2; ++k2) qn[mt][k2] = *(const bf16x8*)(Q + rowq * D + qh * 64 + 32 * k2 + 8 * quad);
    };
    if ((int)blockIdx.x < NIT) { prefetch(blockIdx.x);
#pragma unroll
        for (int mt = 0; mt < 4; ++mt) qload(blockIdx.x, mt); }
    for (int it = blockIdx.x; it < NIT; it += gridDim.x) {
        const bool meta = it >= NREG; const int b = it >> 8, g = meta ? it - NREG : (it >> 6) & 3, blk = it & 63;
        __syncthreads();
#pragma unroll
        for (int i = 0; i < 5; ++i) { const int p = tid + i * NTHREADS;
            if (p < AT_NK * 8) { *(LAS u32x4*)(ks + (p >> 3) * AT_KRS + (p & 7) * 8) = kreg[i]; *(LAS u32x4*)(vt + (p / 34) * AT_VRS + (p % 34) * 8) = vreg[i]; } }
        __syncthreads();
        const bool has_next = it + (int)gridDim.x < NIT;
        if (has_next) prefetch(it + gridDim.x);
        const int qh = g * 4 + (wave >> 1); const float sink = sinks[qh];
#pragma unroll
        for (int mt = 0; mt < 4; ++mt) {
            if (meta && (mt > 0 || (wave & 1))) continue;
            const int t0 = meta ? 0 : 4 * (wave & 1) + mt, qi = 16 * t0 + fr;
            const size_t rowq = meta ? (size_t)MREAL + fr : (size_t)b * SEQ + blk * WINDOW + qi;
            f32x4 s[10];
#pragma unroll
            for (int c = 0; c < 10; ++c) { const int kb = (c < 9) ? 16 * (t0 + c) : 256; s[c] = (f32x4){0.f, 0.f, 0.f, 0.f};
#pragma unroll
                for (int k2 = 0; k2 < 2; ++k2) s[c] = __builtin_amdgcn_mfma_f32_16x16x32_bf16(*(const LAS bf16x8*)(ks + (kb + fr) * AT_KRS + 32 * k2 + 8 * quad), qn[mt][k2], s[c], 0, 0, 0); }
            if (has_next) qload(it + gridDim.x, mt);
            float m = sink;
#pragma unroll
            for (int c = 0; c < 9; ++c)
#pragma unroll
                for (int r = 0; r < 4; ++r) { const int j = 16 * (t0 + c) + 4 * quad + r, rel = qi + WINDOW - j; const bool vis = !meta && (rel >= 0) && (rel < WINDOW) && (blk > 0 || j >= WINDOW);
                    s[c][r] = vis ? s[c][r] : -1.0e30f; m = fmaxf(m, s[c][r]); }
#pragma unroll
            for (int r = 0; r < 4; ++r) { const bool vis = !meta || (4 * quad + r <= fr); s[9][r] = vis ? s[9][r] : -1.0e30f; m = fmaxf(m, s[9][r]); }
            m = fmaxf(m, __shfl_xor(m, 16)); m = fmaxf(m, __shfl_xor(m, 32));
            float sm = 0.f;
#pragma unroll
            for (int c = 0; c < 10; ++c)
#pragma unroll
                for (int r = 0; r < 4; ++r) { const float p = fast_exp(s[c][r] - m); s[c][r] = p; sm += p; }
            sm += __shfl_xor(sm, 16); sm += __shfl_xor(sm, 32);
            const float inv = 1.f / (sm + fast_exp(sink - m));
            f32x4 o[4];
#pragma unroll
            for (int dt = 0; dt < 4; ++dt) o[dt] = (f32x4){0.f, 0.f, 0.f, 0.f};
#pragma unroll
            for (int u = 0; u < 5; ++u) {
                const int kb0 = 16 * (t0 + 2 * u), kb1 = (u < 4) ? 16 * (t0 + 2 * u + 1) : 256;
                u32x4 pw; pw.x = cvt_pk_bf16(s[2 * u][0], s[2 * u][1]); pw.y = cvt_pk_bf16(s[2 * u][2], s[2 * u][3]); pw.z = cvt_pk_bf16(s[2 * u + 1][0], s[2 * u + 1][1]); pw.w = cvt_pk_bf16(s[2 * u + 1][2], s[2 * u + 1][3]);
                const bf16x8 pf = __builtin_bit_cast(bf16x8, pw);
#pragma unroll
                for (int dt = 0; dt < 4; ++dt) { const LAS bf16_t* vr = vt + (16 * dt + fr) * AT_VRS + 4 * quad;
                    u32x4 vw; const u32x2 a = *(const LAS u32x2*)(vr + kb0), c2 = *(const LAS u32x2*)(vr + kb1); vw.x = a.x; vw.y = a.y; vw.z = c2.x; vw.w = c2.y;
                    o[dt] = __builtin_amdgcn_mfma_f32_16x16x32_bf16(__builtin_bit_cast(bf16x8, vw), pf, o[dt], 0, 0, 0); } }
#pragma unroll
            for (int dt = 0; dt < 4; ++dt) { u32x2 w; w.x = cvt_pk_bf16(o[dt][0] * inv, o[dt][1] * inv); w.y = cvt_pk_bf16(o[dt][2] * inv, o[dt][3] * inv);
                *(u32x2*)(HG + rowq * D + qh * 64 + 16 * dt + 4 * quad) = w; }
        }
    }
}

#ifndef SITES
#define SITES 0xFFFF
#endif
#define SITE(n) ((SITES >> (n)) & 1)
#ifndef DUPMASK
#define DUPMASK 0
#endif
#define REPS(n) (1 + ((DUPMASK >> (n)) & 1))
#ifndef MK_PER_PHASE
#define MK_PER_PHASE 0
#endif
constexpr int PH_PER_LAYER = 12, N_PHASES = 1 + 4 * PH_PER_LAYER;

__global__ void __launch_bounds__(NTHREADS, 2) fwd(Params P) {
    extern __shared__ __attribute__((aligned(16))) unsigned char lds_raw[];
    LAS unsigned char* const lds0 = (LAS unsigned char*)lds_raw;
    const int G = gridDim.x;
    const int vcu = (G % 8 == 0) ? ((int)blockIdx.x % 8) * (G / 8) + (int)blockIdx.x / 8 : (int)blockIdx.x;
    const int NGW = G * NWAVES;
    unsigned char* const wsbase = P.ws;
    volatile LAS unsigned* misc = (volatile LAS unsigned*)(lds0 + MISC_OFF);
    if (threadIdx.x < 64) misc[threadIdx.x] = 0u;
    __syncthreads();
    XcdBarrier bar = xcd_barrier_post((unsigned*)(wsbase + WS_CTL) + CW_BAR + P.li * 4096, misc + 8);
    const int lo = P.ph_lo, hi = P.ph_hi;
#define RUN(idx) ((idx) >= lo && (idx) < hi)
#define SEAM(idx) do { if ((idx) + 1 < hi) xcd_barrier(bar); } while (0)
#define IDS() int tid = threadIdx.x; asm volatile("; opaque tid" : "+v"(tid)); unsigned char* ws = wsbase; asm volatile("; opaque ws" : "+s"(ws)); \
              LAS unsigned char* lds = lds0; asm volatile("; opaque lds" : "+s"(lds)); \
              const int lane = tid & 63, wave = __builtin_amdgcn_readfirstlane(tid >> 6); const int gw = vcu * NWAVES + wave; (void)lane; (void)gw; (void)ws

    for (int rep = 0; rep < REPS(0); ++rep) if (SITE(0) && RUN(0)) { IDS(); p0_prologue(P, lds, gw, NGW, wave, lane); SEAM(0); }

    for (int l = 0; l < 4; ++l) {
        const int pb = 1 + l * PH_PER_LAYER;
        const bool moe = (l & 1) != 0; const int fi = l >> 1;
        if (l < 2) {
            for (int rep = 0; rep < REPS(1); ++rep) if (SITE(1) && RUN(pb + 0)) {
                IDS();
                pg8::DenseOrder S; S.init(MREAL / 256, 12, G, (int)blockIdx.x);
                EpiProj E{(bf16_t*)(ws + WS_PROJ), (float*)(ws + WS_GATES), (const float*)(ws + WS_SMALL) + SM_BGATE + l * 16};
                const bf16_t* HBp = (const bf16_t*)(ws + WS_HB); const bf16_t* Wp = (const bf16_t*)(ws + WS_WIN) + (size_t)l * M_INP * D;
                pg8::gemm_phase(lds, HBp, Wp, D, S, E);
                bf16_t* PROJ = (bf16_t*)(ws + WS_PROJ); float* GATES = (float*)(ws + WS_GATES); const float* bg = (const float*)(ws + WS_SMALL) + SM_BGATE + l * 16;
                int par = 0;
                for (int item = (int)blockIdx.x; item < 192; item += G, par ^= 1) { const bf16_t* B1[1] = {Wp + (size_t)item * 16 * D};
                    skinny_item<1>(HBp + (size_t)MREAL * D, D, B1, D, wave, lane, lds, par, [&](const f32x4 (&a)[1], int fr, int quad) {
#pragma unroll
                        for (int r = 0; r < 4; ++r) PROJ[(size_t)(MREAL + 4 * quad + r) * PROJ_LD + item * 16 + fr] = (bf16_t)f2bf(a[0][r]); }); }
                { const int fr = lane & 15, quad = lane >> 4; const bf16_t* bp = Wp + (size_t)(3072 + fr) * D + 8 * quad; const float bias = bg[fr];
                  for (int rt = gw; rt < MV / 16; rt += NGW) { const bf16_t* ap = HBp + (size_t)(rt * 16 + fr) * D + 8 * quad;
                      f32x4 a0 = (f32x4){0.f, 0.f, 0.f, 0.f}, a1 = (f32x4){0.f, 0.f, 0.f, 0.f};
#pragma unroll 8
                      for (int k = 0; k < D; k += 64) { a0 = __builtin_amdgcn_mfma_f32_16x16x32_bf16(*(const bf16x8*)(ap + k), *(const bf16x8*)(bp + k), a0, 0, 0, 0);
                          a1 = __builtin_amdgcn_mfma_f32_16x16x32_bf16(*(const bf16x8*)(ap + k + 32), *(const bf16x8*)(bp + k + 32), a1, 0, 0, 0); }
#pragma unroll
                      for (int r = 0; r < 4; ++r) GATES[(size_t)(rt * 16 + 4 * quad + r) * 16 + fr] = a0[r] + a1[r] + bias; } }
                SEAM(pb + 0); }
            for (int rep = 0; rep < REPS(2); ++rep) if (SITE(2) && RUN(pb + 1)) { IDS(); mlstm_phase<1>(ws, lds, l, tid, wave, lane); SEAM(pb + 1); }
            for (int rep = 0; rep < REPS(3); ++rep) if (SITE(3) && RUN(pb + 2)) { IDS(); mlstm_phase<2>(ws, lds, l, tid, wave, lane); SEAM(pb + 2); }
        } else {
            for (int rep = 0; rep < REPS(4); ++rep) if (SITE(4) && RUN(pb + 0)) {
                IDS();
                pg8::DenseOrder S; S.init(MREAL / 256, l == 2 ? 6 : 4, G, (int)blockIdx.x);
                EpiQKV E{(bf16_t*)(ws + WS_PROJ), (bf16_t*)(ws + WS_KB), (bf16_t*)(ws + WS_VB), (const float*)(ws + WS_ROPE)};
                const bf16_t* HBp = (const bf16_t*)(ws + WS_HB); const bf16_t* Wp = (const bf16_t*)(ws + (l == 2 ? WS_WQKV : WS_WQ3));
                pg8::gemm_phase(lds, HBp, Wp, D, S, E);
                bf16_t* Qp = (bf16_t*)(ws + WS_PROJ); bf16_t* KBp = (bf16_t*)(ws + WS_KB); bf16_t* VTp = (bf16_t*)(ws + WS_VB); const float* rope = (const float*)(ws + WS_ROPE);
                int par = 0;
                for (int item = (int)blockIdx.x; item < (l == 2 ? 96 : 64); item += G, par ^= 1) { const bf16_t* B1[1] = {Wp + (size_t)item * 16 * D};
                    skinny_item<1>(HBp + (size_t)MREAL * D, D, B1, D, wave, lane, lds, par, [&](const f32x4 (&a)[1], int fr, int quad) {
                        const int col = item * 16 + fr; const bool dorope = (item < 80) && ((item & 3) == 0);
#pragma unroll
                        for (int r = 0; r < 4; ++r) { const int pos = 4 * quad + r; float x = a[0][r]; const float y = __shfl_xor(x, 8);
                            if (dorope) { const float c = rope[pos * 16 + (fr & 7)], sn = rope[pos * 16 + 8 + (fr & 7)]; x = (fr < 8) ? x * c - y * sn : x * c + y * sn; }
                            const bf16_t o = (bf16_t)f2bf(x); const size_t row = (size_t)MREAL + pos;
                            if (item < 64) Qp[row * D + col] = o; else if (item < 80) KBp[row * 256 + col - 1024] = o; else VTp[(size_t)(col - 1280) * MP + row] = o; } });
                }
                SEAM(pb + 0); }
            for (int rep = 0; rep < REPS(5); ++rep) if (SITE(5) && RUN(pb + 1)) { IDS(); attn_phase(ws, lds, l - 2, tid, wave, lane); SEAM(pb + 1); }
        }
        for (int rep = 0; rep < REPS(6); ++rep) if (SITE(6) && RUN(pb + 3)) {
            IDS();
            pg8::DenseOrder S; S.init(MREAL / 256, 4, G, (int)blockIdx.x);
            const float* smp = (const float*)(ws + WS_SMALL);
            EpiRes E{(bf16_t*)(ws + WS_H), (const float*)(ws + WS_STATS), l > 0 ? smp + SM_LNG + (size_t)(2 * l - 1) * D : nullptr, smp + SM_LNB + (size_t)(l > 0 ? 2 * l - 1 : 0) * D, P.in[I_X], 1.f};
            const bf16_t* Ap = (const bf16_t*)(ws + WS_HG); const bf16_t* Wp = (const bf16_t*)(ws + (l < 2 ? WS_WOUT : WS_WO)) + (size_t)(l & 1) * D * D;
            pg8::gemm_phase(lds, Ap, Wp, D, S, E);
            int par = 0;
            for (int item = (int)blockIdx.x; item < 64; item += G, par ^= 1) { const bf16_t* B1[1] = {Wp + (size_t)item * 16 * D};
                skinny_item<1>(Ap + (size_t)MREAL * D, D, B1, D, wave, lane, lds, par, [&](const f32x4 (&a)[1], int fr, int quad) { const int col = item * 16 + fr;
#pragma unroll
                    for (int r = 0; r < 4; ++r) { const size_t row = (size_t)MREAL + 4 * quad + r; float h = E.lg ? bf2f(E.H[row * D + col]) : P.in[I_META][(size_t)(4 * quad + r) * D + col];
                        if (E.lg) h = (h - E.stats[2 * row]) * E.stats[2 * row + 1] * E.lg[col] + E.lb[col];
                        E.H[row * D + col] = (bf16_t)f2bf(h * ALPHA + a[0][r]); } });
            }
            SEAM(pb + 3); }
        for (int rep = 0; rep < (moe ? REPS(14) : REPS(7)); ++rep) if (SITE(7) && RUN(pb + 4)) { IDS(); ln_phase(ws, nullptr, lds, gw, NGW, lane, tid, l * 2 + 0, false, moe, fi, false, moe && rep > 0); SEAM(pb + 4); }
        if (!moe) {
            for (int rep = 0; rep < REPS(8); ++rep) if (SITE(8) && RUN(pb + 5)) {
                IDS();
                pg8::DenseOrder S; S.init(MREAL / 256, 2 * D_FF / 256, G, (int)blockIdx.x);
                EpiSwiglu8 E{ws + WS_ACT, D_FF, 1.f};
                const bf16_t* HBp = (const bf16_t*)(ws + WS_HB); const bf16_t* Wp = (const bf16_t*)(ws + WS_WGU) + (size_t)fi * 2 * D_FF * D;
                pg8::gemm_phase(lds, HBp, Wp, D, S, E);
                int par = 0;
                for (int item = (int)blockIdx.x; item < D_FF / 16; item += G, par ^= 1) {
                    const int brow = 256 * (item >> 3) + 16 * (item & 7); const bf16_t* B2[2] = {Wp + (size_t)brow * D, Wp + (size_t)(brow + 128) * D};
                    skinny_item<2>(HBp + (size_t)MREAL * D, D, B2, D, wave, lane, lds, par, [&](const f32x4 (&a)[2], int fr, int quad) {
#pragma unroll
                        for (int r = 0; r < 4; ++r) E.act[(size_t)(MREAL + 4 * quad + r) * D_FF + item * 16 + fr] = (unsigned char)(pk4_fp8(EpiSwiglu::silu_mul(a[0][r], a[1][r]) * F8_SACT, 0.f, 0.f, 0.f) & 0xffu); });
                }
                SEAM(pb + 5); }
            for (int rep = 0; rep < REPS(9); ++rep) if (SITE(9) && RUN(pb + 6)) {
                IDS();
                pg8::DenseOrder S; S.init(MREAL / 256, 4, G, (int)blockIdx.x);
                const float* smp = (const float*)(ws + WS_SMALL);
                EpiRes E{(bf16_t*)(ws + WS_H), (const float*)(ws + WS_STATS), smp + SM_LNG + (size_t)(2 * l) * D, smp + SM_LNB + (size_t)(2 * l) * D, nullptr, F8_INVD};
                const unsigned char* Ap = ws + WS_ACT; const unsigned char* Wp = ws + WS_WDN8 + (size_t)fi * D * D_FF;
                pg8::gemm_phase<EpiRes, pg8::DenseOrder, true>(lds, Ap, Wp, D_FF, S, E);
                int par = 0;
                for (int item = (int)blockIdx.x; item < 64; item += G, par ^= 1) { const unsigned char* B1[1] = {Wp + (size_t)item * 16 * D_FF};
                    skinny_item8<1>(Ap + (size_t)MREAL * D_FF, D_FF, B1, D_FF, wave, lane, lds, par, [&](const f32x4 (&a)[1], int fr, int quad) { const int col = item * 16 + fr;
#pragma unroll
                        for (int r = 0; r < 4; ++r) { const size_t row = (size_t)MREAL + 4 * quad + r; float h = bf2f(E.H[row * D + col]);
                            h = (h - E.stats[2 * row]) * E.stats[2 * row + 1] * E.lg[col] + E.lb[col];
                            E.H[row * D + col] = (bf16_t)f2bf(h * ALPHA + a[0][r] * E.sc); } });
                }
                SEAM(pb + 6); }
        } else {
            for (int rep = 0; rep < REPS(10); ++rep) if (SITE(10) && RUN(pb + 5)) { IDS(); assign_phase(ws, gw, NGW, lane, tid, fi); SEAM(pb + 5); }
            for (int rep = 0; rep < REPS(11); ++rep) if (SITE(11) && RUN(pb + 6)) {
                IDS();
                int cnt[8]; pg8::GroupedOrder S; moe_starts(ws, fi, cnt, S.pstart);
                S.o.init(S.pstart[8], 2 * D_FF_EXP / 256, G, (int)blockIdx.x); S.nexp_rows = 2 * D_FF_EXP; S.rowtok = (const int*)(ws + WS_ROWTOK);
                EpiSwiglu8 E{ws + WS_ACT, D_FF_EXP, F8_INV};
                pg8::gemm_phase<EpiSwiglu8, pg8::GroupedOrder, true>(lds, ws + WS_HB8, ws + WS_WGUE8 + (size_t)fi * 8 * 2 * D_FF_EXP * D, D, S, E);
                SEAM(pb + 6); }
            for (int rep = 0; rep < REPS(12); ++rep) if (SITE(12) && RUN(pb + 7)) {
                IDS();
                int cnt[8]; pg8::GroupedOrder S; moe_starts(ws, fi, cnt, S.pstart);
                S.o.init(S.pstart[8], 4, G, (int)blockIdx.x); S.nexp_rows = D; S.rowtok = nullptr;
                EpiScatter E{(bf16_t*)(ws + WS_CONTRIB), (const int*)(ws + WS_ROWDST), (const float*)(ws + WS_ROWGATE), F8_INVD};
                pg8::gemm_phase<EpiScatter, pg8::GroupedOrder, true>(lds, ws + WS_ACT, ws + WS_WDNE8 + (size_t)fi * 8 * D * D_FF_EXP, D_FF_EXP, S, E);
                SEAM(pb + 7); }
        }
        for (int rep = 0; rep < (moe ? (l == 1 ? REPS(15) : 1) : REPS(13)); ++rep) if (SITE(13) && RUN(pb + 10)) { IDS(); ln_phase(ws, P.out, lds, gw, NGW, lane, tid, l * 2 + 1, moe, false, 0, l == 3, moe && rep == 0 && REPS(15) > 1); SEAM(pb + 10); }
    }
#undef RUN
#undef SEAM
#undef IDS
}

extern "C" void kernel_launch(void* const* d_in, const int* in_sizes, int n_in, void* d_out, int out_size, void* d_ws, size_t ws_size, hipStream_t stream) {
    static int grid = 0;
    if (grid == 0) {
        if (n_in != 18 || out_size != MREAL * D || ws_size < WS_END) { fprintf(stderr, "kernel_launch: unexpected shapes (n_in %d, out %d, ws %zu < %zu)\n", n_in, out_size, ws_size, (size_t)WS_END); grid = -1; return; }
        int dev = 0, cus = 0, per_cu = 0;
        if (hipGetDevice(&dev) != hipSuccess || hipDeviceGetAttribute(&cus, hipDeviceAttributeMultiprocessorCount, dev) != hipSuccess) { grid = -1; return; }
        if (hipFuncSetAttribute((const void*)fwd, hipFuncAttributeMaxDynamicSharedMemorySize, LDS_BYTES) != hipSuccess) { fprintf(stderr, "kernel_launch: hipFuncSetAttribute failed\n"); grid = -1; return; }
        if (hipOccupancyMaxActiveBlocksPerMultiprocessor(&per_cu, (const void*)fwd, NTHREADS, LDS_BYTES) != hipSuccess || per_cu < 1) fprintf(stderr, "kernel_launch: occupancy query reports %d\n", per_cu);
        (void)hipGetLastError();
        grid = cus > 256 ? 256 : cus;
    }
    if (grid < 0) return;
    (void)in_sizes;
    if (hipMemsetAsync((char*)d_ws + WS_CTL, 0, CTL_BYTES, stream) != hipSuccess) return;
    Params p{};
    for (int i = 0; i < 18; ++i) p.in[i] = (const float*)d_in[i];
    p.out = (float*)d_out; p.ws = (unsigned char*)d_ws;
#if MK_PER_PHASE
    int li = 0;
    for (int ph = 0; ph < N_PHASES; ++ph) {
        const int k = (ph - 1) % PH_PER_LAYER, l = (ph - 1) / PH_PER_LAYER;
        if (ph > 0) { const bool moe = l & 1; if (k == 2 && l >= 2) continue; if (k == 8 || k == 9 || k == 11) continue; if (k == 7 && !moe) continue; }
        p.ph_lo = ph; p.ph_hi = ph + 1; p.li = li++; p.pad = 0;
        hipLaunchKernelGGL(fwd, dim3(grid), dim3(NTHREADS), LDS_BYTES, stream, p);
    }
#else
    p.ph_lo = 0; p.ph_hi = N_PHASES; p.li = 0; p.pad = 0;
    hipLaunchKernelGGL(fwd, dim3(grid), dim3(NTHREADS), LDS_BYTES, stream, p);
#endif
}
```

```cpp
#include <hip/hip_runtime.h>
#include <cstdio>
#include <cstdint>

#define LAS __attribute__((address_space(3)))
#define GAS __attribute__((address_space(1)))
typedef unsigned short bf16_t;
typedef short bf16x8 __attribute__((ext_vector_type(8)));
typedef float f32x4 __attribute__((ext_vector_type(4)));
typedef float f32x2 __attribute__((ext_vector_type(2)));
typedef unsigned u32x4 __attribute__((ext_vector_type(4)));
typedef unsigned u32x2 __attribute__((ext_vector_type(2)));
typedef int i32x8 __attribute__((ext_vector_type(8)));

constexpr int D = 1024, NBATCH = 4, SEQ = 8192, NMETA = 16;
constexpr int MREAL = NBATCH * SEQ;
constexpr int MV = MREAL + NMETA;
constexpr int MP = 129 * 256;
constexpr int M_HEADS = 8, M_QK = 64, M_V = 128;
constexpr int M_IN = 3088, M_INP = 3328;
constexpr int PROJ_LD = 3072;
constexpr int A_HEADS = 16, A_KV = 4, A_HD = 64, WINDOW = 128;
constexpr int D_FF = 2816, N_EXP = 8, D_FF_EXP = 3584;
constexpr float ALPHA = 1.681792830507429f;
constexpr float LN_EPS = 1e-5f;
constexpr int RP = 265 * 256;
constexpr int NSEG = 8, SEG_CHUNKS = 16;
constexpr int ST_FLOATS = 8 * 5 * 64 * 4;

constexpr size_t MiB = 1u << 20;
constexpr size_t al(size_t x) { return (x + 4095) & ~(size_t)4095; }
constexpr size_t WS_CTL = 0, CTL_BYTES = 1 * MiB;
constexpr size_t WS_WIN = WS_CTL + CTL_BYTES;
constexpr size_t WS_WOUT = WS_WIN + al((size_t)2 * M_INP * D * 2);
constexpr size_t WS_WQKV = WS_WOUT + al((size_t)2 * D * D * 2);
constexpr size_t WS_WQ3 = WS_WQKV + al((size_t)1536 * D * 2);
constexpr size_t WS_WO = WS_WQ3 + al((size_t)D * D * 2);
constexpr size_t WS_WGU = WS_WO + al((size_t)2 * D * D * 2);
constexpr size_t WS_WDN = WS_WGU + al((size_t)2 * 2 * D_FF * D * 2);
constexpr size_t WS_WGUE = WS_WDN + al((size_t)2 * D * D_FF * 2);
constexpr size_t WS_WDNE = WS_WGUE + al((size_t)16 * 2 * D_FF_EXP * D * 2);
constexpr size_t WS_H = WS_WDNE + al((size_t)16 * D * D_FF_EXP * 2);
constexpr size_t WS_HB = WS_H + al((size_t)MP * D * 4);
constexpr size_t WS_PROJ = WS_HB + al((size_t)MP * D * 2);
constexpr size_t WS_HG = WS_PROJ + (size_t)MP * PROJ_LD * 2;
constexpr size_t WS_CONTRIB = WS_PROJ;
constexpr size_t WS_KB = WS_HG + al((size_t)MP * D * 2);
constexpr size_t WS_VB = WS_KB + al((size_t)MP * 256 * 2);
constexpr size_t WS_GATES = WS_VB + al((size_t)MP * 256 * 2);
constexpr size_t WS_ACT = WS_GATES + al((size_t)MP * 16 * 4);
constexpr size_t WS_STATE = WS_ACT + al((size_t)RP * D_FF_EXP * 2);
constexpr size_t WS_STSC = WS_STATE + al((size_t)32 * 7 * ST_FLOATS * 4);
constexpr size_t WS_ROPE = WS_STSC + al((size_t)32 * 7 * 4 * 4);
constexpr size_t WS_TOPE = WS_ROPE + al((size_t)8208 * 16 * 4);
constexpr size_t WS_TOPG = WS_TOPE + al((size_t)MP * 4);
constexpr size_t WS_ROWTOK = WS_TOPG + al((size_t)MP * 8);
constexpr size_t WS_ROWDST = WS_ROWTOK + al((size_t)RP * 4);
constexpr size_t WS_ROWGATE = WS_ROWDST + al((size_t)RP * 4);
constexpr size_t WS_HB8 = WS_ROWGATE + al((size_t)RP * 4);
constexpr size_t WS_WGUE8 = WS_HB8 + al((size_t)MP * D);
constexpr size_t WS_WDNE8 = WS_WGUE8 + al((size_t)16 * 2 * D_FF_EXP * D);
constexpr size_t WS_WDN8 = WS_WDNE8 + al((size_t)16 * D * D_FF_EXP);
constexpr size_t WS_STATS = WS_WDN8 + al((size_t)2 * D * D_FF);
constexpr size_t WS_SMALL = WS_STATS + al((size_t)MP * 8);
constexpr int SM_BGATE = 0, SM_SINKS = 32, SM_BROUTER = 64, SM_LNH = 128, SM_LNG = SM_LNH + 2 * D, SM_LNB = SM_LNG + 8 * D, SM_WROUTER = SM_LNB + 8 * D, SM_END = SM_WROUTER + 2 * D * N_EXP;
constexpr size_t WS_END = WS_SMALL + al((size_t)SM_END * 4);
static_assert((size_t)MP * 2 * D * 4 <= (WS_KB - WS_PROJ), "contrib overlay fits PROJ+HG");
static_assert(WS_END <= (size_t)1792 * MiB, "workspace map exceeds the guaranteed d_ws size");

constexpr int CW_CNT = 1024;
constexpr int CW_CUR = 1024 + 256;
constexpr int CW_CNTG = 4096;
constexpr int CW_BAR = 16384;

constexpr int LDS_BYTES = 163840 - 512;
constexpr int RING_BYTES = 131072;
constexpr int MISC_OFF = LDS_BYTES - 256;

__device__ __forceinline__ unsigned f2bf(float f) { unsigned u = __builtin_bit_cast(unsigned, f); return (u + 0x7fffu + ((u >> 16) & 1u)) >> 16; }
__device__ __forceinline__ unsigned pk2(float lo, float hi) { return f2bf(lo) | (f2bf(hi) << 16); }
__device__ __forceinline__ unsigned cvt_pk_bf16(float lo, float hi) { unsigned r; asm volatile("v_cvt_pk_bf16_f32 %0, %1, %2" : "=v"(r) : "v"(lo), "v"(hi)); return r; }
__device__ __forceinline__ float bf2f(unsigned short b) { return __builtin_bit_cast(float, ((unsigned)b) << 16); }
__device__ __forceinline__ float lx_(float v, int src) { return __builtin_bit_cast(float, __builtin_amdgcn_ds_bpermute(src << 2, __builtin_bit_cast(int, v))); }
__device__ __forceinline__ unsigned lx_(unsigned v, int src) { return (unsigned)__builtin_amdgcn_ds_bpermute(src << 2, (int)v); }
#define SHX(v, o) lx_((v), lane ^ (o))
#define SHUP(v, o) lx_((v), lane >= (o) ? lane - (o) : lane)
#define SHL(v, src) lx_((v), (src))
__device__ __forceinline__ float wave_sum(float v, int lane) {
#pragma unroll
    for (int o = 1; o < 64; o <<= 1) v += SHX(v, o);
    return v;
}
__device__ __forceinline__ float fast_exp(float x) { return __builtin_amdgcn_exp2f(x * 1.4426950408889634f); }
__device__ __forceinline__ unsigned pk4_fp8(float a, float b, float c, float d) {
    a = __builtin_amdgcn_fmed3f(a, -448.f, 448.f); b = __builtin_amdgcn_fmed3f(b, -448.f, 448.f); c = __builtin_amdgcn_fmed3f(c, -448.f, 448.f); d = __builtin_amdgcn_fmed3f(d, -448.f, 448.f);
    int p = __builtin_amdgcn_cvt_pk_fp8_f32(a, b, 0, false); p = __builtin_amdgcn_cvt_pk_fp8_f32(c, d, p, true); return (unsigned)p; }
constexpr float F8_SA = 16.f, F8_SB = 256.f, F8_INV = 1.f / (16.f * 256.f);
constexpr float F8_SACT = 8.f, F8_SBD = 1024.f, F8_INVD = 1.f / (8.f * 1024.f);
#define LDS_WAIT() asm volatile("s_waitcnt lgkmcnt(0)" ::: "memory")
#define VM_WAIT() asm volatile("s_waitcnt vmcnt(0)" ::: "memory")

#define XB_TMO      128
#define XB_XCNT(j)  (256  + 64 * (j))
#define XB_XSUB(j)  (1280 + 64 * (j))
#define XB_XGEN(j)  (2304 + 64 * (j))
#define XB_TOP      3328
#define XB_TOPGEN   3392
#define XCD_BAR_WORDS 3456
#define XB_SPIN_CAP (1u << 18)
__device__ __forceinline__ unsigned xb_ld(unsigned* p)              { return __hip_atomic_load(p, __ATOMIC_RELAXED, __HIP_MEMORY_SCOPE_AGENT); }
__device__ __forceinline__ unsigned xb_add(unsigned* p, unsigned v) { return __hip_atomic_fetch_add(p, v, __ATOMIC_RELAXED, __HIP_MEMORY_SCOPE_AGENT); }
__device__ __forceinline__ unsigned xb_xcc_id() { return (unsigned)__builtin_amdgcn_s_getreg((3 << 11) | 20) & 0xFu; }
#define XB_SPIN(cond, bar) do { unsigned _sp = 0; while (cond) { __builtin_amdgcn_s_sleep(1); \
    if ((++_sp & 255u) == 0u) { if (xb_ld(&(bar)[XB_TMO])) break; if (_sp > XB_SPIN_CAP) { atomicAdd(&(bar)[XB_TMO], 1u); break; } } } } while (0)
struct XcdBarrier { unsigned* bar; unsigned x; volatile LAS unsigned* st; };
__device__ __forceinline__ XcdBarrier xcd_barrier_post(unsigned* bar, volatile LAS unsigned* st) {
    XcdBarrier b; b.bar = bar; b.x = xb_xcc_id(); b.st = st;
    if (threadIdx.x == 0) (void)xb_add(&bar[XB_XCNT(b.x)], 1u);
    return b;
}
__device__ __forceinline__ void xcd_barrier_complete(unsigned* bar, unsigned x, unsigned& nloc, unsigned& nx) {
    const unsigned G = gridDim.x * gridDim.y * gridDim.z;
    unsigned sum, cnt, mine, sp = 0u;
    for (;;) {
        sum = 0u; cnt = 0u; mine = 0u;
#pragma unroll
        for (unsigned j = 0; j < 16; ++j) { const unsigned c = xb_ld(&bar[XB_XCNT(j)]); sum += c; cnt += (c > 0u) ? 1u : 0u; mine = (j == x) ? c : mine; }
        if (sum == G) break;
        __builtin_amdgcn_s_sleep(1);
        if ((++sp & 255u) == 0u) { if (xb_ld(&bar[XB_TMO])) break; if (sp > XB_SPIN_CAP) { atomicAdd(&bar[XB_TMO], 1u); break; } }
    }
    nloc = mine > 0u ? mine : 1u; nx = cnt > 0u ? cnt : 1u;
}
__device__ __forceinline__ void xcd_barrier(const XcdBarrier& b, bool leader  ) {
    asm volatile("s_waitcnt vmcnt(0)" ::: "memory");
    __syncthreads();
    if (leader) {
        unsigned* bar = b.bar;
        __builtin_amdgcn_s_waitcnt(0);
        unsigned nloc = b.st[0], nx = b.st[1];
        if (nloc == 0u) { xcd_barrier_complete(bar, b.x, nloc, nx); b.st[0] = nloc; b.st[1] = nx; }
        const unsigned old = xb_add(&bar[XB_XSUB(b.x)], 1u);
        const unsigned gen = old / nloc;
        if (old + 1u == (gen + 1u) * nloc) {
            __builtin_amdgcn_fence(__ATOMIC_RELEASE, "agent");
            asm volatile("s_waitcnt vmcnt(0)" ::: "memory");
            const unsigned og = xb_add(&bar[XB_TOP], 1u);
            const unsigned tg = og / nx;
            if (og + 1u == (tg + 1u) * nx) xb_add(&bar[XB_TOPGEN], 1u);
            else XB_SPIN(xb_ld(&bar[XB_TOPGEN]) == tg, bar);
            __builtin_amdgcn_fence(__ATOMIC_ACQUIRE, "agent");
            xb_add(&bar[XB_XGEN(b.x)], 1u);
            asm volatile("s_waitcnt vmcnt(0)" ::: "memory");
        } else {
            XB_SPIN(xb_ld(&bar[XB_XGEN(b.x)]) == gen, bar);
            __builtin_amdgcn_fence(__ATOMIC_ACQUIRE, "agent");
            asm volatile("s_waitcnt vmcnt(0)" ::: "memory");
        }
    }
    __syncthreads();
}

namespace pg8 {
constexpr int BM = 256, BK = 64, HALF = 128, HTB = HALF * BK * 2, STAGE_BYTES = 8 * HTB, NXCD = 8, WGM = 8;
__host__ __device__ __forceinline__ int lds_byte(int r, int c) { const int st = (r >> 4) * 2 + (c >> 5), rr = r & 15, cc = c & 31, ob = rr * 64 + cc * 2; return st * 1024 + (ob ^ (((ob >> 9) & 1) << 5)); }
__host__ __device__ __forceinline__ void stage_rc(int b, int& R, int& C) { const int st = b / 1024, sb = b % 1024, swz = sb ^ (((sb >> 9) & 1) << 5); R = (st >> 1) * 16 + swz / 64; C = (st & 1) * 32 + (swz % 64) / 2; }
__host__ __device__ __forceinline__ int perm32(int rho) { const int n = rho >> 4, i = rho & 15; return 8 * (i >> 2) + 4 * n + (i & 3); }

struct Unit { int pm, pn, brow; };

struct DenseOrder {
    int nM, nN, nwg, G, c;
    __device__ void init(int nM_, int nN_, int G_, int c_) { nM = nM_; nN = nN_; nwg = nM * nN; G = G_; c = c_; }
    __device__ __forceinline__ bool next(int i, Unit& u) const {
        const long L = (long)i * G + c; if (L >= nwg) return false;
        int wgid = (int)L; { const int q = nwg / NXCD, r = nwg % NXCD, xcd = wgid % NXCD, off = wgid / NXCD; wgid = (xcd < r ? xcd * (q + 1) : r * (q + 1) + (xcd - r) * q) + off; }
        const int nig = WGM * nN, gid = wgid / nig, fm = gid * WGM, gsz = (nM - fm) < WGM ? (nM - fm) : WGM;
        u.pm = fm + ((wgid % nig) % gsz); u.pn = (wgid % nig) / gsz; u.brow = u.pn * BM; return true;
    }
    __device__ __forceinline__ int a_row(const Unit& u, int r) const { return u.pm * BM + r; }
};
struct GroupedOrder {
    DenseOrder o; int pstart[9]; int nexp_rows;
    const int* rowtok;
    __device__ __forceinline__ bool next(int i, Unit& u) const {
        if (!o.next(i, u)) return false;
        int e = 0;
#pragma unroll
        for (int k = 1; k < 8; ++k) e += (u.pm >= pstart[k]) ? 1 : 0;
        u.brow = e * nexp_rows + u.pn * BM; return true;
    }
    __device__ __forceinline__ int a_row(const Unit& u, int r) const {
        const int pos = u.pm * BM + r; if (!rowtok) return pos;
        const int t = rowtok[pos]; return t < 0 ? 0 : t;
    }
};

template <class Epi, class Sched, bool FP8 = false>
__device__ __forceinline__ void gemm_phase(LAS unsigned char* lds, const void* Abase, const void* Btbase, const int K, const Sched& S, const Epi& E, int tid) {
    constexpr int ES = FP8 ? 1 : 2;
    asm volatile("; opaque tid" : "+v"(tid));
    const int wid = __builtin_amdgcn_readfirstlane(tid >> 6), lane = tid & 63, wr = wid >> 2, wc = wid & 3, fr = lane & 15, fq = lane >> 4;
    const int nt = K * ES / 128;
    unsigned voffB[2];
#pragma unroll
    for (int i = 0; i < 2; ++i) { int R, C; stage_rc(tid * 16 + i * 8192, R, C); const int Rb = Epi::PERM ? ((R & ~31) + perm32(R & 31)) : R; voffB[i] = (unsigned)(Rb * K * ES + C * 2); }
    const size_t kstep = (size_t)128;
    const size_t hstep = (size_t)HALF * K * ES;
    const unsigned ldsw = (unsigned)wid * 1024u;
    const int aoff = FP8 ? lds_byte(wr * 64 + fr, 16 * (fq & 1)) + (fq >> 1) * 1024 : lds_byte(wr * 64 + fr, fq * 8);
    const int boff = FP8 ? lds_byte(wc * 32 + fr, 16 * (fq & 1)) + (fq >> 1) * 1024 : lds_byte(wc * 32 + fr, fq * 8);
#define PG8_SA(b, h) (((b) * 2 + (h)) * HTB)
#define PG8_SB(b, h) ((4 + (b) * 2 + (h)) * HTB)
#define PG8_STAGE(bufoff, gbase, voff) do { const char* _gb = (const char*)(gbase); asm volatile("" : "+s"(_gb)); _Pragma("unroll") for (int _i = 0; _i < 2; ++_i) \
        __builtin_amdgcn_global_load_lds((const unsigned*)(_gb + (voff)[_i]), (LAS unsigned*)(lds + (bufoff) + ldsw + _i * 8192), 16, 0, 0); } while (0)
#define PG8_LDA(dst, b, h) do { _Pragma("unroll") for (int m = 0; m < 4; ++m) _Pragma("unroll") for (int k = 0; k < 2; ++k) dst[m][k] = *(const LAS bf16x8*)(lds + PG8_SA(b, h) + aoff + m * 2048 + k * (FP8 ? 16 : 1024)); } while (0)
#define PG8_LDB(dst, b, h) do { _Pragma("unroll") for (int n = 0; n < 2; ++n) _Pragma("unroll") for (int k = 0; k < 2; ++k) dst[n][k] = *(const LAS bf16x8*)(lds + PG8_SB(b, h) + boff + n * 2048 + k * (FP8 ? 16 : 1024)); } while (0)
#define PG8_MMA(ai, bj, At, Bt) do { __builtin_amdgcn_s_setprio(1); _Pragma("unroll") for (int m = 0; m < 4; ++m) _Pragma("unroll") for (int n = 0; n < 2; ++n) { \
        if constexpr (FP8) { const u32x4 _b0 = __builtin_bit_cast(u32x4, Bt[n][0]), _b1 = __builtin_bit_cast(u32x4, Bt[n][1]), _a0 = __builtin_bit_cast(u32x4, At[m][0]), _a1 = __builtin_bit_cast(u32x4, At[m][1]); \
            const i32x8 _bv = {(int)_b0.x, (int)_b0.y, (int)_b0.z, (int)_b0.w, (int)_b1.x, (int)_b1.y, (int)_b1.z, (int)_b1.w}, _av = {(int)_a0.x, (int)_a0.y, (int)_a0.z, (int)_a0.w, (int)_a1.x, (int)_a1.y, (int)_a1.z, (int)_a1.w}; \
            acc[ai][bj][m][n] = __builtin_amdgcn_mfma_scale_f32_16x16x128_f8f6f4(_bv, _av, acc[ai][bj][m][n], 0, 0, 0, 0x7F7F7F7F, 0, 0x7F7F7F7F); } \
        else { _Pragma("unroll") for (int k = 0; k < 2; ++k) acc[ai][bj][m][n] = __builtin_amdgcn_mfma_f32_16x16x32_bf16(Bt[n][k], At[m][k], acc[ai][bj][m][n], 0, 0, 0); } } \
        __builtin_amdgcn_s_setprio(0); } while (0)
#define PG8_WAIT_V(n) asm volatile("s_waitcnt vmcnt(" #n ")" ::: "memory")
#define PG8_WAIT_L(n) asm volatile("s_waitcnt lgkmcnt(" #n ")" ::: "memory")
#define PG8_BAR __builtin_amdgcn_s_barrier()
#define PG8_SCHED __builtin_amdgcn_sched_barrier(0)
#define PG8_AOFF(dst, u) do { _Pragma("unroll") for (int _i = 0; _i < 2; ++_i) { int _R, _C; stage_rc(tid * 16 + _i * 8192, _R, _C); _Pragma("unroll") for (int _h = 0; _h < 2; ++_h) \
        dst[_h][_i] = (unsigned)((size_t)S.a_row(u, _h * HALF + _R) * K * ES + _C * 2); } } while (0)
    Unit cur, nxt; int ui = 0;
    if (!S.next(0, cur)) return;
    f32x4 acc[2][2][4][2];
#pragma unroll
    for (int a = 0; a < 2; ++a)
#pragma unroll
        for (int b = 0; b < 2; ++b)
#pragma unroll
            for (int m = 0; m < 4; ++m)
#pragma unroll
                for (int n = 0; n < 2; ++n) acc[a][b][m][n] = (f32x4){0.f, 0.f, 0.f, 0.f};
    bf16x8 At[4][2], B0[2][2], B1[2][2];
    unsigned cao[2][2];
    PG8_AOFF(cao, cur);
    const char* cA = (const char*)Abase; const char* cB = (const char*)Btbase + (size_t)cur.brow * K * ES;
    PG8_STAGE(PG8_SB(0, 0), cB, voffB); PG8_STAGE(PG8_SB(0, 1), cB + hstep, voffB); PG8_STAGE(PG8_SA(0, 0), cA, cao[0]); PG8_STAGE(PG8_SA(0, 1), cA, cao[1]);
    if (wr == 1) PG8_BAR;
    PG8_WAIT_V(2); PG8_BAR;
    PG8_STAGE(PG8_SB(1, 0), cB + kstep, voffB); PG8_STAGE(PG8_SA(1, 0), cA + kstep, cao[0]); PG8_STAGE(PG8_SB(1, 1), cB + hstep + kstep, voffB);
    PG8_WAIT_V(6); PG8_BAR;
    for (;;) {
        const bool has_next = S.next(ui + 1, nxt);
        const char* nB = has_next ? (const char*)Btbase + (size_t)nxt.brow * K * ES : cB;
        for (int t = 0; t < nt; t += 2) {
            const bool last = (t == nt - 2);
            const char* a1 = cA + (size_t)(t + 1) * kstep;
            const char* a2 = last ? cA : cA + (size_t)(t + 2) * kstep; const char* b2 = last ? nB : cB + (size_t)(t + 2) * kstep;
            const char* a3 = a2 + kstep; const char* b3 = b2 + kstep;
            PG8_LDB(B0, 0, 0); PG8_LDB(B1, 0, 1); PG8_SCHED; PG8_LDA(At, 0, 0); PG8_STAGE(PG8_SA(1, 1), a1, cao[1]);
            if (last && has_next) { PG8_AOFF(cao, nxt); }
            PG8_WAIT_V(8); PG8_WAIT_L(0); PG8_BAR; PG8_MMA(0, 0, At, B0); PG8_MMA(0, 1, At, B1); PG8_BAR; PG8_SCHED;
            PG8_LDA(At, 0, 1); PG8_STAGE(PG8_SB(0, 0), b2, voffB); PG8_STAGE(PG8_SB(0, 1), b2 + hstep, voffB); PG8_STAGE(PG8_SA(0, 0), a2, cao[0]);
            PG8_WAIT_V(8); PG8_WAIT_L(0); PG8_BAR; PG8_MMA(1, 0, At, B0); PG8_MMA(1, 1, At, B1); PG8_BAR; PG8_SCHED;
            PG8_LDB(B0, 1, 0); PG8_LDB(B1, 1, 1); PG8_SCHED; PG8_LDA(At, 1, 0); PG8_STAGE(PG8_SA(0, 1), a2, cao[1]);
            PG8_WAIT_V(8); PG8_WAIT_L(0); PG8_BAR; PG8_MMA(0, 0, At, B0); PG8_MMA(0, 1, At, B1); PG8_BAR; PG8_SCHED;
            PG8_LDA(At, 1, 1); PG8_STAGE(PG8_SB(1, 0), b3, voffB); PG8_STAGE(PG8_SB(1, 1), b3 + hstep, voffB); PG8_STAGE(PG8_SA(1, 0), a3, cao[0]);
            PG8_WAIT_V(8); PG8_WAIT_L(0); PG8_BAR; PG8_MMA(1, 0, At, B0); PG8_MMA(1, 1, At, B1); PG8_BAR; PG8_SCHED;
        }
        if (wr == 0) PG8_BAR;
#pragma unroll 1
        for (int er = 0; er < Epi::NREP; ++er) E(acc, cur, wr, wc, fr, fq);
        if (!has_next) break;
#pragma unroll
        for (int a = 0; a < 2; ++a)
#pragma unroll
            for (int b = 0; b < 2; ++b)
#pragma unroll
                for (int m = 0; m < 4; ++m)
#pragma unroll
                    for (int n = 0; n < 2; ++n) acc[a][b][m][n] = (f32x4){0.f, 0.f, 0.f, 0.f};
        cur = nxt; cB = nB; ++ui;
        if (wr == 1) PG8_BAR;
    }
    PG8_WAIT_V(0);
    PG8_BAR;
#undef PG8_SA
#undef PG8_SB
#undef PG8_STAGE
#undef PG8_LDA
#undef PG8_LDB
#undef PG8_MMA
#undef PG8_WAIT_V
#undef PG8_WAIT_L
#undef PG8_BAR
#undef PG8_SCHED
#undef PG8_AOFF
}
}

typedef f32x4 AccT[2][2][4][2];

struct EpiProj {
    static constexpr int NREP = 1; static constexpr bool PERM = true;
    bf16_t* proj; float* gates; const float* bgate;
    __device__ __forceinline__ void operator()(const AccT& acc, const pg8::Unit& u, int wr, int wc, int fr, int fq) const {
        const int row0 = u.pm * 256 + wr * 64 + fr;
        if (u.pn < 12) {
            const int col0 = u.pn * 256 + wc * 32 + 8 * fq;
#pragma unroll
            for (int ai = 0; ai < 2; ++ai)
#pragma unroll
                for (int m = 0; m < 4; ++m) { bf16_t* rowp = proj + (size_t)(row0 + ai * 128 + m * 16) * PROJ_LD + col0;
#pragma unroll
                    for (int bj = 0; bj < 2; ++bj) { const f32x4 v0 = acc[ai][bj][m][0], v1 = acc[ai][bj][m][1];
                        u32x4 w; w.x = cvt_pk_bf16(v0[0], v0[1]); w.y = cvt_pk_bf16(v0[2], v0[3]); w.z = cvt_pk_bf16(v1[0], v1[1]); w.w = cvt_pk_bf16(v1[2], v1[3]);
                        *(u32x4*)(rowp + bj * 128) = w; } }
        } else if (wc == 0 && fq < 2) {
#pragma unroll
            for (int n = 0; n < 2; ++n) { const f32x4 bv = *(const f32x4*)(bgate + 8 * fq + 4 * n);
#pragma unroll
                for (int ai = 0; ai < 2; ++ai)
#pragma unroll
                    for (int m = 0; m < 4; ++m) *(f32x4*)(gates + (size_t)(row0 + ai * 128 + m * 16) * 16 + 8 * fq + 4 * n) = acc[ai][0][m][n] + bv; }
        }
    }
};
__device__ __forceinline__ f32x4 bf4_lo(u32x4 w) { return (f32x4){__builtin_bit_cast(float, w.x << 16), __builtin_bit_cast(float, w.x & 0xffff0000u), __builtin_bit_cast(float, w.y << 16), __builtin_bit_cast(float, w.y & 0xffff0000u)}; }
__device__ __forceinline__ f32x4 bf4_hi(u32x4 w) { return (f32x4){__builtin_bit_cast(float, w.z << 16), __builtin_bit_cast(float, w.z & 0xffff0000u), __builtin_bit_cast(float, w.w << 16), __builtin_bit_cast(float, w.w & 0xffff0000u)}; }
struct EpiRes {
    static constexpr int NREP = 1; static constexpr bool PERM = true;
    bf16_t* H; const float* stats; const float* lg; const float* lb; const float* xsrc; float sc;
    __device__ __forceinline__ void operator()(const AccT& acc, const pg8::Unit& u, int wr, int wc, int fr, int fq) const {
        const int row0 = u.pm * 256 + wr * 64 + fr, col0 = u.pn * 256 + wc * 32 + 8 * fq;
        f32x4 gv[2][2], bv[2][2];
        if (lg) {
#pragma unroll
            for (int bj = 0; bj < 2; ++bj)
#pragma unroll
                for (int n = 0; n < 2; ++n) { gv[bj][n] = *(const f32x4*)(lg + col0 + bj * 128 + n * 4); bv[bj][n] = *(const f32x4*)(lb + col0 + bj * 128 + n * 4); } }
#pragma unroll
        for (int ai = 0; ai < 2; ++ai)
#pragma unroll
            for (int m = 0; m < 4; ++m) { const int row = row0 + ai * 128 + m * 16; bf16_t* rowp = H + (size_t)row * D + col0;
                f32x2 st = (f32x2){0.f, 1.f}; if (lg) st = *(const f32x2*)(stats + 2 * (size_t)row);
#pragma unroll
                for (int bj = 0; bj < 2; ++bj) { f32x4 h0, h1;
                    if (lg) { const u32x4 w = *(const u32x4*)(rowp + bj * 128); h0 = (bf4_lo(w) - st.x) * st.y * gv[bj][0] + bv[bj][0]; h1 = (bf4_hi(w) - st.x) * st.y * gv[bj][1] + bv[bj][1]; }
                    else { const float* xp = xsrc + (size_t)row * D + col0 + bj * 128; h0 = *(const f32x4*)xp; h1 = *(const f32x4*)(xp + 4); }
                    const f32x4 o0 = h0 * ALPHA + acc[ai][bj][m][0] * sc, o1 = h1 * ALPHA + acc[ai][bj][m][1] * sc;
                    u32x4 w; w.x = cvt_pk_bf16(o0[0], o0[1]); w.y = cvt_pk_bf16(o0[2], o0[3]); w.z = cvt_pk_bf16(o1[0], o1[1]); w.w = cvt_pk_bf16(o1[2], o1[3]);
                    *(u32x4*)(rowp + bj * 128) = w; } }
    }
};
struct EpiSwiglu {
    static constexpr int NREP = 1; static constexpr bool PERM = true;
    bf16_t* act; int ld; float sc;
    __device__ __forceinline__ static float silu_mul(float g, float u) { return g * u * __builtin_amdgcn_rcpf(1.0f + __builtin_amdgcn_exp2f(-g * 1.4426950408889634f)); }
    __device__ __forceinline__ void operator()(const AccT& acc, const pg8::Unit& u, int wr, int wc, int fr, int fq) const {
        const int row0 = u.pm * 256 + wr * 64 + fr, col0 = u.pn * 128 + wc * 32 + 8 * fq;
#pragma unroll
        for (int ai = 0; ai < 2; ++ai)
#pragma unroll
            for (int m = 0; m < 4; ++m) { const f32x4 g0 = acc[ai][0][m][0] * sc, g1 = acc[ai][0][m][1] * sc, u0 = acc[ai][1][m][0] * sc, u1 = acc[ai][1][m][1] * sc;
                u32x4 w; w.x = cvt_pk_bf16(silu_mul(g0[0], u0[0]), silu_mul(g0[1], u0[1])); w.y = cvt_pk_bf16(silu_mul(g0[2], u0[2]), silu_mul(g0[3], u0[3]));
                w.z = cvt_pk_bf16(silu_mul(g1[0], u1[0]), silu_mul(g1[1], u1[1])); w.w = cvt_pk_bf16(silu_mul(g1[2], u1[2]), silu_mul(g1[3], u1[3]));
                *(u32x4*)(act + (size_t)(row0 + ai * 128 + m * 16) * ld + col0) = w; }
    }
};
struct EpiSwiglu8 {
    static constexpr int NREP = 1; static constexpr bool PERM = true;
    unsigned char* act; int ld; float sc;
    __device__ __forceinline__ void operator()(const AccT& acc, const pg8::Unit& u, int wr, int wc, int fr, int fq) const {
        const int row0 = u.pm * 256 + wr * 64 + fr, col0 = u.pn * 128 + wc * 32 + 8 * fq;
#pragma unroll
        for (int ai = 0; ai < 2; ++ai)
#pragma unroll
            for (int m = 0; m < 4; ++m) { const f32x4 g0 = acc[ai][0][m][0] * sc, g1 = acc[ai][0][m][1] * sc, u0 = acc[ai][1][m][0] * sc, u1 = acc[ai][1][m][1] * sc;
                u32x2 w; w.x = pk4_fp8(EpiSwiglu::silu_mul(g0[0], u0[0]) * F8_SACT, EpiSwiglu::silu_mul(g0[1], u0[1]) * F8_SACT, EpiSwiglu::silu_mul(g0[2], u0[2]) * F8_SACT, EpiSwiglu::silu_mul(g0[3], u0[3]) * F8_SACT);
                w.y = pk4_fp8(EpiSwiglu::silu_mul(g1[0], u1[0]) * F8_SACT, EpiSwiglu::silu_mul(g1[1], u1[1]) * F8_SACT, EpiSwiglu::silu_mul(g1[2], u1[2]) * F8_SACT, EpiSwiglu::silu_mul(g1[3], u1[3]) * F8_SACT);
                *(u32x2*)(act + (size_t)(row0 + ai * 128 + m * 16) * ld + col0) = w; }
    }
};
struct EpiSwigluProbe : EpiSwiglu { static constexpr int NREP = 2; };
struct EpiScatter {
    static constexpr int NREP = 1; static constexpr bool PERM = true;
    bf16_t* contrib; const int* rowdst; const float* rowgate; float sc;
    __device__ __forceinline__ void operator()(const AccT& acc, const pg8::Unit& u, int wr, int wc, int fr, int fq) const {
        const int row0 = u.pm * 256 + wr * 64 + fr, col0 = u.pn * 256 + wc * 32 + 8 * fq;
#pragma unroll
        for (int ai = 0; ai < 2; ++ai)
#pragma unroll
            for (int m = 0; m < 4; ++m) { const int pos = row0 + ai * 128 + m * 16; const int d = rowdst[pos];
                if (d >= 0) { const float g = rowgate[pos] * sc; bf16_t* rowp = contrib + (size_t)d * D + col0;
#pragma unroll
                    for (int bj = 0; bj < 2; ++bj) { const f32x4 v0 = acc[ai][bj][m][0] * g, v1 = acc[ai][bj][m][1] * g;
                        u32x4 w; w.x = cvt_pk_bf16(v0[0], v0[1]); w.y = cvt_pk_bf16(v0[2], v0[3]); w.z = cvt_pk_bf16(v1[0], v1[1]); w.w = cvt_pk_bf16(v1[2], v1[3]);
                        *(u32x4*)(rowp + bj * 128) = w; } } }
    }
};
struct EpiQKV {
    static constexpr int NREP = 1; static constexpr bool PERM = true;
    bf16_t *Q, *KB, *VB; const float* rope;
    __device__ __forceinline__ void operator()(const AccT& acc, const pg8::Unit& u, int wr, int wc, int fr, int fq) const {
        const int row0 = u.pm * 256 + wr * 64 + fr, cl = wc * 32 + 8 * fq, lane = fr | (fq << 4);
        bf16_t* base; int ld;
        if (u.pn == 5) {
#pragma unroll
            for (int ai = 0; ai < 2; ++ai)
#pragma unroll
                for (int m = 0; m < 4; ++m) { const int row = row0 + ai * 128 + m * 16;
#pragma unroll
                    for (int bj = 0; bj < 2; ++bj)
#pragma unroll
                        for (int n = 0; n < 2; ++n)
#pragma unroll
                            for (int j = 0; j < 4; ++j) VB[(size_t)(bj * 128 + cl + 4 * n + j) * MP + row] = (bf16_t)f2bf(acc[ai][bj][m][n][j]); }
            return; }
        if (u.pn < 4) { base = Q + u.pn * 256 + cl; ld = D; } else { base = KB + cl; ld = 256; }
        const bool dorope = (u.pn <= 4) && ((wc & 1) == 0);
#pragma unroll
        for (int ai = 0; ai < 2; ++ai)
#pragma unroll
            for (int m = 0; m < 4; ++m) { const int row = row0 + ai * 128 + m * 16;
                f32x4 v[2][2];
#pragma unroll
                for (int bj = 0; bj < 2; ++bj)
#pragma unroll
                    for (int n = 0; n < 2; ++n) v[bj][n] = acc[ai][bj][m][n];
                if (dorope) {
                    int pos = row < MREAL ? (row & (SEQ - 1)) + NMETA : row - MREAL; pos = pos > SEQ + NMETA - 1 ? SEQ + NMETA - 1 : pos;
                    const float* rp = rope + (size_t)pos * 16;
                    const f32x4 c0 = *(const f32x4*)rp, c1 = *(const f32x4*)(rp + 4), s0 = *(const f32x4*)(rp + 8), s1 = *(const f32x4*)(rp + 12);
#pragma unroll
                    for (int bj = 0; bj < 2; ++bj)
#pragma unroll
                        for (int n = 0; n < 2; ++n) { const f32x4 c = n ? c1 : c0, s = n ? s1 : s0; f32x4 o;
#pragma unroll
                            for (int j = 0; j < 4; ++j) { const float x = v[bj][n][j]; const float y = SHX(x, 16);
                                o[j] = fq == 0 ? x * c[j] - y * s[j] : (fq == 1 ? x * c[j] + y * s[j] : x); }
                            v[bj][n] = o; }
                }
#pragma unroll
                for (int bj = 0; bj < 2; ++bj) { const f32x4 v0 = v[bj][0], v1 = v[bj][1];
                    u32x4 w; w.x = cvt_pk_bf16(v0[0], v0[1]); w.y = cvt_pk_bf16(v0[2], v0[3]); w.z = cvt_pk_bf16(v1[0], v1[1]); w.w = cvt_pk_bf16(v1[2], v1[3]);
                    *(u32x4*)(base + (size_t)row * ld + bj * 128) = w; } }
    }
};

template <int NACC, class F>
__device__ __forceinline__ void skinny_item(const bf16_t* A, int lda, const bf16_t* (&Bt)[NACC], int K, int wave, int lane, LAS unsigned char* lds, int parity, const F& epi) {
    const int fr = lane & 15, quad = lane >> 4, kw = K >> 3;
    const bf16_t* ap = A + (size_t)fr * lda + wave * kw + 8 * quad;
    f32x4 acc[NACC];
#pragma unroll
    for (int i = 0; i < NACC; ++i) acc[i] = (f32x4){0.f, 0.f, 0.f, 0.f};
#pragma unroll 2
    for (int k = 0; k < kw; k += 32) { const bf16x8 a = *(const bf16x8*)(ap + k);
#pragma unroll
        for (int i = 0; i < NACC; ++i) acc[i] = __builtin_amdgcn_mfma_f32_16x16x32_bf16(a, *(const bf16x8*)(Bt[i] + (size_t)fr * K + wave * kw + 8 * quad + k), acc[i], 0, 0, 0); }
    LAS f32x4* red = (LAS f32x4*)(lds + parity * 16384);
#pragma unroll
    for (int i = 0; i < NACC; ++i) red[(wave * NACC + i) * 64 + lane] = acc[i];
    __syncthreads();
    if (wave == 0) {
#pragma unroll
        for (int i = 0; i < NACC; ++i) { f32x4 t = red[i * 64 + lane];
#pragma unroll
            for (int w = 1; w < 8; ++w) t += red[(w * NACC + i) * 64 + lane];
            acc[i] = t; }
        epi(acc, fr, quad);
    }
}

template <int NACC, class F>
__device__ __forceinline__ void skinny_item8(const unsigned char* A, int lda, const unsigned char* (&Bt)[NACC], int K, int wave, int lane, LAS unsigned char* lds, int parity, const F& epi) {
    const int fr = lane & 15, quad = lane >> 4, nblk = K >> 7, b0 = (wave * nblk) >> 3, b1 = ((wave + 1) * nblk) >> 3;
    f32x4 acc[NACC];
#pragma unroll
    for (int i = 0; i < NACC; ++i) acc[i] = (f32x4){0.f, 0.f, 0.f, 0.f};
    for (int kb = b0; kb < b1; ++kb) { const u32x4* ap = (const u32x4*)(A + (size_t)fr * lda + kb * 128 + 32 * quad); const u32x4 a0 = ap[0], a1 = ap[1];
        const i32x8 av = {(int)a0.x, (int)a0.y, (int)a0.z, (int)a0.w, (int)a1.x, (int)a1.y, (int)a1.z, (int)a1.w};
#pragma unroll
        for (int i = 0; i < NACC; ++i) { const u32x4* bp = (const u32x4*)(Bt[i] + (size_t)fr * K + kb * 128 + 32 * quad); const u32x4 q0 = bp[0], q1 = bp[1];
            const i32x8 bv = {(int)q0.x, (int)q0.y, (int)q0.z, (int)q0.w, (int)q1.x, (int)q1.y, (int)q1.z, (int)q1.w};
            acc[i] = __builtin_amdgcn_mfma_scale_f32_16x16x128_f8f6f4(av, bv, acc[i], 0, 0, 0, 0x7F7F7F7F, 0, 0x7F7F7F7F); } }
    LAS f32x4* red = (LAS f32x4*)(lds + parity * 16384);
#pragma unroll
    for (int i = 0; i < NACC; ++i) red[(wave * NACC + i) * 64 + lane] = acc[i];
    __syncthreads();
    if (wave == 0) {
#pragma unroll
        for (int i = 0; i < NACC; ++i) { f32x4 t = red[i * 64 + lane];
#pragma unroll
            for (int w = 1; w < 8; ++w) t += red[(w * NACC + i) * 64 + lane];
            acc[i] = t; }
        epi(acc, fr, quad);
    }
}

struct Params { const float* in[18]; float* out; unsigned char* ws; int ph_lo, ph_hi, li, pad; };
enum { I_X = 0, I_META, I_WIN, I_BGATE, I_LNH, I_WOUT, I_WKV, I_WQ, I_SINKS, I_WO, I_WGUD, I_WDND, I_WROUTER, I_BROUTER, I_WGUE, I_WDNE, I_LNG, I_LNB };
constexpr int NWAVES = 8, NTHREADS = 512;

template <bool F8 = false>
__device__ __forceinline__ void tr_item(const float* W, int Nsrc, int K, void* WTv, int k0, int n0, int drow0, float scale, int nvalid, LAS float* scr, int lane) {
    bf16_t* WT = (bf16_t*)WTv;
    float ld[32];
#pragma unroll
    for (int i = 0; i < 32; ++i) { const int kk = 2 * i + (lane >> 5), n = lane & 31; ld[i] = (n < nvalid) ? W[(size_t)(k0 + kk) * Nsrc + n0 + n] : 0.f; }
#pragma unroll
    for (int i = 0; i < 32; ++i) { const int kk = 2 * i + (lane >> 5), n = lane & 31; scr[kk * 33 + n] = ld[i] * scale; }
    LDS_WAIT(); asm volatile("" ::: "memory");
    const int c = lane & 7;
#pragma unroll
    for (int j = 0; j < 4; ++j) { const int n = (lane >> 3) + 8 * j; const LAS float* s = scr + (8 * c) * 33 + n;
        if constexpr (F8) { u32x2 o; o.x = pk4_fp8(s[0 * 33], s[1 * 33], s[2 * 33], s[3 * 33]); o.y = pk4_fp8(s[4 * 33], s[5 * 33], s[6 * 33], s[7 * 33]);
            if (n < nvalid) *(u32x2*)((unsigned char*)WTv + (size_t)(drow0 + n) * K + k0 + 8 * c) = o; }
        else { u32x4 o; o.x = pk2(s[0 * 33], s[1 * 33]); o.y = pk2(s[2 * 33], s[3 * 33]); o.z = pk2(s[4 * 33], s[5 * 33]); o.w = pk2(s[6 * 33], s[7 * 33]);
            if (n < nvalid) *(u32x4*)(WT + (size_t)(drow0 + n) * K + k0 + 8 * c) = o; } }
    LDS_WAIT(); asm volatile("" ::: "memory");
}
__device__ __forceinline__ int pair_row(int n, int FF) { const int up = n >= FF ? 1 : 0, j = n - up * FF; return 256 * (j >> 7) + 128 * up + (j & 127); }

__device__ __forceinline__ void p0_prologue(const Params& P, LAS unsigned char* lds, int gw, int NGW, int wave, int lane) {
    unsigned char* ws = P.ws;
    LAS float* scr = (LAS float*)(lds + wave * 16384);
    constexpr int IT0 = 16 * 97, IT1 = 16 * 32, IT2 = 16 * 16, IT5 = 16 * 176, IT6 = 44 * 32, IT7 = 16 * 224, IT8 = 56 * 32;
    constexpr int C0 = 2 * IT0, C1 = C0 + 2 * IT1, C2 = C1 + IT2, C3 = C2 + 2 * IT1, C4 = C3 + 2 * IT1, C5 = C4 + 2 * IT5, C6 = C5 + 2 * IT6, C7 = C6 + 16 * IT7, C8 = C7 + 16 * IT8;
    for (int it = gw; it < C8; it += NGW) {
        if (it < C0) { const int mi = it / IT0, r = it % IT0, kb = r / 97, nb = r % 97; const int n0 = nb * 32;
            tr_item(P.in[I_WIN] + (size_t)mi * D * M_IN, M_IN, D, (bf16_t*)(ws + WS_WIN) + (size_t)mi * M_INP * D, kb * 64, n0, n0, n0 < 512 ? 0.125f : 1.f, nb == 96 ? 16 : 32, scr, lane);
        } else if (it < C1) { const int q = it - C0, mi = q / IT1, r = q % IT1, kb = r / 32, nb = r % 32;
            tr_item(P.in[I_WOUT] + (size_t)mi * D * D, D, D, (bf16_t*)(ws + WS_WOUT) + (size_t)mi * D * D, kb * 64, nb * 32, nb * 32, 1.f, 32, scr, lane);
        } else if (it < C2) { const int r = it - C1, kb = r / 16, nb = r % 16;
            tr_item(P.in[I_WKV], 512, D, (bf16_t*)(ws + WS_WQKV), kb * 64, nb * 32, 1024 + nb * 32, 1.f, 32, scr, lane);
        } else if (it < C3) { const int q = it - C2, mi = q / IT1, r = q % IT1, kb = r / 32, nb = r % 32;
            tr_item(P.in[I_WQ] + (size_t)mi * D * D, D, D, (bf16_t*)(ws + (mi ? WS_WQ3 : WS_WQKV)), kb * 64, nb * 32, nb * 32, 0.125f, 32, scr, lane);
        } else if (it < C4) { const int q = it - C3, mi = q / IT1, r = q % IT1, kb = r / 32, nb = r % 32;
            tr_item(P.in[I_WO] + (size_t)mi * D * D, D, D, (bf16_t*)(ws + WS_WO) + (size_t)mi * D * D, kb * 64, nb * 32, nb * 32, 1.f, 32, scr, lane);
        } else if (it < C5) { const int q = it - C4, mi = q / IT5, r = q % IT5, kb = r / 176, nb = r % 176;
            tr_item(P.in[I_WGUD] + (size_t)mi * D * 2 * D_FF, 2 * D_FF, D, (bf16_t*)(ws + WS_WGU) + (size_t)mi * 2 * D_FF * D, kb * 64, nb * 32, pair_row(nb * 32, D_FF), 1.f, 32, scr, lane);
        } else if (it < C6) { const int q = it - C5, mi = q / IT6, r = q % IT6, kb = r / 32, nb = r % 32;
            tr_item<true>(P.in[I_WDND] + (size_t)mi * D_FF * D, D, D_FF, (ws + WS_WDN8) + (size_t)mi * D * D_FF, kb * 64, nb * 32, nb * 32, F8_SBD, 32, scr, lane);
        } else if (it < C7) { const int q = it - C6, mi = q / IT7, r = q % IT7, kb = r / 224, nb = r % 224;
            tr_item<true>(P.in[I_WGUE] + (size_t)mi * D * 2 * D_FF_EXP, 2 * D_FF_EXP, D, (ws + WS_WGUE8) + (size_t)mi * 2 * D_FF_EXP * D, kb * 64, nb * 32, pair_row(nb * 32, D_FF_EXP), F8_SB, 32, scr, lane);
        } else { const int q = it - C7, mi = q / IT8, r = q % IT8, kb = r / 32, nb = r % 32;
            tr_item<true>(P.in[I_WDNE] + (size_t)mi * D_FF_EXP * D, D, D_FF_EXP, (ws + WS_WDNE8) + (size_t)mi * D * D_FF_EXP, kb * 64, nb * 32, nb * 32, F8_SBD, 32, scr, lane);
        }
    }
    { float* sm = (float*)(ws + WS_SMALL); const int gt = gw * 64 + lane, NT = NGW * 64;
      for (int i = gt; i < SM_END; i += NT) { float v = 0.f;
          if (i < SM_SINKS) v = P.in[I_BGATE][i]; else if (i < SM_BROUTER) v = P.in[I_SINKS][i - SM_SINKS]; else if (i < SM_BROUTER + 16) v = P.in[I_BROUTER][i - SM_BROUTER];
          else if (i < SM_LNH) v = 0.f; else if (i < SM_LNG) v = P.in[I_LNH][i - SM_LNH]; else if (i < SM_LNB) v = P.in[I_LNG][i - SM_LNG]; else if (i < SM_WROUTER) v = P.in[I_LNB][i - SM_LNB]; else v = P.in[I_WROUTER][i - SM_WROUTER];
          sm[i] = v; } }
    { bf16_t* HB = (bf16_t*)(ws + WS_HB);
      const size_t gt = (size_t)gw * 64 + lane, NT = (size_t)NGW * 64;
      for (size_t i = gt; i < (size_t)MV * (D / 4); i += NT) { const size_t row = i >> 8; const int c4 = (int)(i & 255);
          const f32x4 v = row < MREAL ? ((const f32x4*)P.in[I_X])[i] : ((const f32x4*)P.in[I_META])[(row - MREAL) * 256 + c4];
          u32x2 w; w.x = pk2(v[0], v[1]); w.y = pk2(v[2], v[3]); ((u32x2*)HB)[i] = w; }
      float* rope = (float*)(ws + WS_ROPE);
      for (size_t i = gt; i < (size_t)(SEQ + NMETA) * 8; i += NT) { const int pos = (int)(i >> 3), fi = (int)(i & 7);
          const double invf = fi == 0 ? 1.0 : fi == 1 ? 0.19392274474868576 : fi == 2 ? 0.03760603093086393 : fi == 3 ? 0.007292664737217109 : fi == 4 ? 0.001414213562373095
                            : fi == 5 ? 0.0002742481756762073 : fi == 6 ? 5.318295896944988e-05 : 1.031338537721246e-05;
          const float angf = (float)pos * (float)invf;
          double a = (double)angf; a -= 6.283185307179586476925 * __builtin_rint(a * 0.15915494309189533577); const double hx = 0.5 * a, h2 = hx * hx;
          double sp = 1.0, cp = 1.0;
#pragma unroll
          for (int k = 12; k >= 1; --k) { sp = 1.0 - sp * h2 / (double)((2 * k) * (2 * k + 1)); cp = 1.0 - cp * h2 / (double)((2 * k - 1) * (2 * k)); }
          const double sh = hx * sp, ch = cp;
          rope[(size_t)pos * 16 + fi] = (float)(1.0 - 2.0 * sh * sh); rope[(size_t)pos * 16 + 8 + fi] = (float)(2.0 * sh * ch); }
    }
}

__device__ __forceinline__ void ln_phase(unsigned char* ws, float* outp, LAS unsigned char* lds, int gw, int NGW, int lane, int tid,
                                         int lnidx, bool moe_src, bool router, int moe_idx, bool final, bool dry = false) {
    const float* sm = (const float*)(ws + WS_SMALL);
    unsigned char* wo = dry ? ws + WS_ACT : ws;
    const bf16_t* H = (const bf16_t*)(ws + WS_H); bf16_t* Hw = dry ? (bf16_t*)(ws + WS_ACT) : (bf16_t*)(ws + WS_H);
    bf16_t* HB = dry ? (bf16_t*)(ws + WS_ACT + 160 * MiB) : (bf16_t*)(ws + WS_HB); const bf16_t* contrib = (const bf16_t*)(ws + WS_CONTRIB);
    const float* stats = (const float*)(ws + WS_STATS); float* statsw = dry ? (float*)(ws + WS_ACT + 240 * MiB) : (float*)(ws + WS_STATS);
    unsigned char* HB8 = dry ? ws + WS_ACT + 250 * MiB : ws + WS_HB8; (void)wo;
    const float* lg = sm + SM_LNG + (size_t)lnidx * D; const float* lb = sm + SM_LNB + (size_t)lnidx * D;
    f32x4 gv[4], bv[4];
#pragma unroll
    for (int j = 0; j < 4; ++j) { gv[j] = *(const f32x4*)(lg + 256 * j + 4 * lane); bv[j] = *(const f32x4*)(lb + 256 * j + 4 * lane); }
    volatile LAS unsigned* misc = (volatile LAS unsigned*)(lds + MISC_OFF);
    f32x4 wra[4][4], wrb[4][4];
    if (router) {
        const float* src = sm + SM_WROUTER + (size_t)moe_idx * D * N_EXP;
#pragma unroll
        for (int j = 0; j < 4; ++j)
#pragma unroll
            for (int c = 0; c < 4; ++c) { const f32x4* w4 = (const f32x4*)(src + (size_t)(256 * j + 4 * lane + c) * 8); wra[j][c] = w4[0]; wrb[j][c] = w4[1]; }
        if (tid < 8) misc[16 + tid] = 0u;
        __syncthreads();
    }
    int* tope = dry ? (int*)(ws + WS_ACT + 300 * MiB) : (int*)(ws + WS_TOPE); float* topg = dry ? (float*)(ws + WS_ACT + 310 * MiB) : (float*)(ws + WS_TOPG);
    const float* br = sm + SM_BROUTER + moe_idx * N_EXP;
    struct RowBuf { u32x2 nv[4], nc0[4], nc1[4]; f32x2 nst; };
    RowBuf rb0, rb1;
    auto fetch = [&](RowBuf& B, int row) {
        u32x2 (&nv)[4] = B.nv; u32x2 (&nc0)[4] = B.nc0; u32x2 (&nc1)[4] = B.nc1; f32x2& nst = B.nst;
        const u32x2* hr = (const u32x2*)(H + (size_t)row * D) + lane;
#pragma unroll
        for (int j = 0; j < 4; ++j) nv[j] = hr[64 * j];
        if (moe_src) { const u32x2* c0 = (const u32x2*)(contrib + (size_t)(2 * row) * D) + lane; const u32x2* c1 = c0 + 256;
#pragma unroll
            for (int j = 0; j < 4; ++j) { nc0[j] = c0[64 * j]; nc1[j] = c1[64 * j]; } }
        nst = *(const f32x2*)(stats + 2 * (size_t)row);
    };
    auto body = [&](RowBuf& B, int row) {
        u32x2 (&nv)[4] = B.nv; u32x2 (&nc0)[4] = B.nc0; u32x2 (&nc1)[4] = B.nc1;
        f32x4 v[4], c0v[4], c1v[4]; const f32x2 st = B.nst;
#pragma unroll
        for (int j = 0; j < 4; ++j) { v[j] = (f32x4){__builtin_bit_cast(float, nv[j].x << 16), __builtin_bit_cast(float, nv[j].x & 0xffff0000u), __builtin_bit_cast(float, nv[j].y << 16), __builtin_bit_cast(float, nv[j].y & 0xffff0000u)};
            c0v[j] = (f32x4){__builtin_bit_cast(float, nc0[j].x << 16), __builtin_bit_cast(float, nc0[j].x & 0xffff0000u), __builtin_bit_cast(float, nc0[j].y << 16), __builtin_bit_cast(float, nc0[j].y & 0xffff0000u)};
            c1v[j] = (f32x4){__builtin_bit_cast(float, nc1[j].x << 16), __builtin_bit_cast(float, nc1[j].x & 0xffff0000u), __builtin_bit_cast(float, nc1[j].y << 16), __builtin_bit_cast(float, nc1[j].y & 0xffff0000u)}; }
        if (row + 2 * NGW < MV) fetch(B, row + 2 * NGW);
        if (moe_src) { const float* pg = lg - D; const float* pb = lb - D;
#pragma unroll
            for (int j = 0; j < 4; ++j) { const f32x4 g1 = *(const f32x4*)(pg + 256 * j + 4 * lane), b1 = *(const f32x4*)(pb + 256 * j + 4 * lane);
                v[j] = ((v[j] - st.x) * st.y * g1 + b1) * ALPHA + c0v[j] + c1v[j]; }
            if (!final) { u32x2* o = (u32x2*)(Hw + (size_t)row * D) + lane;
#pragma unroll
                for (int j = 0; j < 4; ++j) { u32x2 w; w.x = pk2(v[j][0], v[j][1]); w.y = pk2(v[j][2], v[j][3]); o[64 * j] = w;
                    v[j] = (f32x4){__builtin_bit_cast(float, w.x << 16), __builtin_bit_cast(float, w.x & 0xffff0000u), __builtin_bit_cast(float, w.y << 16), __builtin_bit_cast(float, w.y & 0xffff0000u)}; } } }
        float s = 0.f;
#pragma unroll
        for (int j = 0; j < 4; ++j) s += (v[j][0] + v[j][1]) + (v[j][2] + v[j][3]);
        const float mean = wave_sum(s, lane) * (1.f / D); float s2 = 0.f;
#pragma unroll
        for (int j = 0; j < 4; ++j) { v[j] = v[j] - mean; s2 += (v[j][0] * v[j][0] + v[j][1] * v[j][1]) + (v[j][2] * v[j][2] + v[j][3] * v[j][3]); }
        const float rstd = 1.f / sqrtf(wave_sum(s2, lane) * (1.f / D) + LN_EPS);
#pragma unroll
        for (int j = 0; j < 4; ++j) v[j] = v[j] * rstd * gv[j] + bv[j];
        if (final) { if (row < MREAL) { f32x4* o = (f32x4*)(outp + (size_t)row * D) + lane;
#pragma unroll
                for (int j = 0; j < 4; ++j) o[64 * j] = v[j]; } }
        else { if (lane == 0) *(f32x2*)(statsw + 2 * (size_t)row) = (f32x2){mean, rstd};
            if (router) { unsigned* o8 = (unsigned*)(HB8 + (size_t)row * D) + lane;
#pragma unroll
                for (int j = 0; j < 4; ++j) o8[64 * j] = pk4_fp8(v[j][0] * F8_SA, v[j][1] * F8_SA, v[j][2] * F8_SA, v[j][3] * F8_SA); }
            else { u32x2* ob = (u32x2*)(HB + (size_t)row * D) + lane;
#pragma unroll
                for (int j = 0; j < 4; ++j) { u32x2 w; w.x = pk2(v[j][0], v[j][1]); w.y = pk2(v[j][2], v[j][3]); ob[64 * j] = w; } } }
        if (router) {
            f32x4 la = (f32x4){0.f, 0.f, 0.f, 0.f}, lb4 = (f32x4){0.f, 0.f, 0.f, 0.f};
#pragma unroll
            for (int j = 0; j < 4; ++j)
#pragma unroll
                for (int c = 0; c < 4; ++c) { const float x = v[j][c]; la += wra[j][c] * x; lb4 += wrb[j][c] * x; }
            const bool h5 = (lane & 32) != 0, h4 = (lane & 16) != 0, h3 = (lane & 8) != 0;
            f32x4 k4; { const f32x4 send = h5 ? la : lb4, keep = h5 ? lb4 : la; f32x4 got;
#pragma unroll
                for (int i = 0; i < 4; ++i) got[i] = SHX(send[i], 32);
                k4 = keep + got; }
            f32x2 k2; { const f32x2 send = h4 ? (f32x2){k4[0], k4[1]} : (f32x2){k4[2], k4[3]}, keep = h4 ? (f32x2){k4[2], k4[3]} : (f32x2){k4[0], k4[1]};
                k2 = keep + (f32x2){SHX(send[0], 16), SHX(send[1], 16)}; }
            float k1 = (h3 ? k2[1] : k2[0]) + SHX(h3 ? k2[0] : k2[1], 8);
            k1 += SHX(k1, 4); k1 += SHX(k1, 2); k1 += SHX(k1, 1);
            float lg8[8];
#pragma unroll
            for (int e = 0; e < 8; ++e) lg8[e] = SHL(k1, 8 * e) + br[e];
            int e1 = 0; float v1 = lg8[0];
#pragma unroll
            for (int e = 1; e < 8; ++e) if (lg8[e] > v1) { v1 = lg8[e]; e1 = e; }
            int e2 = -1; float v2 = -3.0e38f;
#pragma unroll
            for (int e = 0; e < 8; ++e) if (e != e1 && lg8[e] > v2) { v2 = lg8[e]; e2 = e; }
            const float ex = expf(v2 - v1), g1 = 1.f / (1.f + ex), g2 = ex / (1.f + ex);
            if (lane == 0) { tope[row] = e1 | (e2 << 8); topg[2 * row] = g1; topg[2 * row + 1] = g2;
                __hip_atomic_fetch_add((LAS unsigned*)&misc[16 + e1], 1u, __ATOMIC_RELAXED, __HIP_MEMORY_SCOPE_WORKGROUP);
                __hip_atomic_fetch_add((LAS unsigned*)&misc[16 + e2], 1u, __ATOMIC_RELAXED, __HIP_MEMORY_SCOPE_WORKGROUP); }
        }
    };
    if (gw < MV) fetch(rb0, gw);
    if (gw + NGW < MV) fetch(rb1, gw + NGW);
    for (int row = gw; row < MV; row += 2 * NGW) { body(rb0, row); if (row + NGW < MV) body(rb1, row + NGW); }
    if (router) { __syncthreads();
        if (tid < 8 && !dry) ((unsigned*)(ws + WS_CTL))[CW_CNTG + (moe_idx * 256 + (gw >> 3)) * 8 + tid] = misc[16 + tid];
        __syncthreads(); }
}

__device__ __forceinline__ void moe_starts(const unsigned char* ws, int moe_idx, int (&cnt)[8], int (&pstart)[9]) {
    const unsigned* c = (const unsigned*)(ws + WS_CTL) + CW_CNT + moe_idx * 64; int p = 0;
#pragma unroll
    for (int e = 0; e < 8; ++e) { cnt[e] = __builtin_amdgcn_readfirstlane((int)__hip_atomic_load(c + e, __ATOMIC_RELAXED, __HIP_MEMORY_SCOPE_AGENT)); pstart[e] = p; p += (cnt[e] + 255) >> 8; }
    pstart[8] = p;
}
__device__ __forceinline__ void assign_phase(unsigned char* ws, LAS unsigned char* lds, int gw, int NGW, int lane, int tid, int wave, int moe_idx) {
    const unsigned* cntg = (const unsigned*)(ws + WS_CTL) + CW_CNTG + moe_idx * 256 * 8;
    volatile LAS unsigned* misc = (volatile LAS unsigned*)(lds + MISC_OFF);
    const int vwg = gw >> 3, nwg = NGW >> 3;
    { const int e = wave; unsigned tot = 0, base = 0;
      for (int w = lane; w < nwg; w += 64) { const unsigned c = cntg[w * 8 + e]; tot += c; base += (w < vwg) ? c : 0u; }
#pragma unroll
      for (int o = 1; o < 64; o <<= 1) { tot += SHX(tot, o); base += SHX(base, o); }
      if (lane == 0) { misc[16 + e] = tot; misc[24 + e] = base; misc[32 + e] = 0u; } }
    __syncthreads();
    int cnt[8], pstart[9]; { int p = 0;
#pragma unroll
      for (int e = 0; e < 8; ++e) { cnt[e] = (int)misc[16 + e]; pstart[e] = p; p += (cnt[e] + 255) >> 8; } pstart[8] = p; }
    if (blockIdx.x == 0 && tid < 8) ((unsigned*)(ws + WS_CTL))[CW_CNT + moe_idx * 64 + tid] = misc[16 + tid];
    const int* tope = (const int*)(ws + WS_TOPE); const float* topg = (const float*)(ws + WS_TOPG);
    int* rowtok = (int*)(ws + WS_ROWTOK); int* rowdst = (int*)(ws + WS_ROWDST); float* rowgate = (float*)(ws + WS_ROWGATE);
    { const int row = gw + lane * NGW;
      if (row < MV) { const int te = tope[row];
#pragma unroll
          for (int slot = 0; slot < 2; ++slot) { const int e = (te >> (8 * slot)) & 255; int ps = 0; unsigned mb = 0;
#pragma unroll
              for (int ee = 0; ee < 8; ++ee) if (ee == e) { ps = pstart[ee]; mb = misc[24 + ee]; }
              const unsigned off = __hip_atomic_fetch_add((LAS unsigned*)&misc[32 + e], 1u, __ATOMIC_RELAXED, __HIP_MEMORY_SCOPE_WORKGROUP);
              const int pos = ps * 256 + (int)mb + (int)off;
              rowtok[pos] = row; rowdst[pos] = 2 * row + slot; rowgate[pos] = topg[2 * row + slot]; } } }
    if (blockIdx.x < 8) { const int e = blockIdx.x; int ps = 0, pe = 0, ce = 0;
#pragma unroll
        for (int ee = 0; ee < 8; ++ee) if (ee == e) { ps = pstart[ee]; pe = pstart[ee + 1]; ce = cnt[ee]; }
        for (int pos = ps * 256 + ce + tid; pos < pe * 256; pos += NTHREADS) { rowtok[pos] = -1; rowdst[pos] = -1; rowgate[pos] = 0.f; } }
}

constexpr int ML_RS = 72;
constexpr int ML_QS = 0, ML_KS = 9216, ML_KT = 18432, ML_PS = 27648, ML_VT = 36864, ML_CT = 57600, ML_HS = 78336, ML_SC = 112128;
constexpr int ML_HSS = 132;
constexpr int ML_TAB = 114688, ML_NCH = 17;
constexpr int ML_TSC = ML_TAB + 7 * ML_NCH * 64 * 4;
static_assert(ML_TSC + 1024 <= MISC_OFF, "mLSTM LDS");
__device__ __forceinline__ bf16x8 ml_frag(LAS unsigned char* lds, int base, int row, int kcol) { return *(const LAS bf16x8*)(lds + base + (row * ML_RS + kcol) * 2); }

template <int MODE>
__device__ __forceinline__ void mlstm_phase(unsigned char* ws, LAS unsigned char* lds, int layer, int tid, int wave, int lane) {
    const int item = blockIdx.x; const int bh = item >> 3, seg = item & 7, b = bh >> 3, h = bh & 7;
    if (MODE == 1 && seg == 7) return;
    const bf16_t* proj = (const bf16_t*)(ws + WS_PROJ); const float* gates = (const float*)(ws + WS_GATES);
    bf16_t* HG = (bf16_t*)(ws + WS_HG);
    float* STATE = (float*)(ws + WS_STATE); float* STSC = (float*)(ws + WS_STSC);
    LAS float* sc = (LAS float*)(lds + ML_SC);
    LAS float* tab = (LAS float*)(lds + ML_TAB); LAS float* tsc = (LAS float*)(lds + ML_TSC);
    const int fr = lane & 15, quad = lane >> 4;
    f32x4 st[5]; float zero = 0.f; asm volatile("; opaque zero" : "+v"(zero));
#pragma unroll
    for (int i = 0; i < 5; ++i) st[i] = (f32x4){zero, zero, zero, zero};
    float m0 = (MODE == 1) ? -1.0e30f : 0.f;
    const int nch = SEG_CHUNKS + (seg == 0 ? 1 : 0);
    auto chunk_rows = [&](int ci, int& rbase, int& nv) { if (seg == 0 && ci == 0) { rbase = MREAL; nv = NMETA; } else { const int c = seg * SEG_CHUNKS + ci - (seg == 0 ? 1 : 0); rbase = b * SEQ + c * 64; nv = 64; } };
    for (int i = tid; i < 16 * ML_RS; i += NTHREADS) ((LAS bf16_t*)(lds + ML_VT))[128 * ML_RS + i] = (i < ML_RS) ? (bf16_t)0x3F80 : (bf16_t)0;
    for (int ci = wave; ci < nch; ci += NWAVES) {
        int rbase, nv; chunk_rows(ci, rbase, nv); const bool ok = lane < nv;
        const float li = ok ? gates[(size_t)(rbase + lane) * 16 + h] : -1.0e30f, f = ok ? gates[(size_t)(rbase + lane) * 16 + 8 + h] : 0.f;
        const float lf = ok ? (fminf(f, 0.f) - logf(1.f + expf(-fabsf(f)))) : 0.f;
        float bc = lf;
#pragma unroll
        for (int o = 1; o < 64; o <<= 1) { const float t = SHUP(bc, o); if (lane >= o) bc += t; }
        const float u = li - bc; float pm = u;
#pragma unroll
        for (int o = 1; o < 64; o <<= 1) { const float t = SHUP(pm, o); if (lane >= o) pm = fmaxf(pm, t); }
        tab[(0 * ML_NCH + ci) * 64 + lane] = bc; tab[(1 * ML_NCH + ci) * 64 + lane] = u; tab[(2 * ML_NCH + ci) * 64 + lane] = pm;
        if (lane == 63) { tsc[ci] = bc; tsc[32 + ci] = pm; }
    }
    if (MODE == 2 && seg > 0) {
        m0 = -1.0e30f;
        for (int s2 = 0; s2 < seg; ++s2) {
            const float ms = STSC[(bh * 7 + s2) * 4 + 0], Gs = STSC[(bh * 7 + s2) * 4 + 1];
            const float mn = fmaxf(Gs + m0, ms), fo = fast_exp(Gs + m0 - mn), fn = fast_exp(ms - mn);
            const f32x4* sp = (const f32x4*)(STATE + (size_t)(bh * 7 + s2) * ST_FLOATS) + (wave * 5) * 64 + lane;
#pragma unroll
            for (int i = 0; i < 5; ++i) st[i] = st[i] * fo + sp[i * 64] * fn;
            m0 = mn;
        }
    }
#pragma unroll
    for (int i = 0; i < 5; ++i) { const int dv = (i < 4) ? 16 * wave + fr : 128 + fr, dk = (i < 4) ? 16 * i + 4 * quad : 16 * wave + 4 * quad;
        if (i < 4 || wave < 4) { u32x2 w; w.x = pk2(st[i][0], st[i][1]); w.y = pk2(st[i][2], st[i][3]); *(LAS u32x2*)(lds + ML_CT + (dv * ML_RS + dk) * 2) = w; } }
    __syncthreads();
    if (wave == 0) {
        const float bl = lane < nch ? tsc[lane] : 0.f, um = lane < nch ? tsc[32 + lane] : 0.f; float m = m0, gs = 0.f;
        for (int ci = 0; ci < nch; ++ci) { const float blast = SHL(bl, ci), umax = SHL(um, ci), amax = blast + umax, mn = fmaxf(blast + m, amax);
            if (lane == 0) { tsc[64 + ci] = m; tsc[96 + ci] = fast_exp(blast + m - mn); tsc[128 + ci] = fast_exp(amax - mn); }
            m = mn; gs += blast; }
        if (lane == 0) { tsc[160] = m; tsc[161] = gs; }
    }
    __syncthreads();
    for (int idx = tid; idx < nch * 64; idx += NTHREADS) { const int ci = idx >> 6, j = idx & 63;
        const float bc = tab[(0 * ML_NCH + ci) * 64 + j], u = tab[(1 * ML_NCH + ci) * 64 + j], pm = tab[(2 * ML_NCH + ci) * 64 + j], mc = tsc[64 + ci], MM = fmaxf(pm, mc);
        tab[(3 * ML_NCH + ci) * 64 + j] = MM; tab[(4 * ML_NCH + ci) * 64 + j] = fast_exp(mc - MM); tab[(5 * ML_NCH + ci) * 64 + j] = fast_exp(-(bc + MM));
        tab[(6 * ML_NCH + ci) * 64 + j] = tsc[128 + ci] * fast_exp(u - tsc[32 + ci]); }
    float lnh[16];
    if (MODE == 2) {
#pragma unroll
        for (int e = 0; e < 16; ++e) lnh[e] = ((const float*)(ws + WS_SMALL))[SM_LNH + layer * D + h * M_V + 16 * (tid & 7) + e]; }
    u32x4 rq, rk, rv0, rv1, rg0, rg1;
    auto load_chunk = [&](int ci) {
        int rbase, nv; chunk_rows(ci, rbase, nv);
        if (MODE == 2) { const int i = tid >> 3, sg = tid & 7; const u32x4* ogp = (const u32x4*)(proj + (size_t)(rbase + (i < nv ? i : 0)) * PROJ_LD + 2048 + h * M_V + 16 * sg); rg0 = ogp[0]; rg1 = ogp[1]; }
        { const int j = tid >> 3, c8 = (tid & 7) * 8; const bf16_t* rp = proj + (size_t)(rbase + j) * PROJ_LD + h * 64 + c8;
          rq = (MODE == 2 && j < nv) ? *(const u32x4*)rp : (u32x4){0u, 0u, 0u, 0u}; }
        { const bf16_t* rp = proj + (size_t)(rbase + lane) * PROJ_LD; const bool ok = lane < nv;
          rk = ok ? *(const u32x4*)(rp + 512 + h * 64 + 8 * wave) : (u32x4){0u, 0u, 0u, 0u};
          rv0 = ok ? *(const u32x4*)(rp + 1024 + h * 128 + 16 * wave) : (u32x4){0u, 0u, 0u, 0u}; rv1 = ok ? *(const u32x4*)(rp + 1024 + h * 128 + 16 * wave + 8) : (u32x4){0u, 0u, 0u, 0u}; }
    };
    load_chunk(0);
    __syncthreads();
    for (int ci = 0; ci < nch; ++ci) {
        int rbase, nv; chunk_rows(ci, rbase, nv);
        const u32x4 g0 = rg0, g1 = rg1;
        const LAS float* tU = tab + (1 * ML_NCH + ci) * 64; const LAS float* tMM = tab + (3 * ML_NCH + ci) * 64; const LAS float* tSI = tab + (4 * ML_NCH + ci) * 64;
        const LAS float* tFL = tab + (5 * ML_NCH + ci) * 64; const LAS float* tWP = tab + (6 * ML_NCH + ci) * 64;
        const float sold = tsc[96 + ci];
        { if (MODE == 2) { const int j = tid >> 3, c8 = (tid & 7) * 8; *(LAS u32x4*)(lds + ML_QS + (j * ML_RS + c8) * 2) = rq; }
          const float wj = tWP[lane]; LAS bf16_t* kt = (LAS bf16_t*)(lds + ML_KT); LAS bf16_t* vt = (LAS bf16_t*)(lds + ML_VT);
          if (MODE == 2) *(LAS u32x4*)(lds + ML_KS + (lane * ML_RS + 8 * wave) * 2) = rk;
          const unsigned kk[4] = {rk.x, rk.y, rk.z, rk.w}, a[4] = {rv0.x, rv0.y, rv0.z, rv0.w}, c[4] = {rv1.x, rv1.y, rv1.z, rv1.w};
#pragma unroll
          for (int e = 0; e < 4; ++e) { kt[(8 * wave + 2 * e) * ML_RS + lane] = (bf16_t)f2bf(bf2f((unsigned short)(kk[e] & 0xffffu)) * wj); kt[(8 * wave + 2 * e + 1) * ML_RS + lane] = (bf16_t)f2bf(bf2f((unsigned short)(kk[e] >> 16)) * wj);
              vt[(16 * wave + 2 * e) * ML_RS + lane] = (bf16_t)(a[e] & 0xffffu); vt[(16 * wave + 2 * e + 1) * ML_RS + lane] = (bf16_t)(a[e] >> 16);
              vt[(16 * wave + 8 + 2 * e) * ML_RS + lane] = (bf16_t)(c[e] & 0xffffu); vt[(16 * wave + 8 + 2 * e + 1) * ML_RS + lane] = (bf16_t)(c[e] >> 16); } }
        __syncthreads();
        if (ci + 1 < nch) load_chunk(ci + 1);
        f32x4 o1[4], o2[4];
        if (MODE == 2) {
            const int mt = wave >> 1;
#pragma unroll
            for (int q = 0; q < 2; ++q) { const int nt = 2 * (wave & 1) + q; f32x4 s = (f32x4){0.f, 0.f, 0.f, 0.f};
                if (nt <= mt) {
#pragma unroll
                    for (int ks = 0; ks < 2; ++ks) s = __builtin_amdgcn_mfma_f32_16x16x32_bf16(ml_frag(lds, ML_QS, 16 * mt + fr, 32 * ks + 8 * quad), ml_frag(lds, ML_KS, 16 * nt + fr, 32 * ks + 8 * quad), s, 0, 0, 0); }
                const int j = 16 * nt + fr; const float uj = tU[j];
#pragma unroll
                for (int r = 0; r < 4; ++r) { const int i = 16 * mt + 4 * quad + r; const float p = (j <= i) ? s[r] * fast_exp(uj - tMM[i]) : 0.f;
                    ((LAS bf16_t*)(lds + ML_PS))[i * ML_RS + j] = (bf16_t)f2bf(p); } }
            __syncthreads();
            bf16x8 vb[2], cb[2];
#pragma unroll
            for (int ks = 0; ks < 2; ++ks) { vb[ks] = ml_frag(lds, ML_VT, 16 * wave + fr, 32 * ks + 8 * quad); cb[ks] = ml_frag(lds, ML_CT, 16 * wave + fr, 32 * ks + 8 * quad); }
#pragma unroll
            for (int mt2 = 0; mt2 < 4; ++mt2) { o1[mt2] = (f32x4){0.f, 0.f, 0.f, 0.f}; o2[mt2] = (f32x4){0.f, 0.f, 0.f, 0.f};
#pragma unroll
                for (int ks = 0; ks < 2; ++ks) { o1[mt2] = __builtin_amdgcn_mfma_f32_16x16x32_bf16(ml_frag(lds, ML_PS, 16 * mt2 + fr, 32 * ks + 8 * quad), vb[ks], o1[mt2], 0, 0, 0);
                    o2[mt2] = __builtin_amdgcn_mfma_f32_16x16x32_bf16(ml_frag(lds, ML_QS, 16 * mt2 + fr, 32 * ks + 8 * quad), cb[ks], o2[mt2], 0, 0, 0); } }
            if (wave < 4) { f32x4 d1 = (f32x4){0.f, 0.f, 0.f, 0.f}, d2 = (f32x4){0.f, 0.f, 0.f, 0.f};
#pragma unroll
                for (int ks = 0; ks < 2; ++ks) { d1 = __builtin_amdgcn_mfma_f32_16x16x32_bf16(ml_frag(lds, ML_PS, 16 * wave + fr, 32 * ks + 8 * quad), ml_frag(lds, ML_VT, 128 + fr, 32 * ks + 8 * quad), d1, 0, 0, 0);
                    d2 = __builtin_amdgcn_mfma_f32_16x16x32_bf16(ml_frag(lds, ML_QS, 16 * wave + fr, 32 * ks + 8 * quad), ml_frag(lds, ML_CT, 128 + fr, 32 * ks + 8 * quad), d2, 0, 0, 0); }
                if (fr == 0) {
#pragma unroll
                    for (int r = 0; r < 4; ++r) { const int i = 16 * wave + 4 * quad + r; sc[320 + i] = d1[r] + tSI[i] * d2[r]; } } }
            __syncthreads();
#pragma unroll
            for (int mt2 = 0; mt2 < 4; ++mt2)
#pragma unroll
                for (int r = 0; r < 4; ++r) { const int i = 16 * mt2 + 4 * quad + r; const float num = o1[mt2][r] + tSI[i] * o2[mt2][r];
                    ((LAS float*)(lds + ML_HS))[i * ML_HSS + 16 * wave + fr] = num * __builtin_amdgcn_rcpf(fmaxf(fabsf(sc[320 + i]), tFL[i])); }
        }
        { bf16x8 vb[2];
#pragma unroll
          for (int ks = 0; ks < 2; ++ks) vb[ks] = ml_frag(lds, ML_VT, 16 * wave + fr, 32 * ks + 8 * quad);
#pragma unroll
          for (int mt2 = 0; mt2 < 4; ++mt2) { st[mt2] = st[mt2] * sold;
#pragma unroll
              for (int ks = 0; ks < 2; ++ks) st[mt2] = __builtin_amdgcn_mfma_f32_16x16x32_bf16(ml_frag(lds, ML_KT, 16 * mt2 + fr, 32 * ks + 8 * quad), vb[ks], st[mt2], 0, 0, 0); }
          if (wave < 4) { st[4] = st[4] * sold;
#pragma unroll
              for (int ks = 0; ks < 2; ++ks) st[4] = __builtin_amdgcn_mfma_f32_16x16x32_bf16(ml_frag(lds, ML_KT, 16 * wave + fr, 32 * ks + 8 * quad), ml_frag(lds, ML_VT, 128 + fr, 32 * ks + 8 * quad), st[4], 0, 0, 0); }
          if (MODE == 2) {
#pragma unroll
              for (int i = 0; i < 5; ++i) { const int dv = (i < 4) ? 16 * wave + fr : 128 + fr, dk = (i < 4) ? 16 * i + 4 * quad : 16 * wave + 4 * quad;
                  if (i < 4 || wave < 4) { u32x2 w; w.x = pk2(st[i][0], st[i][1]); w.y = pk2(st[i][2], st[i][3]); *(LAS u32x2*)(lds + ML_CT + (dv * ML_RS + dk) * 2) = w; } } }
        }
        __syncthreads();
        if (MODE == 2) {
            const int i = tid >> 3, sg = tid & 7; const LAS float* hp = (const LAS float*)(lds + ML_HS) + i * ML_HSS + 16 * sg;
            float x[16]; float s = 0.f;
#pragma unroll
            for (int e = 0; e < 16; ++e) { x[e] = hp[e]; s += x[e]; }
            s += SHX(s, 1); s += SHX(s, 2); s += SHX(s, 4);
            const float mean = s * (1.f / M_V); float q = 0.f;
#pragma unroll
            for (int e = 0; e < 16; ++e) { x[e] -= mean; q += x[e] * x[e]; }
            q += SHX(q, 1); q += SHX(q, 2); q += SHX(q, 4);
            const float rstd = 1.f / sqrtf(q * (1.f / M_V) + LN_EPS);
            if (i < nv && (nv == 64 || b == 0)) {
                const size_t row = (size_t)(rbase + i);
                const unsigned gw8[8] = {g0.x, g0.y, g0.z, g0.w, g1.x, g1.y, g1.z, g1.w}; unsigned ow[8];
#pragma unroll
                for (int e = 0; e < 8; ++e) { const float oga = bf2f((unsigned short)(gw8[e] & 0xffffu)), ogb = bf2f((unsigned short)(gw8[e] >> 16));
                    const float ya = x[2 * e] * rstd * lnh[2 * e] * __builtin_amdgcn_rcpf(1.f + fast_exp(-oga)), yb = x[2 * e + 1] * rstd * lnh[2 * e + 1] * __builtin_amdgcn_rcpf(1.f + fast_exp(-ogb));
                    ow[e] = pk2(ya, yb); }
                u32x4* op = (u32x4*)(HG + row * D + h * M_V + 16 * sg);
                op[0] = (u32x4){ow[0], ow[1], ow[2], ow[3]}; op[1] = (u32x4){ow[4], ow[5], ow[6], ow[7]};
            }
        }
    }
    if (MODE == 1) {
        f32x4* sp = (f32x4*)(STATE + (size_t)(bh * 7 + seg) * ST_FLOATS) + (wave * 5) * 64 + lane;
#pragma unroll
        for (int i = 0; i < 5; ++i) sp[i * 64] = (i < 4 || wave < 4) ? st[i] : (f32x4){0.f, 0.f, 0.f, 0.f};
        if (tid == 0) { STSC[(bh * 7 + seg) * 4 + 0] = tsc[160]; STSC[(bh * 7 + seg) * 4 + 1] = tsc[161]; }
    }
}

constexpr int AT_KRS = 72, AT_VRS = 280, AT_NK = 272;
constexpr int AT_KS = 0, AT_VT = AT_NK * AT_KRS * 2, AT_END = AT_VT + 64 * AT_VRS * 2;
static_assert(AT_END <= MISC_OFF, "attention LDS");
__device__ __forceinline__ void attn_phase(unsigned char* ws, LAS unsigned char* lds, int j_layer, int tid, int wave, int lane) {
    const bf16_t* Q = (const bf16_t*)(ws + WS_PROJ); const bf16_t* KB = (const bf16_t*)(ws + WS_KB); const bf16_t* VT = (const bf16_t*)(ws + WS_VB);
    bf16_t* HG = (bf16_t*)(ws + WS_HG);
    const float* sinks = (const float*)(ws + WS_SMALL) + SM_SINKS + j_layer * A_HEADS;
    const int fr = lane & 15, quad = lane >> 4;
    LAS bf16_t* ks = (LAS bf16_t*)(lds + AT_KS); LAS bf16_t* vt = (LAS bf16_t*)(lds + AT_VT);
    u32x4 kreg[5], vreg[5]; bf16x8 qn[4][2];
    const int NREG = NBATCH * A_KV * (SEQ / WINDOW), NIT = NREG + A_KV;
    auto prefetch = [&](int it) {
        const bool meta = it >= NREG; const int b = meta ? 0 : it >> 8, g = meta ? it - NREG : (it >> 6) & 3, blk = meta ? -1 : it & 63;
#pragma unroll
        for (int i = 0; i < 5; ++i) { const int p = tid + i * NTHREADS; kreg[i] = (u32x4){0u, 0u, 0u, 0u}; vreg[i] = (u32x4){0u, 0u, 0u, 0u};
            if (p < AT_NK * 8) { const int kk = p >> 3, c8 = (p & 7) * 8;
                int row; if (kk >= 256) row = MREAL + kk - 256; else { const int tk = (blk - 1) * WINDOW + kk; row = (tk < 0 || meta) ? -1 : b * SEQ + tk; }
                if (row >= 0) kreg[i] = *(const u32x4*)(KB + (size_t)row * 256 + g * 64 + c8);
                const int d = p / 34, pc = p % 34; const bf16_t* src = VT + (size_t)(g * 64 + d) * MP;
                if (pc >= 32) vreg[i] = *(const u32x4*)(src + MREAL + (pc - 32) * 8);
                else { const int tk = (blk - 1) * WINDOW + pc * 8; if (tk >= 0 && !meta) vreg[i] = *(const u32x4*)(src + (size_t)b * SEQ + tk); } } }
    };
    auto qload = [&](int it, int mt) {
        const bool meta = it >= NREG; const int b = it >> 8, g = meta ? it - NREG : (it >> 6) & 3, blk = it & 63, qh = g * 4 + (wave >> 1);
        const size_t rowq = meta ? (size_t)MREAL + fr : (size_t)b * SEQ + blk * WINDOW + 16 * (4 * (wave & 1) + mt) + fr;
#pragma unroll
        for (int k2 = 0; k2 < 2; ++k2) qn[mt][k2] = *(const bf16x8*)(Q + rowq * D + qh * 64 + 32 * k2 + 8 * quad);
    };
    if ((int)blockIdx.x < NIT) { prefetch(blockIdx.x);
#pragma unroll
        for (int mt = 0; mt < 4; ++mt) qload(blockIdx.x, mt); }
    for (int it = blockIdx.x; it < NIT; it += gridDim.x) {
        const bool meta = it >= NREG; const int b = it >> 8, g = meta ? it - NREG : (it >> 6) & 3, blk = it & 63;
        __syncthreads();
#pragma unroll
        for (int i = 0; i < 5; ++i) { const int p = tid + i * NTHREADS;
            if (p < AT_NK * 8) { *(LAS u32x4*)(ks + (p >> 3) * AT_KRS + (p & 7) * 8) = kreg[i]; *(LAS u32x4*)(vt + (p / 34) * AT_VRS + (p % 34) * 8) = vreg[i]; } }
        __syncthreads();
        const bool has_next = it + (int)gridDim.x < NIT;
        if (has_next) prefetch(it + gridDim.x);
        const int qh = g * 4 + (wave >> 1); const float sink = sinks[qh];
#pragma unroll
        for (int mt = 0; mt < 4; ++mt) {
            if (meta && (mt > 0 || (wave & 1))) continue;
            const int t0 = meta ? 0 : 4 * (wave & 1) + mt, qi = 16 * t0 + fr;
            const size_t rowq = meta ? (size_t)MREAL + fr : (size_t)b * SEQ + blk * WINDOW + qi;
            f32x4 s[10];
#pragma unroll
            for (int c = 0; c < 10; ++c) { const int kb = (c < 9) ? 16 * (t0 + c) : 256; s[c] = (f32x4){0.f, 0.f, 0.f, 0.f};
#pragma unroll
                for (int k2 = 0; k2 < 2; ++k2) s[c] = __builtin_amdgcn_mfma_f32_16x16x32_bf16(*(const LAS bf16x8*)(ks + (kb + fr) * AT_KRS + 32 * k2 + 8 * quad), qn[mt][k2], s[c], 0, 0, 0); }
            if (has_next) qload(it + gridDim.x, mt);
            float m = sink;
#pragma unroll
            for (int c = 0; c < 9; ++c)
#pragma unroll
                for (int r = 0; r < 4; ++r) { const int j = 16 * (t0 + c) + 4 * quad + r, rel = qi + WINDOW - j; const bool vis = !meta && (rel >= 0) && (rel < WINDOW) && (blk > 0 || j >= WINDOW);
                    s[c][r] = vis ? s[c][r] : -1.0e30f; m = fmaxf(m, s[c][r]); }
#pragma unroll
            for (int r = 0; r < 4; ++r) { const bool vis = !meta || (4 * quad + r <= fr); s[9][r] = vis ? s[9][r] : -1.0e30f; m = fmaxf(m, s[9][r]); }
            m = fmaxf(m, SHX(m, 16)); m = fmaxf(m, SHX(m, 32));
            float sm = 0.f;
#pragma unroll
            for (int c = 0; c < 10; ++c)
#pragma unroll
                for (int r = 0; r < 4; ++r) { const float p = fast_exp(s[c][r] - m); s[c][r] = p; sm += p; }
            sm += SHX(sm, 16); sm += SHX(sm, 32);
            const float inv = 1.f / (sm + fast_exp(sink - m));
            f32x4 o[4];
#pragma unroll
            for (int dt = 0; dt < 4; ++dt) o[dt] = (f32x4){0.f, 0.f, 0.f, 0.f};
#pragma unroll
            for (int u = 0; u < 5; ++u) {
                const int kb0 = 16 * (t0 + 2 * u), kb1 = (u < 4) ? 16 * (t0 + 2 * u + 1) : 256;
                u32x4 pw; pw.x = cvt_pk_bf16(s[2 * u][0], s[2 * u][1]); pw.y = cvt_pk_bf16(s[2 * u][2], s[2 * u][3]); pw.z = cvt_pk_bf16(s[2 * u + 1][0], s[2 * u + 1][1]); pw.w = cvt_pk_bf16(s[2 * u + 1][2], s[2 * u + 1][3]);
                const bf16x8 pf = __builtin_bit_cast(bf16x8, pw);
#pragma unroll
                for (int dt = 0; dt < 4; ++dt) { const LAS bf16_t* vr = vt + (16 * dt + fr) * AT_VRS + 4 * quad;
                    u32x4 vw; const u32x2 a = *(const LAS u32x2*)(vr + kb0), c2 = *(const LAS u32x2*)(vr + kb1); vw.x = a.x; vw.y = a.y; vw.z = c2.x; vw.w = c2.y;
                    o[dt] = __builtin_amdgcn_mfma_f32_16x16x32_bf16(__builtin_bit_cast(bf16x8, vw), pf, o[dt], 0, 0, 0); } }
#pragma unroll
            for (int dt = 0; dt < 4; ++dt) { u32x2 w; w.x = cvt_pk_bf16(o[dt][0] * inv, o[dt][1] * inv); w.y = cvt_pk_bf16(o[dt][2] * inv, o[dt][3] * inv);
                *(u32x2*)(HG + rowq * D + qh * 64 + 16 * dt + 4 * quad) = w; }
        }
    }
}

#ifndef SITES
#define SITES 0xFFFF
#endif
#define SITE(n) ((SITES >> (n)) & 1)
#ifndef DUPMASK
#define DUPMASK 0
#endif
#define REPS(n) (1 + ((DUPMASK >> (n)) & 1))
#ifndef MK_PER_PHASE
#define MK_PER_PHASE 0
#endif
constexpr int PH_PER_LAYER = 12, N_PHASES = 1 + 4 * PH_PER_LAYER;

__global__ void __launch_bounds__(NTHREADS, 2) fwd(Params P) {
    extern __shared__ __attribute__((aligned(16))) unsigned char lds_raw[];
    LAS unsigned char* const lds0 = (LAS unsigned char*)lds_raw;
    const int wave_s = __builtin_amdgcn_readfirstlane((int)threadIdx.x >> 6);
    const int G = gridDim.x;
    const int vcu = (G % 8 == 0) ? ((int)blockIdx.x % 8) * (G / 8) + (int)blockIdx.x / 8 : (int)blockIdx.x;
    const int NGW = G * NWAVES;
    unsigned char* const wsbase = P.ws;
    volatile LAS unsigned* misc = (volatile LAS unsigned*)(lds0 + MISC_OFF);
    if (threadIdx.x < 64) misc[threadIdx.x] = 0u;
    __syncthreads();
    XcdBarrier bar = xcd_barrier_post((unsigned*)(wsbase + WS_CTL) + CW_BAR + P.li * 4096, misc + 8);
    const int lo = P.ph_lo, hi = P.ph_hi;
#define RUN(idx) ((idx) >= lo && (idx) < hi)
#define SEAM(idx) do { if ((idx) + 1 < hi) xcd_barrier(bar, tid == 0); } while (0)
#define IDS() int tid = wave_s * 64 + (int)__builtin_amdgcn_mbcnt_hi(~0u, __builtin_amdgcn_mbcnt_lo(~0u, 0u)); asm volatile("; opaque tid" : "+v"(tid));   size_t wsz = 0; asm volatile("; opaque ws offset" : "+s"(wsz)); unsigned char* ws = wsbase + wsz;   \
              LAS unsigned char* lds = lds0; asm volatile("; opaque lds" : "+s"(lds)); \
              const int lane = tid & 63, wave = __builtin_amdgcn_readfirstlane(tid >> 6); const int gw = vcu * NWAVES + wave; (void)lane; (void)gw; (void)ws

    for (int rep = 0; rep < REPS(0); ++rep) if (SITE(0) && RUN(0)) { IDS(); p0_prologue(P, lds, gw, NGW, wave, lane); SEAM(0); }

    for (int l = 0; l < 4; ++l) {
        const int pb = 1 + l * PH_PER_LAYER;
        const bool moe = (l & 1) != 0; const int fi = l >> 1;
        if (l < 2) {
            for (int rep = 0; rep < REPS(1); ++rep) if (SITE(1) && RUN(pb + 0)) {
                IDS();
                pg8::DenseOrder S; S.init(MREAL / 256, 12, G, (int)blockIdx.x);
                EpiProj E{(bf16_t*)(ws + WS_PROJ), (float*)(ws + WS_GATES), (const float*)(ws + WS_SMALL) + SM_BGATE + l * 16};
                const bf16_t* HBp = (const bf16_t*)(ws + WS_HB); const bf16_t* Wp = (const bf16_t*)(ws + WS_WIN) + (size_t)l * M_INP * D;
                pg8::gemm_phase(lds, HBp, Wp, D, S, E, tid);
                bf16_t* PROJ = (bf16_t*)(ws + WS_PROJ); float* GATES = (float*)(ws + WS_GATES); const float* bg = (const float*)(ws + WS_SMALL) + SM_BGATE + l * 16;
                int par = 0;
                for (int item = (int)blockIdx.x; item < 192; item += G, par ^= 1) { const bf16_t* B1[1] = {Wp + (size_t)item * 16 * D};
                    skinny_item<1>(HBp + (size_t)MREAL * D, D, B1, D, wave, lane, lds, par, [&](const f32x4 (&a)[1], int fr, int quad) {
#pragma unroll
                        for (int r = 0; r < 4; ++r) PROJ[(size_t)(MREAL + 4 * quad + r) * PROJ_LD + item * 16 + fr] = (bf16_t)f2bf(a[0][r]); }); }
                { const int fr = lane & 15, quad = lane >> 4; const bf16_t* bp = Wp + (size_t)(3072 + fr) * D + 8 * quad; const float bias = bg[fr];
                  for (int rt = gw; rt < MV / 16; rt += NGW) { const bf16_t* ap = HBp + (size_t)(rt * 16 + fr) * D + 8 * quad;
                      f32x4 a0 = (f32x4){0.f, 0.f, 0.f, 0.f}, a1 = (f32x4){0.f, 0.f, 0.f, 0.f};
#pragma unroll 8
                      for (int k = 0; k < D; k += 64) { a0 = __builtin_amdgcn_mfma_f32_16x16x32_bf16(*(const bf16x8*)(ap + k), *(const bf16x8*)(bp + k), a0, 0, 0, 0);
                          a1 = __builtin_amdgcn_mfma_f32_16x16x32_bf16(*(const bf16x8*)(ap + k + 32), *(const bf16x8*)(bp + k + 32), a1, 0, 0, 0); }
#pragma unroll
                      for (int r = 0; r < 4; ++r) GATES[(size_t)(rt * 16 + 4 * quad + r) * 16 + fr] = a0[r] + a1[r] + bias; } }
                SEAM(pb + 0); }
            for (int rep = 0; rep < REPS(2); ++rep) if (SITE(2) && RUN(pb + 1)) { IDS(); mlstm_phase<1>(ws, lds, l, tid, wave, lane); SEAM(pb + 1); }
            for (int rep = 0; rep < REPS(3); ++rep) if (SITE(3) && RUN(pb + 2)) { IDS(); mlstm_phase<2>(ws, lds, l, tid, wave, lane); SEAM(pb + 2); }
        } else {
            for (int rep = 0; rep < REPS(4); ++rep) if (SITE(4) && RUN(pb + 0)) {
                IDS();
                pg8::DenseOrder S; S.init(MREAL / 256, l == 2 ? 6 : 4, G, (int)blockIdx.x);
                EpiQKV E{(bf16_t*)(ws + WS_PROJ), (bf16_t*)(ws + WS_KB), (bf16_t*)(ws + WS_VB), (const float*)(ws + WS_ROPE)};
                const bf16_t* HBp = (const bf16_t*)(ws + WS_HB); const bf16_t* Wp = (const bf16_t*)(ws + (l == 2 ? WS_WQKV : WS_WQ3));
                pg8::gemm_phase(lds, HBp, Wp, D, S, E, tid);
                bf16_t* Qp = (bf16_t*)(ws + WS_PROJ); bf16_t* KBp = (bf16_t*)(ws + WS_KB); bf16_t* VTp = (bf16_t*)(ws + WS_VB); const float* rope = (const float*)(ws + WS_ROPE);
                int par = 0;
                for (int item = (int)blockIdx.x; item < (l == 2 ? 96 : 64); item += G, par ^= 1) { const bf16_t* B1[1] = {Wp + (size_t)item * 16 * D};
                    skinny_item<1>(HBp + (size_t)MREAL * D, D, B1, D, wave, lane, lds, par, [&](const f32x4 (&a)[1], int fr, int quad) {
                        const int col = item * 16 + fr; const bool dorope = (item < 80) && ((item & 3) == 0);
#pragma unroll
                        for (int r = 0; r < 4; ++r) { const int pos = 4 * quad + r; float x = a[0][r]; const float y = SHX(x, 8);
                            if (dorope) { const float c = rope[pos * 16 + (fr & 7)], sn = rope[pos * 16 + 8 + (fr & 7)]; x = (fr < 8) ? x * c - y * sn : x * c + y * sn; }
                            const bf16_t o = (bf16_t)f2bf(x); const size_t row = (size_t)MREAL + pos;
                            if (item < 64) Qp[row * D + col] = o; else if (item < 80) KBp[row * 256 + col - 1024] = o; else VTp[(size_t)(col - 1280) * MP + row] = o; } });
                }
                SEAM(pb + 0); }
            for (int rep = 0; rep < REPS(5); ++rep) if (SITE(5) && RUN(pb + 1)) { IDS(); attn_phase(ws, lds, l - 2, tid, wave, lane); SEAM(pb + 1); }
        }
        for (int rep = 0; rep < REPS(6); ++rep) if (SITE(6) && RUN(pb + 3)) {
            IDS();
            pg8::DenseOrder S; S.init(MREAL / 256, 4, G, (int)blockIdx.x);
            const float* smp = (const float*)(ws + WS_SMALL);
            EpiRes E{(bf16_t*)(ws + WS_H), (const float*)(ws + WS_STATS), l > 0 ? smp + SM_LNG + (size_t)(2 * l - 1) * D : nullptr, smp + SM_LNB + (size_t)(l > 0 ? 2 * l - 1 : 0) * D, P.in[I_X], 1.f};
            const bf16_t* Ap = (const bf16_t*)(ws + WS_HG); const bf16_t* Wp = (const bf16_t*)(ws + (l < 2 ? WS_WOUT : WS_WO)) + (size_t)(l & 1) * D * D;
            pg8::gemm_phase(lds, Ap, Wp, D, S, E, tid);
            int par = 0;
            for (int item = (int)blockIdx.x; item < 64; item += G, par ^= 1) { const bf16_t* B1[1] = {Wp + (size_t)item * 16 * D};
                skinny_item<1>(Ap + (size_t)MREAL * D, D, B1, D, wave, lane, lds, par, [&](const f32x4 (&a)[1], int fr, int quad) { const int col = item * 16 + fr;
#pragma unroll
                    for (int r = 0; r < 4; ++r) { const size_t row = (size_t)MREAL + 4 * quad + r; float h = E.lg ? bf2f(E.H[row * D + col]) : P.in[I_META][(size_t)(4 * quad + r) * D + col];
                        if (E.lg) h = (h - E.stats[2 * row]) * E.stats[2 * row + 1] * E.lg[col] + E.lb[col];
                        E.H[row * D + col] = (bf16_t)f2bf(h * ALPHA + a[0][r]); } });
            }
            SEAM(pb + 3); }
        for (int rep = 0; rep < (moe ? REPS(14) : REPS(7)); ++rep) if (SITE(7) && RUN(pb + 4)) { IDS(); ln_phase(ws, nullptr, lds, gw, NGW, lane, tid, l * 2 + 0, false, moe, fi, false, moe && rep > 0); SEAM(pb + 4); }
        if (!moe) {
            for (int rep = 0; rep < REPS(8); ++rep) if (SITE(8) && RUN(pb + 5)) {
                IDS();
                pg8::DenseOrder S; S.init(MREAL / 256, 2 * D_FF / 256, G, (int)blockIdx.x);
                EpiSwiglu8 E{ws + WS_ACT, D_FF, 1.f};
                const bf16_t* HBp = (const bf16_t*)(ws + WS_HB); const bf16_t* Wp = (const bf16_t*)(ws + WS_WGU) + (size_t)fi * 2 * D_FF * D;
                pg8::gemm_phase(lds, HBp, Wp, D, S, E, tid);
                int par = 0;
                for (int item = (int)blockIdx.x; item < D_FF / 16; item += G, par ^= 1) {
                    const int brow = 256 * (item >> 3) + 16 * (item & 7); const bf16_t* B2[2] = {Wp + (size_t)brow * D, Wp + (size_t)(brow + 128) * D};
                    skinny_item<2>(HBp + (size_t)MREAL * D, D, B2, D, wave, lane, lds, par, [&](const f32x4 (&a)[2], int fr, int quad) {
#pragma unroll
                        for (int r = 0; r < 4; ++r) E.act[(size_t)(MREAL + 4 * quad + r) * D_FF + item * 16 + fr] = (unsigned char)(pk4_fp8(EpiSwiglu::silu_mul(a[0][r], a[1][r]) * F8_SACT, 0.f, 0.f, 0.f) & 0xffu); });
                }
                SEAM(pb + 5); }
            for (int rep = 0; rep < REPS(9); ++rep) if (SITE(9) && RUN(pb + 6)) {
                IDS();
                pg8::DenseOrder S; S.init(MREAL / 256, 4, G, (int)blockIdx.x);
                const float* smp = (const float*)(ws + WS_SMALL);
                EpiRes E{(bf16_t*)(ws + WS_H), (const float*)(ws + WS_STATS), smp + SM_LNG + (size_t)(2 * l) * D, smp + SM_LNB + (size_t)(2 * l) * D, nullptr, F8_INVD};
                const unsigned char* Ap = ws + WS_ACT; const unsigned char* Wp = ws + WS_WDN8 + (size_t)fi * D * D_FF;
                pg8::gemm_phase<EpiRes, pg8::DenseOrder, true>(lds, Ap, Wp, D_FF, S, E, tid);
                int par = 0;
                for (int item = (int)blockIdx.x; item < 64; item += G, par ^= 1) { const unsigned char* B1[1] = {Wp + (size_t)item * 16 * D_FF};
                    skinny_item8<1>(Ap + (size_t)MREAL * D_FF, D_FF, B1, D_FF, wave, lane, lds, par, [&](const f32x4 (&a)[1], int fr, int quad) { const int col = item * 16 + fr;
#pragma unroll
                        for (int r = 0; r < 4; ++r) { const size_t row = (size_t)MREAL + 4 * quad + r; float h = bf2f(E.H[row * D + col]);
                            h = (h - E.stats[2 * row]) * E.stats[2 * row + 1] * E.lg[col] + E.lb[col];
                            E.H[row * D + col] = (bf16_t)f2bf(h * ALPHA + a[0][r] * E.sc); } });
                }
                SEAM(pb + 6); }
        } else {
            for (int rep = 0; rep < REPS(10); ++rep) if (SITE(10) && RUN(pb + 5)) { IDS(); assign_phase(ws, lds, gw, NGW, lane, tid, wave, fi); SEAM(pb + 5); }
            for (int rep = 0; rep < REPS(11); ++rep) if (SITE(11) && RUN(pb + 6)) {
                IDS();
                int cnt[8]; pg8::GroupedOrder S; moe_starts(ws, fi, cnt, S.pstart);
                S.o.init(S.pstart[8], 2 * D_FF_EXP / 256, G, (int)blockIdx.x); S.nexp_rows = 2 * D_FF_EXP; S.rowtok = (const int*)(ws + WS_ROWTOK);
                EpiSwiglu8 E{ws + WS_ACT, D_FF_EXP, F8_INV};
                pg8::gemm_phase<EpiSwiglu8, pg8::GroupedOrder, true>(lds, ws + WS_HB8, ws + WS_WGUE8 + (size_t)fi * 8 * 2 * D_FF_EXP * D, D, S, E, tid);
                SEAM(pb + 6); }
            for (int rep = 0; rep < REPS(12); ++rep) if (SITE(12) && RUN(pb + 7)) {
                IDS();
                int cnt[8]; pg8::GroupedOrder S; moe_starts(ws, fi, cnt, S.pstart);
                S.o.init(S.pstart[8], 4, G, (int)blockIdx.x); S.nexp_rows = D; S.rowtok = nullptr;
                EpiScatter E{(bf16_t*)(ws + WS_CONTRIB), (const int*)(ws + WS_ROWDST), (const float*)(ws + WS_ROWGATE), F8_INVD};
                pg8::gemm_phase<EpiScatter, pg8::GroupedOrder, true>(lds, ws + WS_ACT, ws + WS_WDNE8 + (size_t)fi * 8 * D * D_FF_EXP, D_FF_EXP, S, E, tid);
                SEAM(pb + 7); }
        }
        for (int rep = 0; rep < (moe ? (l == 1 ? REPS(15) : 1) : REPS(13)); ++rep) if (SITE(13) && RUN(pb + 10)) { IDS(); ln_phase(ws, P.out, lds, gw, NGW, lane, tid, l * 2 + 1, moe, false, 0, l == 3, moe && rep == 0 && REPS(15) > 1); SEAM(pb + 10); }
    }
#undef RUN
#undef SEAM
#undef IDS
}

extern "C" void kernel_launch(void* const* d_in, const int* in_sizes, int n_in, void* d_out, int out_size, void* d_ws, size_t ws_size, hipStream_t stream) {
    static int grid = 0;
    if (grid == 0) {
        if (n_in != 18 || out_size != MREAL * D || ws_size < WS_END) { fprintf(stderr, "kernel_launch: unexpected shapes (n_in %d, out %d, ws %zu < %zu)\n", n_in, out_size, ws_size, (size_t)WS_END); grid = -1; return; }
        int dev = 0, cus = 0, per_cu = 0;
        if (hipGetDevice(&dev) != hipSuccess || hipDeviceGetAttribute(&cus, hipDeviceAttributeMultiprocessorCount, dev) != hipSuccess) { grid = -1; return; }
        if (hipFuncSetAttribute((const void*)fwd, hipFuncAttributeMaxDynamicSharedMemorySize, LDS_BYTES) != hipSuccess) { fprintf(stderr, "kernel_launch: hipFuncSetAttribute failed\n"); grid = -1; return; }
        if (hipOccupancyMaxActiveBlocksPerMultiprocessor(&per_cu, (const void*)fwd, NTHREADS, LDS_BYTES) != hipSuccess || per_cu < 1) fprintf(stderr, "kernel_launch: occupancy query reports %d\n", per_cu);
        (void)hipGetLastError();
        grid = cus > 256 ? 256 : cus;
    }
    if (grid < 0) return;
    (void)in_sizes;
    if (hipMemsetAsync((char*)d_ws + WS_CTL, 0, CTL_BYTES, stream) != hipSuccess) return;
    Params p{};
    for (int i = 0; i < 18; ++i) p.in[i] = (const float*)d_in[i];
    p.out = (float*)d_out; p.ws = (unsigned char*)d_ws;
#if MK_PER_PHASE
    int li = 0;
    for (int ph = 0; ph < N_PHASES; ++ph) {
        const int k = (ph - 1) % PH_PER_LAYER, l = (ph - 1) / PH_PER_LAYER;
        if (ph > 0) { const bool moe = l & 1; if (k == 2 && l >= 2) continue; if (k == 8 || k == 9 || k == 11) continue; if (k == 7 && !moe) continue; }
        p.ph_lo = ph; p.ph_hi = ph + 1; p.li = li++; p.pad = 0;
        hipLaunchKernelGGL(fwd, dim3(grid), dim3(NTHREADS), LDS_BYTES, stream, p);
    }
#else
    p.ph_lo = 0; p.ph_hi = N_PHASES; p.li = 0; p.pad = 0;
    hipLaunchKernelGGL(fwd, dim3(grid), dim3(NTHREADS), LDS_BYTES, stream, p);
#endif
}
```

```cpp
#include <hip/hip_runtime.h>
#include <cstdio>
#include <cstdint>

#define LAS __attribute__((address_space(3)))
#define GAS __attribute__((address_space(1)))
typedef unsigned short bf16_t;
typedef short bf16x8 __attribute__((ext_vector_type(8)));
typedef float f32x4 __attribute__((ext_vector_type(4)));
typedef float f32x2 __attribute__((ext_vector_type(2)));
typedef unsigned u32x4 __attribute__((ext_vector_type(4)));
typedef unsigned u32x2 __attribute__((ext_vector_type(2)));
typedef int i32x8 __attribute__((ext_vector_type(8)));

constexpr int D = 1024, NBATCH = 4, SEQ = 8192, NMETA = 16;
constexpr int MREAL = NBATCH * SEQ;
constexpr int MV = MREAL + NMETA;
constexpr int MP = 129 * 256;
constexpr int M_HEADS = 8, M_QK = 64, M_V = 128;
constexpr int M_IN = 3088, M_INP = 3328;
constexpr int PROJ_LD = 3072;
constexpr int A_HEADS = 16, A_KV = 4, A_HD = 64, WINDOW = 128;
constexpr int D_FF = 2816, N_EXP = 8, D_FF_EXP = 3584;
constexpr float ALPHA = 1.681792830507429f;
constexpr float LN_EPS = 1e-5f;
constexpr int RP = 265 * 256;
constexpr int NSEG = 8, SEG_CHUNKS = 16;
constexpr int ST_FLOATS = 8 * 5 * 64 * 4;

constexpr size_t MiB = 1u << 20;
constexpr size_t al(size_t x) { return (x + 4095) & ~(size_t)4095; }
constexpr size_t WS_CTL = 0, CTL_BYTES = 1 * MiB;
constexpr size_t WS_WIN = WS_CTL + CTL_BYTES;
constexpr size_t WS_WOUT = WS_WIN + al((size_t)2 * M_INP * D * 2);
constexpr size_t WS_WQKV = WS_WOUT + al((size_t)2 * D * D * 2);
constexpr size_t WS_WQ3 = WS_WQKV + al((size_t)1536 * D * 2);
constexpr size_t WS_WO = WS_WQ3 + al((size_t)D * D * 2);
constexpr size_t WS_WGU = WS_WO + al((size_t)2 * D * D * 2);
constexpr size_t WS_WDN = WS_WGU + al((size_t)2 * 2 * D_FF * D * 2);
constexpr size_t WS_WGUE = WS_WDN + al((size_t)2 * D * D_FF * 2);
constexpr size_t WS_WDNE = WS_WGUE + al((size_t)16 * 2 * D_FF_EXP * D * 2);
constexpr size_t WS_H = WS_WDNE + al((size_t)16 * D * D_FF_EXP * 2);
constexpr size_t WS_HB = WS_H + al((size_t)MP * D * 4);
constexpr size_t WS_PROJ = WS_HB + al((size_t)MP * D * 2);
constexpr size_t WS_HG = WS_PROJ + (size_t)MP * PROJ_LD * 2;
constexpr size_t WS_CONTRIB = WS_PROJ;
constexpr size_t WS_KB = WS_HG + al((size_t)MP * D * 2);
constexpr size_t WS_VB = WS_KB + al((size_t)MP * 256 * 2);
constexpr size_t WS_GATES = WS_VB + al((size_t)MP * 256 * 2);
constexpr size_t WS_ACT = WS_GATES + al((size_t)MP * 16 * 4);
constexpr size_t WS_STATE = WS_ACT + al((size_t)RP * D_FF_EXP * 2);
constexpr size_t WS_STSC = WS_STATE + al((size_t)32 * 7 * ST_FLOATS * 4);
constexpr size_t WS_ROPE = WS_STSC + al((size_t)32 * 7 * 4 * 4);
constexpr size_t WS_TOPE = WS_ROPE + al((size_t)8208 * 16 * 4);
constexpr size_t WS_TOPG = WS_TOPE + al((size_t)MP * 4);
constexpr size_t WS_ROWTOK = WS_TOPG + al((size_t)MP * 8);
constexpr size_t WS_ROWDST = WS_ROWTOK + al((size_t)RP * 4);
constexpr size_t WS_ROWGATE = WS_ROWDST + al((size_t)RP * 4);
constexpr size_t WS_HB8 = WS_ROWGATE + al((size_t)RP * 4);
constexpr size_t WS_WGUE8 = WS_HB8 + al((size_t)MP * D);
constexpr size_t WS_WDNE8 = WS_WGUE8 + al((size_t)16 * 2 * D_FF_EXP * D);
constexpr size_t WS_WDN8 = WS_WDNE8 + al((size_t)16 * D * D_FF_EXP);
constexpr size_t WS_STATS = WS_WDN8 + al((size_t)2 * D * D_FF);
constexpr size_t WS_SMALL = WS_STATS + al((size_t)MP * 8);
constexpr int SM_BGATE = 0, SM_SINKS = 32, SM_BROUTER = 64, SM_LNH = 128, SM_LNG = SM_LNH + 2 * D, SM_LNB = SM_LNG + 8 * D, SM_WROUTER = SM_LNB + 8 * D, SM_END = SM_WROUTER + 2 * D * N_EXP;
constexpr size_t WS_END = WS_SMALL + al((size_t)SM_END * 4);
static_assert((size_t)MP * 2 * D * 4 <= (WS_KB - WS_PROJ), "contrib overlay fits PROJ+HG");
static_assert(WS_END <= (size_t)1792 * MiB, "workspace map exceeds the guaranteed d_ws size");

constexpr int CW_CNT = 1024;
constexpr int CW_CUR = 1024 + 256;
constexpr int CW_CNTG = 4096;
constexpr int CW_BAR = 16384;

constexpr int LDS_BYTES = 163840 - 512;
constexpr int RING_BYTES = 131072;
constexpr int MISC_OFF = LDS_BYTES - 256;

__device__ __forceinline__ unsigned f2bf(float f) { unsigned u = __builtin_bit_cast(unsigned, f); return (u + 0x7fffu + ((u >> 16) & 1u)) >> 16; }
__device__ __forceinline__ unsigned pk2(float lo, float hi) { return f2bf(lo) | (f2bf(hi) << 16); }
__device__ __forceinline__ unsigned cvt_pk_bf16(float lo, float hi) { unsigned r; asm volatile("v_cvt_pk_bf16_f32 %0, %1, %2" : "=v"(r) : "v"(lo), "v"(hi)); return r; }
__device__ __forceinline__ float bf2f(unsigned short b) { return __builtin_bit_cast(float, ((unsigned)b) << 16); }
__device__ __forceinline__ float lx_(float v, int src) { return __builtin_bit_cast(float, __builtin_amdgcn_ds_bpermute(src << 2, __builtin_bit_cast(int, v))); }
__device__ __forceinline__ unsigned lx_(unsigned v, int src) { return (unsigned)__builtin_amdgcn_ds_bpermute(src << 2, (int)v); }
#define SHX(v, o) lx_((v), lane ^ (o))
#define SHUP(v, o) lx_((v), lane >= (o) ? lane - (o) : lane)
#define SHL(v, src) lx_((v), (src))
__device__ __forceinline__ float wave_sum(float v, int lane) {
#pragma unroll
    for (int o = 1; o < 64; o <<= 1) v += SHX(v, o);
    return v;
}
__device__ __forceinline__ float fast_exp(float x) { return __builtin_amdgcn_exp2f(x * 1.4426950408889634f); }
__device__ __forceinline__ unsigned pk4_fp8(float a, float b, float c, float d) {
    a = __builtin_amdgcn_fmed3f(a, -448.f, 448.f); b = __builtin_amdgcn_fmed3f(b, -448.f, 448.f); c = __builtin_amdgcn_fmed3f(c, -448.f, 448.f); d = __builtin_amdgcn_fmed3f(d, -448.f, 448.f);
    int p = __builtin_amdgcn_cvt_pk_fp8_f32(a, b, 0, false); p = __builtin_amdgcn_cvt_pk_fp8_f32(c, d, p, true); return (unsigned)p; }
constexpr float F8_SA = 16.f, F8_SB = 256.f, F8_INV = 1.f / (16.f * 256.f);
constexpr float F8_SACT = 8.f, F8_SBD = 1024.f, F8_INVD = 1.f / (8.f * 1024.f);
#define LDS_WAIT() asm volatile("s_waitcnt lgkmcnt(0)" ::: "memory")
#define VM_WAIT() asm volatile("s_waitcnt vmcnt(0)" ::: "memory")

#define XB_TMO      128
#define XB_XCNT(j)  (256  + 64 * (j))
#define XB_XSUB(j)  (1280 + 64 * (j))
#define XB_XGEN(j)  (2304 + 64 * (j))
#define XB_TOP      3328
#define XB_TOPGEN   3392
#define XCD_BAR_WORDS 3456
#define XB_SPIN_CAP (1u << 18)
__device__ __forceinline__ unsigned xb_ld(unsigned* p)              { return __hip_atomic_load(p, __ATOMIC_RELAXED, __HIP_MEMORY_SCOPE_AGENT); }
__device__ __forceinline__ unsigned xb_add(unsigned* p, unsigned v) { return __hip_atomic_fetch_add(p, v, __ATOMIC_RELAXED, __HIP_MEMORY_SCOPE_AGENT); }
__device__ __forceinline__ unsigned xb_xcc_id() { return (unsigned)__builtin_amdgcn_s_getreg((3 << 11) | 20) & 0xFu; }
#define XB_SPIN(cond, bar) do { unsigned _sp = 0; while (cond) { __builtin_amdgcn_s_sleep(1); \
    if ((++_sp & 255u) == 0u) { if (xb_ld(&(bar)[XB_TMO])) break; if (_sp > XB_SPIN_CAP) { atomicAdd(&(bar)[XB_TMO], 1u); break; } } } } while (0)
struct XcdBarrier { unsigned* bar; unsigned x; volatile LAS unsigned* st; };
__device__ __forceinline__ XcdBarrier xcd_barrier_post(unsigned* bar, volatile LAS unsigned* st) {
    XcdBarrier b; b.bar = bar; b.x = xb_xcc_id(); b.st = st;
    if (threadIdx.x == 0) (void)xb_add(&bar[XB_XCNT(b.x)], 1u);
    return b;
}
__device__ __forceinline__ void xcd_barrier_complete(unsigned* bar, unsigned x, unsigned& nloc, unsigned& nx) {
    const unsigned G = gridDim.x * gridDim.y * gridDim.z;
    unsigned sum, cnt, mine, sp = 0u;
    for (;;) {
        sum = 0u; cnt = 0u; mine = 0u;
#pragma unroll
        for (unsigned j = 0; j < 16; ++j) { const unsigned c = xb_ld(&bar[XB_XCNT(j)]); sum += c; cnt += (c > 0u) ? 1u : 0u; mine = (j == x) ? c : mine; }
        if (sum == G) break;
        __builtin_amdgcn_s_sleep(1);
        if ((++sp & 255u) == 0u) { if (xb_ld(&bar[XB_TMO])) break; if (sp > XB_SPIN_CAP) { atomicAdd(&bar[XB_TMO], 1u); break; } }
    }
    nloc = mine > 0u ? mine : 1u; nx = cnt > 0u ? cnt : 1u;
}
__device__ __forceinline__ void xcd_barrier(const XcdBarrier& b, bool leader  ) {
    asm volatile("s_waitcnt vmcnt(0)" ::: "memory");
    __syncthreads();
    if (leader) {
        unsigned* bar = b.bar;
        __builtin_amdgcn_s_waitcnt(0);
        unsigned nloc = b.st[0], nx = b.st[1];
        if (nloc == 0u) { xcd_barrier_complete(bar, b.x, nloc, nx); b.st[0] = nloc; b.st[1] = nx; }
        const unsigned old = xb_add(&bar[XB_XSUB(b.x)], 1u);
        const unsigned gen = old / nloc;
        if (old + 1u == (gen + 1u) * nloc) {
            __builtin_amdgcn_fence(__ATOMIC_RELEASE, "agent");
            asm volatile("s_waitcnt vmcnt(0)" ::: "memory");
            const unsigned og = xb_add(&bar[XB_TOP], 1u);
            const unsigned tg = og / nx;
            if (og + 1u == (tg + 1u) * nx) xb_add(&bar[XB_TOPGEN], 1u);
            else XB_SPIN(xb_ld(&bar[XB_TOPGEN]) == tg, bar);
            __builtin_amdgcn_fence(__ATOMIC_ACQUIRE, "agent");
            xb_add(&bar[XB_XGEN(b.x)], 1u);
            asm volatile("s_waitcnt vmcnt(0)" ::: "memory");
        } else {
            XB_SPIN(xb_ld(&bar[XB_XGEN(b.x)]) == gen, bar);
            __builtin_amdgcn_fence(__ATOMIC_ACQUIRE, "agent");
            asm volatile("s_waitcnt vmcnt(0)" ::: "memory");
        }
    }
    __syncthreads();
}

namespace pg8 {
constexpr int BM = 256, BK = 64, HALF = 128, HTB = HALF * BK * 2, STAGE_BYTES = 8 * HTB, NXCD = 8, WGM = 8;
__host__ __device__ __forceinline__ int lds_byte(int r, int c) { const int st = (r >> 4) * 2 + (c >> 5), rr = r & 15, cc = c & 31, ob = rr * 64 + cc * 2; return st * 1024 + (ob ^ (((ob >> 9) & 1) << 5)); }
__host__ __device__ __forceinline__ void stage_rc(int b, int& R, int& C) { const int st = b / 1024, sb = b % 1024, swz = sb ^ (((sb >> 9) & 1) << 5); R = (st >> 1) * 16 + swz / 64; C = (st & 1) * 32 + (swz % 64) / 2; }
__host__ __device__ __forceinline__ int perm32(int rho) { const int n = rho >> 4, i = rho & 15; return 8 * (i >> 2) + 4 * n + (i & 3); }

struct Unit { int pm, pn, brow; };

struct DenseOrder {
    int nM, nN, nwg, G, c;
    __device__ void init(int nM_, int nN_, int G_, int c_) { nM = nM_; nN = nN_; nwg = nM * nN; G = G_; c = c_; }
    __device__ __forceinline__ bool next(int i, Unit& u) const {
        const long L = (long)i * G + c; if (L >= nwg) return false;
        int wgid = (int)L; { const int q = nwg / NXCD, r = nwg % NXCD, xcd = wgid % NXCD, off = wgid / NXCD; wgid = (xcd < r ? xcd * (q + 1) : r * (q + 1) + (xcd - r) * q) + off; }
        const int nig = WGM * nN, gid = wgid / nig, fm = gid * WGM, gsz = (nM - fm) < WGM ? (nM - fm) : WGM;
        u.pm = fm + ((wgid % nig) % gsz); u.pn = (wgid % nig) / gsz; u.brow = u.pn * BM; return true;
    }
    __device__ __forceinline__ int a_row(const Unit& u, int r) const { return u.pm * BM + r; }
};
struct GroupedOrder {
    DenseOrder o; int pstart[9]; int nexp_rows;
    const int* rowtok;
    __device__ __forceinline__ bool next(int i, Unit& u) const {
        if (!o.next(i, u)) return false;
        int e = 0;
#pragma unroll
        for (int k = 1; k < 8; ++k) e += (u.pm >= pstart[k]) ? 1 : 0;
        u.brow = e * nexp_rows + u.pn * BM; return true;
    }
    __device__ __forceinline__ int a_row(const Unit& u, int r) const {
        const int pos = u.pm * BM + r; if (!rowtok) return pos;
        const int t = rowtok[pos]; return t < 0 ? 0 : t;
    }
};

template <class Epi, class Sched, bool FP8 = false>
__device__ __forceinline__ void gemm_phase(LAS unsigned char* lds, const void* Abase, const void* Btbase, const int K, const Sched& S, const Epi& E, int tid) {
    constexpr int ES = FP8 ? 1 : 2;
    asm volatile("; opaque tid" : "+v"(tid));
    const int wid = __builtin_amdgcn_readfirstlane(tid >> 6), lane = tid & 63, wr = wid >> 2, wc = wid & 3, fr = lane & 15, fq = lane >> 4;
    const int nt = K * ES / 128;
    unsigned voffB[2];
#pragma unroll
    for (int i = 0; i < 2; ++i) { int R, C; stage_rc(tid * 16 + i * 8192, R, C); const int Rb = Epi::PERM ? ((R & ~31) + perm32(R & 31)) : R; voffB[i] = (unsigned)(Rb * K * ES + C * 2); }
    const size_t kstep = (size_t)128;
    const size_t hstep = (size_t)HALF * K * ES;
    const unsigned ldsw = (unsigned)wid * 1024u;
    const int aoff = FP8 ? lds_byte(wr * 64 + fr, 16 * (fq & 1)) + (fq >> 1) * 1024 : lds_byte(wr * 64 + fr, fq * 8);
    const int boff = FP8 ? lds_byte(wc * 32 + fr, 16 * (fq & 1)) + (fq >> 1) * 1024 : lds_byte(wc * 32 + fr, fq * 8);
#define PG8_SA(b, h) (((b) * 2 + (h)) * HTB)
#define PG8_SB(b, h) ((4 + (b) * 2 + (h)) * HTB)
#define PG8_STAGE(bufoff, gbase, voff) do { const char* _gb = (const char*)(gbase); asm volatile("" : "+s"(_gb)); _Pragma("unroll") for (int _i = 0; _i < 2; ++_i) \
        __builtin_amdgcn_global_load_lds((const unsigned*)(_gb + (voff)[_i]), (LAS unsigned*)(lds + (bufoff) + ldsw + _i * 8192), 16, 0, 0); } while (0)
#define PG8_LDA(dst, b, h) do { _Pragma("unroll") for (int m = 0; m < 4; ++m) _Pragma("unroll") for (int k = 0; k < 2; ++k) dst[m][k] = *(const LAS bf16x8*)(lds + PG8_SA(b, h) + aoff + m * 2048 + k * (FP8 ? 16 : 1024)); } while (0)
#define PG8_LDB(dst, b, h) do { _Pragma("unroll") for (int n = 0; n < 2; ++n) _Pragma("unroll") for (int k = 0; k < 2; ++k) dst[n][k] = *(const LAS bf16x8*)(lds + PG8_SB(b, h) + boff + n * 2048 + k * (FP8 ? 16 : 1024)); } while (0)
#define PG8_MMA(ai, bj, At, Bt) do { __builtin_amdgcn_s_setprio(1); _Pragma("unroll") for (int m = 0; m < 4; ++m) _Pragma("unroll") for (int n = 0; n < 2; ++n) { \
        if constexpr (FP8) { const u32x4 _b0 = __builtin_bit_cast(u32x4, Bt[n][0]), _b1 = __builtin_bit_cast(u32x4, Bt[n][1]), _a0 = __builtin_bit_cast(u32x4, At[m][0]), _a1 = __builtin_bit_cast(u32x4, At[m][1]); \
            const i32x8 _bv = {(int)_b0.x, (int)_b0.y, (int)_b0.z, (int)_b0.w, (int)_b1.x, (int)_b1.y, (int)_b1.z, (int)_b1.w}, _av = {(int)_a0.x, (int)_a0.y, (int)_a0.z, (int)_a0.w, (int)_a1.x, (int)_a1.y, (int)_a1.z, (int)_a1.w}; \
            acc[ai][bj][m][n] = __builtin_amdgcn_mfma_scale_f32_16x16x128_f8f6f4(_bv, _av, acc[ai][bj][m][n], 0, 0, 0, 0x7F7F7F7F, 0, 0x7F7F7F7F); } \
        else { _Pragma("unroll") for (int k = 0; k < 2; ++k) acc[ai][bj][m][n] = __builtin_amdgcn_mfma_f32_16x16x32_bf16(Bt[n][k], At[m][k], acc[ai][bj][m][n], 0, 0, 0); } } \
        __builtin_amdgcn_s_setprio(0); } while (0)
#define PG8_WAIT_V(n) asm volatile("s_waitcnt vmcnt(" #n ")" ::: "memory")
#define PG8_WAIT_L(n) asm volatile("s_waitcnt lgkmcnt(" #n ")" ::: "memory")
#define PG8_BAR __builtin_amdgcn_s_barrier()
#define PG8_SCHED __builtin_amdgcn_sched_barrier(0)
#define PG8_AOFF(dst, u) do { _Pragma("unroll") for (int _i = 0; _i < 2; ++_i) { int _R, _C; stage_rc(tid * 16 + _i * 8192, _R, _C); _Pragma("unroll") for (int _h = 0; _h < 2; ++_h) \
        dst[_h][_i] = (unsigned)((size_t)S.a_row(u, _h * HALF + _R) * K * ES + _C * 2); } } while (0)
    Unit cur, nxt; int ui = 0;
    if (!S.next(0, cur)) return;
    f32x4 acc[2][2][4][2];
#pragma unroll
    for (int a = 0; a < 2; ++a)
#pragma unroll
        for (int b = 0; b < 2; ++b)
#pragma unroll
            for (int m = 0; m < 4; ++m)
#pragma unroll
                for (int n = 0; n < 2; ++n) acc[a][b][m][n] = (f32x4){0.f, 0.f, 0.f, 0.f};
    bf16x8 At[4][2], B0[2][2], B1[2][2];
    unsigned cao[2][2];
    PG8_AOFF(cao, cur);
    const char* cA = (const char*)Abase; const char* cB = (const char*)Btbase + (size_t)cur.brow * K * ES;
    PG8_STAGE(PG8_SB(0, 0), cB, voffB); PG8_STAGE(PG8_SB(0, 1), cB + hstep, voffB); PG8_STAGE(PG8_SA(0, 0), cA, cao[0]); PG8_STAGE(PG8_SA(0, 1), cA, cao[1]);
    if (wr == 1) PG8_BAR;
    PG8_WAIT_V(2); PG8_BAR;
    PG8_STAGE(PG8_SB(1, 0), cB + kstep, voffB); PG8_STAGE(PG8_SA(1, 0), cA + kstep, cao[0]); PG8_STAGE(PG8_SB(1, 1), cB + hstep + kstep, voffB);
    PG8_WAIT_V(6); PG8_BAR;
    for (;;) {
        const bool has_next = S.next(ui + 1, nxt);
        const char* nB = has_next ? (const char*)Btbase + (size_t)nxt.brow * K * ES : cB;
        for (int t = 0; t < nt; t += 2) {
            const bool last = (t == nt - 2);
            const char* a1 = cA + (size_t)(t + 1) * kstep;
            const char* a2 = last ? cA : cA + (size_t)(t + 2) * kstep; const char* b2 = last ? nB : cB + (size_t)(t + 2) * kstep;
            const char* a3 = a2 + kstep; const char* b3 = b2 + kstep;
            PG8_LDB(B0, 0, 0); PG8_LDB(B1, 0, 1); PG8_SCHED; PG8_LDA(At, 0, 0); PG8_STAGE(PG8_SA(1, 1), a1, cao[1]);
            if (last && has_next) { PG8_AOFF(cao, nxt); }
            PG8_WAIT_V(8); PG8_WAIT_L(0); PG8_BAR; PG8_MMA(0, 0, At, B0); PG8_MMA(0, 1, At, B1); PG8_BAR; PG8_SCHED;
            PG8_LDA(At, 0, 1); PG8_STAGE(PG8_SB(0, 0), b2, voffB); PG8_STAGE(PG8_SB(0, 1), b2 + hstep, voffB); PG8_STAGE(PG8_SA(0, 0), a2, cao[0]);
            PG8_WAIT_V(8); PG8_WAIT_L(0); PG8_BAR; PG8_MMA(1, 0, At, B0); PG8_MMA(1, 1, At, B1); PG8_BAR; PG8_SCHED;
            PG8_LDB(B0, 1, 0); PG8_LDB(B1, 1, 1); PG8_SCHED; PG8_LDA(At, 1, 0); PG8_STAGE(PG8_SA(0, 1), a2, cao[1]);
            PG8_WAIT_V(8); PG8_WAIT_L(0); PG8_BAR; PG8_MMA(0, 0, At, B0); PG8_MMA(0, 1, At, B1); PG8_BAR; PG8_SCHED;
            PG8_LDA(At, 1, 1); PG8_STAGE(PG8_SB(1, 0), b3, voffB); PG8_STAGE(PG8_SB(1, 1), b3 + hstep, voffB); PG8_STAGE(PG8_SA(1, 0), a3, cao[0]);
            PG8_WAIT_V(8); PG8_WAIT_L(0); PG8_BAR; PG8_MMA(1, 0, At, B0); PG8_MMA(1, 1, At, B1); PG8_BAR; PG8_SCHED;
        }
        if (wr == 0) PG8_BAR;
#pragma unroll 1
        for (int er = 0; er < Epi::NREP; ++er) E(acc, cur, wr, wc, fr, fq);
        if (!has_next) break;
#pragma unroll
        for (int a = 0; a < 2; ++a)
#pragma unroll
            for (int b = 0; b < 2; ++b)
#pragma unroll
                for (int m = 0; m < 4; ++m)
#pragma unroll
                    for (int n = 0; n < 2; ++n) acc[a][b][m][n] = (f32x4){0.f, 0.f, 0.f, 0.f};
        cur = nxt; cB = nB; ++ui;
        if (wr == 1) PG8_BAR;
    }
    PG8_WAIT_V(0);
    PG8_BAR;
#undef PG8_SA
#undef PG8_SB
#undef PG8_STAGE
#undef PG8_LDA
#undef PG8_LDB
#undef PG8_MMA
#undef PG8_WAIT_V
#undef PG8_WAIT_L
#undef PG8_BAR
#undef PG8_SCHED
#undef PG8_AOFF
}
}

typedef f32x4 AccT[2][2][4][2];

struct EpiProj {
    static constexpr int NREP = 1; static constexpr bool PERM = true;
    bf16_t* proj; float* gates; const float* bgate;
    __device__ __forceinline__ void operator()(const AccT& acc, const pg8::Unit& u, int wr, int wc, int fr, int fq) const {
        const int row0 = u.pm * 256 + wr * 64 + fr;
        if (u.pn < 12) {
            const int col0 = u.pn * 256 + wc * 32 + 8 * fq;
#pragma unroll
            for (int ai = 0; ai < 2; ++ai)
#pragma unroll
                for (int m = 0; m < 4; ++m) { bf16_t* rowp = proj + (size_t)(row0 + ai * 128 + m * 16) * PROJ_LD + col0;
#pragma unroll
                    for (int bj = 0; bj < 2; ++bj) { const f32x4 v0 = acc[ai][bj][m][0], v1 = acc[ai][bj][m][1];
                        u32x4 w; w.x = cvt_pk_bf16(v0[0], v0[1]); w.y = cvt_pk_bf16(v0[2], v0[3]); w.z = cvt_pk_bf16(v1[0], v1[1]); w.w = cvt_pk_bf16(v1[2], v1[3]);
                        *(u32x4*)(rowp + bj * 128) = w; } }
        } else if (wc == 0 && fq < 2) {
#pragma unroll
            for (int n = 0; n < 2; ++n) { const f32x4 bv = *(const f32x4*)(bgate + 8 * fq + 4 * n);
#pragma unroll
                for (int ai = 0; ai < 2; ++ai)
#pragma unroll
                    for (int m = 0; m < 4; ++m) *(f32x4*)(gates + (size_t)(row0 + ai * 128 + m * 16) * 16 + 8 * fq + 4 * n) = acc[ai][0][m][n] + bv; }
        }
    }
};
__device__ __forceinline__ f32x4 bf4_lo(u32x4 w) { return (f32x4){__builtin_bit_cast(float, w.x << 16), __builtin_bit_cast(float, w.x & 0xffff0000u), __builtin_bit_cast(float, w.y << 16), __builtin_bit_cast(float, w.y & 0xffff0000u)}; }
__device__ __forceinline__ f32x4 bf4_hi(u32x4 w) { return (f32x4){__builtin_bit_cast(float, w.z << 16), __builtin_bit_cast(float, w.z & 0xffff0000u), __builtin_bit_cast(float, w.w << 16), __builtin_bit_cast(float, w.w & 0xffff0000u)}; }
struct EpiRes {
    static constexpr int NREP = 1; static constexpr bool PERM = true;
    bf16_t* H; const float* stats; const float* lg; const float* lb; const float* xsrc; float sc;
    __device__ __forceinline__ void operator()(const AccT& acc, const pg8::Unit& u, int wr, int wc, int fr, int fq) const {
        const int row0 = u.pm * 256 + wr * 64 + fr, col0 = u.pn * 256 + wc * 32 + 8 * fq;
        f32x4 gv[2][2], bv[2][2];
        if (lg) {
#pragma unroll
            for (int bj = 0; bj < 2; ++bj)
#pragma unroll
                for (int n = 0; n < 2; ++n) { gv[bj][n] = *(const f32x4*)(lg + col0 + bj * 128 + n * 4); bv[bj][n] = *(const f32x4*)(lb + col0 + bj * 128 + n * 4); } }
#pragma unroll
        for (int ai = 0; ai < 2; ++ai)
#pragma unroll
            for (int m = 0; m < 4; ++m) { const int row = row0 + ai * 128 + m * 16; bf16_t* rowp = H + (size_t)row * D + col0;
                f32x2 st = (f32x2){0.f, 1.f}; if (lg) st = *(const f32x2*)(stats + 2 * (size_t)row);
#pragma unroll
                for (int bj = 0; bj < 2; ++bj) { f32x4 h0, h1;
                    if (lg) { const u32x4 w = *(const u32x4*)(rowp + bj * 128); h0 = (bf4_lo(w) - st.x) * st.y * gv[bj][0] + bv[bj][0]; h1 = (bf4_hi(w) - st.x) * st.y * gv[bj][1] + bv[bj][1]; }
                    else { const float* xp = xsrc + (size_t)row * D + col0 + bj * 128; h0 = *(const f32x4*)xp; h1 = *(const f32x4*)(xp + 4); }
                    const f32x4 o0 = h0 * ALPHA + acc[ai][bj][m][0] * sc, o1 = h1 * ALPHA + acc[ai][bj][m][1] * sc;
                    u32x4 w; w.x = cvt_pk_bf16(o0[0], o0[1]); w.y = cvt_pk_bf16(o0[2], o0[3]); w.z = cvt_pk_bf16(o1[0], o1[1]); w.w = cvt_pk_bf16(o1[2], o1[3]);
                    *(u32x4*)(rowp + bj * 128) = w; } }
    }
};
struct EpiSwiglu {
    static constexpr int NREP = 1; static constexpr bool PERM = true;
    bf16_t* act; int ld; float sc;
    __device__ __forceinline__ static float silu_mul(float g, float u) { return g * u * __builtin_amdgcn_rcpf(1.0f + __builtin_amdgcn_exp2f(-g * 1.4426950408889634f)); }
    __device__ __forceinline__ void operator()(const AccT& acc, const pg8::Unit& u, int wr, int wc, int fr, int fq) const {
        const int row0 = u.pm * 256 + wr * 64 + fr, col0 = u.pn * 128 + wc * 32 + 8 * fq;
#pragma unroll
        for (int ai = 0; ai < 2; ++ai)
#pragma unroll
            for (int m = 0; m < 4; ++m) { const f32x4 g0 = acc[ai][0][m][0] * sc, g1 = acc[ai][0][m][1] * sc, u0 = acc[ai][1][m][0] * sc, u1 = acc[ai][1][m][1] * sc;
                u32x4 w; w.x = cvt_pk_bf16(silu_mul(g0[0], u0[0]), silu_mul(g0[1], u0[1])); w.y = cvt_pk_bf16(silu_mul(g0[2], u0[2]), silu_mul(g0[3], u0[3]));
                w.z = cvt_pk_bf16(silu_mul(g1[0], u1[0]), silu_mul(g1[1], u1[1])); w.w = cvt_pk_bf16(silu_mul(g1[2], u1[2]), silu_mul(g1[3], u1[3]));
                *(u32x4*)(act + (size_t)(row0 + ai * 128 + m * 16) * ld + col0) = w; }
    }
};
struct EpiSwiglu8 {
    static constexpr int NREP = 1; static constexpr bool PERM = true;
    unsigned char* act; int ld; float sc;
    __device__ __forceinline__ void operator()(const AccT& acc, const pg8::Unit& u, int wr, int wc, int fr, int fq) const {
        const int row0 = u.pm * 256 + wr * 64 + fr, col0 = u.pn * 128 + wc * 32 + 8 * fq;
#pragma unroll
        for (int ai = 0; ai < 2; ++ai)
#pragma unroll
            for (int m = 0; m < 4; ++m) { const f32x4 g0 = acc[ai][0][m][0] * sc, g1 = acc[ai][0][m][1] * sc, u0 = acc[ai][1][m][0] * sc, u1 = acc[ai][1][m][1] * sc;
                u32x2 w; w.x = pk4_fp8(EpiSwiglu::silu_mul(g0[0], u0[0]) * F8_SACT, EpiSwiglu::silu_mul(g0[1], u0[1]) * F8_SACT, EpiSwiglu::silu_mul(g0[2], u0[2]) * F8_SACT, EpiSwiglu::silu_mul(g0[3], u0[3]) * F8_SACT);
                w.y = pk4_fp8(EpiSwiglu::silu_mul(g1[0], u1[0]) * F8_SACT, EpiSwiglu::silu_mul(g1[1], u1[1]) * F8_SACT, EpiSwiglu::silu_mul(g1[2], u1[2]) * F8_SACT, EpiSwiglu::silu_mul(g1[3], u1[3]) * F8_SACT);
                *(u32x2*)(act + (size_t)(row0 + ai * 128 + m * 16) * ld + col0) = w; }
    }
};
struct EpiSwigluProbe : EpiSwiglu { static constexpr int NREP = 2; };
struct EpiScatter {
    static constexpr int NREP = 1; static constexpr bool PERM = true;
    bf16_t* contrib; const int* rowdst; const float* rowgate; float sc;
    __device__ __forceinline__ void operator()(const AccT& acc, const pg8::Unit& u, int wr, int wc, int fr, int fq) const {
        const int row0 = u.pm * 256 + wr * 64 + fr, col0 = u.pn * 256 + wc * 32 + 8 * fq;
#pragma unroll
        for (int ai = 0; ai < 2; ++ai)
#pragma unroll
            for (int m = 0; m < 4; ++m) { const int pos = row0 + ai * 128 + m * 16; const int d = rowdst[pos];
                if (d >= 0) { const float g = rowgate[pos] * sc; bf16_t* rowp = contrib + (size_t)d * D + col0;
#pragma unroll
                    for (int bj = 0; bj < 2; ++bj) { const f32x4 v0 = acc[ai][bj][m][0] * g, v1 = acc[ai][bj][m][1] * g;
                        u32x4 w; w.x = cvt_pk_bf16(v0[0], v0[1]); w.y = cvt_pk_bf16(v0[2], v0[3]); w.z = cvt_pk_bf16(v1[0], v1[1]); w.w = cvt_pk_bf16(v1[2], v1[3]);
                        *(u32x4*)(rowp + bj * 128) = w; } } }
    }
};
struct EpiQKV {
    static constexpr int NREP = 1; static constexpr bool PERM = true;
    bf16_t *Q, *KB, *VB; const float* rope;
    __device__ __forceinline__ void operator()(const AccT& acc, const pg8::Unit& u, int wr, int wc, int fr, int fq) const {
        const int row0 = u.pm * 256 + wr * 64 + fr, cl = wc * 32 + 8 * fq, lane = fr | (fq << 4);
        bf16_t* base; int ld;
        if (u.pn == 5) {
#pragma unroll
            for (int ai = 0; ai < 2; ++ai)
#pragma unroll
                for (int m = 0; m < 4; ++m) { const int row = row0 + ai * 128 + m * 16;
#pragma unroll
                    for (int bj = 0; bj < 2; ++bj)
#pragma unroll
                        for (int n = 0; n < 2; ++n)
#pragma unroll
                            for (int j = 0; j < 4; ++j) VB[(size_t)(bj * 128 + cl + 4 * n + j) * MP + row] = (bf16_t)f2bf(acc[ai][bj][m][n][j]); }
            return; }
        if (u.pn < 4) { base = Q + u.pn * 256 + cl; ld = D; } else { base = KB + cl; ld = 256; }
        const bool dorope = (u.pn <= 4) && ((wc & 1) == 0);
#pragma unroll
        for (int ai = 0; ai < 2; ++ai)
#pragma unroll
            for (int m = 0; m < 4; ++m) { const int row = row0 + ai * 128 + m * 16;
                f32x4 v[2][2];
#pragma unroll
                for (int bj = 0; bj < 2; ++bj)
#pragma unroll
                    for (int n = 0; n < 2; ++n) v[bj][n] = acc[ai][bj][m][n];
                if (dorope) {
                    int pos = row < MREAL ? (row & (SEQ - 1)) + NMETA : row - MREAL; pos = pos > SEQ + NMETA - 1 ? SEQ + NMETA - 1 : pos;
                    const float* rp = rope + (size_t)pos * 16;
                    const f32x4 c0 = *(const f32x4*)rp, c1 = *(const f32x4*)(rp + 4), s0 = *(const f32x4*)(rp + 8), s1 = *(const f32x4*)(rp + 12);
#pragma unroll
                    for (int bj = 0; bj < 2; ++bj)
#pragma unroll
                        for (int n = 0; n < 2; ++n) { const f32x4 c = n ? c1 : c0, s = n ? s1 : s0; f32x4 o;
#pragma unroll
                            for (int j = 0; j < 4; ++j) { const float x = v[bj][n][j]; const float y = SHX(x, 16);
                                o[j] = fq == 0 ? x * c[j] - y * s[j] : (fq == 1 ? x * c[j] + y * s[j] : x); }
                            v[bj][n] = o; }
                }
#pragma unroll
                for (int bj = 0; bj < 2; ++bj) { const f32x4 v0 = v[bj][0], v1 = v[bj][1];
                    u32x4 w; w.x = cvt_pk_bf16(v0[0], v0[1]); w.y = cvt_pk_bf16(v0[2], v0[3]); w.z = cvt_pk_bf16(v1[0], v1[1]); w.w = cvt_pk_bf16(v1[2], v1[3]);
                    *(u32x4*)(base + (size_t)row * ld + bj * 128) = w; } }
    }
};

template <int NACC, class F>
__device__ __forceinline__ void skinny_item(const bf16_t* A, int lda, const bf16_t* (&Bt)[NACC], int K, int wave, int lane, LAS unsigned char* lds, int parity, const F& epi) {
    const int fr = lane & 15, quad = lane >> 4, kw = K >> 3;
    const bf16_t* ap = A + (size_t)fr * lda + wave * kw + 8 * quad;
    f32x4 acc[NACC];
#pragma unroll
    for (int i = 0; i < NACC; ++i) acc[i] = (f32x4){0.f, 0.f, 0.f, 0.f};
#pragma unroll 2
    for (int k = 0; k < kw; k += 32) { const bf16x8 a = *(const bf16x8*)(ap + k);
#pragma unroll
        for (int i = 0; i < NACC; ++i) acc[i] = __builtin_amdgcn_mfma_f32_16x16x32_bf16(a, *(const bf16x8*)(Bt[i] + (size_t)fr * K + wave * kw + 8 * quad + k), acc[i], 0, 0, 0); }
    LAS f32x4* red = (LAS f32x4*)(lds + parity * 16384);
#pragma unroll
    for (int i = 0; i < NACC; ++i) red[(wave * NACC + i) * 64 + lane] = acc[i];
    __syncthreads();
    if (wave == 0) {
#pragma unroll
        for (int i = 0; i < NACC; ++i) { f32x4 t = red[i * 64 + lane];
#pragma unroll
            for (int w = 1; w < 8; ++w) t += red[(w * NACC + i) * 64 + lane];
            acc[i] = t; }
        epi(acc, fr, quad);
    }
}

template <int NACC, class F>
__device__ __forceinline__ void skinny_item8(const unsigned char* A, int lda, const unsigned char* (&Bt)[NACC], int K, int wave, int lane, LAS unsigned char* lds, int parity, const F& epi) {
    const int fr = lane & 15, quad = lane >> 4, nblk = K >> 7, b0 = (wave * nblk) >> 3, b1 = ((wave + 1) * nblk) >> 3;
    f32x4 acc[NACC];
#pragma unroll
    for (int i = 0; i < NACC; ++i) acc[i] = (f32x4){0.f, 0.f, 0.f, 0.f};
    for (int kb = b0; kb < b1; ++kb) { const u32x4* ap = (const u32x4*)(A + (size_t)fr * lda + kb * 128 + 32 * quad); const u32x4 a0 = ap[0], a1 = ap[1];
        const i32x8 av = {(int)a0.x, (int)a0.y, (int)a0.z, (int)a0.w, (int)a1.x, (int)a1.y, (int)a1.z, (int)a1.w};
#pragma unroll
        for (int i = 0; i < NACC; ++i) { const u32x4* bp = (const u32x4*)(Bt[i] + (size_t)fr * K + kb * 128 + 32 * quad); const u32x4 q0 = bp[0], q1 = bp[1];
            const i32x8 bv = {(int)q0.x, (int)q0.y, (int)q0.z, (int)q0.w, (int)q1.x, (int)q1.y, (int)q1.z, (int)q1.w};
            acc[i] = __builtin_amdgcn_mfma_scale_f32_16x16x128_f8f6f4(av, bv, acc[i], 0, 0, 0, 0x7F7F7F7F, 0, 0x7F7F7F7F); } }
    LAS f32x4* red = (LAS f32x4*)(lds + parity * 16384);
#pragma unroll
    for (int i = 0; i < NACC; ++i) red[(wave * NACC + i) * 64 + lane] = acc[i];
    __syncthreads();
    if (wave == 0) {
#pragma unroll
        for (int i = 0; i < NACC; ++i) { f32x4 t = red[i * 64 + lane];
#pragma unroll
            for (int w = 1; w < 8; ++w) t += red[(w * NACC + i) * 64 + lane];
            acc[i] = t; }
        epi(acc, fr, quad);
    }
}

struct Params { const float* in[18]; float* out; unsigned char* ws; int ph_lo, ph_hi, li, pad; };
enum { I_X = 0, I_META, I_WIN, I_BGATE, I_LNH, I_WOUT, I_WKV, I_WQ, I_SINKS, I_WO, I_WGUD, I_WDND, I_WROUTER, I_BROUTER, I_WGUE, I_WDNE, I_LNG, I_LNB };
constexpr int NWAVES = 8, NTHREADS = 512;

template <bool F8 = false>
__device__ __forceinline__ void tr_item(const float* W, int Nsrc, int K, void* WTv, int k0, int n0, int drow0, float scale, int nvalid, LAS float* scr, int lane) {
    bf16_t* WT = (bf16_t*)WTv;
    float ld[32];
#pragma unroll
    for (int i = 0; i < 32; ++i) { const int kk = 2 * i + (lane >> 5), n = lane & 31; ld[i] = (n < nvalid) ? W[(size_t)(k0 + kk) * Nsrc + n0 + n] : 0.f; }
#pragma unroll
    for (int i = 0; i < 32; ++i) { const int kk = 2 * i + (lane >> 5), n = lane & 31; scr[kk * 33 + n] = ld[i] * scale; }
    LDS_WAIT(); asm volatile("" ::: "memory");
    const int c = lane & 7;
#pragma unroll
    for (int j = 0; j < 4; ++j) { const int n = (lane >> 3) + 8 * j; const LAS float* s = scr + (8 * c) * 33 + n;
        if constexpr (F8) { u32x2 o; o.x = pk4_fp8(s[0 * 33], s[1 * 33], s[2 * 33], s[3 * 33]); o.y = pk4_fp8(s[4 * 33], s[5 * 33], s[6 * 33], s[7 * 33]);
            if (n < nvalid) *(u32x2*)((unsigned char*)WTv + (size_t)(drow0 + n) * K + k0 + 8 * c) = o; }
        else { u32x4 o; o.x = pk2(s[0 * 33], s[1 * 33]); o.y = pk2(s[2 * 33], s[3 * 33]); o.z = pk2(s[4 * 33], s[5 * 33]); o.w = pk2(s[6 * 33], s[7 * 33]);
            if (n < nvalid) *(u32x4*)(WT + (size_t)(drow0 + n) * K + k0 + 8 * c) = o; } }
    LDS_WAIT(); asm volatile("" ::: "memory");
}
__device__ __forceinline__ int pair_row(int n, int FF) { const int up = n >= FF ? 1 : 0, j = n - up * FF; return 256 * (j >> 7) + 128 * up + (j & 127); }

__device__ __forceinline__ void p0_prologue(const Params& P, LAS unsigned char* lds, int gw, int NGW, int wave, int lane) {
    unsigned char* ws = P.ws;
    LAS float* scr = (LAS float*)(lds + wave * 16384);
    constexpr int IT0 = 16 * 97, IT1 = 16 * 32, IT2 = 16 * 16, IT5 = 16 * 176, IT6 = 44 * 32, IT7 = 16 * 224, IT8 = 56 * 32;
    constexpr int C0 = 2 * IT0, C1 = C0 + 2 * IT1, C2 = C1 + IT2, C3 = C2 + 2 * IT1, C4 = C3 + 2 * IT1, C5 = C4 + 2 * IT5, C6 = C5 + 2 * IT6, C7 = C6 + 16 * IT7, C8 = C7 + 16 * IT8;
    for (int it = gw; it < C8; it += NGW) {
        if (it < C0) { const int mi = it / IT0, r = it % IT0, kb = r / 97, nb = r % 97; const int n0 = nb * 32;
            tr_item(P.in[I_WIN] + (size_t)mi * D * M_IN, M_IN, D, (bf16_t*)(ws + WS_WIN) + (size_t)mi * M_INP * D, kb * 64, n0, n0, n0 < 512 ? 0.125f : 1.f, nb == 96 ? 16 : 32, scr, lane);
        } else if (it < C1) { const int q = it - C0, mi = q / IT1, r = q % IT1, kb = r / 32, nb = r % 32;
            tr_item(P.in[I_WOUT] + (size_t)mi * D * D, D, D, (bf16_t*)(ws + WS_WOUT) + (size_t)mi * D * D, kb * 64, nb * 32, nb * 32, 1.f, 32, scr, lane);
        } else if (it < C2) { const int r = it - C1, kb = r / 16, nb = r % 16;
            tr_item(P.in[I_WKV], 512, D, (bf16_t*)(ws + WS_WQKV), kb * 64, nb * 32, 1024 + nb * 32, 1.f, 32, scr, lane);
        } else if (it < C3) { const int q = it - C2, mi = q / IT1, r = q % IT1, kb = r / 32, nb = r % 32;
            tr_item(P.in[I_WQ] + (size_t)mi * D * D, D, D, (bf16_t*)(ws + (mi ? WS_WQ3 : WS_WQKV)), kb * 64, nb * 32, nb * 32, 0.125f, 32, scr, lane);
        } else if (it < C4) { const int q = it - C3, mi = q / IT1, r = q % IT1, kb = r / 32, nb = r % 32;
            tr_item(P.in[I_WO] + (size_t)mi * D * D, D, D, (bf16_t*)(ws + WS_WO) + (size_t)mi * D * D, kb * 64, nb * 32, nb * 32, 1.f, 32, scr, lane);
        } else if (it < C5) { const int q = it - C4, mi = q / IT5, r = q % IT5, kb = r / 176, nb = r % 176;
            tr_item(P.in[I_WGUD] + (size_t)mi * D * 2 * D_FF, 2 * D_FF, D, (bf16_t*)(ws + WS_WGU) + (size_t)mi * 2 * D_FF * D, kb * 64, nb * 32, pair_row(nb * 32, D_FF), 1.f, 32, scr, lane);
        } else if (it < C6) { const int q = it - C5, mi = q / IT6, r = q % IT6, kb = r / 32, nb = r % 32;
            tr_item<true>(P.in[I_WDND] + (size_t)mi * D_FF * D, D, D_FF, (ws + WS_WDN8) + (size_t)mi * D * D_FF, kb * 64, nb * 32, nb * 32, F8_SBD, 32, scr, lane);
        } else if (it < C7) { const int q = it - C6, mi = q / IT7, r = q % IT7, kb = r / 224, nb = r % 224;
            tr_item<true>(P.in[I_WGUE] + (size_t)mi * D * 2 * D_FF_EXP, 2 * D_FF_EXP, D, (ws + WS_WGUE8) + (size_t)mi * 2 * D_FF_EXP * D, kb * 64, nb * 32, pair_row(nb * 32, D_FF_EXP), F8_SB, 32, scr, lane);
        } else { const int q = it - C7, mi = q / IT8, r = q % IT8, kb = r / 32, nb = r % 32;
            tr_item<true>(P.in[I_WDNE] + (size_t)mi * D_FF_EXP * D, D, D_FF_EXP, (ws + WS_WDNE8) + (size_t)mi * D * D_FF_EXP, kb * 64, nb * 32, nb * 32, F8_SBD, 32, scr, lane);
        }
    }
    { float* sm = (float*)(ws + WS_SMALL); const int gt = gw * 64 + lane, NT = NGW * 64;
      for (int i = gt; i < SM_END; i += NT) { float v = 0.f;
          if (i < SM_SINKS) v = P.in[I_BGATE][i]; else if (i < SM_BROUTER) v = P.in[I_SINKS][i - SM_SINKS]; else if (i < SM_BROUTER + 16) v = P.in[I_BROUTER][i - SM_BROUTER];
          else if (i < SM_LNH) v = 0.f; else if (i < SM_LNG) v = P.in[I_LNH][i - SM_LNH]; else if (i < SM_LNB) v = P.in[I_LNG][i - SM_LNG]; else if (i < SM_WROUTER) v = P.in[I_LNB][i - SM_LNB]; else v = P.in[I_WROUTER][i - SM_WROUTER];
          sm[i] = v; } }
    { bf16_t* HB = (bf16_t*)(ws + WS_HB);
      const size_t gt = (size_t)gw * 64 + lane, NT = (size_t)NGW * 64;
      for (size_t i = gt; i < (size_t)MV * (D / 4); i += NT) { const size_t row = i >> 8; const int c4 = (int)(i & 255);
          const f32x4 v = row < MREAL ? ((const f32x4*)P.in[I_X])[i] : ((const f32x4*)P.in[I_META])[(row - MREAL) * 256 + c4];
          u32x2 w; w.x = pk2(v[0], v[1]); w.y = pk2(v[2], v[3]); ((u32x2*)HB)[i] = w; }
      float* rope = (float*)(ws + WS_ROPE);
      for (size_t i = gt; i < (size_t)(SEQ + NMETA) * 8; i += NT) { const int pos = (int)(i >> 3), fi = (int)(i & 7);
          const double invf = fi == 0 ? 1.0 : fi == 1 ? 0.19392274474868576 : fi == 2 ? 0.03760603093086393 : fi == 3 ? 0.007292664737217109 : fi == 4 ? 0.001414213562373095
                            : fi == 5 ? 0.0002742481756762073 : fi == 6 ? 5.318295896944988e-05 : 1.031338537721246e-05;
          const float angf = (float)pos * (float)invf;
          double a = (double)angf; a -= 6.283185307179586476925 * __builtin_rint(a * 0.15915494309189533577); const double hx = 0.5 * a, h2 = hx * hx;
          double sp = 1.0, cp = 1.0;
#pragma unroll
          for (int k = 12; k >= 1; --k) { sp = 1.0 - sp * h2 / (double)((2 * k) * (2 * k + 1)); cp = 1.0 - cp * h2 / (double)((2 * k - 1) * (2 * k)); }
          const double sh = hx * sp, ch = cp;
          rope[(size_t)pos * 16 + fi] = (float)(1.0 - 2.0 * sh * sh); rope[(size_t)pos * 16 + 8 + fi] = (float)(2.0 * sh * ch); }
    }
}

__device__ __forceinline__ void ln_phase(unsigned char* ws, float* outp, LAS unsigned char* lds, int gw, int NGW, int lane, int tid,
                                         int lnidx, bool moe_src, bool router, int moe_idx, bool final, bool dry = false) {
    const float* sm = (const float*)(ws + WS_SMALL);
    unsigned char* wo = dry ? ws + WS_ACT : ws;
    const bf16_t* H = (const bf16_t*)(ws + WS_H); bf16_t* Hw = dry ? (bf16_t*)(ws + WS_ACT) : (bf16_t*)(ws + WS_H);
    bf16_t* HB = dry ? (bf16_t*)(ws + WS_ACT + 160 * MiB) : (bf16_t*)(ws + WS_HB); const bf16_t* contrib = (const bf16_t*)(ws + WS_CONTRIB);
    const float* stats = (const float*)(ws + WS_STATS); float* statsw = dry ? (float*)(ws + WS_ACT + 240 * MiB) : (float*)(ws + WS_STATS);
    unsigned char* HB8 = dry ? ws + WS_ACT + 250 * MiB : ws + WS_HB8; (void)wo;
    const float* lg = sm + SM_LNG + (size_t)lnidx * D; const float* lb = sm + SM_LNB + (size_t)lnidx * D;
    f32x4 gv[4], bv[4];
#pragma unroll
    for (int j = 0; j < 4; ++j) { gv[j] = *(const f32x4*)(lg + 256 * j + 4 * lane); bv[j] = *(const f32x4*)(lb + 256 * j + 4 * lane); }
    volatile LAS unsigned* misc = (volatile LAS unsigned*)(lds + MISC_OFF);
    f32x4 wra[4][4], wrb[4][4];
    if (router) {
        const float* src = sm + SM_WROUTER + (size_t)moe_idx * D * N_EXP;
#pragma unroll
        for (int j = 0; j < 4; ++j)
#pragma unroll
            for (int c = 0; c < 4; ++c) { const f32x4* w4 = (const f32x4*)(src + (size_t)(256 * j + 4 * lane + c) * 8); wra[j][c] = w4[0]; wrb[j][c] = w4[1]; }
        if (tid < 8) misc[16 + tid] = 0u;
        __syncthreads();
    }
    int* tope = dry ? (int*)(ws + WS_ACT + 300 * MiB) : (int*)(ws + WS_TOPE); float* topg = dry ? (float*)(ws + WS_ACT + 310 * MiB) : (float*)(ws + WS_TOPG);
    const float* br = sm + SM_BROUTER + moe_idx * N_EXP;
    struct RowBuf { u32x2 nv[4], nc0[4], nc1[4]; f32x2 nst; };
    RowBuf rb0, rb1;
    auto fetch = [&](RowBuf& B, int row) {
        u32x2 (&nv)[4] = B.nv; u32x2 (&nc0)[4] = B.nc0; u32x2 (&nc1)[4] = B.nc1; f32x2& nst = B.nst;
        const u32x2* hr = (const u32x2*)(H + (size_t)row * D) + lane;
#pragma unroll
        for (int j = 0; j < 4; ++j) nv[j] = hr[64 * j];
        if (moe_src) { const u32x2* c0 = (const u32x2*)(contrib + (size_t)(2 * row) * D) + lane; const u32x2* c1 = c0 + 256;
#pragma unroll
            for (int j = 0; j < 4; ++j) { nc0[j] = c0[64 * j]; nc1[j] = c1[64 * j]; } }
        nst = *(const f32x2*)(stats + 2 * (size_t)row);
    };
    auto body = [&](RowBuf& B, int row) {
        u32x2 (&nv)[4] = B.nv; u32x2 (&nc0)[4] = B.nc0; u32x2 (&nc1)[4] = B.nc1;
        f32x4 v[4], c0v[4], c1v[4]; const f32x2 st = B.nst;
#pragma unroll
        for (int j = 0; j < 4; ++j) { v[j] = (f32x4){__builtin_bit_cast(float, nv[j].x << 16), __builtin_bit_cast(float, nv[j].x & 0xffff0000u), __builtin_bit_cast(float, nv[j].y << 16), __builtin_bit_cast(float, nv[j].y & 0xffff0000u)};
            c0v[j] = (f32x4){__builtin_bit_cast(float, nc0[j].x << 16), __builtin_bit_cast(float, nc0[j].x & 0xffff0000u), __builtin_bit_cast(float, nc0[j].y << 16), __builtin_bit_cast(float, nc0[j].y & 0xffff0000u)};
            c1v[j] = (f32x4){__builtin_bit_cast(float, nc1[j].x << 16), __builtin_bit_cast(float, nc1[j].x & 0xffff0000u), __builtin_bit_cast(float, nc1[j].y << 16), __builtin_bit_cast(float, nc1[j].y & 0xffff0000u)}; }
        if (row + 2 * NGW < MV) fetch(B, row + 2 * NGW);
        if (moe_src) { const float* pg = lg - D; const float* pb = lb - D;
#pragma unroll
            for (int j = 0; j < 4; ++j) { const f32x4 g1 = *(const f32x4*)(pg + 256 * j + 4 * lane), b1 = *(const f32x4*)(pb + 256 * j + 4 * lane);
                v[j] = ((v[j] - st.x) * st.y * g1 + b1) * ALPHA + c0v[j] + c1v[j]; }
            if (!final) { u32x2* o = (u32x2*)(Hw + (size_t)row * D) + lane;
#pragma unroll
                for (int j = 0; j < 4; ++j) { u32x2 w; w.x = pk2(v[j][0], v[j][1]); w.y = pk2(v[j][2], v[j][3]); o[64 * j] = w;
                    v[j] = (f32x4){__builtin_bit_cast(float, w.x << 16), __builtin_bit_cast(float, w.x & 0xffff0000u), __builtin_bit_cast(float, w.y << 16), __builtin_bit_cast(float, w.y & 0xffff0000u)}; } } }
        float s = 0.f;
#pragma unroll
        for (int j = 0; j < 4; ++j) s += (v[j][0] + v[j][1]) + (v[j][2] + v[j][3]);
        const float mean = wave_sum(s, lane) * (1.f / D); float s2 = 0.f;
#pragma unroll
        for (int j = 0; j < 4; ++j) { v[j] = v[j] - mean; s2 += (v[j][0] * v[j][0] + v[j][1] * v[j][1]) + (v[j][2] * v[j][2] + v[j][3] * v[j][3]); }
        const float rstd = 1.f / sqrtf(wave_sum(s2, lane) * (1.f / D) + LN_EPS);
#pragma unroll
        for (int j = 0; j < 4; ++j) v[j] = v[j] * rstd * gv[j] + bv[j];
        if (final) { if (row < MREAL) { f32x4* o = (f32x4*)(outp + (size_t)row * D) + lane;
#pragma unroll
                for (int j = 0; j < 4; ++j) o[64 * j] = v[j]; } }
        else { if (lane == 0) *(f32x2*)(statsw + 2 * (size_t)row) = (f32x2){mean, rstd};
            if (router) { unsigned* o8 = (unsigned*)(HB8 + (size_t)row * D) + lane;
#pragma unroll
                for (int j = 0; j < 4; ++j) o8[64 * j] = pk4_fp8(v[j][0] * F8_SA, v[j][1] * F8_SA, v[j][2] * F8_SA, v[j][3] * F8_SA); }
            else { u32x2* ob = (u32x2*)(HB + (size_t)row * D) + lane;
#pragma unroll
                for (int j = 0; j < 4; ++j) { u32x2 w; w.x = pk2(v[j][0], v[j][1]); w.y = pk2(v[j][2], v[j][3]); ob[64 * j] = w; } } }
        if (router) {
            f32x4 la = (f32x4){0.f, 0.f, 0.f, 0.f}, lb4 = (f32x4){0.f, 0.f, 0.f, 0.f};
#pragma unroll
            for (int j = 0; j < 4; ++j)
#pragma unroll
                for (int c = 0; c < 4; ++c) { const float x = v[j][c]; la += wra[j][c] * x; lb4 += wrb[j][c] * x; }
            const bool h5 = (lane & 32) != 0, h4 = (lane & 16) != 0, h3 = (lane & 8) != 0;
            f32x4 k4; { const f32x4 send = h5 ? la : lb4, keep = h5 ? lb4 : la; f32x4 got;
#pragma unroll
                for (int i = 0; i < 4; ++i) got[i] = SHX(send[i], 32);
                k4 = keep + got; }
            f32x2 k2; { const f32x2 send = h4 ? (f32x2){k4[0], k4[1]} : (f32x2){k4[2], k4[3]}, keep = h4 ? (f32x2){k4[2], k4[3]} : (f32x2){k4[0], k4[1]};
                k2 = keep + (f32x2){SHX(send[0], 16), SHX(send[1], 16)}; }
            float k1 = (h3 ? k2[1] : k2[0]) + SHX(h3 ? k2[0] : k2[1], 8);
            k1 += SHX(k1, 4); k1 += SHX(k1, 2); k1 += SHX(k1, 1);
            float lg8[8];
#pragma unroll
            for (int e = 0; e < 8; ++e) lg8[e] = SHL(k1, 8 * e) + br[e];
            int e1 = 0; float v1 = lg8[0];
#pragma unroll
            for (int e = 1; e < 8; ++e) if (lg8[e] > v1) { v1 = lg8[e]; e1 = e; }
            int e2 = -1; float v2 = -3.0e38f;
#pragma unroll
            for (int e = 0; e < 8; ++e) if (e != e1 && lg8[e] > v2) { v2 = lg8[e]; e2 = e; }
            const float ex = expf(v2 - v1), g1 = 1.f / (1.f + ex), g2 = ex / (1.f + ex);
            if (lane == 0) { tope[row] = e1 | (e2 << 8); topg[2 * row] = g1; topg[2 * row + 1] = g2;
                __hip_atomic_fetch_add((LAS unsigned*)&misc[16 + e1], 1u, __ATOMIC_RELAXED, __HIP_MEMORY_SCOPE_WORKGROUP);
                __hip_atomic_fetch_add((LAS unsigned*)&misc[16 + e2], 1u, __ATOMIC_RELAXED, __HIP_MEMORY_SCOPE_WORKGROUP); }
        }
    };
    if (gw < MV) fetch(rb0, gw);
    if (gw + NGW < MV) fetch(rb1, gw + NGW);
    for (int row = gw; row < MV; row += 2 * NGW) { body(rb0, row); if (row + NGW < MV) body(rb1, row + NGW); }
    if (router) { __syncthreads();
        if (tid < 8 && !dry) ((unsigned*)(ws + WS_CTL))[CW_CNTG + (moe_idx * 256 + (gw >> 3)) * 8 + tid] = misc[16 + tid];
        __syncthreads(); }
}

__device__ __forceinline__ void moe_starts(const unsigned char* ws, int moe_idx, int (&cnt)[8], int (&pstart)[9]) {
    const unsigned* c = (const unsigned*)(ws + WS_CTL) + CW_CNT + moe_idx * 64; int p = 0;
#pragma unroll
    for (int e = 0; e < 8; ++e) { cnt[e] = __builtin_amdgcn_readfirstlane((int)__hip_atomic_load(c + e, __ATOMIC_RELAXED, __HIP_MEMORY_SCOPE_AGENT)); pstart[e] = p; p += (cnt[e] + 255) >> 8; }
    pstart[8] = p;
}
__device__ __forceinline__ void assign_phase(unsigned char* ws, LAS unsigned char* lds, int gw, int NGW, int lane, int tid, int wave, int moe_idx) {
    const unsigned* cntg = (const unsigned*)(ws + WS_CTL) + CW_CNTG + moe_idx * 256 * 8;
    volatile LAS unsigned* misc = (volatile LAS unsigned*)(lds + MISC_OFF);
    const int vwg = gw >> 3, nwg = NGW >> 3;
    { const int e = wave; unsigned tot = 0, base = 0;
      for (int w = lane; w < nwg; w += 64) { const unsigned c = cntg[w * 8 + e]; tot += c; base += (w < vwg) ? c : 0u; }
#pragma unroll
      for (int o = 1; o < 64; o <<= 1) { tot += SHX(tot, o); base += SHX(base, o); }
      if (lane == 0) { misc[16 + e] = tot; misc[24 + e] = base; misc[32 + e] = 0u; } }
    __syncthreads();
    int cnt[8], pstart[9]; { int p = 0;
#pragma unroll
      for (int e = 0; e < 8; ++e) { cnt[e] = (int)misc[16 + e]; pstart[e] = p; p += (cnt[e] + 255) >> 8; } pstart[8] = p; }
    if (blockIdx.x == 0 && tid < 8) ((unsigned*)(ws + WS_CTL))[CW_CNT + moe_idx * 64 + tid] = misc[16 + tid];
    const int* tope = (const int*)(ws + WS_TOPE); const float* topg = (const float*)(ws + WS_TOPG);
    int* rowtok = (int*)(ws + WS_ROWTOK); int* rowdst = (int*)(ws + WS_ROWDST); float* rowgate = (float*)(ws + WS_ROWGATE);
    { const int row = gw + lane * NGW;
      if (row < MV) { const int te = tope[row];
#pragma unroll
          for (int slot = 0; slot < 2; ++slot) { const int e = (te >> (8 * slot)) & 255; int ps = 0; unsigned mb = 0;
#pragma unroll
              for (int ee = 0; ee < 8; ++ee) if (ee == e) { ps = pstart[ee]; mb = misc[24 + ee]; }
              const unsigned off = __hip_atomic_fetch_add((LAS unsigned*)&misc[32 + e], 1u, __ATOMIC_RELAXED, __HIP_MEMORY_SCOPE_WORKGROUP);
              const int pos = ps * 256 + (int)mb + (int)off;
              rowtok[pos] = row; rowdst[pos] = 2 * row + slot; rowgate[pos] = topg[2 * row + slot]; } } }
    if (blockIdx.x < 8) { const int e = blockIdx.x; int ps = 0, pe = 0, ce = 0;
#pragma unroll
        for (int ee = 0; ee < 8; ++ee) if (ee == e) { ps = pstart[ee]; pe = pstart[ee + 1]; ce = cnt[ee]; }
        for (int pos = ps * 256 + ce + tid; pos < pe * 256; pos += NTHREADS) { rowtok[pos] = -1; rowdst[pos] = -1; rowgate[pos] = 0.f; } }
}

constexpr int ML_RS = 72;
constexpr int ML_QS = 0, ML_KS = 9216, ML_KT = 18432, ML_PS = 27648, ML_VT = 36864, ML_CT = 57600, ML_HS = 78336, ML_SC = 112128;
constexpr int ML_HSS = 132;
constexpr int ML_TAB = 114688, ML_NCH = 17;
constexpr int ML_TSC = ML_TAB + 7 * ML_NCH * 64 * 4;
static_assert(ML_TSC + 1024 <= MISC_OFF, "mLSTM LDS");
__device__ __forceinline__ bf16x8 ml_frag(LAS unsigned char* lds, int base, int row, int kcol) { return *(const LAS bf16x8*)(lds + base + (row * ML_RS + kcol) * 2); }

template <int MODE>
__device__ __forceinline__ void mlstm_phase(unsigned char* ws, LAS unsigned char* lds, int layer, int tid, int wave, int lane) {
    const int item = blockIdx.x; const int bh = item >> 3, seg = item & 7, b = bh >> 3, h = bh & 7;
    if (MODE == 1 && seg == 7) return;
    const bf16_t* proj = (const bf16_t*)(ws + WS_PROJ); const float* gates = (const float*)(ws + WS_GATES);
    bf16_t* HG = (bf16_t*)(ws + WS_HG);
    float* STATE = (float*)(ws + WS_STATE); float* STSC = (float*)(ws + WS_STSC);
    LAS float* sc = (LAS float*)(lds + ML_SC);
    LAS float* tab = (LAS float*)(lds + ML_TAB); LAS float* tsc = (LAS float*)(lds + ML_TSC);
    const int fr = lane & 15, quad = lane >> 4;
    f32x4 st[5]; float zero = 0.f; asm volatile("; opaque zero" : "+v"(zero));
#pragma unroll
    for (int i = 0; i < 5; ++i) st[i] = (f32x4){zero, zero, zero, zero};
    float m0 = (MODE == 1) ? -1.0e30f : 0.f;
    const int nch = SEG_CHUNKS + (seg == 0 ? 1 : 0);
    auto chunk_rows = [&](int ci, int& rbase, int& nv) { if (seg == 0 && ci == 0) { rbase = MREAL; nv = NMETA; } else { const int c = seg * SEG_CHUNKS + ci - (seg == 0 ? 1 : 0); rbase = b * SEQ + c * 64; nv = 64; } };
    for (int i = tid; i < 16 * ML_RS; i += NTHREADS) ((LAS bf16_t*)(lds + ML_VT))[128 * ML_RS + i] = (i < ML_RS) ? (bf16_t)0x3F80 : (bf16_t)0;
    for (int ci = wave; ci < nch; ci += NWAVES) {
        int rbase, nv; chunk_rows(ci, rbase, nv); const bool ok = lane < nv;
        const float li = ok ? gates[(size_t)(rbase + lane) * 16 + h] : -1.0e30f, f = ok ? gates[(size_t)(rbase + lane) * 16 + 8 + h] : 0.f;
        const float lf = ok ? (fminf(f, 0.f) - logf(1.f + expf(-fabsf(f)))) : 0.f;
        float bc = lf;
#pragma unroll
        for (int o = 1; o < 64; o <<= 1) { const float t = SHUP(bc, o); if (lane >= o) bc += t; }
        const float u = li - bc; float pm = u;
#pragma unroll
        for (int o = 1; o < 64; o <<= 1) { const float t = SHUP(pm, o); if (lane >= o) pm = fmaxf(pm, t); }
        tab[(0 * ML_NCH + ci) * 64 + lane] = bc; tab[(1 * ML_NCH + ci) * 64 + lane] = u; tab[(2 * ML_NCH + ci) * 64 + lane] = pm;
        if (lane == 63) { tsc[ci] = bc; tsc[32 + ci] = pm; }
    }
    if (MODE == 2 && seg > 0) {
        m0 = -1.0e30f;
        for (int s2 = 0; s2 < seg; ++s2) {
            const float ms = STSC[(bh * 7 + s2) * 4 + 0], Gs = STSC[(bh * 7 + s2) * 4 + 1];
            const float mn = fmaxf(Gs + m0, ms), fo = fast_exp(Gs + m0 - mn), fn = fast_exp(ms - mn);
            const f32x4* sp = (const f32x4*)(STATE + (size_t)(bh * 7 + s2) * ST_FLOATS) + (wave * 5) * 64 + lane;
#pragma unroll
            for (int i = 0; i < 5; ++i) st[i] = st[i] * fo + sp[i * 64] * fn;
            m0 = mn;
        }
    }
#pragma unroll
    for (int i = 0; i < 5; ++i) { const int dv = (i < 4) ? 16 * wave + fr : 128 + fr, dk = (i < 4) ? 16 * i + 4 * quad : 16 * wave + 4 * quad;
        if (i < 4 || wave < 4) { u32x2 w; w.x = pk2(st[i][0], st[i][1]); w.y = pk2(st[i][2], st[i][3]); *(LAS u32x2*)(lds + ML_CT + (dv * ML_RS + dk) * 2) = w; } }
    __syncthreads();
    if (wave == 0) {
        const float bl = lane < nch ? tsc[lane] : 0.f, um = lane < nch ? tsc[32 + lane] : 0.f; float m = m0, gs = 0.f;
        for (int ci = 0; ci < nch; ++ci) { const float blast = SHL(bl, ci), umax = SHL(um, ci), amax = blast + umax, mn = fmaxf(blast + m, amax);
            if (lane == 0) { tsc[64 + ci] = m; tsc[96 + ci] = fast_exp(blast + m - mn); tsc[128 + ci] = fast_exp(amax - mn); }
            m = mn; gs += blast; }
        if (lane == 0) { tsc[160] = m; tsc[161] = gs; }
    }
    __syncthreads();
    for (int idx = tid; idx < nch * 64; idx += NTHREADS) { const int ci = idx >> 6, j = idx & 63;
        const float bc = tab[(0 * ML_NCH + ci) * 64 + j], u = tab[(1 * ML_NCH + ci) * 64 + j], pm = tab[(2 * ML_NCH + ci) * 64 + j], mc = tsc[64 + ci], MM = fmaxf(pm, mc);
        tab[(3 * ML_NCH + ci) * 64 + j] = MM; tab[(4 * ML_NCH + ci) * 64 + j] = fast_exp(mc - MM); tab[(5 * ML_NCH + ci) * 64 + j] = fast_exp(-(bc + MM));
        tab[(6 * ML_NCH + ci) * 64 + j] = tsc[128 + ci] * fast_exp(u - tsc[32 + ci]); }
    float lnh[16];
    if (MODE == 2) {
#pragma unroll
        for (int e = 0; e < 16; ++e) lnh[e] = ((const float*)(ws + WS_SMALL))[SM_LNH + layer * D + h * M_V + 16 * (tid & 7) + e]; }
    u32x4 rq, rk, rv0, rv1, rg0, rg1;
    auto load_chunk = [&](int ci) {
        int rbase, nv; chunk_rows(ci, rbase, nv);
        if (MODE == 2) { const int i = tid >> 3, sg = tid & 7; const u32x4* ogp = (const u32x4*)(proj + (size_t)(rbase + (i < nv ? i : 0)) * PROJ_LD + 2048 + h * M_V + 16 * sg); rg0 = ogp[0]; rg1 = ogp[1]; }
        { const int j = tid >> 3, c8 = (tid & 7) * 8; const bf16_t* rp = proj + (size_t)(rbase + j) * PROJ_LD + h * 64 + c8;
          rq = (MODE == 2 && j < nv) ? *(const u32x4*)rp : (u32x4){0u, 0u, 0u, 0u}; }
        { const bf16_t* rp = proj + (size_t)(rbase + lane) * PROJ_LD; const bool ok = lane < nv;
          rk = ok ? *(const u32x4*)(rp + 512 + h * 64 + 8 * wave) : (u32x4){0u, 0u, 0u, 0u};
          rv0 = ok ? *(const u32x4*)(rp + 1024 + h * 128 + 16 * wave) : (u32x4){0u, 0u, 0u, 0u}; rv1 = ok ? *(const u32x4*)(rp + 1024 + h * 128 + 16 * wave + 8) : (u32x4){0u, 0u, 0u, 0u}; }
    };
    load_chunk(0);
    __syncthreads();
    for (int ci = 0; ci < nch; ++ci) {
        int rbase, nv; chunk_rows(ci, rbase, nv);
        const u32x4 g0 = rg0, g1 = rg1;
        const LAS float* tU = tab + (1 * ML_NCH + ci) * 64; const LAS float* tMM = tab + (3 * ML_NCH + ci) * 64; const LAS float* tSI = tab + (4 * ML_NCH + ci) * 64;
        const LAS float* tFL = tab + (5 * ML_NCH + ci) * 64; const LAS float* tWP = tab + (6 * ML_NCH + ci) * 64;
        const float sold = tsc[96 + ci];
        { if (MODE == 2) { const int j = tid >> 3, c8 = (tid & 7) * 8; *(LAS u32x4*)(lds + ML_QS + (j * ML_RS + c8) * 2) = rq; }
          const float wj = tWP[lane]; LAS bf16_t* kt = (LAS bf16_t*)(lds + ML_KT); LAS bf16_t* vt = (LAS bf16_t*)(lds + ML_VT);
          if (MODE == 2) *(LAS u32x4*)(lds + ML_KS + (lane * ML_RS + 8 * wave) * 2) = rk;
          const unsigned kk[4] = {rk.x, rk.y, rk.z, rk.w}, a[4] = {rv0.x, rv0.y, rv0.z, rv0.w}, c[4] = {rv1.x, rv1.y, rv1.z, rv1.w};
#pragma unroll
          for (int e = 0; e < 4; ++e) { kt[(8 * wave + 2 * e) * ML_RS + lane] = (bf16_t)f2bf(bf2f((unsigned short)(kk[e] & 0xffffu)) * wj); kt[(8 * wave + 2 * e + 1) * ML_RS + lane] = (bf16_t)f2bf(bf2f((unsigned short)(kk[e] >> 16)) * wj);
              vt[(16 * wave + 2 * e) * ML_RS + lane] = (bf16_t)(a[e] & 0xffffu); vt[(16 * wave + 2 * e + 1) * ML_RS + lane] = (bf16_t)(a[e] >> 16);
              vt[(16 * wave + 8 + 2 * e) * ML_RS + lane] = (bf16_t)(c[e] & 0xffffu); vt[(16 * wave + 8 + 2 * e + 1) * ML_RS + lane] = (bf16_t)(c[e] >> 16); } }
        __syncthreads();
        if (ci + 1 < nch) load_chunk(ci + 1);
        f32x4 o1[4], o2[4];
        if (MODE == 2) {
            const int mt = wave >> 1;
#pragma unroll
            for (int q = 0; q < 2; ++q) { const int nt = 2 * (wave & 1) + q; f32x4 s = (f32x4){0.f, 0.f, 0.f, 0.f};
                if (nt <= mt) {
#pragma unroll
                    for (int ks = 0; ks < 2; ++ks) s = __builtin_amdgcn_mfma_f32_16x16x32_bf16(ml_frag(lds, ML_QS, 16 * mt + fr, 32 * ks + 8 * quad), ml_frag(lds, ML_KS, 16 * nt + fr, 32 * ks + 8 * quad), s, 0, 0, 0); }
                const int j = 16 * nt + fr; const float uj = tU[j];
#pragma unroll
                for (int r = 0; r < 4; ++r) { const int i = 16 * mt + 4 * quad + r; const float p = (j <= i) ? s[r] * fast_exp(uj - tMM[i]) : 0.f;
                    ((LAS bf16_t*)(lds + ML_PS))[i * ML_RS + j] = (bf16_t)f2bf(p); } }
            __syncthreads();
            bf16x8 vb[2], cb[2];
#pragma unroll
            for (int ks = 0; ks < 2; ++ks) { vb[ks] = ml_frag(lds, ML_VT, 16 * wave + fr, 32 * ks + 8 * quad); cb[ks] = ml_frag(lds, ML_CT, 16 * wave + fr, 32 * ks + 8 * quad); }
#pragma unroll
            for (int mt2 = 0; mt2 < 4; ++mt2) { o1[mt2] = (f32x4){0.f, 0.f, 0.f, 0.f}; o2[mt2] = (f32x4){0.f, 0.f, 0.f, 0.f};
#pragma unroll
                for (int ks = 0; ks < 2; ++ks) { o1[mt2] = __builtin_amdgcn_mfma_f32_16x16x32_bf16(ml_frag(lds, ML_PS, 16 * mt2 + fr, 32 * ks + 8 * quad), vb[ks], o1[mt2], 0, 0, 0);
                    o2[mt2] = __builtin_amdgcn_mfma_f32_16x16x32_bf16(ml_frag(lds, ML_QS, 16 * mt2 + fr, 32 * ks + 8 * quad), cb[ks], o2[mt2], 0, 0, 0); } }
            if (wave < 4) { f32x4 d1 = (f32x4){0.f, 0.f, 0.f, 0.f}, d2 = (f32x4){0.f, 0.f, 0.f, 0.f};
#pragma unroll
                for (int ks = 0; ks < 2; ++ks) { d1 = __builtin_amdgcn_mfma_f32_16x16x32_bf16(ml_frag(lds, ML_PS, 16 * wave + fr, 32 * ks + 8 * quad), ml_frag(lds, ML_VT, 128 + fr, 32 * ks + 8 * quad), d1, 0, 0, 0);
                    d2 = __builtin_amdgcn_mfma_f32_16x16x32_bf16(ml_frag(lds, ML_QS, 16 * wave + fr, 32 * ks + 8 * quad), ml_frag(lds, ML_CT, 128 + fr, 32 * ks + 8 * quad), d2, 0, 0, 0); }
                if (fr == 0) {
#pragma unroll
                    for (int r = 0; r < 4; ++r) { const int i = 16 * wave + 4 * quad + r; sc[320 + i] = d1[r] + tSI[i] * d2[r]; } } }
            __syncthreads();
#pragma unroll
            for (int mt2 = 0; mt2 < 4; ++mt2)
#pragma unroll
                for (int r = 0; r < 4; ++r) { const int i = 16 * mt2 + 4 * quad + r; const float num = o1[mt2][r] + tSI[i] * o2[mt2][r];
                    ((LAS float*)(lds + ML_HS))[i * ML_HSS + 16 * wave + fr] = num * __builtin_amdgcn_rcpf(fmaxf(fabsf(sc[320 + i]), tFL[i])); }
        }
        { bf16x8 vb[2];
#pragma unroll
          for (int ks = 0; ks < 2; ++ks) vb[ks] = ml_frag(lds, ML_VT, 16 * wave + fr, 32 * ks + 8 * quad);
#pragma unroll
          for (int mt2 = 0; mt2 < 4; ++mt2) { st[mt2] = st[mt2] * sold;
#pragma unroll
              for (int ks = 0; ks < 2; ++ks) st[mt2] = __builtin_amdgcn_mfma_f32_16x16x32_bf16(ml_frag(lds, ML_KT, 16 * mt2 + fr, 32 * ks + 8 * quad), vb[ks], st[mt2], 0, 0, 0); }
          if (wave < 4) { st[4] = st[4] * sold;
#pragma unroll
              for (int ks = 0; ks < 2; ++ks) st[4] = __builtin_amdgcn_mfma_f32_16x16x32_bf16(ml_frag(lds, ML_KT, 16 * wave + fr, 32 * ks + 8 * quad), ml_frag(lds, ML_VT, 128 + fr, 32 * ks + 8 * quad), st[4], 0, 0, 0); }
          if (MODE == 2) {
#pragma unroll
              for (int i = 0; i < 5; ++i) { const int dv = (i < 4) ? 16 * wave + fr : 128 + fr, dk = (i < 4) ? 16 * i + 4 * quad : 16 * wave + 4 * quad;
                  if (i < 4 || wave < 4) { u32x2 w; w.x = pk2(st[i][0], st[i][1]); w.y = pk2(st[i][2], st[i][3]); *(LAS u32x2*)(lds + ML_CT + (dv * ML_RS + dk) * 2) = w; } } }
        }
        __syncthreads();
        if (MODE == 2) {
            const int i = tid >> 3, sg = tid & 7; const LAS float* hp = (const LAS float*)(lds + ML_HS) + i * ML_HSS + 16 * sg;
            float x[16]; float s = 0.f;
#pragma unroll
            for (int e = 0; e < 16; ++e) { x[e] = hp[e]; s += x[e]; }
            s += SHX(s, 1); s += SHX(s, 2); s += SHX(s, 4);
            const float mean = s * (1.f / M_V); float q = 0.f;
#pragma unroll
            for (int e = 0; e < 16; ++e) { x[e] -= mean; q += x[e] * x[e]; }
            q += SHX(q, 1); q += SHX(q, 2); q += SHX(q, 4);
            const float rstd = 1.f / sqrtf(q * (1.f / M_V) + LN_EPS);
            if (i < nv && (nv == 64 || b == 0)) {
                const size_t row = (size_t)(rbase + i);
                const unsigned gw8[8] = {g0.x, g0.y, g0.z, g0.w, g1.x, g1.y, g1.z, g1.w}; unsigned ow[8];
#pragma unroll
                for (int e = 0; e < 8; ++e) { const float oga = bf2f((unsigned short)(gw8[e] & 0xffffu)), ogb = bf2f((unsigned short)(gw8[e] >> 16));
                    const float ya = x[2 * e] * rstd * lnh[2 * e] * __builtin_amdgcn_rcpf(1.f + fast_exp(-oga)), yb = x[2 * e + 1] * rstd * lnh[2 * e + 1] * __builtin_amdgcn_rcpf(1.f + fast_exp(-ogb));
                    ow[e] = pk2(ya, yb); }
                u32x4* op = (u32x4*)(HG + row * D + h * M_V + 16 * sg);
                op[0] = (u32x4){ow[0], ow[1], ow[2], ow[3]}; op[1] = (u32x4){ow[4], ow[5], ow[6], ow[7]};
            }
        }
    }
    if (MODE == 1) {
        f32x4* sp = (f32x4*)(STATE + (size_t)(bh * 7 + seg) * ST_FLOATS) + (wave * 5) * 64 + lane;
#pragma unroll
        for (int i = 0; i < 5; ++i) sp[i * 64] = (i < 4 || wave < 4) ? st[i] : (f32x4){0.f, 0.f, 0.f, 0.f};
        if (tid == 0) { STSC[(bh * 7 + seg) * 4 + 0] = tsc[160]; STSC[(bh * 7 + seg) * 4 + 1] = tsc[161]; }
    }
}

constexpr int AT_KRS = 72, AT_VRS = 280, AT_NK = 272;
constexpr int AT_KS = 0, AT_VT = AT_NK * AT_KRS * 2, AT_END = AT_VT + 64 * AT_VRS * 2;
static_assert(AT_END <= MISC_OFF, "attention LDS");
__device__ __forceinline__ void attn_phase(unsigned char* ws, LAS unsigned char* lds, int j_layer, int tid, int wave, int lane) {
    const bf16_t* Q = (const bf16_t*)(ws + WS_PROJ); const bf16_t* KB = (const bf16_t*)(ws + WS_KB); const bf16_t* VT = (const bf16_t*)(ws + WS_VB);
    bf16_t* HG = (bf16_t*)(ws + WS_HG);
    const float* sinks = (const float*)(ws + WS_SMALL) + SM_SINKS + j_layer * A_HEADS;
    const int fr = lane & 15, quad = lane >> 4;
    LAS bf16_t* ks = (LAS bf16_t*)(lds + AT_KS); LAS bf16_t* vt = (LAS bf16_t*)(lds + AT_VT);
    u32x4 kreg[5], vreg[5]; bf16x8 qn[2][2];
    const int NREG = NBATCH * A_KV * (SEQ / WINDOW), NIT = NREG + A_KV;
    auto prefetch = [&](int it) {
        const bool meta = it >= NREG; const int b = meta ? 0 : it >> 8, g = meta ? it - NREG : (it >> 6) & 3, blk = meta ? -1 : it & 63;
#pragma unroll
        for (int i = 0; i < 5; ++i) { const int p = tid + i * NTHREADS; kreg[i] = (u32x4){0u, 0u, 0u, 0u}; vreg[i] = (u32x4){0u, 0u, 0u, 0u};
            if (p < AT_NK * 8) { const int kk = p >> 3, c8 = (p & 7) * 8;
                int row; if (kk >= 256) row = MREAL + kk - 256; else { const int tk = (blk - 1) * WINDOW + kk; row = (tk < 0 || meta) ? -1 : b * SEQ + tk; }
                if (row >= 0) kreg[i] = *(const u32x4*)(KB + (size_t)row * 256 + g * 64 + c8);
                const int d = p / 34, pc = p % 34; const bf16_t* src = VT + (size_t)(g * 64 + d) * MP;
                if (pc >= 32) vreg[i] = *(const u32x4*)(src + MREAL + (pc - 32) * 8);
                else { const int tk = (blk - 1) * WINDOW + pc * 8; if (tk >= 0 && !meta) vreg[i] = *(const u32x4*)(src + (size_t)b * SEQ + tk); } } }
    };
    auto qload = [&](int it, int mp) {
        const bool meta = it >= NREG; const int b = it >> 8, g = meta ? it - NREG : (it >> 6) & 3, blk = it & 63, qh = g * 4 + (wave >> 1);
#pragma unroll
        for (int x = 0; x < 2; ++x) { const size_t rowq = meta ? (size_t)MREAL + fr : (size_t)b * SEQ + blk * WINDOW + 16 * (4 * (wave & 1) + 2 * mp + x) + fr;
#pragma unroll
            for (int k2 = 0; k2 < 2; ++k2) qn[x][k2] = *(const bf16x8*)(Q + rowq * D + qh * 64 + 32 * k2 + 8 * quad); }
    };
    if ((int)blockIdx.x < NIT) { prefetch(blockIdx.x); qload(blockIdx.x, 0); }
    for (int it = blockIdx.x; it < NIT; it += gridDim.x) {
        const bool meta = it >= NREG; const int b = it >> 8, g = meta ? it - NREG : (it >> 6) & 3, blk = it & 63;
        __syncthreads();
#pragma unroll
        for (int i = 0; i < 5; ++i) { const int p = tid + i * NTHREADS;
            if (p < AT_NK * 8) { *(LAS u32x4*)(ks + (p >> 3) * AT_KRS + (p & 7) * 8) = kreg[i]; *(LAS u32x4*)(vt + (p / 34) * AT_VRS + (p % 34) * 8) = vreg[i]; } }
        __syncthreads();
        const bool has_next = it + (int)gridDim.x < NIT;
        if (has_next) prefetch(it + gridDim.x);
        const int qh = g * 4 + (wave >> 1); const float sink = sinks[qh];
#pragma unroll 1
        for (int mp = 0; mp < 2; ++mp) {
            if (meta && (mp > 0 || (wave & 1))) continue;
            const int t0 = meta ? 0 : 4 * (wave & 1) + 2 * mp;
            f32x4 s[2][11];
#pragma unroll
            for (int c = 0; c < 11; ++c) { const int kb = (c < 10) ? 16 * (t0 + c) : 256; s[0][c] = (f32x4){0.f, 0.f, 0.f, 0.f}; s[1][c] = (f32x4){0.f, 0.f, 0.f, 0.f};
#pragma unroll
                for (int k2 = 0; k2 < 2; ++k2) { const bf16x8 kf = *(const LAS bf16x8*)(ks + (kb + fr) * AT_KRS + 32 * k2 + 8 * quad);
                    if (c != 9) s[0][c] = __builtin_amdgcn_mfma_f32_16x16x32_bf16(kf, qn[0][k2], s[0][c], 0, 0, 0);
                    if (c != 0) s[1][c] = __builtin_amdgcn_mfma_f32_16x16x32_bf16(kf, qn[1][k2], s[1][c], 0, 0, 0); } }
            if (mp == 0) { if (!meta) qload(it, 1); } else if (has_next) qload(it + gridDim.x, 0);
            float inv[2];
#pragma unroll
            for (int x = 0; x < 2; ++x) {
                float m = sink;
#pragma unroll
                for (int c = 0; c < 10; ++c) { const int rc = c - x;
                    const bool tok = !meta && rc >= 0 && rc <= 8 && (blk > 0 || t0 + c >= 8);
#pragma unroll
                    for (int r = 0; r < 4; ++r) { const bool vis = tok && (rc != 0 || fr < 4 * quad + r) && (rc != 8 || fr >= 4 * quad + r);
                        s[x][c][r] = vis ? s[x][c][r] : -1.0e30f; m = fmaxf(m, s[x][c][r]); } }
#pragma unroll
                for (int r = 0; r < 4; ++r) { const bool vis = !meta || (4 * quad + r <= fr); s[x][10][r] = vis ? s[x][10][r] : -1.0e30f; m = fmaxf(m, s[x][10][r]); }
                m = fmaxf(m, SHX(m, 16)); m = fmaxf(m, SHX(m, 32));
                float sm = 0.f;
#pragma unroll
                for (int c = 0; c < 11; ++c)
#pragma unroll
                    for (int r = 0; r < 4; ++r) { const float p = fast_exp(s[x][c][r] - m); s[x][c][r] = p; sm += p; }
                sm += SHX(sm, 16); sm += SHX(sm, 32);
                inv[x] = 1.f / (sm + fast_exp(sink - m));
            }
            f32x4 o[2][4];
#pragma unroll
            for (int x = 0; x < 2; ++x)
#pragma unroll
                for (int dt = 0; dt < 4; ++dt) o[x][dt] = (f32x4){0.f, 0.f, 0.f, 0.f};
#pragma unroll
            for (int u = 0; u < 6; ++u) {
                const int kb0 = (u < 5) ? 16 * (t0 + 2 * u) : 256, kb1 = (u < 5) ? 16 * (t0 + 2 * u + 1) : 256;
                bf16x8 pf[2];
#pragma unroll
                for (int x = 0; x < 2; ++x) { u32x4 pw;
                    if (u < 5) { pw.x = cvt_pk_bf16(s[x][2 * u][0], s[x][2 * u][1]); pw.y = cvt_pk_bf16(s[x][2 * u][2], s[x][2 * u][3]); pw.z = cvt_pk_bf16(s[x][2 * u + 1][0], s[x][2 * u + 1][1]); pw.w = cvt_pk_bf16(s[x][2 * u + 1][2], s[x][2 * u + 1][3]); }
                    else { pw.x = cvt_pk_bf16(s[x][10][0], s[x][10][1]); pw.y = cvt_pk_bf16(s[x][10][2], s[x][10][3]); pw.z = 0u; pw.w = 0u; }
                    pf[x] = __builtin_bit_cast(bf16x8, pw); }
#pragma unroll
                for (int dt = 0; dt < 4; ++dt) { const LAS bf16_t* vr = vt + (16 * dt + fr) * AT_VRS + 4 * quad;
                    u32x4 vw; const u32x2 a = *(const LAS u32x2*)(vr + kb0), c2 = *(const LAS u32x2*)(vr + kb1); vw.x = a.x; vw.y = a.y; vw.z = c2.x; vw.w = c2.y;
                    const bf16x8 vf = __builtin_bit_cast(bf16x8, vw);
                    o[0][dt] = __builtin_amdgcn_mfma_f32_16x16x32_bf16(vf, pf[0], o[0][dt], 0, 0, 0);
                    o[1][dt] = __builtin_amdgcn_mfma_f32_16x16x32_bf16(vf, pf[1], o[1][dt], 0, 0, 0); } }
#pragma unroll
            for (int x = 0; x < 2; ++x) { if (meta && x > 0) continue;
                const size_t rowq = meta ? (size_t)MREAL + fr : (size_t)b * SEQ + blk * WINDOW + 16 * (t0 + x) + fr;
#pragma unroll
                for (int dt = 0; dt < 4; ++dt) { u32x2 w; w.x = cvt_pk_bf16(o[x][dt][0] * inv[x], o[x][dt][1] * inv[x]); w.y = cvt_pk_bf16(o[x][dt][2] * inv[x], o[x][dt][3] * inv[x]);
                    *(u32x2*)(HG + rowq * D + qh * 64 + 16 * dt + 4 * quad) = w; } }
        }
    }
}

#ifndef SITES
#define SITES 0xFFFF
#endif
#define SITE(n) ((SITES >> (n)) & 1)
#ifndef DUPMASK
#define DUPMASK 0
#endif
#define REPS(n) (1 + ((DUPMASK >> (n)) & 1))
#ifndef MK_PER_PHASE
#define MK_PER_PHASE 0
#endif
constexpr int PH_PER_LAYER = 12, N_PHASES = 1 + 4 * PH_PER_LAYER;

__global__ void __launch_bounds__(NTHREADS, 2) fwd(Params P) {
    extern __shared__ __attribute__((aligned(16))) unsigned char lds_raw[];
    LAS unsigned char* const lds0 = (LAS unsigned char*)lds_raw;
    const int wave_s = __builtin_amdgcn_readfirstlane((int)threadIdx.x >> 6);
    const int G = gridDim.x;
    const int vcu = (G % 8 == 0) ? ((int)blockIdx.x % 8) * (G / 8) + (int)blockIdx.x / 8 : (int)blockIdx.x;
    const int NGW = G * NWAVES;
    unsigned char* const wsbase = P.ws;
    volatile LAS unsigned* misc = (volatile LAS unsigned*)(lds0 + MISC_OFF);
    if (threadIdx.x < 64) misc[threadIdx.x] = 0u;
    __syncthreads();
    XcdBarrier bar = xcd_barrier_post((unsigned*)(wsbase + WS_CTL) + CW_BAR + P.li * 4096, misc + 8);
    const int lo = P.ph_lo, hi = P.ph_hi;
#define RUN(idx) ((idx) >= lo && (idx) < hi)
#define SEAM(idx) do { if ((idx) + 1 < hi) xcd_barrier(bar, tid == 0); } while (0)
#define IDS() unsigned mall = ~0u; asm volatile("; opaque mask" : "+s"(mall)); int tid = wave_s * 64 + (int)__builtin_amdgcn_mbcnt_hi(mall, __builtin_amdgcn_mbcnt_lo(mall, 0u)); asm volatile("; opaque tid" : "+v"(tid));   size_t wsz = 0; asm volatile("; opaque ws offset" : "+s"(wsz)); unsigned char* ws = wsbase + wsz;   \
              LAS unsigned char* lds = lds0; asm volatile("; opaque lds" : "+s"(lds)); \
              const int lane = tid & 63, wave = __builtin_amdgcn_readfirstlane(tid >> 6); const int gw = vcu * NWAVES + wave; (void)lane; (void)gw; (void)ws

    for (int rep = 0; rep < REPS(0); ++rep) if (SITE(0) && RUN(0)) { IDS(); p0_prologue(P, lds, gw, NGW, wave, lane); SEAM(0); }

    for (int l = 0; l < 4; ++l) {
        const int pb = 1 + l * PH_PER_LAYER;
        const bool moe = (l & 1) != 0; const int fi = l >> 1;
        if (l < 2) {
            for (int rep = 0; rep < REPS(1); ++rep) if (SITE(1) && RUN(pb + 0)) {
                IDS();
                pg8::DenseOrder S; S.init(MREAL / 256, 12, G, (int)blockIdx.x);
                EpiProj E{(bf16_t*)(ws + WS_PROJ), (float*)(ws + WS_GATES), (const float*)(ws + WS_SMALL) + SM_BGATE + l * 16};
                const bf16_t* HBp = (const bf16_t*)(ws + WS_HB); const bf16_t* Wp = (const bf16_t*)(ws + WS_WIN) + (size_t)l * M_INP * D;
                pg8::gemm_phase(lds, HBp, Wp, D, S, E, tid);
                bf16_t* PROJ = (bf16_t*)(ws + WS_PROJ); float* GATES = (float*)(ws + WS_GATES); const float* bg = (const float*)(ws + WS_SMALL) + SM_BGATE + l * 16;
                int par = 0;
                for (int item = (int)blockIdx.x; item < 192; item += G, par ^= 1) { const bf16_t* B1[1] = {Wp + (size_t)item * 16 * D};
                    skinny_item<1>(HBp + (size_t)MREAL * D, D, B1, D, wave, lane, lds, par, [&](const f32x4 (&a)[1], int fr, int quad) {
#pragma unroll
                        for (int r = 0; r < 4; ++r) PROJ[(size_t)(MREAL + 4 * quad + r) * PROJ_LD + item * 16 + fr] = (bf16_t)f2bf(a[0][r]); }); }
                { const int fr = lane & 15, quad = lane >> 4; const bf16_t* bp = Wp + (size_t)(3072 + fr) * D + 8 * quad; const float bias = bg[fr];
                  for (int rt = gw; rt < MV / 16; rt += NGW) { const bf16_t* ap = HBp + (size_t)(rt * 16 + fr) * D + 8 * quad;
                      f32x4 a0 = (f32x4){0.f, 0.f, 0.f, 0.f}, a1 = (f32x4){0.f, 0.f, 0.f, 0.f};
#pragma unroll 8
                      for (int k = 0; k < D; k += 64) { a0 = __builtin_amdgcn_mfma_f32_16x16x32_bf16(*(const bf16x8*)(ap + k), *(const bf16x8*)(bp + k), a0, 0, 0, 0);
                          a1 = __builtin_amdgcn_mfma_f32_16x16x32_bf16(*(const bf16x8*)(ap + k + 32), *(const bf16x8*)(bp + k + 32), a1, 0, 0, 0); }
#pragma unroll
                      for (int r = 0; r < 4; ++r) GATES[(size_t)(rt * 16 + 4 * quad + r) * 16 + fr] = a0[r] + a1[r] + bias; } }
                SEAM(pb + 0); }
            for (int rep = 0; rep < REPS(2); ++rep) if (SITE(2) && RUN(pb + 1)) { IDS(); mlstm_phase<1>(ws, lds, l, tid, wave, lane); SEAM(pb + 1); }
            for (int rep = 0; rep < REPS(3); ++rep) if (SITE(3) && RUN(pb + 2)) { IDS(); mlstm_phase<2>(ws, lds, l, tid, wave, lane); SEAM(pb + 2); }
        } else {
            for (int rep = 0; rep < REPS(4); ++rep) if (SITE(4) && RUN(pb + 0)) {
                IDS();
                pg8::DenseOrder S; S.init(MREAL / 256, l == 2 ? 6 : 4, G, (int)blockIdx.x);
                EpiQKV E{(bf16_t*)(ws + WS_PROJ), (bf16_t*)(ws + WS_KB), (bf16_t*)(ws + WS_VB), (const float*)(ws + WS_ROPE)};
                const bf16_t* HBp = (const bf16_t*)(ws + WS_HB); const bf16_t* Wp = (const bf16_t*)(ws + (l == 2 ? WS_WQKV : WS_WQ3));
                pg8::gemm_phase(lds, HBp, Wp, D, S, E, tid);
                bf16_t* Qp = (bf16_t*)(ws + WS_PROJ); bf16_t* KBp = (bf16_t*)(ws + WS_KB); bf16_t* VTp = (bf16_t*)(ws + WS_VB); const float* rope = (const float*)(ws + WS_ROPE);
                int par = 0;
                for (int item = (int)blockIdx.x; item < (l == 2 ? 96 : 64); item += G, par ^= 1) { const bf16_t* B1[1] = {Wp + (size_t)item * 16 * D};
                    skinny_item<1>(HBp + (size_t)MREAL * D, D, B1, D, wave, lane, lds, par, [&](const f32x4 (&a)[1], int fr, int quad) {
                        const int col = item * 16 + fr; const bool dorope = (item < 80) && ((item & 3) == 0);
#pragma unroll
                        for (int r = 0; r < 4; ++r) { const int pos = 4 * quad + r; float x = a[0][r]; const float y = SHX(x, 8);
                            if (dorope) { const float c = rope[pos * 16 + (fr & 7)], sn = rope[pos * 16 + 8 + (fr & 7)]; x = (fr < 8) ? x * c - y * sn : x * c + y * sn; }
                            const bf16_t o = (bf16_t)f2bf(x); const size_t row = (size_t)MREAL + pos;
                            if (item < 64) Qp[row * D + col] = o; else if (item < 80) KBp[row * 256 + col - 1024] = o; else VTp[(size_t)(col - 1280) * MP + row] = o; } });
                }
                SEAM(pb + 0); }
            for (int rep = 0; rep < REPS(5); ++rep) if (SITE(5) && RUN(pb + 1)) { IDS(); attn_phase(ws, lds, l - 2, tid, wave, lane); SEAM(pb + 1); }
        }
        for (int rep = 0; rep < REPS(6); ++rep) if (SITE(6) && RUN(pb + 3)) {
            IDS();
            pg8::DenseOrder S; S.init(MREAL / 256, 4, G, (int)blockIdx.x);
            const float* smp = (const float*)(ws + WS_SMALL);
            EpiRes E{(bf16_t*)(ws + WS_H), (const float*)(ws + WS_STATS), l > 0 ? smp + SM_LNG + (size_t)(2 * l - 1) * D : nullptr, smp + SM_LNB + (size_t)(l > 0 ? 2 * l - 1 : 0) * D, P.in[I_X], 1.f};
            const bf16_t* Ap = (const bf16_t*)(ws + WS_HG); const bf16_t* Wp = (const bf16_t*)(ws + (l < 2 ? WS_WOUT : WS_WO)) + (size_t)(l & 1) * D * D;
            pg8::gemm_phase(lds, Ap, Wp, D, S, E, tid);
            int par = 0;
            for (int item = (int)blockIdx.x; item < 64; item += G, par ^= 1) { const bf16_t* B1[1] = {Wp + (size_t)item * 16 * D};
                skinny_item<1>(Ap + (size_t)MREAL * D, D, B1, D, wave, lane, lds, par, [&](const f32x4 (&a)[1], int fr, int quad) { const int col = item * 16 + fr;
#pragma unroll
                    for (int r = 0; r < 4; ++r) { const size_t row = (size_t)MREAL + 4 * quad + r; float h = E.lg ? bf2f(E.H[row * D + col]) : P.in[I_META][(size_t)(4 * quad + r) * D + col];
                        if (E.lg) h = (h - E.stats[2 * row]) * E.stats[2 * row + 1] * E.lg[col] + E.lb[col];
                        E.H[row * D + col] = (bf16_t)f2bf(h * ALPHA + a[0][r]); } });
            }
            SEAM(pb + 3); }
        for (int rep = 0; rep < (moe ? REPS(14) : REPS(7)); ++rep) if (SITE(7) && RUN(pb + 4)) { IDS(); ln_phase(ws, nullptr, lds, gw, NGW, lane, tid, l * 2 + 0, false, moe, fi, false, moe && rep > 0); SEAM(pb + 4); }
        if (!moe) {
            for (int rep = 0; rep < REPS(8); ++rep) if (SITE(8) && RUN(pb + 5)) {
                IDS();
                pg8::DenseOrder S; S.init(MREAL / 256, 2 * D_FF / 256, G, (int)blockIdx.x);
                EpiSwiglu8 E{ws + WS_ACT, D_FF, 1.f};
                const bf16_t* HBp = (const bf16_t*)(ws + WS_HB); const bf16_t* Wp = (const bf16_t*)(ws + WS_WGU) + (size_t)fi * 2 * D_FF * D;
                pg8::gemm_phase(lds, HBp, Wp, D, S, E, tid);
                int par = 0;
                for (int item = (int)blockIdx.x; item < D_FF / 16; item += G, par ^= 1) {
                    const int brow = 256 * (item >> 3) + 16 * (item & 7); const bf16_t* B2[2] = {Wp + (size_t)brow * D, Wp + (size_t)(brow + 128) * D};
                    skinny_item<2>(HBp + (size_t)MREAL * D, D, B2, D, wave, lane, lds, par, [&](const f32x4 (&a)[2], int fr, int quad) {
#pragma unroll
                        for (int r = 0; r < 4; ++r) E.act[(size_t)(MREAL + 4 * quad + r) * D_FF + item * 16 + fr] = (unsigned char)(pk4_fp8(EpiSwiglu::silu_mul(a[0][r], a[1][r]) * F8_SACT, 0.f, 0.f, 0.f) & 0xffu); });
                }
                SEAM(pb + 5); }
            for (int rep = 0; rep < REPS(9); ++rep) if (SITE(9) && RUN(pb + 6)) {
                IDS();
                pg8::DenseOrder S; S.init(MREAL / 256, 4, G, (int)blockIdx.x);
                const float* smp = (const float*)(ws + WS_SMALL);
                EpiRes E{(bf16_t*)(ws + WS_H), (const float*)(ws + WS_STATS), smp + SM_LNG + (size_t)(2 * l) * D, smp + SM_LNB + (size_t)(2 * l) * D, nullptr, F8_INVD};
                const unsigned char* Ap = ws + WS_ACT; const unsigned char* Wp = ws + WS_WDN8 + (size_t)fi * D * D_FF;
                pg8::gemm_phase<EpiRes, pg8::DenseOrder, true>(lds, Ap, Wp, D_FF, S, E, tid);
                int par = 0;
                for (int item = (int)blockIdx.x; item < 64; item += G, par ^= 1) { const unsigned char* B1[1] = {Wp + (size_t)item * 16 * D_FF};
                    skinny_item8<1>(Ap + (size_t)MREAL * D_FF, D_FF, B1, D_FF, wave, lane, lds, par, [&](const f32x4 (&a)[1], int fr, int quad) { const int col = item * 16 + fr;
#pragma unroll
                        for (int r = 0; r < 4; ++r) { const size_t row = (size_t)MREAL + 4 * quad + r; float h = bf2f(E.H[row * D + col]);
                            h = (h - E.stats[2 * row]) * E.stats[2 * row + 1] * E.lg[col] + E.lb[col];
                            E.H[row * D + col] = (bf16_t)f2bf(h * ALPHA + a[0][r] * E.sc); } });
                }
                SEAM(pb + 6); }
        } else {
            for (int rep = 0; rep < REPS(10); ++rep) if (SITE(10) && RUN(pb + 5)) { IDS(); assign_phase(ws, lds, gw, NGW, lane, tid, wave, fi); SEAM(pb + 5); }
            for (int rep = 0; rep < REPS(11); ++rep) if (SITE(11) && RUN(pb + 6)) {
                IDS();
                int cnt[8]; pg8::GroupedOrder S; moe_starts(ws, fi, cnt, S.pstart);
                S.o.init(S.pstart[8], 2 * D_FF_EXP / 256, G, (int)blockIdx.x); S.nexp_rows = 2 * D_FF_EXP; S.rowtok = (const int*)(ws + WS_ROWTOK);
                EpiSwiglu8 E{ws + WS_ACT, D_FF_EXP, F8_INV};
                pg8::gemm_phase<EpiSwiglu8, pg8::GroupedOrder, true>(lds, ws + WS_HB8, ws + WS_WGUE8 + (size_t)fi * 8 * 2 * D_FF_EXP * D, D, S, E, tid);
                SEAM(pb + 6); }
            for (int rep = 0; rep < REPS(12); ++rep) if (SITE(12) && RUN(pb + 7)) {
                IDS();
                int cnt[8]; pg8::GroupedOrder S; moe_starts(ws, fi, cnt, S.pstart);
                S.o.init(S.pstart[8], 4, G, (int)blockIdx.x); S.nexp_rows = D; S.rowtok = nullptr;
                EpiScatter E{(bf16_t*)(ws + WS_CONTRIB), (const int*)(ws + WS_ROWDST), (const float*)(ws + WS_ROWGATE), F8_INVD};
                pg8::gemm_phase<EpiScatter, pg8::GroupedOrder, true>(lds, ws + WS_ACT, ws + WS_WDNE8 + (size_t)fi * 8 * D * D_FF_EXP, D_FF_EXP, S, E, tid);
                SEAM(pb + 7); }
        }
        for (int rep = 0; rep < (moe ? (l == 1 ? REPS(15) : 1) : REPS(13)); ++rep) if (SITE(13) && RUN(pb + 10)) { IDS(); ln_phase(ws, P.out, lds, gw, NGW, lane, tid, l * 2 + 1, moe, false, 0, l == 3, moe && rep == 0 && REPS(15) > 1); SEAM(pb + 10); }
    }
#undef RUN
#undef SEAM
#undef IDS
}

extern "C" void kernel_launch(void* const* d_in, const int* in_sizes, int n_in, void* d_out, int out_size, void* d_ws, size_t ws_size, hipStream_t stream) {
    static int grid = 0;
    if (grid == 0) {
        if (n_in != 18 || out_size != MREAL * D || ws_size < WS_END) { fprintf(stderr, "kernel_launch: unexpected shapes (n_in %d, out %d, ws %zu < %zu)\n", n_in, out_size, ws_size, (size_t)WS_END); grid = -1; return; }
        int dev = 0, cus = 0, per_cu = 0;
        if (hipGetDevice(&dev) != hipSuccess || hipDeviceGetAttribute(&cus, hipDeviceAttributeMultiprocessorCount, dev) != hipSuccess) { grid = -1; return; }
        if (hipFuncSetAttribute((const void*)fwd, hipFuncAttributeMaxDynamicSharedMemorySize, LDS_BYTES) != hipSuccess) { fprintf(stderr, "kernel_launch: hipFuncSetAttribute failed\n"); grid = -1; return; }
        if (hipOccupancyMaxActiveBlocksPerMultiprocessor(&per_cu, (const void*)fwd, NTHREADS, LDS_BYTES) != hipSuccess || per_cu < 1) fprintf(stderr, "kernel_launch: occupancy query reports %d\n", per_cu);
        (void)hipGetLastError();
        grid = cus > 256 ? 256 : cus;
    }
    if (grid < 0) return;
    (void)in_sizes;
    if (hipMemsetAsync((char*)d_ws + WS_CTL, 0, CTL_BYTES, stream) != hipSuccess) return;
    Params p{};
    for (int i = 0; i < 18; ++i) p.in[i] = (const float*)d_in[i];
    p.out = (float*)d_out; p.ws = (unsigned char*)d_ws;
#if MK_PER_PHASE
    int li = 0;
    for (int ph = 0; ph < N_PHASES; ++ph) {
        const int k = (ph - 1) % PH_PER_LAYER, l = (ph - 1) / PH_PER_LAYER;
        if (ph > 0) { const bool moe = l & 1; if (k == 2 && l >= 2) continue; if (k == 8 || k == 9 || k == 11) continue; if (k == 7 && !moe) continue; }
        p.ph_lo = ph; p.ph_hi = ph + 1; p.li = li++; p.pad = 0;
        hipLaunchKernelGGL(fwd, dim3(grid), dim3(NTHREADS), LDS_BYTES, stream, p);
    }
#else
    p.ph_lo = 0; p.ph_hi = N_PHASES; p.li = 0; p.pad = 0;
    hipLaunchKernelGGL(fwd, dim3(grid), dim3(NTHREADS), LDS_BYTES, stream, p);
#endif
}
```

```cpp
#include <hip/hip_runtime.h>
#include <cstdio>
#include <cstdint>

#define LAS __attribute__((address_space(3)))
#define GAS __attribute__((address_space(1)))
typedef unsigned short bf16_t;
typedef short bf16x8 __attribute__((ext_vector_type(8)));
typedef float f32x4 __attribute__((ext_vector_type(4)));
typedef float f32x2 __attribute__((ext_vector_type(2)));
typedef unsigned u32x4 __attribute__((ext_vector_type(4)));
typedef unsigned u32x2 __attribute__((ext_vector_type(2)));
typedef int i32x8 __attribute__((ext_vector_type(8)));
typedef int i32x4 __attribute__((ext_vector_type(4)));

constexpr int D = 1024, NBATCH = 4, SEQ = 8192, NMETA = 16;
constexpr int MREAL = NBATCH * SEQ;
constexpr int MV = MREAL + NMETA;
constexpr int MP = 129 * 256;
constexpr int M_HEADS = 8, M_QK = 64, M_V = 128;
constexpr int M_IN = 3088, M_INP = 3328;
constexpr int PROJ_LD = 3072;
constexpr int A_HEADS = 16, A_KV = 4, A_HD = 64, WINDOW = 128;
constexpr int D_FF = 2816, N_EXP = 8, D_FF_EXP = 3584;
constexpr float ALPHA = 1.681792830507429f;
constexpr float LN_EPS = 1e-5f;
constexpr int RP = 265 * 256;
constexpr int NSEG = 8, SEG_CHUNKS = 16;
constexpr int ST_FLOATS = 8 * 5 * 64 * 4;

constexpr size_t MiB = 1u << 20;
constexpr size_t al(size_t x) { return (x + 4095) & ~(size_t)4095; }
constexpr size_t WS_CTL = 0, CTL_BYTES = 1 * MiB;
constexpr size_t WS_WIN = WS_CTL + CTL_BYTES;
constexpr size_t WS_WOUT = WS_WIN + al((size_t)2 * M_INP * D * 2);
constexpr size_t WS_WQKV = WS_WOUT + al((size_t)2 * D * D * 2);
constexpr size_t WS_WQ3 = WS_WQKV + al((size_t)1536 * D * 2);
constexpr size_t WS_WO = WS_WQ3 + al((size_t)D * D * 2);
constexpr size_t WS_WGU = WS_WO + al((size_t)2 * D * D * 2);
constexpr size_t WS_WDN = WS_WGU + al((size_t)2 * 2 * D_FF * D * 2);
constexpr size_t WS_WGUE = WS_WDN + al((size_t)2 * D * D_FF * 2);
constexpr size_t WS_WDNE = WS_WGUE + al((size_t)16 * 2 * D_FF_EXP * D * 2);
constexpr size_t WS_H = WS_WDNE + al((size_t)16 * D * D_FF_EXP * 2);
constexpr size_t WS_HB = WS_H + al((size_t)MP * D * 4);
constexpr size_t WS_PROJ = WS_HB + al((size_t)MP * D * 2);
constexpr size_t WS_HG = WS_PROJ + (size_t)MP * PROJ_LD * 2;
constexpr size_t WS_CONTRIB = WS_PROJ;
constexpr size_t WS_KB = WS_HG + al((size_t)MP * D * 2);
constexpr size_t WS_VB = WS_KB + al((size_t)MP * 256 * 2);
constexpr size_t WS_GATES = WS_VB + al((size_t)MP * 256 * 2);
constexpr size_t WS_ACT = WS_GATES + al((size_t)MP * 16 * 4);
constexpr size_t WS_STATE = WS_ACT + al((size_t)RP * D_FF_EXP * 2);
constexpr size_t WS_STSC = WS_STATE + al((size_t)32 * 7 * ST_FLOATS * 4);
constexpr size_t WS_ROPE = WS_STSC + al((size_t)32 * 7 * 4 * 4);
constexpr size_t WS_TOPE = WS_ROPE + al((size_t)8208 * 16 * 4);
constexpr size_t WS_TOPG = WS_TOPE + al((size_t)MP * 4);
constexpr size_t WS_ROWTOK = WS_TOPG + al((size_t)MP * 8);
constexpr size_t WS_ROWDST = WS_ROWTOK + al((size_t)RP * 4);
constexpr size_t WS_ROWGATE = WS_ROWDST + al((size_t)RP * 4);
constexpr size_t WS_HB8 = WS_ROWGATE + al((size_t)RP * 4);
constexpr size_t WS_WGUE8 = WS_HB8 + al((size_t)MP * D);
constexpr size_t WS_WDNE8 = WS_WGUE8 + al((size_t)16 * 2 * D_FF_EXP * D);
constexpr size_t WS_WDN8 = WS_WDNE8 + al((size_t)16 * D * D_FF_EXP);
constexpr size_t WS_WGU8 = WS_WDN8 + al((size_t)2 * D * D_FF);
constexpr size_t WS_ROWSC = WS_WGU8 + al((size_t)2 * 2 * D_FF * D);
constexpr size_t WS_WO8 = WS_ROWSC + al((size_t)MP * 4);
constexpr size_t WS_WQKV8 = WS_WO8 + al((size_t)2 * D * D);
constexpr size_t WS_WIN8 = WS_WQKV8 + al((size_t)2560 * D);
constexpr size_t WS_STATS = WS_WIN8 + al((size_t)2 * 3072 * D);
constexpr size_t WS_SMALL = WS_STATS + al((size_t)MP * 8);
constexpr int SM_BGATE = 0, SM_SINKS = 32, SM_BROUTER = 64, SM_LNH = 128, SM_LNG = SM_LNH + 2 * D, SM_LNB = SM_LNG + 8 * D, SM_WROUTER = SM_LNB + 8 * D, SM_WSCALE = SM_WROUTER + 2 * D * N_EXP, SM_ASCALE = SM_WSCALE + 24, SM_END = SM_WSCALE + 32;
constexpr size_t WS_END = WS_SMALL + al((size_t)SM_END * 4);
static_assert((size_t)MP * 2 * D * 4 <= (WS_KB - WS_PROJ), "contrib overlay fits PROJ+HG");
static_assert(WS_END <= (size_t)1792 * MiB, "workspace map exceeds the guaranteed d_ws size");

constexpr int CW_CNT = 1024;
constexpr int CW_CUR = 1024 + 256;
constexpr int CW_AMAX = 2560;
constexpr int CW_ITEM = 3072;
constexpr int CW_CNTG = 4096;
constexpr int CW_BAR = 16384;

constexpr int LDS_BYTES = 163840 - 512;
constexpr int RING_BYTES = 131072;
constexpr int MISC_OFF = LDS_BYTES - 256;

__device__ __forceinline__ unsigned f2bf(float f) { unsigned u = __builtin_bit_cast(unsigned, f); return (u + 0x7fffu + ((u >> 16) & 1u)) >> 16; }
__device__ __forceinline__ unsigned pk2(float lo, float hi) { return f2bf(lo) | (f2bf(hi) << 16); }
__device__ __forceinline__ unsigned cvt_pk_bf16(float lo, float hi) { unsigned r; asm volatile("v_cvt_pk_bf16_f32 %0, %1, %2" : "=v"(r) : "v"(lo), "v"(hi)); return r; }
__device__ __forceinline__ float bf2f(unsigned short b) { return __builtin_bit_cast(float, ((unsigned)b) << 16); }
__device__ __forceinline__ float lx_(float v, int src) { return __builtin_bit_cast(float, __builtin_amdgcn_ds_bpermute(src << 2, __builtin_bit_cast(int, v))); }
__device__ __forceinline__ unsigned lx_(unsigned v, int src) { return (unsigned)__builtin_amdgcn_ds_bpermute(src << 2, (int)v); }
#define SHX(v, o) lx_((v), lane ^ (o))
#define SHUP(v, o) lx_((v), lane >= (o) ? lane - (o) : lane)
#define SHL(v, src) lx_((v), (src))
__device__ __forceinline__ float wave_sum(float v, int lane) {
#pragma unroll
    for (int o = 1; o < 64; o <<= 1) v += SHX(v, o);
    return v;
}
__device__ __forceinline__ float fast_exp(float x) { return __builtin_amdgcn_exp2f(x * 1.4426950408889634f); }
__device__ __forceinline__ unsigned pk4_fp8(float a, float b, float c, float d) {
    a = __builtin_amdgcn_fmed3f(a, -448.f, 448.f); b = __builtin_amdgcn_fmed3f(b, -448.f, 448.f); c = __builtin_amdgcn_fmed3f(c, -448.f, 448.f); d = __builtin_amdgcn_fmed3f(d, -448.f, 448.f);
    int p = __builtin_amdgcn_cvt_pk_fp8_f32(a, b, 0, false); p = __builtin_amdgcn_cvt_pk_fp8_f32(c, d, p, true); return (unsigned)p; }
constexpr float F8_SA = 16.f, F8_SB = 256.f, F8_INV = 1.f / (16.f * 256.f);
constexpr float F8_SACT = 8.f, F8_SBD = 1024.f, F8_INVD = 1.f / (8.f * 1024.f);
constexpr float F8_SO = 32.f, F8_SWO = 512.f, F8_INVO = 1.f / (32.f * 512.f);
#define LDS_WAIT() asm volatile("s_waitcnt lgkmcnt(0)" ::: "memory")
#define VM_WAIT() asm volatile("s_waitcnt vmcnt(0)" ::: "memory")

#define XB_TMO      128
#define XB_XCNT(j)  (256  + 64 * (j))
#define XB_XSUB(j)  (1280 + 64 * (j))
#define XB_XGEN(j)  (2304 + 64 * (j))
#define XB_TOP      3328
#define XB_TOPGEN   3392
#define XCD_BAR_WORDS 3456
#define XB_SPIN_CAP (1u << 18)
__device__ __forceinline__ unsigned xb_ld(unsigned* p)              { return __hip_atomic_load(p, __ATOMIC_RELAXED, __HIP_MEMORY_SCOPE_AGENT); }
__device__ __forceinline__ unsigned xb_add(unsigned* p, unsigned v) { return __hip_atomic_fetch_add(p, v, __ATOMIC_RELAXED, __HIP_MEMORY_SCOPE_AGENT); }
__device__ __forceinline__ unsigned xb_xcc_id() { return (unsigned)__builtin_amdgcn_s_getreg((3 << 11) | 20) & 0xFu; }
#define XB_SPIN(cond, bar) do { unsigned _sp = 0; while (cond) { __builtin_amdgcn_s_sleep(1); \
    if ((++_sp & 255u) == 0u) { if (xb_ld(&(bar)[XB_TMO])) break; if (_sp > XB_SPIN_CAP) { atomicAdd(&(bar)[XB_TMO], 1u); break; } } } } while (0)
struct XcdBarrier { unsigned* bar; unsigned x; volatile LAS unsigned* st; };
__device__ __forceinline__ XcdBarrier xcd_barrier_post(unsigned* bar, volatile LAS unsigned* st) {
    XcdBarrier b; b.bar = bar; b.x = xb_xcc_id(); b.st = st;
    if (threadIdx.x == 0) (void)xb_add(&bar[XB_XCNT(b.x)], 1u);
    return b;
}
__device__ __forceinline__ void xcd_barrier_complete(unsigned* bar, unsigned x, unsigned& nloc, unsigned& nx) {
    const unsigned G = gridDim.x * gridDim.y * gridDim.z;
    unsigned sum, cnt, mine, sp = 0u;
    for (;;) {
        sum = 0u; cnt = 0u; mine = 0u;
#pragma unroll
        for (unsigned j = 0; j < 16; ++j) { const unsigned c = xb_ld(&bar[XB_XCNT(j)]); sum += c; cnt += (c > 0u) ? 1u : 0u; mine = (j == x) ? c : mine; }
        if (sum == G) break;
        __builtin_amdgcn_s_sleep(1);
        if ((++sp & 255u) == 0u) { if (xb_ld(&bar[XB_TMO])) break; if (sp > XB_SPIN_CAP) { atomicAdd(&bar[XB_TMO], 1u); break; } }
    }
    nloc = mine > 0u ? mine : 1u; nx = cnt > 0u ? cnt : 1u;
}
__device__ __forceinline__ void xcd_barrier(const XcdBarrier& b, bool leader  ) {
    asm volatile("s_waitcnt vmcnt(0)" ::: "memory");
    __syncthreads();
    if (leader) {
        unsigned* bar = b.bar;
        __builtin_amdgcn_s_waitcnt(0);
        unsigned nloc = b.st[0], nx = b.st[1];
        if (nloc == 0u) { xcd_barrier_complete(bar, b.x, nloc, nx); b.st[0] = nloc; b.st[1] = nx; }
        const unsigned old = xb_add(&bar[XB_XSUB(b.x)], 1u);
        const unsigned gen = old / nloc;
        if (old + 1u == (gen + 1u) * nloc) {
            __builtin_amdgcn_fence(__ATOMIC_RELEASE, "agent");
            asm volatile("s_waitcnt vmcnt(0)" ::: "memory");
            const unsigned og = xb_add(&bar[XB_TOP], 1u);
            const unsigned tg = og / nx;
            if (og + 1u == (tg + 1u) * nx) xb_add(&bar[XB_TOPGEN], 1u);
            else XB_SPIN(xb_ld(&bar[XB_TOPGEN]) == tg, bar);
            __builtin_amdgcn_fence(__ATOMIC_ACQUIRE, "agent");
            xb_add(&bar[XB_XGEN(b.x)], 1u);
            asm volatile("s_waitcnt vmcnt(0)" ::: "memory");
        } else {
            XB_SPIN(xb_ld(&bar[XB_XGEN(b.x)]) == gen, bar);
            __builtin_amdgcn_fence(__ATOMIC_ACQUIRE, "agent");
            asm volatile("s_waitcnt vmcnt(0)" ::: "memory");
        }
    }
    __syncthreads();
}

namespace pg8 {
constexpr int BM = 256, BK = 64, HALF = 128, HTB = HALF * BK * 2, STAGE_BYTES = 8 * HTB, NXCD = 8, WGM = 8;
__host__ __device__ __forceinline__ int lds_byte(int r, int c) { const int st = (r >> 4) * 2 + (c >> 5), rr = r & 15, cc = c & 31, ob = rr * 64 + cc * 2; return st * 1024 + (ob ^ (((ob >> 9) & 1) << 5)); }
__host__ __device__ __forceinline__ void stage_rc(int b, int& R, int& C) { const int st = b / 1024, sb = b % 1024, swz = sb ^ (((sb >> 9) & 1) << 5); R = (st >> 1) * 16 + swz / 64; C = (st & 1) * 32 + (swz % 64) / 2; }
__host__ __device__ __forceinline__ int perm32(int rho) { const int n = rho >> 4, i = rho & 15; return 8 * (i >> 2) + 4 * n + (i & 3); }

struct Unit { int pm, pn, brow; };

struct DenseOrder {
    int nM, nN, nwg, G, c;
    __device__ void init(int nM_, int nN_, int G_, int c_) { nM = nM_; nN = nN_; nwg = nM * nN; G = G_; c = c_; }
    __device__ __forceinline__ bool next(int i, Unit& u) const {
        const long L = (long)i * G + c; if (L >= nwg) return false;
        int wgid = (int)L; { const int q = nwg / NXCD, r = nwg % NXCD, xcd = wgid % NXCD, off = wgid / NXCD; wgid = (xcd < r ? xcd * (q + 1) : r * (q + 1) + (xcd - r) * q) + off; }
        const int nig = WGM * nN, gid = wgid / nig, fm = gid * WGM, gsz = (nM - fm) < WGM ? (nM - fm) : WGM;
        u.pm = fm + ((wgid % nig) % gsz); u.pn = (wgid % nig) / gsz; u.brow = u.pn * BM; return true;
    }
    __device__ __forceinline__ int a_row(const Unit& u, int r) const { return u.pm * BM + r; }
};
struct GroupedOrder {
    DenseOrder o; int pstart[9]; int nexp_rows;
    const int* rowtok;
    __device__ __forceinline__ bool next(int i, Unit& u) const {
        if (!o.next(i, u)) return false;
        int e = 0;
#pragma unroll
        for (int k = 1; k < 8; ++k) e += (u.pm >= pstart[k]) ? 1 : 0;
        u.brow = e * nexp_rows + u.pn * BM; return true;
    }
    __device__ __forceinline__ int a_row(const Unit& u, int r) const {
        const int pos = u.pm * BM + r; if (!rowtok) return pos;
        const int t = rowtok[pos]; return t < 0 ? 0 : t;
    }
};

template <class Epi, class Sched, int MODE = 0>
__device__ __forceinline__ void gemm_phase(LAS unsigned char* lds, const void* Abase, const void* Btbase, const int K, const Sched& S, const Epi& E, int tid) {
    constexpr int ES = MODE ? 1 : 2;
    constexpr bool FP8 = (MODE == 1);
    asm volatile("; opaque tid" : "+v"(tid));
    const int wid = __builtin_amdgcn_readfirstlane(tid >> 6), lane = tid & 63, wr = wid >> 2, wc = wid & 3, fr = lane & 15, fq = lane >> 4;
    const int nt = K * ES / 128;
    unsigned voffB[2];
#pragma unroll
    for (int i = 0; i < 2; ++i) { int R, C; stage_rc(tid * 16 + i * 8192, R, C); const int Rb = Epi::PERM ? ((R & ~31) + perm32(R & 31)) : R; voffB[i] = (unsigned)(Rb * K * ES + C * 2); }
    const size_t kstep = (size_t)128;
    const size_t hstep = (size_t)HALF * K * ES;
    const unsigned ldsw = (unsigned)wid * 1024u;
    const int aoff = FP8 ? lds_byte(wr * 64 + fr, 16 * (fq & 1)) + (fq >> 1) * 1024 : lds_byte(wr * 64 + fr, fq * 8);
    const int boff = FP8 ? lds_byte(wc * 32 + fr, 16 * (fq & 1)) + (fq >> 1) * 1024 : lds_byte(wc * 32 + fr, fq * 8);
#define PG8_SA(b, h) (((b) * 2 + (h)) * HTB)
#define PG8_SB(b, h) ((4 + (b) * 2 + (h)) * HTB)
#define PG8_STAGE(bufoff, gbase, voff) do { const char* _gb = (const char*)(gbase); asm volatile("" : "+s"(_gb)); _Pragma("unroll") for (int _i = 0; _i < 2; ++_i) \
        __builtin_amdgcn_global_load_lds((const unsigned*)(_gb + (voff)[_i]), (LAS unsigned*)(lds + (bufoff) + ldsw + _i * 8192), 16, 0, 0); } while (0)
#define PG8_LDA(dst, b, h) do { _Pragma("unroll") for (int m = 0; m < 4; ++m) _Pragma("unroll") for (int k = 0; k < 2; ++k) dst[m][k] = *(const LAS bf16x8*)(lds + PG8_SA(b, h) + aoff + m * 2048 + k * (FP8 ? 16 : 1024)); } while (0)
#define PG8_LDB(dst, b, h) do { _Pragma("unroll") for (int n = 0; n < 2; ++n) _Pragma("unroll") for (int k = 0; k < 2; ++k) dst[n][k] = *(const LAS bf16x8*)(lds + PG8_SB(b, h) + boff + n * 2048 + k * (FP8 ? 16 : 1024)); } while (0)
#define PG8_MMA(ai, bj, At, Bt) do { __builtin_amdgcn_s_setprio(1); _Pragma("unroll") for (int m = 0; m < 4; ++m) _Pragma("unroll") for (int n = 0; n < 2; ++n) { \
        if constexpr (FP8) { const u32x4 _b0 = __builtin_bit_cast(u32x4, Bt[n][0]), _b1 = __builtin_bit_cast(u32x4, Bt[n][1]), _a0 = __builtin_bit_cast(u32x4, At[m][0]), _a1 = __builtin_bit_cast(u32x4, At[m][1]); \
            const i32x8 _bv = {(int)_b0.x, (int)_b0.y, (int)_b0.z, (int)_b0.w, (int)_b1.x, (int)_b1.y, (int)_b1.z, (int)_b1.w}, _av = {(int)_a0.x, (int)_a0.y, (int)_a0.z, (int)_a0.w, (int)_a1.x, (int)_a1.y, (int)_a1.z, (int)_a1.w}; \
            acc[ai][bj][m][n] = __builtin_amdgcn_mfma_scale_f32_16x16x128_f8f6f4(_bv, _av, acc[ai][bj][m][n], 0, 0, 0, 0x7F7F7F7F, 0, 0x7F7F7F7F); } \
        else if constexpr (MODE == 2) { _Pragma("unroll") for (int k = 0; k < 2; ++k) acc[ai][bj][m][n] = __builtin_bit_cast(f32x4, __builtin_amdgcn_mfma_i32_16x16x64_i8(__builtin_bit_cast(i32x4, Bt[n][k]), __builtin_bit_cast(i32x4, At[m][k]), __builtin_bit_cast(i32x4, acc[ai][bj][m][n]), 0, 0, 0)); } \
        else { _Pragma("unroll") for (int k = 0; k < 2; ++k) acc[ai][bj][m][n] = __builtin_amdgcn_mfma_f32_16x16x32_bf16(Bt[n][k], At[m][k], acc[ai][bj][m][n], 0, 0, 0); } } \
        __builtin_amdgcn_s_setprio(0); } while (0)
#define PG8_WAIT_V(n) asm volatile("s_waitcnt vmcnt(" #n ")" ::: "memory")
#define PG8_WAIT_L(n) asm volatile("s_waitcnt lgkmcnt(" #n ")" ::: "memory")
#define PG8_BAR __builtin_amdgcn_s_barrier()
#define PG8_SCHED __builtin_amdgcn_sched_barrier(0)
#define PG8_AOFF(dst, u) do { _Pragma("unroll") for (int _i = 0; _i < 2; ++_i) { int _R, _C; stage_rc(tid * 16 + _i * 8192, _R, _C); _Pragma("unroll") for (int _h = 0; _h < 2; ++_h) \
        dst[_h][_i] = (unsigned)((size_t)S.a_row(u, _h * HALF + _R) * K * ES + _C * 2); } } while (0)
    Unit cur, nxt; int ui = 0;
    if (!S.next(0, cur)) return;
    f32x4 acc[2][2][4][2];
#pragma unroll
    for (int a = 0; a < 2; ++a)
#pragma unroll
        for (int b = 0; b < 2; ++b)
#pragma unroll
            for (int m = 0; m < 4; ++m)
#pragma unroll
                for (int n = 0; n < 2; ++n) acc[a][b][m][n] = (f32x4){0.f, 0.f, 0.f, 0.f};
    bf16x8 At[4][2], B0[2][2], B1[2][2];
    unsigned cao[2][2];
    PG8_AOFF(cao, cur);
    const char* cA = (const char*)Abase; const char* cB = (const char*)Btbase + (size_t)cur.brow * K * ES;
    PG8_STAGE(PG8_SB(0, 0), cB, voffB); PG8_STAGE(PG8_SB(0, 1), cB + hstep, voffB); PG8_STAGE(PG8_SA(0, 0), cA, cao[0]); PG8_STAGE(PG8_SA(0, 1), cA, cao[1]);
    if (wr == 1) PG8_BAR;
    PG8_WAIT_V(2); PG8_BAR;
    PG8_STAGE(PG8_SB(1, 0), cB + kstep, voffB); PG8_STAGE(PG8_SA(1, 0), cA + kstep, cao[0]); PG8_STAGE(PG8_SB(1, 1), cB + hstep + kstep, voffB);
    PG8_WAIT_V(6); PG8_BAR;
    for (;;) {
        const bool has_next = S.next(ui + 1, nxt);
        const char* nB = has_next ? (const char*)Btbase + (size_t)nxt.brow * K * ES : cB;
        for (int t = 0; t < nt; t += 2) {
            const bool last = (t == nt - 2);
            const char* a1 = cA + (size_t)(t + 1) * kstep;
            const char* a2 = last ? cA : cA + (size_t)(t + 2) * kstep; const char* b2 = last ? nB : cB + (size_t)(t + 2) * kstep;
            const char* a3 = a2 + kstep; const char* b3 = b2 + kstep;
            PG8_LDB(B0, 0, 0); PG8_LDB(B1, 0, 1); PG8_SCHED; PG8_LDA(At, 0, 0); PG8_STAGE(PG8_SA(1, 1), a1, cao[1]);
            if (last && has_next) { PG8_AOFF(cao, nxt); }
            PG8_WAIT_V(8); PG8_WAIT_L(0); PG8_BAR; PG8_MMA(0, 0, At, B0); PG8_MMA(0, 1, At, B1); PG8_BAR; PG8_SCHED;
            PG8_LDA(At, 0, 1); PG8_STAGE(PG8_SB(0, 0), b2, voffB); PG8_STAGE(PG8_SB(0, 1), b2 + hstep, voffB); PG8_STAGE(PG8_SA(0, 0), a2, cao[0]);
            PG8_WAIT_V(8); PG8_WAIT_L(0); PG8_BAR; PG8_MMA(1, 0, At, B0); PG8_MMA(1, 1, At, B1); PG8_BAR; PG8_SCHED;
            PG8_LDB(B0, 1, 0); PG8_LDB(B1, 1, 1); PG8_SCHED; PG8_LDA(At, 1, 0); PG8_STAGE(PG8_SA(0, 1), a2, cao[1]);
            PG8_WAIT_V(8); PG8_WAIT_L(0); PG8_BAR; PG8_MMA(0, 0, At, B0); PG8_MMA(0, 1, At, B1); PG8_BAR; PG8_SCHED;
            PG8_LDA(At, 1, 1); PG8_STAGE(PG8_SB(1, 0), b3, voffB); PG8_STAGE(PG8_SB(1, 1), b3 + hstep, voffB); PG8_STAGE(PG8_SA(1, 0), a3, cao[0]);
            PG8_WAIT_V(8); PG8_WAIT_L(0); PG8_BAR; PG8_MMA(1, 0, At, B0); PG8_MMA(1, 1, At, B1); PG8_BAR; PG8_SCHED;
        }
        if (wr == 0) PG8_BAR;
        if constexpr (MODE == 2) {
#pragma unroll
            for (int a = 0; a < 2; ++a)
#pragma unroll
                for (int b = 0; b < 2; ++b)
#pragma unroll
                    for (int m = 0; m < 4; ++m)
#pragma unroll
                        for (int n = 0; n < 2; ++n) { const i32x4 iv = __builtin_bit_cast(i32x4, acc[a][b][m][n]); acc[a][b][m][n] = (f32x4){(float)iv[0], (float)iv[1], (float)iv[2], (float)iv[3]}; } }
#pragma unroll 1
        for (int er = 0; er < Epi::NREP; ++er) E(acc, cur, wr, wc, fr, fq);
        if (!has_next) break;
#pragma unroll
        for (int a = 0; a < 2; ++a)
#pragma unroll
            for (int b = 0; b < 2; ++b)
#pragma unroll
                for (int m = 0; m < 4; ++m)
#pragma unroll
                    for (int n = 0; n < 2; ++n) acc[a][b][m][n] = (f32x4){0.f, 0.f, 0.f, 0.f};
        cur = nxt; cB = nB; ++ui;
        if (wr == 1) PG8_BAR;
    }
    PG8_WAIT_V(0);
    PG8_BAR;
#undef PG8_SA
#undef PG8_SB
#undef PG8_STAGE
#undef PG8_LDA
#undef PG8_LDB
#undef PG8_MMA
#undef PG8_WAIT_V
#undef PG8_WAIT_L
#undef PG8_BAR
#undef PG8_SCHED
#undef PG8_AOFF
}
}

typedef f32x4 AccT[2][2][4][2];

struct EpiProj {
    static constexpr int NREP = 1; static constexpr bool PERM = true;
    bf16_t* proj; float* gates; const float* bgate; float sc;
    __device__ __forceinline__ void operator()(const AccT& acc, const pg8::Unit& u, int wr, int wc, int fr, int fq) const {
        const int row0 = u.pm * 256 + wr * 64 + fr; const float scu = u.pn < 2 ? sc * 0.125f : sc;
        if (u.pn < 12) {
            const int col0 = u.pn * 256 + wc * 32 + 8 * fq;
#pragma unroll
            for (int ai = 0; ai < 2; ++ai)
#pragma unroll
                for (int m = 0; m < 4; ++m) { bf16_t* rowp = proj + (size_t)(row0 + ai * 128 + m * 16) * PROJ_LD + col0;
#pragma unroll
                    for (int bj = 0; bj < 2; ++bj) { const f32x4 v0 = acc[ai][bj][m][0] * scu, v1 = acc[ai][bj][m][1] * scu;
                        u32x4 w; w.x = cvt_pk_bf16(v0[0], v0[1]); w.y = cvt_pk_bf16(v0[2], v0[3]); w.z = cvt_pk_bf16(v1[0], v1[1]); w.w = cvt_pk_bf16(v1[2], v1[3]);
                        *(u32x4*)(rowp + bj * 128) = w; } }
        } else if (wc == 0 && fq < 2) {
#pragma unroll
            for (int n = 0; n < 2; ++n) { const f32x4 bv = *(const f32x4*)(bgate + 8 * fq + 4 * n);
#pragma unroll
                for (int ai = 0; ai < 2; ++ai)
#pragma unroll
                    for (int m = 0; m < 4; ++m) *(f32x4*)(gates + (size_t)(row0 + ai * 128 + m * 16) * 16 + 8 * fq + 4 * n) = acc[ai][0][m][n] + bv; }
        }
    }
};
__device__ __forceinline__ f32x4 bf4_lo(u32x4 w) { return (f32x4){__builtin_bit_cast(float, w.x << 16), __builtin_bit_cast(float, w.x & 0xffff0000u), __builtin_bit_cast(float, w.y << 16), __builtin_bit_cast(float, w.y & 0xffff0000u)}; }
__device__ __forceinline__ f32x4 bf4_hi(u32x4 w) { return (f32x4){__builtin_bit_cast(float, w.z << 16), __builtin_bit_cast(float, w.z & 0xffff0000u), __builtin_bit_cast(float, w.w << 16), __builtin_bit_cast(float, w.w & 0xffff0000u)}; }
struct EpiRes {
    static constexpr int NREP = 1; static constexpr bool PERM = true;
    bf16_t* H; const float* stats; const float* lg; const float* lb; const float* xsrc; float sc;
    __device__ __forceinline__ void operator()(const AccT& acc, const pg8::Unit& u, int wr, int wc, int fr, int fq) const {
        const int row0 = u.pm * 256 + wr * 64 + fr, col0 = u.pn * 256 + wc * 32 + 8 * fq;
        f32x4 gv[2][2], bv[2][2];
        if (lg) {
#pragma unroll
            for (int bj = 0; bj < 2; ++bj)
#pragma unroll
                for (int n = 0; n < 2; ++n) { gv[bj][n] = *(const f32x4*)(lg + col0 + bj * 128 + n * 4); bv[bj][n] = *(const f32x4*)(lb + col0 + bj * 128 + n * 4); } }
#pragma unroll
        for (int ai = 0; ai < 2; ++ai)
#pragma unroll
            for (int m = 0; m < 4; ++m) { const int row = row0 + ai * 128 + m * 16; bf16_t* rowp = H + (size_t)row * D + col0;
                f32x2 st = (f32x2){0.f, 1.f}; if (lg) st = *(const f32x2*)(stats + 2 * (size_t)row);
#pragma unroll
                for (int bj = 0; bj < 2; ++bj) { f32x4 h0, h1;
                    if (lg) { const u32x4 w = *(const u32x4*)(rowp + bj * 128); h0 = (bf4_lo(w) - st.x) * st.y * gv[bj][0] + bv[bj][0]; h1 = (bf4_hi(w) - st.x) * st.y * gv[bj][1] + bv[bj][1]; }
                    else { const float* xp = xsrc + (size_t)row * D + col0 + bj * 128; h0 = *(const f32x4*)xp; h1 = *(const f32x4*)(xp + 4); }
                    const f32x4 o0 = h0 * ALPHA + acc[ai][bj][m][0] * sc, o1 = h1 * ALPHA + acc[ai][bj][m][1] * sc;
                    u32x4 w; w.x = cvt_pk_bf16(o0[0], o0[1]); w.y = cvt_pk_bf16(o0[2], o0[3]); w.z = cvt_pk_bf16(o1[0], o1[1]); w.w = cvt_pk_bf16(o1[2], o1[3]);
                    *(u32x4*)(rowp + bj * 128) = w; } }
    }
};
struct EpiSwiglu {
    static constexpr int NREP = 1; static constexpr bool PERM = true;
    bf16_t* act; int ld; float sc;
    __device__ __forceinline__ static float silu_mul(float g, float u) { return g * u * __builtin_amdgcn_rcpf(1.0f + __builtin_amdgcn_exp2f(-g * 1.4426950408889634f)); }
    __device__ __forceinline__ void operator()(const AccT& acc, const pg8::Unit& u, int wr, int wc, int fr, int fq) const {
        const int row0 = u.pm * 256 + wr * 64 + fr, col0 = u.pn * 128 + wc * 32 + 8 * fq;
#pragma unroll
        for (int ai = 0; ai < 2; ++ai)
#pragma unroll
            for (int m = 0; m < 4; ++m) { const f32x4 g0 = acc[ai][0][m][0] * sc, g1 = acc[ai][0][m][1] * sc, u0 = acc[ai][1][m][0] * sc, u1 = acc[ai][1][m][1] * sc;
                u32x4 w; w.x = cvt_pk_bf16(silu_mul(g0[0], u0[0]), silu_mul(g0[1], u0[1])); w.y = cvt_pk_bf16(silu_mul(g0[2], u0[2]), silu_mul(g0[3], u0[3]));
                w.z = cvt_pk_bf16(silu_mul(g1[0], u1[0]), silu_mul(g1[1], u1[1])); w.w = cvt_pk_bf16(silu_mul(g1[2], u1[2]), silu_mul(g1[3], u1[3]));
                *(u32x4*)(act + (size_t)(row0 + ai * 128 + m * 16) * ld + col0) = w; }
    }
};
struct EpiSwiglu8 {
    static constexpr int NREP = 1; static constexpr bool PERM = true;
    unsigned char* act; int ld; float sc;
    const float* wscale; int wdiv;
    __device__ __forceinline__ void operator()(const AccT& acc, const pg8::Unit& u, int wr, int wc, int fr, int fq) const {
        const int row0 = u.pm * 256 + wr * 64 + fr, col0 = u.pn * 128 + wc * 32 + 8 * fq;
        const float rs = wscale ? sc * wscale[wdiv ? u.brow / wdiv : 0] : sc;
        const float c1 = -rs * 1.4426950408889634f, c2 = rs * rs * F8_SACT, l2 = -__builtin_amdgcn_logf(c2), ic2 = __builtin_amdgcn_rcpf(c2);
#pragma unroll
        for (int ai = 0; ai < 2; ++ai)
#pragma unroll
            for (int m = 0; m < 4; ++m) { float o[8];
#pragma unroll
                for (int n = 0; n < 2; ++n)
#pragma unroll
                    for (int j = 0; j < 4; ++j) { const float g = acc[ai][0][m][n][j], up = acc[ai][1][m][n][j];
                        o[4 * n + j] = (g * up) * __builtin_amdgcn_rcpf(__builtin_amdgcn_exp2f(__builtin_fmaf(g, c1, l2)) + ic2); }
                u32x2 w; int p = __builtin_amdgcn_cvt_pk_fp8_f32(o[0], o[1], 0, false); p = __builtin_amdgcn_cvt_pk_fp8_f32(o[2], o[3], p, true); w.x = (unsigned)p;
                p = __builtin_amdgcn_cvt_pk_fp8_f32(o[4], o[5], 0, false); p = __builtin_amdgcn_cvt_pk_fp8_f32(o[6], o[7], p, true); w.y = (unsigned)p;
                *(u32x2*)(act + (size_t)(row0 + ai * 128 + m * 16) * ld + col0) = w; }
    }
};
struct EpiSwigluProbe : EpiSwiglu { static constexpr int NREP = 2; };
struct EpiScatter {
    static constexpr int NREP = 1; static constexpr bool PERM = true;
    bf16_t* contrib; const int* rowdst; const float* rowgate; float sc;
    __device__ __forceinline__ void operator()(const AccT& acc, const pg8::Unit& u, int wr, int wc, int fr, int fq) const {
        const int row0 = u.pm * 256 + wr * 64 + fr, col0 = u.pn * 256 + wc * 32 + 8 * fq;
#pragma unroll
        for (int ai = 0; ai < 2; ++ai)
#pragma unroll
            for (int m = 0; m < 4; ++m) { const int pos = row0 + ai * 128 + m * 16; const int d = rowdst[pos];
                if (d >= 0) { const float g = rowgate[pos] * sc; bf16_t* rowp = contrib + (size_t)d * D + col0;
#pragma unroll
                    for (int bj = 0; bj < 2; ++bj) { const f32x4 v0 = acc[ai][bj][m][0] * g, v1 = acc[ai][bj][m][1] * g;
                        u32x4 w; w.x = cvt_pk_bf16(v0[0], v0[1]); w.y = cvt_pk_bf16(v0[2], v0[3]); w.z = cvt_pk_bf16(v1[0], v1[1]); w.w = cvt_pk_bf16(v1[2], v1[3]);
                        *(u32x4*)(rowp + bj * 128) = w; } } }
    }
};
struct EpiQKV {
    static constexpr int NREP = 1; static constexpr bool PERM = true;
    bf16_t *Q, *KB, *VB; const float* rope; float sq, skv; LAS unsigned char* tlds;
    __device__ __forceinline__ void operator()(const AccT& acc, const pg8::Unit& u, int wr, int wc, int fr, int fq) const {
        const int row0 = u.pm * 256 + wr * 64 + fr, cl = wc * 32 + 8 * fq, lane = fr | (fq << 4);
        bf16_t* base; int ld;
        if (u.pn == 5) {
            LAS unsigned char* tp = tlds + (wr * 4 + wc) * 2560;
#pragma unroll
            for (int ai = 0; ai < 2; ++ai)
#pragma unroll
                for (int mp = 0; mp < 2; ++mp)
#pragma unroll
                    for (int bj = 0; bj < 2; ++bj) {
#pragma unroll
                        for (int mm = 0; mm < 2; ++mm)
#pragma unroll
                            for (int n = 0; n < 2; ++n)
#pragma unroll
                                for (int j = 0; j < 4; ++j) *(LAS unsigned short*)(tp + (8 * fq + 4 * n + j) * 80 + (mm * 16 + fr) * 2) = (unsigned short)f2bf(acc[ai][bj][2 * mp + mm][n][j] * skv);
                        asm volatile("s_waitcnt lgkmcnt(0)" ::: "memory");
                        const int c = lane & 31, h = lane >> 5;
                        const u32x4 r0 = *(const LAS u32x4*)(tp + c * 80 + h * 32), r1 = *(const LAS u32x4*)(tp + c * 80 + h * 32 + 16);
                        bf16_t* dst = VB + (size_t)(bj * 128 + wc * 32 + c) * MP + (u.pm * 256 + ai * 128 + wr * 64 + mp * 32 + h * 16);
                        *(u32x4*)dst = r0; *(u32x4*)(dst + 8) = r1;
                        asm volatile("s_waitcnt lgkmcnt(0)" ::: "memory"); }
            return; }
        if (u.pn < 4) { base = Q + u.pn * 256 + cl; ld = D; } else { base = KB + cl; ld = 256; }
        const bool dorope = (u.pn <= 4) && ((wc & 1) == 0);
        { const char* src = (const char*)(rope + (size_t)(((u.pm * 256) & (SEQ - 1)) + NMETA) * 16) + (wr * 4 + wc) * 2048 + lane * 16;
          __builtin_amdgcn_global_load_lds((const unsigned*)src, (LAS unsigned*)(tlds + (wr * 4 + wc) * 2048), 16, 0, 0);
          __builtin_amdgcn_global_load_lds((const unsigned*)(src + 1024), (LAS unsigned*)(tlds + (wr * 4 + wc) * 2048 + 1024), 16, 0, 0);
          asm volatile("s_waitcnt vmcnt(0)" ::: "memory"); __builtin_amdgcn_s_barrier(); asm volatile("" ::: "memory"); }
#pragma unroll
        for (int ai = 0; ai < 2; ++ai)
#pragma unroll
            for (int m = 0; m < 4; ++m) { const int row = row0 + ai * 128 + m * 16;
                f32x4 v[2][2];
#pragma unroll
                for (int bj = 0; bj < 2; ++bj)
#pragma unroll
                    for (int n = 0; n < 2; ++n) v[bj][n] = acc[ai][bj][m][n] * (u.pn < 4 ? sq : skv);
                if (dorope) {
                    const LAS float* rp = (const LAS float*)(tlds + (wr * 64 + ai * 128 + m * 16 + fr) * 64);
                    const f32x4 c0 = *(const LAS f32x4*)rp, c1 = *(const LAS f32x4*)(rp + 4), s0 = *(const LAS f32x4*)(rp + 8), s1 = *(const LAS f32x4*)(rp + 12);
#pragma unroll
                    for (int bj = 0; bj < 2; ++bj)
#pragma unroll
                        for (int n = 0; n < 2; ++n) { const f32x4 c = n ? c1 : c0, s = n ? s1 : s0; f32x4 o;
#pragma unroll
                            for (int j = 0; j < 4; ++j) { const float x = v[bj][n][j]; const float y = SHX(x, 16);
                                o[j] = fq == 0 ? x * c[j] - y * s[j] : (fq == 1 ? x * c[j] + y * s[j] : x); }
                            v[bj][n] = o; }
                }
#pragma unroll
                for (int bj = 0; bj < 2; ++bj) { const f32x4 v0 = v[bj][0], v1 = v[bj][1];
                    u32x4 w; w.x = cvt_pk_bf16(v0[0], v0[1]); w.y = cvt_pk_bf16(v0[2], v0[3]); w.z = cvt_pk_bf16(v1[0], v1[1]); w.w = cvt_pk_bf16(v1[2], v1[3]);
                    *(u32x4*)(base + (size_t)row * ld + bj * 128) = w; } }
    }
};

template <int NACC, class F>
__device__ __forceinline__ void skinny_item(const bf16_t* A, int lda, const bf16_t* (&Bt)[NACC], int K, int wave, int lane, LAS unsigned char* lds, int parity, const F& epi) {
    const int fr = lane & 15, quad = lane >> 4, kw = K >> 3;
    const bf16_t* ap = A + (size_t)fr * lda + wave * kw + 8 * quad;
    f32x4 acc[NACC];
#pragma unroll
    for (int i = 0; i < NACC; ++i) acc[i] = (f32x4){0.f, 0.f, 0.f, 0.f};
#pragma unroll 2
    for (int k = 0; k < kw; k += 32) { const bf16x8 a = *(const bf16x8*)(ap + k);
#pragma unroll
        for (int i = 0; i < NACC; ++i) acc[i] = __builtin_amdgcn_mfma_f32_16x16x32_bf16(a, *(const bf16x8*)(Bt[i] + (size_t)fr * K + wave * kw + 8 * quad + k), acc[i], 0, 0, 0); }
    LAS f32x4* red = (LAS f32x4*)(lds + parity * 16384);
#pragma unroll
    for (int i = 0; i < NACC; ++i) red[(wave * NACC + i) * 64 + lane] = acc[i];
    __syncthreads();
    if (wave == 0) {
#pragma unroll
        for (int i = 0; i < NACC; ++i) { f32x4 t = red[i * 64 + lane];
#pragma unroll
            for (int w = 1; w < 8; ++w) t += red[(w * NACC + i) * 64 + lane];
            acc[i] = t; }
        epi(acc, fr, quad);
    }
}

template <int NACC, class F>
__device__ __forceinline__ void skinny_item8(const unsigned char* A, int lda, const unsigned char* (&Bt)[NACC], int K, int wave, int lane, LAS unsigned char* lds, int parity, const F& epi) {
    const int fr = lane & 15, quad = lane >> 4, nblk = K >> 7, b0 = (wave * nblk) >> 3, b1 = ((wave + 1) * nblk) >> 3;
    f32x4 acc[NACC];
#pragma unroll
    for (int i = 0; i < NACC; ++i) acc[i] = (f32x4){0.f, 0.f, 0.f, 0.f};
    for (int kb = b0; kb < b1; ++kb) { const u32x4* ap = (const u32x4*)(A + (size_t)fr * lda + kb * 128 + 32 * quad); const u32x4 a0 = ap[0], a1 = ap[1];
        const i32x8 av = {(int)a0.x, (int)a0.y, (int)a0.z, (int)a0.w, (int)a1.x, (int)a1.y, (int)a1.z, (int)a1.w};
#pragma unroll
        for (int i = 0; i < NACC; ++i) { const u32x4* bp = (const u32x4*)(Bt[i] + (size_t)fr * K + kb * 128 + 32 * quad); const u32x4 q0 = bp[0], q1 = bp[1];
            const i32x8 bv = {(int)q0.x, (int)q0.y, (int)q0.z, (int)q0.w, (int)q1.x, (int)q1.y, (int)q1.z, (int)q1.w};
            acc[i] = __builtin_amdgcn_mfma_scale_f32_16x16x128_f8f6f4(av, bv, acc[i], 0, 0, 0, 0x7F7F7F7F, 0, 0x7F7F7F7F); } }
    LAS f32x4* red = (LAS f32x4*)(lds + parity * 16384);
#pragma unroll
    for (int i = 0; i < NACC; ++i) red[(wave * NACC + i) * 64 + lane] = acc[i];
    __syncthreads();
    if (wave == 0) {
#pragma unroll
        for (int i = 0; i < NACC; ++i) { f32x4 t = red[i * 64 + lane];
#pragma unroll
            for (int w = 1; w < 8; ++w) t += red[(w * NACC + i) * 64 + lane];
            acc[i] = t; }
        epi(acc, fr, quad);
    }
}

__device__ __forceinline__ int claim_item(unsigned* ctr, LAS unsigned char* lds, int tid) {
    volatile LAS unsigned* slot = (volatile LAS unsigned*)(lds + MISC_OFF) + 48;
    if (tid == 0) slot[0] = __hip_atomic_fetch_add(ctr, 1u, __ATOMIC_RELAXED, __HIP_MEMORY_SCOPE_AGENT);
    __syncthreads();
    const int item = (int)slot[0];
    __syncthreads();
    return item;
}

struct Params { const float* in[18]; float* out; unsigned char* ws; int ph_lo, ph_hi, li, pad; };
enum { I_X = 0, I_META, I_WIN, I_BGATE, I_LNH, I_WOUT, I_WKV, I_WQ, I_SINKS, I_WO, I_WGUD, I_WDND, I_WROUTER, I_BROUTER, I_WGUE, I_WDNE, I_LNG, I_LNB };
constexpr int NWAVES = 8, NTHREADS = 512;

__device__ __forceinline__ unsigned pk4_i8(float a, float b, float c, float d) {
    const int ia = (int)__builtin_rintf(__builtin_amdgcn_fmed3f(a, -127.f, 127.f)), ib = (int)__builtin_rintf(__builtin_amdgcn_fmed3f(b, -127.f, 127.f));
    const int ic = (int)__builtin_rintf(__builtin_amdgcn_fmed3f(c, -127.f, 127.f)), id = (int)__builtin_rintf(__builtin_amdgcn_fmed3f(d, -127.f, 127.f));
    return (unsigned)(ia & 0xff) | ((unsigned)(ib & 0xff) << 8) | ((unsigned)(ic & 0xff) << 16) | ((unsigned)(id & 0xff) << 24); }
template <int F8 = 0>
__device__ __forceinline__ void tr_item(const float* W, int Nsrc, int K, void* WTv, int k0, int n0, int drow0, float scale, int nvalid, LAS float* scr, int lane) {
    bf16_t* WT = (bf16_t*)WTv;
    float ld[32];
#pragma unroll
    for (int i = 0; i < 32; ++i) { const int kk = 2 * i + (lane >> 5), n = lane & 31; ld[i] = (n < nvalid) ? W[(size_t)(k0 + kk) * Nsrc + n0 + n] : 0.f; }
#pragma unroll
    for (int i = 0; i < 32; ++i) { const int kk = 2 * i + (lane >> 5), n = lane & 31; scr[kk * 33 + n] = ld[i] * scale; }
    LDS_WAIT(); asm volatile("" ::: "memory");
    const int c = lane & 7;
#pragma unroll
    for (int j = 0; j < 4; ++j) { const int n = (lane >> 3) + 8 * j; const LAS float* s = scr + (8 * c) * 33 + n;
        if constexpr (F8 == 2) { u32x2 o; o.x = pk4_i8(s[0 * 33], s[1 * 33], s[2 * 33], s[3 * 33]); o.y = pk4_i8(s[4 * 33], s[5 * 33], s[6 * 33], s[7 * 33]);
            if (n < nvalid) *(u32x2*)((unsigned char*)WTv + (size_t)(drow0 + n) * K + k0 + 8 * c) = o; }
        else if constexpr (F8 == 1) { u32x2 o; o.x = pk4_fp8(s[0 * 33], s[1 * 33], s[2 * 33], s[3 * 33]); o.y = pk4_fp8(s[4 * 33], s[5 * 33], s[6 * 33], s[7 * 33]);
            if (n < nvalid) *(u32x2*)((unsigned char*)WTv + (size_t)(drow0 + n) * K + k0 + 8 * c) = o; }
        else { u32x4 o; o.x = pk2(s[0 * 33], s[1 * 33]); o.y = pk2(s[2 * 33], s[3 * 33]); o.z = pk2(s[4 * 33], s[5 * 33]); o.w = pk2(s[6 * 33], s[7 * 33]);
            if (n < nvalid) *(u32x4*)(WT + (size_t)(drow0 + n) * K + k0 + 8 * c) = o; } }
    LDS_WAIT(); asm volatile("" ::: "memory");
}
__device__ __forceinline__ int pair_row(int n, int FF) { const int up = n >= FF ? 1 : 0, j = n - up * FF; return 256 * (j >> 7) + 128 * up + (j & 127); }

__device__ __forceinline__ void p0_prologue(const Params& P, LAS unsigned char* lds, int gw, int NGW, int wave, int lane, const XcdBarrier& bar, int tid) {
    unsigned char* ws = P.ws;
    LAS float* scr = (LAS float*)(lds + wave * 16384);
    { unsigned* amax = (unsigned*)(ws + WS_CTL) + CW_AMAX;
      const int vwg = gw >> 3;
      if (vwg < 192) { const int m = vwg >> 3, part = vwg & 7;
          const float* src = m < 2 ? P.in[I_WGUD] + (size_t)m * D * 2 * D_FF : m < 18 ? P.in[I_WGUE] + (size_t)(m - 2) * D * 2 * D_FF_EXP : m < 20 ? P.in[I_WQ] + (size_t)(m - 18) * D * D : m < 21 ? P.in[I_WKV]
                           : m < 23 ? P.in[I_WIN] + (size_t)(m - 21) * D * M_IN : P.in[I_X];
          const int n4 = 16 * (m < 2 ? 2 * D_FF : m < 18 ? 2 * D_FF_EXP : m < 20 ? D : m < 21 ? 512 : m < 23 ? M_IN : 4096), pn4 = n4 >> 3;
          float mx = 0.f;
          for (int i = part * pn4 + tid; i < (part + 1) * pn4; i += NTHREADS) { const f32x4 v = ((const f32x4*)src)[i]; mx = fmaxf(fmaxf(mx, fmaxf(fabsf(v[0]), fabsf(v[1]))), fmaxf(fabsf(v[2]), fabsf(v[3]))); }
#pragma unroll
          for (int o = 1; o < 64; o <<= 1) mx = fmaxf(mx, SHX(mx, o));
          volatile LAS float* red = (volatile LAS float*)(lds + MISC_OFF) + 40;
          if (lane == 0) red[wave] = mx;
          __syncthreads();
          if (tid == 0) { float t = red[0];
#pragma unroll
              for (int w = 1; w < 8; ++w) t = fmaxf(t, red[w]);
              __hip_atomic_fetch_max(amax + m, __builtin_bit_cast(unsigned, t), __ATOMIC_RELAXED, __HIP_MEMORY_SCOPE_AGENT); } }
      xcd_barrier(bar, tid == 0);
      if (gw == 0 && lane < 24) ((float*)(ws + WS_SMALL))[SM_WSCALE + lane] = 1.15f * __builtin_bit_cast(float, __hip_atomic_load(amax + lane, __ATOMIC_RELAXED, __HIP_MEMORY_SCOPE_AGENT)) * (1.f / 127.f); }
    const unsigned* amaxr = (const unsigned*)(ws + WS_CTL) + CW_AMAX;
    constexpr int IT0 = 16 * 97, IT1 = 16 * 32, IT2 = 16 * 16, IT5 = 16 * 176, IT6 = 22 * 32, IT7 = 8 * 224, IT8 = 28 * 32, IT4 = 8 * 32;
    constexpr int C0 = 2 * IT0, C1 = C0 + 2 * IT1, C2 = C1 + IT2, C3 = C2 + 2 * IT1, C4 = C3 + 2 * IT4, C5 = C4 + 2 * IT5, C6 = C5 + 2 * IT6, C7 = C6 + 16 * IT7, C8 = C7 + 16 * IT8;
    for (int it = gw; it < C8; it += NGW) {
        if (it < C0) { const int mi = it / IT0, r = it % IT0, kb = r / 97, nb = r % 97; const int n0 = nb * 32;
            tr_item(P.in[I_WIN] + (size_t)mi * D * M_IN, M_IN, D, (bf16_t*)(ws + WS_WIN) + (size_t)mi * M_INP * D, kb * 64, n0, n0, n0 < 512 ? 0.125f : 1.f, nb == 96 ? 16 : 32, scr, lane);
            if (nb < 96) { const float qs = 127.f / (1.15f * __builtin_bit_cast(float, __hip_atomic_load(amaxr + 21 + mi, __ATOMIC_RELAXED, __HIP_MEMORY_SCOPE_AGENT)));
                tr_item<2>(P.in[I_WIN] + (size_t)mi * D * M_IN, M_IN, D, ws + WS_WIN8 + (size_t)mi * 3072 * D, kb * 64, n0, n0, qs, 32, scr, lane); }
        } else if (it < C1) { const int q = it - C0, mi = q / IT1, r = q % IT1, kb = r / 32, nb = r % 32;
            tr_item(P.in[I_WOUT] + (size_t)mi * D * D, D, D, (bf16_t*)(ws + WS_WOUT) + (size_t)mi * D * D, kb * 64, nb * 32, nb * 32, 1.f, 32, scr, lane);
        } else if (it < C2) { const int r = it - C1, kb = r / 16, nb = r % 16;
            tr_item(P.in[I_WKV], 512, D, (bf16_t*)(ws + WS_WQKV), kb * 64, nb * 32, 1024 + nb * 32, 1.f, 32, scr, lane);
            { const float qs = 127.f / (1.15f * __builtin_bit_cast(float, __hip_atomic_load(amaxr + 20, __ATOMIC_RELAXED, __HIP_MEMORY_SCOPE_AGENT)));
              tr_item<2>(P.in[I_WKV], 512, D, ws + WS_WQKV8, kb * 64, nb * 32, 1024 + nb * 32, qs, 32, scr, lane); }
        } else if (it < C3) { const int q = it - C2, mi = q / IT1, r = q % IT1, kb = r / 32, nb = r % 32;
            tr_item(P.in[I_WQ] + (size_t)mi * D * D, D, D, (bf16_t*)(ws + (mi ? WS_WQ3 : WS_WQKV)), kb * 64, nb * 32, nb * 32, 0.125f, 32, scr, lane);
            { const float qs = 127.f / (1.15f * __builtin_bit_cast(float, __hip_atomic_load(amaxr + 18 + mi, __ATOMIC_RELAXED, __HIP_MEMORY_SCOPE_AGENT)));
              tr_item<2>(P.in[I_WQ] + (size_t)mi * D * D, D, D, ws + WS_WQKV8 + (mi ? (size_t)1536 * D : 0), kb * 64, nb * 32, nb * 32, qs, 32, scr, lane); }
        } else if (it < C4) { const int q = it - C3, mi = q / IT4, r = q % IT4, kp = r / 32, nb = r % 32;
#pragma unroll 1
            for (int kb = 2 * kp; kb < 2 * kp + 2; ++kb) tr_item<1>(P.in[I_WO] + (size_t)mi * D * D, D, D, (ws + WS_WO8) + (size_t)mi * D * D, kb * 64, nb * 32, nb * 32, F8_SWO, 32, scr, lane);
        } else if (it < C5) { const int q = it - C4, mi = q / IT5, r = q % IT5, kb = r / 176, nb = r % 176;
            tr_item(P.in[I_WGUD] + (size_t)mi * D * 2 * D_FF, 2 * D_FF, D, (bf16_t*)(ws + WS_WGU) + (size_t)mi * 2 * D_FF * D, kb * 64, nb * 32, pair_row(nb * 32, D_FF), 1.f, 32, scr, lane);
            { const float qs = 127.f / (1.15f * __builtin_bit_cast(float, __hip_atomic_load(amaxr + mi, __ATOMIC_RELAXED, __HIP_MEMORY_SCOPE_AGENT)));
              tr_item<2>(P.in[I_WGUD] + (size_t)mi * D * 2 * D_FF, 2 * D_FF, D, (ws + WS_WGU8) + (size_t)mi * 2 * D_FF * D, kb * 64, nb * 32, pair_row(nb * 32, D_FF), qs, 32, scr, lane); }
        } else if (it < C6) { const int q = it - C5, mi = q / IT6, r = q % IT6, kp = r / 32, nb = r % 32;
#pragma unroll 1
            for (int kb = 2 * kp; kb < 2 * kp + 2; ++kb) tr_item<1>(P.in[I_WDND] + (size_t)mi * D_FF * D, D, D_FF, (ws + WS_WDN8) + (size_t)mi * D * D_FF, kb * 64, nb * 32, nb * 32, F8_SBD, 32, scr, lane);
        } else if (it < C7) { const int q = it - C6, mi = q / IT7, r = q % IT7, kp = r / 224, nb = r % 224;
            const float qs = 127.f / (1.15f * __builtin_bit_cast(float, __hip_atomic_load(amaxr + 2 + mi, __ATOMIC_RELAXED, __HIP_MEMORY_SCOPE_AGENT)));
#pragma unroll 1
            for (int kb = 2 * kp; kb < 2 * kp + 2; ++kb) tr_item<2>(P.in[I_WGUE] + (size_t)mi * D * 2 * D_FF_EXP, 2 * D_FF_EXP, D, (ws + WS_WGUE8) + (size_t)mi * 2 * D_FF_EXP * D, kb * 64, nb * 32, pair_row(nb * 32, D_FF_EXP), qs, 32, scr, lane);
        } else { const int q = it - C7, mi = q / IT8, r = q % IT8, kp = r / 32, nb = r % 32;
#pragma unroll 1
            for (int kb = 2 * kp; kb < 2 * kp + 2; ++kb) tr_item<1>(P.in[I_WDNE] + (size_t)mi * D_FF_EXP * D, D, D_FF_EXP, (ws + WS_WDNE8) + (size_t)mi * D * D_FF_EXP, kb * 64, nb * 32, nb * 32, F8_SBD, 32, scr, lane);
        }
    }
    { float* sm = (float*)(ws + WS_SMALL); const int gt = gw * 64 + lane, NT = NGW * 64;
      for (int i = gt; i < SM_WSCALE; i += NT) { float v = 0.f;
          if (i < SM_SINKS) v = P.in[I_BGATE][i]; else if (i < SM_BROUTER) v = P.in[I_SINKS][i - SM_SINKS]; else if (i < SM_BROUTER + 16) v = P.in[I_BROUTER][i - SM_BROUTER];
          else if (i < SM_LNH) v = 0.f; else if (i < SM_LNG) v = P.in[I_LNH][i - SM_LNH]; else if (i < SM_LNB) v = P.in[I_LNG][i - SM_LNG]; else if (i < SM_WROUTER) v = P.in[I_LNB][i - SM_LNB]; else v = P.in[I_WROUTER][i - SM_WROUTER];
          sm[i] = v; } }
    { bf16_t* HB = (bf16_t*)(ws + WS_HB); const float xq = 127.f / (1.15f * __builtin_bit_cast(float, __hip_atomic_load(amaxr + 23, __ATOMIC_RELAXED, __HIP_MEMORY_SCOPE_AGENT)));
      const size_t gt = (size_t)gw * 64 + lane, NT = (size_t)NGW * 64;
      for (size_t i = gt; i < (size_t)MV * (D / 4); i += NT) { const size_t row = i >> 8; const int c4 = (int)(i & 255);
          const f32x4 v = row < MREAL ? ((const f32x4*)P.in[I_X])[i] : ((const f32x4*)P.in[I_META])[(row - MREAL) * 256 + c4];
          u32x2 w; w.x = pk2(v[0], v[1]); w.y = pk2(v[2], v[3]); ((u32x2*)HB)[i] = w;
          ((unsigned*)(ws + WS_HB8))[i] = pk4_i8(v[0] * xq, v[1] * xq, v[2] * xq, v[3] * xq); }
      float* rope = (float*)(ws + WS_ROPE);
      for (size_t i = gt; i < (size_t)(SEQ + NMETA) * 8; i += NT) { const int pos = (int)(i >> 3), fi = (int)(i & 7);
          const double invf = fi == 0 ? 1.0 : fi == 1 ? 0.19392274474868576 : fi == 2 ? 0.03760603093086393 : fi == 3 ? 0.007292664737217109 : fi == 4 ? 0.001414213562373095
                            : fi == 5 ? 0.0002742481756762073 : fi == 6 ? 5.318295896944988e-05 : 1.031338537721246e-05;
          const float angf = (float)pos * (float)invf;
          double a = (double)angf; a -= 6.283185307179586476925 * __builtin_rint(a * 0.15915494309189533577); const double hx = 0.5 * a, h2 = hx * hx;
          double sp = 1.0, cp = 1.0;
#pragma unroll
          for (int k = 12; k >= 1; --k) { sp = 1.0 - sp * h2 / (double)((2 * k) * (2 * k + 1)); cp = 1.0 - cp * h2 / (double)((2 * k - 1) * (2 * k)); }
          const double sh = hx * sp, ch = cp;
          rope[(size_t)pos * 16 + fi] = (float)(1.0 - 2.0 * sh * sh); rope[(size_t)pos * 16 + 8 + fi] = (float)(2.0 * sh * ch); }
    }
}

__device__ __forceinline__ void ln_phase(unsigned char* ws, float* outp, LAS unsigned char* lds, int gw, int NGW, int lane, int tid,
                                         int lnidx, bool moe_src, bool router, int moe_idx, bool final, bool dry = false, bool q8 = false, bool fullhb = false) {
    const float* sm = (const float*)(ws + WS_SMALL);
    unsigned char* wo = dry ? ws + WS_ACT : ws;
    const bf16_t* H = (const bf16_t*)(ws + WS_H); bf16_t* Hw = dry ? (bf16_t*)(ws + WS_ACT) : (bf16_t*)(ws + WS_H);
    bf16_t* HB = dry ? (bf16_t*)(ws + WS_ACT + 160 * MiB) : (bf16_t*)(ws + WS_HB); const bf16_t* contrib = (const bf16_t*)(ws + WS_CONTRIB);
    const float* stats = (const float*)(ws + WS_STATS); float* statsw = dry ? (float*)(ws + WS_ACT + 240 * MiB) : (float*)(ws + WS_STATS);
    unsigned char* HB8 = dry ? ws + WS_ACT + 250 * MiB : ws + WS_HB8; (void)wo;
    const float* lg = sm + SM_LNG + (size_t)lnidx * D; const float* lb = sm + SM_LNB + (size_t)lnidx * D;
    f32x4 gv[4], bv[4];
#pragma unroll
    for (int j = 0; j < 4; ++j) { gv[j] = *(const f32x4*)(lg + 256 * j + 4 * lane); bv[j] = *(const f32x4*)(lb + 256 * j + 4 * lane); }
    float qi8 = 0.f;
    if (q8) { float gm = 0.f, bm = 0.f;
#pragma unroll
        for (int j = 0; j < 4; ++j)
#pragma unroll
            for (int c = 0; c < 4; ++c) { gm = fmaxf(gm, fabsf(gv[j][c])); bm = fmaxf(bm, fabsf(bv[j][c])); }
#pragma unroll
        for (int o = 1; o < 64; o <<= 1) { gm = fmaxf(gm, SHX(gm, o)); bm = fmaxf(bm, SHX(bm, o)); }
        const float clip = 5.5f * gm + bm; qi8 = 127.f / clip;
        if (gw == 0 && lane == 0 && !dry) ((float*)(ws + WS_SMALL))[SM_ASCALE + lnidx] = clip * (1.f / 127.f); }
    volatile LAS unsigned* misc = (volatile LAS unsigned*)(lds + MISC_OFF);
    f32x4 wra[4][4], wrb[4][4];
    if (router) {
        const float* src = sm + SM_WROUTER + (size_t)moe_idx * D * N_EXP;
#pragma unroll
        for (int j = 0; j < 4; ++j)
#pragma unroll
            for (int c = 0; c < 4; ++c) { const f32x4* w4 = (const f32x4*)(src + (size_t)(256 * j + 4 * lane + c) * 8); wra[j][c] = w4[0]; wrb[j][c] = w4[1]; }
        if (tid < 8) misc[16 + tid] = 0u;
        __syncthreads();
    }
    int* tope = dry ? (int*)(ws + WS_ACT + 300 * MiB) : (int*)(ws + WS_TOPE); float* topg = dry ? (float*)(ws + WS_ACT + 310 * MiB) : (float*)(ws + WS_TOPG);
    const float* br = sm + SM_BROUTER + moe_idx * N_EXP;
    struct RowBuf { u32x2 nv[4], nc0[4], nc1[4]; f32x2 nst; };
    RowBuf rb0 = {}, rb1 = {};
    auto fetch = [&](RowBuf& B, int row) {
        u32x2 (&nv)[4] = B.nv; u32x2 (&nc0)[4] = B.nc0; u32x2 (&nc1)[4] = B.nc1; f32x2& nst = B.nst;
        const u32x2* hr = (const u32x2*)(H + (size_t)row * D) + lane;
#pragma unroll
        for (int j = 0; j < 4; ++j) nv[j] = hr[64 * j];
        if (moe_src) { const u32x2* c0 = (const u32x2*)(contrib + (size_t)(2 * row) * D) + lane; const u32x2* c1 = c0 + 256;
#pragma unroll
            for (int j = 0; j < 4; ++j) { nc0[j] = c0[64 * j]; nc1[j] = c1[64 * j]; } }
        nst = *(const f32x2*)(stats + 2 * (size_t)row);
    };
    auto body = [&](RowBuf& B, int row) {
        u32x2 (&nv)[4] = B.nv; u32x2 nc0[4], nc1[4];
#pragma unroll
        for (int j = 0; j < 4; ++j) { nc0[j] = moe_src ? B.nc0[j] : (u32x2){0u, 0u}; nc1[j] = moe_src ? B.nc1[j] : (u32x2){0u, 0u}; }
        f32x4 v[4], c0v[4], c1v[4]; const f32x2 st = B.nst;
#pragma unroll
        for (int j = 0; j < 4; ++j) { v[j] = (f32x4){__builtin_bit_cast(float, nv[j].x << 16), __builtin_bit_cast(float, nv[j].x & 0xffff0000u), __builtin_bit_cast(float, nv[j].y << 16), __builtin_bit_cast(float, nv[j].y & 0xffff0000u)};
            c0v[j] = (f32x4){__builtin_bit_cast(float, nc0[j].x << 16), __builtin_bit_cast(float, nc0[j].x & 0xffff0000u), __builtin_bit_cast(float, nc0[j].y << 16), __builtin_bit_cast(float, nc0[j].y & 0xffff0000u)};
            c1v[j] = (f32x4){__builtin_bit_cast(float, nc1[j].x << 16), __builtin_bit_cast(float, nc1[j].x & 0xffff0000u), __builtin_bit_cast(float, nc1[j].y << 16), __builtin_bit_cast(float, nc1[j].y & 0xffff0000u)}; }
        if (row + 2 * NGW < MV) fetch(B, row + 2 * NGW);
        if (moe_src) { const float* pg = lg - D; const float* pb = lb - D;
#pragma unroll
            for (int j = 0; j < 4; ++j) { const f32x4 g1 = *(const f32x4*)(pg + 256 * j + 4 * lane), b1 = *(const f32x4*)(pb + 256 * j + 4 * lane);
                v[j] = ((v[j] - st.x) * st.y * g1 + b1) * ALPHA + c0v[j] + c1v[j]; }
            if (!final) { u32x2* o = (u32x2*)(Hw + (size_t)row * D) + lane;
#pragma unroll
                for (int j = 0; j < 4; ++j) { u32x2 w; w.x = pk2(v[j][0], v[j][1]); w.y = pk2(v[j][2], v[j][3]); o[64 * j] = w;
                    v[j] = (f32x4){__builtin_bit_cast(float, w.x << 16), __builtin_bit_cast(float, w.x & 0xffff0000u), __builtin_bit_cast(float, w.y << 16), __builtin_bit_cast(float, w.y & 0xffff0000u)}; } } }
        float s = 0.f;
#pragma unroll
        for (int j = 0; j < 4; ++j) s += (v[j][0] + v[j][1]) + (v[j][2] + v[j][3]);
        const float mean = wave_sum(s, lane) * (1.f / D); float s2 = 0.f;
#pragma unroll
        for (int j = 0; j < 4; ++j) { v[j] = v[j] - mean; s2 += (v[j][0] * v[j][0] + v[j][1] * v[j][1]) + (v[j][2] * v[j][2] + v[j][3] * v[j][3]); }
        const float rstd = 1.f / sqrtf(wave_sum(s2, lane) * (1.f / D) + LN_EPS);
#pragma unroll
        for (int j = 0; j < 4; ++j) v[j] = v[j] * rstd * gv[j] + bv[j];
        if (final) { if (row < MREAL) { f32x4* o = (f32x4*)(outp + (size_t)row * D) + lane;
#pragma unroll
                for (int j = 0; j < 4; ++j) o[64 * j] = v[j]; } }
        else { if (lane == 0) *(f32x2*)(statsw + 2 * (size_t)row) = (f32x2){mean, rstd};
            if (q8) {
                unsigned* o8 = (unsigned*)(HB8 + (size_t)row * D) + lane;
#pragma unroll
                for (int j = 0; j < 4; ++j) o8[64 * j] = pk4_i8(v[j][0] * qi8, v[j][1] * qi8, v[j][2] * qi8, v[j][3] * qi8); }
            if (!q8 || fullhb || row >= MREAL) { u32x2* ob = (u32x2*)(HB + (size_t)row * D) + lane;
#pragma unroll
                for (int j = 0; j < 4; ++j) { u32x2 w; w.x = pk2(v[j][0], v[j][1]); w.y = pk2(v[j][2], v[j][3]); ob[64 * j] = w; } } }
        if (router) {
            f32x4 la = (f32x4){0.f, 0.f, 0.f, 0.f}, lb4 = (f32x4){0.f, 0.f, 0.f, 0.f};
#pragma unroll
            for (int j = 0; j < 4; ++j)
#pragma unroll
                for (int c = 0; c < 4; ++c) { const float x = v[j][c]; la += wra[j][c] * x; lb4 += wrb[j][c] * x; }
            const bool h5 = (lane & 32) != 0, h4 = (lane & 16) != 0, h3 = (lane & 8) != 0;
            f32x4 k4; { const f32x4 send = h5 ? la : lb4, keep = h5 ? lb4 : la; f32x4 got;
#pragma unroll
                for (int i = 0; i < 4; ++i) got[i] = SHX(send[i], 32);
                k4 = keep + got; }
            f32x2 k2; { const f32x2 send = h4 ? (f32x2){k4[0], k4[1]} : (f32x2){k4[2], k4[3]}, keep = h4 ? (f32x2){k4[2], k4[3]} : (f32x2){k4[0], k4[1]};
                k2 = keep + (f32x2){SHX(send[0], 16), SHX(send[1], 16)}; }
            float k1 = (h3 ? k2[1] : k2[0]) + SHX(h3 ? k2[0] : k2[1], 8);
            k1 += SHX(k1, 4); k1 += SHX(k1, 2); k1 += SHX(k1, 1);
            float lg8[8];
#pragma unroll
            for (int e = 0; e < 8; ++e) lg8[e] = SHL(k1, 8 * e) + br[e];
            int e1 = 0; float v1 = lg8[0];
#pragma unroll
            for (int e = 1; e < 8; ++e) if (lg8[e] > v1) { v1 = lg8[e]; e1 = e; }
            int e2 = -1; float v2 = -3.0e38f;
#pragma unroll
            for (int e = 0; e < 8; ++e) if (e != e1 && lg8[e] > v2) { v2 = lg8[e]; e2 = e; }
            const float ex = expf(v2 - v1), g1 = 1.f / (1.f + ex), g2 = ex / (1.f + ex);
            if (lane == 0) { tope[row] = e1 | (e2 << 8); topg[2 * row] = g1; topg[2 * row + 1] = g2;
                __hip_atomic_fetch_add((LAS unsigned*)&misc[16 + e1], 1u, __ATOMIC_RELAXED, __HIP_MEMORY_SCOPE_WORKGROUP);
                __hip_atomic_fetch_add((LAS unsigned*)&misc[16 + e2], 1u, __ATOMIC_RELAXED, __HIP_MEMORY_SCOPE_WORKGROUP); }
        }
    };
    if (gw < MV) fetch(rb0, gw);
    if (gw + NGW < MV) fetch(rb1, gw + NGW);
    for (int row = gw; row < MV; row += 2 * NGW) { body(rb0, row); if (row + NGW < MV) body(rb1, row + NGW); }
    if (router) { __syncthreads();
        if (tid < 8 && !dry) ((unsigned*)(ws + WS_CTL))[CW_CNTG + (moe_idx * 256 + (gw >> 3)) * 8 + tid] = misc[16 + tid];
        __syncthreads(); }
}

__device__ __forceinline__ void moe_starts(const unsigned char* ws, int moe_idx, int (&cnt)[8], int (&pstart)[9]) {
    const unsigned* c = (const unsigned*)(ws + WS_CTL) + CW_CNT + moe_idx * 64; int p = 0;
#pragma unroll
    for (int e = 0; e < 8; ++e) { cnt[e] = __builtin_amdgcn_readfirstlane((int)__hip_atomic_load(c + e, __ATOMIC_RELAXED, __HIP_MEMORY_SCOPE_AGENT)); pstart[e] = p; p += (cnt[e] + 255) >> 8; }
    pstart[8] = p;
}
__device__ __forceinline__ void assign_phase(unsigned char* ws, LAS unsigned char* lds, int gw, int NGW, int lane, int tid, int wave, int moe_idx) {
    const unsigned* cntg = (const unsigned*)(ws + WS_CTL) + CW_CNTG + moe_idx * 256 * 8;
    volatile LAS unsigned* misc = (volatile LAS unsigned*)(lds + MISC_OFF);
    const int vwg = gw >> 3, nwg = NGW >> 3;
    { const int e = wave; unsigned tot = 0, base = 0;
      for (int w = lane; w < nwg; w += 64) { const unsigned c = cntg[w * 8 + e]; tot += c; base += (w < vwg) ? c : 0u; }
#pragma unroll
      for (int o = 1; o < 64; o <<= 1) { tot += SHX(tot, o); base += SHX(base, o); }
      if (lane == 0) { misc[16 + e] = tot; misc[24 + e] = base; misc[32 + e] = 0u; } }
    __syncthreads();
    int cnt[8], pstart[9]; { int p = 0;
#pragma unroll
      for (int e = 0; e < 8; ++e) { cnt[e] = (int)misc[16 + e]; pstart[e] = p; p += (cnt[e] + 255) >> 8; } pstart[8] = p; }
    if (blockIdx.x == 0 && tid < 8) ((unsigned*)(ws + WS_CTL))[CW_CNT + moe_idx * 64 + tid] = misc[16 + tid];
    const int* tope = (const int*)(ws + WS_TOPE); const float* topg = (const float*)(ws + WS_TOPG);
    int* rowtok = (int*)(ws + WS_ROWTOK); int* rowdst = (int*)(ws + WS_ROWDST); float* rowgate = (float*)(ws + WS_ROWGATE);
    { const int row = gw + lane * NGW;
      if (row < MV) { const int te = tope[row];
#pragma unroll
          for (int slot = 0; slot < 2; ++slot) { const int e = (te >> (8 * slot)) & 255; int ps = 0; unsigned mb = 0;
#pragma unroll
              for (int ee = 0; ee < 8; ++ee) if (ee == e) { ps = pstart[ee]; mb = misc[24 + ee]; }
              const unsigned off = __hip_atomic_fetch_add((LAS unsigned*)&misc[32 + e], 1u, __ATOMIC_RELAXED, __HIP_MEMORY_SCOPE_WORKGROUP);
              const int pos = ps * 256 + (int)mb + (int)off;
              rowtok[pos] = row; rowdst[pos] = 2 * row + slot; rowgate[pos] = topg[2 * row + slot]; } } }
    if (blockIdx.x < 8) { const int e = blockIdx.x; int ps = 0, pe = 0, ce = 0;
#pragma unroll
        for (int ee = 0; ee < 8; ++ee) if (ee == e) { ps = pstart[ee]; pe = pstart[ee + 1]; ce = cnt[ee]; }
        for (int pos = ps * 256 + ce + tid; pos < pe * 256; pos += NTHREADS) { rowtok[pos] = -1; rowdst[pos] = -1; rowgate[pos] = 0.f; } }
}

constexpr int ML_RS = 72;
constexpr int ML_QS = 0, ML_KS = 9216, ML_KT = 18432, ML_VT = 27648, ML_CT = 48384, ML_CTB = 20736, ML_HS = 89856;
constexpr int ML_HSS = 132;
constexpr int ML_TAB = 123648, ML_NCH = 17;
constexpr int ML_TSC = ML_TAB + 7 * ML_NCH * 64 * 4;
static_assert(ML_TSC + 1024 <= MISC_OFF, "mLSTM LDS");
__device__ __forceinline__ bf16x8 ml_frag(LAS unsigned char* lds, int base, int row, int kcol) { return *(const LAS bf16x8*)(lds + base + (row * ML_RS + kcol) * 2); }

#ifndef PROBE_M2
#define PROBE_M2 0
#endif
template <int MODE>
__device__ __forceinline__ void mlstm_phase(unsigned char* ws, LAS unsigned char* lds, int layer, int tid, int wave, int lane, unsigned long long* pticks = nullptr) {
    unsigned long long pt0 = 0, pacc = 0; (void)pt0; (void)pacc;
#define PM2_BEGIN(k) do { if (PROBE_M2 == (k) && MODE == 2) pt0 = __builtin_amdgcn_s_memrealtime(); } while (0)
#define PM2_END(k) do { if (PROBE_M2 == (k) && MODE == 2) pacc += __builtin_amdgcn_s_memrealtime() - pt0; } while (0)
    PM2_BEGIN(1);
    const int item = blockIdx.x; const int bh = item >> 3, seg = item & 7, b = bh >> 3, h = bh & 7;
    if (MODE == 1 && seg == 7) return;
    const bf16_t* proj = (const bf16_t*)(ws + WS_PROJ); const float* gates = (const float*)(ws + WS_GATES);
    bf16_t* HG = (bf16_t*)(ws + WS_HG);
    float* STATE = (float*)(ws + WS_STATE); float* STSC = (float*)(ws + WS_STSC);
    LAS float* tab = (LAS float*)(lds + ML_TAB); LAS float* tsc = (LAS float*)(lds + ML_TSC);
    const int fr = lane & 15, quad = lane >> 4;
    f32x4 st[5]; float zero = 0.f; asm volatile("; opaque zero" : "+v"(zero));
#pragma unroll
    for (int i = 0; i < 5; ++i) st[i] = (f32x4){zero, zero, zero, zero};
    float m0 = (MODE == 1) ? -1.0e30f : 0.f;
    const int nch = SEG_CHUNKS + (seg == 0 ? 1 : 0);
    auto chunk_rows = [&](int ci, int& rbase, int& nv) { if (seg == 0 && ci == 0) { rbase = MREAL; nv = NMETA; } else { const int c = seg * SEG_CHUNKS + ci - (seg == 0 ? 1 : 0); rbase = b * SEQ + c * 64; nv = 64; } };
    for (int i = tid; i < 16 * ML_RS; i += NTHREADS) ((LAS bf16_t*)(lds + ML_VT))[128 * ML_RS + i] = (i < ML_RS) ? (bf16_t)0x3F80 : (bf16_t)0;
    for (int ci = wave; ci < nch; ci += NWAVES) {
        int rbase, nv; chunk_rows(ci, rbase, nv); const bool ok = lane < nv;
        const float li = ok ? gates[(size_t)(rbase + lane) * 16 + h] : -1.0e30f, f = ok ? gates[(size_t)(rbase + lane) * 16 + 8 + h] : 0.f;
        const float lf = ok ? (fminf(f, 0.f) - logf(1.f + expf(-fabsf(f)))) : 0.f;
        float bc = lf;
#pragma unroll
        for (int o = 1; o < 64; o <<= 1) { const float t = SHUP(bc, o); if (lane >= o) bc += t; }
        const float u = li - bc; float pm = u;
#pragma unroll
        for (int o = 1; o < 64; o <<= 1) { const float t = SHUP(pm, o); if (lane >= o) pm = fmaxf(pm, t); }
        tab[(0 * ML_NCH + ci) * 64 + lane] = bc; tab[(1 * ML_NCH + ci) * 64 + lane] = u; tab[(2 * ML_NCH + ci) * 64 + lane] = pm;
        if (lane == 63) { tsc[ci] = bc; tsc[32 + ci] = pm; }
    }
    if (MODE == 2 && seg > 0) {
        float ms[7], gs[7];
#pragma unroll
        for (int s2 = 0; s2 < 7; ++s2) { const bool ok = s2 < seg; ms[s2] = ok ? STSC[(bh * 7 + s2) * 4 + 0] : -1.0e30f; gs[s2] = ok ? STSC[(bh * 7 + s2) * 4 + 1] : 0.f; }
        float suf = 0.f; m0 = -1.0e30f;
#pragma unroll
        for (int s2 = 6; s2 >= 0; --s2) { ms[s2] += suf; suf += gs[s2]; m0 = fmaxf(m0, ms[s2]); }
#pragma unroll
        for (int s2 = 0; s2 < 7; ++s2) if (s2 < seg) {
            const float cf = fast_exp(ms[s2] - m0);
            const f32x4* sp = (const f32x4*)(STATE + (size_t)(bh * 7 + s2) * ST_FLOATS) + (wave * 5) * 64 + lane;
#pragma unroll
            for (int i = 0; i < 5; ++i) st[i] += sp[i * 64] * cf; }
    }
#pragma unroll
    for (int i = 0; i < 5; ++i) { const int dv = (i < 4) ? 16 * wave + fr : 128 + fr, dk = (i < 4) ? 16 * i + 4 * quad : 16 * wave + 4 * quad;
        if (i < 4 || wave < 4) { u32x2 w; w.x = pk2(st[i][0], st[i][1]); w.y = pk2(st[i][2], st[i][3]); *(LAS u32x2*)(lds + ML_CT + (dv * ML_RS + dk) * 2) = w; } }
    __syncthreads();
    if (wave == 0) {
        const float bl = lane < nch ? tsc[lane] : 0.f, um = lane < nch ? tsc[32 + lane] : 0.f; float m = m0, gs = 0.f;
        for (int ci = 0; ci < nch; ++ci) { const float blast = SHL(bl, ci), umax = SHL(um, ci), amax = blast + umax, mn = fmaxf(blast + m, amax);
            if (lane == 0) { tsc[64 + ci] = m; tsc[96 + ci] = fast_exp(blast + m - mn); tsc[128 + ci] = fast_exp(amax - mn); }
            m = mn; gs += blast; }
        if (lane == 0) { tsc[160] = m; tsc[161] = gs; }
    }
    __syncthreads();
    for (int idx = tid; idx < nch * 64; idx += NTHREADS) { const int ci = idx >> 6, j = idx & 63;
        const float bc = tab[(0 * ML_NCH + ci) * 64 + j], u = tab[(1 * ML_NCH + ci) * 64 + j], pm = tab[(2 * ML_NCH + ci) * 64 + j], mc = tsc[64 + ci], MM = fmaxf(pm, mc);
        tab[(3 * ML_NCH + ci) * 64 + j] = MM; tab[(4 * ML_NCH + ci) * 64 + j] = fast_exp(mc - MM); tab[(5 * ML_NCH + ci) * 64 + j] = fast_exp(-(bc + MM));
        tab[(6 * ML_NCH + ci) * 64 + j] = tsc[128 + ci] * fast_exp(u - tsc[32 + ci]); }
    float lnh[16];
    if (MODE == 2) {
#pragma unroll
        for (int e = 0; e < 16; ++e) lnh[e] = ((const float*)(ws + WS_SMALL))[SM_LNH + layer * D + h * M_V + 16 * (tid & 7) + e]; }
    u32x4 rq, rk, rv0, rv1, rg0, rg1;
    auto load_chunk = [&](int ci) {
        int rbase, nv; chunk_rows(ci, rbase, nv);
        if (MODE == 2) { const int i = tid >> 3, sg = tid & 7; const u32x4* ogp = (const u32x4*)(proj + (size_t)(rbase + (i < nv ? i : 0)) * PROJ_LD + 2048 + h * M_V + 16 * sg); rg0 = ogp[0]; rg1 = ogp[1]; }
        { const int j = tid >> 3, c8 = (tid & 7) * 8; const bf16_t* rp = proj + (size_t)(rbase + j) * PROJ_LD + h * 64 + c8;
          rq = (MODE == 2 && j < nv) ? *(const u32x4*)rp : (u32x4){0u, 0u, 0u, 0u}; }
        { const bf16_t* rp = proj + (size_t)(rbase + lane) * PROJ_LD; const bool ok = lane < nv;
          rk = ok ? *(const u32x4*)(rp + 512 + h * 64 + 8 * wave) : (u32x4){0u, 0u, 0u, 0u};
          rv0 = ok ? *(const u32x4*)(rp + 1024 + h * 128 + 16 * wave) : (u32x4){0u, 0u, 0u, 0u}; rv1 = ok ? *(const u32x4*)(rp + 1024 + h * 128 + 16 * wave + 8) : (u32x4){0u, 0u, 0u, 0u}; }
    };
    load_chunk(0);
    __syncthreads();
    PM2_END(1);
    for (int ci = 0; ci < nch; ++ci) {
        PM2_BEGIN(2);
        int rbase, nv; chunk_rows(ci, rbase, nv);
        const u32x4 g0 = rg0, g1 = rg1;
        const LAS float* tU = tab + (1 * ML_NCH + ci) * 64; const LAS float* tMM = tab + (3 * ML_NCH + ci) * 64; const LAS float* tSI = tab + (4 * ML_NCH + ci) * 64;
        const LAS float* tFL = tab + (5 * ML_NCH + ci) * 64; const LAS float* tWP = tab + (6 * ML_NCH + ci) * 64;
        const float sold = tsc[96 + ci];
        { if (MODE == 2) { const int j = tid >> 3, c8 = (tid & 7) * 8; *(LAS u32x4*)(lds + ML_QS + (j * ML_RS + c8) * 2) = rq; }
          const float wj = tWP[lane]; LAS bf16_t* kt = (LAS bf16_t*)(lds + ML_KT); LAS bf16_t* vt = (LAS bf16_t*)(lds + ML_VT);
          if (MODE == 2) *(LAS u32x4*)(lds + ML_KS + (lane * ML_RS + 8 * wave) * 2) = rk;
          const unsigned kk[4] = {rk.x, rk.y, rk.z, rk.w}, a[4] = {rv0.x, rv0.y, rv0.z, rv0.w}, c[4] = {rv1.x, rv1.y, rv1.z, rv1.w};
#pragma unroll
          for (int e = 0; e < 4; ++e) { kt[(8 * wave + 2 * e) * ML_RS + lane] = (bf16_t)f2bf(bf2f((unsigned short)(kk[e] & 0xffffu)) * wj); kt[(8 * wave + 2 * e + 1) * ML_RS + lane] = (bf16_t)f2bf(bf2f((unsigned short)(kk[e] >> 16)) * wj);
              vt[(16 * wave + 2 * e) * ML_RS + lane] = (bf16_t)(a[e] & 0xffffu); vt[(16 * wave + 2 * e + 1) * ML_RS + lane] = (bf16_t)(a[e] >> 16);
              vt[(16 * wave + 8 + 2 * e) * ML_RS + lane] = (bf16_t)(c[e] & 0xffffu); vt[(16 * wave + 8 + 2 * e + 1) * ML_RS + lane] = (bf16_t)(c[e] >> 16); } }
        __syncthreads();
        PM2_END(2); PM2_BEGIN(3);
        if (ci + 1 < nch) load_chunk(ci + 1);
        const int par = ci & 1, npar = par ^ 1;
        if (MODE == 2) {
            const int it = wave >> 1, dh = wave & 1, i = 16 * it + fr;
            const bf16x8 q0 = ml_frag(lds, ML_QS, i, 8 * quad), q1 = ml_frag(lds, ML_QS, i, 32 + 8 * quad);
            const float mmi = tMM[i], si = tSI[i], fl = tFL[i];
            f32x4 sT[4];
#pragma unroll
            for (int jt = 0; jt < 4; ++jt) { sT[jt] = (f32x4){0.f, 0.f, 0.f, 0.f};
                if (jt <= it) {
                    sT[jt] = __builtin_amdgcn_mfma_f32_16x16x32_bf16(ml_frag(lds, ML_KS, 16 * jt + fr, 8 * quad), q0, sT[jt], 0, 0, 0);
                    sT[jt] = __builtin_amdgcn_mfma_f32_16x16x32_bf16(ml_frag(lds, ML_KS, 16 * jt + fr, 32 + 8 * quad), q1, sT[jt], 0, 0, 0);
                    const f32x4 uj = *(const LAS f32x4*)(tU + 16 * jt + 4 * quad);
#pragma unroll
                    for (int r = 0; r < 4; ++r) { const bool vis = (jt < it) || (4 * quad + r <= fr); sT[jt][r] = vis ? sT[jt][r] * fast_exp(uj[r] - mmi) : 0.f; } } }
            f32x4 o1[4], o2[4], d1 = (f32x4){0.f, 0.f, 0.f, 0.f}, d2 = (f32x4){0.f, 0.f, 0.f, 0.f};
#pragma unroll
            for (int dt = 0; dt < 4; ++dt) { o1[dt] = (f32x4){0.f, 0.f, 0.f, 0.f}; o2[dt] = (f32x4){0.f, 0.f, 0.f, 0.f}; }
#pragma unroll
            for (int u = 0; u < 2; ++u) if (2 * u <= it) {
                u32x4 pw; pw.x = cvt_pk_bf16(sT[2 * u][0], sT[2 * u][1]); pw.y = cvt_pk_bf16(sT[2 * u][2], sT[2 * u][3]); pw.z = cvt_pk_bf16(sT[2 * u + 1][0], sT[2 * u + 1][1]); pw.w = cvt_pk_bf16(sT[2 * u + 1][2], sT[2 * u + 1][3]);
                const bf16x8 pf = __builtin_bit_cast(bf16x8, pw);
#pragma unroll
                for (int dt = 0; dt < 5; ++dt) { const int vrow = dt < 4 ? 16 * (4 * dh + dt) + fr : 128 + fr;
                    const LAS bf16_t* vr = (const LAS bf16_t*)(lds + ML_VT) + vrow * ML_RS + 32 * u + 4 * quad;
                    u32x4 vw; const u32x2 a = *(const LAS u32x2*)vr, c = *(const LAS u32x2*)(vr + 16); vw.x = a.x; vw.y = a.y; vw.z = c.x; vw.w = c.y;
                    if (dt < 4) o1[dt] = __builtin_amdgcn_mfma_f32_16x16x32_bf16(__builtin_bit_cast(bf16x8, vw), pf, o1[dt], 0, 0, 0);
                    else d1 = __builtin_amdgcn_mfma_f32_16x16x32_bf16(__builtin_bit_cast(bf16x8, vw), pf, d1, 0, 0, 0); } }
#pragma unroll
            for (int dt = 0; dt < 5; ++dt) { const int crow = dt < 4 ? 16 * (4 * dh + dt) + fr : 128 + fr;
                const bf16x8 c0 = ml_frag(lds, ML_CT + par * ML_CTB, crow, 8 * quad), c1 = ml_frag(lds, ML_CT + par * ML_CTB, crow, 32 + 8 * quad);
                if (dt < 4) { o2[dt] = __builtin_amdgcn_mfma_f32_16x16x32_bf16(c0, q0, o2[dt], 0, 0, 0); o2[dt] = __builtin_amdgcn_mfma_f32_16x16x32_bf16(c1, q1, o2[dt], 0, 0, 0); }
                else { d2 = __builtin_amdgcn_mfma_f32_16x16x32_bf16(c0, q0, d2, 0, 0, 0); d2 = __builtin_amdgcn_mfma_f32_16x16x32_bf16(c1, q1, d2, 0, 0, 0); } }
            float den = d1[0] + si * d2[0]; den = lx_(den, fr);
            const float rinv = __builtin_amdgcn_rcpf(fmaxf(fabsf(den), fl));
#pragma unroll
            for (int dt = 0; dt < 4; ++dt) *(LAS f32x4*)(lds + ML_HS + (i * ML_HSS + 16 * (4 * dh + dt) + 4 * quad) * 4) = (o1[dt] + o2[dt] * si) * rinv;
        }
        { bf16x8 vb[2];
#pragma unroll
          for (int ks = 0; ks < 2; ++ks) vb[ks] = ml_frag(lds, ML_VT, 16 * wave + fr, 32 * ks + 8 * quad);
#pragma unroll
          for (int mt2 = 0; mt2 < 4; ++mt2) { st[mt2] = st[mt2] * sold;
#pragma unroll
              for (int ks = 0; ks < 2; ++ks) st[mt2] = __builtin_amdgcn_mfma_f32_16x16x32_bf16(ml_frag(lds, ML_KT, 16 * mt2 + fr, 32 * ks + 8 * quad), vb[ks], st[mt2], 0, 0, 0); }
          if (wave < 4) { st[4] = st[4] * sold;
#pragma unroll
              for (int ks = 0; ks < 2; ++ks) st[4] = __builtin_amdgcn_mfma_f32_16x16x32_bf16(ml_frag(lds, ML_KT, 16 * wave + fr, 32 * ks + 8 * quad), ml_frag(lds, ML_VT, 128 + fr, 32 * ks + 8 * quad), st[4], 0, 0, 0); }
          if (MODE == 2) {
#pragma unroll
              for (int i = 0; i < 5; ++i) { const int dv = (i < 4) ? 16 * wave + fr : 128 + fr, dk = (i < 4) ? 16 * i + 4 * quad : 16 * wave + 4 * quad;
                  if (i < 4 || wave < 4) { u32x2 w; w.x = pk2(st[i][0], st[i][1]); w.y = pk2(st[i][2], st[i][3]); *(LAS u32x2*)(lds + ML_CT + npar * ML_CTB + (dv * ML_RS + dk) * 2) = w; } } }
        }
        __syncthreads();
        PM2_END(3); PM2_BEGIN(4);
        if (MODE == 2) {
            const int i = tid >> 3, sg = tid & 7; const LAS float* hp = (const LAS float*)(lds + ML_HS) + i * ML_HSS + 16 * sg;
            float x[16]; float s = 0.f;
#pragma unroll
            for (int e = 0; e < 16; ++e) { x[e] = hp[e]; s += x[e]; }
            s += SHX(s, 1); s += SHX(s, 2); s += SHX(s, 4);
            const float mean = s * (1.f / M_V); float q = 0.f;
#pragma unroll
            for (int e = 0; e < 16; ++e) { x[e] -= mean; q += x[e] * x[e]; }
            q += SHX(q, 1); q += SHX(q, 2); q += SHX(q, 4);
            const float rstd = 1.f / sqrtf(q * (1.f / M_V) + LN_EPS);
            if (i < nv && (nv == 64 || b == 0)) {
                const size_t row = (size_t)(rbase + i);
                const unsigned gw8[8] = {g0.x, g0.y, g0.z, g0.w, g1.x, g1.y, g1.z, g1.w}; unsigned ow[8];
#pragma unroll
                for (int e = 0; e < 8; ++e) { const float oga = bf2f((unsigned short)(gw8[e] & 0xffffu)), ogb = bf2f((unsigned short)(gw8[e] >> 16));
                    const float ya = x[2 * e] * rstd * lnh[2 * e] * __builtin_amdgcn_rcpf(1.f + fast_exp(-oga)), yb = x[2 * e + 1] * rstd * lnh[2 * e + 1] * __builtin_amdgcn_rcpf(1.f + fast_exp(-ogb));
                    ow[e] = pk2(ya, yb); }
                u32x4* op = (u32x4*)(HG + row * D + h * M_V + 16 * sg);
                op[0] = (u32x4){ow[0], ow[1], ow[2], ow[3]}; op[1] = (u32x4){ow[4], ow[5], ow[6], ow[7]};
            }
        }
        PM2_END(4);
    }
    if (PROBE_M2 && MODE == 2 && pticks) *pticks += pacc;
    if (MODE == 1) {
        f32x4* sp = (f32x4*)(STATE + (size_t)(bh * 7 + seg) * ST_FLOATS) + (wave * 5) * 64 + lane;
#pragma unroll
        for (int i = 0; i < 5; ++i) sp[i * 64] = (i < 4 || wave < 4) ? st[i] : (f32x4){0.f, 0.f, 0.f, 0.f};
        if (tid == 0) { STSC[(bh * 7 + seg) * 4 + 0] = tsc[160]; STSC[(bh * 7 + seg) * 4 + 1] = tsc[161]; }
    }
}

constexpr int AT_KRS = 72, AT_VRS = 280, AT_NK = 272;
constexpr int AT_KS = 0, AT_VT = AT_NK * AT_KRS * 2, AT_END = AT_VT + 64 * AT_VRS * 2;
static_assert(AT_END <= MISC_OFF, "attention LDS");
__device__ __forceinline__ void attn_phase(unsigned char* ws, LAS unsigned char* lds, int j_layer, int tid, int wave, int lane) {
    const bf16_t* Q = (const bf16_t*)(ws + WS_PROJ); const bf16_t* KB = (const bf16_t*)(ws + WS_KB); const bf16_t* VT = (const bf16_t*)(ws + WS_VB);
    unsigned char* HG8 = ws + WS_HG;
    const float* sinks = (const float*)(ws + WS_SMALL) + SM_SINKS + j_layer * A_HEADS;
    const int fr = lane & 15, quad = lane >> 4;
    LAS bf16_t* ks = (LAS bf16_t*)(lds + AT_KS); LAS bf16_t* vt = (LAS bf16_t*)(lds + AT_VT);
    u32x4 kreg[5], vreg[5]; bf16x8 qn[2][2];
    const int NREG = NBATCH * A_KV * (SEQ / WINDOW), NIT = NREG + A_KV;
    auto prefetch = [&](int it) {
        const bool meta = it >= NREG; const int b = meta ? 0 : it >> 8, g = meta ? it - NREG : (it >> 6) & 3, blk = meta ? -1 : it & 63;
#pragma unroll
        for (int i = 0; i < 5; ++i) { const int p = tid + i * NTHREADS; kreg[i] = (u32x4){0u, 0u, 0u, 0u}; vreg[i] = (u32x4){0u, 0u, 0u, 0u};
            if (p < AT_NK * 8) { const int kk = p >> 3, c8 = (p & 7) * 8;
                int row; if (kk >= 256) row = MREAL + kk - 256; else { const int tk = (blk - 1) * WINDOW + kk; row = (tk < 0 || meta) ? -1 : b * SEQ + tk; }
                if (row >= 0) kreg[i] = *(const u32x4*)(KB + (size_t)row * 256 + g * 64 + c8);
                const int d = p / 34, pc = p % 34; const bf16_t* src = VT + (size_t)(g * 64 + d) * MP;
                if (pc >= 32) vreg[i] = *(const u32x4*)(src + MREAL + (pc - 32) * 8);
                else { const int tk = (blk - 1) * WINDOW + pc * 8; if (tk >= 0 && !meta) vreg[i] = *(const u32x4*)(src + (size_t)b * SEQ + tk); } } }
    };
    auto qload = [&](int it, int mp) {
        const bool meta = it >= NREG; const int b = it >> 8, g = meta ? it - NREG : (it >> 6) & 3, blk = it & 63, qh = g * 4 + (wave >> 1);
#pragma unroll
        for (int x = 0; x < 2; ++x) { const size_t rowq = meta ? (size_t)MREAL + fr : (size_t)b * SEQ + blk * WINDOW + 16 * (4 * (wave & 1) + 2 * mp + x) + fr;
#pragma unroll
            for (int k2 = 0; k2 < 2; ++k2) qn[x][k2] = *(const bf16x8*)(Q + rowq * D + qh * 64 + 32 * k2 + 8 * quad); }
    };
    if ((int)blockIdx.x < NIT) { prefetch(blockIdx.x); qload(blockIdx.x, 0); }
    for (int it = blockIdx.x; it < NIT; it += gridDim.x) {
        const bool meta = it >= NREG; const int b = it >> 8, g = meta ? it - NREG : (it >> 6) & 3, blk = it & 63;
        __syncthreads();
#pragma unroll
        for (int i = 0; i < 5; ++i) { const int p = tid + i * NTHREADS;
            if (p < AT_NK * 8) { *(LAS u32x4*)(ks + (p >> 3) * AT_KRS + (p & 7) * 8) = kreg[i]; *(LAS u32x4*)(vt + (p / 34) * AT_VRS + (p % 34) * 8) = vreg[i]; } }
        __syncthreads();
        const bool has_next = it + (int)gridDim.x < NIT;
        if (has_next) prefetch(it + gridDim.x);
        const int qh = g * 4 + (wave >> 1); const float sink = sinks[qh];
#pragma unroll 1
        for (int mp = 0; mp < 2; ++mp) {
            if (meta && (mp > 0 || (wave & 1))) continue;
            const int t0 = meta ? 0 : 4 * (wave & 1) + 2 * mp;
            f32x4 s[2][11];
#pragma unroll
            for (int c = 0; c < 11; ++c) { const int kb = (c < 10) ? 16 * (t0 + c) : 256; s[0][c] = (f32x4){0.f, 0.f, 0.f, 0.f}; s[1][c] = (f32x4){0.f, 0.f, 0.f, 0.f};
#pragma unroll
                for (int k2 = 0; k2 < 2; ++k2) { const bf16x8 kf = *(const LAS bf16x8*)(ks + (kb + fr) * AT_KRS + 32 * k2 + 8 * quad);
                    if (c != 9) s[0][c] = __builtin_amdgcn_mfma_f32_16x16x32_bf16(kf, qn[0][k2], s[0][c], 0, 0, 0);
                    if (c != 0) s[1][c] = __builtin_amdgcn_mfma_f32_16x16x32_bf16(kf, qn[1][k2], s[1][c], 0, 0, 0); } }
            if (mp == 0) { if (!meta) qload(it, 1); } else if (has_next) qload(it + gridDim.x, 0);
            float inv[2];
#pragma unroll
            for (int x = 0; x < 2; ++x) {
                float m = sink;
#pragma unroll
                for (int c = 0; c < 10; ++c) { const int rc = c - x;
                    const bool tok = !meta && rc >= 0 && rc <= 8 && (blk > 0 || t0 + c >= 8);
#pragma unroll
                    for (int r = 0; r < 4; ++r) { const bool vis = tok && (rc != 0 || fr < 4 * quad + r) && (rc != 8 || fr >= 4 * quad + r);
                        s[x][c][r] = vis ? s[x][c][r] : -1.0e30f; m = fmaxf(m, s[x][c][r]); } }
#pragma unroll
                for (int r = 0; r < 4; ++r) { const bool vis = !meta || (4 * quad + r <= fr); s[x][10][r] = vis ? s[x][10][r] : -1.0e30f; m = fmaxf(m, s[x][10][r]); }
                m = fmaxf(m, SHX(m, 16)); m = fmaxf(m, SHX(m, 32));
                float sm = 0.f;
#pragma unroll
                for (int c = 0; c < 11; ++c)
#pragma unroll
                    for (int r = 0; r < 4; ++r) { const float p = fast_exp(s[x][c][r] - m); s[x][c][r] = p; sm += p; }
                sm += SHX(sm, 16); sm += SHX(sm, 32);
                inv[x] = 1.f / (sm + fast_exp(sink - m));
            }
            f32x4 o[2][4];
#pragma unroll
            for (int x = 0; x < 2; ++x)
#pragma unroll
                for (int dt = 0; dt < 4; ++dt) o[x][dt] = (f32x4){0.f, 0.f, 0.f, 0.f};
#pragma unroll
            for (int u = 0; u < 6; ++u) {
                const int kb0 = (u < 5) ? 16 * (t0 + 2 * u) : 256, kb1 = (u < 5) ? 16 * (t0 + 2 * u + 1) : 256;
                bf16x8 pf[2];
#pragma unroll
                for (int x = 0; x < 2; ++x) { u32x4 pw;
                    if (u < 5) { pw.x = cvt_pk_bf16(s[x][2 * u][0], s[x][2 * u][1]); pw.y = cvt_pk_bf16(s[x][2 * u][2], s[x][2 * u][3]); pw.z = cvt_pk_bf16(s[x][2 * u + 1][0], s[x][2 * u + 1][1]); pw.w = cvt_pk_bf16(s[x][2 * u + 1][2], s[x][2 * u + 1][3]); }
                    else { pw.x = cvt_pk_bf16(s[x][10][0], s[x][10][1]); pw.y = cvt_pk_bf16(s[x][10][2], s[x][10][3]); pw.z = 0u; pw.w = 0u; }
                    pf[x] = __builtin_bit_cast(bf16x8, pw); }
#pragma unroll
                for (int dt = 0; dt < 4; ++dt) { const LAS bf16_t* vr = vt + (16 * dt + fr) * AT_VRS + 4 * quad;
                    u32x4 vw; const u32x2 a = *(const LAS u32x2*)(vr + kb0), c2 = *(const LAS u32x2*)(vr + kb1); vw.x = a.x; vw.y = a.y; vw.z = c2.x; vw.w = c2.y;
                    const bf16x8 vf = __builtin_bit_cast(bf16x8, vw);
                    o[0][dt] = __builtin_amdgcn_mfma_f32_16x16x32_bf16(vf, pf[0], o[0][dt], 0, 0, 0);
                    o[1][dt] = __builtin_amdgcn_mfma_f32_16x16x32_bf16(vf, pf[1], o[1][dt], 0, 0, 0); } }
#pragma unroll
            for (int x = 0; x < 2; ++x) { if (meta && x > 0) continue;
                const size_t rowq = meta ? (size_t)MREAL + fr : (size_t)b * SEQ + blk * WINDOW + 16 * (t0 + x) + fr;
#pragma unroll
                for (int dt = 0; dt < 4; ++dt) { const float sv = inv[x] * F8_SO;
                    *(unsigned*)(HG8 + rowq * D + qh * 64 + 16 * dt + 4 * quad) = pk4_fp8(o[x][dt][0] * sv, o[x][dt][1] * sv, o[x][dt][2] * sv, o[x][dt][3] * sv); } }
        }
    }
}

#ifndef SITES
#define SITES 0xFFFF
#endif
#define SITE(n) ((SITES >> (n)) & 1)
#ifndef DUPMASK
#define DUPMASK 0
#endif
#define REPS(n) (1 + ((DUPMASK >> (n)) & 1))
#ifndef MK_PER_PHASE
#define MK_PER_PHASE 0
#endif
constexpr int PH_PER_LAYER = 12, N_PHASES = 1 + 4 * PH_PER_LAYER;

__global__ void __launch_bounds__(NTHREADS, 2) fwd(Params P) {
    extern __shared__ __attribute__((aligned(16))) unsigned char lds_raw[];
    LAS unsigned char* const lds0 = (LAS unsigned char*)lds_raw;
    const int wave_s = __builtin_amdgcn_readfirstlane((int)threadIdx.x >> 6);
    const int G = gridDim.x;
    const int vcu = (G % 8 == 0) ? ((int)blockIdx.x % 8) * (G / 8) + (int)blockIdx.x / 8 : (int)blockIdx.x;
    const int NGW = G * NWAVES;
    unsigned char* const wsbase = P.ws;
    volatile LAS unsigned* misc = (volatile LAS unsigned*)(lds0 + MISC_OFF);
    if (threadIdx.x < 64) misc[threadIdx.x] = 0u;
    __syncthreads();
    XcdBarrier bar = xcd_barrier_post((unsigned*)(wsbase + WS_CTL) + CW_BAR + P.li * 4096, misc + 8);
    const int lo = P.ph_lo, hi = P.ph_hi;
    unsigned long long idle_ticks = 0; (void)idle_ticks;
#define RUN(idx) ((idx) >= lo && (idx) < hi)
#ifndef PROBE_IDLE
#define PROBE_IDLE 0
#endif
#if PROBE_IDLE
#ifndef PROBE_KMASK
#define PROBE_KMASK 0xFFFF
#endif
#define SEAM(idx) do { if ((idx) + 1 < hi) { const unsigned long long _t0 = __builtin_amdgcn_s_memrealtime(); xcd_barrier(bar, tid == 0); const int _k = (idx) == 0 ? 15 : ((idx) - 1) % PH_PER_LAYER; \
        if ((PROBE_KMASK >> _k) & 1) idle_ticks += __builtin_amdgcn_s_memrealtime() - _t0; } } while (0)
#else
#define SEAM(idx) do { if ((idx) + 1 < hi) xcd_barrier(bar, tid == 0); } while (0)
#endif
#define IDS() unsigned mall = ~0u; asm volatile("; opaque mask" : "+s"(mall)); int tid = wave_s * 64 + (int)__builtin_amdgcn_mbcnt_hi(mall, __builtin_amdgcn_mbcnt_lo(mall, 0u)); asm volatile("; opaque tid" : "+v"(tid));   size_t wsz = 0; asm volatile("; opaque ws offset" : "+s"(wsz)); unsigned char* ws = wsbase + wsz;   \
              LAS unsigned char* lds = lds0; asm volatile("; opaque lds" : "+s"(lds)); \
              const int lane = tid & 63, wave = __builtin_amdgcn_readfirstlane(tid >> 6); const int gw = vcu * NWAVES + wave; (void)lane; (void)gw; (void)ws

    for (int rep = 0; rep < REPS(0); ++rep) if (SITE(0) && RUN(0)) { IDS(); p0_prologue(P, lds, gw, NGW, wave, lane, bar, tid); SEAM(0); }

    for (int l = 0; l < 4; ++l) {
        const int pb = 1 + l * PH_PER_LAYER;
        const bool moe = (l & 1) != 0; const int fi = l >> 1;
        if (l < 2) {
            for (int rep = 0; rep < REPS(1); ++rep) if (SITE(1) && RUN(pb + 0)) {
                IDS();
                pg8::DenseOrder S; S.init(MREAL / 256, 12, G, (int)blockIdx.x);
                const float* smi = (const float*)(ws + WS_SMALL); const float asc = l == 0 ? smi[SM_WSCALE + 23] : smi[SM_ASCALE + 2 * l - 1];
                EpiProj E{(bf16_t*)(ws + WS_PROJ), (float*)(ws + WS_GATES), smi + SM_BGATE + l * 16, asc * smi[SM_WSCALE + 21 + l]};
                const bf16_t* HBp = (const bf16_t*)(ws + WS_HB); const bf16_t* Wp = (const bf16_t*)(ws + WS_WIN) + (size_t)l * M_INP * D;
                pg8::gemm_phase<EpiProj, pg8::DenseOrder, 2>(lds, ws + WS_HB8, ws + WS_WIN8 + (size_t)l * 3072 * D, D, S, E, tid);
                bf16_t* PROJ = (bf16_t*)(ws + WS_PROJ); float* GATES = (float*)(ws + WS_GATES); const float* bg = (const float*)(ws + WS_SMALL) + SM_BGATE + l * 16;
                unsigned* itemctr = (unsigned*)(ws + WS_CTL) + CW_ITEM + l * 8 + 1; int par = 0;
                for (int item = claim_item(itemctr, lds, tid); item < 192; item = claim_item(itemctr, lds, tid), par ^= 1) { const bf16_t* B1[1] = {Wp + (size_t)item * 16 * D};
                    skinny_item<1>(HBp + (size_t)MREAL * D, D, B1, D, wave, lane, lds, par, [&](const f32x4 (&a)[1], int fr, int quad) {
#pragma unroll
                        for (int r = 0; r < 4; ++r) PROJ[(size_t)(MREAL + 4 * quad + r) * PROJ_LD + item * 16 + fr] = (bf16_t)f2bf(a[0][r]); }); }
                { const int fr = lane & 15, quad = lane >> 4; const bf16_t* bp = Wp + (size_t)(3072 + fr) * D + 8 * quad; const float bias = bg[fr];
                  for (int rt = gw; rt < MV / 16; rt += NGW) { const bf16_t* ap = HBp + (size_t)(rt * 16 + fr) * D + 8 * quad;
                      f32x4 a0 = (f32x4){0.f, 0.f, 0.f, 0.f}, a1 = (f32x4){0.f, 0.f, 0.f, 0.f};
#pragma unroll 8
                      for (int k = 0; k < D; k += 64) { a0 = __builtin_amdgcn_mfma_f32_16x16x32_bf16(*(const bf16x8*)(ap + k), *(const bf16x8*)(bp + k), a0, 0, 0, 0);
                          a1 = __builtin_amdgcn_mfma_f32_16x16x32_bf16(*(const bf16x8*)(ap + k + 32), *(const bf16x8*)(bp + k + 32), a1, 0, 0, 0); }
#pragma unroll
                      for (int r = 0; r < 4; ++r) GATES[(size_t)(rt * 16 + 4 * quad + r) * 16 + fr] = a0[r] + a1[r] + bias; } }
                SEAM(pb + 0); }
            for (int rep = 0; rep < REPS(2); ++rep) if (SITE(2) && RUN(pb + 1)) { IDS(); mlstm_phase<1>(ws, lds, l, tid, wave, lane); SEAM(pb + 1); }
            for (int rep = 0; rep < REPS(3); ++rep) if (SITE(3) && RUN(pb + 2)) { IDS(); mlstm_phase<2>(ws, lds, l, tid, wave, lane, &idle_ticks); SEAM(pb + 2); }
        } else {
            for (int rep = 0; rep < REPS(4); ++rep) if (SITE(4) && RUN(pb + 0)) {
                IDS();
                pg8::DenseOrder S; S.init(MREAL / 256, l == 2 ? 6 : 4, G, (int)blockIdx.x);
                const float* smq = (const float*)(ws + WS_SMALL); const float asc = smq[SM_ASCALE + 2 * l - 1];
                EpiQKV E{(bf16_t*)(ws + WS_PROJ), (bf16_t*)(ws + WS_KB), (bf16_t*)(ws + WS_VB), (const float*)(ws + WS_ROPE), asc * smq[SM_WSCALE + 18 + (l - 2)] * 0.125f, asc * smq[SM_WSCALE + 20], lds + RING_BYTES};
                const bf16_t* HBp = (const bf16_t*)(ws + WS_HB); const bf16_t* Wp = (const bf16_t*)(ws + (l == 2 ? WS_WQKV : WS_WQ3));
                pg8::gemm_phase<EpiQKV, pg8::DenseOrder, 2>(lds, ws + WS_HB8, ws + WS_WQKV8 + (l == 2 ? 0 : (size_t)1536 * D), D, S, E, tid);
                bf16_t* Qp = (bf16_t*)(ws + WS_PROJ); bf16_t* KBp = (bf16_t*)(ws + WS_KB); bf16_t* VTp = (bf16_t*)(ws + WS_VB); const float* rope = (const float*)(ws + WS_ROPE);
                unsigned* itemctr = (unsigned*)(ws + WS_CTL) + CW_ITEM + l * 8 + 2; int par = 0;
                for (int item = claim_item(itemctr, lds, tid); item < (l == 2 ? 96 : 64); item = claim_item(itemctr, lds, tid), par ^= 1) { const bf16_t* B1[1] = {Wp + (size_t)item * 16 * D};
                    skinny_item<1>(HBp + (size_t)MREAL * D, D, B1, D, wave, lane, lds, par, [&](const f32x4 (&a)[1], int fr, int quad) {
                        const int col = item * 16 + fr; const bool dorope = (item < 80) && ((item & 3) == 0);
#pragma unroll
                        for (int r = 0; r < 4; ++r) { const int pos = 4 * quad + r; float x = a[0][r]; const float y = SHX(x, 8);
                            if (dorope) { const float c = rope[pos * 16 + (fr & 7)], sn = rope[pos * 16 + 8 + (fr & 7)]; x = (fr < 8) ? x * c - y * sn : x * c + y * sn; }
                            const bf16_t o = (bf16_t)f2bf(x); const size_t row = (size_t)MREAL + pos;
                            if (item < 64) Qp[row * D + col] = o; else if (item < 80) KBp[row * 256 + col - 1024] = o; else VTp[(size_t)(col - 1280) * MP + row] = o; } });
                }
                SEAM(pb + 0); }
            for (int rep = 0; rep < REPS(5); ++rep) if (SITE(5) && RUN(pb + 1)) { IDS(); attn_phase(ws, lds, l - 2, tid, wave, lane); SEAM(pb + 1); }
        }
        for (int rep = 0; rep < REPS(6); ++rep) if (SITE(6) && RUN(pb + 3)) {
            IDS();
            pg8::DenseOrder S; S.init(MREAL / 256, 4, G, (int)blockIdx.x);
            const float* smp = (const float*)(ws + WS_SMALL);
            EpiRes E{(bf16_t*)(ws + WS_H), (const float*)(ws + WS_STATS), l > 0 ? smp + SM_LNG + (size_t)(2 * l - 1) * D : nullptr, smp + SM_LNB + (size_t)(l > 0 ? 2 * l - 1 : 0) * D, P.in[I_X], 1.f};
            if (l < 2) {
            const bf16_t* Ap = (const bf16_t*)(ws + WS_HG); const bf16_t* Wp = (const bf16_t*)(ws + WS_WOUT) + (size_t)(l & 1) * D * D;
            pg8::gemm_phase(lds, Ap, Wp, D, S, E, tid);
            unsigned* itemctr = (unsigned*)(ws + WS_CTL) + CW_ITEM + l * 8 + 3; int par = 0;
            for (int item = claim_item(itemctr, lds, tid); item < 64; item = claim_item(itemctr, lds, tid), par ^= 1) { const bf16_t* B1[1] = {Wp + (size_t)item * 16 * D};
                skinny_item<1>(Ap + (size_t)MREAL * D, D, B1, D, wave, lane, lds, par, [&](const f32x4 (&a)[1], int fr, int quad) { const int col = item * 16 + fr;
#pragma unroll
                    for (int r = 0; r < 4; ++r) { const size_t row = (size_t)MREAL + 4 * quad + r; float h = E.lg ? bf2f(E.H[row * D + col]) : P.in[I_META][(size_t)(4 * quad + r) * D + col];
                        if (E.lg) h = (h - E.stats[2 * row]) * E.stats[2 * row + 1] * E.lg[col] + E.lb[col];
                        E.H[row * D + col] = (bf16_t)f2bf(h * ALPHA + a[0][r]); } });
            }
            } else {
            EpiRes E8 = E; E8.sc = F8_INVO;
            const unsigned char* Ap = ws + WS_HG; const unsigned char* Wp = ws + WS_WO8 + (size_t)(l & 1) * D * D;
            pg8::gemm_phase<EpiRes, pg8::DenseOrder, 1>(lds, Ap, Wp, D, S, E8, tid);
            unsigned* itemctr = (unsigned*)(ws + WS_CTL) + CW_ITEM + l * 8 + 4; int par = 0;
            for (int item = claim_item(itemctr, lds, tid); item < 64; item = claim_item(itemctr, lds, tid), par ^= 1) { const unsigned char* B1[1] = {Wp + (size_t)item * 16 * D};
                skinny_item8<1>(Ap + (size_t)MREAL * D, D, B1, D, wave, lane, lds, par, [&](const f32x4 (&a)[1], int fr, int quad) { const int col = item * 16 + fr;
#pragma unroll
                    for (int r = 0; r < 4; ++r) { const size_t row = (size_t)MREAL + 4 * quad + r; float h = bf2f(E.H[row * D + col]);
                        h = (h - E.stats[2 * row]) * E.stats[2 * row + 1] * E.lg[col] + E.lb[col];
                        E.H[row * D + col] = (bf16_t)f2bf(h * ALPHA + a[0][r] * F8_INVO); } });
            }
            }
            SEAM(pb + 3); }
        for (int rep = 0; rep < (moe ? REPS(14) : REPS(7)); ++rep) if (SITE(7) && RUN(pb + 4)) { IDS(); ln_phase(ws, nullptr, lds, gw, NGW, lane, tid, l * 2 + 0, false, moe, fi, false, moe && rep > 0, true); SEAM(pb + 4); }
        if (!moe) {
            for (int rep = 0; rep < REPS(8); ++rep) if (SITE(8) && RUN(pb + 5)) {
                IDS();
                pg8::DenseOrder S; S.init(MREAL / 256, 2 * D_FF / 256, G, (int)blockIdx.x);
                EpiSwiglu8 E{ws + WS_ACT, D_FF, ((const float*)(ws + WS_SMALL))[SM_ASCALE + 2 * l], (const float*)(ws + WS_SMALL) + SM_WSCALE + fi, 0};
                const bf16_t* HBp = (const bf16_t*)(ws + WS_HB); const bf16_t* Wp = (const bf16_t*)(ws + WS_WGU) + (size_t)fi * 2 * D_FF * D;
                pg8::gemm_phase<EpiSwiglu8, pg8::DenseOrder, 2>(lds, ws + WS_HB8, ws + WS_WGU8 + (size_t)fi * 2 * D_FF * D, D, S, E, tid);
                unsigned* itemctr = (unsigned*)(ws + WS_CTL) + CW_ITEM + l * 8 + 5; int par = 0;
                for (int item = claim_item(itemctr, lds, tid); item < D_FF / 16; item = claim_item(itemctr, lds, tid), par ^= 1) {
                    const int brow = 256 * (item >> 3) + 16 * (item & 7); const bf16_t* B2[2] = {Wp + (size_t)brow * D, Wp + (size_t)(brow + 128) * D};
                    skinny_item<2>(HBp + (size_t)MREAL * D, D, B2, D, wave, lane, lds, par, [&](const f32x4 (&a)[2], int fr, int quad) {
#pragma unroll
                        for (int r = 0; r < 4; ++r) E.act[(size_t)(MREAL + 4 * quad + r) * D_FF + item * 16 + fr] = (unsigned char)(pk4_fp8(EpiSwiglu::silu_mul(a[0][r], a[1][r]) * F8_SACT, 0.f, 0.f, 0.f) & 0xffu); });
                }
                SEAM(pb + 5); }
            for (int rep = 0; rep < REPS(9); ++rep) if (SITE(9) && RUN(pb + 6)) {
                IDS();
                pg8::DenseOrder S; S.init(MREAL / 256, 4, G, (int)blockIdx.x);
                const float* smp = (const float*)(ws + WS_SMALL);
                EpiRes E{(bf16_t*)(ws + WS_H), (const float*)(ws + WS_STATS), smp + SM_LNG + (size_t)(2 * l) * D, smp + SM_LNB + (size_t)(2 * l) * D, nullptr, F8_INVD};
                const unsigned char* Ap = ws + WS_ACT; const unsigned char* Wp = ws + WS_WDN8 + (size_t)fi * D * D_FF;
                pg8::gemm_phase<EpiRes, pg8::DenseOrder, true>(lds, Ap, Wp, D_FF, S, E, tid);
                unsigned* itemctr = (unsigned*)(ws + WS_CTL) + CW_ITEM + l * 8 + 6; int par = 0;
                for (int item = claim_item(itemctr, lds, tid); item < 64; item = claim_item(itemctr, lds, tid), par ^= 1) { const unsigned char* B1[1] = {Wp + (size_t)item * 16 * D_FF};
                    skinny_item8<1>(Ap + (size_t)MREAL * D_FF, D_FF, B1, D_FF, wave, lane, lds, par, [&](const f32x4 (&a)[1], int fr, int quad) { const int col = item * 16 + fr;
#pragma unroll
                        for (int r = 0; r < 4; ++r) { const size_t row = (size_t)MREAL + 4 * quad + r; float h = bf2f(E.H[row * D + col]);
                            h = (h - E.stats[2 * row]) * E.stats[2 * row + 1] * E.lg[col] + E.lb[col];
                            E.H[row * D + col] = (bf16_t)f2bf(h * ALPHA + a[0][r] * E.sc); } });
                }
                SEAM(pb + 6); }
        } else {
            for (int rep = 0; rep < REPS(10); ++rep) if (SITE(10) && RUN(pb + 5)) { IDS(); assign_phase(ws, lds, gw, NGW, lane, tid, wave, fi); SEAM(pb + 5); }
            for (int rep = 0; rep < REPS(11); ++rep) if (SITE(11) && RUN(pb + 6)) {
                IDS();
                int cnt[8]; pg8::GroupedOrder S; moe_starts(ws, fi, cnt, S.pstart);
                S.o.init(S.pstart[8], 2 * D_FF_EXP / 256, G, (int)blockIdx.x); S.nexp_rows = 2 * D_FF_EXP; S.rowtok = (const int*)(ws + WS_ROWTOK);
                EpiSwiglu8 E{ws + WS_ACT, D_FF_EXP, ((const float*)(ws + WS_SMALL))[SM_ASCALE + 2 * l], (const float*)(ws + WS_SMALL) + SM_WSCALE + 2 + fi * 8, 2 * D_FF_EXP};
                pg8::gemm_phase<EpiSwiglu8, pg8::GroupedOrder, 2>(lds, ws + WS_HB8, ws + WS_WGUE8 + (size_t)fi * 8 * 2 * D_FF_EXP * D, D, S, E, tid);
                SEAM(pb + 6); }
            for (int rep = 0; rep < REPS(12); ++rep) if (SITE(12) && RUN(pb + 7)) {
                IDS();
                int cnt[8]; pg8::GroupedOrder S; moe_starts(ws, fi, cnt, S.pstart);
                S.o.init(S.pstart[8], 4, G, (int)blockIdx.x); S.nexp_rows = D; S.rowtok = nullptr;
                EpiScatter E{(bf16_t*)(ws + WS_CONTRIB), (const int*)(ws + WS_ROWDST), (const float*)(ws + WS_ROWGATE), F8_INVD};
                pg8::gemm_phase<EpiScatter, pg8::GroupedOrder, true>(lds, ws + WS_ACT, ws + WS_WDNE8 + (size_t)fi * 8 * D * D_FF_EXP, D_FF_EXP, S, E, tid);
                SEAM(pb + 7); }
        }
        for (int rep = 0; rep < (moe ? (l == 1 ? REPS(15) : 1) : REPS(13)); ++rep) if (SITE(13) && RUN(pb + 10)) { IDS(); ln_phase(ws, P.out, lds, gw, NGW, lane, tid, l * 2 + 1, moe, false, 0, l == 3, moe && rep == 0 && REPS(15) > 1, l <= 2, l == 0); SEAM(pb + 10); }
    }
#if PROBE_IDLE
    { unsigned* ctl = (unsigned*)(wsbase + WS_CTL); IDS();
      if (tid == 0) __hip_atomic_fetch_add(ctl + 2048, (unsigned)idle_ticks, __ATOMIC_RELAXED, __HIP_MEMORY_SCOPE_AGENT);
      xcd_barrier(bar, tid == 0);
      if (blockIdx.x == 0 && tid == 0) { const unsigned long long w = (unsigned long long)__hip_atomic_load(ctl + 2048, __ATOMIC_RELAXED, __HIP_MEMORY_SCOPE_AGENT) / (unsigned)G;
          const unsigned long long t0 = __builtin_amdgcn_s_memrealtime(); while (__builtin_amdgcn_s_memrealtime() - t0 < w) __builtin_amdgcn_s_sleep(8); } }
#endif
#undef RUN
#undef SEAM
#undef IDS
}

extern "C" void kernel_launch(void* const* d_in, const int* in_sizes, int n_in, void* d_out, int out_size, void* d_ws, size_t ws_size, hipStream_t stream) {
    static int grid = 0;
    if (grid == 0) {
        if (n_in != 18 || out_size != MREAL * D || ws_size < WS_END) { fprintf(stderr, "kernel_launch: unexpected shapes (n_in %d, out %d, ws %zu < %zu)\n", n_in, out_size, ws_size, (size_t)WS_END); grid = -1; return; }
        int dev = 0, cus = 0, per_cu = 0;
        if (hipGetDevice(&dev) != hipSuccess || hipDeviceGetAttribute(&cus, hipDeviceAttributeMultiprocessorCount, dev) != hipSuccess) { grid = -1; return; }
        if (hipFuncSetAttribute((const void*)fwd, hipFuncAttributeMaxDynamicSharedMemorySize, LDS_BYTES) != hipSuccess) { fprintf(stderr, "kernel_launch: hipFuncSetAttribute failed\n"); grid = -1; return; }
        if (hipOccupancyMaxActiveBlocksPerMultiprocessor(&per_cu, (const void*)fwd, NTHREADS, LDS_BYTES) != hipSuccess || per_cu < 1) fprintf(stderr, "kernel_launch: occupancy query reports %d\n", per_cu);
        (void)hipGetLastError();
        grid = cus > 256 ? 256 : cus;
    }
    if (grid < 0) return;
    (void)in_sizes;
    if (hipMemsetAsync((char*)d_ws + WS_CTL, 0, CTL_BYTES, stream) != hipSuccess) return;
    Params p{};
    for (int i = 0; i < 18; ++i) p.in[i] = (const float*)d_in[i];
    p.out = (float*)d_out; p.ws = (unsigned char*)d_ws;
#if MK_PER_PHASE
    int li = 0;
    for (int ph = 0; ph < N_PHASES; ++ph) {
        const int k = (ph - 1) % PH_PER_LAYER, l = (ph - 1) / PH_PER_LAYER;
        if (ph > 0) { const bool moe = l & 1; if (k == 2 && l >= 2) continue; if (k == 8 || k == 9 || k == 11) continue; if (k == 7 && !moe) continue; }
        p.ph_lo = ph; p.ph_hi = ph + 1; p.li = li++; p.pad = 0;
        hipLaunchKernelGGL(fwd, dim3(grid), dim3(NTHREADS), LDS_BYTES, stream, p);
    }
#else
    p.ph_lo = 0; p.ph_hi = N_PHASES; p.li = 0; p.pad = 0;
    hipLaunchKernelGGL(fwd, dim3(grid), dim3(NTHREADS), LDS_BYTES, stream, p);
#endif
}
```

```cpp
#include <hip/hip_runtime.h>
#include <cstdio>
#include <cstdint>

#define LAS __attribute__((address_space(3)))
#define GAS __attribute__((address_space(1)))
typedef unsigned short bf16_t;
typedef short bf16x8 __attribute__((ext_vector_type(8)));
typedef float f32x4 __attribute__((ext_vector_type(4)));
typedef float f32x2 __attribute__((ext_vector_type(2)));
typedef unsigned u32x4 __attribute__((ext_vector_type(4)));
typedef unsigned u32x2 __attribute__((ext_vector_type(2)));
typedef int i32x8 __attribute__((ext_vector_type(8)));
typedef int i32x4 __attribute__((ext_vector_type(4)));

constexpr int D = 1024, NBATCH = 4, SEQ = 8192, NMETA = 16;
constexpr int MREAL = NBATCH * SEQ;
constexpr int MV = MREAL + NMETA;
constexpr int MP = 129 * 256;
constexpr int M_HEADS = 8, M_QK = 64, M_V = 128;
constexpr int M_IN = 3088, M_INP = 3328;
constexpr int PROJ_LD = 3072;
constexpr int A_HEADS = 16, A_KV = 4, A_HD = 64, WINDOW = 128;
constexpr int D_FF = 2816, N_EXP = 8, D_FF_EXP = 3584;
constexpr float ALPHA = 1.681792830507429f;
constexpr float LN_EPS = 1e-5f;
constexpr int RP = 265 * 256;
constexpr int NSEG = 8, SEG_CHUNKS = 16;
constexpr int ST_FLOATS = 8 * 5 * 64 * 4;

constexpr size_t MiB = 1u << 20;
constexpr size_t al(size_t x) { return (x + 4095) & ~(size_t)4095; }
constexpr size_t WS_CTL = 0, CTL_BYTES = 1 * MiB;
constexpr size_t WS_WIN = WS_CTL + CTL_BYTES;
constexpr size_t WS_WOUT = WS_WIN + al((size_t)2 * M_INP * D * 2);
constexpr size_t WS_WQKV = WS_WOUT + al((size_t)2 * D * D * 2);
constexpr size_t WS_WQ3 = WS_WQKV + al((size_t)1536 * D * 2);
constexpr size_t WS_WO = WS_WQ3 + al((size_t)D * D * 2);
constexpr size_t WS_WGU = WS_WO + al((size_t)2 * D * D * 2);
constexpr size_t WS_WDN = WS_WGU + al((size_t)2 * 2 * D_FF * D * 2);
constexpr size_t WS_WGUE = WS_WDN + al((size_t)2 * D * D_FF * 2);
constexpr size_t WS_WDNE = WS_WGUE + al((size_t)16 * 2 * D_FF_EXP * D * 2);
constexpr size_t WS_H = WS_WDNE + al((size_t)16 * D * D_FF_EXP * 2);
constexpr size_t WS_HB = WS_H + al((size_t)MP * D * 4);
constexpr size_t WS_PROJ = WS_HB + al((size_t)MP * D * 2);
constexpr size_t WS_HG = WS_PROJ + (size_t)MP * PROJ_LD * 2;
constexpr size_t WS_CONTRIB = WS_PROJ;
constexpr size_t WS_KB = WS_HG + al((size_t)MP * D * 2);
constexpr size_t WS_VB = WS_KB + al((size_t)MP * 256 * 2);
constexpr size_t WS_GATES = WS_VB + al((size_t)MP * 256 * 2);
constexpr size_t WS_ACT = WS_GATES + al((size_t)MP * 16 * 4);
constexpr size_t WS_STATE = WS_ACT + al((size_t)RP * D_FF_EXP * 2);
constexpr size_t WS_STSC = WS_STATE + al((size_t)32 * 7 * ST_FLOATS * 4);
constexpr size_t WS_ROPE = WS_STSC + al((size_t)32 * 7 * 4 * 4);
constexpr size_t WS_TOPE = WS_ROPE + al((size_t)8208 * 16 * 4);
constexpr size_t WS_TOPG = WS_TOPE + al((size_t)MP * 4);
constexpr size_t WS_ROWTOK = WS_TOPG + al((size_t)MP * 8);
constexpr size_t WS_ROWDST = WS_ROWTOK + al((size_t)RP * 4);
constexpr size_t WS_ROWGATE = WS_ROWDST + al((size_t)RP * 4);
constexpr size_t WS_HB8 = WS_ROWGATE + al((size_t)RP * 4);
constexpr size_t WS_WGUE8 = WS_HB8 + al((size_t)MP * D);
constexpr size_t WS_WDNE8 = WS_WGUE8 + al((size_t)16 * 2 * D_FF_EXP * D);
constexpr size_t WS_WDN8 = WS_WDNE8 + al((size_t)16 * D * D_FF_EXP);
constexpr size_t WS_WGU8 = WS_WDN8 + al((size_t)2 * D * D_FF);
constexpr size_t WS_ROWSC = WS_WGU8 + al((size_t)2 * 2 * D_FF * D);
constexpr size_t WS_WO8 = WS_ROWSC + al((size_t)MP * 4);
constexpr size_t WS_WQKV8 = WS_WO8 + al((size_t)2 * D * D);
constexpr size_t WS_WIN8 = WS_WQKV8 + al((size_t)2560 * D);
constexpr size_t WS_STATS = WS_WIN8 + al((size_t)2 * 3072 * D);
constexpr size_t WS_SMALL = WS_STATS + al((size_t)MP * 8);
constexpr int SM_BGATE = 0, SM_SINKS = 32, SM_BROUTER = 64, SM_LNH = 128, SM_LNG = SM_LNH + 2 * D, SM_LNB = SM_LNG + 8 * D, SM_WROUTER = SM_LNB + 8 * D, SM_WSCALE = SM_WROUTER + 2 * D * N_EXP, SM_ASCALE = SM_WSCALE + 24, SM_END = SM_WSCALE + 32;
constexpr size_t WS_END = WS_SMALL + al((size_t)SM_END * 4);
static_assert((size_t)MP * 2 * D * 4 <= (WS_KB - WS_PROJ), "contrib overlay fits PROJ+HG");
static_assert(WS_END <= (size_t)1792 * MiB, "workspace map exceeds the guaranteed d_ws size");

constexpr int CW_CNT = 1024;
constexpr int CW_CUR = 1024 + 256;
constexpr int CW_AMAX = 2560;
constexpr int CW_ITEM = 3072;
constexpr int CW_CNTG = 4096;
constexpr int CW_BAR = 16384;

constexpr int LDS_BYTES = 163840 - 512;
constexpr int RING_BYTES = 131072;
constexpr int MISC_OFF = LDS_BYTES - 256;

__device__ __forceinline__ unsigned f2bf(float f) { unsigned u = __builtin_bit_cast(unsigned, f); return (u + 0x7fffu + ((u >> 16) & 1u)) >> 16; }
__device__ __forceinline__ unsigned pk2(float lo, float hi) { return f2bf(lo) | (f2bf(hi) << 16); }
__device__ __forceinline__ unsigned cvt_pk_bf16(float lo, float hi) { unsigned r; asm volatile("v_cvt_pk_bf16_f32 %0, %1, %2" : "=v"(r) : "v"(lo), "v"(hi)); return r; }
__device__ __forceinline__ float bf2f(unsigned short b) { return __builtin_bit_cast(float, ((unsigned)b) << 16); }
__device__ __forceinline__ float lx_(float v, int src) { return __builtin_bit_cast(float, __builtin_amdgcn_ds_bpermute(src << 2, __builtin_bit_cast(int, v))); }
__device__ __forceinline__ unsigned lx_(unsigned v, int src) { return (unsigned)__builtin_amdgcn_ds_bpermute(src << 2, (int)v); }
#define SHX(v, o) lx_((v), lane ^ (o))
#define SHUP(v, o) lx_((v), lane >= (o) ? lane - (o) : lane)
#define SHL(v, src) lx_((v), (src))
__device__ __forceinline__ float wave_sum(float v, int lane) {
#pragma unroll
    for (int o = 1; o < 64; o <<= 1) v += SHX(v, o);
    return v;
}
__device__ __forceinline__ float fast_exp(float x) { return __builtin_amdgcn_exp2f(x * 1.4426950408889634f); }
__device__ __forceinline__ unsigned pk4_fp8(float a, float b, float c, float d) {
    a = __builtin_amdgcn_fmed3f(a, -448.f, 448.f); b = __builtin_amdgcn_fmed3f(b, -448.f, 448.f); c = __builtin_amdgcn_fmed3f(c, -448.f, 448.f); d = __builtin_amdgcn_fmed3f(d, -448.f, 448.f);
    int p = __builtin_amdgcn_cvt_pk_fp8_f32(a, b, 0, false); p = __builtin_amdgcn_cvt_pk_fp8_f32(c, d, p, true); return (unsigned)p; }
constexpr float F8_SA = 16.f, F8_SB = 256.f, F8_INV = 1.f / (16.f * 256.f);
constexpr float F8_SACT = 8.f, F8_SBD = 1024.f, F8_INVD = 1.f / (8.f * 1024.f);
constexpr float F8_SO = 32.f, F8_SWO = 512.f, F8_INVO = 1.f / (32.f * 512.f);
#define LDS_WAIT() asm volatile("s_waitcnt lgkmcnt(0)" ::: "memory")
#define VM_WAIT() asm volatile("s_waitcnt vmcnt(0)" ::: "memory")

#define XB_TMO      128
#define XB_XCNT(j)  (256  + 64 * (j))
#define XB_XSUB(j)  (1280 + 64 * (j))
#define XB_XGEN(j)  (2304 + 64 * (j))
#define XB_TOP      3328
#define XB_TOPGEN   3392
#define XCD_BAR_WORDS 3456
#define XB_SPIN_CAP (1u << 18)
__device__ __forceinline__ unsigned xb_ld(unsigned* p)              { return __hip_atomic_load(p, __ATOMIC_RELAXED, __HIP_MEMORY_SCOPE_AGENT); }
__device__ __forceinline__ unsigned xb_add(unsigned* p, unsigned v) { return __hip_atomic_fetch_add(p, v, __ATOMIC_RELAXED, __HIP_MEMORY_SCOPE_AGENT); }
__device__ __forceinline__ unsigned xb_xcc_id() { return (unsigned)__builtin_amdgcn_s_getreg((3 << 11) | 20) & 0xFu; }
#define XB_SPIN(cond, bar) do { unsigned _sp = 0; while (cond) { __builtin_amdgcn_s_sleep(1); \
    if ((++_sp & 255u) == 0u) { if (xb_ld(&(bar)[XB_TMO])) break; if (_sp > XB_SPIN_CAP) { atomicAdd(&(bar)[XB_TMO], 1u); break; } } } } while (0)
struct XcdBarrier { unsigned* bar; unsigned x; volatile LAS unsigned* st; };
__device__ __forceinline__ XcdBarrier xcd_barrier_post(unsigned* bar, volatile LAS unsigned* st) {
    XcdBarrier b; b.bar = bar; b.x = xb_xcc_id(); b.st = st;
    if (threadIdx.x == 0) (void)xb_add(&bar[XB_XCNT(b.x)], 1u);
    return b;
}
__device__ __forceinline__ void xcd_barrier_complete(unsigned* bar, unsigned x, unsigned& nloc, unsigned& nx) {
    const unsigned G = gridDim.x * gridDim.y * gridDim.z;
    unsigned sum, cnt, mine, sp = 0u;
    for (;;) {
        sum = 0u; cnt = 0u; mine = 0u;
#pragma unroll
        for (unsigned j = 0; j < 16; ++j) { const unsigned c = xb_ld(&bar[XB_XCNT(j)]); sum += c; cnt += (c > 0u) ? 1u : 0u; mine = (j == x) ? c : mine; }
        if (sum == G) break;
        __builtin_amdgcn_s_sleep(1);
        if ((++sp & 255u) == 0u) { if (xb_ld(&bar[XB_TMO])) break; if (sp > XB_SPIN_CAP) { atomicAdd(&bar[XB_TMO], 1u); break; } }
    }
    nloc = mine > 0u ? mine : 1u; nx = cnt > 0u ? cnt : 1u;
}
__device__ __forceinline__ void xcd_barrier(const XcdBarrier& b, bool leader  ) {
    asm volatile("s_waitcnt vmcnt(0)" ::: "memory");
    __syncthreads();
    if (leader) {
        unsigned* bar = b.bar;
        __builtin_amdgcn_s_waitcnt(0);
        unsigned nloc = b.st[0], nx = b.st[1];
        if (nloc == 0u) { xcd_barrier_complete(bar, b.x, nloc, nx); b.st[0] = nloc; b.st[1] = nx; }
        const unsigned old = xb_add(&bar[XB_XSUB(b.x)], 1u);
        const unsigned gen = old / nloc;
        if (old + 1u == (gen + 1u) * nloc) {
            __builtin_amdgcn_fence(__ATOMIC_RELEASE, "agent");
            asm volatile("s_waitcnt vmcnt(0)" ::: "memory");
            const unsigned og = xb_add(&bar[XB_TOP], 1u);
            const unsigned tg = og / nx;
            if (og + 1u == (tg + 1u) * nx) xb_add(&bar[XB_TOPGEN], 1u);
            else XB_SPIN(xb_ld(&bar[XB_TOPGEN]) == tg, bar);
            __builtin_amdgcn_fence(__ATOMIC_ACQUIRE, "agent");
            xb_add(&bar[XB_XGEN(b.x)], 1u);
            asm volatile("s_waitcnt vmcnt(0)" ::: "memory");
        } else {
            XB_SPIN(xb_ld(&bar[XB_XGEN(b.x)]) == gen, bar);
            __builtin_amdgcn_fence(__ATOMIC_ACQUIRE, "agent");
            asm volatile("s_waitcnt vmcnt(0)" ::: "memory");
        }
    }
    __syncthreads();
}

namespace pg8 {
constexpr int BM = 256, BK = 64, HALF = 128, HTB = HALF * BK * 2, STAGE_BYTES = 8 * HTB, NXCD = 8, WGM = 8;
__host__ __device__ __forceinline__ int lds_byte(int r, int c) { const int st = (r >> 4) * 2 + (c >> 5), rr = r & 15, cc = c & 31, ob = rr * 64 + cc * 2; return st * 1024 + (ob ^ (((ob >> 9) & 1) << 5)); }
__host__ __device__ __forceinline__ void stage_rc(int b, int& R, int& C) { const int st = b / 1024, sb = b % 1024, swz = sb ^ (((sb >> 9) & 1) << 5); R = (st >> 1) * 16 + swz / 64; C = (st & 1) * 32 + (swz % 64) / 2; }
__host__ __device__ __forceinline__ int perm32(int rho) { const int n = rho >> 4, i = rho & 15; return 8 * (i >> 2) + 4 * n + (i & 3); }

struct Unit { int pm, pn, brow; };

struct DenseOrder {
    int nM, nN, nwg, G, c;
    __device__ void init(int nM_, int nN_, int G_, int c_) { nM = nM_; nN = nN_; nwg = nM * nN; G = G_; c = c_; }
    __device__ __forceinline__ bool next(int i, Unit& u) const {
        const long L = (long)i * G + c; if (L >= nwg) return false;
        int wgid = (int)L; { const int q = nwg / NXCD, r = nwg % NXCD, xcd = wgid % NXCD, off = wgid / NXCD; wgid = (xcd < r ? xcd * (q + 1) : r * (q + 1) + (xcd - r) * q) + off; }
        const int nig = WGM * nN, gid = wgid / nig, fm = gid * WGM, gsz = (nM - fm) < WGM ? (nM - fm) : WGM;
        u.pm = fm + ((wgid % nig) % gsz); u.pn = (wgid % nig) / gsz; u.brow = u.pn * BM; return true;
    }
    __device__ __forceinline__ int a_row(const Unit& u, int r) const { return u.pm * BM + r; }
};
struct GroupedOrder {
    DenseOrder o; int pstart[9]; int nexp_rows;
    const int* rowtok;
    __device__ __forceinline__ bool next(int i, Unit& u) const {
        if (!o.next(i, u)) return false;
        int e = 0;
#pragma unroll
        for (int k = 1; k < 8; ++k) e += (u.pm >= pstart[k]) ? 1 : 0;
        u.brow = e * nexp_rows + u.pn * BM; return true;
    }
    __device__ __forceinline__ int a_row(const Unit& u, int r) const {
        const int pos = u.pm * BM + r; if (!rowtok) return pos;
        const int t = rowtok[pos]; return t < 0 ? 0 : t;
    }
};

template <class Epi, class Sched, int MODE = 0>
__device__ __forceinline__ void gemm_phase(LAS unsigned char* lds, const void* Abase, const void* Btbase, const int K, const Sched& S, const Epi& E, int tid) {
    constexpr int ES = MODE ? 1 : 2;
    constexpr bool FP8 = (MODE == 1);
    asm volatile("; opaque tid" : "+v"(tid));
    const int wid = __builtin_amdgcn_readfirstlane(tid >> 6), lane = tid & 63, wr = wid >> 2, wc = wid & 3, fr = lane & 15, fq = lane >> 4;
    const int nt = K * ES / 128;
    unsigned voffB[2];
#pragma unroll
    for (int i = 0; i < 2; ++i) { int R, C; stage_rc(tid * 16 + i * 8192, R, C); const int Rb = Epi::PERM ? ((R & ~31) + perm32(R & 31)) : R; voffB[i] = (unsigned)(Rb * K * ES + C * 2); }
    const size_t kstep = (size_t)128;
    const size_t hstep = (size_t)HALF * K * ES;
    const unsigned ldsw = (unsigned)wid * 1024u;
    const int aoff = FP8 ? lds_byte(wr * 64 + fr, 16 * (fq & 1)) + (fq >> 1) * 1024 : lds_byte(wr * 64 + fr, fq * 8);
    const int boff = FP8 ? lds_byte(wc * 32 + fr, 16 * (fq & 1)) + (fq >> 1) * 1024 : lds_byte(wc * 32 + fr, fq * 8);
#define PG8_SA(b, h) (((b) * 2 + (h)) * HTB)
#define PG8_SB(b, h) ((4 + (b) * 2 + (h)) * HTB)
#define PG8_STAGE(bufoff, gbase, voff) do { const char* _gb = (const char*)(gbase); asm volatile("" : "+s"(_gb)); _Pragma("unroll") for (int _i = 0; _i < 2; ++_i) \
        __builtin_amdgcn_global_load_lds((const unsigned*)(_gb + (voff)[_i]), (LAS unsigned*)(lds + (bufoff) + ldsw + _i * 8192), 16, 0, 0); } while (0)
#define PG8_LDA(dst, b, h) do { _Pragma("unroll") for (int m = 0; m < 4; ++m) _Pragma("unroll") for (int k = 0; k < 2; ++k) dst[m][k] = *(const LAS bf16x8*)(lds + PG8_SA(b, h) + aoff + m * 2048 + k * (FP8 ? 16 : 1024)); } while (0)
#define PG8_LDB(dst, b, h) do { _Pragma("unroll") for (int n = 0; n < 2; ++n) _Pragma("unroll") for (int k = 0; k < 2; ++k) dst[n][k] = *(const LAS bf16x8*)(lds + PG8_SB(b, h) + boff + n * 2048 + k * (FP8 ? 16 : 1024)); } while (0)
#define PG8_MMA(ai, bj, At, Bt) do { __builtin_amdgcn_s_setprio(1); _Pragma("unroll") for (int m = 0; m < 4; ++m) _Pragma("unroll") for (int n = 0; n < 2; ++n) { \
        if constexpr (FP8) { const u32x4 _b0 = __builtin_bit_cast(u32x4, Bt[n][0]), _b1 = __builtin_bit_cast(u32x4, Bt[n][1]), _a0 = __builtin_bit_cast(u32x4, At[m][0]), _a1 = __builtin_bit_cast(u32x4, At[m][1]); \
            const i32x8 _bv = {(int)_b0.x, (int)_b0.y, (int)_b0.z, (int)_b0.w, (int)_b1.x, (int)_b1.y, (int)_b1.z, (int)_b1.w}, _av = {(int)_a0.x, (int)_a0.y, (int)_a0.z, (int)_a0.w, (int)_a1.x, (int)_a1.y, (int)_a1.z, (int)_a1.w}; \
            acc[ai][bj][m][n] = __builtin_amdgcn_mfma_scale_f32_16x16x128_f8f6f4(_bv, _av, acc[ai][bj][m][n], 0, 0, 0, 0x7F7F7F7F, 0, 0x7F7F7F7F); } \
        else if constexpr (MODE == 2) { _Pragma("unroll") for (int k = 0; k < 2; ++k) acc[ai][bj][m][n] = __builtin_bit_cast(f32x4, __builtin_amdgcn_mfma_i32_16x16x64_i8(__builtin_bit_cast(i32x4, Bt[n][k]), __builtin_bit_cast(i32x4, At[m][k]), __builtin_bit_cast(i32x4, acc[ai][bj][m][n]), 0, 0, 0)); } \
        else { _Pragma("unroll") for (int k = 0; k < 2; ++k) acc[ai][bj][m][n] = __builtin_amdgcn_mfma_f32_16x16x32_bf16(Bt[n][k], At[m][k], acc[ai][bj][m][n], 0, 0, 0); } } \
        __builtin_amdgcn_s_setprio(0); } while (0)
#define PG8_WAIT_V(n) asm volatile("s_waitcnt vmcnt(" #n ")" ::: "memory")
#define PG8_WAIT_L(n) asm volatile("s_waitcnt lgkmcnt(" #n ")" ::: "memory")
#define PG8_BAR __builtin_amdgcn_s_barrier()
#define PG8_SCHED __builtin_amdgcn_sched_barrier(0)
#define PG8_AOFF(dst, u) do { _Pragma("unroll") for (int _i = 0; _i < 2; ++_i) { int _R, _C; stage_rc(tid * 16 + _i * 8192, _R, _C); _Pragma("unroll") for (int _h = 0; _h < 2; ++_h) \
        dst[_h][_i] = (unsigned)((size_t)S.a_row(u, _h * HALF + _R) * K * ES + _C * 2); } } while (0)
    Unit cur, nxt; int ui = 0;
    if (!S.next(0, cur)) return;
    f32x4 acc[2][2][4][2];
#pragma unroll
    for (int a = 0; a < 2; ++a)
#pragma unroll
        for (int b = 0; b < 2; ++b)
#pragma unroll
            for (int m = 0; m < 4; ++m)
#pragma unroll
                for (int n = 0; n < 2; ++n) acc[a][b][m][n] = (f32x4){0.f, 0.f, 0.f, 0.f};
    bf16x8 At[4][2], B0[2][2], B1[2][2];
    unsigned cao[2][2];
    PG8_AOFF(cao, cur);
    const char* cA = (const char*)Abase; const char* cB = (const char*)Btbase + (size_t)cur.brow * K * ES;
    PG8_STAGE(PG8_SB(0, 0), cB, voffB); PG8_STAGE(PG8_SB(0, 1), cB + hstep, voffB); PG8_STAGE(PG8_SA(0, 0), cA, cao[0]); PG8_STAGE(PG8_SA(0, 1), cA, cao[1]);
    if (wr == 1) PG8_BAR;
    PG8_WAIT_V(2); PG8_BAR;
    PG8_STAGE(PG8_SB(1, 0), cB + kstep, voffB); PG8_STAGE(PG8_SA(1, 0), cA + kstep, cao[0]); PG8_STAGE(PG8_SB(1, 1), cB + hstep + kstep, voffB);
    PG8_WAIT_V(6); PG8_BAR;
    for (;;) {
        const bool has_next = S.next(ui + 1, nxt);
        const char* nB = has_next ? (const char*)Btbase + (size_t)nxt.brow * K * ES : cB;
        for (int t = 0; t < nt; t += 2) {
            const bool last = (t == nt - 2);
            const char* a1 = cA + (size_t)(t + 1) * kstep;
            const char* a2 = last ? cA : cA + (size_t)(t + 2) * kstep; const char* b2 = last ? nB : cB + (size_t)(t + 2) * kstep;
            const char* a3 = a2 + kstep; const char* b3 = b2 + kstep;
            PG8_LDB(B0, 0, 0); PG8_LDB(B1, 0, 1); PG8_SCHED; PG8_LDA(At, 0, 0); PG8_STAGE(PG8_SA(1, 1), a1, cao[1]);
            if (last && has_next) { PG8_AOFF(cao, nxt); }
            PG8_WAIT_V(8); PG8_WAIT_L(0); PG8_BAR; PG8_MMA(0, 0, At, B0); PG8_MMA(0, 1, At, B1); PG8_BAR; PG8_SCHED;
            PG8_LDA(At, 0, 1); PG8_STAGE(PG8_SB(0, 0), b2, voffB); PG8_STAGE(PG8_SB(0, 1), b2 + hstep, voffB); PG8_STAGE(PG8_SA(0, 0), a2, cao[0]);
            PG8_WAIT_V(8); PG8_WAIT_L(0); PG8_BAR; PG8_MMA(1, 0, At, B0); PG8_MMA(1, 1, At, B1); PG8_BAR; PG8_SCHED;
            PG8_LDB(B0, 1, 0); PG8_LDB(B1, 1, 1); PG8_SCHED; PG8_LDA(At, 1, 0); PG8_STAGE(PG8_SA(0, 1), a2, cao[1]);
            PG8_WAIT_V(8); PG8_WAIT_L(0); PG8_BAR; PG8_MMA(0, 0, At, B0); PG8_MMA(0, 1, At, B1); PG8_BAR; PG8_SCHED;
            PG8_LDA(At, 1, 1); PG8_STAGE(PG8_SB(1, 0), b3, voffB); PG8_STAGE(PG8_SB(1, 1), b3 + hstep, voffB); PG8_STAGE(PG8_SA(1, 0), a3, cao[0]);
            PG8_WAIT_V(8); PG8_WAIT_L(0); PG8_BAR; PG8_MMA(1, 0, At, B0); PG8_MMA(1, 1, At, B1); PG8_BAR; PG8_SCHED;
        }
        if (wr == 0) PG8_BAR;
        if constexpr (MODE == 2) {
#pragma unroll
            for (int a = 0; a < 2; ++a)
#pragma unroll
                for (int b = 0; b < 2; ++b)
#pragma unroll
                    for (int m = 0; m < 4; ++m)
#pragma unroll
                        for (int n = 0; n < 2; ++n) { const i32x4 iv = __builtin_bit_cast(i32x4, acc[a][b][m][n]); acc[a][b][m][n] = (f32x4){(float)iv[0], (float)iv[1], (float)iv[2], (float)iv[3]}; } }
#pragma unroll 1
        for (int er = 0; er < Epi::NREP; ++er) E(acc, cur, wr, wc, fr, fq);
        if (!has_next) break;
#pragma unroll
        for (int a = 0; a < 2; ++a)
#pragma unroll
            for (int b = 0; b < 2; ++b)
#pragma unroll
                for (int m = 0; m < 4; ++m)
#pragma unroll
                    for (int n = 0; n < 2; ++n) acc[a][b][m][n] = (f32x4){0.f, 0.f, 0.f, 0.f};
        cur = nxt; cB = nB; ++ui;
        if (wr == 1) PG8_BAR;
    }
    PG8_WAIT_V(0);
    PG8_BAR;
#undef PG8_SA
#undef PG8_SB
#undef PG8_STAGE
#undef PG8_LDA
#undef PG8_LDB
#undef PG8_MMA
#undef PG8_WAIT_V
#undef PG8_WAIT_L
#undef PG8_BAR
#undef PG8_SCHED
#undef PG8_AOFF
}
}

typedef f32x4 AccT[2][2][4][2];

struct EpiProj {
    static constexpr int NREP = 1; static constexpr bool PERM = true;
    bf16_t* proj; float* gates; const float* bgate; float sc;
    __device__ __forceinline__ void operator()(const AccT& acc, const pg8::Unit& u, int wr, int wc, int fr, int fq) const {
        const int row0 = u.pm * 256 + wr * 64 + fr; const float scu = u.pn < 2 ? sc * 0.125f : sc;
        if (u.pn < 12) {
            const int col0 = u.pn * 256 + wc * 32 + 8 * fq;
#pragma unroll
            for (int ai = 0; ai < 2; ++ai)
#pragma unroll
                for (int m = 0; m < 4; ++m) { bf16_t* rowp = proj + (size_t)(row0 + ai * 128 + m * 16) * PROJ_LD + col0;
#pragma unroll
                    for (int bj = 0; bj < 2; ++bj) { const f32x4 v0 = acc[ai][bj][m][0] * scu, v1 = acc[ai][bj][m][1] * scu;
                        u32x4 w; w.x = cvt_pk_bf16(v0[0], v0[1]); w.y = cvt_pk_bf16(v0[2], v0[3]); w.z = cvt_pk_bf16(v1[0], v1[1]); w.w = cvt_pk_bf16(v1[2], v1[3]);
                        *(u32x4*)(rowp + bj * 128) = w; } }
        } else if (wc == 0 && fq < 2) {
#pragma unroll
            for (int n = 0; n < 2; ++n) { const f32x4 bv = *(const f32x4*)(bgate + 8 * fq + 4 * n);
#pragma unroll
                for (int ai = 0; ai < 2; ++ai)
#pragma unroll
                    for (int m = 0; m < 4; ++m) *(f32x4*)(gates + (size_t)(row0 + ai * 128 + m * 16) * 16 + 8 * fq + 4 * n) = acc[ai][0][m][n] + bv; }
        }
    }
};
__device__ __forceinline__ f32x4 bf4_lo(u32x4 w) { return (f32x4){__builtin_bit_cast(float, w.x << 16), __builtin_bit_cast(float, w.x & 0xffff0000u), __builtin_bit_cast(float, w.y << 16), __builtin_bit_cast(float, w.y & 0xffff0000u)}; }
__device__ __forceinline__ f32x4 bf4_hi(u32x4 w) { return (f32x4){__builtin_bit_cast(float, w.z << 16), __builtin_bit_cast(float, w.z & 0xffff0000u), __builtin_bit_cast(float, w.w << 16), __builtin_bit_cast(float, w.w & 0xffff0000u)}; }
struct EpiRes {
    static constexpr int NREP = 1; static constexpr bool PERM = true;
    bf16_t* H; const float* stats; const float* lg; const float* lb; const float* xsrc; float sc;
    __device__ __forceinline__ void operator()(const AccT& acc, const pg8::Unit& u, int wr, int wc, int fr, int fq) const {
        const int row0 = u.pm * 256 + wr * 64 + fr, col0 = u.pn * 256 + wc * 32 + 8 * fq;
        f32x4 gv[2][2], bv[2][2];
        if (lg) {
#pragma unroll
            for (int bj = 0; bj < 2; ++bj)
#pragma unroll
                for (int n = 0; n < 2; ++n) { gv[bj][n] = *(const f32x4*)(lg + col0 + bj * 128 + n * 4); bv[bj][n] = *(const f32x4*)(lb + col0 + bj * 128 + n * 4); } }
#pragma unroll
        for (int ai = 0; ai < 2; ++ai)
#pragma unroll
            for (int m = 0; m < 4; ++m) { const int row = row0 + ai * 128 + m * 16; bf16_t* rowp = H + (size_t)row * D + col0;
                f32x2 st = (f32x2){0.f, 1.f}; if (lg) st = *(const f32x2*)(stats + 2 * (size_t)row);
#pragma unroll
                for (int bj = 0; bj < 2; ++bj) { f32x4 h0, h1;
                    if (lg) { const u32x4 w = *(const u32x4*)(rowp + bj * 128); h0 = (bf4_lo(w) - st.x) * st.y * gv[bj][0] + bv[bj][0]; h1 = (bf4_hi(w) - st.x) * st.y * gv[bj][1] + bv[bj][1]; }
                    else { const float* xp = xsrc + (size_t)row * D + col0 + bj * 128; h0 = *(const f32x4*)xp; h1 = *(const f32x4*)(xp + 4); }
                    const f32x4 o0 = h0 * ALPHA + acc[ai][bj][m][0] * sc, o1 = h1 * ALPHA + acc[ai][bj][m][1] * sc;
                    u32x4 w; w.x = cvt_pk_bf16(o0[0], o0[1]); w.y = cvt_pk_bf16(o0[2], o0[3]); w.z = cvt_pk_bf16(o1[0], o1[1]); w.w = cvt_pk_bf16(o1[2], o1[3]);
                    *(u32x4*)(rowp + bj * 128) = w; } }
    }
};
struct EpiSwiglu {
    static constexpr int NREP = 1; static constexpr bool PERM = true;
    bf16_t* act; int ld; float sc;
    __device__ __forceinline__ static float silu_mul(float g, float u) { return g * u * __builtin_amdgcn_rcpf(1.0f + __builtin_amdgcn_exp2f(-g * 1.4426950408889634f)); }
    __device__ __forceinline__ void operator()(const AccT& acc, const pg8::Unit& u, int wr, int wc, int fr, int fq) const {
        const int row0 = u.pm * 256 + wr * 64 + fr, col0 = u.pn * 128 + wc * 32 + 8 * fq;
#pragma unroll
        for (int ai = 0; ai < 2; ++ai)
#pragma unroll
            for (int m = 0; m < 4; ++m) { const f32x4 g0 = acc[ai][0][m][0] * sc, g1 = acc[ai][0][m][1] * sc, u0 = acc[ai][1][m][0] * sc, u1 = acc[ai][1][m][1] * sc;
                u32x4 w; w.x = cvt_pk_bf16(silu_mul(g0[0], u0[0]), silu_mul(g0[1], u0[1])); w.y = cvt_pk_bf16(silu_mul(g0[2], u0[2]), silu_mul(g0[3], u0[3]));
                w.z = cvt_pk_bf16(silu_mul(g1[0], u1[0]), silu_mul(g1[1], u1[1])); w.w = cvt_pk_bf16(silu_mul(g1[2], u1[2]), silu_mul(g1[3], u1[3]));
                *(u32x4*)(act + (size_t)(row0 + ai * 128 + m * 16) * ld + col0) = w; }
    }
};
struct EpiSwiglu8 {
    static constexpr int NREP = 1; static constexpr bool PERM = true;
    unsigned char* act; int ld; float sc;
    const float* wscale; int wdiv;
    __device__ __forceinline__ void operator()(const AccT& acc, const pg8::Unit& u, int wr, int wc, int fr, int fq) const {
        const int row0 = u.pm * 256 + wr * 64 + fr, col0 = u.pn * 128 + wc * 32 + 8 * fq;
        const float rs = wscale ? sc * wscale[wdiv ? u.brow / wdiv : 0] : sc;
        const float c1 = -rs * 1.4426950408889634f, c2 = rs * rs * F8_SACT, l2 = -__builtin_amdgcn_logf(c2), ic2 = __builtin_amdgcn_rcpf(c2);
#pragma unroll
        for (int ai = 0; ai < 2; ++ai)
#pragma unroll
            for (int m = 0; m < 4; ++m) { float o[8];
#pragma unroll
                for (int n = 0; n < 2; ++n)
#pragma unroll
                    for (int j = 0; j < 4; ++j) { const float g = acc[ai][0][m][n][j], up = acc[ai][1][m][n][j];
                        o[4 * n + j] = (g * up) * __builtin_amdgcn_rcpf(__builtin_amdgcn_exp2f(__builtin_fmaf(g, c1, l2)) + ic2); }
                u32x2 w; int p = __builtin_amdgcn_cvt_pk_fp8_f32(o[0], o[1], 0, false); p = __builtin_amdgcn_cvt_pk_fp8_f32(o[2], o[3], p, true); w.x = (unsigned)p;
                p = __builtin_amdgcn_cvt_pk_fp8_f32(o[4], o[5], 0, false); p = __builtin_amdgcn_cvt_pk_fp8_f32(o[6], o[7], p, true); w.y = (unsigned)p;
                *(u32x2*)(act + (size_t)(row0 + ai * 128 + m * 16) * ld + col0) = w; }
    }
};
struct EpiSwigluProbe : EpiSwiglu { static constexpr int NREP = 2; };
struct EpiScatter {
    static constexpr int NREP = 1; static constexpr bool PERM = true;
    bf16_t* contrib; const int* rowdst; const float* rowgate; float sc;
    __device__ __forceinline__ void operator()(const AccT& acc, const pg8::Unit& u, int wr, int wc, int fr, int fq) const {
        const int row0 = u.pm * 256 + wr * 64 + fr, col0 = u.pn * 256 + wc * 32 + 8 * fq;
        int dd[8]; float gg[8];
#pragma unroll
        for (int k = 0; k < 8; ++k) { const int pos = row0 + (k >> 2) * 128 + (k & 3) * 16; dd[k] = rowdst[pos]; gg[k] = rowgate[pos]; }
#pragma unroll
        for (int ai = 0; ai < 2; ++ai)
#pragma unroll
            for (int m = 0; m < 4; ++m) { const int d = dd[ai * 4 + m];
                if (d >= 0) { const float g = gg[ai * 4 + m] * sc; bf16_t* rowp = contrib + (size_t)d * D + col0;
#pragma unroll
                    for (int bj = 0; bj < 2; ++bj) { const f32x4 v0 = acc[ai][bj][m][0] * g, v1 = acc[ai][bj][m][1] * g;
                        u32x4 w; w.x = cvt_pk_bf16(v0[0], v0[1]); w.y = cvt_pk_bf16(v0[2], v0[3]); w.z = cvt_pk_bf16(v1[0], v1[1]); w.w = cvt_pk_bf16(v1[2], v1[3]);
                        *(u32x4*)(rowp + bj * 128) = w; } } }
    }
};
struct EpiQKV {
    static constexpr int NREP = 1; static constexpr bool PERM = true;
    bf16_t *Q, *KB, *VB; const float* rope; float sq, skv; LAS unsigned char* tlds;
    __device__ __forceinline__ void operator()(const AccT& acc, const pg8::Unit& u, int wr, int wc, int fr, int fq) const {
        const int row0 = u.pm * 256 + wr * 64 + fr, cl = wc * 32 + 8 * fq, lane = fr | (fq << 4);
        bf16_t* base; int ld;
        if (u.pn == 5) {
            LAS unsigned char* tp = tlds + (wr * 4 + wc) * 2560;
#pragma unroll
            for (int ai = 0; ai < 2; ++ai)
#pragma unroll
                for (int mp = 0; mp < 2; ++mp)
#pragma unroll
                    for (int bj = 0; bj < 2; ++bj) {
#pragma unroll
                        for (int mm = 0; mm < 2; ++mm)
#pragma unroll
                            for (int n = 0; n < 2; ++n)
#pragma unroll
                                for (int j = 0; j < 4; ++j) *(LAS unsigned short*)(tp + (8 * fq + 4 * n + j) * 80 + (mm * 16 + fr) * 2) = (unsigned short)f2bf(acc[ai][bj][2 * mp + mm][n][j] * skv);
                        asm volatile("s_waitcnt lgkmcnt(0)" ::: "memory");
                        const int c = lane & 31, h = lane >> 5;
                        const u32x4 r0 = *(const LAS u32x4*)(tp + c * 80 + h * 32), r1 = *(const LAS u32x4*)(tp + c * 80 + h * 32 + 16);
                        bf16_t* dst = VB + (size_t)(bj * 128 + wc * 32 + c) * MP + (u.pm * 256 + ai * 128 + wr * 64 + mp * 32 + h * 16);
                        *(u32x4*)dst = r0; *(u32x4*)(dst + 8) = r1;
                        asm volatile("s_waitcnt lgkmcnt(0)" ::: "memory"); }
            return; }
        if (u.pn < 4) { base = Q + u.pn * 256 + cl; ld = D; } else { base = KB + cl; ld = 256; }
        const bool dorope = (u.pn <= 4) && ((wc & 1) == 0);
        { const char* src = (const char*)(rope + (size_t)(((u.pm * 256) & (SEQ - 1)) + NMETA) * 16) + (wr * 4 + wc) * 2048 + lane * 16;
          __builtin_amdgcn_global_load_lds((const unsigned*)src, (LAS unsigned*)(tlds + (wr * 4 + wc) * 2048), 16, 0, 0);
          __builtin_amdgcn_global_load_lds((const unsigned*)(src + 1024), (LAS unsigned*)(tlds + (wr * 4 + wc) * 2048 + 1024), 16, 0, 0);
          asm volatile("s_waitcnt vmcnt(0)" ::: "memory"); __builtin_amdgcn_s_barrier(); asm volatile("" ::: "memory"); }
#pragma unroll
        for (int ai = 0; ai < 2; ++ai)
#pragma unroll
            for (int m = 0; m < 4; ++m) { const int row = row0 + ai * 128 + m * 16;
                f32x4 v[2][2];
#pragma unroll
                for (int bj = 0; bj < 2; ++bj)
#pragma unroll
                    for (int n = 0; n < 2; ++n) v[bj][n] = acc[ai][bj][m][n] * (u.pn < 4 ? sq : skv);
                if (dorope) {
                    const LAS float* rp = (const LAS float*)(tlds + (wr * 64 + ai * 128 + m * 16 + fr) * 64);
                    const f32x4 c0 = *(const LAS f32x4*)rp, c1 = *(const LAS f32x4*)(rp + 4), s0 = *(const LAS f32x4*)(rp + 8), s1 = *(const LAS f32x4*)(rp + 12);
#pragma unroll
                    for (int bj = 0; bj < 2; ++bj)
#pragma unroll
                        for (int n = 0; n < 2; ++n) { const f32x4 c = n ? c1 : c0, s = n ? s1 : s0; f32x4 o;
#pragma unroll
                            for (int j = 0; j < 4; ++j) { const float x = v[bj][n][j]; const float y = SHX(x, 16);
                                o[j] = fq == 0 ? x * c[j] - y * s[j] : (fq == 1 ? x * c[j] + y * s[j] : x); }
                            v[bj][n] = o; }
                }
#pragma unroll
                for (int bj = 0; bj < 2; ++bj) { const f32x4 v0 = v[bj][0], v1 = v[bj][1];
                    u32x4 w; w.x = cvt_pk_bf16(v0[0], v0[1]); w.y = cvt_pk_bf16(v0[2], v0[3]); w.z = cvt_pk_bf16(v1[0], v1[1]); w.w = cvt_pk_bf16(v1[2], v1[3]);
                    *(u32x4*)(base + (size_t)row * ld + bj * 128) = w; } }
    }
};

template <int NACC, class F>
__device__ __forceinline__ void skinny_item(const bf16_t* A, int lda, const bf16_t* (&Bt)[NACC], int K, int wave, int lane, LAS unsigned char* lds, int parity, const F& epi) {
    const int fr = lane & 15, quad = lane >> 4, kw = K >> 3;
    const bf16_t* ap = A + (size_t)fr * lda + wave * kw + 8 * quad;
    f32x4 acc[NACC];
#pragma unroll
    for (int i = 0; i < NACC; ++i) acc[i] = (f32x4){0.f, 0.f, 0.f, 0.f};
#pragma unroll 2
    for (int k = 0; k < kw; k += 32) { const bf16x8 a = *(const bf16x8*)(ap + k);
#pragma unroll
        for (int i = 0; i < NACC; ++i) acc[i] = __builtin_amdgcn_mfma_f32_16x16x32_bf16(a, *(const bf16x8*)(Bt[i] + (size_t)fr * K + wave * kw + 8 * quad + k), acc[i], 0, 0, 0); }
    LAS f32x4* red = (LAS f32x4*)(lds + parity * 16384);
#pragma unroll
    for (int i = 0; i < NACC; ++i) red[(wave * NACC + i) * 64 + lane] = acc[i];
    __syncthreads();
    if (wave == 0) {
#pragma unroll
        for (int i = 0; i < NACC; ++i) { f32x4 t = red[i * 64 + lane];
#pragma unroll
            for (int w = 1; w < 8; ++w) t += red[(w * NACC + i) * 64 + lane];
            acc[i] = t; }
        epi(acc, fr, quad);
    }
}

template <int NACC, class F>
__device__ __forceinline__ void skinny_item8(const unsigned char* A, int lda, const unsigned char* (&Bt)[NACC], int K, int wave, int lane, LAS unsigned char* lds, int parity, const F& epi) {
    const int fr = lane & 15, quad = lane >> 4, nblk = K >> 7, b0 = (wave * nblk) >> 3, b1 = ((wave + 1) * nblk) >> 3;
    f32x4 acc[NACC];
#pragma unroll
    for (int i = 0; i < NACC; ++i) acc[i] = (f32x4){0.f, 0.f, 0.f, 0.f};
    for (int kb = b0; kb < b1; ++kb) { const u32x4* ap = (const u32x4*)(A + (size_t)fr * lda + kb * 128 + 32 * quad); const u32x4 a0 = ap[0], a1 = ap[1];
        const i32x8 av = {(int)a0.x, (int)a0.y, (int)a0.z, (int)a0.w, (int)a1.x, (int)a1.y, (int)a1.z, (int)a1.w};
#pragma unroll
        for (int i = 0; i < NACC; ++i) { const u32x4* bp = (const u32x4*)(Bt[i] + (size_t)fr * K + kb * 128 + 32 * quad); const u32x4 q0 = bp[0], q1 = bp[1];
            const i32x8 bv = {(int)q0.x, (int)q0.y, (int)q0.z, (int)q0.w, (int)q1.x, (int)q1.y, (int)q1.z, (int)q1.w};
            acc[i] = __builtin_amdgcn_mfma_scale_f32_16x16x128_f8f6f4(av, bv, acc[i], 0, 0, 0, 0x7F7F7F7F, 0, 0x7F7F7F7F); } }
    LAS f32x4* red = (LAS f32x4*)(lds + parity * 16384);
#pragma unroll
    for (int i = 0; i < NACC; ++i) red[(wave * NACC + i) * 64 + lane] = acc[i];
    __syncthreads();
    if (wave == 0) {
#pragma unroll
        for (int i = 0; i < NACC; ++i) { f32x4 t = red[i * 64 + lane];
#pragma unroll
            for (int w = 1; w < 8; ++w) t += red[(w * NACC + i) * 64 + lane];
            acc[i] = t; }
        epi(acc, fr, quad);
    }
}

__device__ __forceinline__ int claim_item(unsigned* ctr, LAS unsigned char* lds, int tid) {
    volatile LAS unsigned* slot = (volatile LAS unsigned*)(lds + MISC_OFF) + 48;
    if (tid == 0) slot[0] = __hip_atomic_fetch_add(ctr, 1u, __ATOMIC_RELAXED, __HIP_MEMORY_SCOPE_AGENT);
    __syncthreads();
    const int item = (int)slot[0];
    __syncthreads();
    return item;
}

struct Params { const float* in[18]; float* out; unsigned char* ws; int ph_lo, ph_hi, li, pad; };
enum { I_X = 0, I_META, I_WIN, I_BGATE, I_LNH, I_WOUT, I_WKV, I_WQ, I_SINKS, I_WO, I_WGUD, I_WDND, I_WROUTER, I_BROUTER, I_WGUE, I_WDNE, I_LNG, I_LNB };
constexpr int NWAVES = 8, NTHREADS = 512;

__device__ __forceinline__ unsigned pk4_i8(float a, float b, float c, float d) {
    const int ia = (int)__builtin_rintf(__builtin_amdgcn_fmed3f(a, -127.f, 127.f)), ib = (int)__builtin_rintf(__builtin_amdgcn_fmed3f(b, -127.f, 127.f));
    const int ic = (int)__builtin_rintf(__builtin_amdgcn_fmed3f(c, -127.f, 127.f)), id = (int)__builtin_rintf(__builtin_amdgcn_fmed3f(d, -127.f, 127.f));
    return (unsigned)(ia & 0xff) | ((unsigned)(ib & 0xff) << 8) | ((unsigned)(ic & 0xff) << 16) | ((unsigned)(id & 0xff) << 24); }
template <int F8 = 0>
__device__ __forceinline__ void tr_item(const float* W, int Nsrc, int K, void* WTv, int k0, int n0, int drow0, float scale, int nvalid, LAS float* scr, int lane) {
    bf16_t* WT = (bf16_t*)WTv;
    float ld[32];
#pragma unroll
    for (int i = 0; i < 32; ++i) { const int kk = 2 * i + (lane >> 5), n = lane & 31; ld[i] = (n < nvalid) ? W[(size_t)(k0 + kk) * Nsrc + n0 + n] : 0.f; }
#pragma unroll
    for (int i = 0; i < 32; ++i) { const int kk = 2 * i + (lane >> 5), n = lane & 31; scr[kk * 33 + n] = ld[i] * scale; }
    LDS_WAIT(); asm volatile("" ::: "memory");
    const int c = lane & 7;
#pragma unroll
    for (int j = 0; j < 4; ++j) { const int n = (lane >> 3) + 8 * j; const LAS float* s = scr + (8 * c) * 33 + n;
        if constexpr (F8 == 2) { u32x2 o; o.x = pk4_i8(s[0 * 33], s[1 * 33], s[2 * 33], s[3 * 33]); o.y = pk4_i8(s[4 * 33], s[5 * 33], s[6 * 33], s[7 * 33]);
            if (n < nvalid) *(u32x2*)((unsigned char*)WTv + (size_t)(drow0 + n) * K + k0 + 8 * c) = o; }
        else if constexpr (F8 == 1) { u32x2 o; o.x = pk4_fp8(s[0 * 33], s[1 * 33], s[2 * 33], s[3 * 33]); o.y = pk4_fp8(s[4 * 33], s[5 * 33], s[6 * 33], s[7 * 33]);
            if (n < nvalid) *(u32x2*)((unsigned char*)WTv + (size_t)(drow0 + n) * K + k0 + 8 * c) = o; }
        else { u32x4 o; o.x = pk2(s[0 * 33], s[1 * 33]); o.y = pk2(s[2 * 33], s[3 * 33]); o.z = pk2(s[4 * 33], s[5 * 33]); o.w = pk2(s[6 * 33], s[7 * 33]);
            if (n < nvalid) *(u32x4*)(WT + (size_t)(drow0 + n) * K + k0 + 8 * c) = o; } }
    LDS_WAIT(); asm volatile("" ::: "memory");
}
__device__ __forceinline__ int pair_row(int n, int FF) { const int up = n >= FF ? 1 : 0, j = n - up * FF; return 256 * (j >> 7) + 128 * up + (j & 127); }

__device__ __forceinline__ void p0_prologue(const Params& P, LAS unsigned char* lds, int gw, int NGW, int wave, int lane, const XcdBarrier& bar, int tid) {
    unsigned char* ws = P.ws;
    LAS float* scr = (LAS float*)(lds + wave * 16384);
    { unsigned* amax = (unsigned*)(ws + WS_CTL) + CW_AMAX;
      const int vwg = gw >> 3;
      if (vwg < 192) { const int m = vwg >> 3, part = vwg & 7;
          const float* src = m < 2 ? P.in[I_WGUD] + (size_t)m * D * 2 * D_FF : m < 18 ? P.in[I_WGUE] + (size_t)(m - 2) * D * 2 * D_FF_EXP : m < 20 ? P.in[I_WQ] + (size_t)(m - 18) * D * D : m < 21 ? P.in[I_WKV]
                           : m < 23 ? P.in[I_WIN] + (size_t)(m - 21) * D * M_IN : P.in[I_X];
          const int n4 = 16 * (m < 2 ? 2 * D_FF : m < 18 ? 2 * D_FF_EXP : m < 20 ? D : m < 21 ? 512 : m < 23 ? M_IN : 4096), pn4 = n4 >> 3;
          float mx = 0.f;
          for (int i = part * pn4 + tid; i < (part + 1) * pn4; i += NTHREADS) { const f32x4 v = ((const f32x4*)src)[i]; mx = fmaxf(fmaxf(mx, fmaxf(fabsf(v[0]), fabsf(v[1]))), fmaxf(fabsf(v[2]), fabsf(v[3]))); }
#pragma unroll
          for (int o = 1; o < 64; o <<= 1) mx = fmaxf(mx, SHX(mx, o));
          volatile LAS float* red = (volatile LAS float*)(lds + MISC_OFF) + 40;
          if (lane == 0) red[wave] = mx;
          __syncthreads();
          if (tid == 0) { float t = red[0];
#pragma unroll
              for (int w = 1; w < 8; ++w) t = fmaxf(t, red[w]);
              __hip_atomic_fetch_max(amax + m, __builtin_bit_cast(unsigned, t), __ATOMIC_RELAXED, __HIP_MEMORY_SCOPE_AGENT); } }
      xcd_barrier(bar, tid == 0);
      if (gw == 0 && lane < 24) ((float*)(ws + WS_SMALL))[SM_WSCALE + lane] = 1.15f * __builtin_bit_cast(float, __hip_atomic_load(amax + lane, __ATOMIC_RELAXED, __HIP_MEMORY_SCOPE_AGENT)) * (1.f / 127.f); }
    const unsigned* amaxr = (const unsigned*)(ws + WS_CTL) + CW_AMAX;
    constexpr int IT0 = 16 * 97, IT1 = 16 * 32, IT2 = 16 * 16, IT5 = 16 * 176, IT6 = 44 * 32, IT7 = 16 * 224, IT8 = 56 * 32;
    constexpr int C0 = 2 * IT0, C1 = C0 + 2 * IT1, C2 = C1 + IT2, C3 = C2 + 2 * IT1, C4 = C3 + 2 * IT1, C5 = C4 + 2 * IT5, C6 = C5 + 2 * IT6, C7 = C6 + 16 * IT7, C8 = C7 + 16 * IT8;
    for (int it = gw; it < C8; it += NGW) {
        if (it < C0) { const int mi = it / IT0, r = it % IT0, kb = r / 97, nb = r % 97; const int n0 = nb * 32;
            tr_item(P.in[I_WIN] + (size_t)mi * D * M_IN, M_IN, D, (bf16_t*)(ws + WS_WIN) + (size_t)mi * M_INP * D, kb * 64, n0, n0, n0 < 512 ? 0.125f : 1.f, nb == 96 ? 16 : 32, scr, lane);
            if (nb < 96) { const float qs = 127.f / (1.15f * __builtin_bit_cast(float, __hip_atomic_load(amaxr + 21 + mi, __ATOMIC_RELAXED, __HIP_MEMORY_SCOPE_AGENT)));
                tr_item<2>(P.in[I_WIN] + (size_t)mi * D * M_IN, M_IN, D, ws + WS_WIN8 + (size_t)mi * 3072 * D, kb * 64, n0, n0, qs, 32, scr, lane); }
        } else if (it < C1) { const int q = it - C0, mi = q / IT1, r = q % IT1, kb = r / 32, nb = r % 32;
            tr_item(P.in[I_WOUT] + (size_t)mi * D * D, D, D, (bf16_t*)(ws + WS_WOUT) + (size_t)mi * D * D, kb * 64, nb * 32, nb * 32, 1.f, 32, scr, lane);
        } else if (it < C2) { const int r = it - C1, kb = r / 16, nb = r % 16;
            tr_item(P.in[I_WKV], 512, D, (bf16_t*)(ws + WS_WQKV), kb * 64, nb * 32, 1024 + nb * 32, 1.f, 32, scr, lane);
            { const float qs = 127.f / (1.15f * __builtin_bit_cast(float, __hip_atomic_load(amaxr + 20, __ATOMIC_RELAXED, __HIP_MEMORY_SCOPE_AGENT)));
              tr_item<2>(P.in[I_WKV], 512, D, ws + WS_WQKV8, kb * 64, nb * 32, 1024 + nb * 32, qs, 32, scr, lane); }
        } else if (it < C3) { const int q = it - C2, mi = q / IT1, r = q % IT1, kb = r / 32, nb = r % 32;
            tr_item(P.in[I_WQ] + (size_t)mi * D * D, D, D, (bf16_t*)(ws + (mi ? WS_WQ3 : WS_WQKV)), kb * 64, nb * 32, nb * 32, 0.125f, 32, scr, lane);
            { const float qs = 127.f / (1.15f * __builtin_bit_cast(float, __hip_atomic_load(amaxr + 18 + mi, __ATOMIC_RELAXED, __HIP_MEMORY_SCOPE_AGENT)));
              tr_item<2>(P.in[I_WQ] + (size_t)mi * D * D, D, D, ws + WS_WQKV8 + (mi ? (size_t)1536 * D : 0), kb * 64, nb * 32, nb * 32, qs, 32, scr, lane); }
        } else if (it < C4) { const int q = it - C3, mi = q / IT1, r = q % IT1, kb = r / 32, nb = r % 32;
            tr_item<1>(P.in[I_WO] + (size_t)mi * D * D, D, D, (ws + WS_WO8) + (size_t)mi * D * D, kb * 64, nb * 32, nb * 32, F8_SWO, 32, scr, lane);
        } else if (it < C5) { const int q = it - C4, mi = q / IT5, r = q % IT5, kb = r / 176, nb = r % 176;
            tr_item(P.in[I_WGUD] + (size_t)mi * D * 2 * D_FF, 2 * D_FF, D, (bf16_t*)(ws + WS_WGU) + (size_t)mi * 2 * D_FF * D, kb * 64, nb * 32, pair_row(nb * 32, D_FF), 1.f, 32, scr, lane);
            { const float qs = 127.f / (1.15f * __builtin_bit_cast(float, __hip_atomic_load(amaxr + mi, __ATOMIC_RELAXED, __HIP_MEMORY_SCOPE_AGENT)));
              tr_item<2>(P.in[I_WGUD] + (size_t)mi * D * 2 * D_FF, 2 * D_FF, D, (ws + WS_WGU8) + (size_t)mi * 2 * D_FF * D, kb * 64, nb * 32, pair_row(nb * 32, D_FF), qs, 32, scr, lane); }
        } else if (it < C6) { const int q = it - C5, mi = q / IT6, r = q % IT6, kb = r / 32, nb = r % 32;
            tr_item<1>(P.in[I_WDND] + (size_t)mi * D_FF * D, D, D_FF, (ws + WS_WDN8) + (size_t)mi * D * D_FF, kb * 64, nb * 32, nb * 32, F8_SBD, 32, scr, lane);
        } else if (it < C7) { const int q = it - C6, mi = q / IT7, r = q % IT7, kb = r / 224, nb = r % 224;
            const float qs = 127.f / (1.15f * __builtin_bit_cast(float, __hip_atomic_load(amaxr + 2 + mi, __ATOMIC_RELAXED, __HIP_MEMORY_SCOPE_AGENT)));
            tr_item<2>(P.in[I_WGUE] + (size_t)mi * D * 2 * D_FF_EXP, 2 * D_FF_EXP, D, (ws + WS_WGUE8) + (size_t)mi * 2 * D_FF_EXP * D, kb * 64, nb * 32, pair_row(nb * 32, D_FF_EXP), qs, 32, scr, lane);
        } else { const int q = it - C7, mi = q / IT8, r = q % IT8, kb = r / 32, nb = r % 32;
            tr_item<1>(P.in[I_WDNE] + (size_t)mi * D_FF_EXP * D, D, D_FF_EXP, (ws + WS_WDNE8) + (size_t)mi * D * D_FF_EXP, kb * 64, nb * 32, nb * 32, F8_SBD, 32, scr, lane);
        }
    }
    { float* sm = (float*)(ws + WS_SMALL); const int gt = gw * 64 + lane, NT = NGW * 64;
      for (int i = gt; i < SM_WSCALE; i += NT) { float v = 0.f;
          if (i < SM_SINKS) v = P.in[I_BGATE][i]; else if (i < SM_BROUTER) v = P.in[I_SINKS][i - SM_SINKS]; else if (i < SM_BROUTER + 16) v = P.in[I_BROUTER][i - SM_BROUTER];
          else if (i < SM_LNH) v = 0.f; else if (i < SM_LNG) v = P.in[I_LNH][i - SM_LNH]; else if (i < SM_LNB) v = P.in[I_LNG][i - SM_LNG]; else if (i < SM_WROUTER) v = P.in[I_LNB][i - SM_LNB]; else v = P.in[I_WROUTER][i - SM_WROUTER];
          sm[i] = v; } }
    { bf16_t* HB = (bf16_t*)(ws + WS_HB); const float xq = 127.f / (1.15f * __builtin_bit_cast(float, __hip_atomic_load(amaxr + 23, __ATOMIC_RELAXED, __HIP_MEMORY_SCOPE_AGENT)));
      const size_t gt = (size_t)gw * 64 + lane, NT = (size_t)NGW * 64;
      for (size_t i = gt; i < (size_t)MV * (D / 4); i += NT) { const size_t row = i >> 8; const int c4 = (int)(i & 255);
          const f32x4 v = row < MREAL ? ((const f32x4*)P.in[I_X])[i] : ((const f32x4*)P.in[I_META])[(row - MREAL) * 256 + c4];
          u32x2 w; w.x = pk2(v[0], v[1]); w.y = pk2(v[2], v[3]); ((u32x2*)HB)[i] = w;
          ((unsigned*)(ws + WS_HB8))[i] = pk4_i8(v[0] * xq, v[1] * xq, v[2] * xq, v[3] * xq); }
      float* rope = (float*)(ws + WS_ROPE);
      for (size_t i = gt; i < (size_t)(SEQ + NMETA) * 8; i += NT) { const int pos = (int)(i >> 3), fi = (int)(i & 7);
          const double invf = fi == 0 ? 1.0 : fi == 1 ? 0.19392274474868576 : fi == 2 ? 0.03760603093086393 : fi == 3 ? 0.007292664737217109 : fi == 4 ? 0.001414213562373095
                            : fi == 5 ? 0.0002742481756762073 : fi == 6 ? 5.318295896944988e-05 : 1.031338537721246e-05;
          const float angf = (float)pos * (float)invf;
          double a = (double)angf; a -= 6.283185307179586476925 * __builtin_rint(a * 0.15915494309189533577); const double hx = 0.5 * a, h2 = hx * hx;
          double sp = 1.0, cp = 1.0;
#pragma unroll
          for (int k = 12; k >= 1; --k) { sp = 1.0 - sp * h2 / (double)((2 * k) * (2 * k + 1)); cp = 1.0 - cp * h2 / (double)((2 * k - 1) * (2 * k)); }
          const double sh = hx * sp, ch = cp;
          rope[(size_t)pos * 16 + fi] = (float)(1.0 - 2.0 * sh * sh); rope[(size_t)pos * 16 + 8 + fi] = (float)(2.0 * sh * ch); }
    }
}

__device__ __forceinline__ void ln_phase(unsigned char* ws, float* outp, LAS unsigned char* lds, int gw, int NGW, int lane, int tid,
                                         int lnidx, bool moe_src, bool router, int moe_idx, bool final, bool dry = false, bool q8 = false, bool fullhb = false) {
    const float* sm = (const float*)(ws + WS_SMALL);
    unsigned char* wo = dry ? ws + WS_ACT : ws;
    const bf16_t* H = (const bf16_t*)(ws + WS_H); bf16_t* Hw = dry ? (bf16_t*)(ws + WS_ACT) : (bf16_t*)(ws + WS_H);
    bf16_t* HB = dry ? (bf16_t*)(ws + WS_ACT + 160 * MiB) : (bf16_t*)(ws + WS_HB); const bf16_t* contrib = (const bf16_t*)(ws + WS_CONTRIB);
    const float* stats = (const float*)(ws + WS_STATS); float* statsw = dry ? (float*)(ws + WS_ACT + 240 * MiB) : (float*)(ws + WS_STATS);
    unsigned char* HB8 = dry ? ws + WS_ACT + 250 * MiB : ws + WS_HB8; (void)wo;
    const float* lg = sm + SM_LNG + (size_t)lnidx * D; const float* lb = sm + SM_LNB + (size_t)lnidx * D;
    f32x4 gv[4], bv[4];
#pragma unroll
    for (int j = 0; j < 4; ++j) { gv[j] = *(const f32x4*)(lg + 256 * j + 4 * lane); bv[j] = *(const f32x4*)(lb + 256 * j + 4 * lane); }
    float qi8 = 0.f;
    if (q8) { float gm = 0.f, bm = 0.f;
#pragma unroll
        for (int j = 0; j < 4; ++j)
#pragma unroll
            for (int c = 0; c < 4; ++c) { gm = fmaxf(gm, fabsf(gv[j][c])); bm = fmaxf(bm, fabsf(bv[j][c])); }
#pragma unroll
        for (int o = 1; o < 64; o <<= 1) { gm = fmaxf(gm, SHX(gm, o)); bm = fmaxf(bm, SHX(bm, o)); }
        const float clip = 5.5f * gm + bm; qi8 = 127.f / clip;
        if (gw == 0 && lane == 0 && !dry) ((float*)(ws + WS_SMALL))[SM_ASCALE + lnidx] = clip * (1.f / 127.f); }
    volatile LAS unsigned* misc = (volatile LAS unsigned*)(lds + MISC_OFF);
    f32x4 wra[4][4], wrb[4][4];
    if (router) {
        const float* src = sm + SM_WROUTER + (size_t)moe_idx * D * N_EXP;
#pragma unroll
        for (int j = 0; j < 4; ++j)
#pragma unroll
            for (int c = 0; c < 4; ++c) { const f32x4* w4 = (const f32x4*)(src + (size_t)(256 * j + 4 * lane + c) * 8); wra[j][c] = w4[0]; wrb[j][c] = w4[1]; }
        if (tid < 8) misc[16 + tid] = 0u;
        __syncthreads();
    }
    int* tope = dry ? (int*)(ws + WS_ACT + 300 * MiB) : (int*)(ws + WS_TOPE); float* topg = dry ? (float*)(ws + WS_ACT + 310 * MiB) : (float*)(ws + WS_TOPG);
    const float* br = sm + SM_BROUTER + moe_idx * N_EXP;
    struct RowBuf { u32x2 nv[4], nc0[4], nc1[4]; f32x2 nst; };
    RowBuf rb0 = {}, rb1 = {};
    auto fetch = [&](RowBuf& B, int row) {
        u32x2 (&nv)[4] = B.nv; u32x2 (&nc0)[4] = B.nc0; u32x2 (&nc1)[4] = B.nc1; f32x2& nst = B.nst;
        const u32x2* hr = (const u32x2*)(H + (size_t)row * D) + lane;
#pragma unroll
        for (int j = 0; j < 4; ++j) nv[j] = hr[64 * j];
        if (moe_src) { const u32x2* c0 = (const u32x2*)(contrib + (size_t)(2 * row) * D) + lane; const u32x2* c1 = c0 + 256;
#pragma unroll
            for (int j = 0; j < 4; ++j) { nc0[j] = c0[64 * j]; nc1[j] = c1[64 * j]; } }
        nst = *(const f32x2*)(stats + 2 * (size_t)row);
    };
    auto body = [&](RowBuf& B, int row) {
        u32x2 (&nv)[4] = B.nv; u32x2 nc0[4], nc1[4];
#pragma unroll
        for (int j = 0; j < 4; ++j) { nc0[j] = moe_src ? B.nc0[j] : (u32x2){0u, 0u}; nc1[j] = moe_src ? B.nc1[j] : (u32x2){0u, 0u}; }
        f32x4 v[4], c0v[4], c1v[4]; const f32x2 st = B.nst;
#pragma unroll
        for (int j = 0; j < 4; ++j) { v[j] = (f32x4){__builtin_bit_cast(float, nv[j].x << 16), __builtin_bit_cast(float, nv[j].x & 0xffff0000u), __builtin_bit_cast(float, nv[j].y << 16), __builtin_bit_cast(float, nv[j].y & 0xffff0000u)};
            c0v[j] = (f32x4){__builtin_bit_cast(float, nc0[j].x << 16), __builtin_bit_cast(float, nc0[j].x & 0xffff0000u), __builtin_bit_cast(float, nc0[j].y << 16), __builtin_bit_cast(float, nc0[j].y & 0xffff0000u)};
            c1v[j] = (f32x4){__builtin_bit_cast(float, nc1[j].x << 16), __builtin_bit_cast(float, nc1[j].x & 0xffff0000u), __builtin_bit_cast(float, nc1[j].y << 16), __builtin_bit_cast(float, nc1[j].y & 0xffff0000u)}; }
        if (row + 2 * NGW < MV) fetch(B, row + 2 * NGW);
        if (moe_src) { const float* pg = lg - D; const float* pb = lb - D;
#pragma unroll
            for (int j = 0; j < 4; ++j) { const f32x4 g1 = *(const f32x4*)(pg + 256 * j + 4 * lane), b1 = *(const f32x4*)(pb + 256 * j + 4 * lane);
                v[j] = ((v[j] - st.x) * st.y * g1 + b1) * ALPHA + c0v[j] + c1v[j]; }
            if (!final) { u32x2* o = (u32x2*)(Hw + (size_t)row * D) + lane;
#pragma unroll
                for (int j = 0; j < 4; ++j) { u32x2 w; w.x = pk2(v[j][0], v[j][1]); w.y = pk2(v[j][2], v[j][3]); o[64 * j] = w;
                    v[j] = (f32x4){__builtin_bit_cast(float, w.x << 16), __builtin_bit_cast(float, w.x & 0xffff0000u), __builtin_bit_cast(float, w.y << 16), __builtin_bit_cast(float, w.y & 0xffff0000u)}; } } }
        float s = 0.f;
#pragma unroll
        for (int j = 0; j < 4; ++j) s += (v[j][0] + v[j][1]) + (v[j][2] + v[j][3]);
        const float mean = wave_sum(s, lane) * (1.f / D); float s2 = 0.f;
#pragma unroll
        for (int j = 0; j < 4; ++j) { v[j] = v[j] - mean; s2 += (v[j][0] * v[j][0] + v[j][1] * v[j][1]) + (v[j][2] * v[j][2] + v[j][3] * v[j][3]); }
        const float rstd = 1.f / sqrtf(wave_sum(s2, lane) * (1.f / D) + LN_EPS);
#pragma unroll
        for (int j = 0; j < 4; ++j) v[j] = v[j] * rstd * gv[j] + bv[j];
        if (final) { if (row < MREAL) { f32x4* o = (f32x4*)(outp + (size_t)row * D) + lane;
#pragma unroll
                for (int j = 0; j < 4; ++j) o[64 * j] = v[j]; } }
        else { if (lane == 0) *(f32x2*)(statsw + 2 * (size_t)row) = (f32x2){mean, rstd};
            if (q8) {
                unsigned* o8 = (unsigned*)(HB8 + (size_t)row * D) + lane;
#pragma unroll
                for (int j = 0; j < 4; ++j) o8[64 * j] = pk4_i8(v[j][0] * qi8, v[j][1] * qi8, v[j][2] * qi8, v[j][3] * qi8); }
            if (!q8 || fullhb || row >= MREAL) { u32x2* ob = (u32x2*)(HB + (size_t)row * D) + lane;
#pragma unroll
                for (int j = 0; j < 4; ++j) { u32x2 w; w.x = pk2(v[j][0], v[j][1]); w.y = pk2(v[j][2], v[j][3]); ob[64 * j] = w; } } }
        if (router) {
            f32x4 la = (f32x4){0.f, 0.f, 0.f, 0.f}, lb4 = (f32x4){0.f, 0.f, 0.f, 0.f};
#pragma unroll
            for (int j = 0; j < 4; ++j)
#pragma unroll
                for (int c = 0; c < 4; ++c) { const float x = v[j][c]; la += wra[j][c] * x; lb4 += wrb[j][c] * x; }
            const bool h5 = (lane & 32) != 0, h4 = (lane & 16) != 0, h3 = (lane & 8) != 0;
            f32x4 k4; { const f32x4 send = h5 ? la : lb4, keep = h5 ? lb4 : la; f32x4 got;
#pragma unroll
                for (int i = 0; i < 4; ++i) got[i] = SHX(send[i], 32);
                k4 = keep + got; }
            f32x2 k2; { const f32x2 send = h4 ? (f32x2){k4[0], k4[1]} : (f32x2){k4[2], k4[3]}, keep = h4 ? (f32x2){k4[2], k4[3]} : (f32x2){k4[0], k4[1]};
                k2 = keep + (f32x2){SHX(send[0], 16), SHX(send[1], 16)}; }
            float k1 = (h3 ? k2[1] : k2[0]) + SHX(h3 ? k2[0] : k2[1], 8);
            k1 += SHX(k1, 4); k1 += SHX(k1, 2); k1 += SHX(k1, 1);
            float lg8[8];
#pragma unroll
            for (int e = 0; e < 8; ++e) lg8[e] = SHL(k1, 8 * e) + br[e];
            int e1 = 0; float v1 = lg8[0];
#pragma unroll
            for (int e = 1; e < 8; ++e) if (lg8[e] > v1) { v1 = lg8[e]; e1 = e; }
            int e2 = -1; float v2 = -3.0e38f;
#pragma unroll
            for (int e = 0; e < 8; ++e) if (e != e1 && lg8[e] > v2) { v2 = lg8[e]; e2 = e; }
            const float ex = expf(v2 - v1), g1 = 1.f / (1.f + ex), g2 = ex / (1.f + ex);
            if (lane == 0) { tope[row] = e1 | (e2 << 8); topg[2 * row] = g1; topg[2 * row + 1] = g2;
                __hip_atomic_fetch_add((LAS unsigned*)&misc[16 + e1], 1u, __ATOMIC_RELAXED, __HIP_MEMORY_SCOPE_WORKGROUP);
                __hip_atomic_fetch_add((LAS unsigned*)&misc[16 + e2], 1u, __ATOMIC_RELAXED, __HIP_MEMORY_SCOPE_WORKGROUP); }
        }
    };
    auto unpack = [&](RowBuf& B, f32x4 (&v)[4], f32x4 (&c0v)[4], f32x4 (&c1v)[4]) {
#pragma unroll
        for (int j = 0; j < 4; ++j) { const u32x2 a = B.nv[j], b0 = moe_src ? B.nc0[j] : (u32x2){0u, 0u}, b1 = moe_src ? B.nc1[j] : (u32x2){0u, 0u};
            v[j] = (f32x4){__builtin_bit_cast(float, a.x << 16), __builtin_bit_cast(float, a.x & 0xffff0000u), __builtin_bit_cast(float, a.y << 16), __builtin_bit_cast(float, a.y & 0xffff0000u)};
            c0v[j] = (f32x4){__builtin_bit_cast(float, b0.x << 16), __builtin_bit_cast(float, b0.x & 0xffff0000u), __builtin_bit_cast(float, b0.y << 16), __builtin_bit_cast(float, b0.y & 0xffff0000u)};
            c1v[j] = (f32x4){__builtin_bit_cast(float, b1.x << 16), __builtin_bit_cast(float, b1.x & 0xffff0000u), __builtin_bit_cast(float, b1.y << 16), __builtin_bit_cast(float, b1.y & 0xffff0000u)}; } };
    auto body2 = [&](int rowA) {
        const int rw[2] = {rowA, rowA + NGW};
        f32x4 v[2][4], c0v[2][4], c1v[2][4]; const f32x2 st[2] = {rb0.nst, rb1.nst};
        unpack(rb0, v[0], c0v[0], c1v[0]); unpack(rb1, v[1], c0v[1], c1v[1]);
        if (rw[0] + 2 * NGW < MV) fetch(rb0, rw[0] + 2 * NGW);
        if (rw[1] + 2 * NGW < MV) fetch(rb1, rw[1] + 2 * NGW);
        if (moe_src) { const float* pg = lg - D; const float* pb = lb - D;
#pragma unroll
            for (int j = 0; j < 4; ++j) { const f32x4 g1 = *(const f32x4*)(pg + 256 * j + 4 * lane), b1 = *(const f32x4*)(pb + 256 * j + 4 * lane);
#pragma unroll
                for (int r = 0; r < 2; ++r) v[r][j] = ((v[r][j] - st[r].x) * st[r].y * g1 + b1) * ALPHA + c0v[r][j] + c1v[r][j]; }
            if (!final) {
#pragma unroll
                for (int r = 0; r < 2; ++r) { u32x2* o = (u32x2*)(Hw + (size_t)rw[r] * D) + lane;
#pragma unroll
                    for (int j = 0; j < 4; ++j) { u32x2 w; w.x = pk2(v[r][j][0], v[r][j][1]); w.y = pk2(v[r][j][2], v[r][j][3]); o[64 * j] = w;
                        v[r][j] = (f32x4){__builtin_bit_cast(float, w.x << 16), __builtin_bit_cast(float, w.x & 0xffff0000u), __builtin_bit_cast(float, w.y << 16), __builtin_bit_cast(float, w.y & 0xffff0000u)}; } } } }
        float s[2] = {0.f, 0.f};
#pragma unroll
        for (int r = 0; r < 2; ++r)
#pragma unroll
            for (int j = 0; j < 4; ++j) s[r] += (v[r][j][0] + v[r][j][1]) + (v[r][j][2] + v[r][j][3]);
#pragma unroll
        for (int o = 1; o < 64; o <<= 1) { const float t0 = SHX(s[0], o), t1 = SHX(s[1], o); s[0] += t0; s[1] += t1; }
        const float mean[2] = {s[0] * (1.f / D), s[1] * (1.f / D)}; float s2[2] = {0.f, 0.f};
#pragma unroll
        for (int r = 0; r < 2; ++r)
#pragma unroll
            for (int j = 0; j < 4; ++j) { v[r][j] = v[r][j] - mean[r]; s2[r] += (v[r][j][0] * v[r][j][0] + v[r][j][1] * v[r][j][1]) + (v[r][j][2] * v[r][j][2] + v[r][j][3] * v[r][j][3]); }
#pragma unroll
        for (int o = 1; o < 64; o <<= 1) { const float t0 = SHX(s2[0], o), t1 = SHX(s2[1], o); s2[0] += t0; s2[1] += t1; }
        const float rstd[2] = {1.f / sqrtf(s2[0] * (1.f / D) + LN_EPS), 1.f / sqrtf(s2[1] * (1.f / D) + LN_EPS)};
#pragma unroll
        for (int j = 0; j < 4; ++j)
#pragma unroll
            for (int r = 0; r < 2; ++r) v[r][j] = v[r][j] * rstd[r] * gv[j] + bv[j];
        if (final) {
#pragma unroll
            for (int r = 0; r < 2; ++r) { f32x4* o = (f32x4*)(outp + (size_t)rw[r] * D) + lane;
#pragma unroll
                for (int j = 0; j < 4; ++j) o[64 * j] = v[r][j]; } }
        else { if (lane == 0) { *(f32x2*)(statsw + 2 * (size_t)rw[0]) = (f32x2){mean[0], rstd[0]}; *(f32x2*)(statsw + 2 * (size_t)rw[1]) = (f32x2){mean[1], rstd[1]}; }
            if (q8) {
#pragma unroll
                for (int r = 0; r < 2; ++r) { unsigned* o8 = (unsigned*)(HB8 + (size_t)rw[r] * D) + lane;
#pragma unroll
                    for (int j = 0; j < 4; ++j) o8[64 * j] = pk4_i8(v[r][j][0] * qi8, v[r][j][1] * qi8, v[r][j][2] * qi8, v[r][j][3] * qi8); } }
            if (!q8 || fullhb) {
#pragma unroll
                for (int r = 0; r < 2; ++r) { u32x2* ob = (u32x2*)(HB + (size_t)rw[r] * D) + lane;
#pragma unroll
                    for (int j = 0; j < 4; ++j) { u32x2 w; w.x = pk2(v[r][j][0], v[r][j][1]); w.y = pk2(v[r][j][2], v[r][j][3]); ob[64 * j] = w; } } } }
    };
    if (gw < MV) fetch(rb0, gw);
    if (gw + NGW < MV) fetch(rb1, gw + NGW);
    int row = gw;
    if (!router) for (; row + NGW < MREAL; row += 2 * NGW) body2(row);
    for (; row < MV; row += 2 * NGW) { body(rb0, row); if (row + NGW < MV) body(rb1, row + NGW); }
    if (router) { __syncthreads();
        if (tid < 8 && !dry) ((unsigned*)(ws + WS_CTL))[CW_CNTG + (moe_idx * 256 + (gw >> 3)) * 8 + tid] = misc[16 + tid];
        __syncthreads(); }
}

__device__ __forceinline__ void moe_starts(const unsigned char* ws, int moe_idx, int (&cnt)[8], int (&pstart)[9]) {
    const unsigned* c = (const unsigned*)(ws + WS_CTL) + CW_CNT + moe_idx * 64; int p = 0;
#pragma unroll
    for (int e = 0; e < 8; ++e) { cnt[e] = __builtin_amdgcn_readfirstlane((int)__hip_atomic_load(c + e, __ATOMIC_RELAXED, __HIP_MEMORY_SCOPE_AGENT)); pstart[e] = p; p += (cnt[e] + 255) >> 8; }
    pstart[8] = p;
}
__device__ __forceinline__ void assign_phase(unsigned char* ws, LAS unsigned char* lds, int gw, int NGW, int lane, int tid, int wave, int moe_idx) {
    const unsigned* cntg = (const unsigned*)(ws + WS_CTL) + CW_CNTG + moe_idx * 256 * 8;
    volatile LAS unsigned* misc = (volatile LAS unsigned*)(lds + MISC_OFF);
    const int vwg = gw >> 3, nwg = NGW >> 3;
    { const int e = wave; unsigned tot = 0, base = 0;
      for (int w = lane; w < nwg; w += 64) { const unsigned c = cntg[w * 8 + e]; tot += c; base += (w < vwg) ? c : 0u; }
#pragma unroll
      for (int o = 1; o < 64; o <<= 1) { tot += SHX(tot, o); base += SHX(base, o); }
      if (lane == 0) { misc[16 + e] = tot; misc[24 + e] = base; misc[32 + e] = 0u; } }
    __syncthreads();
    int cnt[8], pstart[9]; { int p = 0;
#pragma unroll
      for (int e = 0; e < 8; ++e) { cnt[e] = (int)misc[16 + e]; pstart[e] = p; p += (cnt[e] + 255) >> 8; } pstart[8] = p; }
    if (blockIdx.x == 0 && tid < 8) ((unsigned*)(ws + WS_CTL))[CW_CNT + moe_idx * 64 + tid] = misc[16 + tid];
    const int* tope = (const int*)(ws + WS_TOPE); const float* topg = (const float*)(ws + WS_TOPG);
    int* rowtok = (int*)(ws + WS_ROWTOK); int* rowdst = (int*)(ws + WS_ROWDST); float* rowgate = (float*)(ws + WS_ROWGATE);
    { const int row = gw + lane * NGW;
      if (row < MV) { const int te = tope[row];
#pragma unroll
          for (int slot = 0; slot < 2; ++slot) { const int e = (te >> (8 * slot)) & 255; int ps = 0; unsigned mb = 0;
#pragma unroll
              for (int ee = 0; ee < 8; ++ee) if (ee == e) { ps = pstart[ee]; mb = misc[24 + ee]; }
              const unsigned off = __hip_atomic_fetch_add((LAS unsigned*)&misc[32 + e], 1u, __ATOMIC_RELAXED, __HIP_MEMORY_SCOPE_WORKGROUP);
              const int pos = ps * 256 + (int)mb + (int)off;
              rowtok[pos] = row; rowdst[pos] = 2 * row + slot; rowgate[pos] = topg[2 * row + slot]; } } }
    if (blockIdx.x < 8) { const int e = blockIdx.x; int ps = 0, pe = 0, ce = 0;
#pragma unroll
        for (int ee = 0; ee < 8; ++ee) if (ee == e) { ps = pstart[ee]; pe = pstart[ee + 1]; ce = cnt[ee]; }
        for (int pos = ps * 256 + ce + tid; pos < pe * 256; pos += NTHREADS) { rowtok[pos] = -1; rowdst[pos] = -1; rowgate[pos] = 0.f; } }
}

constexpr int ML_RS = 72;
constexpr int ML_QS = 0, ML_KS = 9216, ML_KT = 18432, ML_VT = 27648, ML_CT = 48384, ML_CTB = 20736, ML_HS = 89856;
constexpr int ML_HSS = 132;
constexpr int ML_TAB = 123648, ML_NCH = 17;
constexpr int ML_TSC = ML_TAB + 7 * ML_NCH * 64 * 4;
static_assert(ML_TSC + 1024 <= MISC_OFF, "mLSTM LDS");
__device__ __forceinline__ bf16x8 ml_frag(LAS unsigned char* lds, int base, int row, int kcol) { return *(const LAS bf16x8*)(lds + base + (row * ML_RS + kcol) * 2); }

#ifndef PROBE_M2
#define PROBE_M2 0
#endif
template <int MODE>
__device__ __forceinline__ void mlstm_phase(unsigned char* ws, LAS unsigned char* lds, int layer, int tid, int wave, int lane, unsigned long long* pticks = nullptr) {
    unsigned long long pt0 = 0, pacc = 0; (void)pt0; (void)pacc;
#define PM2_BEGIN(k) do { if (PROBE_M2 == (k) && MODE == 2) pt0 = __builtin_amdgcn_s_memrealtime(); } while (0)
#define PM2_END(k) do { if (PROBE_M2 == (k) && MODE == 2) pacc += __builtin_amdgcn_s_memrealtime() - pt0; } while (0)
    PM2_BEGIN(1);
    const int item = blockIdx.x; const int bh = item >> 3, seg = item & 7, b = bh >> 3, h = bh & 7;
    if (MODE == 1 && seg == 7) return;
    const bf16_t* proj = (const bf16_t*)(ws + WS_PROJ); const float* gates = (const float*)(ws + WS_GATES);
    bf16_t* HG = (bf16_t*)(ws + WS_HG);
    float* STATE = (float*)(ws + WS_STATE); float* STSC = (float*)(ws + WS_STSC);
    LAS float* tab = (LAS float*)(lds + ML_TAB); LAS float* tsc = (LAS float*)(lds + ML_TSC);
    const int fr = lane & 15, quad = lane >> 4;
    f32x4 st[5]; float zero = 0.f; asm volatile("; opaque zero" : "+v"(zero));
#pragma unroll
    for (int i = 0; i < 5; ++i) st[i] = (f32x4){zero, zero, zero, zero};
    float m0 = (MODE == 1) ? -1.0e30f : 0.f;
    const int nch = SEG_CHUNKS + (seg == 0 ? 1 : 0);
    auto chunk_rows = [&](int ci, int& rbase, int& nv) { if (seg == 0 && ci == 0) { rbase = MREAL; nv = NMETA; } else { const int c = seg * SEG_CHUNKS + ci - (seg == 0 ? 1 : 0); rbase = b * SEQ + c * 64; nv = 64; } };
    for (int i = tid; i < 16 * ML_RS; i += NTHREADS) ((LAS bf16_t*)(lds + ML_VT))[128 * ML_RS + i] = (i < ML_RS) ? (bf16_t)0x3F80 : (bf16_t)0;
    for (int ci = wave; ci < nch; ci += NWAVES) {
        int rbase, nv; chunk_rows(ci, rbase, nv); const bool ok = lane < nv;
        const float li = ok ? gates[(size_t)(rbase + lane) * 16 + h] : -1.0e30f, f = ok ? gates[(size_t)(rbase + lane) * 16 + 8 + h] : 0.f;
        const float lf = ok ? (fminf(f, 0.f) - logf(1.f + expf(-fabsf(f)))) : 0.f;
        float bc = lf;
#pragma unroll
        for (int o = 1; o < 64; o <<= 1) { const float t = SHUP(bc, o); if (lane >= o) bc += t; }
        const float u = li - bc; float pm = u;
#pragma unroll
        for (int o = 1; o < 64; o <<= 1) { const float t = SHUP(pm, o); if (lane >= o) pm = fmaxf(pm, t); }
        tab[(0 * ML_NCH + ci) * 64 + lane] = bc; tab[(1 * ML_NCH + ci) * 64 + lane] = u; tab[(2 * ML_NCH + ci) * 64 + lane] = pm;
        if (lane == 63) { tsc[ci] = bc; tsc[32 + ci] = pm; }
    }
    if (MODE == 2 && seg > 0) {
        float ms[7], gs[7];
#pragma unroll
        for (int s2 = 0; s2 < 7; ++s2) { const bool ok = s2 < seg; ms[s2] = ok ? STSC[(bh * 7 + s2) * 4 + 0] : -1.0e30f; gs[s2] = ok ? STSC[(bh * 7 + s2) * 4 + 1] : 0.f; }
        float suf = 0.f; m0 = -1.0e30f;
#pragma unroll
        for (int s2 = 6; s2 >= 0; --s2) { ms[s2] += suf; suf += gs[s2]; m0 = fmaxf(m0, ms[s2]); }
#pragma unroll
        for (int s2 = 0; s2 < 7; ++s2) if (s2 < seg) {
            const float cf = fast_exp(ms[s2] - m0);
            const f32x4* sp = (const f32x4*)(STATE + (size_t)(bh * 7 + s2) * ST_FLOATS) + (wave * 5) * 64 + lane;
#pragma unroll
            for (int i = 0; i < 5; ++i) st[i] += sp[i * 64] * cf; }
    }
#pragma unroll
    for (int i = 0; i < 5; ++i) { const int dv = (i < 4) ? 16 * wave + fr : 128 + fr, dk = (i < 4) ? 16 * i + 4 * quad : 16 * wave + 4 * quad;
        if (i < 4 || wave < 4) { u32x2 w; w.x = pk2(st[i][0], st[i][1]); w.y = pk2(st[i][2], st[i][3]); *(LAS u32x2*)(lds + ML_CT + (dv * ML_RS + dk) * 2) = w; } }
    __syncthreads();
    if (wave == 0) {
        const float bl = lane < nch ? tsc[lane] : 0.f, um = lane < nch ? tsc[32 + lane] : 0.f; float m = m0, gs = 0.f;
        for (int ci = 0; ci < nch; ++ci) { const float blast = SHL(bl, ci), umax = SHL(um, ci), amax = blast + umax, mn = fmaxf(blast + m, amax);
            if (lane == 0) { tsc[64 + ci] = m; tsc[96 + ci] = fast_exp(blast + m - mn); tsc[128 + ci] = fast_exp(amax - mn); }
            m = mn; gs += blast; }
        if (lane == 0) { tsc[160] = m; tsc[161] = gs; }
    }
    __syncthreads();
    for (int idx = tid; idx < nch * 64; idx += NTHREADS) { const int ci = idx >> 6, j = idx & 63;
        const float bc = tab[(0 * ML_NCH + ci) * 64 + j], u = tab[(1 * ML_NCH + ci) * 64 + j], pm = tab[(2 * ML_NCH + ci) * 64 + j], mc = tsc[64 + ci], MM = fmaxf(pm, mc);
        tab[(3 * ML_NCH + ci) * 64 + j] = MM; tab[(4 * ML_NCH + ci) * 64 + j] = fast_exp(mc - MM); tab[(5 * ML_NCH + ci) * 64 + j] = fast_exp(-(bc + MM));
        tab[(6 * ML_NCH + ci) * 64 + j] = tsc[128 + ci] * fast_exp(u - tsc[32 + ci]); }
    float lnh[16];
    if (MODE == 2) {
#pragma unroll
        for (int e = 0; e < 16; ++e) lnh[e] = ((const float*)(ws + WS_SMALL))[SM_LNH + layer * D + h * M_V + 16 * (tid & 7) + e]; }
    u32x4 rq, rk, rv0, rv1, rg0, rg1;
    auto load_chunk = [&](int ci) {
        int rbase, nv; chunk_rows(ci, rbase, nv);
        if (MODE == 2) { const int i = tid >> 3, sg = tid & 7; const u32x4* ogp = (const u32x4*)(proj + (size_t)(rbase + (i < nv ? i : 0)) * PROJ_LD + 2048 + h * M_V + 16 * sg); rg0 = ogp[0]; rg1 = ogp[1]; }
        { const int j = tid >> 3, c8 = (tid & 7) * 8; const bf16_t* rp = proj + (size_t)(rbase + j) * PROJ_LD + h * 64 + c8;
          rq = (MODE == 2 && j < nv) ? *(const u32x4*)rp : (u32x4){0u, 0u, 0u, 0u}; }
        { const bf16_t* rp = proj + (size_t)(rbase + lane) * PROJ_LD; const bool ok = lane < nv;
          rk = ok ? *(const u32x4*)(rp + 512 + h * 64 + 8 * wave) : (u32x4){0u, 0u, 0u, 0u};
          rv0 = ok ? *(const u32x4*)(rp + 1024 + h * 128 + 16 * wave) : (u32x4){0u, 0u, 0u, 0u}; rv1 = ok ? *(const u32x4*)(rp + 1024 + h * 128 + 16 * wave + 8) : (u32x4){0u, 0u, 0u, 0u}; }
    };
    load_chunk(0);
    __syncthreads();
    PM2_END(1);
    for (int ci = 0; ci < nch; ++ci) {
        PM2_BEGIN(2);
        int rbase, nv; chunk_rows(ci, rbase, nv);
        const u32x4 g0 = rg0, g1 = rg1;
        const LAS float* tU = tab + (1 * ML_NCH + ci) * 64; const LAS float* tMM = tab + (3 * ML_NCH + ci) * 64; const LAS float* tSI = tab + (4 * ML_NCH + ci) * 64;
        const LAS float* tFL = tab + (5 * ML_NCH + ci) * 64; const LAS float* tWP = tab + (6 * ML_NCH + ci) * 64;
        const float sold = tsc[96 + ci];
        { if (MODE == 2) { const int j = tid >> 3, c8 = (tid & 7) * 8; *(LAS u32x4*)(lds + ML_QS + (j * ML_RS + c8) * 2) = rq; }
          const float wj = tWP[lane]; LAS bf16_t* kt = (LAS bf16_t*)(lds + ML_KT); LAS bf16_t* vt = (LAS bf16_t*)(lds + ML_VT);
          if (MODE == 2) *(LAS u32x4*)(lds + ML_KS + (lane * ML_RS + 8 * wave) * 2) = rk;
          const unsigned kk[4] = {rk.x, rk.y, rk.z, rk.w}, a[4] = {rv0.x, rv0.y, rv0.z, rv0.w}, c[4] = {rv1.x, rv1.y, rv1.z, rv1.w};
#pragma unroll
          for (int e = 0; e < 4; ++e) { kt[(8 * wave + 2 * e) * ML_RS + lane] = (bf16_t)f2bf(bf2f((unsigned short)(kk[e] & 0xffffu)) * wj); kt[(8 * wave + 2 * e + 1) * ML_RS + lane] = (bf16_t)f2bf(bf2f((unsigned short)(kk[e] >> 16)) * wj);
              vt[(16 * wave + 2 * e) * ML_RS + lane] = (bf16_t)(a[e] & 0xffffu); vt[(16 * wave + 2 * e + 1) * ML_RS + lane] = (bf16_t)(a[e] >> 16);
              vt[(16 * wave + 8 + 2 * e) * ML_RS + lane] = (bf16_t)(c[e] & 0xffffu); vt[(16 * wave + 8 + 2 * e + 1) * ML_RS + lane] = (bf16_t)(c[e] >> 16); } }
        __syncthreads();
        PM2_END(2); PM2_BEGIN(3);
        if (ci + 1 < nch) load_chunk(ci + 1);
        const int par = ci & 1, npar = par ^ 1;
        if (MODE == 2) {
            const int it = wave >> 1, dh = wave & 1, i = 16 * it + fr;
            const bf16x8 q0 = ml_frag(lds, ML_QS, i, 8 * quad), q1 = ml_frag(lds, ML_QS, i, 32 + 8 * quad);
            const float mmi = tMM[i], si = tSI[i], fl = tFL[i];
            f32x4 sT[4];
#pragma unroll
            for (int jt = 0; jt < 4; ++jt) { sT[jt] = (f32x4){0.f, 0.f, 0.f, 0.f};
                if (jt <= it) {
                    sT[jt] = __builtin_amdgcn_mfma_f32_16x16x32_bf16(ml_frag(lds, ML_KS, 16 * jt + fr, 8 * quad), q0, sT[jt], 0, 0, 0);
                    sT[jt] = __builtin_amdgcn_mfma_f32_16x16x32_bf16(ml_frag(lds, ML_KS, 16 * jt + fr, 32 + 8 * quad), q1, sT[jt], 0, 0, 0);
                    const f32x4 uj = *(const LAS f32x4*)(tU + 16 * jt + 4 * quad);
#pragma unroll
                    for (int r = 0; r < 4; ++r) { const bool vis = (jt < it) || (4 * quad + r <= fr); sT[jt][r] = vis ? sT[jt][r] * fast_exp(uj[r] - mmi) : 0.f; } } }
            f32x4 o1[4], o2[4], d1 = (f32x4){0.f, 0.f, 0.f, 0.f}, d2 = (f32x4){0.f, 0.f, 0.f, 0.f};
#pragma unroll
            for (int dt = 0; dt < 4; ++dt) { o1[dt] = (f32x4){0.f, 0.f, 0.f, 0.f}; o2[dt] = (f32x4){0.f, 0.f, 0.f, 0.f}; }
#pragma unroll
            for (int u = 0; u < 2; ++u) if (2 * u <= it) {
                u32x4 pw; pw.x = cvt_pk_bf16(sT[2 * u][0], sT[2 * u][1]); pw.y = cvt_pk_bf16(sT[2 * u][2], sT[2 * u][3]); pw.z = cvt_pk_bf16(sT[2 * u + 1][0], sT[2 * u + 1][1]); pw.w = cvt_pk_bf16(sT[2 * u + 1][2], sT[2 * u + 1][3]);
                const bf16x8 pf = __builtin_bit_cast(bf16x8, pw);
#pragma unroll
                for (int dt = 0; dt < 5; ++dt) { const int vrow = dt < 4 ? 16 * (4 * dh + dt) + fr : 128 + fr;
                    const LAS bf16_t* vr = (const LAS bf16_t*)(lds + ML_VT) + vrow * ML_RS + 32 * u + 4 * quad;
                    u32x4 vw; const u32x2 a = *(const LAS u32x2*)vr, c = *(const LAS u32x2*)(vr + 16); vw.x = a.x; vw.y = a.y; vw.z = c.x; vw.w = c.y;
                    if (dt < 4) o1[dt] = __builtin_amdgcn_mfma_f32_16x16x32_bf16(__builtin_bit_cast(bf16x8, vw), pf, o1[dt], 0, 0, 0);
                    else d1 = __builtin_amdgcn_mfma_f32_16x16x32_bf16(__builtin_bit_cast(bf16x8, vw), pf, d1, 0, 0, 0); } }
#pragma unroll
            for (int dt = 0; dt < 5; ++dt) { const int crow = dt < 4 ? 16 * (4 * dh + dt) + fr : 128 + fr;
                const bf16x8 c0 = ml_frag(lds, ML_CT + par * ML_CTB, crow, 8 * quad), c1 = ml_frag(lds, ML_CT + par * ML_CTB, crow, 32 + 8 * quad);
                if (dt < 4) { o2[dt] = __builtin_amdgcn_mfma_f32_16x16x32_bf16(c0, q0, o2[dt], 0, 0, 0); o2[dt] = __builtin_amdgcn_mfma_f32_16x16x32_bf16(c1, q1, o2[dt], 0, 0, 0); }
                else { d2 = __builtin_amdgcn_mfma_f32_16x16x32_bf16(c0, q0, d2, 0, 0, 0); d2 = __builtin_amdgcn_mfma_f32_16x16x32_bf16(c1, q1, d2, 0, 0, 0); } }
            float den = d1[0] + si * d2[0]; den = lx_(den, fr);
            const float rinv = __builtin_amdgcn_rcpf(fmaxf(fabsf(den), fl));
#pragma unroll
            for (int dt = 0; dt < 4; ++dt) *(LAS f32x4*)(lds + ML_HS + (i * ML_HSS + 16 * (4 * dh + dt) + 4 * quad) * 4) = (o1[dt] + o2[dt] * si) * rinv;
        }
        { bf16x8 vb[2];
#pragma unroll
          for (int ks = 0; ks < 2; ++ks) vb[ks] = ml_frag(lds, ML_VT, 16 * wave + fr, 32 * ks + 8 * quad);
#pragma unroll
          for (int mt2 = 0; mt2 < 4; ++mt2) { st[mt2] = st[mt2] * sold;
#pragma unroll
              for (int ks = 0; ks < 2; ++ks) st[mt2] = __builtin_amdgcn_mfma_f32_16x16x32_bf16(ml_frag(lds, ML_KT, 16 * mt2 + fr, 32 * ks + 8 * quad), vb[ks], st[mt2], 0, 0, 0); }
          if (wave < 4) { st[4] = st[4] * sold;
#pragma unroll
              for (int ks = 0; ks < 2; ++ks) st[4] = __builtin_amdgcn_mfma_f32_16x16x32_bf16(ml_frag(lds, ML_KT, 16 * wave + fr, 32 * ks + 8 * quad), ml_frag(lds, ML_VT, 128 + fr, 32 * ks + 8 * quad), st[4], 0, 0, 0); }
          if (MODE == 2) {
#pragma unroll
              for (int i = 0; i < 5; ++i) { const int dv = (i < 4) ? 16 * wave + fr : 128 + fr, dk = (i < 4) ? 16 * i + 4 * quad : 16 * wave + 4 * quad;
                  if (i < 4 || wave < 4) { u32x2 w; w.x = pk2(st[i][0], st[i][1]); w.y = pk2(st[i][2], st[i][3]); *(LAS u32x2*)(lds + ML_CT + npar * ML_CTB + (dv * ML_RS + dk) * 2) = w; } } }
        }
        __syncthreads();
        PM2_END(3); PM2_BEGIN(4);
        if (MODE == 2) {
            const int i = tid >> 3, sg = tid & 7; const LAS float* hp = (const LAS float*)(lds + ML_HS) + i * ML_HSS + 16 * sg;
            float x[16]; float s = 0.f;
#pragma unroll
            for (int e = 0; e < 16; ++e) { x[e] = hp[e]; s += x[e]; }
            s += SHX(s, 1); s += SHX(s, 2); s += SHX(s, 4);
            const float mean = s * (1.f / M_V); float q = 0.f;
#pragma unroll
            for (int e = 0; e < 16; ++e) { x[e] -= mean; q += x[e] * x[e]; }
            q += SHX(q, 1); q += SHX(q, 2); q += SHX(q, 4);
            const float rstd = 1.f / sqrtf(q * (1.f / M_V) + LN_EPS);
            if (i < nv && (nv == 64 || b == 0)) {
                const size_t row = (size_t)(rbase + i);
                const unsigned gw8[8] = {g0.x, g0.y, g0.z, g0.w, g1.x, g1.y, g1.z, g1.w}; unsigned ow[8];
#pragma unroll
                for (int e = 0; e < 8; ++e) { const float oga = bf2f((unsigned short)(gw8[e] & 0xffffu)), ogb = bf2f((unsigned short)(gw8[e] >> 16));
                    const float ya = x[2 * e] * rstd * lnh[2 * e] * __builtin_amdgcn_rcpf(1.f + fast_exp(-oga)), yb = x[2 * e + 1] * rstd * lnh[2 * e + 1] * __builtin_amdgcn_rcpf(1.f + fast_exp(-ogb));
                    ow[e] = pk2(ya, yb); }
                u32x4* op = (u32x4*)(HG + row * D + h * M_V + 16 * sg);
                op[0] = (u32x4){ow[0], ow[1], ow[2], ow[3]}; op[1] = (u32x4){ow[4], ow[5], ow[6], ow[7]};
            }
        }
        PM2_END(4);
    }
    if (PROBE_M2 && MODE == 2 && pticks) *pticks += pacc;
    if (MODE == 1) {
        f32x4* sp = (f32x4*)(STATE + (size_t)(bh * 7 + seg) * ST_FLOATS) + (wave * 5) * 64 + lane;
#pragma unroll
        for (int i = 0; i < 5; ++i) sp[i * 64] = (i < 4 || wave < 4) ? st[i] : (f32x4){0.f, 0.f, 0.f, 0.f};
        if (tid == 0) { STSC[(bh * 7 + seg) * 4 + 0] = tsc[160]; STSC[(bh * 7 + seg) * 4 + 1] = tsc[161]; }
    }
}

constexpr int AT_KRS = 72, AT_VRS = 280, AT_NK = 272;
constexpr int AT_KS = 0, AT_VT = AT_NK * AT_KRS * 2, AT_END = AT_VT + 64 * AT_VRS * 2;
static_assert(AT_END <= MISC_OFF, "attention LDS");
__device__ __forceinline__ void attn_phase(unsigned char* ws, LAS unsigned char* lds, int j_layer, int tid, int wave, int lane) {
    const bf16_t* Q = (const bf16_t*)(ws + WS_PROJ); const bf16_t* KB = (const bf16_t*)(ws + WS_KB); const bf16_t* VT = (const bf16_t*)(ws + WS_VB);
    unsigned char* HG8 = ws + WS_HG;
    const float* sinks = (const float*)(ws + WS_SMALL) + SM_SINKS + j_layer * A_HEADS;
    const int fr = lane & 15, quad = lane >> 4;
    LAS bf16_t* ks = (LAS bf16_t*)(lds + AT_KS); LAS bf16_t* vt = (LAS bf16_t*)(lds + AT_VT);
    u32x4 kreg[5], vreg[5]; bf16x8 qn[2][2];
    const int NREG = NBATCH * A_KV * (SEQ / WINDOW), NIT = NREG + A_KV;
    auto prefetch = [&](int it) {
        const bool meta = it >= NREG; const int b = meta ? 0 : it >> 8, g = meta ? it - NREG : (it >> 6) & 3, blk = meta ? -1 : it & 63;
#pragma unroll
        for (int i = 0; i < 5; ++i) { const int p = tid + i * NTHREADS; kreg[i] = (u32x4){0u, 0u, 0u, 0u}; vreg[i] = (u32x4){0u, 0u, 0u, 0u};
            if (p < AT_NK * 8) { const int kk = p >> 3, c8 = (p & 7) * 8;
                int row; if (kk >= 256) row = MREAL + kk - 256; else { const int tk = (blk - 1) * WINDOW + kk; row = (tk < 0 || meta) ? -1 : b * SEQ + tk; }
                if (row >= 0) kreg[i] = *(const u32x4*)(KB + (size_t)row * 256 + g * 64 + c8);
                const int d = p / 34, pc = p % 34; const bf16_t* src = VT + (size_t)(g * 64 + d) * MP;
                if (pc >= 32) vreg[i] = *(const u32x4*)(src + MREAL + (pc - 32) * 8);
                else { const int tk = (blk - 1) * WINDOW + pc * 8; if (tk >= 0 && !meta) vreg[i] = *(const u32x4*)(src + (size_t)b * SEQ + tk); } } }
    };
    auto qload = [&](int it, int mp) {
        const bool meta = it >= NREG; const int b = it >> 8, g = meta ? it - NREG : (it >> 6) & 3, blk = it & 63, qh = g * 4 + (wave >> 1);
#pragma unroll
        for (int x = 0; x < 2; ++x) { const size_t rowq = meta ? (size_t)MREAL + fr : (size_t)b * SEQ + blk * WINDOW + 16 * (4 * (wave & 1) + 2 * mp + x) + fr;
#pragma unroll
            for (int k2 = 0; k2 < 2; ++k2) qn[x][k2] = *(const bf16x8*)(Q + rowq * D + qh * 64 + 32 * k2 + 8 * quad); }
    };
    if ((int)blockIdx.x < NIT) { prefetch(blockIdx.x); qload(blockIdx.x, 0); }
    for (int it = blockIdx.x; it < NIT; it += gridDim.x) {
        const bool meta = it >= NREG; const int b = it >> 8, g = meta ? it - NREG : (it >> 6) & 3, blk = it & 63;
        __syncthreads();
#pragma unroll
        for (int i = 0; i < 5; ++i) { const int p = tid + i * NTHREADS;
            if (p < AT_NK * 8) { *(LAS u32x4*)(ks + (p >> 3) * AT_KRS + (p & 7) * 8) = kreg[i]; *(LAS u32x4*)(vt + (p / 34) * AT_VRS + (p % 34) * 8) = vreg[i]; } }
        __syncthreads();
        const bool has_next = it + (int)gridDim.x < NIT;
        if (has_next) prefetch(it + gridDim.x);
        const int qh = g * 4 + (wave >> 1); const float sink = sinks[qh];
#pragma unroll 1
        for (int mp = 0; mp < 2; ++mp) {
            if (meta && (mp > 0 || (wave & 1))) continue;
            const int t0 = meta ? 0 : 4 * (wave & 1) + 2 * mp;
            f32x4 s[2][11];
#pragma unroll
            for (int c = 0; c < 11; ++c) { const int kb = (c < 10) ? 16 * (t0 + c) : 256; s[0][c] = (f32x4){0.f, 0.f, 0.f, 0.f}; s[1][c] = (f32x4){0.f, 0.f, 0.f, 0.f};
#pragma unroll
                for (int k2 = 0; k2 < 2; ++k2) { const bf16x8 kf = *(const LAS bf16x8*)(ks + (kb + fr) * AT_KRS + 32 * k2 + 8 * quad);
                    if (c != 9) s[0][c] = __builtin_amdgcn_mfma_f32_16x16x32_bf16(kf, qn[0][k2], s[0][c], 0, 0, 0);
                    if (c != 0) s[1][c] = __builtin_amdgcn_mfma_f32_16x16x32_bf16(kf, qn[1][k2], s[1][c], 0, 0, 0); } }
            if (mp == 0) { if (!meta) qload(it, 1); } else if (has_next) qload(it + gridDim.x, 0);
            float inv[2];
#pragma unroll
            for (int x = 0; x < 2; ++x) {
                float m = sink;
#pragma unroll
                for (int c = 0; c < 10; ++c) { const int rc = c - x;
                    const bool tok = !meta && rc >= 0 && rc <= 8 && (blk > 0 || t0 + c >= 8);
#pragma unroll
                    for (int r = 0; r < 4; ++r) { const bool vis = tok && (rc != 0 || fr < 4 * quad + r) && (rc != 8 || fr >= 4 * quad + r);
                        s[x][c][r] = vis ? s[x][c][r] : -1.0e30f; m = fmaxf(m, s[x][c][r]); } }
#pragma unroll
                for (int r = 0; r < 4; ++r) { const bool vis = !meta || (4 * quad + r <= fr); s[x][10][r] = vis ? s[x][10][r] : -1.0e30f; m = fmaxf(m, s[x][10][r]); }
                m = fmaxf(m, SHX(m, 16)); m = fmaxf(m, SHX(m, 32));
                float sm = 0.f;
#pragma unroll
                for (int c = 0; c < 11; ++c)
#pragma unroll
                    for (int r = 0; r < 4; ++r) { const float p = fast_exp(s[x][c][r] - m); s[x][c][r] = p; sm += p; }
                sm += SHX(sm, 16); sm += SHX(sm, 32);
                inv[x] = 1.f / (sm + fast_exp(sink - m));
            }
            f32x4 o[2][4];
#pragma unroll
            for (int x = 0; x < 2; ++x)
#pragma unroll
                for (int dt = 0; dt < 4; ++dt) o[x][dt] = (f32x4){0.f, 0.f, 0.f, 0.f};
#pragma unroll
            for (int u = 0; u < 6; ++u) {
                const int kb0 = (u < 5) ? 16 * (t0 + 2 * u) : 256, kb1 = (u < 5) ? 16 * (t0 + 2 * u + 1) : 256;
                bf16x8 pf[2];
#pragma unroll
                for (int x = 0; x < 2; ++x) { u32x4 pw;
                    if (u < 5) { pw.x = cvt_pk_bf16(s[x][2 * u][0], s[x][2 * u][1]); pw.y = cvt_pk_bf16(s[x][2 * u][2], s[x][2 * u][3]); pw.z = cvt_pk_bf16(s[x][2 * u + 1][0], s[x][2 * u + 1][1]); pw.w = cvt_pk_bf16(s[x][2 * u + 1][2], s[x][2 * u + 1][3]); }
                    else { pw.x = cvt_pk_bf16(s[x][10][0], s[x][10][1]); pw.y = cvt_pk_bf16(s[x][10][2], s[x][10][3]); pw.z = 0u; pw.w = 0u; }
                    pf[x] = __builtin_bit_cast(bf16x8, pw); }
#pragma unroll
                for (int dt = 0; dt < 4; ++dt) { const LAS bf16_t* vr = vt + (16 * dt + fr) * AT_VRS + 4 * quad;
                    u32x4 vw; const u32x2 a = *(const LAS u32x2*)(vr + kb0), c2 = *(const LAS u32x2*)(vr + kb1); vw.x = a.x; vw.y = a.y; vw.z = c2.x; vw.w = c2.y;
                    const bf16x8 vf = __builtin_bit_cast(bf16x8, vw);
                    o[0][dt] = __builtin_amdgcn_mfma_f32_16x16x32_bf16(vf, pf[0], o[0][dt], 0, 0, 0);
                    o[1][dt] = __builtin_amdgcn_mfma_f32_16x16x32_bf16(vf, pf[1], o[1][dt], 0, 0, 0); } }
#pragma unroll
            for (int x = 0; x < 2; ++x) { if (meta && x > 0) continue;
                const size_t rowq = meta ? (size_t)MREAL + fr : (size_t)b * SEQ + blk * WINDOW + 16 * (t0 + x) + fr;
#pragma unroll
                for (int dt = 0; dt < 4; ++dt) { const float sv = inv[x] * F8_SO;
                    *(unsigned*)(HG8 + rowq * D + qh * 64 + 16 * dt + 4 * quad) = pk4_fp8(o[x][dt][0] * sv, o[x][dt][1] * sv, o[x][dt][2] * sv, o[x][dt][3] * sv); } }
        }
    }
}

#ifndef SITES
#define SITES 0xFFFF
#endif
#define SITE(n) ((SITES >> (n)) & 1)
#ifndef DUPMASK
#define DUPMASK 0
#endif
#define REPS(n) (1 + ((DUPMASK >> (n)) & 1))
#ifndef MK_PER_PHASE
#define MK_PER_PHASE 0
#endif
constexpr int PH_PER_LAYER = 12, N_PHASES = 1 + 4 * PH_PER_LAYER;

__global__ void __launch_bounds__(NTHREADS, 2) fwd(Params P) {
    extern __shared__ __attribute__((aligned(16))) unsigned char lds_raw[];
    LAS unsigned char* const lds0 = (LAS unsigned char*)lds_raw;
    const int wave_s = __builtin_amdgcn_readfirstlane((int)threadIdx.x >> 6);
    const int G = gridDim.x;
    const int vcu = (G % 8 == 0) ? ((int)blockIdx.x % 8) * (G / 8) + (int)blockIdx.x / 8 : (int)blockIdx.x;
    const int NGW = G * NWAVES;
    unsigned char* const wsbase = P.ws;
    volatile LAS unsigned* misc = (volatile LAS unsigned*)(lds0 + MISC_OFF);
    if (threadIdx.x < 64) misc[threadIdx.x] = 0u;
    __syncthreads();
    XcdBarrier bar = xcd_barrier_post((unsigned*)(wsbase + WS_CTL) + CW_BAR + P.li * 4096, misc + 8);
    const int lo = P.ph_lo, hi = P.ph_hi;
    unsigned long long idle_ticks = 0; (void)idle_ticks;
#define RUN(idx) ((idx) >= lo && (idx) < hi)
#ifndef PROBE_IDLE
#define PROBE_IDLE 0
#endif
#if PROBE_IDLE
#ifndef PROBE_KMASK
#define PROBE_KMASK 0xFFFF
#endif
#define SEAM(idx) do { if ((idx) + 1 < hi) { const unsigned long long _t0 = __builtin_amdgcn_s_memrealtime(); xcd_barrier(bar, tid == 0); const int _k = (idx) == 0 ? 15 : ((idx) - 1) % PH_PER_LAYER; \
        if ((PROBE_KMASK >> _k) & 1) idle_ticks += __builtin_amdgcn_s_memrealtime() - _t0; } } while (0)
#else
#define SEAM(idx) do { if ((idx) + 1 < hi) xcd_barrier(bar, tid == 0); } while (0)
#endif
#define IDS() unsigned mall = ~0u; asm volatile("; opaque mask" : "+s"(mall)); int tid = wave_s * 64 + (int)__builtin_amdgcn_mbcnt_hi(mall, __builtin_amdgcn_mbcnt_lo(mall, 0u)); asm volatile("; opaque tid" : "+v"(tid));   size_t wsz = 0; asm volatile("; opaque ws offset" : "+s"(wsz)); unsigned char* ws = wsbase + wsz;   \
              LAS unsigned char* lds = lds0; asm volatile("; opaque lds" : "+s"(lds)); \
              const int lane = tid & 63, wave = __builtin_amdgcn_readfirstlane(tid >> 6); const int gw = vcu * NWAVES + wave; (void)lane; (void)gw; (void)ws

    for (int rep = 0; rep < REPS(0); ++rep) if (SITE(0) && RUN(0)) { IDS(); p0_prologue(P, lds, gw, NGW, wave, lane, bar, tid); SEAM(0); }

    for (int l = 0; l < 4; ++l) {
        const int pb = 1 + l * PH_PER_LAYER;
        const bool moe = (l & 1) != 0; const int fi = l >> 1;
        if (l < 2) {
            for (int rep = 0; rep < REPS(1); ++rep) if (SITE(1) && RUN(pb + 0)) {
                IDS();
                pg8::DenseOrder S; S.init(MREAL / 256, 12, G, (int)blockIdx.x);
                const float* smi = (const float*)(ws + WS_SMALL); const float asc = l == 0 ? smi[SM_WSCALE + 23] : smi[SM_ASCALE + 2 * l - 1];
                EpiProj E{(bf16_t*)(ws + WS_PROJ), (float*)(ws + WS_GATES), smi + SM_BGATE + l * 16, asc * smi[SM_WSCALE + 21 + l]};
                const bf16_t* HBp = (const bf16_t*)(ws + WS_HB); const bf16_t* Wp = (const bf16_t*)(ws + WS_WIN) + (size_t)l * M_INP * D;
                pg8::gemm_phase<EpiProj, pg8::DenseOrder, 2>(lds, ws + WS_HB8, ws + WS_WIN8 + (size_t)l * 3072 * D, D, S, E, tid);
                bf16_t* PROJ = (bf16_t*)(ws + WS_PROJ); float* GATES = (float*)(ws + WS_GATES); const float* bg = (const float*)(ws + WS_SMALL) + SM_BGATE + l * 16;
                unsigned* itemctr = (unsigned*)(ws + WS_CTL) + CW_ITEM + l * 8 + 1; int par = 0;
                for (int item = claim_item(itemctr, lds, tid); item < 192; item = claim_item(itemctr, lds, tid), par ^= 1) { const bf16_t* B1[1] = {Wp + (size_t)item * 16 * D};
                    skinny_item<1>(HBp + (size_t)MREAL * D, D, B1, D, wave, lane, lds, par, [&](const f32x4 (&a)[1], int fr, int quad) {
#pragma unroll
                        for (int r = 0; r < 4; ++r) PROJ[(size_t)(MREAL + 4 * quad + r) * PROJ_LD + item * 16 + fr] = (bf16_t)f2bf(a[0][r]); }); }
                { const int fr = lane & 15, quad = lane >> 4; const bf16_t* bp = Wp + (size_t)(3072 + fr) * D + 8 * quad; const float bias = bg[fr];
                  for (int rt = gw; rt < MV / 16; rt += NGW) { const bf16_t* ap = HBp + (size_t)(rt * 16 + fr) * D + 8 * quad;
                      f32x4 a0 = (f32x4){0.f, 0.f, 0.f, 0.f}, a1 = (f32x4){0.f, 0.f, 0.f, 0.f};
#pragma unroll 8
                      for (int k = 0; k < D; k += 64) { a0 = __builtin_amdgcn_mfma_f32_16x16x32_bf16(*(const bf16x8*)(ap + k), *(const bf16x8*)(bp + k), a0, 0, 0, 0);
                          a1 = __builtin_amdgcn_mfma_f32_16x16x32_bf16(*(const bf16x8*)(ap + k + 32), *(const bf16x8*)(bp + k + 32), a1, 0, 0, 0); }
#pragma unroll
                      for (int r = 0; r < 4; ++r) GATES[(size_t)(rt * 16 + 4 * quad + r) * 16 + fr] = a0[r] + a1[r] + bias; } }
                SEAM(pb + 0); }
            for (int rep = 0; rep < REPS(2); ++rep) if (SITE(2) && RUN(pb + 1)) { IDS(); mlstm_phase<1>(ws, lds, l, tid, wave, lane); SEAM(pb + 1); }
            for (int rep = 0; rep < REPS(3); ++rep) if (SITE(3) && RUN(pb + 2)) { IDS(); mlstm_phase<2>(ws, lds, l, tid, wave, lane, &idle_ticks); SEAM(pb + 2); }
        } else {
            for (int rep = 0; rep < REPS(4); ++rep) if (SITE(4) && RUN(pb + 0)) {
                IDS();
                pg8::DenseOrder S; S.init(MREAL / 256, l == 2 ? 6 : 4, G, (int)blockIdx.x);
                const float* smq = (const float*)(ws + WS_SMALL); const float asc = smq[SM_ASCALE + 2 * l - 1];
                EpiQKV E{(bf16_t*)(ws + WS_PROJ), (bf16_t*)(ws + WS_KB), (bf16_t*)(ws + WS_VB), (const float*)(ws + WS_ROPE), asc * smq[SM_WSCALE + 18 + (l - 2)] * 0.125f, asc * smq[SM_WSCALE + 20], lds + RING_BYTES};
                const bf16_t* HBp = (const bf16_t*)(ws + WS_HB); const bf16_t* Wp = (const bf16_t*)(ws + (l == 2 ? WS_WQKV : WS_WQ3));
                pg8::gemm_phase<EpiQKV, pg8::DenseOrder, 2>(lds, ws + WS_HB8, ws + WS_WQKV8 + (l == 2 ? 0 : (size_t)1536 * D), D, S, E, tid);
                bf16_t* Qp = (bf16_t*)(ws + WS_PROJ); bf16_t* KBp = (bf16_t*)(ws + WS_KB); bf16_t* VTp = (bf16_t*)(ws + WS_VB); const float* rope = (const float*)(ws + WS_ROPE);
                unsigned* itemctr = (unsigned*)(ws + WS_CTL) + CW_ITEM + l * 8 + 2; int par = 0;
                for (int item = claim_item(itemctr, lds, tid); item < (l == 2 ? 96 : 64); item = claim_item(itemctr, lds, tid), par ^= 1) { const bf16_t* B1[1] = {Wp + (size_t)item * 16 * D};
                    skinny_item<1>(HBp + (size_t)MREAL * D, D, B1, D, wave, lane, lds, par, [&](const f32x4 (&a)[1], int fr, int quad) {
                        const int col = item * 16 + fr; const bool dorope = (item < 80) && ((item & 3) == 0);
#pragma unroll
                        for (int r = 0; r < 4; ++r) { const int pos = 4 * quad + r; float x = a[0][r]; const float y = SHX(x, 8);
                            if (dorope) { const float c = rope[pos * 16 + (fr & 7)], sn = rope[pos * 16 + 8 + (fr & 7)]; x = (fr < 8) ? x * c - y * sn : x * c + y * sn; }
                            const bf16_t o = (bf16_t)f2bf(x); const size_t row = (size_t)MREAL + pos;
                            if (item < 64) Qp[row * D + col] = o; else if (item < 80) KBp[row * 256 + col - 1024] = o; else VTp[(size_t)(col - 1280) * MP + row] = o; } });
                }
                SEAM(pb + 0); }
            for (int rep = 0; rep < REPS(5); ++rep) if (SITE(5) && RUN(pb + 1)) { IDS(); attn_phase(ws, lds, l - 2, tid, wave, lane); SEAM(pb + 1); }
        }
        for (int rep = 0; rep < REPS(6); ++rep) if (SITE(6) && RUN(pb + 3)) {
            IDS();
            pg8::DenseOrder S; S.init(MREAL / 256, 4, G, (int)blockIdx.x);
            const float* smp = (const float*)(ws + WS_SMALL);
            EpiRes E{(bf16_t*)(ws + WS_H), (const float*)(ws + WS_STATS), l > 0 ? smp + SM_LNG + (size_t)(2 * l - 1) * D : nullptr, smp + SM_LNB + (size_t)(l > 0 ? 2 * l - 1 : 0) * D, P.in[I_X], 1.f};
            if (l < 2) {
            const bf16_t* Ap = (const bf16_t*)(ws + WS_HG); const bf16_t* Wp = (const bf16_t*)(ws + WS_WOUT) + (size_t)(l & 1) * D * D;
            pg8::gemm_phase(lds, Ap, Wp, D, S, E, tid);
            unsigned* itemctr = (unsigned*)(ws + WS_CTL) + CW_ITEM + l * 8 + 3; int par = 0;
            for (int item = claim_item(itemctr, lds, tid); item < 64; item = claim_item(itemctr, lds, tid), par ^= 1) { const bf16_t* B1[1] = {Wp + (size_t)item * 16 * D};
                skinny_item<1>(Ap + (size_t)MREAL * D, D, B1, D, wave, lane, lds, par, [&](const f32x4 (&a)[1], int fr, int quad) { const int col = item * 16 + fr;
#pragma unroll
                    for (int r = 0; r < 4; ++r) { const size_t row = (size_t)MREAL + 4 * quad + r; float h = E.lg ? bf2f(E.H[row * D + col]) : P.in[I_META][(size_t)(4 * quad + r) * D + col];
                        if (E.lg) h = (h - E.stats[2 * row]) * E.stats[2 * row + 1] * E.lg[col] + E.lb[col];
                        E.H[row * D + col] = (bf16_t)f2bf(h * ALPHA + a[0][r]); } });
            }
            } else {
            EpiRes E8 = E; E8.sc = F8_INVO;
            const unsigned char* Ap = ws + WS_HG; const unsigned char* Wp = ws + WS_WO8 + (size_t)(l & 1) * D * D;
            pg8::gemm_phase<EpiRes, pg8::DenseOrder, 1>(lds, Ap, Wp, D, S, E8, tid);
            unsigned* itemctr = (unsigned*)(ws + WS_CTL) + CW_ITEM + l * 8 + 4; int par = 0;
            for (int item = claim_item(itemctr, lds, tid); item < 64; item = claim_item(itemctr, lds, tid), par ^= 1) { const unsigned char* B1[1] = {Wp + (size_t)item * 16 * D};
                skinny_item8<1>(Ap + (size_t)MREAL * D, D, B1, D, wave, lane, lds, par, [&](const f32x4 (&a)[1], int fr, int quad) { const int col = item * 16 + fr;
#pragma unroll
                    for (int r = 0; r < 4; ++r) { const size_t row = (size_t)MREAL + 4 * quad + r; float h = bf2f(E.H[row * D + col]);
                        h = (h - E.stats[2 * row]) * E.stats[2 * row + 1] * E.lg[col] + E.lb[col];
                        E.H[row * D + col] = (bf16_t)f2bf(h * ALPHA + a[0][r] * F8_INVO); } });
            }
            }
            SEAM(pb + 3); }
        for (int rep = 0; rep < (moe ? REPS(14) : REPS(7)); ++rep) if (SITE(7) && RUN(pb + 4)) { IDS(); ln_phase(ws, nullptr, lds, gw, NGW, lane, tid, l * 2 + 0, false, moe, fi, false, moe && rep > 0, true); SEAM(pb + 4); }
        if (!moe) {
            for (int rep = 0; rep < REPS(8); ++rep) if (SITE(8) && RUN(pb + 5)) {
                IDS();
                pg8::DenseOrder S; S.init(MREAL / 256, 2 * D_FF / 256, G, (int)blockIdx.x);
                EpiSwiglu8 E{ws + WS_ACT, D_FF, ((const float*)(ws + WS_SMALL))[SM_ASCALE + 2 * l], (const float*)(ws + WS_SMALL) + SM_WSCALE + fi, 0};
                const bf16_t* HBp = (const bf16_t*)(ws + WS_HB); const bf16_t* Wp = (const bf16_t*)(ws + WS_WGU) + (size_t)fi * 2 * D_FF * D;
                pg8::gemm_phase<EpiSwiglu8, pg8::DenseOrder, 2>(lds, ws + WS_HB8, ws + WS_WGU8 + (size_t)fi * 2 * D_FF * D, D, S, E, tid);
                unsigned* itemctr = (unsigned*)(ws + WS_CTL) + CW_ITEM + l * 8 + 5; int par = 0;
                for (int item = claim_item(itemctr, lds, tid); item < D_FF / 16; item = claim_item(itemctr, lds, tid), par ^= 1) {
                    const int brow = 256 * (item >> 3) + 16 * (item & 7); const bf16_t* B2[2] = {Wp + (size_t)brow * D, Wp + (size_t)(brow + 128) * D};
                    skinny_item<2>(HBp + (size_t)MREAL * D, D, B2, D, wave, lane, lds, par, [&](const f32x4 (&a)[2], int fr, int quad) {
#pragma unroll
                        for (int r = 0; r < 4; ++r) E.act[(size_t)(MREAL + 4 * quad + r) * D_FF + item * 16 + fr] = (unsigned char)(pk4_fp8(EpiSwiglu::silu_mul(a[0][r], a[1][r]) * F8_SACT, 0.f, 0.f, 0.f) & 0xffu); });
                }
                SEAM(pb + 5); }
            for (int rep = 0; rep < REPS(9); ++rep) if (SITE(9) && RUN(pb + 6)) {
                IDS();
                pg8::DenseOrder S; S.init(MREAL / 256, 4, G, (int)blockIdx.x);
                const float* smp = (const float*)(ws + WS_SMALL);
                EpiRes E{(bf16_t*)(ws + WS_H), (const float*)(ws + WS_STATS), smp + SM_LNG + (size_t)(2 * l) * D, smp + SM_LNB + (size_t)(2 * l) * D, nullptr, F8_INVD};
                const unsigned char* Ap = ws + WS_ACT; const unsigned char* Wp = ws + WS_WDN8 + (size_t)fi * D * D_FF;
                pg8::gemm_phase<EpiRes, pg8::DenseOrder, true>(lds, Ap, Wp, D_FF, S, E, tid);
                unsigned* itemctr = (unsigned*)(ws + WS_CTL) + CW_ITEM + l * 8 + 6; int par = 0;
                for (int item = claim_item(itemctr, lds, tid); item < 64; item = claim_item(itemctr, lds, tid), par ^= 1) { const unsigned char* B1[1] = {Wp + (size_t)item * 16 * D_FF};
                    skinny_item8<1>(Ap + (size_t)MREAL * D_FF, D_FF, B1, D_FF, wave, lane, lds, par, [&](const f32x4 (&a)[1], int fr, int quad) { const int col = item * 16 + fr;
#pragma unroll
                        for (int r = 0; r < 4; ++r) { const size_t row = (size_t)MREAL + 4 * quad + r; float h = bf2f(E.H[row * D + col]);
                            h = (h - E.stats[2 * row]) * E.stats[2 * row + 1] * E.lg[col] + E.lb[col];
                            E.H[row * D + col] = (bf16_t)f2bf(h * ALPHA + a[0][r] * E.sc); } });
                }
                SEAM(pb + 6); }
        } else {
            for (int rep = 0; rep < REPS(10); ++rep) if (SITE(10) && RUN(pb + 5)) { IDS(); assign_phase(ws, lds, gw, NGW, lane, tid, wave, fi); SEAM(pb + 5); }
            for (int rep = 0; rep < REPS(11); ++rep) if (SITE(11) && RUN(pb + 6)) {
                IDS();
                int cnt[8]; pg8::GroupedOrder S; moe_starts(ws, fi, cnt, S.pstart);
                S.o.init(S.pstart[8], 2 * D_FF_EXP / 256, G, (int)blockIdx.x); S.nexp_rows = 2 * D_FF_EXP; S.rowtok = (const int*)(ws + WS_ROWTOK);
                EpiSwiglu8 E{ws + WS_ACT, D_FF_EXP, ((const float*)(ws + WS_SMALL))[SM_ASCALE + 2 * l], (const float*)(ws + WS_SMALL) + SM_WSCALE + 2 + fi * 8, 2 * D_FF_EXP};
                pg8::gemm_phase<EpiSwiglu8, pg8::GroupedOrder, 2>(lds, ws + WS_HB8, ws + WS_WGUE8 + (size_t)fi * 8 * 2 * D_FF_EXP * D, D, S, E, tid);
                SEAM(pb + 6); }
            for (int rep = 0; rep < REPS(12); ++rep) if (SITE(12) && RUN(pb + 7)) {
                IDS();
                int cnt[8]; pg8::GroupedOrder S; moe_starts(ws, fi, cnt, S.pstart);
                S.o.init(S.pstart[8], 4, G, (int)blockIdx.x); S.nexp_rows = D; S.rowtok = nullptr;
                EpiScatter E{(bf16_t*)(ws + WS_CONTRIB), (const int*)(ws + WS_ROWDST), (const float*)(ws + WS_ROWGATE), F8_INVD};
                pg8::gemm_phase<EpiScatter, pg8::GroupedOrder, true>(lds, ws + WS_ACT, ws + WS_WDNE8 + (size_t)fi * 8 * D * D_FF_EXP, D_FF_EXP, S, E, tid);
                SEAM(pb + 7); }
        }
        for (int rep = 0; rep < (moe ? (l == 1 ? REPS(15) : 1) : REPS(13)); ++rep) if (SITE(13) && RUN(pb + 10)) { IDS(); ln_phase(ws, P.out, lds, gw, NGW, lane, tid, l * 2 + 1, moe, false, 0, l == 3, moe && rep == 0 && REPS(15) > 1, l <= 2, l == 0); SEAM(pb + 10); }
    }
#if PROBE_IDLE
    { unsigned* ctl = (unsigned*)(wsbase + WS_CTL); IDS();
      if (tid == 0) __hip_atomic_fetch_add(ctl + 2048, (unsigned)idle_ticks, __ATOMIC_RELAXED, __HIP_MEMORY_SCOPE_AGENT);
      xcd_barrier(bar, tid == 0);
      if (blockIdx.x == 0 && tid == 0) { const unsigned long long w = (unsigned long long)__hip_atomic_load(ctl + 2048, __ATOMIC_RELAXED, __HIP_MEMORY_SCOPE_AGENT) / (unsigned)G;
          const unsigned long long t0 = __builtin_amdgcn_s_memrealtime(); while (__builtin_amdgcn_s_memrealtime() - t0 < w) __builtin_amdgcn_s_sleep(8); } }
#endif
#undef RUN
#undef SEAM
#undef IDS
}

extern "C" void kernel_launch(void* const* d_in, const int* in_sizes, int n_in, void* d_out, int out_size, void* d_ws, size_t ws_size, hipStream_t stream) {
    static int grid = 0;
    if (grid == 0) {
        if (n_in != 18 || out_size != MREAL * D || ws_size < WS_END) { fprintf(stderr, "kernel_launch: unexpected shapes (n_in %d, out %d, ws %zu < %zu)\n", n_in, out_size, ws_size, (size_t)WS_END); grid = -1; return; }
        int dev = 0, cus = 0, per_cu = 0;
        if (hipGetDevice(&dev) != hipSuccess || hipDeviceGetAttribute(&cus, hipDeviceAttributeMultiprocessorCount, dev) != hipSuccess) { grid = -1; return; }
        if (hipFuncSetAttribute((const void*)fwd, hipFuncAttributeMaxDynamicSharedMemorySize, LDS_BYTES) != hipSuccess) { fprintf(stderr, "kernel_launch: hipFuncSetAttribute failed\n"); grid = -1; return; }
        if (hipOccupancyMaxActiveBlocksPerMultiprocessor(&per_cu, (const void*)fwd, NTHREADS, LDS_BYTES) != hipSuccess || per_cu < 1) fprintf(stderr, "kernel_launch: occupancy query reports %d\n", per_cu);
        (void)hipGetLastError();
        grid = cus > 256 ? 256 : cus;
    }
    if (grid < 0) return;
    (void)in_sizes;
    if (hipMemsetAsync((char*)d_ws + WS_CTL, 0, CTL_BYTES, stream) != hipSuccess) return;
    Params p{};
    for (int i = 0; i < 18; ++i) p.in[i] = (const float*)d_in[i];
    p.out = (float*)d_out; p.ws = (unsigned char*)d_ws;
#if MK_PER_PHASE
    int li = 0;
    for (int ph = 0; ph < N_PHASES; ++ph) {
        const int k = (ph - 1) % PH_PER_LAYER, l = (ph - 1) / PH_PER_LAYER;
        if (ph > 0) { const bool moe = l & 1; if (k == 2 && l >= 2) continue; if (k == 8 || k == 9 || k == 11) continue; if (k == 7 && !moe) continue; }
        p.ph_lo = ph; p.ph_hi = ph + 1; p.li = li++; p.pad = 0;
        hipLaunchKernelGGL(fwd, dim3(grid), dim3(NTHREADS), LDS_BYTES, stream, p);
    }
#else
    p.ph_lo = 0; p.ph_hi = N_PHASES; p.li = 0; p.pad = 0;
    hipLaunchKernelGGL(fwd, dim3(grid), dim3(NTHREADS), LDS_BYTES, stream, p);
#endif
}
```

```cpp
#include <hip/hip_runtime.h>
#include <cstdio>
#include <cstdint>

#define LAS __attribute__((address_space(3)))
#define GAS __attribute__((address_space(1)))
typedef unsigned short bf16_t;
typedef short bf16x8 __attribute__((ext_vector_type(8)));
typedef float f32x4 __attribute__((ext_vector_type(4)));
typedef float f32x2 __attribute__((ext_vector_type(2)));
typedef unsigned u32x4 __attribute__((ext_vector_type(4)));
typedef unsigned u32x2 __attribute__((ext_vector_type(2)));
typedef int i32x8 __attribute__((ext_vector_type(8)));
typedef int i32x4 __attribute__((ext_vector_type(4)));

constexpr int D = 1024, NBATCH = 4, SEQ = 8192, NMETA = 16;
constexpr int MREAL = NBATCH * SEQ;
constexpr int MV = MREAL + NMETA;
constexpr int MP = 129 * 256;
constexpr int M_HEADS = 8, M_QK = 64, M_V = 128;
constexpr int M_IN = 3088, M_INP = 3328;
constexpr int PROJ_LD = 3072;
constexpr int A_HEADS = 16, A_KV = 4, A_HD = 64, WINDOW = 128;
constexpr int D_FF = 2816, N_EXP = 8, D_FF_EXP = 3584;
constexpr float ALPHA = 1.681792830507429f;
constexpr float LN_EPS = 1e-5f;
constexpr int RP = 265 * 256;
constexpr int NSEG = 8, SEG_CHUNKS = 16;
constexpr int ST_FLOATS = 8 * 5 * 64 * 4;

constexpr size_t MiB = 1u << 20;
constexpr size_t al(size_t x) { return (x + 4095) & ~(size_t)4095; }
constexpr size_t WS_CTL = 0, CTL_BYTES = 1 * MiB;
constexpr size_t WS_WIN = WS_CTL + CTL_BYTES;
constexpr size_t WS_WOUT = WS_WIN + al((size_t)2 * M_INP * D * 2);
constexpr size_t WS_WQKV = WS_WOUT + al((size_t)2 * D * D * 2);
constexpr size_t WS_WQ3 = WS_WQKV + al((size_t)1536 * D * 2);
constexpr size_t WS_WO = WS_WQ3 + al((size_t)D * D * 2);
constexpr size_t WS_WGU = WS_WO + al((size_t)2 * D * D * 2);
constexpr size_t WS_WDN = WS_WGU + al((size_t)2 * 2 * D_FF * D * 2);
constexpr size_t WS_WGUE = WS_WDN + al((size_t)2 * D * D_FF * 2);
constexpr size_t WS_WDNE = WS_WGUE + al((size_t)16 * 2 * D_FF_EXP * D * 2);
constexpr size_t WS_H = WS_WDNE + al((size_t)16 * D * D_FF_EXP * 2);
constexpr size_t WS_HB = WS_H + al((size_t)MP * D * 4);
constexpr size_t WS_PROJ = WS_HB + al((size_t)MP * D * 2);
constexpr size_t WS_HG = WS_PROJ + (size_t)MP * PROJ_LD * 2;
constexpr size_t WS_CONTRIB = WS_PROJ;
constexpr size_t WS_KB = WS_HG + al((size_t)MP * D * 2);
constexpr size_t WS_VB = WS_KB + al((size_t)MP * 256 * 2);
constexpr size_t WS_GATES = WS_VB + al((size_t)MP * 256 * 2);
constexpr size_t WS_ACT = WS_GATES + al((size_t)MP * 16 * 4);
constexpr size_t WS_STATE = WS_ACT + al((size_t)RP * D_FF_EXP * 2);
constexpr size_t WS_STSC = WS_STATE + al((size_t)32 * 7 * ST_FLOATS * 4);
constexpr size_t WS_ROPE = WS_STSC + al((size_t)32 * 7 * 4 * 4);
constexpr size_t WS_TOPE = WS_ROPE + al((size_t)8208 * 16 * 4);
constexpr size_t WS_TOPG = WS_TOPE + al((size_t)MP * 4);
constexpr size_t WS_ROWTOK = WS_TOPG + al((size_t)MP * 8);
constexpr size_t WS_ROWDST = WS_ROWTOK + al((size_t)RP * 4);
constexpr size_t WS_ROWGATE = WS_ROWDST + al((size_t)RP * 4);
constexpr size_t WS_HB8 = WS_ROWGATE + al((size_t)RP * 4);
constexpr size_t WS_WGUE8 = WS_HB8 + al((size_t)MP * D);
constexpr size_t WS_WDNE8 = WS_WGUE8 + al((size_t)16 * 2 * D_FF_EXP * D);
constexpr size_t WS_WDN8 = WS_WDNE8 + al((size_t)16 * D * D_FF_EXP);
constexpr size_t WS_WGU8 = WS_WDN8 + al((size_t)2 * D * D_FF);
constexpr size_t WS_ROWSC = WS_WGU8 + al((size_t)2 * 2 * D_FF * D);
constexpr size_t WS_WO8 = WS_ROWSC + al((size_t)MP * 4);
constexpr size_t WS_WQKV8 = WS_WO8 + al((size_t)2 * D * D);
constexpr size_t WS_WIN8 = WS_WQKV8 + al((size_t)2560 * D);
constexpr size_t WS_STATS = WS_WIN8 + al((size_t)2 * 3072 * D);
constexpr size_t WS_SMALL = WS_STATS + al((size_t)MP * 8);
constexpr int SM_BGATE = 0, SM_SINKS = 32, SM_BROUTER = 64, SM_LNH = 128, SM_LNG = SM_LNH + 2 * D, SM_LNB = SM_LNG + 8 * D, SM_WROUTER = SM_LNB + 8 * D, SM_WSCALE = SM_WROUTER + 2 * D * N_EXP, SM_ASCALE = SM_WSCALE + 24, SM_END = SM_WSCALE + 32;
constexpr size_t WS_END = WS_SMALL + al((size_t)SM_END * 4);
static_assert((size_t)MP * 2 * D * 4 <= (WS_KB - WS_PROJ), "contrib overlay fits PROJ+HG");
static_assert(WS_END <= (size_t)1792 * MiB, "workspace map exceeds the guaranteed d_ws size");

constexpr int CW_CNT = 1024;
constexpr int CW_CUR = 1024 + 256;
constexpr int CW_AMAX = 2560;
constexpr int CW_ITEM = 3072;
constexpr int CW_CNTG = 4096;
constexpr int CW_BAR = 16384;

constexpr int LDS_BYTES = 163840 - 512;
constexpr int RING_BYTES = 131072;
constexpr int MISC_OFF = LDS_BYTES - 256;

__device__ __forceinline__ unsigned f2bf(float f) { unsigned u = __builtin_bit_cast(unsigned, f); return (u + 0x7fffu + ((u >> 16) & 1u)) >> 16; }
__device__ __forceinline__ unsigned pk2(float lo, float hi) { return f2bf(lo) | (f2bf(hi) << 16); }
__device__ __forceinline__ unsigned cvt_pk_bf16(float lo, float hi) { unsigned r; asm volatile("v_cvt_pk_bf16_f32 %0, %1, %2" : "=v"(r) : "v"(lo), "v"(hi)); return r; }
__device__ __forceinline__ float bf2f(unsigned short b) { return __builtin_bit_cast(float, ((unsigned)b) << 16); }
__device__ __forceinline__ float lx_(float v, int src) { return __builtin_bit_cast(float, __builtin_amdgcn_ds_bpermute(src << 2, __builtin_bit_cast(int, v))); }
__device__ __forceinline__ unsigned lx_(unsigned v, int src) { return (unsigned)__builtin_amdgcn_ds_bpermute(src << 2, (int)v); }
#define SHX(v, o) lx_((v), lane ^ (o))
#define SHUP(v, o) lx_((v), lane >= (o) ? lane - (o) : lane)
#define SHL(v, src) lx_((v), (src))
__device__ __forceinline__ float wave_sum(float v, int lane) {
#pragma unroll
    for (int o = 1; o < 64; o <<= 1) v += SHX(v, o);
    return v;
}
__device__ __forceinline__ float fast_exp(float x) { return __builtin_amdgcn_exp2f(x * 1.4426950408889634f); }
__device__ __forceinline__ unsigned pk4_fp8(float a, float b, float c, float d) {
    a = __builtin_amdgcn_fmed3f(a, -448.f, 448.f); b = __builtin_amdgcn_fmed3f(b, -448.f, 448.f); c = __builtin_amdgcn_fmed3f(c, -448.f, 448.f); d = __builtin_amdgcn_fmed3f(d, -448.f, 448.f);
    int p = __builtin_amdgcn_cvt_pk_fp8_f32(a, b, 0, false); p = __builtin_amdgcn_cvt_pk_fp8_f32(c, d, p, true); return (unsigned)p; }
constexpr float F8_SA = 16.f, F8_SB = 256.f, F8_INV = 1.f / (16.f * 256.f);
constexpr float F8_SACT = 8.f, F8_SBD = 1024.f, F8_INVD = 1.f / (8.f * 1024.f);
constexpr float F8_SO = 32.f, F8_SWO = 512.f, F8_INVO = 1.f / (32.f * 512.f);
#define LDS_WAIT() asm volatile("s_waitcnt lgkmcnt(0)" ::: "memory")
#define VM_WAIT() asm volatile("s_waitcnt vmcnt(0)" ::: "memory")

#define XB_TMO      128
#define XB_XCNT(j)  (256  + 64 * (j))
#define XB_XSUB(j)  (1280 + 64 * (j))
#define XB_XGEN(j)  (2304 + 64 * (j))
#define XB_TOP      3328
#define XB_TOPGEN   3392
#define XCD_BAR_WORDS 3456
#define XB_SPIN_CAP (1u << 18)
__device__ __forceinline__ unsigned xb_ld(unsigned* p)              { return __hip_atomic_load(p, __ATOMIC_RELAXED, __HIP_MEMORY_SCOPE_AGENT); }
__device__ __forceinline__ unsigned xb_add(unsigned* p, unsigned v) { return __hip_atomic_fetch_add(p, v, __ATOMIC_RELAXED, __HIP_MEMORY_SCOPE_AGENT); }
__device__ __forceinline__ unsigned xb_xcc_id() { return (unsigned)__builtin_amdgcn_s_getreg((3 << 11) | 20) & 0xFu; }
#define XB_SPIN(cond, bar) do { unsigned _sp = 0; while (cond) { __builtin_amdgcn_s_sleep(1); \
    if ((++_sp & 255u) == 0u) { if (xb_ld(&(bar)[XB_TMO])) break; if (_sp > XB_SPIN_CAP) { atomicAdd(&(bar)[XB_TMO], 1u); break; } } } } while (0)
struct XcdBarrier { unsigned* bar; unsigned x; volatile LAS unsigned* st; };
__device__ __forceinline__ XcdBarrier xcd_barrier_post(unsigned* bar, volatile LAS unsigned* st) {
    XcdBarrier b; b.bar = bar; b.x = xb_xcc_id(); b.st = st;
    if (threadIdx.x == 0) (void)xb_add(&bar[XB_XCNT(b.x)], 1u);
    return b;
}
__device__ __forceinline__ void xcd_barrier_complete(unsigned* bar, unsigned x, unsigned& nloc, unsigned& nx) {
    const unsigned G = gridDim.x * gridDim.y * gridDim.z;
    unsigned sum, cnt, mine, sp = 0u;
    for (;;) {
        sum = 0u; cnt = 0u; mine = 0u;
#pragma unroll
        for (unsigned j = 0; j < 16; ++j) { const unsigned c = xb_ld(&bar[XB_XCNT(j)]); sum += c; cnt += (c > 0u) ? 1u : 0u; mine = (j == x) ? c : mine; }
        if (sum == G) break;
        __builtin_amdgcn_s_sleep(1);
        if ((++sp & 255u) == 0u) { if (xb_ld(&bar[XB_TMO])) break; if (sp > XB_SPIN_CAP) { atomicAdd(&bar[XB_TMO], 1u); break; } }
    }
    nloc = mine > 0u ? mine : 1u; nx = cnt > 0u ? cnt : 1u;
}
__device__ __forceinline__ void xcd_barrier(const XcdBarrier& b, bool leader  ) {
    asm volatile("s_waitcnt vmcnt(0)" ::: "memory");
    __syncthreads();
    if (leader) {
        unsigned* bar = b.bar;
        __builtin_amdgcn_s_waitcnt(0);
        unsigned nloc = b.st[0], nx = b.st[1];
        if (nloc == 0u) { xcd_barrier_complete(bar, b.x, nloc, nx); b.st[0] = nloc; b.st[1] = nx; }
        const unsigned old = xb_add(&bar[XB_XSUB(b.x)], 1u);
        const unsigned gen = old / nloc;
        if (old + 1u == (gen + 1u) * nloc) {
            __builtin_amdgcn_fence(__ATOMIC_RELEASE, "agent");
            asm volatile("s_waitcnt vmcnt(0)" ::: "memory");
            const unsigned og = xb_add(&bar[XB_TOP], 1u);
            const unsigned tg = og / nx;
            if (og + 1u == (tg + 1u) * nx) xb_add(&bar[XB_TOPGEN], 1u);
            else XB_SPIN(xb_ld(&bar[XB_TOPGEN]) == tg, bar);
            __builtin_amdgcn_fence(__ATOMIC_ACQUIRE, "agent");
            xb_add(&bar[XB_XGEN(b.x)], 1u);
            asm volatile("s_waitcnt vmcnt(0)" ::: "memory");
        } else {
            XB_SPIN(xb_ld(&bar[XB_XGEN(b.x)]) == gen, bar);
            __builtin_amdgcn_fence(__ATOMIC_ACQUIRE, "agent");
            asm volatile("s_waitcnt vmcnt(0)" ::: "memory");
        }
    }
    __syncthreads();
}

namespace pg8 {
constexpr int BM = 256, BK = 64, HALF = 128, HTB = HALF * BK * 2, STAGE_BYTES = 8 * HTB, NXCD = 8, WGM = 8;
__host__ __device__ __forceinline__ int lds_byte(int r, int c) { const int st = (r >> 4) * 2 + (c >> 5), rr = r & 15, cc = c & 31, ob = rr * 64 + cc * 2; return st * 1024 + (ob ^ (((ob >> 9) & 1) << 5)); }
__host__ __device__ __forceinline__ void stage_rc(int b, int& R, int& C) { const int st = b / 1024, sb = b % 1024, swz = sb ^ (((sb >> 9) & 1) << 5); R = (st >> 1) * 16 + swz / 64; C = (st & 1) * 32 + (swz % 64) / 2; }
__host__ __device__ __forceinline__ int perm32(int rho) { const int n = rho >> 4, i = rho & 15; return 8 * (i >> 2) + 4 * n + (i & 3); }

struct Unit { int pm, pn, brow; };

struct DenseOrder {
    int nM, nN, nwg, G, c;
    __device__ void init(int nM_, int nN_, int G_, int c_) { nM = nM_; nN = nN_; nwg = nM * nN; G = G_; c = c_; }
    __device__ __forceinline__ bool next(int i, Unit& u) const {
        const long L = (long)i * G + c; if (L >= nwg) return false;
        int wgid = (int)L; { const int q = nwg / NXCD, r = nwg % NXCD, xcd = wgid % NXCD, off = wgid / NXCD; wgid = (xcd < r ? xcd * (q + 1) : r * (q + 1) + (xcd - r) * q) + off; }
        const int nig = WGM * nN, gid = wgid / nig, fm = gid * WGM, gsz = (nM - fm) < WGM ? (nM - fm) : WGM;
        u.pm = fm + ((wgid % nig) % gsz); u.pn = (wgid % nig) / gsz; u.brow = u.pn * BM; return true;
    }
    __device__ __forceinline__ int a_row(const Unit& u, int r) const { return u.pm * BM + r; }
};
struct GroupedOrder {
    DenseOrder o; int pstart[9]; int nexp_rows;
    const int* rowtok;
    __device__ __forceinline__ bool next(int i, Unit& u) const {
        if (!o.next(i, u)) return false;
        int e = 0;
#pragma unroll
        for (int k = 1; k < 8; ++k) e += (u.pm >= pstart[k]) ? 1 : 0;
        u.brow = e * nexp_rows + u.pn * BM; return true;
    }
    __device__ __forceinline__ int a_row(const Unit& u, int r) const {
        const int pos = u.pm * BM + r; if (!rowtok) return pos;
        const int t = rowtok[pos]; return t < 0 ? 0 : t;
    }
};

template <class Epi, class Sched, int MODE = 0>
__device__ __forceinline__ void gemm_phase(LAS unsigned char* lds, const void* Abase, const void* Btbase, const int K, const Sched& S, const Epi& E, int tid) {
    constexpr int ES = MODE ? 1 : 2;
    constexpr bool FP8 = (MODE == 1);
    asm volatile("; opaque tid" : "+v"(tid));
    const int wid = __builtin_amdgcn_readfirstlane(tid >> 6), lane = tid & 63, wr = wid >> 2, wc = wid & 3, fr = lane & 15, fq = lane >> 4;
    const int nt = K * ES / 128;
    unsigned voffB[2];
#pragma unroll
    for (int i = 0; i < 2; ++i) { int R, C; stage_rc(tid * 16 + i * 8192, R, C); const int Rb = Epi::PERM ? ((R & ~31) + perm32(R & 31)) : R; voffB[i] = (unsigned)(Rb * K * ES + C * 2); }
    const size_t kstep = (size_t)128;
    const size_t hstep = (size_t)HALF * K * ES;
    const unsigned ldsw = (unsigned)wid * 1024u;
    const int aoff = FP8 ? lds_byte(wr * 64 + fr, 16 * (fq & 1)) + (fq >> 1) * 1024 : lds_byte(wr * 64 + fr, fq * 8);
    const int boff = FP8 ? lds_byte(wc * 32 + fr, 16 * (fq & 1)) + (fq >> 1) * 1024 : lds_byte(wc * 32 + fr, fq * 8);
#define PG8_SA(b, h) (((b) * 2 + (h)) * HTB)
#define PG8_SB(b, h) ((4 + (b) * 2 + (h)) * HTB)
#define PG8_STAGE(bufoff, gbase, voff) do { const char* _gb = (const char*)(gbase); asm volatile("" : "+s"(_gb)); _Pragma("unroll") for (int _i = 0; _i < 2; ++_i) \
        __builtin_amdgcn_global_load_lds((const unsigned*)(_gb + (voff)[_i]), (LAS unsigned*)(lds + (bufoff) + ldsw + _i * 8192), 16, 0, 0); } while (0)
#define PG8_LDA(dst, b, h) do { _Pragma("unroll") for (int m = 0; m < 4; ++m) _Pragma("unroll") for (int k = 0; k < 2; ++k) dst[m][k] = *(const LAS bf16x8*)(lds + PG8_SA(b, h) + aoff + m * 2048 + k * (FP8 ? 16 : 1024)); } while (0)
#define PG8_LDB(dst, b, h) do { _Pragma("unroll") for (int n = 0; n < 2; ++n) _Pragma("unroll") for (int k = 0; k < 2; ++k) dst[n][k] = *(const LAS bf16x8*)(lds + PG8_SB(b, h) + boff + n * 2048 + k * (FP8 ? 16 : 1024)); } while (0)
#define PG8_MMA(ai, bj, At, Bt) do { __builtin_amdgcn_s_setprio(1); _Pragma("unroll") for (int m = 0; m < 4; ++m) _Pragma("unroll") for (int n = 0; n < 2; ++n) { \
        if constexpr (FP8) { const u32x4 _b0 = __builtin_bit_cast(u32x4, Bt[n][0]), _b1 = __builtin_bit_cast(u32x4, Bt[n][1]), _a0 = __builtin_bit_cast(u32x4, At[m][0]), _a1 = __builtin_bit_cast(u32x4, At[m][1]); \
            const i32x8 _bv = {(int)_b0.x, (int)_b0.y, (int)_b0.z, (int)_b0.w, (int)_b1.x, (int)_b1.y, (int)_b1.z, (int)_b1.w}, _av = {(int)_a0.x, (int)_a0.y, (int)_a0.z, (int)_a0.w, (int)_a1.x, (int)_a1.y, (int)_a1.z, (int)_a1.w}; \
            acc[ai][bj][m][n] = __builtin_amdgcn_mfma_scale_f32_16x16x128_f8f6f4(_bv, _av, acc[ai][bj][m][n], 0, 0, 0, 0x7F7F7F7F, 0, 0x7F7F7F7F); } \
        else if constexpr (MODE == 2) { _Pragma("unroll") for (int k = 0; k < 2; ++k) acc[ai][bj][m][n] = __builtin_bit_cast(f32x4, __builtin_amdgcn_mfma_i32_16x16x64_i8(__builtin_bit_cast(i32x4, Bt[n][k]), __builtin_bit_cast(i32x4, At[m][k]), __builtin_bit_cast(i32x4, acc[ai][bj][m][n]), 0, 0, 0)); } \
        else { _Pragma("unroll") for (int k = 0; k < 2; ++k) acc[ai][bj][m][n] = __builtin_amdgcn_mfma_f32_16x16x32_bf16(Bt[n][k], At[m][k], acc[ai][bj][m][n], 0, 0, 0); } } \
        __builtin_amdgcn_s_setprio(0); } while (0)
#define PG8_WAIT_V(n) asm volatile("s_waitcnt vmcnt(" #n ")" ::: "memory")
#define PG8_WAIT_L(n) asm volatile("s_waitcnt lgkmcnt(" #n ")" ::: "memory")
#define PG8_BAR __builtin_amdgcn_s_barrier()
#define PG8_SCHED __builtin_amdgcn_sched_barrier(0)
#define PG8_AOFF(dst, u) do { _Pragma("unroll") for (int _i = 0; _i < 2; ++_i) { int _R, _C; stage_rc(tid * 16 + _i * 8192, _R, _C); _Pragma("unroll") for (int _h = 0; _h < 2; ++_h) \
        dst[_h][_i] = (unsigned)((size_t)S.a_row(u, _h * HALF + _R) * K * ES + _C * 2); } } while (0)
    Unit cur, nxt; int ui = 0;
    if (!S.next(0, cur)) return;
    f32x4 acc[2][2][4][2];
#pragma unroll
    for (int a = 0; a < 2; ++a)
#pragma unroll
        for (int b = 0; b < 2; ++b)
#pragma unroll
            for (int m = 0; m < 4; ++m)
#pragma unroll
                for (int n = 0; n < 2; ++n) acc[a][b][m][n] = (f32x4){0.f, 0.f, 0.f, 0.f};
    bf16x8 At[4][2], B0[2][2], B1[2][2];
    unsigned cao[2][2];
    PG8_AOFF(cao, cur);
    const char* cA = (const char*)Abase; const char* cB = (const char*)Btbase + (size_t)cur.brow * K * ES;
    PG8_STAGE(PG8_SB(0, 0), cB, voffB); PG8_STAGE(PG8_SB(0, 1), cB + hstep, voffB); PG8_STAGE(PG8_SA(0, 0), cA, cao[0]); PG8_STAGE(PG8_SA(0, 1), cA, cao[1]);
    if (wr == 1) PG8_BAR;
    PG8_WAIT_V(2); PG8_BAR;
    PG8_STAGE(PG8_SB(1, 0), cB + kstep, voffB); PG8_STAGE(PG8_SA(1, 0), cA + kstep, cao[0]); PG8_STAGE(PG8_SB(1, 1), cB + hstep + kstep, voffB);
    PG8_WAIT_V(6); PG8_BAR;
    for (;;) {
        const bool has_next = S.next(ui + 1, nxt);
        const char* nB = has_next ? (const char*)Btbase + (size_t)nxt.brow * K * ES : cB;
        for (int t = 0; t < nt; t += 2) {
            const bool last = (t == nt - 2);
            const char* a1 = cA + (size_t)(t + 1) * kstep;
            const char* a2 = last ? cA : cA + (size_t)(t + 2) * kstep; const char* b2 = last ? nB : cB + (size_t)(t + 2) * kstep;
            const char* a3 = a2 + kstep; const char* b3 = b2 + kstep;
            PG8_LDB(B0, 0, 0); PG8_LDB(B1, 0, 1); PG8_SCHED; PG8_LDA(At, 0, 0); PG8_STAGE(PG8_SA(1, 1), a1, cao[1]);
            if (last && has_next) { PG8_AOFF(cao, nxt); }
            PG8_WAIT_V(8); PG8_WAIT_L(0); PG8_BAR; PG8_MMA(0, 0, At, B0); PG8_MMA(0, 1, At, B1); PG8_BAR; PG8_SCHED;
            PG8_LDA(At, 0, 1); PG8_STAGE(PG8_SB(0, 0), b2, voffB); PG8_STAGE(PG8_SB(0, 1), b2 + hstep, voffB); PG8_STAGE(PG8_SA(0, 0), a2, cao[0]);
            PG8_WAIT_V(8); PG8_WAIT_L(0); PG8_BAR; PG8_MMA(1, 0, At, B0); PG8_MMA(1, 1, At, B1); PG8_BAR; PG8_SCHED;
            PG8_LDB(B0, 1, 0); PG8_LDB(B1, 1, 1); PG8_SCHED; PG8_LDA(At, 1, 0); PG8_STAGE(PG8_SA(0, 1), a2, cao[1]);
            PG8_WAIT_V(8); PG8_WAIT_L(0); PG8_BAR; PG8_MMA(0, 0, At, B0); PG8_MMA(0, 1, At, B1); PG8_BAR; PG8_SCHED;
            PG8_LDA(At, 1, 1); PG8_STAGE(PG8_SB(1, 0), b3, voffB); PG8_STAGE(PG8_SB(1, 1), b3 + hstep, voffB); PG8_STAGE(PG8_SA(1, 0), a3, cao[0]);
            PG8_WAIT_V(8); PG8_WAIT_L(0); PG8_BAR; PG8_MMA(1, 0, At, B0); PG8_MMA(1, 1, At, B1); PG8_BAR; PG8_SCHED;
        }
        if (wr == 0) PG8_BAR;
        if constexpr (MODE == 2) {
#pragma unroll
            for (int a = 0; a < 2; ++a)
#pragma unroll
                for (int b = 0; b < 2; ++b)
#pragma unroll
                    for (int m = 0; m < 4; ++m)
#pragma unroll
                        for (int n = 0; n < 2; ++n) { const i32x4 iv = __builtin_bit_cast(i32x4, acc[a][b][m][n]); acc[a][b][m][n] = (f32x4){(float)iv[0], (float)iv[1], (float)iv[2], (float)iv[3]}; } }
#pragma unroll 1
        for (int er = 0; er < Epi::NREP; ++er) E(acc, cur, wr, wc, fr, fq);
        if (!has_next) break;
#pragma unroll
        for (int a = 0; a < 2; ++a)
#pragma unroll
            for (int b = 0; b < 2; ++b)
#pragma unroll
                for (int m = 0; m < 4; ++m)
#pragma unroll
                    for (int n = 0; n < 2; ++n) acc[a][b][m][n] = (f32x4){0.f, 0.f, 0.f, 0.f};
        cur = nxt; cB = nB; ++ui;
        if (wr == 1) PG8_BAR;
    }
    PG8_WAIT_V(0);
    PG8_BAR;
#undef PG8_SA
#undef PG8_SB
#undef PG8_STAGE
#undef PG8_LDA
#undef PG8_LDB
#undef PG8_MMA
#undef PG8_WAIT_V
#undef PG8_WAIT_L
#undef PG8_BAR
#undef PG8_SCHED
#undef PG8_AOFF
}
}

typedef f32x4 AccT[2][2][4][2];

struct EpiProj {
    static constexpr int NREP = 1; static constexpr bool PERM = true;
    bf16_t* proj; float* gates; const float* bgate; float sc;
    __device__ __forceinline__ void operator()(const AccT& acc, const pg8::Unit& u, int wr, int wc, int fr, int fq) const {
        const int row0 = u.pm * 256 + wr * 64 + fr; const float scu = u.pn < 2 ? sc * 0.125f : sc;
        if (u.pn < 12) {
            const int col0 = u.pn * 256 + wc * 32 + 8 * fq;
#pragma unroll
            for (int ai = 0; ai < 2; ++ai)
#pragma unroll
                for (int m = 0; m < 4; ++m) { bf16_t* rowp = proj + (size_t)(row0 + ai * 128 + m * 16) * PROJ_LD + col0;
#pragma unroll
                    for (int bj = 0; bj < 2; ++bj) { const f32x4 v0 = acc[ai][bj][m][0] * scu, v1 = acc[ai][bj][m][1] * scu;
                        u32x4 w; w.x = cvt_pk_bf16(v0[0], v0[1]); w.y = cvt_pk_bf16(v0[2], v0[3]); w.z = cvt_pk_bf16(v1[0], v1[1]); w.w = cvt_pk_bf16(v1[2], v1[3]);
                        *(u32x4*)(rowp + bj * 128) = w; } }
        } else if (wc == 0 && fq < 2) {
#pragma unroll
            for (int n = 0; n < 2; ++n) { const f32x4 bv = *(const f32x4*)(bgate + 8 * fq + 4 * n);
#pragma unroll
                for (int ai = 0; ai < 2; ++ai)
#pragma unroll
                    for (int m = 0; m < 4; ++m) *(f32x4*)(gates + (size_t)(row0 + ai * 128 + m * 16) * 16 + 8 * fq + 4 * n) = acc[ai][0][m][n] + bv; }
        }
    }
};
__device__ __forceinline__ f32x4 bf4_lo(u32x4 w) { return (f32x4){__builtin_bit_cast(float, w.x << 16), __builtin_bit_cast(float, w.x & 0xffff0000u), __builtin_bit_cast(float, w.y << 16), __builtin_bit_cast(float, w.y & 0xffff0000u)}; }
__device__ __forceinline__ f32x4 bf4_hi(u32x4 w) { return (f32x4){__builtin_bit_cast(float, w.z << 16), __builtin_bit_cast(float, w.z & 0xffff0000u), __builtin_bit_cast(float, w.w << 16), __builtin_bit_cast(float, w.w & 0xffff0000u)}; }
struct EpiRes {
    static constexpr int NREP = 1; static constexpr bool PERM = true;
    bf16_t* H; const float* stats; const float* lg; const float* lb; const float* xsrc; float sc;
    __device__ __forceinline__ void operator()(const AccT& acc, const pg8::Unit& u, int wr, int wc, int fr, int fq) const {
        const int row0 = u.pm * 256 + wr * 64 + fr, col0 = u.pn * 256 + wc * 32 + 8 * fq;
        f32x4 gv[2][2], bv[2][2];
        if (lg) {
#pragma unroll
            for (int bj = 0; bj < 2; ++bj)
#pragma unroll
                for (int n = 0; n < 2; ++n) { gv[bj][n] = *(const f32x4*)(lg + col0 + bj * 128 + n * 4); bv[bj][n] = *(const f32x4*)(lb + col0 + bj * 128 + n * 4); } }
#pragma unroll
        for (int ai = 0; ai < 2; ++ai)
#pragma unroll
            for (int m = 0; m < 4; ++m) { const int row = row0 + ai * 128 + m * 16; bf16_t* rowp = H + (size_t)row * D + col0;
                f32x2 st = (f32x2){0.f, 1.f}; if (lg) st = *(const f32x2*)(stats + 2 * (size_t)row);
#pragma unroll
                for (int bj = 0; bj < 2; ++bj) { f32x4 h0, h1;
                    if (lg) { const u32x4 w = *(const u32x4*)(rowp + bj * 128); h0 = (bf4_lo(w) - st.x) * st.y * gv[bj][0] + bv[bj][0]; h1 = (bf4_hi(w) - st.x) * st.y * gv[bj][1] + bv[bj][1]; }
                    else { const float* xp = xsrc + (size_t)row * D + col0 + bj * 128; h0 = *(const f32x4*)xp; h1 = *(const f32x4*)(xp + 4); }
                    const f32x4 o0 = h0 * ALPHA + acc[ai][bj][m][0] * sc, o1 = h1 * ALPHA + acc[ai][bj][m][1] * sc;
                    u32x4 w; w.x = cvt_pk_bf16(o0[0], o0[1]); w.y = cvt_pk_bf16(o0[2], o0[3]); w.z = cvt_pk_bf16(o1[0], o1[1]); w.w = cvt_pk_bf16(o1[2], o1[3]);
                    *(u32x4*)(rowp + bj * 128) = w; } }
    }
};
struct EpiSwiglu {
    static constexpr int NREP = 1; static constexpr bool PERM = true;
    bf16_t* act; int ld; float sc;
    __device__ __forceinline__ static float silu_mul(float g, float u) { return g * u * __builtin_amdgcn_rcpf(1.0f + __builtin_amdgcn_exp2f(-g * 1.4426950408889634f)); }
    __device__ __forceinline__ void operator()(const AccT& acc, const pg8::Unit& u, int wr, int wc, int fr, int fq) const {
        const int row0 = u.pm * 256 + wr * 64 + fr, col0 = u.pn * 128 + wc * 32 + 8 * fq;
#pragma unroll
        for (int ai = 0; ai < 2; ++ai)
#pragma unroll
            for (int m = 0; m < 4; ++m) { const f32x4 g0 = acc[ai][0][m][0] * sc, g1 = acc[ai][0][m][1] * sc, u0 = acc[ai][1][m][0] * sc, u1 = acc[ai][1][m][1] * sc;
                u32x4 w; w.x = cvt_pk_bf16(silu_mul(g0[0], u0[0]), silu_mul(g0[1], u0[1])); w.y = cvt_pk_bf16(silu_mul(g0[2], u0[2]), silu_mul(g0[3], u0[3]));
                w.z = cvt_pk_bf16(silu_mul(g1[0], u1[0]), silu_mul(g1[1], u1[1])); w.w = cvt_pk_bf16(silu_mul(g1[2], u1[2]), silu_mul(g1[3], u1[3]));
                *(u32x4*)(act + (size_t)(row0 + ai * 128 + m * 16) * ld + col0) = w; }
    }
};
struct EpiSwiglu8 {
    static constexpr int NREP = 1; static constexpr bool PERM = true;
    unsigned char* act; int ld; float sc;
    const float* wscale; int wdiv;
    __device__ __forceinline__ void operator()(const AccT& acc, const pg8::Unit& u, int wr, int wc, int fr, int fq) const {
        const int row0 = u.pm * 256 + wr * 64 + fr, col0 = u.pn * 128 + wc * 32 + 8 * fq;
        const float rs = wscale ? sc * wscale[wdiv ? u.brow / wdiv : 0] : sc;
        const float c1 = -rs * 1.4426950408889634f, c2 = rs * rs * F8_SACT, l2 = -__builtin_amdgcn_logf(c2), ic2 = __builtin_amdgcn_rcpf(c2);
#pragma unroll
        for (int ai = 0; ai < 2; ++ai)
#pragma unroll
            for (int m = 0; m < 4; ++m) { float o[8];
#pragma unroll
                for (int n = 0; n < 2; ++n)
#pragma unroll
                    for (int j = 0; j < 4; ++j) { const float g = acc[ai][0][m][n][j], up = acc[ai][1][m][n][j];
                        o[4 * n + j] = (g * up) * __builtin_amdgcn_rcpf(__builtin_amdgcn_exp2f(__builtin_fmaf(g, c1, l2)) + ic2); }
                u32x2 w; int p = __builtin_amdgcn_cvt_pk_fp8_f32(o[0], o[1], 0, false); p = __builtin_amdgcn_cvt_pk_fp8_f32(o[2], o[3], p, true); w.x = (unsigned)p;
                p = __builtin_amdgcn_cvt_pk_fp8_f32(o[4], o[5], 0, false); p = __builtin_amdgcn_cvt_pk_fp8_f32(o[6], o[7], p, true); w.y = (unsigned)p;
                *(u32x2*)(act + (size_t)(row0 + ai * 128 + m * 16) * ld + col0) = w; }
    }
};
struct EpiSwigluProbe : EpiSwiglu { static constexpr int NREP = 2; };
struct EpiScatter {
    static constexpr int NREP = 1; static constexpr bool PERM = true;
    bf16_t* contrib; const int* rowdst; const float* rowgate; float sc;
    __device__ __forceinline__ void operator()(const AccT& acc, const pg8::Unit& u, int wr, int wc, int fr, int fq) const {
        const int row0 = u.pm * 256 + wr * 64 + fr, col0 = u.pn * 256 + wc * 32 + 8 * fq;
        int dd[8]; float gg[8];
#pragma unroll
        for (int k = 0; k < 8; ++k) { const int pos = row0 + (k >> 2) * 128 + (k & 3) * 16; dd[k] = rowdst[pos]; gg[k] = rowgate[pos]; }
#pragma unroll
        for (int ai = 0; ai < 2; ++ai)
#pragma unroll
            for (int m = 0; m < 4; ++m) { const int d = dd[ai * 4 + m];
                if (d >= 0) { const float g = gg[ai * 4 + m] * sc; bf16_t* rowp = contrib + (size_t)d * D + col0;
#pragma unroll
                    for (int bj = 0; bj < 2; ++bj) { const f32x4 v0 = acc[ai][bj][m][0] * g, v1 = acc[ai][bj][m][1] * g;
                        u32x4 w; w.x = cvt_pk_bf16(v0[0], v0[1]); w.y = cvt_pk_bf16(v0[2], v0[3]); w.z = cvt_pk_bf16(v1[0], v1[1]); w.w = cvt_pk_bf16(v1[2], v1[3]);
                        *(u32x4*)(rowp + bj * 128) = w; } } }
    }
};
struct EpiQKV {
    static constexpr int NREP = 1; static constexpr bool PERM = true;
    bf16_t *Q, *KB, *VB; const float* rope; float sq, skv; LAS unsigned char* tlds;
    __device__ __forceinline__ void operator()(const AccT& acc, const pg8::Unit& u, int wr, int wc, int fr, int fq) const {
        const int row0 = u.pm * 256 + wr * 64 + fr, cl = wc * 32 + 8 * fq, lane = fr | (fq << 4);
        bf16_t* base; int ld;
        if (u.pn == 5) {
            LAS unsigned char* tp = tlds + (wr * 4 + wc) * 2560;
#pragma unroll
            for (int ai = 0; ai < 2; ++ai)
#pragma unroll
                for (int mp = 0; mp < 2; ++mp)
#pragma unroll
                    for (int bj = 0; bj < 2; ++bj) {
#pragma unroll
                        for (int mm = 0; mm < 2; ++mm)
#pragma unroll
                            for (int n = 0; n < 2; ++n)
#pragma unroll
                                for (int j = 0; j < 4; ++j) *(LAS unsigned short*)(tp + (8 * fq + 4 * n + j) * 80 + (mm * 16 + fr) * 2) = (unsigned short)f2bf(acc[ai][bj][2 * mp + mm][n][j] * skv);
                        asm volatile("s_waitcnt lgkmcnt(0)" ::: "memory");
                        const int c = lane & 31, h = lane >> 5;
                        const u32x4 r0 = *(const LAS u32x4*)(tp + c * 80 + h * 32), r1 = *(const LAS u32x4*)(tp + c * 80 + h * 32 + 16);
                        bf16_t* dst = VB + (size_t)(bj * 128 + wc * 32 + c) * MP + (u.pm * 256 + ai * 128 + wr * 64 + mp * 32 + h * 16);
                        *(u32x4*)dst = r0; *(u32x4*)(dst + 8) = r1;
                        asm volatile("s_waitcnt lgkmcnt(0)" ::: "memory"); }
            return; }
        if (u.pn < 4) { base = Q + u.pn * 256 + cl; ld = D; } else { base = KB + cl; ld = 256; }
        const bool dorope = (u.pn <= 4) && ((wc & 1) == 0);
        { const char* src = (const char*)(rope + (size_t)(((u.pm * 256) & (SEQ - 1)) + NMETA) * 16) + (wr * 4 + wc) * 2048 + lane * 16;
          __builtin_amdgcn_global_load_lds((const unsigned*)src, (LAS unsigned*)(tlds + (wr * 4 + wc) * 2048), 16, 0, 0);
          __builtin_amdgcn_global_load_lds((const unsigned*)(src + 1024), (LAS unsigned*)(tlds + (wr * 4 + wc) * 2048 + 1024), 16, 0, 0);
          asm volatile("s_waitcnt vmcnt(0)" ::: "memory"); __builtin_amdgcn_s_barrier(); asm volatile("" ::: "memory"); }
#pragma unroll
        for (int ai = 0; ai < 2; ++ai)
#pragma unroll
            for (int m = 0; m < 4; ++m) { const int row = row0 + ai * 128 + m * 16;
                f32x4 v[2][2];
#pragma unroll
                for (int bj = 0; bj < 2; ++bj)
#pragma unroll
                    for (int n = 0; n < 2; ++n) v[bj][n] = acc[ai][bj][m][n] * (u.pn < 4 ? sq : skv);
                if (dorope) {
                    const LAS float* rp = (const LAS float*)(tlds + (wr * 64 + ai * 128 + m * 16 + fr) * 64);
                    const f32x4 c0 = *(const LAS f32x4*)rp, c1 = *(const LAS f32x4*)(rp + 4), s0 = *(const LAS f32x4*)(rp + 8), s1 = *(const LAS f32x4*)(rp + 12);
#pragma unroll
                    for (int bj = 0; bj < 2; ++bj)
#pragma unroll
                        for (int n = 0; n < 2; ++n) { const f32x4 c = n ? c1 : c0, s = n ? s1 : s0; f32x4 o;
#pragma unroll
                            for (int j = 0; j < 4; ++j) { const float x = v[bj][n][j]; const float y = SHX(x, 16);
                                o[j] = fq == 0 ? x * c[j] - y * s[j] : (fq == 1 ? x * c[j] + y * s[j] : x); }
                            v[bj][n] = o; }
                }
#pragma unroll
                for (int bj = 0; bj < 2; ++bj) { const f32x4 v0 = v[bj][0], v1 = v[bj][1];
                    u32x4 w; w.x = cvt_pk_bf16(v0[0], v0[1]); w.y = cvt_pk_bf16(v0[2], v0[3]); w.z = cvt_pk_bf16(v1[0], v1[1]); w.w = cvt_pk_bf16(v1[2], v1[3]);
                    *(u32x4*)(base + (size_t)row * ld + bj * 128) = w; } }
    }
};

template <int NACC, class F>
__device__ __forceinline__ void skinny_item(const bf16_t* A, int lda, const bf16_t* (&Bt)[NACC], int K, int wave, int lane, LAS unsigned char* lds, int parity, const F& epi) {
    const int fr = lane & 15, quad = lane >> 4, kw = K >> 3;
    const bf16_t* ap = A + (size_t)fr * lda + wave * kw + 8 * quad;
    f32x4 acc[NACC];
#pragma unroll
    for (int i = 0; i < NACC; ++i) acc[i] = (f32x4){0.f, 0.f, 0.f, 0.f};
#pragma unroll 2
    for (int k = 0; k < kw; k += 32) { const bf16x8 a = *(const bf16x8*)(ap + k);
#pragma unroll
        for (int i = 0; i < NACC; ++i) acc[i] = __builtin_amdgcn_mfma_f32_16x16x32_bf16(a, *(const bf16x8*)(Bt[i] + (size_t)fr * K + wave * kw + 8 * quad + k), acc[i], 0, 0, 0); }
    LAS f32x4* red = (LAS f32x4*)(lds + parity * 16384);
#pragma unroll
    for (int i = 0; i < NACC; ++i) red[(wave * NACC + i) * 64 + lane] = acc[i];
    __syncthreads();
    if (wave == 0) {
#pragma unroll
        for (int i = 0; i < NACC; ++i) { f32x4 t = red[i * 64 + lane];
#pragma unroll
            for (int w = 1; w < 8; ++w) t += red[(w * NACC + i) * 64 + lane];
            acc[i] = t; }
        epi(acc, fr, quad);
    }
}

template <int NACC, class F>
__device__ __forceinline__ void skinny_item8(const unsigned char* A, int lda, const unsigned char* (&Bt)[NACC], int K, int wave, int lane, LAS unsigned char* lds, int parity, const F& epi) {
    const int fr = lane & 15, quad = lane >> 4, nblk = K >> 7, b0 = (wave * nblk) >> 3, b1 = ((wave + 1) * nblk) >> 3;
    f32x4 acc[NACC];
#pragma unroll
    for (int i = 0; i < NACC; ++i) acc[i] = (f32x4){0.f, 0.f, 0.f, 0.f};
    for (int kb = b0; kb < b1; ++kb) { const u32x4* ap = (const u32x4*)(A + (size_t)fr * lda + kb * 128 + 32 * quad); const u32x4 a0 = ap[0], a1 = ap[1];
        const i32x8 av = {(int)a0.x, (int)a0.y, (int)a0.z, (int)a0.w, (int)a1.x, (int)a1.y, (int)a1.z, (int)a1.w};
#pragma unroll
        for (int i = 0; i < NACC; ++i) { const u32x4* bp = (const u32x4*)(Bt[i] + (size_t)fr * K + kb * 128 + 32 * quad); const u32x4 q0 = bp[0], q1 = bp[1];
            const i32x8 bv = {(int)q0.x, (int)q0.y, (int)q0.z, (int)q0.w, (int)q1.x, (int)q1.y, (int)q1.z, (int)q1.w};
            acc[i] = __builtin_amdgcn_mfma_scale_f32_16x16x128_f8f6f4(av, bv, acc[i], 0, 0, 0, 0x7F7F7F7F, 0, 0x7F7F7F7F); } }
    LAS f32x4* red = (LAS f32x4*)(lds + parity * 16384);
#pragma unroll
    for (int i = 0; i < NACC; ++i) red[(wave * NACC + i) * 64 + lane] = acc[i];
    __syncthreads();
    if (wave == 0) {
#pragma unroll
        for (int i = 0; i < NACC; ++i) { f32x4 t = red[i * 64 + lane];
#pragma unroll
            for (int w = 1; w < 8; ++w) t += red[(w * NACC + i) * 64 + lane];
            acc[i] = t; }
        epi(acc, fr, quad);
    }
}

__device__ __forceinline__ int claim_item(unsigned* ctr, LAS unsigned char* lds, int tid) {
    volatile LAS unsigned* slot = (volatile LAS unsigned*)(lds + MISC_OFF) + 48;
    if (tid == 0) slot[0] = __hip_atomic_fetch_add(ctr, 1u, __ATOMIC_RELAXED, __HIP_MEMORY_SCOPE_AGENT);
    __syncthreads();
    const int item = (int)slot[0];
    __syncthreads();
    return item;
}

struct Params { const float* in[18]; float* out; unsigned char* ws; int ph_lo, ph_hi, li, pad; };
enum { I_X = 0, I_META, I_WIN, I_BGATE, I_LNH, I_WOUT, I_WKV, I_WQ, I_SINKS, I_WO, I_WGUD, I_WDND, I_WROUTER, I_BROUTER, I_WGUE, I_WDNE, I_LNG, I_LNB };
constexpr int NWAVES = 8, NTHREADS = 512;

__device__ __forceinline__ unsigned pk4_i8(float a, float b, float c, float d) {
    const int ia = (int)__builtin_rintf(__builtin_amdgcn_fmed3f(a, -127.f, 127.f)), ib = (int)__builtin_rintf(__builtin_amdgcn_fmed3f(b, -127.f, 127.f));
    const int ic = (int)__builtin_rintf(__builtin_amdgcn_fmed3f(c, -127.f, 127.f)), id = (int)__builtin_rintf(__builtin_amdgcn_fmed3f(d, -127.f, 127.f));
    return (unsigned)(ia & 0xff) | ((unsigned)(ib & 0xff) << 8) | ((unsigned)(ic & 0xff) << 16) | ((unsigned)(id & 0xff) << 24); }
template <int F8 = 0>
__device__ __forceinline__ void tr_item(const float* W, int Nsrc, int K, void* WTv, int k0, int n0, int drow0, float scale, int nvalid, LAS float* scr, int lane) {
    bf16_t* WT = (bf16_t*)WTv;
    float ld[32];
#pragma unroll
    for (int i = 0; i < 32; ++i) { const int kk = 2 * i + (lane >> 5), n = lane & 31; ld[i] = (n < nvalid) ? W[(size_t)(k0 + kk) * Nsrc + n0 + n] : 0.f; }
#pragma unroll
    for (int i = 0; i < 32; ++i) { const int kk = 2 * i + (lane >> 5), n = lane & 31; scr[kk * 33 + n] = ld[i] * scale; }
    LDS_WAIT(); asm volatile("" ::: "memory");
    const int c = lane & 7;
#pragma unroll
    for (int j = 0; j < 4; ++j) { const int n = (lane >> 3) + 8 * j; const LAS float* s = scr + (8 * c) * 33 + n;
        if constexpr (F8 == 2) { u32x2 o; o.x = pk4_i8(s[0 * 33], s[1 * 33], s[2 * 33], s[3 * 33]); o.y = pk4_i8(s[4 * 33], s[5 * 33], s[6 * 33], s[7 * 33]);
            if (n < nvalid) *(u32x2*)((unsigned char*)WTv + (size_t)(drow0 + n) * K + k0 + 8 * c) = o; }
        else if constexpr (F8 == 1) { u32x2 o; o.x = pk4_fp8(s[0 * 33], s[1 * 33], s[2 * 33], s[3 * 33]); o.y = pk4_fp8(s[4 * 33], s[5 * 33], s[6 * 33], s[7 * 33]);
            if (n < nvalid) *(u32x2*)((unsigned char*)WTv + (size_t)(drow0 + n) * K + k0 + 8 * c) = o; }
        else { u32x4 o; o.x = pk2(s[0 * 33], s[1 * 33]); o.y = pk2(s[2 * 33], s[3 * 33]); o.z = pk2(s[4 * 33], s[5 * 33]); o.w = pk2(s[6 * 33], s[7 * 33]);
            if (n < nvalid) *(u32x4*)(WT + (size_t)(drow0 + n) * K + k0 + 8 * c) = o; } }
    LDS_WAIT(); asm volatile("" ::: "memory");
}
__device__ __forceinline__ int pair_row(int n, int FF) { const int up = n >= FF ? 1 : 0, j = n - up * FF; return 256 * (j >> 7) + 128 * up + (j & 127); }

__device__ __forceinline__ void p0_prologue(const Params& P, LAS unsigned char* lds, int gw, int NGW, int wave, int lane, const XcdBarrier& bar, int tid) {
    unsigned char* ws = P.ws;
    LAS float* scr = (LAS float*)(lds + wave * 16384);
    { unsigned* amax = (unsigned*)(ws + WS_CTL) + CW_AMAX;
      const int vwg = gw >> 3;
      if (vwg < 192) { const int m = vwg >> 3, part = vwg & 7;
          const float* src = m < 2 ? P.in[I_WGUD] + (size_t)m * D * 2 * D_FF : m < 18 ? P.in[I_WGUE] + (size_t)(m - 2) * D * 2 * D_FF_EXP : m < 20 ? P.in[I_WQ] + (size_t)(m - 18) * D * D : m < 21 ? P.in[I_WKV]
                           : m < 23 ? P.in[I_WIN] + (size_t)(m - 21) * D * M_IN : P.in[I_X];
          const int n4 = 16 * (m < 2 ? 2 * D_FF : m < 18 ? 2 * D_FF_EXP : m < 20 ? D : m < 21 ? 512 : m < 23 ? M_IN : 4096), pn4 = n4 >> 3;
          float mx = 0.f;
          for (int i = part * pn4 + tid; i < (part + 1) * pn4; i += NTHREADS) { const f32x4 v = ((const f32x4*)src)[i]; mx = fmaxf(fmaxf(mx, fmaxf(fabsf(v[0]), fabsf(v[1]))), fmaxf(fabsf(v[2]), fabsf(v[3]))); }
#pragma unroll
          for (int o = 1; o < 64; o <<= 1) mx = fmaxf(mx, SHX(mx, o));
          volatile LAS float* red = (volatile LAS float*)(lds + MISC_OFF) + 40;
          if (lane == 0) red[wave] = mx;
          __syncthreads();
          if (tid == 0) { float t = red[0];
#pragma unroll
              for (int w = 1; w < 8; ++w) t = fmaxf(t, red[w]);
              __hip_atomic_fetch_max(amax + m, __builtin_bit_cast(unsigned, t), __ATOMIC_RELAXED, __HIP_MEMORY_SCOPE_AGENT); } }
      xcd_barrier(bar, tid == 0);
      if (gw == 0 && lane < 24) ((float*)(ws + WS_SMALL))[SM_WSCALE + lane] = 1.15f * __builtin_bit_cast(float, __hip_atomic_load(amax + lane, __ATOMIC_RELAXED, __HIP_MEMORY_SCOPE_AGENT)) * (1.f / 127.f); }
    const unsigned* amaxr = (const unsigned*)(ws + WS_CTL) + CW_AMAX;
    constexpr int IT0 = 16 * 97, IT1 = 16 * 32, IT2 = 16 * 16, IT5 = 16 * 176, IT6 = 44 * 32, IT7 = 16 * 224, IT8 = 56 * 32;
    constexpr int C0 = 2 * IT0, C1 = C0 + 2 * IT1, C2 = C1 + IT2, C3 = C2 + 2 * IT1, C4 = C3 + 2 * IT1, C5 = C4 + 2 * IT5, C6 = C5 + 2 * IT6, C7 = C6 + 16 * IT7, C8 = C7 + 16 * IT8;
    for (int it = gw; it < C8; it += NGW) {
        if (it < C0) { const int mi = it / IT0, r = it % IT0, kb = r / 97, nb = r % 97; const int n0 = nb * 32;
            tr_item(P.in[I_WIN] + (size_t)mi * D * M_IN, M_IN, D, (bf16_t*)(ws + WS_WIN) + (size_t)mi * M_INP * D, kb * 64, n0, n0, n0 < 512 ? 0.125f : 1.f, nb == 96 ? 16 : 32, scr, lane);
            if (nb < 96) { const float qs = 127.f / (1.15f * __builtin_bit_cast(float, __hip_atomic_load(amaxr + 21 + mi, __ATOMIC_RELAXED, __HIP_MEMORY_SCOPE_AGENT)));
                tr_item<2>(P.in[I_WIN] + (size_t)mi * D * M_IN, M_IN, D, ws + WS_WIN8 + (size_t)mi * 3072 * D, kb * 64, n0, n0, qs, 32, scr, lane); }
        } else if (it < C1) { const int q = it - C0, mi = q / IT1, r = q % IT1, kb = r / 32, nb = r % 32;
            tr_item(P.in[I_WOUT] + (size_t)mi * D * D, D, D, (bf16_t*)(ws + WS_WOUT) + (size_t)mi * D * D, kb * 64, nb * 32, nb * 32, 1.f, 32, scr, lane);
        } else if (it < C2) { const int r = it - C1, kb = r / 16, nb = r % 16;
            tr_item(P.in[I_WKV], 512, D, (bf16_t*)(ws + WS_WQKV), kb * 64, nb * 32, 1024 + nb * 32, 1.f, 32, scr, lane);
            { const float qs = 127.f / (1.15f * __builtin_bit_cast(float, __hip_atomic_load(amaxr + 20, __ATOMIC_RELAXED, __HIP_MEMORY_SCOPE_AGENT)));
              tr_item<2>(P.in[I_WKV], 512, D, ws + WS_WQKV8, kb * 64, nb * 32, 1024 + nb * 32, qs, 32, scr, lane); }
        } else if (it < C3) { const int q = it - C2, mi = q / IT1, r = q % IT1, kb = r / 32, nb = r % 32;
            tr_item(P.in[I_WQ] + (size_t)mi * D * D, D, D, (bf16_t*)(ws + (mi ? WS_WQ3 : WS_WQKV)), kb * 64, nb * 32, nb * 32, 0.125f, 32, scr, lane);
            { const float qs = 127.f / (1.15f * __builtin_bit_cast(float, __hip_atomic_load(amaxr + 18 + mi, __ATOMIC_RELAXED, __HIP_MEMORY_SCOPE_AGENT)));
              tr_item<2>(P.in[I_WQ] + (size_t)mi * D * D, D, D, ws + WS_WQKV8 + (mi ? (size_t)1536 * D : 0), kb * 64, nb * 32, nb * 32, qs, 32, scr, lane); }
        } else if (it < C4) { const int q = it - C3, mi = q / IT1, r = q % IT1, kb = r / 32, nb = r % 32;
            tr_item<1>(P.in[I_WO] + (size_t)mi * D * D, D, D, (ws + WS_WO8) + (size_t)mi * D * D, kb * 64, nb * 32, nb * 32, F8_SWO, 32, scr, lane);
        } else if (it < C5) { const int q = it - C4, mi = q / IT5, r = q % IT5, kb = r / 176, nb = r % 176;
            tr_item(P.in[I_WGUD] + (size_t)mi * D * 2 * D_FF, 2 * D_FF, D, (bf16_t*)(ws + WS_WGU) + (size_t)mi * 2 * D_FF * D, kb * 64, nb * 32, pair_row(nb * 32, D_FF), 1.f, 32, scr, lane);
            { const float qs = 127.f / (1.15f * __builtin_bit_cast(float, __hip_atomic_load(amaxr + mi, __ATOMIC_RELAXED, __HIP_MEMORY_SCOPE_AGENT)));
              tr_item<2>(P.in[I_WGUD] + (size_t)mi * D * 2 * D_FF, 2 * D_FF, D, (ws + WS_WGU8) + (size_t)mi * 2 * D_FF * D, kb * 64, nb * 32, pair_row(nb * 32, D_FF), qs, 32, scr, lane); }
        } else if (it < C6) { const int q = it - C5, mi = q / IT6, r = q % IT6, kb = r / 32, nb = r % 32;
            tr_item<1>(P.in[I_WDND] + (size_t)mi * D_FF * D, D, D_FF, (ws + WS_WDN8) + (size_t)mi * D * D_FF, kb * 64, nb * 32, nb * 32, F8_SBD, 32, scr, lane);
        } else if (it < C7) { const int q = it - C6, mi = q / IT7, r = q % IT7, kb = r / 224, nb = r % 224;
            const float qs = 127.f / (1.15f * __builtin_bit_cast(float, __hip_atomic_load(amaxr + 2 + mi, __ATOMIC_RELAXED, __HIP_MEMORY_SCOPE_AGENT)));
            tr_item<2>(P.in[I_WGUE] + (size_t)mi * D * 2 * D_FF_EXP, 2 * D_FF_EXP, D, (ws + WS_WGUE8) + (size_t)mi * 2 * D_FF_EXP * D, kb * 64, nb * 32, pair_row(nb * 32, D_FF_EXP), qs, 32, scr, lane);
        } else { const int q = it - C7, mi = q / IT8, r = q % IT8, kb = r / 32, nb = r % 32;
            tr_item<1>(P.in[I_WDNE] + (size_t)mi * D_FF_EXP * D, D, D_FF_EXP, (ws + WS_WDNE8) + (size_t)mi * D * D_FF_EXP, kb * 64, nb * 32, nb * 32, F8_SBD, 32, scr, lane);
        }
    }
    { float* sm = (float*)(ws + WS_SMALL); const int gt = gw * 64 + lane, NT = NGW * 64;
      for (int i = gt; i < SM_WSCALE; i += NT) { float v = 0.f;
          if (i < SM_SINKS) v = P.in[I_BGATE][i]; else if (i < SM_BROUTER) v = P.in[I_SINKS][i - SM_SINKS]; else if (i < SM_BROUTER + 16) v = P.in[I_BROUTER][i - SM_BROUTER];
          else if (i < SM_LNH) v = 0.f; else if (i < SM_LNG) v = P.in[I_LNH][i - SM_LNH]; else if (i < SM_LNB) v = P.in[I_LNG][i - SM_LNG]; else if (i < SM_WROUTER) v = P.in[I_LNB][i - SM_LNB]; else v = P.in[I_WROUTER][i - SM_WROUTER];
          sm[i] = v; } }
    { bf16_t* HB = (bf16_t*)(ws + WS_HB); const float xq = 127.f / (1.15f * __builtin_bit_cast(float, __hip_atomic_load(amaxr + 23, __ATOMIC_RELAXED, __HIP_MEMORY_SCOPE_AGENT)));
      const size_t gt = (size_t)gw * 64 + lane, NT = (size_t)NGW * 64;
      for (size_t i = gt; i < (size_t)MV * (D / 4); i += NT) { const size_t row = i >> 8; const int c4 = (int)(i & 255);
          const f32x4 v = row < MREAL ? ((const f32x4*)P.in[I_X])[i] : ((const f32x4*)P.in[I_META])[(row - MREAL) * 256 + c4];
          u32x2 w; w.x = pk2(v[0], v[1]); w.y = pk2(v[2], v[3]); ((u32x2*)HB)[i] = w;
          ((unsigned*)(ws + WS_HB8))[i] = pk4_i8(v[0] * xq, v[1] * xq, v[2] * xq, v[3] * xq); }
      float* rope = (float*)(ws + WS_ROPE);
      for (size_t i = gt; i < (size_t)(SEQ + NMETA) * 8; i += NT) { const int pos = (int)(i >> 3), fi = (int)(i & 7);
          const double invf = fi == 0 ? 1.0 : fi == 1 ? 0.19392274474868576 : fi == 2 ? 0.03760603093086393 : fi == 3 ? 0.007292664737217109 : fi == 4 ? 0.001414213562373095
                            : fi == 5 ? 0.0002742481756762073 : fi == 6 ? 5.318295896944988e-05 : 1.031338537721246e-05;
          const float angf = (float)pos * (float)invf;
          double a = (double)angf; a -= 6.283185307179586476925 * __builtin_rint(a * 0.15915494309189533577); const double hx = 0.5 * a, h2 = hx * hx;
          double sp = 1.0, cp = 1.0;
#pragma unroll
          for (int k = 12; k >= 1; --k) { sp = 1.0 - sp * h2 / (double)((2 * k) * (2 * k + 1)); cp = 1.0 - cp * h2 / (double)((2 * k - 1) * (2 * k)); }
          const double sh = hx * sp, ch = cp;
          rope[(size_t)pos * 16 + fi] = (float)(1.0 - 2.0 * sh * sh); rope[(size_t)pos * 16 + 8 + fi] = (float)(2.0 * sh * ch); }
    }
}

__device__ __forceinline__ void ln_phase(unsigned char* ws, float* outp, LAS unsigned char* lds, int gw, int NGW, int lane, int tid,
                                         int lnidx, bool moe_src, bool router, int moe_idx, bool final, bool dry = false, bool q8 = false, bool fullhb = false) {
    const float* sm = (const float*)(ws + WS_SMALL);
    unsigned char* wo = dry ? ws + WS_ACT : ws;
    const bf16_t* H = (const bf16_t*)(ws + WS_H); bf16_t* Hw = dry ? (bf16_t*)(ws + WS_ACT) : (bf16_t*)(ws + WS_H);
    bf16_t* HB = dry ? (bf16_t*)(ws + WS_ACT + 160 * MiB) : (bf16_t*)(ws + WS_HB); const bf16_t* contrib = (const bf16_t*)(ws + WS_CONTRIB);
    const float* stats = (const float*)(ws + WS_STATS); float* statsw = dry ? (float*)(ws + WS_ACT + 240 * MiB) : (float*)(ws + WS_STATS);
    unsigned char* HB8 = dry ? ws + WS_ACT + 250 * MiB : ws + WS_HB8; (void)wo;
    const float* lg = sm + SM_LNG + (size_t)lnidx * D; const float* lb = sm + SM_LNB + (size_t)lnidx * D;
    f32x4 gv[4], bv[4];
#pragma unroll
    for (int j = 0; j < 4; ++j) { gv[j] = *(const f32x4*)(lg + 256 * j + 4 * lane); bv[j] = *(const f32x4*)(lb + 256 * j + 4 * lane); }
    float qi8 = 0.f;
    if (q8) { float gm = 0.f, bm = 0.f;
#pragma unroll
        for (int j = 0; j < 4; ++j)
#pragma unroll
            for (int c = 0; c < 4; ++c) { gm = fmaxf(gm, fabsf(gv[j][c])); bm = fmaxf(bm, fabsf(bv[j][c])); }
#pragma unroll
        for (int o = 1; o < 64; o <<= 1) { gm = fmaxf(gm, SHX(gm, o)); bm = fmaxf(bm, SHX(bm, o)); }
        const float clip = 5.5f * gm + bm; qi8 = 127.f / clip;
        if (gw == 0 && lane == 0 && !dry) ((float*)(ws + WS_SMALL))[SM_ASCALE + lnidx] = clip * (1.f / 127.f); }
    volatile LAS unsigned* misc = (volatile LAS unsigned*)(lds + MISC_OFF);
    f32x4 wra[4][4], wrb[4][4];
    if (router) {
        const float* src = sm + SM_WROUTER + (size_t)moe_idx * D * N_EXP;
#pragma unroll
        for (int j = 0; j < 4; ++j)
#pragma unroll
            for (int c = 0; c < 4; ++c) { const f32x4* w4 = (const f32x4*)(src + (size_t)(256 * j + 4 * lane + c) * 8); wra[j][c] = w4[0]; wrb[j][c] = w4[1]; }
        if (tid < 8) misc[16 + tid] = 0u;
        __syncthreads();
    }
    int* tope = dry ? (int*)(ws + WS_ACT + 300 * MiB) : (int*)(ws + WS_TOPE); float* topg = dry ? (float*)(ws + WS_ACT + 310 * MiB) : (float*)(ws + WS_TOPG);
    const float* br = sm + SM_BROUTER + moe_idx * N_EXP;
    struct RowBuf { u32x2 nv[4], nc0[4], nc1[4]; f32x2 nst; };
    RowBuf rb0 = {}, rb1 = {};
    auto fetch = [&](RowBuf& B, int row) {
        u32x2 (&nv)[4] = B.nv; u32x2 (&nc0)[4] = B.nc0; u32x2 (&nc1)[4] = B.nc1; f32x2& nst = B.nst;
        const u32x2* hr = (const u32x2*)((const char*)H + ((unsigned)row * (unsigned)(D * 2) + (unsigned)lane * 8u));
#pragma unroll
        for (int j = 0; j < 4; ++j) nv[j] = hr[64 * j];
        if (moe_src) { const u32x2* c0 = (const u32x2*)((const char*)contrib + ((unsigned)row * (unsigned)(D * 4) + (unsigned)lane * 8u)); const u32x2* c1 = c0 + 256;
#pragma unroll
            for (int j = 0; j < 4; ++j) { nc0[j] = c0[64 * j]; nc1[j] = c1[64 * j]; } }
        if (moe_src) nst = *(const f32x2*)((const char*)stats + (unsigned)row * 8u);
    };
    auto body = [&](RowBuf& B, int row) {
        u32x2 (&nv)[4] = B.nv; u32x2 nc0[4], nc1[4];
#pragma unroll
        for (int j = 0; j < 4; ++j) { nc0[j] = moe_src ? B.nc0[j] : (u32x2){0u, 0u}; nc1[j] = moe_src ? B.nc1[j] : (u32x2){0u, 0u}; }
        f32x4 v[4], c0v[4], c1v[4]; const f32x2 st = moe_src ? B.nst : (f32x2){0.f, 1.f};
#pragma unroll
        for (int j = 0; j < 4; ++j) { v[j] = (f32x4){__builtin_bit_cast(float, nv[j].x << 16), __builtin_bit_cast(float, nv[j].x & 0xffff0000u), __builtin_bit_cast(float, nv[j].y << 16), __builtin_bit_cast(float, nv[j].y & 0xffff0000u)};
            c0v[j] = (f32x4){__builtin_bit_cast(float, nc0[j].x << 16), __builtin_bit_cast(float, nc0[j].x & 0xffff0000u), __builtin_bit_cast(float, nc0[j].y << 16), __builtin_bit_cast(float, nc0[j].y & 0xffff0000u)};
            c1v[j] = (f32x4){__builtin_bit_cast(float, nc1[j].x << 16), __builtin_bit_cast(float, nc1[j].x & 0xffff0000u), __builtin_bit_cast(float, nc1[j].y << 16), __builtin_bit_cast(float, nc1[j].y & 0xffff0000u)}; }
        if (row + 2 * NGW < MV) fetch(B, row + 2 * NGW);
        if (moe_src) { const float* pg = lg - D; const float* pb = lb - D;
#pragma unroll
            for (int j = 0; j < 4; ++j) { const f32x4 g1 = *(const f32x4*)(pg + 256 * j + 4 * lane), b1 = *(const f32x4*)(pb + 256 * j + 4 * lane);
                v[j] = ((v[j] - st.x) * st.y * g1 + b1) * ALPHA + c0v[j] + c1v[j]; }
            if (!final) { u32x2* o = (u32x2*)(Hw + (size_t)row * D) + lane;
#pragma unroll
                for (int j = 0; j < 4; ++j) { u32x2 w; w.x = pk2(v[j][0], v[j][1]); w.y = pk2(v[j][2], v[j][3]); o[64 * j] = w;
                    v[j] = (f32x4){__builtin_bit_cast(float, w.x << 16), __builtin_bit_cast(float, w.x & 0xffff0000u), __builtin_bit_cast(float, w.y << 16), __builtin_bit_cast(float, w.y & 0xffff0000u)}; } } }
        float s = 0.f;
#pragma unroll
        for (int j = 0; j < 4; ++j) s += (v[j][0] + v[j][1]) + (v[j][2] + v[j][3]);
        const float mean = wave_sum(s, lane) * (1.f / D); float s2 = 0.f;
#pragma unroll
        for (int j = 0; j < 4; ++j) { v[j] = v[j] - mean; s2 += (v[j][0] * v[j][0] + v[j][1] * v[j][1]) + (v[j][2] * v[j][2] + v[j][3] * v[j][3]); }
        const float rstd = 1.f / sqrtf(wave_sum(s2, lane) * (1.f / D) + LN_EPS);
#pragma unroll
        for (int j = 0; j < 4; ++j) { const float* lgq = lg; const float* lbq = lb; asm volatile("" : "+s"(lgq), "+s"(lbq));
            v[j] = v[j] * rstd * *(const f32x4*)(lgq + 256 * j + 4 * lane) + *(const f32x4*)(lbq + 256 * j + 4 * lane); }
        if (final) { if (row < MREAL) { f32x4* o = (f32x4*)(outp + (size_t)row * D) + lane;
#pragma unroll
                for (int j = 0; j < 4; ++j) o[64 * j] = v[j]; } }
        else { if (lane == 0) *(f32x2*)(statsw + 2 * (size_t)row) = (f32x2){mean, rstd};
            if (q8) {
                unsigned* o8 = (unsigned*)(HB8 + (size_t)row * D) + lane;
#pragma unroll
                for (int j = 0; j < 4; ++j) o8[64 * j] = pk4_i8(v[j][0] * qi8, v[j][1] * qi8, v[j][2] * qi8, v[j][3] * qi8); }
            if (!q8 || fullhb || row >= MREAL) { u32x2* ob = (u32x2*)(HB + (size_t)row * D) + lane;
#pragma unroll
                for (int j = 0; j < 4; ++j) { u32x2 w; w.x = pk2(v[j][0], v[j][1]); w.y = pk2(v[j][2], v[j][3]); ob[64 * j] = w; } } }
        if (router) {
            f32x4 la = (f32x4){0.f, 0.f, 0.f, 0.f}, lb4 = (f32x4){0.f, 0.f, 0.f, 0.f};
#pragma unroll
            for (int j = 0; j < 4; ++j)
#pragma unroll
                for (int c = 0; c < 4; ++c) { const float x = v[j][c]; la += wra[j][c] * x; lb4 += wrb[j][c] * x; }
            const bool h5 = (lane & 32) != 0, h4 = (lane & 16) != 0, h3 = (lane & 8) != 0;
            f32x4 k4; { const f32x4 send = h5 ? la : lb4, keep = h5 ? lb4 : la; f32x4 got;
#pragma unroll
                for (int i = 0; i < 4; ++i) got[i] = SHX(send[i], 32);
                k4 = keep + got; }
            f32x2 k2; { const f32x2 send = h4 ? (f32x2){k4[0], k4[1]} : (f32x2){k4[2], k4[3]}, keep = h4 ? (f32x2){k4[2], k4[3]} : (f32x2){k4[0], k4[1]};
                k2 = keep + (f32x2){SHX(send[0], 16), SHX(send[1], 16)}; }
            float k1 = (h3 ? k2[1] : k2[0]) + SHX(h3 ? k2[0] : k2[1], 8);
            k1 += SHX(k1, 4); k1 += SHX(k1, 2); k1 += SHX(k1, 1);
            float lg8[8];
#pragma unroll
            for (int e = 0; e < 8; ++e) lg8[e] = SHL(k1, 8 * e) + br[e];
            int e1 = 0; float v1 = lg8[0];
#pragma unroll
            for (int e = 1; e < 8; ++e) if (lg8[e] > v1) { v1 = lg8[e]; e1 = e; }
            int e2 = -1; float v2 = -3.0e38f;
#pragma unroll
            for (int e = 0; e < 8; ++e) if (e != e1 && lg8[e] > v2) { v2 = lg8[e]; e2 = e; }
            const float ex = expf(v2 - v1), g1 = 1.f / (1.f + ex), g2 = ex / (1.f + ex);
            if (lane == 0) { tope[row] = e1 | (e2 << 8); topg[2 * row] = g1; topg[2 * row + 1] = g2;
                __hip_atomic_fetch_add((LAS unsigned*)&misc[16 + e1], 1u, __ATOMIC_RELAXED, __HIP_MEMORY_SCOPE_WORKGROUP);
                __hip_atomic_fetch_add((LAS unsigned*)&misc[16 + e2], 1u, __ATOMIC_RELAXED, __HIP_MEMORY_SCOPE_WORKGROUP); }
        }
    };
    auto unpack = [&](RowBuf& B, f32x4 (&v)[4], f32x4 (&c0v)[4], f32x4 (&c1v)[4]) {
#pragma unroll
        for (int j = 0; j < 4; ++j) { const u32x2 a = B.nv[j], b0 = moe_src ? B.nc0[j] : (u32x2){0u, 0u}, b1 = moe_src ? B.nc1[j] : (u32x2){0u, 0u};
            v[j] = (f32x4){__builtin_bit_cast(float, a.x << 16), __builtin_bit_cast(float, a.x & 0xffff0000u), __builtin_bit_cast(float, a.y << 16), __builtin_bit_cast(float, a.y & 0xffff0000u)};
            c0v[j] = (f32x4){__builtin_bit_cast(float, b0.x << 16), __builtin_bit_cast(float, b0.x & 0xffff0000u), __builtin_bit_cast(float, b0.y << 16), __builtin_bit_cast(float, b0.y & 0xffff0000u)};
            c1v[j] = (f32x4){__builtin_bit_cast(float, b1.x << 16), __builtin_bit_cast(float, b1.x & 0xffff0000u), __builtin_bit_cast(float, b1.y << 16), __builtin_bit_cast(float, b1.y & 0xffff0000u)}; } };
    auto body2 = [&](int rowA) {
        const int rw[2] = {rowA, rowA + NGW};
        f32x4 v[2][4], c0v[2][4], c1v[2][4]; const f32x2 st[2] = {moe_src ? rb0.nst : (f32x2){0.f, 1.f}, moe_src ? rb1.nst : (f32x2){0.f, 1.f}};
        unpack(rb0, v[0], c0v[0], c1v[0]); unpack(rb1, v[1], c0v[1], c1v[1]);
        if (rw[0] + 2 * NGW < MV) fetch(rb0, rw[0] + 2 * NGW);
        if (rw[1] + 2 * NGW < MV) fetch(rb1, rw[1] + 2 * NGW);
        if (moe_src) { const float* pg = lg - D; const float* pb = lb - D;
#pragma unroll
            for (int j = 0; j < 4; ++j) { const f32x4 g1 = *(const f32x4*)(pg + 256 * j + 4 * lane), b1 = *(const f32x4*)(pb + 256 * j + 4 * lane);
#pragma unroll
                for (int r = 0; r < 2; ++r) v[r][j] = ((v[r][j] - st[r].x) * st[r].y * g1 + b1) * ALPHA + c0v[r][j] + c1v[r][j]; }
            if (!final) {
#pragma unroll
                for (int r = 0; r < 2; ++r) { u32x2* o = (u32x2*)((char*)Hw + ((unsigned)rw[r] * (unsigned)(D * 2) + (unsigned)lane * 8u));
#pragma unroll
                    for (int j = 0; j < 4; ++j) { u32x2 w; w.x = pk2(v[r][j][0], v[r][j][1]); w.y = pk2(v[r][j][2], v[r][j][3]); o[64 * j] = w;
                        v[r][j] = (f32x4){__builtin_bit_cast(float, w.x << 16), __builtin_bit_cast(float, w.x & 0xffff0000u), __builtin_bit_cast(float, w.y << 16), __builtin_bit_cast(float, w.y & 0xffff0000u)}; } } } }
        float s[2] = {0.f, 0.f};
#pragma unroll
        for (int r = 0; r < 2; ++r)
#pragma unroll
            for (int j = 0; j < 4; ++j) s[r] += (v[r][j][0] + v[r][j][1]) + (v[r][j][2] + v[r][j][3]);
#pragma unroll
        for (int o = 1; o < 64; o <<= 1) { const float t0 = SHX(s[0], o), t1 = SHX(s[1], o); s[0] += t0; s[1] += t1; }
        const float mean[2] = {s[0] * (1.f / D), s[1] * (1.f / D)}; float s2[2] = {0.f, 0.f};
#pragma unroll
        for (int r = 0; r < 2; ++r)
#pragma unroll
            for (int j = 0; j < 4; ++j) { v[r][j] = v[r][j] - mean[r]; s2[r] += (v[r][j][0] * v[r][j][0] + v[r][j][1] * v[r][j][1]) + (v[r][j][2] * v[r][j][2] + v[r][j][3] * v[r][j][3]); }
#pragma unroll
        for (int o = 1; o < 64; o <<= 1) { const float t0 = SHX(s2[0], o), t1 = SHX(s2[1], o); s2[0] += t0; s2[1] += t1; }
        const float rstd[2] = {1.f / sqrtf(s2[0] * (1.f / D) + LN_EPS), 1.f / sqrtf(s2[1] * (1.f / D) + LN_EPS)};
#pragma unroll
        for (int j = 0; j < 4; ++j) { const float* lgq = lg; const float* lbq = lb; asm volatile("" : "+s"(lgq), "+s"(lbq));
            const f32x4 gq = *(const f32x4*)(lgq + 256 * j + 4 * lane), bq = *(const f32x4*)(lbq + 256 * j + 4 * lane);
#pragma unroll
            for (int r = 0; r < 2; ++r) v[r][j] = v[r][j] * rstd[r] * gq + bq; }
        if (final) {
#pragma unroll
            for (int r = 0; r < 2; ++r) { f32x4* o = (f32x4*)((char*)outp + ((unsigned)rw[r] * (unsigned)(D * 4) + (unsigned)lane * 16u));
#pragma unroll
                for (int j = 0; j < 4; ++j) o[64 * j] = v[r][j]; } }
        else { if (lane == 0) { *(f32x2*)((char*)statsw + (unsigned)rw[0] * 8u) = (f32x2){mean[0], rstd[0]}; *(f32x2*)((char*)statsw + (unsigned)rw[1] * 8u) = (f32x2){mean[1], rstd[1]}; }
            if (q8) {
#pragma unroll
                for (int r = 0; r < 2; ++r) { unsigned* o8 = (unsigned*)(HB8 + ((unsigned)rw[r] * (unsigned)D + (unsigned)lane * 4u));
#pragma unroll
                    for (int j = 0; j < 4; ++j) o8[64 * j] = pk4_i8(v[r][j][0] * qi8, v[r][j][1] * qi8, v[r][j][2] * qi8, v[r][j][3] * qi8); } }
            if (!q8 || fullhb) {
#pragma unroll
                for (int r = 0; r < 2; ++r) { u32x2* ob = (u32x2*)((char*)HB + ((unsigned)rw[r] * (unsigned)(D * 2) + (unsigned)lane * 8u));
#pragma unroll
                    for (int j = 0; j < 4; ++j) { u32x2 w; w.x = pk2(v[r][j][0], v[r][j][1]); w.y = pk2(v[r][j][2], v[r][j][3]); ob[64 * j] = w; } } } }
        if (router) {
            f32x4 la[2], lb4[2];
#pragma unroll
            for (int r = 0; r < 2; ++r) { la[r] = (f32x4){0.f, 0.f, 0.f, 0.f}; lb4[r] = (f32x4){0.f, 0.f, 0.f, 0.f}; }
#pragma unroll
            for (int j = 0; j < 4; ++j)
#pragma unroll
                for (int c = 0; c < 4; ++c)
#pragma unroll
                    for (int r = 0; r < 2; ++r) { const float x = v[r][j][c]; la[r] += wra[j][c] * x; lb4[r] += wrb[j][c] * x; }
            unsigned ul = (unsigned)lane; asm volatile("" : "+v"(ul));
            const bool h5 = (ul & 32u) != 0u, h4 = (ul & 16u) != 0u, h3 = (ul & 8u) != 0u;
            f32x4 k4[2]; f32x2 k2[2]; float k1[2];
#pragma unroll
            for (int r = 0; r < 2; ++r) { const f32x4 send = h5 ? la[r] : lb4[r], keep = h5 ? lb4[r] : la[r]; f32x4 got;
#pragma unroll
                for (int i = 0; i < 4; ++i) got[i] = SHX(send[i], 32);
                k4[r] = keep + got; }
#pragma unroll
            for (int r = 0; r < 2; ++r) { const f32x2 send = h4 ? (f32x2){k4[r][0], k4[r][1]} : (f32x2){k4[r][2], k4[r][3]}, keep = h4 ? (f32x2){k4[r][2], k4[r][3]} : (f32x2){k4[r][0], k4[r][1]};
                k2[r] = keep + (f32x2){SHX(send[0], 16), SHX(send[1], 16)}; }
#pragma unroll
            for (int r = 0; r < 2; ++r) k1[r] = (h3 ? k2[r][1] : k2[r][0]) + SHX(h3 ? k2[r][0] : k2[r][1], 8);
#pragma unroll
            for (int o = 4; o >= 1; o >>= 1) { const float t0 = SHX(k1[0], o), t1 = SHX(k1[1], o); k1[0] += t0; k1[1] += t1; }
            float lg8[2][8];
#pragma unroll
            for (int e = 0; e < 8; ++e)
#pragma unroll
                for (int r = 0; r < 2; ++r) lg8[r][e] = SHL(k1[r], 8 * e) + br[e];
            int e1[2], e2[2]; float g1[2], g2[2];
#pragma unroll
            for (int r = 0; r < 2; ++r) { e1[r] = 0; float v1 = lg8[r][0];
#pragma unroll
                for (int e = 1; e < 8; ++e) if (lg8[r][e] > v1) { v1 = lg8[r][e]; e1[r] = e; }
                e2[r] = -1; float v2 = -3.0e38f;
#pragma unroll
                for (int e = 0; e < 8; ++e) if (e != e1[r] && lg8[r][e] > v2) { v2 = lg8[r][e]; e2[r] = e; }
                const float ex = expf(v2 - v1); g1[r] = 1.f / (1.f + ex); g2[r] = ex / (1.f + ex); }
            if (lane == 0) {
#pragma unroll
                for (int r = 0; r < 2; ++r) { *(int*)((char*)tope + (unsigned)rw[r] * 4u) = e1[r] | (e2[r] << 8); *(f32x2*)((char*)topg + (unsigned)rw[r] * 8u) = (f32x2){g1[r], g2[r]};
                    __hip_atomic_fetch_add((LAS unsigned*)&misc[16 + e1[r]], 1u, __ATOMIC_RELAXED, __HIP_MEMORY_SCOPE_WORKGROUP);
                    __hip_atomic_fetch_add((LAS unsigned*)&misc[16 + e2[r]], 1u, __ATOMIC_RELAXED, __HIP_MEMORY_SCOPE_WORKGROUP); } }
        }
    };
    if (gw < MV) fetch(rb0, gw);
    if (gw + NGW < MV) fetch(rb1, gw + NGW);
    int row = gw;
    for (; row + NGW < MREAL; row += 2 * NGW) body2(row);
    for (; row < MV; row += 2 * NGW) { body(rb0, row); if (row + NGW < MV) body(rb1, row + NGW); }
    if (router) { __syncthreads();
        if (tid < 8 && !dry) ((unsigned*)(ws + WS_CTL))[CW_CNTG + (moe_idx * 256 + (gw >> 3)) * 8 + tid] = misc[16 + tid];
        __syncthreads(); }
}

__device__ __forceinline__ void moe_starts(const unsigned char* ws, int moe_idx, int (&cnt)[8], int (&pstart)[9]) {
    const unsigned* c = (const unsigned*)(ws + WS_CTL) + CW_CNT + moe_idx * 64; int p = 0;
#pragma unroll
    for (int e = 0; e < 8; ++e) { cnt[e] = __builtin_amdgcn_readfirstlane((int)__hip_atomic_load(c + e, __ATOMIC_RELAXED, __HIP_MEMORY_SCOPE_AGENT)); pstart[e] = p; p += (cnt[e] + 255) >> 8; }
    pstart[8] = p;
}
__device__ __forceinline__ void assign_phase(unsigned char* ws, LAS unsigned char* lds, int gw, int NGW, int lane, int tid, int wave, int moe_idx) {
    const unsigned* cntg = (const unsigned*)(ws + WS_CTL) + CW_CNTG + moe_idx * 256 * 8;
    volatile LAS unsigned* misc = (volatile LAS unsigned*)(lds + MISC_OFF);
    const int vwg = gw >> 3, nwg = NGW >> 3;
    { const int e = wave; unsigned tot = 0, base = 0;
      for (int w = lane; w < nwg; w += 64) { const unsigned c = cntg[w * 8 + e]; tot += c; base += (w < vwg) ? c : 0u; }
#pragma unroll
      for (int o = 1; o < 64; o <<= 1) { tot += SHX(tot, o); base += SHX(base, o); }
      if (lane == 0) { misc[16 + e] = tot; misc[24 + e] = base; misc[32 + e] = 0u; } }
    __syncthreads();
    int cnt[8], pstart[9]; { int p = 0;
#pragma unroll
      for (int e = 0; e < 8; ++e) { cnt[e] = (int)misc[16 + e]; pstart[e] = p; p += (cnt[e] + 255) >> 8; } pstart[8] = p; }
    if (blockIdx.x == 0 && tid < 8) ((unsigned*)(ws + WS_CTL))[CW_CNT + moe_idx * 64 + tid] = misc[16 + tid];
    const int* tope = (const int*)(ws + WS_TOPE); const float* topg = (const float*)(ws + WS_TOPG);
    int* rowtok = (int*)(ws + WS_ROWTOK); int* rowdst = (int*)(ws + WS_ROWDST); float* rowgate = (float*)(ws + WS_ROWGATE);
    { const int row = gw + lane * NGW;
      if (row < MV) { const int te = tope[row];
#pragma unroll
          for (int slot = 0; slot < 2; ++slot) { const int e = (te >> (8 * slot)) & 255; int ps = 0; unsigned mb = 0;
#pragma unroll
              for (int ee = 0; ee < 8; ++ee) if (ee == e) { ps = pstart[ee]; mb = misc[24 + ee]; }
              const unsigned off = __hip_atomic_fetch_add((LAS unsigned*)&misc[32 + e], 1u, __ATOMIC_RELAXED, __HIP_MEMORY_SCOPE_WORKGROUP);
              const int pos = ps * 256 + (int)mb + (int)off;
              rowtok[pos] = row; rowdst[pos] = 2 * row + slot; rowgate[pos] = topg[2 * row + slot]; } } }
    if (blockIdx.x < 8) { const int e = blockIdx.x; int ps = 0, pe = 0, ce = 0;
#pragma unroll
        for (int ee = 0; ee < 8; ++ee) if (ee == e) { ps = pstart[ee]; pe = pstart[ee + 1]; ce = cnt[ee]; }
        for (int pos = ps * 256 + ce + tid; pos < pe * 256; pos += NTHREADS) { rowtok[pos] = -1; rowdst[pos] = -1; rowgate[pos] = 0.f; } }
}

constexpr int ML_RS = 72;
constexpr int ML_QS = 0, ML_KS = 9216, ML_KT = 18432, ML_VT = 27648, ML_CT = 48384, ML_CTB = 20736, ML_HS = 89856;
constexpr int ML_HSS = 132;
constexpr int ML_TAB = 123648, ML_NCH = 17;
constexpr int ML_TSC = ML_TAB + 7 * ML_NCH * 64 * 4;
static_assert(ML_TSC + 1024 <= MISC_OFF, "mLSTM LDS");
__device__ __forceinline__ bf16x8 ml_frag(LAS unsigned char* lds, int base, int row, int kcol) { return *(const LAS bf16x8*)(lds + base + (row * ML_RS + kcol) * 2); }

#ifndef PROBE_M2
#define PROBE_M2 0
#endif
template <int MODE>
__device__ __forceinline__ void mlstm_phase(unsigned char* ws, LAS unsigned char* lds, int layer, int tid, int wave, int lane, unsigned long long* pticks = nullptr) {
    unsigned long long pt0 = 0, pacc = 0; (void)pt0; (void)pacc;
#define PM2_BEGIN(k) do { if (PROBE_M2 == (k) && MODE == 2) pt0 = __builtin_amdgcn_s_memrealtime(); } while (0)
#define PM2_END(k) do { if (PROBE_M2 == (k) && MODE == 2) pacc += __builtin_amdgcn_s_memrealtime() - pt0; } while (0)
    PM2_BEGIN(1);
    const int item = blockIdx.x; const int bh = item >> 3, seg = item & 7, b = bh >> 3, h = bh & 7;
    if (MODE == 1 && seg == 7) return;
    const bf16_t* proj = (const bf16_t*)(ws + WS_PROJ); const float* gates = (const float*)(ws + WS_GATES);
    bf16_t* HG = (bf16_t*)(ws + WS_HG);
    float* STATE = (float*)(ws + WS_STATE); float* STSC = (float*)(ws + WS_STSC);
    LAS float* tab = (LAS float*)(lds + ML_TAB); LAS float* tsc = (LAS float*)(lds + ML_TSC);
    const int fr = lane & 15, quad = lane >> 4;
    f32x4 st[5]; float zero = 0.f; asm volatile("; opaque zero" : "+v"(zero));
#pragma unroll
    for (int i = 0; i < 5; ++i) st[i] = (f32x4){zero, zero, zero, zero};
    float m0 = (MODE == 1) ? -1.0e30f : 0.f;
    const int nch = SEG_CHUNKS + (seg == 0 ? 1 : 0);
    auto chunk_rows = [&](int ci, int& rbase, int& nv) { if (seg == 0 && ci == 0) { rbase = MREAL; nv = NMETA; } else { const int c = seg * SEG_CHUNKS + ci - (seg == 0 ? 1 : 0); rbase = b * SEQ + c * 64; nv = 64; } };
    for (int i = tid; i < 16 * ML_RS; i += NTHREADS) ((LAS bf16_t*)(lds + ML_VT))[128 * ML_RS + i] = (i < ML_RS) ? (bf16_t)0x3F80 : (bf16_t)0;
    for (int ci = wave; ci < nch; ci += NWAVES) {
        int rbase, nv; chunk_rows(ci, rbase, nv); const bool ok = lane < nv;
        const float li = ok ? gates[(size_t)(rbase + lane) * 16 + h] : -1.0e30f, f = ok ? gates[(size_t)(rbase + lane) * 16 + 8 + h] : 0.f;
        const float lf = ok ? (fminf(f, 0.f) - logf(1.f + expf(-fabsf(f)))) : 0.f;
        float bc = lf;
#pragma unroll
        for (int o = 1; o < 64; o <<= 1) { const float t = SHUP(bc, o); if (lane >= o) bc += t; }
        const float u = li - bc; float pm = u;
#pragma unroll
        for (int o = 1; o < 64; o <<= 1) { const float t = SHUP(pm, o); if (lane >= o) pm = fmaxf(pm, t); }
        tab[(0 * ML_NCH + ci) * 64 + lane] = bc; tab[(1 * ML_NCH + ci) * 64 + lane] = u; tab[(2 * ML_NCH + ci) * 64 + lane] = pm;
        if (lane == 63) { tsc[ci] = bc; tsc[32 + ci] = pm; }
    }
    if (MODE == 2 && seg > 0) {
        float ms[7], gs[7];
#pragma unroll
        for (int s2 = 0; s2 < 7; ++s2) { const bool ok = s2 < seg; ms[s2] = ok ? STSC[(bh * 7 + s2) * 4 + 0] : -1.0e30f; gs[s2] = ok ? STSC[(bh * 7 + s2) * 4 + 1] : 0.f; }
        float suf = 0.f; m0 = -1.0e30f;
#pragma unroll
        for (int s2 = 6; s2 >= 0; --s2) { ms[s2] += suf; suf += gs[s2]; m0 = fmaxf(m0, ms[s2]); }
#pragma unroll
        for (int s2 = 0; s2 < 7; ++s2) if (s2 < seg) {
            const float cf = fast_exp(ms[s2] - m0);
            const f32x4* sp = (const f32x4*)(STATE + (size_t)(bh * 7 + s2) * ST_FLOATS) + (wave * 5) * 64 + lane;
#pragma unroll
            for (int i = 0; i < 5; ++i) st[i] += sp[i * 64] * cf; }
    }
#pragma unroll
    for (int i = 0; i < 5; ++i) { const int dv = (i < 4) ? 16 * wave + fr : 128 + fr, dk = (i < 4) ? 16 * i + 4 * quad : 16 * wave + 4 * quad;
        if (i < 4 || wave < 4) { u32x2 w; w.x = pk2(st[i][0], st[i][1]); w.y = pk2(st[i][2], st[i][3]); *(LAS u32x2*)(lds + ML_CT + (dv * ML_RS + dk) * 2) = w; } }
    __syncthreads();
    if (wave == 0) {
        const float bl = lane < nch ? tsc[lane] : 0.f, um = lane < nch ? tsc[32 + lane] : 0.f; float m = m0, gs = 0.f;
        for (int ci = 0; ci < nch; ++ci) { const float blast = SHL(bl, ci), umax = SHL(um, ci), amax = blast + umax, mn = fmaxf(blast + m, amax);
            if (lane == 0) { tsc[64 + ci] = m; tsc[96 + ci] = fast_exp(blast + m - mn); tsc[128 + ci] = fast_exp(amax - mn); }
            m = mn; gs += blast; }
        if (lane == 0) { tsc[160] = m; tsc[161] = gs; }
    }
    __syncthreads();
    for (int idx = tid; idx < nch * 64; idx += NTHREADS) { const int ci = idx >> 6, j = idx & 63;
        const float bc = tab[(0 * ML_NCH + ci) * 64 + j], u = tab[(1 * ML_NCH + ci) * 64 + j], pm = tab[(2 * ML_NCH + ci) * 64 + j], mc = tsc[64 + ci], MM = fmaxf(pm, mc);
        tab[(3 * ML_NCH + ci) * 64 + j] = MM; tab[(4 * ML_NCH + ci) * 64 + j] = fast_exp(mc - MM); tab[(5 * ML_NCH + ci) * 64 + j] = fast_exp(-(bc + MM));
        tab[(6 * ML_NCH + ci) * 64 + j] = tsc[128 + ci] * fast_exp(u - tsc[32 + ci]); }
    float lnh[16];
    if (MODE == 2) {
#pragma unroll
        for (int e = 0; e < 16; ++e) lnh[e] = ((const float*)(ws + WS_SMALL))[SM_LNH + layer * D + h * M_V + 16 * (tid & 7) + e]; }
    u32x4 rq, rk, rv0, rv1, rg0, rg1;
    auto load_chunk = [&](int ci) {
        int rbase, nv; chunk_rows(ci, rbase, nv);
        if (MODE == 2) { const int i = tid >> 3, sg = tid & 7; const u32x4* ogp = (const u32x4*)(proj + (size_t)(rbase + (i < nv ? i : 0)) * PROJ_LD + 2048 + h * M_V + 16 * sg); rg0 = ogp[0]; rg1 = ogp[1]; }
        { const int j = tid >> 3, c8 = (tid & 7) * 8; const bf16_t* rp = proj + (size_t)(rbase + j) * PROJ_LD + h * 64 + c8;
          rq = (MODE == 2 && j < nv) ? *(const u32x4*)rp : (u32x4){0u, 0u, 0u, 0u}; }
        { const bf16_t* rp = proj + (size_t)(rbase + lane) * PROJ_LD; const bool ok = lane < nv;
          rk = ok ? *(const u32x4*)(rp + 512 + h * 64 + 8 * wave) : (u32x4){0u, 0u, 0u, 0u};
          rv0 = ok ? *(const u32x4*)(rp + 1024 + h * 128 + 16 * wave) : (u32x4){0u, 0u, 0u, 0u}; rv1 = ok ? *(const u32x4*)(rp + 1024 + h * 128 + 16 * wave + 8) : (u32x4){0u, 0u, 0u, 0u}; }
    };
    load_chunk(0);
    __syncthreads();
    PM2_END(1);
    for (int ci = 0; ci < nch; ++ci) {
        PM2_BEGIN(2);
        int rbase, nv; chunk_rows(ci, rbase, nv);
        const u32x4 g0 = rg0, g1 = rg1;
        const LAS float* tU = tab + (1 * ML_NCH + ci) * 64; const LAS float* tMM = tab + (3 * ML_NCH + ci) * 64; const LAS float* tSI = tab + (4 * ML_NCH + ci) * 64;
        const LAS float* tFL = tab + (5 * ML_NCH + ci) * 64; const LAS float* tWP = tab + (6 * ML_NCH + ci) * 64;
        const float sold = tsc[96 + ci];
        { if (MODE == 2) { const int j = tid >> 3, c8 = (tid & 7) * 8; *(LAS u32x4*)(lds + ML_QS + (j * ML_RS + c8) * 2) = rq; }
          const float wj = tWP[lane]; LAS bf16_t* kt = (LAS bf16_t*)(lds + ML_KT); LAS bf16_t* vt = (LAS bf16_t*)(lds + ML_VT);
          if (MODE == 2) *(LAS u32x4*)(lds + ML_KS + (lane * ML_RS + 8 * wave) * 2) = rk;
          const unsigned kk[4] = {rk.x, rk.y, rk.z, rk.w}, a[4] = {rv0.x, rv0.y, rv0.z, rv0.w}, c[4] = {rv1.x, rv1.y, rv1.z, rv1.w};
#pragma unroll
          for (int e = 0; e < 4; ++e) { kt[(8 * wave + 2 * e) * ML_RS + lane] = (bf16_t)f2bf(bf2f((unsigned short)(kk[e] & 0xffffu)) * wj); kt[(8 * wave + 2 * e + 1) * ML_RS + lane] = (bf16_t)f2bf(bf2f((unsigned short)(kk[e] >> 16)) * wj);
              vt[(16 * wave + 2 * e) * ML_RS + lane] = (bf16_t)(a[e] & 0xffffu); vt[(16 * wave + 2 * e + 1) * ML_RS + lane] = (bf16_t)(a[e] >> 16);
              vt[(16 * wave + 8 + 2 * e) * ML_RS + lane] = (bf16_t)(c[e] & 0xffffu); vt[(16 * wave + 8 + 2 * e + 1) * ML_RS + lane] = (bf16_t)(c[e] >> 16); } }
        __syncthreads();
        PM2_END(2); PM2_BEGIN(3);
        if (ci + 1 < nch) load_chunk(ci + 1);
        const int par = ci & 1, npar = par ^ 1;
        if (MODE == 2) {
            const int it = wave >> 1, dh = wave & 1, i = 16 * it + fr;
            const bf16x8 q0 = ml_frag(lds, ML_QS, i, 8 * quad), q1 = ml_frag(lds, ML_QS, i, 32 + 8 * quad);
            const float mmi = tMM[i], si = tSI[i], fl = tFL[i];
            f32x4 sT[4];
#pragma unroll
            for (int jt = 0; jt < 4; ++jt) { sT[jt] = (f32x4){0.f, 0.f, 0.f, 0.f};
                if (jt <= it) {
                    sT[jt] = __builtin_amdgcn_mfma_f32_16x16x32_bf16(ml_frag(lds, ML_KS, 16 * jt + fr, 8 * quad), q0, sT[jt], 0, 0, 0);
                    sT[jt] = __builtin_amdgcn_mfma_f32_16x16x32_bf16(ml_frag(lds, ML_KS, 16 * jt + fr, 32 + 8 * quad), q1, sT[jt], 0, 0, 0);
                    const f32x4 uj = *(const LAS f32x4*)(tU + 16 * jt + 4 * quad);
#pragma unroll
                    for (int r = 0; r < 4; ++r) { const bool vis = (jt < it) || (4 * quad + r <= fr); sT[jt][r] = vis ? sT[jt][r] * fast_exp(uj[r] - mmi) : 0.f; } } }
            f32x4 o1[4], o2[4], d1 = (f32x4){0.f, 0.f, 0.f, 0.f}, d2 = (f32x4){0.f, 0.f, 0.f, 0.f};
#pragma unroll
            for (int dt = 0; dt < 4; ++dt) { o1[dt] = (f32x4){0.f, 0.f, 0.f, 0.f}; o2[dt] = (f32x4){0.f, 0.f, 0.f, 0.f}; }
#pragma unroll
            for (int u = 0; u < 2; ++u) if (2 * u <= it) {
                u32x4 pw; pw.x = cvt_pk_bf16(sT[2 * u][0], sT[2 * u][1]); pw.y = cvt_pk_bf16(sT[2 * u][2], sT[2 * u][3]); pw.z = cvt_pk_bf16(sT[2 * u + 1][0], sT[2 * u + 1][1]); pw.w = cvt_pk_bf16(sT[2 * u + 1][2], sT[2 * u + 1][3]);
                const bf16x8 pf = __builtin_bit_cast(bf16x8, pw);
#pragma unroll
                for (int dt = 0; dt < 5; ++dt) { const int vrow = dt < 4 ? 16 * (4 * dh + dt) + fr : 128 + fr;
                    const LAS bf16_t* vr = (const LAS bf16_t*)(lds + ML_VT) + vrow * ML_RS + 32 * u + 4 * quad;
                    u32x4 vw; const u32x2 a = *(const LAS u32x2*)vr, c = *(const LAS u32x2*)(vr + 16); vw.x = a.x; vw.y = a.y; vw.z = c.x; vw.w = c.y;
                    if (dt < 4) o1[dt] = __builtin_amdgcn_mfma_f32_16x16x32_bf16(__builtin_bit_cast(bf16x8, vw), pf, o1[dt], 0, 0, 0);
                    else d1 = __builtin_amdgcn_mfma_f32_16x16x32_bf16(__builtin_bit_cast(bf16x8, vw), pf, d1, 0, 0, 0); } }
#pragma unroll
            for (int dt = 0; dt < 5; ++dt) { const int crow = dt < 4 ? 16 * (4 * dh + dt) + fr : 128 + fr;
                const bf16x8 c0 = ml_frag(lds, ML_CT + par * ML_CTB, crow, 8 * quad), c1 = ml_frag(lds, ML_CT + par * ML_CTB, crow, 32 + 8 * quad);
                if (dt < 4) { o2[dt] = __builtin_amdgcn_mfma_f32_16x16x32_bf16(c0, q0, o2[dt], 0, 0, 0); o2[dt] = __builtin_amdgcn_mfma_f32_16x16x32_bf16(c1, q1, o2[dt], 0, 0, 0); }
                else { d2 = __builtin_amdgcn_mfma_f32_16x16x32_bf16(c0, q0, d2, 0, 0, 0); d2 = __builtin_amdgcn_mfma_f32_16x16x32_bf16(c1, q1, d2, 0, 0, 0); } }
            float den = d1[0] + si * d2[0]; den = lx_(den, fr);
            const float rinv = __builtin_amdgcn_rcpf(fmaxf(fabsf(den), fl));
#pragma unroll
            for (int dt = 0; dt < 4; ++dt) *(LAS f32x4*)(lds + ML_HS + (i * ML_HSS + 16 * (4 * dh + dt) + 4 * quad) * 4) = (o1[dt] + o2[dt] * si) * rinv;
        }
        { bf16x8 vb[2];
#pragma unroll
          for (int ks = 0; ks < 2; ++ks) vb[ks] = ml_frag(lds, ML_VT, 16 * wave + fr, 32 * ks + 8 * quad);
#pragma unroll
          for (int mt2 = 0; mt2 < 4; ++mt2) { st[mt2] = st[mt2] * sold;
#pragma unroll
              for (int ks = 0; ks < 2; ++ks) st[mt2] = __builtin_amdgcn_mfma_f32_16x16x32_bf16(ml_frag(lds, ML_KT, 16 * mt2 + fr, 32 * ks + 8 * quad), vb[ks], st[mt2], 0, 0, 0); }
          if (wave < 4) { st[4] = st[4] * sold;
#pragma unroll
              for (int ks = 0; ks < 2; ++ks) st[4] = __builtin_amdgcn_mfma_f32_16x16x32_bf16(ml_frag(lds, ML_KT, 16 * wave + fr, 32 * ks + 8 * quad), ml_frag(lds, ML_VT, 128 + fr, 32 * ks + 8 * quad), st[4], 0, 0, 0); }
          if (MODE == 2) {
#pragma unroll
              for (int i = 0; i < 5; ++i) { const int dv = (i < 4) ? 16 * wave + fr : 128 + fr, dk = (i < 4) ? 16 * i + 4 * quad : 16 * wave + 4 * quad;
                  if (i < 4 || wave < 4) { u32x2 w; w.x = pk2(st[i][0], st[i][1]); w.y = pk2(st[i][2], st[i][3]); *(LAS u32x2*)(lds + ML_CT + npar * ML_CTB + (dv * ML_RS + dk) * 2) = w; } } }
        }
        __syncthreads();
        PM2_END(3); PM2_BEGIN(4);
        if (MODE == 2) {
            const int i = tid >> 3, sg = tid & 7; const LAS float* hp = (const LAS float*)(lds + ML_HS) + i * ML_HSS + 16 * sg;
            float x[16]; float s = 0.f;
#pragma unroll
            for (int e = 0; e < 16; ++e) { x[e] = hp[e]; s += x[e]; }
            s += SHX(s, 1); s += SHX(s, 2); s += SHX(s, 4);
            const float mean = s * (1.f / M_V); float q = 0.f;
#pragma unroll
            for (int e = 0; e < 16; ++e) { x[e] -= mean; q += x[e] * x[e]; }
            q += SHX(q, 1); q += SHX(q, 2); q += SHX(q, 4);
            const float rstd = 1.f / sqrtf(q * (1.f / M_V) + LN_EPS);
            if (i < nv && (nv == 64 || b == 0)) {
                const size_t row = (size_t)(rbase + i);
                const unsigned gw8[8] = {g0.x, g0.y, g0.z, g0.w, g1.x, g1.y, g1.z, g1.w}; unsigned ow[8];
#pragma unroll
                for (int e = 0; e < 8; ++e) { const float oga = bf2f((unsigned short)(gw8[e] & 0xffffu)), ogb = bf2f((unsigned short)(gw8[e] >> 16));
                    const float ya = x[2 * e] * rstd * lnh[2 * e] * __builtin_amdgcn_rcpf(1.f + fast_exp(-oga)), yb = x[2 * e + 1] * rstd * lnh[2 * e + 1] * __builtin_amdgcn_rcpf(1.f + fast_exp(-ogb));
                    ow[e] = pk2(ya, yb); }
                u32x4* op = (u32x4*)(HG + row * D + h * M_V + 16 * sg);
                op[0] = (u32x4){ow[0], ow[1], ow[2], ow[3]}; op[1] = (u32x4){ow[4], ow[5], ow[6], ow[7]};
            }
        }
        PM2_END(4);
    }
    if (PROBE_M2 && MODE == 2 && pticks) *pticks += pacc;
    if (MODE == 1) {
        f32x4* sp = (f32x4*)(STATE + (size_t)(bh * 7 + seg) * ST_FLOATS) + (wave * 5) * 64 + lane;
#pragma unroll
        for (int i = 0; i < 5; ++i) sp[i * 64] = (i < 4 || wave < 4) ? st[i] : (f32x4){0.f, 0.f, 0.f, 0.f};
        if (tid == 0) { STSC[(bh * 7 + seg) * 4 + 0] = tsc[160]; STSC[(bh * 7 + seg) * 4 + 1] = tsc[161]; }
    }
}

constexpr int AT_KRS = 72, AT_VRS = 280, AT_NK = 272;
constexpr int AT_KS = 0, AT_VT = AT_NK * AT_KRS * 2, AT_END = AT_VT + 64 * AT_VRS * 2;
static_assert(AT_END <= MISC_OFF, "attention LDS");
__device__ __forceinline__ void attn_phase(unsigned char* ws, LAS unsigned char* lds, int j_layer, int tid, int wave, int lane) {
    const bf16_t* Q = (const bf16_t*)(ws + WS_PROJ); const bf16_t* KB = (const bf16_t*)(ws + WS_KB); const bf16_t* VT = (const bf16_t*)(ws + WS_VB);
    unsigned char* HG8 = ws + WS_HG;
    const float* sinks = (const float*)(ws + WS_SMALL) + SM_SINKS + j_layer * A_HEADS;
    const int fr = lane & 15, quad = lane >> 4;
    LAS bf16_t* ks = (LAS bf16_t*)(lds + AT_KS); LAS bf16_t* vt = (LAS bf16_t*)(lds + AT_VT);
    u32x4 kreg[5], vreg[5]; bf16x8 qn[2][2];
    const int NREG = NBATCH * A_KV * (SEQ / WINDOW), NIT = NREG + A_KV;
    auto prefetch = [&](int it) {
        const bool meta = it >= NREG; const int b = meta ? 0 : it >> 8, g = meta ? it - NREG : (it >> 6) & 3, blk = meta ? -1 : it & 63;
#pragma unroll
        for (int i = 0; i < 5; ++i) { const int p = tid + i * NTHREADS; kreg[i] = (u32x4){0u, 0u, 0u, 0u}; vreg[i] = (u32x4){0u, 0u, 0u, 0u};
            if (p < AT_NK * 8) { const int kk = p >> 3, c8 = (p & 7) * 8;
                int row; if (kk >= 256) row = MREAL + kk - 256; else { const int tk = (blk - 1) * WINDOW + kk; row = (tk < 0 || meta) ? -1 : b * SEQ + tk; }
                if (row >= 0) kreg[i] = *(const u32x4*)(KB + (size_t)row * 256 + g * 64 + c8);
                const int d = p / 34, pc = p % 34; const bf16_t* src = VT + (size_t)(g * 64 + d) * MP;
                if (pc >= 32) vreg[i] = *(const u32x4*)(src + MREAL + (pc - 32) * 8);
                else { const int tk = (blk - 1) * WINDOW + pc * 8; if (tk >= 0 && !meta) vreg[i] = *(const u32x4*)(src + (size_t)b * SEQ + tk); } } }
    };
    auto qload = [&](int it, int mp) {
        const bool meta = it >= NREG; const int b = it >> 8, g = meta ? it - NREG : (it >> 6) & 3, blk = it & 63, qh = g * 4 + (wave >> 1);
#pragma unroll
        for (int x = 0; x < 2; ++x) { const size_t rowq = meta ? (size_t)MREAL + fr : (size_t)b * SEQ + blk * WINDOW + 16 * (4 * (wave & 1) + 2 * mp + x) + fr;
#pragma unroll
            for (int k2 = 0; k2 < 2; ++k2) qn[x][k2] = *(const bf16x8*)(Q + rowq * D + qh * 64 + 32 * k2 + 8 * quad); }
    };
    if ((int)blockIdx.x < NIT) { prefetch(blockIdx.x); qload(blockIdx.x, 0); }
    for (int it = blockIdx.x; it < NIT; it += gridDim.x) {
        const bool meta = it >= NREG; const int b = it >> 8, g = meta ? it - NREG : (it >> 6) & 3, blk = it & 63;
        __syncthreads();
#pragma unroll
        for (int i = 0; i < 5; ++i) { const int p = tid + i * NTHREADS;
            if (p < AT_NK * 8) { *(LAS u32x4*)(ks + (p >> 3) * AT_KRS + (p & 7) * 8) = kreg[i]; *(LAS u32x4*)(vt + (p / 34) * AT_VRS + (p % 34) * 8) = vreg[i]; } }
        __syncthreads();
        const bool has_next = it + (int)gridDim.x < NIT;
        if (has_next) prefetch(it + gridDim.x);
        const int qh = g * 4 + (wave >> 1); const float sink = sinks[qh];
#pragma unroll 1
        for (int mp = 0; mp < 2; ++mp) {
            if (meta && (mp > 0 || (wave & 1))) continue;
            const int t0 = meta ? 0 : 4 * (wave & 1) + 2 * mp;
            f32x4 s[2][11];
#pragma unroll
            for (int c = 0; c < 11; ++c) { const int kb = (c < 10) ? 16 * (t0 + c) : 256; s[0][c] = (f32x4){0.f, 0.f, 0.f, 0.f}; s[1][c] = (f32x4){0.f, 0.f, 0.f, 0.f};
#pragma unroll
                for (int k2 = 0; k2 < 2; ++k2) { const bf16x8 kf = *(const LAS bf16x8*)(ks + (kb + fr) * AT_KRS + 32 * k2 + 8 * quad);
                    if (c != 9) s[0][c] = __builtin_amdgcn_mfma_f32_16x16x32_bf16(kf, qn[0][k2], s[0][c], 0, 0, 0);
                    if (c != 0) s[1][c] = __builtin_amdgcn_mfma_f32_16x16x32_bf16(kf, qn[1][k2], s[1][c], 0, 0, 0); } }
            if (mp == 0) { if (!meta) qload(it, 1); } else if (has_next) qload(it + gridDim.x, 0);
            float inv[2];
#pragma unroll
            for (int x = 0; x < 2; ++x) {
                float m = sink;
#pragma unroll
                for (int c = 0; c < 10; ++c) { const int rc = c - x;
                    const bool tok = !meta && rc >= 0 && rc <= 8 && (blk > 0 || t0 + c >= 8);
#pragma unroll
                    for (int r = 0; r < 4; ++r) { const bool vis = tok && (rc != 0 || fr < 4 * quad + r) && (rc != 8 || fr >= 4 * quad + r);
                        s[x][c][r] = vis ? s[x][c][r] : -1.0e30f; m = fmaxf(m, s[x][c][r]); } }
#pragma unroll
                for (int r = 0; r < 4; ++r) { const bool vis = !meta || (4 * quad + r <= fr); s[x][10][r] = vis ? s[x][10][r] : -1.0e30f; m = fmaxf(m, s[x][10][r]); }
                m = fmaxf(m, SHX(m, 16)); m = fmaxf(m, SHX(m, 32));
                float sm = 0.f;
#pragma unroll
                for (int c = 0; c < 11; ++c)
#pragma unroll
                    for (int r = 0; r < 4; ++r) { const float p = fast_exp(s[x][c][r] - m); s[x][c][r] = p; sm += p; }
                sm += SHX(sm, 16); sm += SHX(sm, 32);
                inv[x] = 1.f / (sm + fast_exp(sink - m));
            }
            f32x4 o[2][4];
#pragma unroll
            for (int x = 0; x < 2; ++x)
#pragma unroll
                for (int dt = 0; dt < 4; ++dt) o[x][dt] = (f32x4){0.f, 0.f, 0.f, 0.f};
#pragma unroll
            for (int u = 0; u < 6; ++u) {
                const int kb0 = (u < 5) ? 16 * (t0 + 2 * u) : 256, kb1 = (u < 5) ? 16 * (t0 + 2 * u + 1) : 256;
                bf16x8 pf[2];
#pragma unroll
                for (int x = 0; x < 2; ++x) { u32x4 pw;
                    if (u < 5) { pw.x = cvt_pk_bf16(s[x][2 * u][0], s[x][2 * u][1]); pw.y = cvt_pk_bf16(s[x][2 * u][2], s[x][2 * u][3]); pw.z = cvt_pk_bf16(s[x][2 * u + 1][0], s[x][2 * u + 1][1]); pw.w = cvt_pk_bf16(s[x][2 * u + 1][2], s[x][2 * u + 1][3]); }
                    else { pw.x = cvt_pk_bf16(s[x][10][0], s[x][10][1]); pw.y = cvt_pk_bf16(s[x][10][2], s[x][10][3]); pw.z = 0u; pw.w = 0u; }
                    pf[x] = __builtin_bit_cast(bf16x8, pw); }
#pragma unroll
                for (int dt = 0; dt < 4; ++dt) { const LAS bf16_t* vr = vt + (16 * dt + fr) * AT_VRS + 4 * quad;
                    u32x4 vw; const u32x2 a = *(const LAS u32x2*)(vr + kb0), c2 = *(const LAS u32x2*)(vr + kb1); vw.x = a.x; vw.y = a.y; vw.z = c2.x; vw.w = c2.y;
                    const bf16x8 vf = __builtin_bit_cast(bf16x8, vw);
                    o[0][dt] = __builtin_amdgcn_mfma_f32_16x16x32_bf16(vf, pf[0], o[0][dt], 0, 0, 0);
                    o[1][dt] = __builtin_amdgcn_mfma_f32_16x16x32_bf16(vf, pf[1], o[1][dt], 0, 0, 0); } }
#pragma unroll
            for (int x = 0; x < 2; ++x) { if (meta && x > 0) continue;
                const size_t rowq = meta ? (size_t)MREAL + fr : (size_t)b * SEQ + blk * WINDOW + 16 * (t0 + x) + fr;
#pragma unroll
                for (int dt = 0; dt < 4; ++dt) { const float sv = inv[x] * F8_SO;
                    *(unsigned*)(HG8 + rowq * D + qh * 64 + 16 * dt + 4 * quad) = pk4_fp8(o[x][dt][0] * sv, o[x][dt][1] * sv, o[x][dt][2] * sv, o[x][dt][3] * sv); } }
        }
    }
}

#ifndef SITES
#define SITES 0xFFFF
#endif
#define SITE(n) ((SITES >> (n)) & 1)
#ifndef DUPMASK
#define DUPMASK 0
#endif
#define REPS(n) (1 + ((DUPMASK >> (n)) & 1))
#ifndef MK_PER_PHASE
#define MK_PER_PHASE 0
#endif
constexpr int PH_PER_LAYER = 12, N_PHASES = 1 + 4 * PH_PER_LAYER;

__global__ void __launch_bounds__(NTHREADS, 2) fwd(Params P) {
    extern __shared__ __attribute__((aligned(16))) unsigned char lds_raw[];
    LAS unsigned char* const lds0 = (LAS unsigned char*)lds_raw;
    const int wave_s = __builtin_amdgcn_readfirstlane((int)threadIdx.x >> 6);
    const int G = gridDim.x;
    const int vcu = (G % 8 == 0) ? ((int)blockIdx.x % 8) * (G / 8) + (int)blockIdx.x / 8 : (int)blockIdx.x;
    const int NGW = G * NWAVES;
    unsigned char* const wsbase = P.ws;
    volatile LAS unsigned* misc = (volatile LAS unsigned*)(lds0 + MISC_OFF);
    if (threadIdx.x < 64) misc[threadIdx.x] = 0u;
    __syncthreads();
    XcdBarrier bar = xcd_barrier_post((unsigned*)(wsbase + WS_CTL) + CW_BAR + P.li * 4096, misc + 8);
    const int lo = P.ph_lo, hi = P.ph_hi;
    unsigned long long idle_ticks = 0; (void)idle_ticks;
#define RUN(idx) ((idx) >= lo && (idx) < hi)
#ifndef PROBE_IDLE
#define PROBE_IDLE 0
#endif
#if PROBE_IDLE
#ifndef PROBE_KMASK
#define PROBE_KMASK 0xFFFF
#endif
#define SEAM(idx) do { if ((idx) + 1 < hi) { const unsigned long long _t0 = __builtin_amdgcn_s_memrealtime(); xcd_barrier(bar, tid == 0); const int _k = (idx) == 0 ? 15 : ((idx) - 1) % PH_PER_LAYER; \
        if ((PROBE_KMASK >> _k) & 1) idle_ticks += __builtin_amdgcn_s_memrealtime() - _t0; } } while (0)
#else
#define SEAM(idx) do { if ((idx) + 1 < hi) xcd_barrier(bar, tid == 0); } while (0)
#endif
#define IDS() unsigned mall = ~0u; asm volatile("; opaque mask" : "+s"(mall)); int tid = wave_s * 64 + (int)__builtin_amdgcn_mbcnt_hi(mall, __builtin_amdgcn_mbcnt_lo(mall, 0u)); asm volatile("; opaque tid" : "+v"(tid));   size_t wsz = 0; asm volatile("; opaque ws offset" : "+s"(wsz)); unsigned char* ws = wsbase + wsz;   \
              LAS unsigned char* lds = lds0; asm volatile("; opaque lds" : "+s"(lds)); \
              const int lane = tid & 63, wave = __builtin_amdgcn_readfirstlane(tid >> 6); const int gw = vcu * NWAVES + wave; (void)lane; (void)gw; (void)ws

    for (int rep = 0; rep < REPS(0); ++rep) if (SITE(0) && RUN(0)) { IDS(); p0_prologue(P, lds, gw, NGW, wave, lane, bar, tid); SEAM(0); }

    for (int l = 0; l < 4; ++l) {
        const int pb = 1 + l * PH_PER_LAYER;
        const bool moe = (l & 1) != 0; const int fi = l >> 1;
        if (l < 2) {
            for (int rep = 0; rep < REPS(1); ++rep) if (SITE(1) && RUN(pb + 0)) {
                IDS();
                pg8::DenseOrder S; S.init(MREAL / 256, 12, G, (int)blockIdx.x);
                const float* smi = (const float*)(ws + WS_SMALL); const float asc = l == 0 ? smi[SM_WSCALE + 23] : smi[SM_ASCALE + 2 * l - 1];
                EpiProj E{(bf16_t*)(ws + WS_PROJ), (float*)(ws + WS_GATES), smi + SM_BGATE + l * 16, asc * smi[SM_WSCALE + 21 + l]};
                const bf16_t* HBp = (const bf16_t*)(ws + WS_HB); const bf16_t* Wp = (const bf16_t*)(ws + WS_WIN) + (size_t)l * M_INP * D;
                pg8::gemm_phase<EpiProj, pg8::DenseOrder, 2>(lds, ws + WS_HB8, ws + WS_WIN8 + (size_t)l * 3072 * D, D, S, E, tid);
                bf16_t* PROJ = (bf16_t*)(ws + WS_PROJ); float* GATES = (float*)(ws + WS_GATES); const float* bg = (const float*)(ws + WS_SMALL) + SM_BGATE + l * 16;
                unsigned* itemctr = (unsigned*)(ws + WS_CTL) + CW_ITEM + l * 8 + 1; int par = 0;
                for (int item = claim_item(itemctr, lds, tid); item < 192; item = claim_item(itemctr, lds, tid), par ^= 1) { const bf16_t* B1[1] = {Wp + (size_t)item * 16 * D};
                    skinny_item<1>(HBp + (size_t)MREAL * D, D, B1, D, wave, lane, lds, par, [&](const f32x4 (&a)[1], int fr, int quad) {
#pragma unroll
                        for (int r = 0; r < 4; ++r) PROJ[(size_t)(MREAL + 4 * quad + r) * PROJ_LD + item * 16 + fr] = (bf16_t)f2bf(a[0][r]); }); }
                { const int fr = lane & 15, quad = lane >> 4; const bf16_t* bp = Wp + (size_t)(3072 + fr) * D + 8 * quad; const float bias = bg[fr];
                  for (int rt = gw; rt < MV / 16; rt += NGW) { const bf16_t* ap = HBp + (size_t)(rt * 16 + fr) * D + 8 * quad;
                      f32x4 a0 = (f32x4){0.f, 0.f, 0.f, 0.f}, a1 = (f32x4){0.f, 0.f, 0.f, 0.f};
#pragma unroll 8
                      for (int k = 0; k < D; k += 64) { a0 = __builtin_amdgcn_mfma_f32_16x16x32_bf16(*(const bf16x8*)(ap + k), *(const bf16x8*)(bp + k), a0, 0, 0, 0);
                          a1 = __builtin_amdgcn_mfma_f32_16x16x32_bf16(*(const bf16x8*)(ap + k + 32), *(const bf16x8*)(bp + k + 32), a1, 0, 0, 0); }
#pragma unroll
                      for (int r = 0; r < 4; ++r) GATES[(size_t)(rt * 16 + 4 * quad + r) * 16 + fr] = a0[r] + a1[r] + bias; } }
                SEAM(pb + 0); }
            for (int rep = 0; rep < REPS(2); ++rep) if (SITE(2) && RUN(pb + 1)) { IDS(); mlstm_phase<1>(ws, lds, l, tid, wave, lane); SEAM(pb + 1); }
            for (int rep = 0; rep < REPS(3); ++rep) if (SITE(3) && RUN(pb + 2)) { IDS(); mlstm_phase<2>(ws, lds, l, tid, wave, lane, &idle_ticks); SEAM(pb + 2); }
        } else {
            for (int rep = 0; rep < REPS(4); ++rep) if (SITE(4) && RUN(pb + 0)) {
                IDS();
                pg8::DenseOrder S; S.init(MREAL / 256, l == 2 ? 6 : 4, G, (int)blockIdx.x);
                const float* smq = (const float*)(ws + WS_SMALL); const float asc = smq[SM_ASCALE + 2 * l - 1];
                EpiQKV E{(bf16_t*)(ws + WS_PROJ), (bf16_t*)(ws + WS_KB), (bf16_t*)(ws + WS_VB), (const float*)(ws + WS_ROPE), asc * smq[SM_WSCALE + 18 + (l - 2)] * 0.125f, asc * smq[SM_WSCALE + 20], lds + RING_BYTES};
                const bf16_t* HBp = (const bf16_t*)(ws + WS_HB); const bf16_t* Wp = (const bf16_t*)(ws + (l == 2 ? WS_WQKV : WS_WQ3));
                pg8::gemm_phase<EpiQKV, pg8::DenseOrder, 2>(lds, ws + WS_HB8, ws + WS_WQKV8 + (l == 2 ? 0 : (size_t)1536 * D), D, S, E, tid);
                bf16_t* Qp = (bf16_t*)(ws + WS_PROJ); bf16_t* KBp = (bf16_t*)(ws + WS_KB); bf16_t* VTp = (bf16_t*)(ws + WS_VB); const float* rope = (const float*)(ws + WS_ROPE);
                unsigned* itemctr = (unsigned*)(ws + WS_CTL) + CW_ITEM + l * 8 + 2; int par = 0;
                for (int item = claim_item(itemctr, lds, tid); item < (l == 2 ? 96 : 64); item = claim_item(itemctr, lds, tid), par ^= 1) { const bf16_t* B1[1] = {Wp + (size_t)item * 16 * D};
                    skinny_item<1>(HBp + (size_t)MREAL * D, D, B1, D, wave, lane, lds, par, [&](const f32x4 (&a)[1], int fr, int quad) {
                        const int col = item * 16 + fr; const bool dorope = (item < 80) && ((item & 3) == 0);
#pragma unroll
                        for (int r = 0; r < 4; ++r) { const int pos = 4 * quad + r; float x = a[0][r]; const float y = SHX(x, 8);
                            if (dorope) { const float c = rope[pos * 16 + (fr & 7)], sn = rope[pos * 16 + 8 + (fr & 7)]; x = (fr < 8) ? x * c - y * sn : x * c + y * sn; }
                            const bf16_t o = (bf16_t)f2bf(x); const size_t row = (size_t)MREAL + pos;
                            if (item < 64) Qp[row * D + col] = o; else if (item < 80) KBp[row * 256 + col - 1024] = o; else VTp[(size_t)(col - 1280) * MP + row] = o; } });
                }
                SEAM(pb + 0); }
            for (int rep = 0; rep < REPS(5); ++rep) if (SITE(5) && RUN(pb + 1)) { IDS(); attn_phase(ws, lds, l - 2, tid, wave, lane); SEAM(pb + 1); }
        }
        for (int rep = 0; rep < REPS(6); ++rep) if (SITE(6) && RUN(pb + 3)) {
            IDS();
            pg8::DenseOrder S; S.init(MREAL / 256, 4, G, (int)blockIdx.x);
            const float* smp = (const float*)(ws + WS_SMALL);
            EpiRes E{(bf16_t*)(ws + WS_H), (const float*)(ws + WS_STATS), l > 0 ? smp + SM_LNG + (size_t)(2 * l - 1) * D : nullptr, smp + SM_LNB + (size_t)(l > 0 ? 2 * l - 1 : 0) * D, P.in[I_X], 1.f};
            if (l < 2) {
            const bf16_t* Ap = (const bf16_t*)(ws + WS_HG); const bf16_t* Wp = (const bf16_t*)(ws + WS_WOUT) + (size_t)(l & 1) * D * D;
            pg8::gemm_phase(lds, Ap, Wp, D, S, E, tid);
            unsigned* itemctr = (unsigned*)(ws + WS_CTL) + CW_ITEM + l * 8 + 3; int par = 0;
            for (int item = claim_item(itemctr, lds, tid); item < 64; item = claim_item(itemctr, lds, tid), par ^= 1) { const bf16_t* B1[1] = {Wp + (size_t)item * 16 * D};
                skinny_item<1>(Ap + (size_t)MREAL * D, D, B1, D, wave, lane, lds, par, [&](const f32x4 (&a)[1], int fr, int quad) { const int col = item * 16 + fr;
#pragma unroll
                    for (int r = 0; r < 4; ++r) { const size_t row = (size_t)MREAL + 4 * quad + r; float h = E.lg ? bf2f(E.H[row * D + col]) : P.in[I_META][(size_t)(4 * quad + r) * D + col];
                        if (E.lg) h = (h - E.stats[2 * row]) * E.stats[2 * row + 1] * E.lg[col] + E.lb[col];
                        E.H[row * D + col] = (bf16_t)f2bf(h * ALPHA + a[0][r]); } });
            }
            } else {
            EpiRes E8 = E; E8.sc = F8_INVO;
            const unsigned char* Ap = ws + WS_HG; const unsigned char* Wp = ws + WS_WO8 + (size_t)(l & 1) * D * D;
            pg8::gemm_phase<EpiRes, pg8::DenseOrder, 1>(lds, Ap, Wp, D, S, E8, tid);
            unsigned* itemctr = (unsigned*)(ws + WS_CTL) + CW_ITEM + l * 8 + 4; int par = 0;
            for (int item = claim_item(itemctr, lds, tid); item < 64; item = claim_item(itemctr, lds, tid), par ^= 1) { const unsigned char* B1[1] = {Wp + (size_t)item * 16 * D};
                skinny_item8<1>(Ap + (size_t)MREAL * D, D, B1, D, wave, lane, lds, par, [&](const f32x4 (&a)[1], int fr, int quad) { const int col = item * 16 + fr;
#pragma unroll
                    for (int r = 0; r < 4; ++r) { const size_t row = (size_t)MREAL + 4 * quad + r; float h = bf2f(E.H[row * D + col]);
                        h = (h - E.stats[2 * row]) * E.stats[2 * row + 1] * E.lg[col] + E.lb[col];
                        E.H[row * D + col] = (bf16_t)f2bf(h * ALPHA + a[0][r] * F8_INVO); } });
            }
            }
            SEAM(pb + 3); }
        for (int rep = 0; rep < (moe ? REPS(14) : REPS(7)); ++rep) if (SITE(7) && RUN(pb + 4)) { IDS(); ln_phase(ws, nullptr, lds, gw, NGW, lane, tid, l * 2 + 0, false, moe, fi, false, moe && rep > 0, true); SEAM(pb + 4); }
        if (!moe) {
            for (int rep = 0; rep < REPS(8); ++rep) if (SITE(8) && RUN(pb + 5)) {
                IDS();
                pg8::DenseOrder S; S.init(MREAL / 256, 2 * D_FF / 256, G, (int)blockIdx.x);
                EpiSwiglu8 E{ws + WS_ACT, D_FF, ((const float*)(ws + WS_SMALL))[SM_ASCALE + 2 * l], (const float*)(ws + WS_SMALL) + SM_WSCALE + fi, 0};
                const bf16_t* HBp = (const bf16_t*)(ws + WS_HB); const bf16_t* Wp = (const bf16_t*)(ws + WS_WGU) + (size_t)fi * 2 * D_FF * D;
                pg8::gemm_phase<EpiSwiglu8, pg8::DenseOrder, 2>(lds, ws + WS_HB8, ws + WS_WGU8 + (size_t)fi * 2 * D_FF * D, D, S, E, tid);
                unsigned* itemctr = (unsigned*)(ws + WS_CTL) + CW_ITEM + l * 8 + 5; int par = 0;
                for (int item = claim_item(itemctr, lds, tid); item < D_FF / 16; item = claim_item(itemctr, lds, tid), par ^= 1) {
                    const int brow = 256 * (item >> 3) + 16 * (item & 7); const bf16_t* B2[2] = {Wp + (size_t)brow * D, Wp + (size_t)(brow + 128) * D};
                    skinny_item<2>(HBp + (size_t)MREAL * D, D, B2, D, wave, lane, lds, par, [&](const f32x4 (&a)[2], int fr, int quad) {
#pragma unroll
                        for (int r = 0; r < 4; ++r) E.act[(size_t)(MREAL + 4 * quad + r) * D_FF + item * 16 + fr] = (unsigned char)(pk4_fp8(EpiSwiglu::silu_mul(a[0][r], a[1][r]) * F8_SACT, 0.f, 0.f, 0.f) & 0xffu); });
                }
                SEAM(pb + 5); }
            for (int rep = 0; rep < REPS(9); ++rep) if (SITE(9) && RUN(pb + 6)) {
                IDS();
                pg8::DenseOrder S; S.init(MREAL / 256, 4, G, (int)blockIdx.x);
                const float* smp = (const float*)(ws + WS_SMALL);
                EpiRes E{(bf16_t*)(ws + WS_H), (const float*)(ws + WS_STATS), smp + SM_LNG + (size_t)(2 * l) * D, smp + SM_LNB + (size_t)(2 * l) * D, nullptr, F8_INVD};
                const unsigned char* Ap = ws + WS_ACT; const unsigned char* Wp = ws + WS_WDN8 + (size_t)fi * D * D_FF;
                pg8::gemm_phase<EpiRes, pg8::DenseOrder, true>(lds, Ap, Wp, D_FF, S, E, tid);
                unsigned* itemctr = (unsigned*)(ws + WS_CTL) + CW_ITEM + l * 8 + 6; int par = 0;
                for (int item = claim_item(itemctr, lds, tid); item < 64; item = claim_item(itemctr, lds, tid), par ^= 1) { const unsigned char* B1[1] = {Wp + (size_t)item * 16 * D_FF};
                    skinny_item8<1>(Ap + (size_t)MREAL * D_FF, D_FF, B1, D_FF, wave, lane, lds, par, [&](const f32x4 (&a)[1], int fr, int quad) { const int col = item * 16 + fr;
#pragma unroll
                        for (int r = 0; r < 4; ++r) { const size_t row = (size_t)MREAL + 4 * quad + r; float h = bf2f(E.H[row * D + col]);
                            h = (h - E.stats[2 * row]) * E.stats[2 * row + 1] * E.lg[col] + E.lb[col];
                            E.H[row * D + col] = (bf16_t)f2bf(h * ALPHA + a[0][r] * E.sc); } });
                }
                SEAM(pb + 6); }
        } else {
            for (int rep = 0; rep < REPS(10); ++rep) if (SITE(10) && RUN(pb + 5)) { IDS(); assign_phase(ws, lds, gw, NGW, lane, tid, wave, fi); SEAM(pb + 5); }
            for (int rep = 0; rep < REPS(11); ++rep) if (SITE(11) && RUN(pb + 6)) {
                IDS();
                int cnt[8]; pg8::GroupedOrder S; moe_starts(ws, fi, cnt, S.pstart);
                S.o.init(S.pstart[8], 2 * D_FF_EXP / 256, G, (int)blockIdx.x); S.nexp_rows = 2 * D_FF_EXP; S.rowtok = (const int*)(ws + WS_ROWTOK);
                EpiSwiglu8 E{ws + WS_ACT, D_FF_EXP, ((const float*)(ws + WS_SMALL))[SM_ASCALE + 2 * l], (const float*)(ws + WS_SMALL) + SM_WSCALE + 2 + fi * 8, 2 * D_FF_EXP};
                pg8::gemm_phase<EpiSwiglu8, pg8::GroupedOrder, 2>(lds, ws + WS_HB8, ws + WS_WGUE8 + (size_t)fi * 8 * 2 * D_FF_EXP * D, D, S, E, tid);
                SEAM(pb + 6); }
            for (int rep = 0; rep < REPS(12); ++rep) if (SITE(12) && RUN(pb + 7)) {
                IDS();
                int cnt[8]; pg8::GroupedOrder S; moe_starts(ws, fi, cnt, S.pstart);
                S.o.init(S.pstart[8], 4, G, (int)blockIdx.x); S.nexp_rows = D; S.rowtok = nullptr;
                EpiScatter E{(bf16_t*)(ws + WS_CONTRIB), (const int*)(ws + WS_ROWDST), (const float*)(ws + WS_ROWGATE), F8_INVD};
                pg8::gemm_phase<EpiScatter, pg8::GroupedOrder, true>(lds, ws + WS_ACT, ws + WS_WDNE8 + (size_t)fi * 8 * D * D_FF_EXP, D_FF_EXP, S, E, tid);
                SEAM(pb + 7); }
        }
        for (int rep = 0; rep < (moe ? (l == 1 ? REPS(15) : 1) : REPS(13)); ++rep) if (SITE(13) && RUN(pb + 10)) { IDS(); ln_phase(ws, P.out, lds, gw, NGW, lane, tid, l * 2 + 1, moe, false, 0, l == 3, moe && rep == 0 && REPS(15) > 1, l <= 2, l == 0); SEAM(pb + 10); }
    }
#if PROBE_IDLE
    { unsigned* ctl = (unsigned*)(wsbase + WS_CTL); IDS();
      if (tid == 0) __hip_atomic_fetch_add(ctl + 2048, (unsigned)idle_ticks, __ATOMIC_RELAXED, __HIP_MEMORY_SCOPE_AGENT);
      xcd_barrier(bar, tid == 0);
      if (blockIdx.x == 0 && tid == 0) { const unsigned long long w = (unsigned long long)__hip_atomic_load(ctl + 2048, __ATOMIC_RELAXED, __HIP_MEMORY_SCOPE_AGENT) / (unsigned)G;
          const unsigned long long t0 = __builtin_amdgcn_s_memrealtime(); while (__builtin_amdgcn_s_memrealtime() - t0 < w) __builtin_amdgcn_s_sleep(8); } }
#endif
#undef RUN
#undef SEAM
#undef IDS
}

extern "C" void kernel_launch(void* const* d_in, const int* in_sizes, int n_in, void* d_out, int out_size, void* d_ws, size_t ws_size, hipStream_t stream) {
    static int grid = 0;
    if (grid == 0) {
        if (n_in != 18 || out_size != MREAL * D || ws_size < WS_END) { fprintf(stderr, "kernel_launch: unexpected shapes (n_in %d, out %d, ws %zu < %zu)\n", n_in, out_size, ws_size, (size_t)WS_END); grid = -1; return; }
        int dev = 0, cus = 0, per_cu = 0;
        if (hipGetDevice(&dev) != hipSuccess || hipDeviceGetAttribute(&cus, hipDeviceAttributeMultiprocessorCount, dev) != hipSuccess) { grid = -1; return; }
        if (hipFuncSetAttribute((const void*)fwd, hipFuncAttributeMaxDynamicSharedMemorySize, LDS_BYTES) != hipSuccess) { fprintf(stderr, "kernel_launch: hipFuncSetAttribute failed\n"); grid = -1; return; }
        if (hipOccupancyMaxActiveBlocksPerMultiprocessor(&per_cu, (const void*)fwd, NTHREADS, LDS_BYTES) != hipSuccess || per_cu < 1) fprintf(stderr, "kernel_launch: occupancy query reports %d\n", per_cu);
        (void)hipGetLastError();
        grid = cus > 256 ? 256 : cus;
    }
    if (grid < 0) return;
    (void)in_sizes;
    if (hipMemsetAsync((char*)d_ws + WS_CTL, 0, CTL_BYTES, stream) != hipSuccess) return;
    Params p{};
    for (int i = 0; i < 18; ++i) p.in[i] = (const float*)d_in[i];
    p.out = (float*)d_out; p.ws = (unsigned char*)d_ws;
#if MK_PER_PHASE
    int li = 0;
    for (int ph = 0; ph < N_PHASES; ++ph) {
        const int k = (ph - 1) % PH_PER_LAYER, l = (ph - 1) / PH_PER_LAYER;
        if (ph > 0) { const bool moe = l & 1; if (k == 2 && l >= 2) continue; if (k == 8 || k == 9 || k == 11) continue; if (k == 7 && !moe) continue; }
        p.ph_lo = ph; p.ph_hi = ph + 1; p.li = li++; p.pad = 0;
        hipLaunchKernelGGL(fwd, dim3(grid), dim3(NTHREADS), LDS_BYTES, stream, p);
    }
#else
    p.ph_lo = 0; p.ph_hi = N_PHASES; p.li = 0; p.pad = 0;
    hipLaunchKernelGGL(fwd, dim3(grid), dim3(NTHREADS), LDS_BYTES, stream, p);
#endif
}
```
